# Optimizing an MI355X kernel written in HIP

```python
import math
import jax
import jax.numpy as jnp
from jax import lax
import numpy as np

D_MODEL = 1024
BATCH = 2
SEQ = 8192
DEPTH = 2

N_MIXERS = 4
GROUP_W = D_MODEL // N_MIXERS
HEAD_DIM = 64
N_GROUP_HEADS = GROUP_W // HEAD_DIM
ML_CHUNK = 128
MLA_Q_RANK = 224
MLA_KV_RANK = 128
MLA_NOPE = 64
MLA_ROPE = 32
MLA_V = 64
ROPE_THETA = 10000.0
ATTN_Q_BLOCK = 128
HY_ORDER = 2
HY_BANDS = 8
HY_EMB = 1 + 2 * HY_BANDS
HY_FFN = 64
HY_N_FILT = HY_ORDER * 2 * GROUP_W
CONV_W = 3
N_EXPERTS = 16
EC_CAPACITY = 2
EXPERT_FF = 2 * D_MODEL
NORM_EPS = 1e-6
D_IN = 4 * GROUP_W + 4 * N_GROUP_HEADS + MLA_Q_RANK + MLA_KV_RANK + MLA_ROPE + 6 * GROUP_W
F32 = jnp.float32

kernel_name = 'hybrid_group_mixer_ec_moe_encoder'


def rmsnorm(x, g):
    xf = x.astype(F32)
    y = xf * lax.rsqrt(jnp.mean(xf * xf, axis=-1, keepdims=True) + NORM_EPS)
    return (y * g.astype(F32)).astype(x.dtype)


def head_rmsnorm(y, g):
    b, s, d = y.shape
    yf = y.astype(F32).reshape(b, s, d // HEAD_DIM, HEAD_DIM)
    yf = yf * lax.rsqrt(jnp.mean(yf * yf, axis=-1, keepdims=True) + NORM_EPS)
    return (yf.reshape(b, s, d) * g.astype(F32)).astype(y.dtype)


def dwconv3(x, w, b=None):
    ch = x.shape[-1]
    rhs = jnp.transpose(w)[:, None, :].astype(x.dtype)
    y = lax.conv_general_dilated(x, rhs, window_strides=(1,), padding='SAME',
                                 dimension_numbers=('NWC', 'WIO', 'NWC'),
                                 feature_group_count=ch)
    return y if b is None else y + b.astype(x.dtype)


def rope(x, pos):
    half = x.shape[-1] // 2
    inv = ROPE_THETA ** (-jnp.arange(half, dtype=F32) / half)
    ang = pos.astype(F32)[..., None] * inv
    ang = ang.reshape(ang.shape[:2] + (1,) * (x.ndim - 3) + (half,))
    cos, sin = jnp.cos(ang), jnp.sin(ang)
    xf = x.astype(F32)
    x1, x2 = xf[..., :half], xf[..., half:]
    return jnp.concatenate([x1 * cos - x2 * sin, x2 * cos + x1 * sin], axis=-1).astype(x.dtype)


def mlstm_scan(q, k, v, i_pre, f_pre):
    b, h, s, dh = q.shape
    nc = s // ML_CHUNK
    q, k, v = (t.reshape(b, h, nc, ML_CHUNK, dh) for t in (q, k, v))
    ig = i_pre.reshape(b, h, nc, ML_CHUNK)
    a = jnp.cumsum(jax.nn.log_sigmoid(f_pre).reshape(b, h, nc, ML_CHUNK), axis=-1)
    a_end = a[..., -1]
    w_st = a_end[..., None] - a + ig
    m_loc = jnp.max(w_st, axis=-1)
    e_st = jnp.exp(w_st - m_loc[..., None])
    c_loc = jnp.einsum('bhnl,bhnld,bhnle->bhnde', e_st, k, v)
    n_loc = jnp.einsum('bhnl,bhnld->bhnd', e_st, k)

    def step(carry, inp):
        c_st, n_st, m_st = carry
        cl, nl, ml, ae = inp
        m_new = jnp.maximum(ae + m_st, ml)
        sp = jnp.exp(ae + m_st - m_new)
        sl = jnp.exp(ml - m_new)
        c_new = sp[..., None, None] * c_st + sl[..., None, None] * cl
        n_new = sp[..., None] * n_st + sl[..., None] * nl
        return (c_new, n_new, m_new), (c_st, n_st, m_st)

    init = (jnp.zeros((b, h, dh, dh), q.dtype), jnp.zeros((b, h, dh), q.dtype), jnp.zeros((b, h), q.dtype))
    xs = tuple(jnp.moveaxis(t, 2, 0) for t in (c_loc, n_loc, m_loc, a_end))
    _, (c_prev, n_prev, m_prev) = lax.scan(step, init, xs)
    c_prev = jnp.moveaxis(c_prev, 0, 2)
    n_prev = jnp.moveaxis(n_prev, 0, 2)
    m_prev = jnp.moveaxis(m_prev, 0, 2)
    tri = jnp.tril(jnp.ones((ML_CHUNK, ML_CHUNK), dtype=bool))
    d_log = jnp.where(tri, a[..., :, None] - a[..., None, :] + ig[..., None, :], -jnp.inf)
    inter_log = a + m_prev[..., None]
    m_t = jnp.maximum(inter_log, jnp.max(d_log, axis=-1))
    p_intra = jnp.exp(d_log - m_t[..., None]) * jnp.einsum('bhnld,bhnsd->bhnls', q, k)
    sc_inter = jnp.exp(inter_log - m_t)
    num = (jnp.einsum('bhnls,bhnsd->bhnld', p_intra, v)
           + sc_inter[..., None] * jnp.einsum('bhnld,bhnde->bhnle', q, c_prev))
    den = jnp.sum(p_intra, axis=-1) + sc_inter * jnp.einsum('bhnld,bhnd->bhnl', q, n_prev)
    out = num / jnp.maximum(jnp.abs(den), jnp.exp(-m_t))[..., None]
    return out.reshape(b, h, s, dh)


def mlstm_mixer(q, k, v, o, g, gate_b):
    b, s, _ = q.shape
    hh = N_GROUP_HEADS
    heads = lambda t: jnp.transpose(t.astype(F32).reshape(b, s, hh, HEAD_DIM), (0, 2, 1, 3))
    qh, kh, vh = heads(q), heads(k) * (HEAD_DIM ** -0.5), heads(v)
    gates = jnp.transpose(g.astype(F32).reshape(b, s, 4, hh) + gate_b.astype(F32), (2, 0, 3, 1))
    h_fwd = mlstm_scan(qh, kh, vh, gates[0], gates[1])
    fl = lambda t: jnp.flip(t, axis=2)
    h_bwd = fl(mlstm_scan(fl(qh), fl(kh), fl(vh), jnp.flip(gates[2], -1), jnp.flip(gates[3], -1)))
    hsum = jnp.transpose(h_fwd + h_bwd, (0, 2, 1, 3)).reshape(b, s, GROUP_W)
    return (jax.nn.sigmoid(o.astype(F32)) * hsum).astype(q.dtype)


def mla_mixer(cq, ckv, kr, pos, q_norm, kv_norm, w_uq, w_uk, w_uv):
    b, s, _ = cq.shape
    hh = N_GROUP_HEADS
    q = (rmsnorm(cq, q_norm) @ w_uq).reshape(b, s, hh, MLA_NOPE + MLA_ROPE)
    c_kv = rmsnorm(ckv, kv_norm)
    k_nope = (c_kv @ w_uk).reshape(b, s, hh, MLA_NOPE)
    v = (c_kv @ w_uv).reshape(b, s, hh, MLA_V)
    q = jnp.concatenate([q[..., :MLA_NOPE], rope(q[..., MLA_NOPE:], pos)], axis=-1)
    k_rope = jnp.broadcast_to(rope(kr, pos)[:, :, None, :], (b, s, hh, MLA_ROPE))
    k = jnp.concatenate([k_nope, k_rope], axis=-1)
    scale = (MLA_NOPE + MLA_ROPE) ** -0.5
    nb = s // ATTN_Q_BLOCK
    qb = jnp.moveaxis(q.reshape(b, nb, ATTN_Q_BLOCK, hh, MLA_NOPE + MLA_ROPE), 1, 0)

    def attend(qblk):
        sc = jnp.einsum('bqhd,bkhd->bhqk', qblk, k).astype(F32) * scale
        p = jax.nn.softmax(sc, axis=-1).astype(v.dtype)
        return jnp.einsum('bhqk,bkhd->bqhd', p, v)

    out = lax.map(attend, qb)
    return jnp.moveaxis(out, 0, 1).reshape(b, s, hh * MLA_V)


def hyena_filters(length, w1, b1, fr1, w2, b2, fr2, w3, b3, log_decay):
    w1, b1, fr1, w2, b2, fr2, w3, b3, log_decay = (t.astype(F32) for t in (w1, b1, fr1, w2, b2, fr2, w3, b3, log_decay))
    t = jnp.arange(length, dtype=F32) / length
    bands = jnp.arange(1, HY_BANDS + 1, dtype=F32)
    ang = (2.0 * math.pi) * t[:, None] * bands
    z = jnp.concatenate([t[:, None], jnp.sin(ang), jnp.cos(ang)], axis=-1)
    hid = jnp.sin(fr1 * (z @ w1 + b1))
    hid = jnp.sin(fr2 * (hid @ w2 + b2))
    filt = (hid @ w3 + b3) * jnp.exp(-t[:, None] * jnp.exp(log_decay))
    filt = filt.reshape(length, HY_ORDER, 2, GROUP_W)
    filt = filt / jnp.sum(jnp.abs(filt), axis=(0, 2), keepdims=True)
    k_full = jnp.concatenate([filt[:, :, 0], filt[::-1, :, 1]], axis=0)
    return jnp.fft.rfft(k_full, axis=0)


def hyena_mixer(hy_u, conv_w, conv_b, w1, b1, fr1, w2, b2, fr2, w3, b3, log_decay, bias):
    b, length, _ = hy_u.shape
    proj = dwconv3(hy_u, conv_w, conv_b).astype(F32)
    x1, x2, z = jnp.split(proj, 3, axis=-1)
    kf = hyena_filters(length, w1, b1, fr1, w2, b2, fr2, w3, b3, log_decay)
    bias = bias.astype(F32)
    for o, gate in enumerate((x1, x2)):
        zf = jnp.fft.rfft(z, n=2 * length, axis=1)
        y = jnp.fft.irfft(zf * kf[None, :, o], n=2 * length, axis=1)[:, :length]
        z = gate * (y + z * bias[o])
    return z.astype(hy_u.dtype)


def shortconv_mixer(sc_u, w):
    bg, cg, xin = jnp.split(sc_u, 3, axis=-1)
    return bg * dwconv3(cg * xin, w)


def hybrid_mixer(h, pos, w_in, ml_gate_b, q_norm, kv_norm, w_uq, w_uk, w_uv,
                 hy_conv_w, hy_conv_b, hy_w1, hy_b1, hy_fr1, hy_w2, hy_b2, hy_fr2, hy_w3, hy_b3,
                 hy_log_decay, hy_bias, sc_conv_w, out_g, w_out):
    u = h @ w_in
    sizes = (GROUP_W, GROUP_W, GROUP_W, GROUP_W, 4 * N_GROUP_HEADS, MLA_Q_RANK, MLA_KV_RANK,
             MLA_ROPE, 3 * GROUP_W, 3 * GROUP_W)
    cuts, acc = [], 0
    for sz in sizes[:-1]:
        acc += sz
        cuts.append(acc)
    ml_q, ml_k, ml_v, ml_o, ml_g, cq, ckv, kr, hy_u, sc_u = jnp.split(u, cuts, axis=-1)
    y_a = mlstm_mixer(ml_q, ml_k, ml_v, ml_o, ml_g, ml_gate_b)
    y_b = mla_mixer(cq, ckv, kr, pos, q_norm, kv_norm, w_uq, w_uk, w_uv)
    y_c = hyena_mixer(hy_u, hy_conv_w, hy_conv_b, hy_w1, hy_b1, hy_fr1, hy_w2, hy_b2, hy_fr2,
                      hy_w3, hy_b3, hy_log_decay, hy_bias)
    y_d = shortconv_mixer(sc_u, sc_conv_w)
    y = jnp.concatenate([y_a, y_b.astype(y_a.dtype), y_c.astype(y_a.dtype), y_d.astype(y_a.dtype)], axis=-1)
    return head_rmsnorm(y, out_g) @ w_out


def ec_moe(h, router_w, w_gate, w_up, w_down):
    b, s, d = h.shape
    cap = EC_CAPACITY * s // N_EXPERTS
    aff = jax.nn.softmax(jnp.einsum('bsd,de->bse', h, router_w).astype(F32), axis=-1)
    g, idx = lax.top_k(jnp.swapaxes(aff, 1, 2), cap)
    xe = jax.vmap(lambda hb, ib: hb[ib])(h, idx)
    a = jnp.einsum('becd,edf->becf', xe, w_gate)
    up = jnp.einsum('becd,edf->becf', xe, w_up)
    ye = jnp.einsum('becf,efd->becd', jax.nn.silu(a) * up, w_down) * g.astype(h.dtype)[..., None]
    flat = (jnp.arange(b, dtype=jnp.int32)[:, None, None] * s + idx).reshape(-1)
    out = jnp.zeros((b * s, d), ye.dtype).at[flat].add(ye.reshape(-1, d))
    return out.reshape(b, s, d)


def setup_inputs(seed: int = 0) -> dict:
    key = jax.random.key(seed)
    ks = iter(jax.random.split(key, 48))
    L = DEPTH
    hh = N_GROUP_HEADS

    def nrm(shape, scale):
        return jax.random.normal(next(ks), shape, F32) * scale

    def gain(shape):
        return 1.0 + nrm(shape, 0.05)

    x = nrm((BATCH, SEQ, D_MODEL), 1.0)
    c = nrm((BATCH, D_MODEL), 1.0)
    positions = (jnp.arange(SEQ, dtype=jnp.int32)[None, :]
                 + jax.random.randint(next(ks), (BATCH, 1), 0, SEQ, dtype=jnp.int32))
    ada_w = nrm((L, D_MODEL, 6 * D_MODEL), 0.5 * D_MODEL ** -0.5)
    ada_b = nrm((L, 6 * D_MODEL), 0.02)
    mix_pre_g = gain((L, D_MODEL))
    mix_post_g = gain((L, D_MODEL))
    ffn_pre_g = gain((L, D_MODEL))
    ffn_post_g = gain((L, D_MODEL))
    w_in = nrm((L, D_MODEL, D_IN), D_MODEL ** -0.5)
    ib = nrm((L, 2, hh), 0.1)
    fb = jax.random.uniform(next(ks), (L, 2, hh), F32, 3.0, 6.0)
    ml_gate_b = jnp.stack([ib[:, 0], fb[:, 0], ib[:, 1], fb[:, 1]], axis=1)
    mla_q_norm = gain((L, MLA_Q_RANK))
    mla_kv_norm = gain((L, MLA_KV_RANK))
    mla_w_uq = nrm((L, MLA_Q_RANK, hh * (MLA_NOPE + MLA_ROPE)), MLA_Q_RANK ** -0.5)
    mla_w_uk = nrm((L, MLA_KV_RANK, hh * MLA_NOPE), MLA_KV_RANK ** -0.5)
    mla_w_uv = nrm((L, MLA_KV_RANK, hh * MLA_V), MLA_KV_RANK ** -0.5)
    hy_conv_w = nrm((L, 3 * GROUP_W, CONV_W), CONV_W ** -0.5)
    hy_conv_b = nrm((L, 3 * GROUP_W), 0.02)
    hy_w1 = nrm((L, HY_EMB, HY_FFN), HY_EMB ** -0.5)
    hy_b1 = nrm((L, HY_FFN), 0.5)
    hy_fr1 = 1.0 + nrm((L, HY_FFN), 0.1)
    hy_w2 = nrm((L, HY_FFN, HY_FFN), HY_FFN ** -0.5)
    hy_b2 = nrm((L, HY_FFN), 0.5)
    hy_fr2 = 1.0 + nrm((L, HY_FFN), 0.1)
    hy_w3 = nrm((L, HY_FFN, HY_N_FILT), HY_FFN ** -0.5)
    hy_b3 = nrm((L, HY_N_FILT), 0.02)
    hy_log_decay = jnp.log(jax.random.uniform(next(ks), (L, HY_N_FILT), F32, 3.0, 15.0))
    hy_bias = nrm((L, HY_ORDER, GROUP_W), 0.1)
    sc_conv_w = nrm((L, GROUP_W, CONV_W), CONV_W ** -0.5)
    mix_out_g = gain((L, D_MODEL))
    w_out = nrm((L, D_MODEL, D_MODEL), D_MODEL ** -0.5)
    router_w = nrm((L, D_MODEL, N_EXPERTS), D_MODEL ** -0.5)
    exp_w_gate = nrm((L, N_EXPERTS, D_MODEL, EXPERT_FF), D_MODEL ** -0.5)
    exp_w_up = nrm((L, N_EXPERTS, D_MODEL, EXPERT_FF), D_MODEL ** -0.5)
    exp_w_down = nrm((L, N_EXPERTS, EXPERT_FF, D_MODEL), EXPERT_FF ** -0.5)
    return {'x': x, 'c': c, 'positions': positions, 'ada_w': ada_w, 'ada_b': ada_b,
            'mix_pre_g': mix_pre_g, 'mix_post_g': mix_post_g, 'ffn_pre_g': ffn_pre_g,
            'ffn_post_g': ffn_post_g, 'w_in': w_in, 'ml_gate_b': ml_gate_b,
            'mla_q_norm': mla_q_norm, 'mla_kv_norm': mla_kv_norm, 'mla_w_uq': mla_w_uq,
            'mla_w_uk': mla_w_uk, 'mla_w_uv': mla_w_uv, 'hy_conv_w': hy_conv_w,
            'hy_conv_b': hy_conv_b, 'hy_w1': hy_w1, 'hy_b1': hy_b1, 'hy_fr1': hy_fr1,
            'hy_w2': hy_w2, 'hy_b2': hy_b2, 'hy_fr2': hy_fr2, 'hy_w3': hy_w3, 'hy_b3': hy_b3,
            'hy_log_decay': hy_log_decay, 'hy_bias': hy_bias, 'sc_conv_w': sc_conv_w,
            'mix_out_g': mix_out_g, 'w_out': w_out, 'router_w': router_w,
            'exp_w_gate': exp_w_gate, 'exp_w_up': exp_w_up, 'exp_w_down': exp_w_down}


def reference(x, c, positions, ada_w, ada_b, mix_pre_g, mix_post_g, ffn_pre_g, ffn_post_g,
              w_in, ml_gate_b, mla_q_norm, mla_kv_norm, mla_w_uq, mla_w_uk, mla_w_uv,
              hy_conv_w, hy_conv_b, hy_w1, hy_b1, hy_fr1, hy_w2, hy_b2, hy_fr2, hy_w3, hy_b3,
              hy_log_decay, hy_bias, sc_conv_w, mix_out_g, w_out, router_w,
              exp_w_gate, exp_w_up, exp_w_down):
    cs = jax.nn.silu(c)
    for l in range(DEPTH):
        mod = cs @ ada_w[l] + ada_b[l]
        sh1, sc1, g1, sh2, sc2, g2 = (m[:, None, :] for m in jnp.split(mod, 6, axis=-1))
        h = rmsnorm(x, mix_pre_g[l]) * (1.0 + sc1) + sh1
        y = hybrid_mixer(h, positions, w_in[l], ml_gate_b[l], mla_q_norm[l], mla_kv_norm[l],
                         mla_w_uq[l], mla_w_uk[l], mla_w_uv[l], hy_conv_w[l], hy_conv_b[l],
                         hy_w1[l], hy_b1[l], hy_fr1[l], hy_w2[l], hy_b2[l], hy_fr2[l], hy_w3[l],
                         hy_b3[l], hy_log_decay[l], hy_bias[l], sc_conv_w[l], mix_out_g[l], w_out[l])
        x = x + g1 * rmsnorm(y, mix_post_g[l])
        h = rmsnorm(x, ffn_pre_g[l]) * (1.0 + sc2) + sh2
        y = ec_moe(h, router_w[l], exp_w_gate[l], exp_w_up[l], exp_w_down[l])
        x = x + g2 * rmsnorm(y, ffn_post_g[l])
    return x
```

```cpp
#include <hip/hip_runtime.h>
#include <cstdio>
#include <cstdint>

#ifndef MK_SPLIT
#define MK_SPLIT 0
#endif

#define GAS __attribute__((address_space(1)))
#define LAS __attribute__((address_space(3)))
typedef GAS unsigned gu32;
#define RLX_AGENT __ATOMIC_RELAXED, __HIP_MEMORY_SCOPE_AGENT
typedef unsigned short bf16_t;
typedef short bf16x8 __attribute__((ext_vector_type(8)));
typedef short s16x4 __attribute__((ext_vector_type(4)));
typedef float f32x4 __attribute__((ext_vector_type(4)));
typedef float f32x2 __attribute__((ext_vector_type(2)));
typedef float f32x16 __attribute__((ext_vector_type(16)));
typedef unsigned u32x4 __attribute__((ext_vector_type(4)));
typedef unsigned u32x2 __attribute__((ext_vector_type(2)));
typedef __bf16 bf16x2_t __attribute__((ext_vector_type(2)));

namespace pg8 {
#define PG8_LAS __attribute__((address_space(3)))
constexpr int BM = 256, BK = 64, HALF = 128, HTB = HALF * BK * 2, STAGE_BYTES = 8 * HTB, NXCD = 8, WGM = 8;
__host__ __device__ __forceinline__ int lds_byte(int r, int c) { const int st = (r >> 4) * 2 + (c >> 5), rr = r & 15, cc = c & 31, ob = rr * 64 + cc * 2; return st * 1024 + (ob ^ (((ob >> 9) & 1) << 5)); }
__host__ __device__ __forceinline__ void stage_rc(int b, int& R, int& C) { const int st = b / 1024, sb = b % 1024, swz = sb ^ (((sb >> 9) & 1) << 5); R = (st >> 1) * 16 + swz / 64; C = (st & 1) * 32 + (swz % 64) / 2; }
__host__ __device__ __forceinline__ int perm32(int rho) { const int n = rho >> 4, i = rho & 15; return 8 * (i >> 2) + 4 * n + (i & 3); }
struct Unit { int pm, pn; };
struct Gemm { const bf16_t* A; const bf16_t* Bt; int M, N, K; };
struct StaticOrder {
    int nM, nN, nwg, G, c;
    __host__ __device__ void init(int M, int N, int G_, int c_) { nM = M / BM; nN = N / BM; nwg = nM * nN; G = G_; c = c_; }
    __host__ __device__ bool next(int i, Unit& u) const {
        const long L = (long)i * G + c; if (L >= nwg) return false;
        int wgid = (int)L; { const int q = nwg / NXCD, r = nwg % NXCD, xcd = wgid % NXCD, off = wgid / NXCD; wgid = (xcd < r ? xcd * (q + 1) : r * (q + 1) + (xcd - r) * q) + off; }
        const int nig = WGM * nN, gid = wgid / nig, fm = gid * WGM, gsz = (nM - fm) < WGM ? (nM - fm) : WGM;
        u.pm = fm + ((wgid % nig) % gsz); u.pn = (wgid % nig) / gsz; return true;
    }
    __device__ __forceinline__ void a_ready(const Unit&) const {}
    __device__ __forceinline__ void done(const Unit&) const {}
};
struct GroupedOrder {
    int nNl, total, G, c;
    __host__ __device__ void init(int nNl_, int G_, int c_) { nNl = nNl_; total = 16 * 8 * nNl_; G = G_; c = c_; }
    __host__ __device__ bool next(int i, Unit& u) const {
        const long L = (long)i * G + c; if (L >= total) return false;
        const int per_e = 8 * nNl, e = (int)L / per_e, r = (int)L % per_e;
        u.pm = e * 8 + (r % 8); u.pn = e * nNl + (r / 8); return true;
    }
    __device__ __forceinline__ void a_ready(const Unit&) const {}
    __device__ __forceinline__ void done(const Unit&) const {}
};
__device__ __forceinline__ unsigned cvt_pk_bf16(float lo, float hi) { f32x2 v = {lo, hi}; bf16x2_t b = __builtin_convertvector(v, bf16x2_t); return __builtin_bit_cast(unsigned, b); }

struct EpiBf16 {
    static constexpr bool PERM = true, AFTER_DRAIN = false;
    bf16_t* O; int ldc; int ntn;
    __device__ __forceinline__ void operator()(const f32x4 (&acc)[2][2][4][2], const Unit& u, int wr, int wc, int fr, int fq) const {
        const int row0 = u.pm * BM + wr * 64 + fr; const int colt = (u.pn % ntn) * BM;
        const int col0 = colt + wc * 32 + 8 * fq;
#pragma unroll
        for (int ai = 0; ai < 2; ++ai)
#pragma unroll
            for (int m = 0; m < 4; ++m) { bf16_t* rowp = O + (size_t)(row0 + ai * HALF + m * 16) * ldc + col0;
#pragma unroll
                for (int bj = 0; bj < 2; ++bj) { const f32x4 v0 = acc[ai][bj][m][0], v1 = acc[ai][bj][m][1];
                    u32x4 w; w.x = cvt_pk_bf16(v0[0], v0[1]); w.y = cvt_pk_bf16(v0[2], v0[3]); w.z = cvt_pk_bf16(v1[0], v1[1]); w.w = cvt_pk_bf16(v1[2], v1[3]);
                    *(u32x4*)(rowp + bj * HALF) = w; } }
    }
};
struct EpiF32 {
    static constexpr bool PERM = false, AFTER_DRAIN = false;
    float* O; int ldc;
    __device__ __forceinline__ void operator()(const f32x4 (&acc)[2][2][4][2], const Unit& u, int wr, int wc, int fr, int fq) const {
        const int col0 = u.pn * BM + wc * 32 + 4 * fq;
#pragma unroll
        for (int ai = 0; ai < 2; ++ai)
#pragma unroll
            for (int m = 0; m < 4; ++m) { float* rowp = O + (size_t)(u.pm * BM + ai * HALF + wr * 64 + m * 16 + fr) * ldc + col0;
#pragma unroll
                for (int bj = 0; bj < 2; ++bj)
#pragma unroll
                    for (int n = 0; n < 2; ++n) *(f32x4*)(rowp + bj * HALF + n * 16) = acc[ai][bj][m][n]; }
    }
};
__device__ __forceinline__ float silu_f(float a) { return a * __builtin_amdgcn_rcpf(1.0f + __builtin_amdgcn_exp2f(-1.4426950408889634f * a)); }
struct EpiSwiGLU {
    static constexpr bool PERM = true, AFTER_DRAIN = false;
    bf16_t* O; int ldc;
    __device__ __forceinline__ void operator()(const f32x4 (&acc)[2][2][4][2], const Unit& u, int wr, int wc, int fr, int fq) const {
        const int row0 = u.pm * BM + wr * 64 + fr; const int col0 = (u.pn % 16) * HALF + wc * 32 + 8 * fq;
#pragma unroll
        for (int ai = 0; ai < 2; ++ai)
#pragma unroll
            for (int m = 0; m < 4; ++m) { bf16_t* rowp = O + (size_t)(row0 + ai * HALF + m * 16) * ldc + col0;
                const f32x4 g0 = acc[ai][0][m][0], g1 = acc[ai][0][m][1], u0 = acc[ai][1][m][0], u1 = acc[ai][1][m][1];
                u32x4 w;
                w.x = cvt_pk_bf16(silu_f(g0[0]) * u0[0], silu_f(g0[1]) * u0[1]); w.y = cvt_pk_bf16(silu_f(g0[2]) * u0[2], silu_f(g0[3]) * u0[3]);
                w.z = cvt_pk_bf16(silu_f(g1[0]) * u1[0], silu_f(g1[1]) * u1[1]); w.w = cvt_pk_bf16(silu_f(g1[2]) * u1[2], silu_f(g1[3]) * u1[3]);
                *(u32x4*)rowp = w; }
    }
};

template <class Epi, class Sched, bool ALIGN_EPI = false, bool SP2 = false>
__device__ __forceinline__ void gemm_phase(PG8_LAS unsigned char* lds, const Gemm g, const Sched& S, const Epi& E, const int tid) {
    const int wid = __builtin_amdgcn_readfirstlane(tid >> 6), lane = tid & 63, wr = wid >> 2, wc = wid & 3, fr = lane & 15, fq = lane >> 4;
    int K_ = g.K; asm volatile("" : "+s"(K_));
    const int K = K_, nt = K / BK;
    unsigned voffA[2], voffB[2];
#pragma unroll
    for (int i = 0; i < 2; ++i) { int R, C; stage_rc(tid * 16 + i * 8192, R, C); const int Rb = Epi::PERM ? ((R & ~31) + perm32(R & 31)) : R;
        voffA[i] = (unsigned)(R * K + C) * 2u; voffB[i] = (unsigned)(Rb * K + C) * 2u; }
    const size_t kstep = (size_t)(BK * 2);
    const size_t hstep = (size_t)HALF * K * 2;
    const size_t tstep = 2 * hstep;
    const unsigned ldsw = (unsigned)wid * 1024u;
    const int aoff = lds_byte(wr * 64 + fr, fq * 8), boff = lds_byte(wc * 32 + fr, fq * 8);
#define PG8_SA(b, h) (((b) * 2 + (h)) * HTB)
#define PG8_SB(b, h) ((4 + (b) * 2 + (h)) * HTB)
#define PG8_STAGE(bufoff, gbase, voff) do { _Pragma("unroll") for (int _i = 0; _i < 2; ++_i) \
        __builtin_amdgcn_global_load_lds((const unsigned*)((const char*)(gbase) + (voff)[_i]), (PG8_LAS unsigned*)(lds + (bufoff) + ldsw + _i * 8192), 16, 0, 0); } while (0)
#define PG8_LDA(dst, b, h) do { _Pragma("unroll") for (int m = 0; m < 4; ++m) _Pragma("unroll") for (int k = 0; k < 2; ++k) dst[m][k] = *(const PG8_LAS bf16x8*)(lds + PG8_SA(b, h) + aoff + m * 2048 + k * 1024); } while (0)
#define PG8_LDB(dst, b, h) do { _Pragma("unroll") for (int n = 0; n < 2; ++n) _Pragma("unroll") for (int k = 0; k < 2; ++k) dst[n][k] = *(const PG8_LAS bf16x8*)(lds + PG8_SB(b, h) + boff + n * 2048 + k * 1024); } while (0)
#define PG8_MMA(ai, bj, At, Bt) do { __builtin_amdgcn_s_setprio(1); _Pragma("unroll") for (int m = 0; m < 4; ++m) _Pragma("unroll") for (int n = 0; n < 2; ++n) _Pragma("unroll") for (int k = 0; k < 2; ++k) \
        acc[ai][bj][m][n] = __builtin_amdgcn_mfma_f32_16x16x32_bf16(Bt[n][k], At[m][k], acc[ai][bj][m][n], 0, 0, 0); __builtin_amdgcn_s_setprio(0); } while (0)
#define PG8_WAIT_V(n) asm volatile("s_waitcnt vmcnt(" #n ")" ::: "memory")
#define PG8_WAIT_L(n) asm volatile("s_waitcnt lgkmcnt(" #n ")" ::: "memory")
#define PG8_BAR __builtin_amdgcn_s_barrier()
#define PG8_SCHED __builtin_amdgcn_sched_barrier(0)
    Unit cur, nxt; int ui = 0;
    if (!S.next(0, cur)) return;
    f32x4 acc[2][2][4][2];
#pragma unroll
    for (int a = 0; a < 2; ++a)
#pragma unroll
        for (int b = 0; b < 2; ++b)
#pragma unroll
            for (int m = 0; m < 4; ++m)
#pragma unroll
                for (int n = 0; n < 2; ++n) acc[a][b][m][n] = (f32x4){0.f, 0.f, 0.f, 0.f};
    bf16x8 At[4][2], B0[2][2], B1[2][2];
    const char* cA = (const char*)g.A + (size_t)cur.pm * tstep; const char* cB = (const char*)g.Bt + (size_t)cur.pn * tstep;
    S.a_ready(cur);
    if constexpr (SP2) {
        PG8_STAGE(PG8_SB(0, 0), cB, voffB); PG8_STAGE(PG8_SB(0, 1), cB + hstep, voffB); PG8_STAGE(PG8_SA(0, 0), cA, voffA); PG8_STAGE(PG8_SA(0, 1), cA + hstep, voffA);
        if (wr == 1) PG8_BAR;
        PG8_WAIT_V(2); PG8_BAR;
        PG8_STAGE(PG8_SB(1, 0), cB + kstep, voffB); PG8_STAGE(PG8_SA(1, 0), cA + kstep, voffA); PG8_STAGE(PG8_SB(1, 1), cB + hstep + kstep, voffB);
        PG8_WAIT_V(6); PG8_BAR;
    } else {
        PG8_STAGE(PG8_SB(0, 0), cB, voffB); PG8_STAGE(PG8_SA(0, 0), cA, voffA); PG8_STAGE(PG8_SB(0, 1), cB + hstep, voffB); PG8_STAGE(PG8_SA(0, 1), cA + hstep, voffA);
        if (wr == 1) PG8_BAR;
        PG8_WAIT_V(4); PG8_BAR;
        PG8_STAGE(PG8_SB(1, 0), cB + kstep, voffB); PG8_STAGE(PG8_SA(1, 0), cA + kstep, voffA); PG8_STAGE(PG8_SB(1, 1), cB + hstep + kstep, voffB);
        PG8_WAIT_V(6); PG8_BAR;
    }
    for (;;) {
        const bool has_next = S.next(ui + 1, nxt);
        const char* nA = has_next ? (const char*)g.A + (size_t)nxt.pm * tstep : cA; const char* nB = has_next ? (const char*)g.Bt + (size_t)nxt.pn * tstep : cB;
        for (int t = 0; t < nt; t += 2) {
            const bool last = (t == nt - 2);
            const char* a1 = cA + (size_t)(t + 1) * kstep;
            const char* a2 = last ? nA : cA + (size_t)(t + 2) * kstep; const char* b2 = last ? nB : cB + (size_t)(t + 2) * kstep;
            const char* a3 = a2 + kstep; const char* b3 = b2 + kstep;
            if (last && has_next) S.a_ready(nxt);
            if constexpr (SP2) {
            PG8_LDB(B0, 0, 0); PG8_LDB(B1, 0, 1); PG8_SCHED; PG8_LDA(At, 0, 0); PG8_STAGE(PG8_SA(1, 1), a1 + hstep, voffA);
            PG8_WAIT_V(8); PG8_WAIT_L(0); PG8_BAR; PG8_MMA(0, 0, At, B0); PG8_MMA(0, 1, At, B1); PG8_BAR; PG8_SCHED;
            PG8_LDA(At, 0, 1); PG8_STAGE(PG8_SB(0, 0), b2, voffB); PG8_STAGE(PG8_SB(0, 1), b2 + hstep, voffB); PG8_STAGE(PG8_SA(0, 0), a2, voffA);
            PG8_WAIT_V(8); PG8_WAIT_L(0); PG8_BAR; PG8_MMA(1, 0, At, B0); PG8_MMA(1, 1, At, B1); PG8_BAR; PG8_SCHED;
            PG8_LDB(B0, 1, 0); PG8_LDB(B1, 1, 1); PG8_SCHED; PG8_LDA(At, 1, 0); PG8_STAGE(PG8_SA(0, 1), a2 + hstep, voffA);
            PG8_WAIT_V(8); PG8_WAIT_L(0); PG8_BAR; PG8_MMA(0, 0, At, B0); PG8_MMA(0, 1, At, B1); PG8_BAR; PG8_SCHED;
            PG8_LDA(At, 1, 1); PG8_STAGE(PG8_SB(1, 0), b3, voffB); PG8_STAGE(PG8_SB(1, 1), b3 + hstep, voffB); PG8_STAGE(PG8_SA(1, 0), a3, voffA);
            PG8_WAIT_V(8); PG8_WAIT_L(0); PG8_BAR; PG8_MMA(1, 0, At, B0); PG8_MMA(1, 1, At, B1); PG8_BAR; PG8_SCHED;
            } else {
            PG8_LDB(B0, 0, 0); PG8_SCHED; PG8_LDA(At, 0, 0); PG8_STAGE(PG8_SA(1, 1), a1 + hstep, voffA);
            PG8_WAIT_L(8); PG8_BAR; PG8_WAIT_L(0); PG8_MMA(0, 0, At, B0); PG8_BAR; PG8_SCHED;
            PG8_LDB(B1, 0, 1); PG8_STAGE(PG8_SB(0, 0), b2, voffB);
            PG8_BAR; PG8_WAIT_L(0); PG8_MMA(0, 1, At, B1); PG8_BAR;
            PG8_LDA(At, 0, 1); PG8_STAGE(PG8_SA(0, 0), a2, voffA);
            PG8_BAR; PG8_WAIT_L(0); PG8_MMA(1, 0, At, B0); PG8_BAR; PG8_SCHED;
            PG8_STAGE(PG8_SB(0, 1), b2 + hstep, voffB);
            PG8_WAIT_V(6); PG8_BAR; PG8_MMA(1, 1, At, B1); PG8_BAR;
            PG8_LDB(B0, 1, 0); PG8_SCHED; PG8_LDA(At, 1, 0); PG8_STAGE(PG8_SA(0, 1), a2 + hstep, voffA);
            PG8_WAIT_L(8); PG8_BAR; PG8_WAIT_L(0); PG8_MMA(0, 0, At, B0); PG8_BAR; PG8_SCHED;
            PG8_LDB(B1, 1, 1); PG8_STAGE(PG8_SB(1, 0), b3, voffB);
            PG8_BAR; PG8_WAIT_L(0); PG8_MMA(0, 1, At, B1); PG8_BAR;
            PG8_LDA(At, 1, 1); PG8_STAGE(PG8_SA(1, 0), a3, voffA);
            PG8_BAR; PG8_WAIT_L(0); PG8_MMA(1, 0, At, B0); PG8_BAR; PG8_SCHED;
            PG8_STAGE(PG8_SB(1, 1), b3 + hstep, voffB);
            PG8_WAIT_V(6); PG8_BAR; PG8_MMA(1, 1, At, B1); PG8_BAR;
            }
        }
        if constexpr (ALIGN_EPI) { if (wr == 0) PG8_BAR; }
        if constexpr (!Epi::AFTER_DRAIN) { E(acc, cur, wr, wc, fr, fq); S.done(cur); }
        if (!has_next) break;
#pragma unroll
        for (int a = 0; a < 2; ++a)
#pragma unroll
            for (int b = 0; b < 2; ++b)
#pragma unroll
                for (int m = 0; m < 4; ++m)
#pragma unroll
                    for (int n = 0; n < 2; ++n) acc[a][b][m][n] = (f32x4){0.f, 0.f, 0.f, 0.f};
        cur = nxt; cA = nA; cB = nB; ++ui;
        if constexpr (ALIGN_EPI) { if (wr == 1) PG8_BAR; }
    }
    PG8_WAIT_V(0);
    if constexpr (!ALIGN_EPI) { if (wr == 0) PG8_BAR; }
    PG8_BAR;
#undef PG8_SA
#undef PG8_SB
#undef PG8_STAGE
#undef PG8_LDA
#undef PG8_LDB
#undef PG8_MMA
#undef PG8_WAIT_V
#undef PG8_WAIT_L
#undef PG8_BAR
#undef PG8_SCHED
}
}

constexpr int NWAVES = 8, NTHR = 512;
constexpr int BATCH = 2, SEQ = 8192, DM = 1024, MTOK = BATCH * SEQ;
constexpr int DIN = 2960, DINP = 3072;
constexpr int NEXP = 16, CAP = 1024, EFF = 2048;
constexpr float EPS = 1e-6f;
constexpr int U_MLQ = 0, U_MLK = 256, U_MLV = 512, U_MLO = 768, U_MLG = 1024, U_CQ = 1040, U_CKV = 1264, U_KR = 1392, U_HY = 1424, U_SC = 2192;
constexpr float LOG2E = 1.4426950408889634f;

constexpr size_t MiB = 1u << 20;
constexpr size_t WS_CTL = 0, CTL_ZERO_BYTES = 1 * MiB;
constexpr size_t WS_MOD = 1 * MiB;
constexpr size_t WS_MLS = 1 * MiB + 128 * 1024;
constexpr size_t WS_MLN = 1 * MiB + 256 * 1024;
constexpr size_t WS_AFF = 2 * MiB;
constexpr size_t WS_SLOT = 3 * MiB;
constexpr size_t WS_IDX = 4 * MiB;
constexpr size_t WS_HID = 5 * MiB;
constexpr size_t WS_WMLA = 9 * MiB;
constexpr size_t WS_WOUT = 11 * MiB;
constexpr size_t WS_WIN = 15 * MiB;
constexpr size_t WS_WGU = 28 * MiB;
constexpr size_t WS_WDN = 284 * MiB;
constexpr size_t WS_XN = 412 * MiB;
constexpr size_t WS_AMLA = 444 * MiB;
constexpr size_t WS_Q = 456 * MiB;
constexpr size_t WS_KIMG = 468 * MiB;
constexpr size_t WS_VIMG = 480 * MiB;
constexpr size_t WS_MLC = 488 * MiB;
constexpr size_t WS_HF = 504 * MiB;
constexpr size_t WS_HB = 520 * MiB;
constexpr size_t WS_YMIX = 536 * MiB;
constexpr size_t WS_YN = 552 * MiB;
constexpr size_t WS_X1 = 584 * MiB;
constexpr size_t WS_U = 648 * MiB;
constexpr size_t WS_OMLA = 744 * MiB;
constexpr size_t WS_ACT = 648 * MiB;
constexpr size_t WS_KF = 776 * MiB;
constexpr size_t WS_Y2 = 776 * MiB;
constexpr size_t WS_XE = 776 * MiB;
constexpr size_t WS_YE = 840 * MiB;
constexpr size_t WS_END = 904 * MiB;
constexpr int CW_BAR = 4096;

constexpr int RING_BYTES = 131072;
constexpr int LDSCTL_OFF = RING_BYTES, MISC_OFF = LDSCTL_OFF + 320;
constexpr int XTRA_OFF = RING_BYTES + 1024;
constexpr int LDS_BYTES = 147456;

__device__ __forceinline__ float bf2f(unsigned short u) { return __uint_as_float((unsigned)u << 16); }
__device__ __forceinline__ unsigned pk2(float lo, float hi) { f32x2 v = {lo, hi}; bf16x2_t b = __builtin_convertvector(v, bf16x2_t); return __builtin_bit_cast(unsigned, b); }
__device__ __forceinline__ float bflo(unsigned w) { return __uint_as_float(w << 16); }
__device__ __forceinline__ float bfhi(unsigned w) { return __uint_as_float(w & 0xffff0000u); }
__device__ __forceinline__ float wave_sum(float v) {
#pragma unroll
    for (int o = 1; o < 64; o <<= 1) v += __shfl_xor(v, o);
    return v;
}
__device__ __forceinline__ float fexp(float x) { return __builtin_amdgcn_exp2f(x * LOG2E); }
__device__ __forceinline__ float flog(float x) { return __builtin_amdgcn_logf(x) * 0.6931471805599453f; }
__device__ __forceinline__ float sin_rev(float r) { return __builtin_amdgcn_sinf(r); }
__device__ __forceinline__ float cos_rev(float r) { return __builtin_amdgcn_cosf(r); }
__device__ __forceinline__ float sin_rad(float x) { float r = x * 0.15915494309189535f; r = r - __builtin_rintf(r); return __builtin_amdgcn_sinf(r); }
__device__ __forceinline__ int crow(int r, int hi) { return (r & 3) + 8 * (r >> 2) + 4 * hi; }
#define LDS_WAIT() asm volatile("s_waitcnt lgkmcnt(0)" ::: "memory")
#define VM_WAIT() asm volatile("s_waitcnt vmcnt(0)" ::: "memory")

#define XB_TMO      128
#define XB_XCNT(j)  (256  + 64 * (j))
#define XB_XSUB(j)  (1280 + 64 * (j))
#define XB_XGEN(j)  (2304 + 64 * (j))
#define XB_TOP      3328
#define XB_TOPGEN   3392
#define XCD_BAR_WORDS 3456
#define XB_SPIN_CAP (1u << 18)
__device__ __forceinline__ unsigned xb_ld(unsigned* p)              { return __hip_atomic_load(p, __ATOMIC_RELAXED, __HIP_MEMORY_SCOPE_AGENT); }
__device__ __forceinline__ unsigned xb_add(unsigned* p, unsigned v) { return __hip_atomic_fetch_add(p, v, __ATOMIC_RELAXED, __HIP_MEMORY_SCOPE_AGENT); }
__device__ __forceinline__ unsigned xb_xcc_id() { return (unsigned)__builtin_amdgcn_s_getreg((3 << 11) | 20) & 0xFu; }
#define XB_SPIN(cond, bar) do { unsigned _sp = 0; while (cond) { __builtin_amdgcn_s_sleep(1); \
    if ((++_sp & 255u) == 0u) { if (xb_ld(&(bar)[XB_TMO])) break; if (_sp > XB_SPIN_CAP) { atomicAdd(&(bar)[XB_TMO], 1u); break; } } } } while (0)
struct XcdBarrier { unsigned* bar; unsigned x; volatile LAS unsigned* st; };
__device__ __forceinline__ XcdBarrier xcd_barrier_post(unsigned* bar, volatile LAS unsigned* st) {
    XcdBarrier b; b.bar = bar; b.x = xb_xcc_id(); b.st = st;
    if (threadIdx.x == 0) (void)xb_add(&bar[XB_XCNT(b.x)], 1u);
    return b;
}
__device__ __forceinline__ void xcd_barrier_complete(unsigned* bar, unsigned x, unsigned& nloc, unsigned& nx) {
    const unsigned G = gridDim.x * gridDim.y * gridDim.z;
    unsigned sum, cnt, mine, sp = 0u;
    for (;;) {
        sum = 0u; cnt = 0u; mine = 0u;
#pragma unroll
        for (unsigned j = 0; j < 16; ++j) { const unsigned c = xb_ld(&bar[XB_XCNT(j)]); sum += c; cnt += (c > 0u) ? 1u : 0u; mine = (j == x) ? c : mine; }
        if (sum == G) break;
        __builtin_amdgcn_s_sleep(1);
        if ((++sp & 255u) == 0u) { if (xb_ld(&bar[XB_TMO])) break; if (sp > XB_SPIN_CAP) { atomicAdd(&bar[XB_TMO], 1u); break; } }
    }
    nloc = mine > 0u ? mine : 1u; nx = cnt > 0u ? cnt : 1u;
}
__device__ __forceinline__ void xcd_barrier(const XcdBarrier& b) {
    asm volatile("s_waitcnt vmcnt(0)" ::: "memory");
    __syncthreads();
    if (threadIdx.x == 0) {
        unsigned* bar = b.bar;
        __builtin_amdgcn_s_waitcnt(0);
        unsigned nloc = b.st[0], nx = b.st[1];
        if (nloc == 0u) { xcd_barrier_complete(bar, b.x, nloc, nx); b.st[0] = nloc; b.st[1] = nx; }
        const unsigned old = xb_add(&bar[XB_XSUB(b.x)], 1u);
        const unsigned gen = old / nloc;
        if (old + 1u == (gen + 1u) * nloc) {
            __builtin_amdgcn_fence(__ATOMIC_RELEASE, "agent");
            asm volatile("s_waitcnt vmcnt(0)" ::: "memory");
            const unsigned og = xb_add(&bar[XB_TOP], 1u);
            const unsigned tg = og / nx;
            if (og + 1u == (tg + 1u) * nx) xb_add(&bar[XB_TOPGEN], 1u);
            else XB_SPIN(xb_ld(&bar[XB_TOPGEN]) == tg, bar);
            __builtin_amdgcn_fence(__ATOMIC_ACQUIRE, "agent");
            xb_add(&bar[XB_XGEN(b.x)], 1u);
            asm volatile("s_waitcnt vmcnt(0)" ::: "memory");
        } else {
            XB_SPIN(xb_ld(&bar[XB_XGEN(b.x)]) == gen, bar);
            __builtin_amdgcn_fence(__ATOMIC_ACQUIRE, "agent");
            asm volatile("s_waitcnt vmcnt(0)" ::: "memory");
        }
    }
    __syncthreads();
}

struct Args { const void* in[35]; float* out; unsigned char* ws; int ph_lo, ph_hi; };
struct Frame {
    LAS unsigned char* lds;
    int tid, lane, wave, vcu, G;
    const Args* a;
    unsigned char* ws;
};
#define INF(i) ((const float*)F.a->in[i])
#define WSP(T, off) ((T*)(F.ws + (off)))

__device__ __forceinline__ void tr_item(const float* W, int ldw, int Kvalid, int Nvalid, int k0, int n0, bf16_t* dst, int dpitch, int drow0, int dk0, LAS float* scr, int lane) {
    const int nn = n0 + (lane & 31);
#pragma unroll 8
    for (int i = 0; i < 32; ++i) { const int kk = 2 * i + (lane >> 5); float v = 0.f;
        if (W != nullptr && (k0 + kk) < Kvalid && nn < Nvalid) v = W[(size_t)(k0 + kk) * ldw + nn];
        scr[kk * 33 + (lane & 31)] = v; }
    LDS_WAIT(); asm volatile("" ::: "memory");
    const int c = lane & 7;
#pragma unroll
    for (int j = 0; j < 4; ++j) { const int n = (lane >> 3) + 8 * j; const LAS float* s = scr + (8 * c) * 33 + n;
        u32x4 o; o.x = pk2(s[0 * 33], s[1 * 33]); o.y = pk2(s[2 * 33], s[3 * 33]); o.z = pk2(s[4 * 33], s[5 * 33]); o.w = pk2(s[6 * 33], s[7 * 33]);
        *(GAS u32x4*)(dst + (size_t)(drow0 + n) * dpitch + dk0 + k0 + 8 * c) = o; }
    LDS_WAIT(); asm volatile("" ::: "memory");
}

__device__ __forceinline__ void p0_phase(Frame& F) {
    const int tid = F.tid, lane = F.lane, wave = F.wave;
    {
        LAS float* cs = (LAS float*)(F.lds);
        LAS float* red = (LAS float*)(F.lds + 8192);
        const float* c = INF(1);
        for (int i = tid; i < 2048; i += NTHR) { const float v = c[i]; cs[i] = v / (1.0f + fexp(-v)); }
        __syncthreads();
        for (int cb = blockIdx.x; cb < 256; cb += F.G) {
            const int j = tid % 48, kg = tid / 48;
            const int col = cb * 48 + j, l = col / 6144, n = col % 6144;
            if (kg < 10) {
                const float* w = INF(3) + (size_t)l * 1024 * 6144 + n;
                float a0 = 0.f, a1 = 0.f;
#pragma unroll 4
                for (int k = kg; k < 1024; k += 10) { const float wv = w[(size_t)k * 6144]; a0 += cs[k] * wv; a1 += cs[1024 + k] * wv; }
                red[(kg * 48 + j) * 2] = a0; red[(kg * 48 + j) * 2 + 1] = a1;
            }
            __syncthreads();
            if (tid < 96) { const int jj = tid >> 1, b = tid & 1; float s = 0.f;
                for (int g = 0; g < 10; ++g) s += red[(g * 48 + jj) * 2 + b];
                const int col2 = cb * 48 + jj, l2 = col2 / 6144, n2 = col2 % 6144;
                WSP(float, WS_MOD)[(l2 * 2 + b) * 6144 + n2] = s + INF(4)[l2 * 6144 + n2]; }
            __syncthreads();
        }
    }
    {
        const int gw = F.vcu * NWAVES + wave, NGW = F.G * NWAVES;
        for (int l = 0; l < 2; ++l) {
            const float* w1 = INF(18) + l * 17 * 64; const float* w2 = INF(21) + l * 64 * 64;
            float w1c[17], w2c[64];
#pragma unroll
            for (int i = 0; i < 17; ++i) w1c[i] = w1[i * 64 + lane];
#pragma unroll
            for (int k = 0; k < 64; ++k) w2c[k] = w2[k * 64 + lane];
            const float b1 = INF(19)[l * 64 + lane], fr1 = INF(20)[l * 64 + lane], b2 = INF(22)[l * 64 + lane], fr2 = INF(23)[l * 64 + lane];
            for (int t = gw; t < SEQ; t += NGW) {
                const float tt = (float)t * (1.0f / SEQ);
                float a = b1 + tt * w1c[0];
#pragma unroll
                for (int bnd = 1; bnd <= 8; ++bnd) { float r = (float)((t * bnd) & (SEQ - 1)) * (1.0f / SEQ); a += sin_rev(r) * w1c[bnd] + cos_rev(r) * w1c[8 + bnd]; }
                const float h1 = sin_rad(fr1 * a);
                float a2 = b2;
#pragma unroll
                for (int k = 0; k < 64; ++k) a2 += __shfl(h1, k) * w2c[k];
                WSP(float, WS_HID)[((size_t)l * SEQ + t) * 64 + lane] = sin_rad(fr2 * a2);
            }
        }
    }
    {
        LAS float* scr = (LAS float*)(F.lds + wave * 16384);
        const int gw = F.vcu * NWAVES + wave, NGW = F.G * NWAVES;
        constexpr int I_WIN = 16 * 96, I_WOUT = 16 * 32, I_WMLA = 6 * 32, I_GU = 16 * 2 * 16 * 64, I_DN = 16 * 32 * 32;
        constexpr int I_LAYER = I_WIN + I_WOUT + I_WMLA + I_GU + I_DN;
        for (int it = gw; it < 2 * I_LAYER; it += NGW) {
            const int l = it / I_LAYER; int r = it % I_LAYER;
            if (r < I_WIN) { const int kb = r / 96, nb = r % 96;
                tr_item(INF(9) + (size_t)l * 1024 * DIN, DIN, 1024, DIN, kb * 64, nb * 32, WSP(bf16_t, WS_WIN) + (size_t)l * DINP * 1024, 1024, nb * 32, 0, scr, lane); continue; }
            r -= I_WIN;
            if (r < I_WOUT) { const int kb = r / 32, nb = r % 32;
                tr_item(INF(30) + (size_t)l * 1024 * 1024, 1024, 1024, 1024, kb * 64, nb * 32, WSP(bf16_t, WS_WOUT) + (size_t)l * 1024 * 1024, 1024, nb * 32, 0, scr, lane); continue; }
            r -= I_WOUT;
            if (r < I_WMLA) { const int kb = r / 32, nb = r % 32;
                bf16_t* dst = WSP(bf16_t, WS_WMLA) + (size_t)l * 1024 * 384;
                const float* W = nullptr; int ldw = 1, Kv = 0, Nv = 0, ksrc = 0, nsrc = 0;
                if (nb < 12 && kb < 4) { W = INF(13) + (size_t)l * 224 * 384; ldw = 384; Kv = 224; Nv = 384; ksrc = kb * 64; nsrc = nb * 32; }
                else if (nb >= 12 && nb < 20 && kb >= 4) { W = INF(14) + (size_t)l * 128 * 256; ldw = 256; Kv = 128; Nv = 256; ksrc = (kb - 4) * 64; nsrc = (nb - 12) * 32; }
                else if (nb >= 20 && nb < 28 && kb >= 4) { W = INF(15) + (size_t)l * 128 * 256; ldw = 256; Kv = 128; Nv = 256; ksrc = (kb - 4) * 64; nsrc = (nb - 20) * 32; }
                tr_item(W, ldw, Kv, Nv, ksrc, nsrc, dst, 384, nb * 32, kb * 64 - ksrc, scr, lane); continue; }
            r -= I_WMLA;
            if (r < I_GU) { const int e = r / (2 * 16 * 64); int q = r % (2 * 16 * 64); const int which = q / (16 * 64); q %= (16 * 64); const int kb = q / 64, nb = q % 64;
                const float* W = INF(which ? 33 : 32) + ((size_t)l * NEXP + e) * 1024 * 2048;
                const int n0 = nb * 32, drow = (n0 >> 7) * 256 + (n0 & 127) + (which ? 128 : 0);
                tr_item(W, 2048, 1024, 2048, kb * 64, n0, WSP(bf16_t, WS_WGU) + ((size_t)l * NEXP + e) * 4096 * 1024, 1024, drow, 0, scr, lane); continue; }
            r -= I_GU;
            { const int e = r / (32 * 32); const int q = r % (32 * 32); const int kb = q / 32, nb = q % 32;
                const float* W = INF(34) + ((size_t)l * NEXP + e) * 2048 * 1024;
                tr_item(W, 1024, 2048, 1024, kb * 64, nb * 32, WSP(bf16_t, WS_WDN) + ((size_t)l * NEXP + e) * 1024 * 2048, 2048, nb * 32, 0, scr, lane); }
        }
    }
}

__device__ __forceinline__ void ld_row_f32(const float* p, int lane, f32x4 (&v)[4]) {
    const GAS f32x4* r = (const GAS f32x4*)p + lane;
#pragma unroll
    for (int j = 0; j < 4; ++j) v[j] = r[64 * j];
}
__device__ __forceinline__ void st_row_f32(float* p, int lane, const f32x4 (&v)[4]) {
    GAS f32x4* r = (GAS f32x4*)p + lane;
#pragma unroll
    for (int j = 0; j < 4; ++j) r[64 * j] = v[j];
}
__device__ __forceinline__ void st_row_bf16(bf16_t* p, int lane, const f32x4 (&v)[4]) {
    GAS u32x2* r = (GAS u32x2*)p + lane;
#pragma unroll
    for (int j = 0; j < 4; ++j) { u32x2 w; w.x = pk2(v[j].x, v[j].y); w.y = pk2(v[j].z, v[j].w); r[64 * j] = w; }
}
__device__ __forceinline__ float row_ss(const f32x4 (&v)[4]) {
    float s = 0.f;
#pragma unroll
    for (int j = 0; j < 4; ++j) s += (v[j].x * v[j].x + v[j].y * v[j].y) + (v[j].z * v[j].z + v[j].w * v[j].w);
    return wave_sum(s);
}
__device__ __forceinline__ void modnorm(const f32x4 (&x)[4], const float* g, const float* sc, const float* sh, int lane, f32x4 (&h)[4]) {
    const float rstd = __builtin_amdgcn_rsqf(row_ss(x) * (1.0f / DM) + EPS);
    f32x4 gv[4], scv[4], shv[4];
    ld_row_f32(g, lane, gv); ld_row_f32(sc, lane, scv); ld_row_f32(sh, lane, shv);
#pragma unroll
    for (int j = 0; j < 4; ++j) h[j] = (x[j] * rstd) * gv[j] * (scv[j] + 1.0f) + shv[j];
}

__device__ __forceinline__ void p1_phase(Frame& F) {
    const int gw = F.vcu * NWAVES + F.wave, NGW = F.G * NWAVES;
    const float* mod = WSP(float, WS_MOD);
    for (int m = gw; m < MTOK; m += NGW) {
        const int b = m >> 13; f32x4 x[4], h[4];
        ld_row_f32(INF(0) + (size_t)m * DM, F.lane, x);
        modnorm(x, INF(5), mod + (0 * 2 + b) * 6144 + 1024, mod + (0 * 2 + b) * 6144, F.lane, h);
        st_row_bf16(WSP(bf16_t, WS_XN) + (size_t)m * DM, F.lane, h);
    }
}

__device__ __forceinline__ float logsigmoid(float x) { return fminf(x, 0.f) - flog(1.0f + fexp(-fabsf(x))); }
struct MlItem { int b, h, dir, n, t0; };
__device__ __forceinline__ MlItem ml_decode(int item) { MlItem I; I.b = item >> 9; I.h = (item >> 7) & 3; I.dir = (item >> 6) & 1; I.n = item & 63;
    I.t0 = I.b * SEQ + (I.dir ? SEQ - 128 * (I.n + 1) : 128 * I.n); return I; }

__device__ __forceinline__ void ml_local_item(Frame& F, int item, int l) {
    const int tid = F.tid; const MlItem I = ml_decode(item);
    const bf16_t* U = WSP(bf16_t, WS_U);
    LAS float* EK = (LAS float*)(F.lds);
    LAS float* VV = (LAS float*)(F.lds + 32768);
    LAS float* LF = (LAS float*)(F.lds + 65536);
    LAS float* IG = LF + 128; LAS float* WW = LF + 256; LAS float* EST = LF + 384;
    const float* gb = INF(10) + l * 16;
    if (tid < 128) { const int j = tid, r = I.dir ? 127 - j : j; const size_t t = (size_t)(I.t0 + r);
        const float ipre = bf2f(U[t * DINP + U_MLG + (I.dir ? 2 : 0) * 4 + I.h]) + gb[(I.dir ? 2 : 0) * 4 + I.h];
        const float fpre = bf2f(U[t * DINP + U_MLG + (I.dir ? 3 : 1) * 4 + I.h]) + gb[(I.dir ? 3 : 1) * 4 + I.h];
        LF[j] = logsigmoid(fpre); IG[j] = ipre; }
    __syncthreads();
    float a = 0.f, aend = 0.f;
    if (tid < 128) { for (int i = 0; i < 128; ++i) { const float v = LF[i]; aend += v; if (i <= tid) a += v; }
        WW[tid] = aend - a + IG[tid]; }
    __syncthreads();
    float mloc = -3.0e38f;
    if (tid < 128) { for (int i = 0; i < 128; ++i) mloc = fmaxf(mloc, WW[i]);
        const int r = I.dir ? 127 - tid : tid; EST[r] = fexp(WW[tid] - mloc); }
    __syncthreads();
#pragma unroll
    for (int i = 0; i < 2; ++i) { const int p = tid + 512 * i, row = p >> 3, c8 = p & 7;
        const u32x4 kq = *(const GAS u32x4*)(U + (size_t)(I.t0 + row) * DINP + U_MLK + I.h * 64 + c8 * 8);
        const u32x4 vq = *(const GAS u32x4*)(U + (size_t)(I.t0 + row) * DINP + U_MLV + I.h * 64 + c8 * 8);
        const float es = EST[row] * 0.125f;
        LAS f32x4* ek = (LAS f32x4*)(EK + row * 64 + c8 * 8); LAS f32x4* vv = (LAS f32x4*)(VV + row * 64 + c8 * 8);
        ek[0] = (f32x4){bflo(kq.x) * es, bfhi(kq.x) * es, bflo(kq.y) * es, bfhi(kq.y) * es};
        ek[1] = (f32x4){bflo(kq.z) * es, bfhi(kq.z) * es, bflo(kq.w) * es, bfhi(kq.w) * es};
        vv[0] = (f32x4){bflo(vq.x), bfhi(vq.x), bflo(vq.y), bfhi(vq.y)};
        vv[1] = (f32x4){bflo(vq.z), bfhi(vq.z), bflo(vq.w), bfhi(vq.w)}; }
    __syncthreads();
    {
        const int d = tid >> 3, e0 = (tid & 7) * 8;
        f32x4 c0 = {0.f, 0.f, 0.f, 0.f}, c1 = {0.f, 0.f, 0.f, 0.f};
#pragma unroll 4
        for (int j = 0; j < 128; ++j) { const float ek = EK[j * 64 + d]; const f32x4 v0 = *(const LAS f32x4*)(VV + j * 64 + e0), v1 = *(const LAS f32x4*)(VV + j * 64 + e0 + 4);
            c0 += v0 * ek; c1 += v1 * ek; }
        GAS f32x4* dst = (GAS f32x4*)(WSP(float, WS_MLC) + (size_t)item * 4096 + d * 64 + e0);
        dst[0] = c0; dst[1] = c1;
        if (tid < 64) { float s = 0.f; for (int j = 0; j < 128; ++j) s += EK[j * 64 + tid]; WSP(float, WS_MLN)[item * 64 + tid] = s; }
        if (tid == 0) { WSP(float, WS_MLS)[item * 4] = mloc; WSP(float, WS_MLS)[item * 4 + 1] = aend; }
    }
    __syncthreads();
}

__device__ __forceinline__ void ml_scan(Frame& F) {
    float* MLC = WSP(float, WS_MLC); float* MLN = WSP(float, WS_MLN); float* MLS = WSP(float, WS_MLS);
    for (int idx = blockIdx.x * NTHR + F.tid; idx < 16 * 4160; idx += F.G * NTHR) {
        const int seq = idx / 4160, el = idx % 4160;
        float mst = 0.f, st = 0.f;
#pragma unroll 4
        for (int n = 0; n < 64; ++n) { const int item = seq * 64 + n;
            const float ml = MLS[item * 4], ae = MLS[item * 4 + 1];
            float* p = el < 4096 ? (MLC + (size_t)item * 4096 + el) : (MLN + item * 64 + (el - 4096));
            const float cl = *p; *p = st;
            if (el == 0) MLS[item * 4 + 2] = mst;
            const float mnew = fmaxf(ae + mst, ml), sp = fexp(ae + mst - mnew), sl = fexp(ml - mnew);
            st = sp * st + sl * cl; mst = mnew; }
    }
}

#define MFMA32(a, b, c) __builtin_amdgcn_mfma_f32_32x32x16_bf16((a), (b), (c), 0, 0, 0)
template <int NK>
__device__ __forceinline__ void qkt_tile(f32x16& p0, f32x16& p1, LAS const unsigned char* Kt, const bf16x8 (&qr)[NK], int r32, int hi) {
#pragma unroll
    for (int r = 0; r < 16; ++r) { p0[r] = 0.f; p1[r] = 0.f; }
#pragma unroll
    for (int d0 = 0; d0 < NK; ++d0) {
        const bf16x8 b0 = *(const LAS bf16x8*)(Kt + (2 * d0 + hi) * 1024 + r32 * 16);
        const bf16x8 b1 = *(const LAS bf16x8*)(Kt + (2 * d0 + hi) * 1024 + r32 * 16 + 512);
        p0 = MFMA32(b0, qr[d0], p0); p1 = MFMA32(b1, qr[d0], p1);
    }
}
typedef short v4i16_t __attribute__((ext_vector_type(4)));
__device__ __forceinline__ s16x4 vtr(LAS const unsigned char* p) { return __builtin_bit_cast(s16x4, __builtin_amdgcn_ds_read_tr16_b64_v4i16((LAS v4i16_t*)p)); }
__device__ __forceinline__ void pv_tile(f32x16 (&o)[2], LAS const unsigned char* Vt, const bf16x8 (&pa)[4], int lane) {
    const int hi = lane >> 5;
    LAS const unsigned char* vb = Vt + ((lane >> 4) & 1) * 32 + (lane & 3) * 8 + (4 * hi + ((lane & 15) >> 2)) * 64;
#pragma unroll
    for (int d0 = 0; d0 < 2; ++d0)
#pragma unroll
        for (int ks = 0; ks < 4; ++ks) {
            const s16x4 lo = vtr(vb + d0 * 4096 + ks * 1024), hh = vtr(vb + d0 * 4096 + ks * 1024 + 512);
            const bf16x8 vf = (bf16x8){lo[0], lo[1], lo[2], lo[3], hh[0], hh[1], hh[2], hh[3]};
            o[d0] = MFMA32(pa[ks], vf, o[d0]);
        }
}
__device__ __forceinline__ void pack_p(const f32x16& p0, const f32x16& p1, bf16x8 (&pa)[4]) {
    u32x4 w0, w1, w2, w3;
    w0 = (u32x4){pk2(p0[0], p0[1]), pk2(p0[2], p0[3]), pk2(p0[4], p0[5]), pk2(p0[6], p0[7])};
    w1 = (u32x4){pk2(p0[8], p0[9]), pk2(p0[10], p0[11]), pk2(p0[12], p0[13]), pk2(p0[14], p0[15])};
    w2 = (u32x4){pk2(p1[0], p1[1]), pk2(p1[2], p1[3]), pk2(p1[4], p1[5]), pk2(p1[6], p1[7])};
    w3 = (u32x4){pk2(p1[8], p1[9]), pk2(p1[10], p1[11]), pk2(p1[12], p1[13]), pk2(p1[14], p1[15])};
    pa[0] = __builtin_bit_cast(bf16x8, w0); pa[1] = __builtin_bit_cast(bf16x8, w1); pa[2] = __builtin_bit_cast(bf16x8, w2); pa[3] = __builtin_bit_cast(bf16x8, w3);
}

__device__ __forceinline__ void ml_out_pair(Frame& F, int pair, int l) {
    const int tid = F.tid, lane = F.lane, wid = F.wave, half = wid >> 2, wq = wid & 3, th = tid & 255, r32 = lane & 31, hi = lane >> 5;
    const int item = pair * 2 + half; const MlItem I = ml_decode(item);
    const bf16_t* U = WSP(bf16_t, WS_U);
    LAS unsigned char* base = F.lds + half * 49152;
    LAS unsigned char* KI = base;
    LAS unsigned char* VI = base + 16384;
    LAS unsigned char* CT = base + 32768;
    LAS float* vec = (LAS float*)(base + 32768 + 9216);
    LAS float* LF = vec; LAS float* IG = vec + 128; LAS float* BL = vec + 256; LAS float* SA = vec + 384; LAS float* SCI = vec + 512; LAS float* EDEN = vec + 640;
    LAS float* NPV = vec + 768; LAS float* wsf = vec + 832 + wq * 64;
    const float* gb = INF(10) + l * 16;
    if (th < 128) { const int j = th, r = I.dir ? 127 - j : j; const size_t t = (size_t)(I.t0 + r);
        const float ipre = bf2f(U[t * DINP + U_MLG + (I.dir ? 2 : 0) * 4 + I.h]) + gb[(I.dir ? 2 : 0) * 4 + I.h];
        const float fpre = bf2f(U[t * DINP + U_MLG + (I.dir ? 3 : 1) * 4 + I.h]) + gb[(I.dir ? 3 : 1) * 4 + I.h];
        LF[j] = logsigmoid(fpre); IG[j] = ipre; }
    __syncthreads();
    float a = 0.f;
    if (th < 128) { for (int i = 0; i <= th; ++i) a += LF[i]; BL[th] = IG[th] - a; }
    __syncthreads();
    if (th < 128) { float bm = -3.0e38f; for (int i = 0; i <= th; ++i) bm = fmaxf(bm, BL[i]);
        const float mprev = WSP(float, WS_MLS)[item * 4 + 2];
        const float mt = a + fmaxf(mprev, bm);
        SA[th] = (a - mt) * LOG2E; SCI[th] = fexp(a + mprev - mt); EDEN[th] = fexp(-mt); }
    __syncthreads();
    if (th < 128) BL[th] = BL[th] * LOG2E;
#pragma unroll
    for (int i = 0; i < 4; ++i) { const int p = th + 256 * i;
        { const int tt = p >> 9, c = (p >> 6) & 7, kv = p & 63, j = 64 * tt + kv, r = I.dir ? 127 - j : j;
          *(LAS u32x4*)(KI + tt * 8192 + c * 1024 + kv * 16) = *(const GAS u32x4*)(U + (size_t)(I.t0 + r) * DINP + U_MLK + I.h * 64 + c * 8); }
        { const int tt = p >> 9, dh = (p >> 8) & 1, kv = (p >> 2) & 63, c4 = p & 3, j = 64 * tt + kv, r = I.dir ? 127 - j : j;
          *(LAS u32x4*)(VI + tt * 8192 + dh * 4096 + kv * 64 + c4 * 16) = *(const GAS u32x4*)(U + (size_t)(I.t0 + r) * DINP + U_MLV + I.h * 64 + dh * 32 + c4 * 8); } }
    { const float* cp = WSP(float, WS_MLC) + (size_t)item * 4096;
#pragma unroll
      for (int i = 0; i < 16; ++i) { const int idx = th + 256 * i, d = idx >> 6, e = idx & 63;
          *(LAS unsigned short*)(CT + e * 144 + d * 2) = (unsigned short)(pk2(cp[idx], 0.f) & 0xffffu); }
      if (th < 64) NPV[th] = WSP(float, WS_MLN)[item * 64 + th]; }
    __syncthreads();
    {
        const int q = 32 * wq + r32;
        const int rq = I.dir ? 127 - q : q;
        bf16x8 qr[4];
        const bf16_t* qp = U + (size_t)(I.t0 + rq) * DINP + U_MLQ + I.h * 64 + hi * 8;
#pragma unroll
        for (int d0 = 0; d0 < 4; ++d0) qr[d0] = *(const GAS bf16x8*)(qp + d0 * 16);
        f32x16 o[2];
#pragma unroll
        for (int r = 0; r < 16; ++r) { o[0][r] = 0.f; o[1][r] = 0.f; }
        const float saq = SA[q], scq = SCI[q];
        float den = 0.f;
        for (int tt = 0; tt < 2; ++tt) {
            if (64 * tt > 32 * wq + 31) break;
            f32x16 p0, p1;
            qkt_tile<4>(p0, p1, KI + tt * 8192, qr, r32, hi);
#pragma unroll
            for (int g = 0; g < 4; ++g) {
                const f32x4 b0 = *(const LAS f32x4*)(BL + 64 * tt + 8 * g + 4 * hi), b1 = *(const LAS f32x4*)(BL + 64 * tt + 32 + 8 * g + 4 * hi);
#pragma unroll
                for (int i = 0; i < 4; ++i) { const int r = 4 * g + i; const int kv0 = 64 * tt + 8 * g + 4 * hi + i, kv1 = kv0 + 32;
                    const float e0 = (kv0 <= q) ? __builtin_amdgcn_exp2f(saq + b0[i]) * 0.125f : 0.f, e1 = (kv1 <= q) ? __builtin_amdgcn_exp2f(saq + b1[i]) * 0.125f : 0.f;
                    p0[r] *= e0; p1[r] *= e1; den += p0[r] + p1[r]; }
            }
            bf16x8 pa[4]; pack_p(p0, p1, pa);
            pv_tile(o, VI + tt * 8192, pa, lane);
        }
        float dot = 0.f;
#pragma unroll
        for (int ks = 0; ks < 4; ++ks) {
            const u32x4 qw = __builtin_bit_cast(u32x4, qr[ks]);
            const f32x4 n0 = *(const LAS f32x4*)(NPV + 16 * ks + 8 * hi), n1 = *(const LAS f32x4*)(NPV + 16 * ks + 8 * hi + 4);
            const float q0 = bflo(qw.x), q1 = bfhi(qw.x), q2 = bflo(qw.y), q3 = bfhi(qw.y), q4 = bflo(qw.z), q5 = bfhi(qw.z), q6 = bflo(qw.w), q7 = bfhi(qw.w);
            dot += q0 * n0[0] + q1 * n0[1] + q2 * n0[2] + q3 * n0[3] + q4 * n1[0] + q5 * n1[1] + q6 * n1[2] + q7 * n1[3];
            const u32x4 sw = (u32x4){pk2(q0 * scq, q1 * scq), pk2(q2 * scq, q3 * scq), pk2(q4 * scq, q5 * scq), pk2(q6 * scq, q7 * scq)};
            const bf16x8 qs = __builtin_bit_cast(bf16x8, sw);
#pragma unroll
            for (int de = 0; de < 2; ++de) {
                const bf16x8 cf = *(const LAS bf16x8*)(CT + (de * 32 + r32) * 144 + (16 * ks + 8 * hi) * 2);
                o[de] = MFMA32(qs, cf, o[de]);
            }
        }
        den += scq * dot;
        den += __shfl_xor(den, 32);
        const float rinv = 1.0f / fmaxf(fabsf(den), EDEN[q]);
        if (hi == 0) wsf[r32] = rinv;
        LDS_WAIT();
        float* dst = WSP(float, I.dir ? WS_HB : WS_HF);
#pragma unroll
        for (int r = 0; r < 16; ++r) { const int jq = 32 * wq + crow(r, hi), row = I.dir ? 127 - jq : jq; const float rr = wsf[crow(r, hi)];
            float* dp = dst + (size_t)(I.t0 + row) * 256 + I.h * 64 + r32;
            dp[0] = o[0][r] * rr; dp[32] = o[1][r] * rr; }
    }
    __syncthreads();
}

__device__ __forceinline__ void mla_prep_rows(Frame& F, int l) {
    const int gw = F.vcu * NWAVES + F.wave, NGW = F.G * NWAVES, lane = F.lane;
    const bf16_t* U = WSP(bf16_t, WS_U); bf16_t* A = WSP(bf16_t, WS_AMLA);
    const float* qn = INF(11) + l * 224; const float* kn = INF(12) + l * 128;
    for (int m = gw; m < MTOK; m += NGW) {
        const bf16_t* ur = U + (size_t)m * DINP;
        float q0 = 0.f, q1 = 0.f, q2 = 0.f, q3 = 0.f;
        if (lane < 56) { const u32x2 w = *(const GAS u32x2*)(ur + U_CQ + 4 * lane); q0 = bflo(w.x); q1 = bfhi(w.x); q2 = bflo(w.y); q3 = bfhi(w.y); }
        const unsigned kw = *(const GAS unsigned*)(ur + U_CKV + 2 * lane); const float k0 = bflo(kw), k1 = bfhi(kw);
        const float rq = __builtin_amdgcn_rsqf(wave_sum(q0 * q0 + q1 * q1 + q2 * q2 + q3 * q3) * (1.0f / 224.0f) + EPS);
        const float rk = __builtin_amdgcn_rsqf(wave_sum(k0 * k0 + k1 * k1) * (1.0f / 128.0f) + EPS);
        bf16_t* ar = A + (size_t)m * 384;
        u32x2 qo = {0u, 0u};
        if (lane < 56) { const f32x4 g = *(const GAS f32x4*)(qn + 4 * lane); qo.x = pk2(q0 * rq * g.x, q1 * rq * g.y); qo.y = pk2(q2 * rq * g.z, q3 * rq * g.w); }
        *(GAS u32x2*)(ar + 4 * lane) = qo;
        const f32x2 g2 = *(const GAS f32x2*)(kn + 2 * lane);
        *(GAS unsigned*)(ar + 256 + 2 * lane) = pk2(k0 * rk * g2.x, k1 * rk * g2.y);
    }
}

__device__ __forceinline__ void rope_cs(int pos, int i, float& c, float& s) {
    const double inv = __builtin_exp2(-(double)i * (13.287712379549449 / 16.0));
    double rev = (double)pos * inv * 0.15915494309189535;
    rev -= __builtin_floor(rev);
    const float r = (float)rev;
    c = cos_rev(r); s = sin_rev(r);
}
__device__ __forceinline__ void relayout_phase(Frame& F) {
    const bf16_t* O = WSP(bf16_t, WS_OMLA); const bf16_t* U = WSP(bf16_t, WS_U);
    const int* pos = (const int*)F.a->in[2];
    const float qscale = 0.10206207261596577f * LOG2E;
    for (int idx = blockIdx.x * NTHR + F.tid; idx < MTOK * 4; idx += F.G * NTHR) {
        const int t = idx >> 2, h = idx & 3, b = t >> 13, s = t & 8191, bh = b * 4 + h;
        const int p = pos[t];
        float cs[16], sn[16];
#pragma unroll
        for (int i = 0; i < 16; ++i) rope_cs(p, i, cs[i], sn[i]);
        const bf16_t* qsrc = O + (size_t)t * 1024 + h * 96;
        bf16_t* qdst = WSP(bf16_t, WS_Q) + ((size_t)bh * SEQ + s) * 96;
#pragma unroll
        for (int c = 0; c < 8; ++c) { const u32x4 w = *(const GAS u32x4*)(qsrc + c * 8);
            u32x4 o; o.x = pk2(bflo(w.x) * qscale, bfhi(w.x) * qscale); o.y = pk2(bflo(w.y) * qscale, bfhi(w.y) * qscale); o.z = pk2(bflo(w.z) * qscale, bfhi(w.z) * qscale); o.w = pk2(bflo(w.w) * qscale, bfhi(w.w) * qscale);
            *(GAS u32x4*)(qdst + c * 8) = o; }
        {
            float x1[16], x2[16];
#pragma unroll
            for (int c = 0; c < 2; ++c) { const u32x4 w = *(const GAS u32x4*)(qsrc + 64 + c * 8); const u32x4 v = *(const GAS u32x4*)(qsrc + 80 + c * 8);
                x1[c * 8 + 0] = bflo(w.x); x1[c * 8 + 1] = bfhi(w.x); x1[c * 8 + 2] = bflo(w.y); x1[c * 8 + 3] = bfhi(w.y); x1[c * 8 + 4] = bflo(w.z); x1[c * 8 + 5] = bfhi(w.z); x1[c * 8 + 6] = bflo(w.w); x1[c * 8 + 7] = bfhi(w.w);
                x2[c * 8 + 0] = bflo(v.x); x2[c * 8 + 1] = bfhi(v.x); x2[c * 8 + 2] = bflo(v.y); x2[c * 8 + 3] = bfhi(v.y); x2[c * 8 + 4] = bflo(v.z); x2[c * 8 + 5] = bfhi(v.z); x2[c * 8 + 6] = bflo(v.w); x2[c * 8 + 7] = bfhi(v.w); }
#pragma unroll
            for (int c = 0; c < 2; ++c) { u32x4 o1, o2;
#define RQ1(i) ((x1[i] * cs[i] - x2[i] * sn[i]) * qscale)
#define RQ2(i) ((x2[i] * cs[i] + x1[i] * sn[i]) * qscale)
                o1.x = pk2(RQ1(c * 8 + 0), RQ1(c * 8 + 1)); o1.y = pk2(RQ1(c * 8 + 2), RQ1(c * 8 + 3)); o1.z = pk2(RQ1(c * 8 + 4), RQ1(c * 8 + 5)); o1.w = pk2(RQ1(c * 8 + 6), RQ1(c * 8 + 7));
                o2.x = pk2(RQ2(c * 8 + 0), RQ2(c * 8 + 1)); o2.y = pk2(RQ2(c * 8 + 2), RQ2(c * 8 + 3)); o2.z = pk2(RQ2(c * 8 + 4), RQ2(c * 8 + 5)); o2.w = pk2(RQ2(c * 8 + 6), RQ2(c * 8 + 7));
                *(GAS u32x4*)(qdst + 64 + c * 8) = o1; *(GAS u32x4*)(qdst + 80 + c * 8) = o2; }
#undef RQ1
#undef RQ2
        }
        bf16_t* kdst = WSP(bf16_t, WS_KIMG) + ((size_t)bh * 128 + (s >> 6)) * 6144 + (s & 63) * 8;
        const bf16_t* ksrc = O + (size_t)t * 1024 + 384 + h * 64;
#pragma unroll
        for (int c = 0; c < 8; ++c) *(GAS u32x4*)(kdst + c * 512) = *(const GAS u32x4*)(ksrc + c * 8);
        {
            const bf16_t* krs = U + (size_t)t * DINP + U_KR;
            float x1[16], x2[16];
#pragma unroll
            for (int c = 0; c < 2; ++c) { const u32x4 w = *(const GAS u32x4*)(krs + c * 8); const u32x4 v = *(const GAS u32x4*)(krs + 16 + c * 8);
                x1[c * 8 + 0] = bflo(w.x); x1[c * 8 + 1] = bfhi(w.x); x1[c * 8 + 2] = bflo(w.y); x1[c * 8 + 3] = bfhi(w.y); x1[c * 8 + 4] = bflo(w.z); x1[c * 8 + 5] = bfhi(w.z); x1[c * 8 + 6] = bflo(w.w); x1[c * 8 + 7] = bfhi(w.w);
                x2[c * 8 + 0] = bflo(v.x); x2[c * 8 + 1] = bfhi(v.x); x2[c * 8 + 2] = bflo(v.y); x2[c * 8 + 3] = bfhi(v.y); x2[c * 8 + 4] = bflo(v.z); x2[c * 8 + 5] = bfhi(v.z); x2[c * 8 + 6] = bflo(v.w); x2[c * 8 + 7] = bfhi(v.w); }
#pragma unroll
            for (int c = 0; c < 2; ++c) { u32x4 o1, o2;
#define RK1(i) (x1[i] * cs[i] - x2[i] * sn[i])
#define RK2(i) (x2[i] * cs[i] + x1[i] * sn[i])
                o1.x = pk2(RK1(c * 8 + 0), RK1(c * 8 + 1)); o1.y = pk2(RK1(c * 8 + 2), RK1(c * 8 + 3)); o1.z = pk2(RK1(c * 8 + 4), RK1(c * 8 + 5)); o1.w = pk2(RK1(c * 8 + 6), RK1(c * 8 + 7));
                o2.x = pk2(RK2(c * 8 + 0), RK2(c * 8 + 1)); o2.y = pk2(RK2(c * 8 + 2), RK2(c * 8 + 3)); o2.z = pk2(RK2(c * 8 + 4), RK2(c * 8 + 5)); o2.w = pk2(RK2(c * 8 + 6), RK2(c * 8 + 7));
                *(GAS u32x4*)(kdst + (8 + c) * 512) = o1; *(GAS u32x4*)(kdst + (10 + c) * 512) = o2; }
#undef RK1
#undef RK2
        }
        bf16_t* vdst = WSP(bf16_t, WS_VIMG) + ((size_t)bh * 128 + (s >> 6)) * 4096 + (s & 63) * 32;
        const bf16_t* vsrc = O + (size_t)t * 1024 + 640 + h * 64;
#pragma unroll
        for (int c = 0; c < 8; ++c) *(GAS u32x4*)(vdst + (c >> 2) * 2048 + (c & 3) * 8) = *(const GAS u32x4*)(vsrc + c * 8);
    }
}

__device__ __forceinline__ void attn_unit(Frame& F, int bh, int qb) {
    const int tid = F.tid, lane = F.lane, wid = F.wave, r32 = lane & 31, hi = lane >> 5;
    LAS unsigned char* KB = F.lds;
    LAS unsigned char* VB = F.lds + 24576;
    LAS float* wsf = (LAS float*)(F.lds + 40960) + wid * 64;
    const int b = bh >> 2, h = bh & 3;
    const bf16_t* Qp = WSP(bf16_t, WS_Q) + ((size_t)bh * SEQ + qb * 256 + wid * 32 + r32) * 96 + hi * 8;
    bf16x8 qr[6];
#pragma unroll
    for (int d0 = 0; d0 < 6; ++d0) qr[d0] = *(const GAS bf16x8*)(Qp + d0 * 16);
    const GAS u32x4* Kg = (const GAS u32x4*)(WSP(bf16_t, WS_KIMG) + (size_t)bh * 128 * 6144);
    const GAS u32x4* Vg = (const GAS u32x4*)(WSP(bf16_t, WS_VIMG) + (size_t)bh * 128 * 4096);
    u32x4 k0 = Kg[tid], k1 = (tid < 256) ? Kg[512 + tid] : (u32x4){0u, 0u, 0u, 0u}, v0 = Vg[tid];
    *(LAS u32x4*)(KB + tid * 16) = k0; if (tid < 256) *(LAS u32x4*)(KB + (512 + tid) * 16) = k1; *(LAS u32x4*)(VB + tid * 16) = v0;
    __syncthreads();
    float m = -1.0e30f, lsum = 0.f;
    f32x16 o[2];
#pragma unroll
    for (int r = 0; r < 16; ++r) { o[0][r] = 0.f; o[1][r] = 0.f; }
    for (int t = 0; t < 128; ++t) {
        const int cur = t & 1;
        if (t + 1 < 128) { k0 = Kg[(t + 1) * 768 + tid]; if (tid < 256) k1 = Kg[(t + 1) * 768 + 512 + tid]; v0 = Vg[(t + 1) * 512 + tid]; }
        f32x16 p0, p1;
        qkt_tile<6>(p0, p1, KB + cur * 12288, qr, r32, hi);
        float rm = fmaxf(p0[0], p1[0]);
#pragma unroll
        for (int r = 1; r < 16; ++r) rm = fmaxf(rm, fmaxf(p0[r], p1[r]));
        rm = fmaxf(rm, __shfl_xor(rm, 32));
        if (__any(rm > m + 8.0f)) {
            const float mn = fmaxf(m, rm), f = __builtin_amdgcn_exp2f(m - mn);
            m = mn; lsum *= f;
            if (hi == 0) wsf[r32] = f;
            LDS_WAIT();
#pragma unroll
            for (int r = 0; r < 16; ++r) { const float fr = wsf[crow(r, hi)]; o[0][r] *= fr; o[1][r] *= fr; }
        }
#pragma unroll
        for (int r = 0; r < 16; ++r) { p0[r] = __builtin_amdgcn_exp2f(p0[r] - m); p1[r] = __builtin_amdgcn_exp2f(p1[r] - m); lsum += p0[r] + p1[r]; }
        bf16x8 pa[4]; pack_p(p0, p1, pa);
        pv_tile(o, VB + cur * 8192, pa, lane);
        if (t + 1 < 128) { const int nb = cur ^ 1;
            *(LAS u32x4*)(KB + nb * 12288 + tid * 16) = k0; if (tid < 256) *(LAS u32x4*)(KB + nb * 12288 + (512 + tid) * 16) = k1; *(LAS u32x4*)(VB + nb * 8192 + tid * 16) = v0; }
        __syncthreads();
    }
    lsum += __shfl_xor(lsum, 32);
    if (hi == 0) wsf[r32] = 1.0f / lsum;
    LDS_WAIT();
    bf16_t* Y = WSP(bf16_t, WS_YMIX);
#pragma unroll
    for (int r = 0; r < 16; ++r) { const float rl = wsf[crow(r, hi)]; const int q = qb * 256 + wid * 32 + crow(r, hi);
        bf16_t* yp = Y + ((size_t)b * SEQ + q) * 512 + h * 64 + r32;
        yp[0] = (bf16_t)(pk2(o[0][r] * rl, 0.f) & 0xffffu); yp[32] = (bf16_t)(pk2(o[1][r] * rl, 0.f) & 0xffffu); }
    __syncthreads();
}

template <bool INV>
__device__ __forceinline__ void fft16k(LAS f32x2* X, int tid) {
#pragma unroll 1
    for (int s = 0; s < 7; ++s) {
        const int lq = INV ? 2 * s : 12 - 2 * s; const int q = 1 << lq;
        const float rq = 1.0f / (float)(4 * q);
#pragma unroll 2
        for (int i = 0; i < 8; ++i) {
            const int t = tid + 512 * i; const int j = t & (q - 1); const int base = ((t >> lq) << (lq + 2)) + j;
            f32x2 x0 = X[base], x1 = X[base + q], x2 = X[base + 2 * q], x3 = X[base + 3 * q];
            const float ang = (float)j * rq;
            const float c1 = cos_rev(ang), s1 = INV ? sin_rev(ang) : -sin_rev(ang);
            const float c2 = c1 * c1 - s1 * s1, s2 = 2.0f * c1 * s1;
            const float c3 = c2 * c1 - s2 * s1, s3 = c2 * s1 + s2 * c1;
            if (!INV) {
                const f32x2 a = x0 + x2, b = x0 - x2, c = x1 + x3, d = x1 - x3;
                const f32x2 y0 = a + c, y2 = a - c, y1 = (f32x2){b.x + d.y, b.y - d.x}, y3 = (f32x2){b.x - d.y, b.y + d.x};
                X[base] = y0;
                X[base + q] = (f32x2){y1.x * c1 - y1.y * s1, y1.x * s1 + y1.y * c1};
                X[base + 2 * q] = (f32x2){y2.x * c2 - y2.y * s2, y2.x * s2 + y2.y * c2};
                X[base + 3 * q] = (f32x2){y3.x * c3 - y3.y * s3, y3.x * s3 + y3.y * c3};
            } else {
                x1 = (f32x2){x1.x * c1 - x1.y * s1, x1.x * s1 + x1.y * c1};
                x2 = (f32x2){x2.x * c2 - x2.y * s2, x2.x * s2 + x2.y * c2};
                x3 = (f32x2){x3.x * c3 - x3.y * s3, x3.x * s3 + x3.y * c3};
                const f32x2 a = x0 + x2, b = x0 - x2, c = x1 + x3, d = x1 - x3;
                X[base] = a + c; X[base + 2 * q] = a - c;
                X[base + q] = (f32x2){b.x - d.y, b.y + d.x};
                X[base + 3 * q] = (f32x2){b.x + d.y, b.y - d.x};
            }
        }
        __syncthreads();
    }
}
__device__ __forceinline__ float block_sum(Frame& F, float v, LAS float* red) {
    v = wave_sum(v);
    if (F.lane == 0) red[F.wave] = v;
    __syncthreads();
    float s = 0.f;
#pragma unroll
    for (int w = 0; w < NWAVES; ++w) s += red[w];
    __syncthreads();
    return s;
}
__device__ __forceinline__ void hyena_item(Frame& F, int c, int l) {
    const int tid = F.tid;
    LAS f32x2* X = (LAS f32x2*)F.lds;
    LAS float* W3F = (LAS float*)(F.lds + XTRA_OFF); LAS float* W3B = W3F + 64; LAS float* red = W3F + 128;
    f32x2* KF = WSP(f32x2, WS_KF) + (size_t)c * 2 * 16384;
    const float* HID = WSP(float, WS_HID) + (size_t)l * SEQ * 64;
    for (int o = 0; o < 2; ++o) {
        const int cf = o * 512 + c, cb = cf + 256;
        if (tid < 64) W3F[tid] = INF(24)[(size_t)l * 64 * 1024 + tid * 1024 + cf];
        else if (tid < 128) W3B[tid - 64] = INF(24)[(size_t)l * 64 * 1024 + (tid - 64) * 1024 + cb];
        const float b3f = INF(25)[l * 1024 + cf], b3b = INF(25)[l * 1024 + cb];
        const float df = fexp(INF(26)[l * 1024 + cf]), db = fexp(INF(26)[l * 1024 + cb]);
        __syncthreads();
        float ssum = 0.f;
#pragma unroll 1
        for (int i = 0; i < 16; ++i) { const int t = tid + 512 * i;
            const GAS f32x4* hv = (const GAS f32x4*)(HID + (size_t)t * 64);
            float ff = b3f, fb = b3b;
#pragma unroll
            for (int m4 = 0; m4 < 16; ++m4) { const f32x4 h = hv[m4]; const f32x4 wf = *(const LAS f32x4*)(W3F + 4 * m4), wb = *(const LAS f32x4*)(W3B + 4 * m4);
                ff += h.x * wf.x + h.y * wf.y + h.z * wf.z + h.w * wf.w; fb += h.x * wb.x + h.y * wb.y + h.z * wb.z + h.w * wb.w; }
            const float tt = (float)t * (1.0f / SEQ);
            ff *= fexp(-tt * df); fb *= fexp(-tt * db);
            ssum += fabsf(ff) + fabsf(fb);
            X[t] = (f32x2){ff, 0.f}; X[16383 - t] = (f32x2){fb, 0.f}; }
        const float inv = 1.0f / block_sum(F, ssum, red);
        fft16k<false>(X, tid);
#pragma unroll 4
        for (int i = 0; i < 32; ++i) { const int p = tid + 512 * i; const f32x2 v = X[p]; KF[o * 16384 + p] = (f32x2){v.x * inv, v.y * inv}; }
        __syncthreads();
    }
    const bf16_t* U = WSP(bf16_t, WS_U);
    float wx1[3], wx2[3], wz[3];
#pragma unroll
    for (int j = 0; j < 3; ++j) { wx1[j] = INF(16)[(size_t)l * 768 * 3 + c * 3 + j]; wx2[j] = INF(16)[(size_t)l * 768 * 3 + (256 + c) * 3 + j]; wz[j] = INF(16)[(size_t)l * 768 * 3 + (512 + c) * 3 + j]; }
    const float bx1 = INF(17)[l * 768 + c], bx2 = INF(17)[l * 768 + 256 + c], bz = INF(17)[l * 768 + 512 + c];
    const float hb0 = INF(27)[l * 512 + c], hb1 = INF(27)[l * 512 + 256 + c];
    float zz[16][2];
#define HY_CONV(dst, colofs, w, bias) do { const bf16_t* up_ = U + ((size_t)b * SEQ + t) * DINP + U_HY + (colofs) + c; \
        const float a_m = (t > 0) ? bf2f(up_[-DINP]) : 0.f, a_0 = bf2f(up_[0]), a_p = (t < SEQ - 1) ? bf2f(up_[DINP]) : 0.f; \
        dst = w[0] * a_m + w[1] * a_0 + w[2] * a_p + (bias); } while (0)
#pragma unroll
    for (int i = 0; i < 16; ++i) { int t = tid + 512 * i; asm volatile("" : "+v"(t));
#pragma unroll
        for (int b = 0; b < 2; ++b) HY_CONV(zz[i][b], 512, wz, bz);
        X[t] = (f32x2){zz[i][0], zz[i][1]}; X[8192 + t] = (f32x2){0.f, 0.f}; asm volatile("" ::: "memory"); }
    __syncthreads();
    const float invn = 1.0f / 16384.0f;
    for (int o = 0; o < 2; ++o) {
        fft16k<false>(X, tid);
#pragma unroll 4
        for (int i = 0; i < 32; ++i) { const int p = tid + 512 * i; const f32x2 v = X[p]; const f32x2 k = KF[o * 16384 + p]; X[p] = (f32x2){v.x * k.x - v.y * k.y, v.x * k.y + v.y * k.x}; }
        __syncthreads();
        fft16k<true>(X, tid);
        if (o == 0) {
#pragma unroll
            for (int i = 0; i < 16; ++i) { int t = tid + 512 * i; asm volatile("" : "+v"(t)); const f32x2 y = X[t];
                float ga, gb2; { const int b = 0; HY_CONV(ga, 0, wx1, bx1); } { const int b = 1; HY_CONV(gb2, 0, wx1, bx1); }
                zz[i][0] = ga * (y.x * invn + zz[i][0] * hb0); zz[i][1] = gb2 * (y.y * invn + zz[i][1] * hb0);
                X[t] = (f32x2){zz[i][0], zz[i][1]}; X[8192 + t] = (f32x2){0.f, 0.f}; asm volatile("" ::: "memory"); }
            __syncthreads();
        } else {
            bf16_t* Y = WSP(bf16_t, WS_YMIX);
#pragma unroll
            for (int i = 0; i < 16; ++i) { int t = tid + 512 * i; asm volatile("" : "+v"(t)); const f32x2 y = X[t];
                float ga, gb2; { const int b = 0; HY_CONV(ga, 256, wx2, bx2); } { const int b = 1; HY_CONV(gb2, 256, wx2, bx2); }
                const float r0 = ga * (y.x * invn + zz[i][0] * hb1), r1 = gb2 * (y.y * invn + zz[i][1] * hb1);
                Y[((size_t)t) * 512 + 256 + c] = (bf16_t)(pk2(r0, 0.f) & 0xffffu); Y[((size_t)SEQ + t) * 512 + 256 + c] = (bf16_t)(pk2(r1, 0.f) & 0xffffu); asm volatile("" ::: "memory"); }
            __syncthreads();
        }
    }
#undef HY_CONV
}

__device__ __forceinline__ void headnorm_phase(Frame& F, int l) {
    const int gw = F.vcu * NWAVES + F.wave, NGW = F.G * NWAVES, lane = F.lane;
    const bf16_t* U = WSP(bf16_t, WS_U); const bf16_t* YM = WSP(bf16_t, WS_YMIX);
    const float* og = INF(29) + l * 1024;
    for (int m = gw; m < MTOK; m += NGW) {
        float y[16];
        const int ch = 16 * lane;
        if (lane < 16) {
            const bf16_t* op = U + (size_t)m * DINP + U_MLO + ch;
            const u32x4 o0 = *(const GAS u32x4*)op, o1 = *(const GAS u32x4*)(op + 8);
            const unsigned ow[8] = {o0.x, o0.y, o0.z, o0.w, o1.x, o1.y, o1.z, o1.w};
            const GAS f32x4* hf = (const GAS f32x4*)(WSP(float, WS_HF) + (size_t)m * 256 + ch);
            const GAS f32x4* hb = (const GAS f32x4*)(WSP(float, WS_HB) + (size_t)m * 256 + ch);
#pragma unroll
            for (int j = 0; j < 4; ++j) { const f32x4 s = hf[j] + hb[j];
                const float oa = bflo(ow[2 * j]), ob = bfhi(ow[2 * j]), oc = bflo(ow[2 * j + 1]), od = bfhi(ow[2 * j + 1]);
                y[4 * j + 0] = s.x / (1.0f + fexp(-oa)); y[4 * j + 1] = s.y / (1.0f + fexp(-ob)); y[4 * j + 2] = s.z / (1.0f + fexp(-oc)); y[4 * j + 3] = s.w / (1.0f + fexp(-od)); }
        } else if (lane < 48) {
            const bf16_t* yp = YM + (size_t)m * 512 + (ch - 256);
            const u32x4 o0 = *(const GAS u32x4*)yp, o1 = *(const GAS u32x4*)(yp + 8);
            const unsigned ow[8] = {o0.x, o0.y, o0.z, o0.w, o1.x, o1.y, o1.z, o1.w};
#pragma unroll
            for (int j = 0; j < 8; ++j) { y[2 * j] = bflo(ow[j]); y[2 * j + 1] = bfhi(ow[j]); }
        } else {
            const int c = ch - 768, s = m & 8191;
            const bf16_t* up = U + (size_t)m * DINP + U_SC + c;
            float acc[16];
#pragma unroll
            for (int j = 0; j < 16; ++j) acc[j] = 0.f;
#pragma unroll
            for (int dt = -1; dt <= 1; ++dt) {
                if ((s + dt) < 0 || (s + dt) >= SEQ) continue;
                const bf16_t* rp = up + (ptrdiff_t)dt * DINP;
                const u32x4 c0 = *(const GAS u32x4*)(rp + 256), c1 = *(const GAS u32x4*)(rp + 264), x0 = *(const GAS u32x4*)(rp + 512), x1 = *(const GAS u32x4*)(rp + 520);
                const unsigned cw[8] = {c0.x, c0.y, c0.z, c0.w, c1.x, c1.y, c1.z, c1.w}, xw[8] = {x0.x, x0.y, x0.z, x0.w, x1.x, x1.y, x1.z, x1.w};
#pragma unroll
                for (int j = 0; j < 8; ++j) { acc[2 * j] += bflo(cw[j]) * bflo(xw[j]) * INF(28)[(size_t)l * 768 + (c + 2 * j) * 3 + dt + 1]; acc[2 * j + 1] += bfhi(cw[j]) * bfhi(xw[j]) * INF(28)[(size_t)l * 768 + (c + 2 * j + 1) * 3 + dt + 1]; }
            }
            const u32x4 b0 = *(const GAS u32x4*)up, b1 = *(const GAS u32x4*)(up + 8);
            const unsigned bw[8] = {b0.x, b0.y, b0.z, b0.w, b1.x, b1.y, b1.z, b1.w};
#pragma unroll
            for (int j = 0; j < 8; ++j) { y[2 * j] = bflo(bw[j]) * acc[2 * j]; y[2 * j + 1] = bfhi(bw[j]) * acc[2 * j + 1]; }
        }
        float ss = 0.f;
#pragma unroll
        for (int j = 0; j < 16; ++j) ss += y[j] * y[j];
        ss += __shfl_xor(ss, 1); ss += __shfl_xor(ss, 2);
        const float rstd = __builtin_amdgcn_rsqf(ss * (1.0f / 64.0f) + EPS);
        const GAS f32x4* gp = (const GAS f32x4*)(og + ch);
        u32x4 w0, w1;
        { const f32x4 ga = gp[0], gb2 = gp[1], gc = gp[2], gd = gp[3];
          w0.x = pk2(y[0] * rstd * ga.x, y[1] * rstd * ga.y); w0.y = pk2(y[2] * rstd * ga.z, y[3] * rstd * ga.w); w0.z = pk2(y[4] * rstd * gb2.x, y[5] * rstd * gb2.y); w0.w = pk2(y[6] * rstd * gb2.z, y[7] * rstd * gb2.w);
          w1.x = pk2(y[8] * rstd * gc.x, y[9] * rstd * gc.y); w1.y = pk2(y[10] * rstd * gc.z, y[11] * rstd * gc.w); w1.z = pk2(y[12] * rstd * gd.x, y[13] * rstd * gd.y); w1.w = pk2(y[14] * rstd * gd.z, y[15] * rstd * gd.w); }
        bf16_t* yn = WSP(bf16_t, WS_YN) + (size_t)m * DM + ch;
        *(GAS u32x4*)yn = w0; *(GAS u32x4*)(yn + 8) = w1;
    }
}

__device__ __forceinline__ void post_mixer_phase(Frame& F, int l, const float* xin) {
    const int gw = F.vcu * NWAVES + F.wave, NGW = F.G * NWAVES, lane = F.lane, tid = F.tid;
    LAS float* RW = (LAS float*)F.lds;
    { const GAS f32x4* src = (const GAS f32x4*)(INF(31) + (size_t)l * 1024 * 16);
      for (int i = tid; i < 4096; i += NTHR) ((LAS f32x4*)RW)[i] = src[i]; }
    __syncthreads();
    const float* mod = WSP(float, WS_MOD);
    for (int m = gw; m < MTOK; m += NGW) {
        const int b = m >> 13, s = m & 8191; const float* md = mod + (l * 2 + b) * 6144;
        f32x4 y2[4], x[4], pg[4], g1[4];
        ld_row_f32(WSP(float, WS_Y2) + (size_t)m * DM, lane, y2);
        ld_row_f32(xin + (size_t)m * DM, lane, x);
        ld_row_f32(INF(6) + l * 1024, lane, pg); ld_row_f32(md + 2048, lane, g1);
        const float rstd = __builtin_amdgcn_rsqf(row_ss(y2) * (1.0f / DM) + EPS);
#pragma unroll
        for (int j = 0; j < 4; ++j) x[j] = x[j] + g1[j] * (y2[j] * rstd * pg[j]);
        st_row_f32(WSP(float, WS_X1) + (size_t)m * DM, lane, x);
        f32x4 h[4];
        modnorm(x, INF(7) + l * 1024, md + 4096, md + 3072, lane, h);
        st_row_bf16(WSP(bf16_t, WS_XN) + (size_t)m * DM, lane, h);
        float part[16];
#pragma unroll
        for (int e = 0; e < 16; ++e) part[e] = 0.f;
#pragma unroll
        for (int j = 0; j < 4; ++j)
#pragma unroll
            for (int i = 0; i < 4; ++i) { const float hv = h[j][i]; const LAS f32x4* rw = (const LAS f32x4*)(RW + (4 * lane + 256 * j + i) * 16);
#pragma unroll
                for (int e4 = 0; e4 < 4; ++e4) { const f32x4 w = rw[e4]; part[4 * e4] += hv * w.x; part[4 * e4 + 1] += hv * w.y; part[4 * e4 + 2] += hv * w.z; part[4 * e4 + 3] += hv * w.w; }
                asm volatile("" ::: "memory"); }
#pragma unroll
        for (int e = 0; e < 16; ++e) part[e] = wave_sum(part[e]);
        float lg = part[0];
#pragma unroll
        for (int e = 1; e < 16; ++e) lg = (lane == e) ? part[e] : lg;
        float mx = lg;
#pragma unroll
        for (int o = 1; o < 16; o <<= 1) mx = fmaxf(mx, __shfl_xor(mx, o));
        const float ex = fexp(lg - mx); float sm = ex;
#pragma unroll
        for (int o = 1; o < 16; o <<= 1) sm += __shfl_xor(sm, o);
        if (lane < 16) { WSP(float, WS_AFF)[((size_t)b * 16 + lane) * SEQ + s] = ex / sm; WSP(int, WS_SLOT)[(size_t)m * 16 + lane] = -1; }
    }
    __syncthreads();
}

__device__ __forceinline__ void topk_item(Frame& F, int it) {
    const int tid = F.tid, lane = F.lane, wave = F.wave;
    const int b = it >> 4, e = it & 15;
    LAS unsigned* keys = (LAS unsigned*)F.lds;
    LAS unsigned* hist = (LAS unsigned*)(F.lds + 32768);
    LAS unsigned* ctl = hist + 256;
    LAS unsigned* wtot = hist + 320;
    const unsigned* src = (const unsigned*)(WSP(float, WS_AFF) + (size_t)it * SEQ);
#pragma unroll
    for (int i = 0; i < 16; ++i) keys[tid + 512 * i] = src[tid + 512 * i];
    unsigned prefix = 0u, mask = 0u, need = CAP;
    for (int pass = 0; pass < 4; ++pass) {
        const int shift = 24 - 8 * pass;
        if (tid < 256) hist[tid] = 0u;
        __syncthreads();
#pragma unroll
        for (int i = 0; i < 16; ++i) { const unsigned k = keys[tid + 512 * i]; if ((k & mask) == prefix) atomicAdd((unsigned*)&hist[(k >> shift) & 255u], 1u); }
        __syncthreads();
        if (tid == 0) { unsigned cum = 0u; int bin = 255; for (; bin > 0; --bin) { const unsigned hcount = hist[bin]; if (cum + hcount >= need) break; cum += hcount; }
            ctl[0] = (unsigned)bin; ctl[1] = need - cum; }
        __syncthreads();
        prefix |= ctl[0] << shift; mask |= 0xffu << shift; need = ctl[1];
        __syncthreads();
    }
    unsigned cg = 0u, ce = 0u;
#pragma unroll
    for (int i = 0; i < 16; ++i) { const unsigned k = keys[tid * 16 + i]; cg += (k > prefix) ? 1u : 0u; ce += (k == prefix) ? 1u : 0u; }
    unsigned v = cg | (ce << 16), inc = v;
#pragma unroll
    for (int o = 1; o < 64; o <<= 1) { const unsigned n = __shfl_up(inc, o); if (lane >= o) inc += n; }
    if (lane == 63) wtot[wave] = inc;
    __syncthreads();
    unsigned off = 0u;
    for (int w = 0; w < wave; ++w) off += wtot[w];
    const unsigned excl = off + inc - v;
    unsigned ng = excl & 0xffffu, ne = excl >> 16;
    int* IDX = WSP(int, WS_IDX) + it * CAP; int* SLOT = WSP(int, WS_SLOT);
#pragma unroll
    for (int i = 0; i < 16; ++i) { const int idx = tid * 16 + i; const unsigned k = keys[idx];
        const bool gt = k > prefix, eq = k == prefix; const bool sel = gt || (eq && ne < need);
        if (sel) { const int slot = (int)(ng + (ne < need ? ne : need)); IDX[slot] = idx; SLOT[((size_t)b * SEQ + idx) * 16 + e] = slot; }
        ng += gt ? 1u : 0u; ne += eq ? 1u : 0u; }
    __syncthreads();
}

__device__ __forceinline__ void gather_phase(Frame& F) {
    const int gw = F.vcu * NWAVES + F.wave, NGW = F.G * NWAVES, lane = F.lane;
    const int* IDX = WSP(int, WS_IDX);
    for (int r = gw; r < NEXP * 2 * CAP; r += NGW) {
        const int e = r >> 11, b = (r >> 10) & 1, j = r & 1023;
        const int tok = IDX[(b * 16 + e) * CAP + j];
        const GAS u32x4* src = (const GAS u32x4*)(WSP(bf16_t, WS_XN) + ((size_t)b * SEQ + tok) * DM);
        GAS u32x4* dst = (GAS u32x4*)(WSP(bf16_t, WS_XE) + (size_t)r * DM);
        dst[lane] = src[lane]; dst[64 + lane] = src[64 + lane];
    }
}

__device__ __forceinline__ void combine_phase(Frame& F, int l) {
    const int gw = F.vcu * NWAVES + F.wave, NGW = F.G * NWAVES, lane = F.lane;
    const float* mod = WSP(float, WS_MOD);
    const bf16_t* YE = WSP(bf16_t, WS_YE);
    for (int m = gw; m < MTOK; m += NGW) {
        const int b = m >> 13, s = m & 8191; const float* md = mod + (l * 2 + b) * 6144;
        int sl = -1; float gv = 0.f;
        if (lane < 16) { sl = WSP(int, WS_SLOT)[(size_t)m * 16 + lane]; gv = WSP(float, WS_AFF)[((size_t)b * 16 + lane) * SEQ + s]; }
        f32x4 acc[4];
#pragma unroll
        for (int j = 0; j < 4; ++j) acc[j] = (f32x4){0.f, 0.f, 0.f, 0.f};
#pragma unroll 1
        for (int e = 0; e < 16; ++e) {
            const int se = __shfl(sl, e);
            if (se >= 0) { const float ge = __shfl(gv, e);
                const GAS u32x2* rp = (const GAS u32x2*)(YE + ((size_t)e * 2048 + b * CAP + se) * DM) + lane;
#pragma unroll
                for (int j = 0; j < 4; ++j) { const u32x2 w = rp[64 * j]; acc[j] += (f32x4){bflo(w.x), bfhi(w.x), bflo(w.y), bfhi(w.y)} * ge; } }
        }
        f32x4 x1[4], pg[4], g2[4];
        ld_row_f32(WSP(float, WS_X1) + (size_t)m * DM, lane, x1);
        ld_row_f32(INF(8) + l * 1024, lane, pg); ld_row_f32(md + 5120, lane, g2);
        const float rstd = __builtin_amdgcn_rsqf(row_ss(acc) * (1.0f / DM) + EPS);
#pragma unroll
        for (int j = 0; j < 4; ++j) x1[j] = x1[j] + g2[j] * (acc[j] * rstd * pg[j]);
        st_row_f32(F.a->out + (size_t)m * DM, lane, x1);
        if (l == 0) { f32x4 h[4]; const float* md1 = mod + (1 * 2 + b) * 6144;
            modnorm(x1, INF(5) + 1024, md1 + 1024, md1, lane, h);
            st_row_bf16(WSP(bf16_t, WS_XN) + (size_t)m * DM, lane, h); }
    }
}

constexpr int PH_PER_LAYER = 13, N_PHASES = 2 + 2 * PH_PER_LAYER;
__global__ void __launch_bounds__(NTHR, 2) mega_fwd(Args args) {
    extern __shared__ __attribute__((aligned(16))) unsigned char lds_raw[];
    Frame F;
    F.lds = (LAS unsigned char*)lds_raw;
    F.tid = threadIdx.x; F.lane = F.tid & 63; F.wave = __builtin_amdgcn_readfirstlane(F.tid >> 6);
    F.G = gridDim.x; { const int bx = blockIdx.x; F.vcu = (F.G % 8 == 0) ? (bx % 8) * (F.G / 8) + bx / 8 : bx; }
    F.a = &args; F.ws = args.ws;
    volatile LAS unsigned* MISC = (volatile LAS unsigned*)(F.lds + MISC_OFF);
    for (int u = F.tid; u < (LDS_BYTES - LDSCTL_OFF) / 4; u += NTHR) ((LAS unsigned*)(F.lds + LDSCTL_OFF))[u] = 0u;
    __syncthreads();
    gu32* ctl = (gu32*)(F.ws + WS_CTL);
    XcdBarrier bar; bar.bar = (unsigned*)(ctl + CW_BAR); bar.x = 0; bar.st = nullptr;
#if !MK_SPLIT
    bar = xcd_barrier_post((unsigned*)(ctl + CW_BAR), MISC + 8);
#endif
    const int lo = args.ph_lo, hi = args.ph_hi;
    int ph = 0;
#if MK_SPLIT
#define SEAM() do { } while (0)
#else
#define SEAM() do { if (ph + 1 < hi) xcd_barrier(bar); } while (0)
#endif
#ifndef PHSEL
#define PHSEL -1
#endif
#ifndef PHMASK
#define PHMASK 0x7fff
#endif
#define PHASE_BEGIN(id) if ((PHSEL < 0 || PHSEL == (id)) && ((PHMASK >> (id)) & 1) && lo <= ph && ph < hi) { { int t_ = threadIdx.x; asm volatile("" : "+v"(t_)); F.tid = t_; F.lane = t_ & 63; F.wave = __builtin_amdgcn_readfirstlane(t_ >> 6); }
#define PHASE_END   SEAM(); } ++ph;

    PHASE_BEGIN(0) p0_phase(F); PHASE_END
    PHASE_BEGIN(1) p1_phase(F); PHASE_END
#pragma unroll 1
    for (int l = 0; l < 2; ++l) {
        const float* xin = (l == 0) ? (const float*)args.in[0] : (const float*)args.out;
        PHASE_BEGIN(2) {
            pg8::Gemm g{WSP(bf16_t, WS_XN), WSP(bf16_t, WS_WIN) + (size_t)l * DINP * 1024, MTOK, DINP, 1024}; pg8::StaticOrder S; S.init(MTOK, DINP, F.G, (int)blockIdx.x);
            pg8::EpiBf16 E{WSP(bf16_t, WS_U), DINP, DINP / 256};
            pg8::gemm_phase<pg8::EpiBf16, pg8::StaticOrder, true, true>(F.lds, g, S, E, F.tid);
        } PHASE_END
        PHASE_BEGIN(3) {
#ifndef SUBSEL
#define SUBSEL 0
#endif
            if (SUBSEL == 0 || SUBSEL == 1) for (int it = F.vcu; it < 1024; it += F.G) ml_local_item(F, it, l);
            if (SUBSEL == 0 || SUBSEL == 2) mla_prep_rows(F, l);
            if (SUBSEL == 0 || SUBSEL == 3) for (int c = F.vcu; c < 256; c += F.G) hyena_item(F, c, l);
        } PHASE_END
        PHASE_BEGIN(4) {
            pg8::Gemm g{WSP(bf16_t, WS_AMLA), WSP(bf16_t, WS_WMLA) + (size_t)l * 1024 * 384, MTOK, 1024, 384}; pg8::StaticOrder S; S.init(MTOK, 1024, F.G, (int)blockIdx.x);
            pg8::EpiBf16 E{WSP(bf16_t, WS_OMLA), 1024, 4};
            if (SUBSEL == 0 || SUBSEL == 1) pg8::gemm_phase<pg8::EpiBf16, pg8::StaticOrder, true, true>(F.lds, g, S, E, F.tid);
            if (SUBSEL == 0 || SUBSEL == 2) ml_scan(F);
        } PHASE_END
        PHASE_BEGIN(5) relayout_phase(F); PHASE_END
        PHASE_BEGIN(6) {
            if (SUBSEL == 0 || SUBSEL == 1) for (int u = F.vcu; u < 256; u += F.G) attn_unit(F, u >> 5, u & 31);
            if (SUBSEL == 0 || SUBSEL == 2) for (int p = F.vcu; p < 512; p += F.G) ml_out_pair(F, p, l);
        } PHASE_END
        PHASE_BEGIN(7) headnorm_phase(F, l); PHASE_END
        PHASE_BEGIN(8) {
            pg8::Gemm g{WSP(bf16_t, WS_YN), WSP(bf16_t, WS_WOUT) + (size_t)l * 1024 * 1024, MTOK, 1024, 1024}; pg8::StaticOrder S; S.init(MTOK, 1024, F.G, (int)blockIdx.x);
            pg8::EpiF32 E{WSP(float, WS_Y2), 1024};
            pg8::gemm_phase<pg8::EpiF32, pg8::StaticOrder, true, true>(F.lds, g, S, E, F.tid);
        } PHASE_END
        PHASE_BEGIN(9) post_mixer_phase(F, l, xin); PHASE_END
        PHASE_BEGIN(10) { for (int it = F.vcu; it < 32; it += F.G) topk_item(F, it); } PHASE_END
        PHASE_BEGIN(11) gather_phase(F); PHASE_END
        PHASE_BEGIN(12) {
            pg8::Gemm g{WSP(bf16_t, WS_XE), WSP(bf16_t, WS_WGU) + (size_t)l * NEXP * 4096 * 1024, NEXP * 2048, NEXP * 4096, 1024}; pg8::GroupedOrder S; S.init(16, F.G, (int)blockIdx.x);
            pg8::EpiSwiGLU E{WSP(bf16_t, WS_ACT), EFF};
            pg8::gemm_phase<pg8::EpiSwiGLU, pg8::GroupedOrder, true, true>(F.lds, g, S, E, F.tid);
        } PHASE_END
        PHASE_BEGIN(13) {
            pg8::Gemm g{WSP(bf16_t, WS_ACT), WSP(bf16_t, WS_WDN) + (size_t)l * NEXP * 1024 * 2048, NEXP * 2048, NEXP * 1024, 2048}; pg8::GroupedOrder S; S.init(4, F.G, (int)blockIdx.x);
            pg8::EpiBf16 E{WSP(bf16_t, WS_YE), 1024, 4};
            pg8::gemm_phase<pg8::EpiBf16, pg8::GroupedOrder, true, true>(F.lds, g, S, E, F.tid);
        } PHASE_END
        PHASE_BEGIN(14) combine_phase(F, l); PHASE_END
    }
}

extern "C" void kernel_launch(void* const* d_in, const int* in_sizes, int n_in, void* d_out, int out_size, void* d_ws, size_t ws_size, hipStream_t stream) {
    static int grid = 0;
    if (grid == 0) {
        if (n_in != 35 || out_size != MTOK * DM || ws_size < WS_END) { fprintf(stderr, "kernel_launch: unexpected shapes: n_in %d out %d ws %zu (need %zu)\n", n_in, out_size, ws_size, (size_t)WS_END); grid = -1; return; }
        int dev = 0, cus = 0, per_cu = 0;
        if (hipGetDevice(&dev) != hipSuccess || hipDeviceGetAttribute(&cus, hipDeviceAttributeMultiprocessorCount, dev) != hipSuccess) { grid = -1; return; }
        if (hipFuncSetAttribute((const void*)mega_fwd, hipFuncAttributeMaxDynamicSharedMemorySize, LDS_BYTES) != hipSuccess) { fprintf(stderr, "kernel_launch: hipFuncSetAttribute failed\n"); grid = -1; return; }
        (void)hipOccupancyMaxActiveBlocksPerMultiprocessor(&per_cu, (const void*)mega_fwd, NTHR, LDS_BYTES);
        (void)hipGetLastError();
        grid = cus > 0 ? cus : 256;
        if (per_cu < 1) fprintf(stderr, "kernel_launch: occupancy query reports %d\n", per_cu);
    }
    if (grid < 0) return;
    (void)hipMemsetAsync((char*)d_ws + WS_CTL, 0, CTL_ZERO_BYTES, stream);
    Args a{};
    for (int i = 0; i < 35; ++i) a.in[i] = d_in[i];
    a.out = (float*)d_out; a.ws = (unsigned char*)d_ws;
#if MK_SPLIT
    for (int p = 0; p < N_PHASES; ++p) { a.ph_lo = p; a.ph_hi = p + 1; hipLaunchKernelGGL(mega_fwd, dim3(grid), dim3(NTHR), LDS_BYTES, stream, a); }
#else
    a.ph_lo = 0; a.ph_hi = N_PHASES;
    hipLaunchKernelGGL(mega_fwd, dim3(grid), dim3(NTHR), LDS_BYTES, stream, a);
#endif
}
```

```cpp
#include <hip/hip_runtime.h>
#include <cstdio>
#include <cstdint>

#ifndef MK_SPLIT
#define MK_SPLIT 0
#endif

#define GAS __attribute__((address_space(1)))
#define LAS __attribute__((address_space(3)))
typedef GAS unsigned gu32;
#define RLX_AGENT __ATOMIC_RELAXED, __HIP_MEMORY_SCOPE_AGENT
typedef unsigned short bf16_t;
typedef short bf16x8 __attribute__((ext_vector_type(8)));
typedef short s16x4 __attribute__((ext_vector_type(4)));
typedef float f32x4 __attribute__((ext_vector_type(4)));
typedef float f32x2 __attribute__((ext_vector_type(2)));
typedef float f32x16 __attribute__((ext_vector_type(16)));
typedef unsigned u32x4 __attribute__((ext_vector_type(4)));
typedef unsigned u32x2 __attribute__((ext_vector_type(2)));
typedef __bf16 bf16x2_t __attribute__((ext_vector_type(2)));

namespace pg8 {
#define PG8_LAS __attribute__((address_space(3)))
constexpr int BM = 256, BK = 64, HALF = 128, HTB = HALF * BK * 2, STAGE_BYTES = 8 * HTB, NXCD = 8, WGM = 8;
__host__ __device__ __forceinline__ int lds_byte(int r, int c) { const int st = (r >> 4) * 2 + (c >> 5), rr = r & 15, cc = c & 31, ob = rr * 64 + cc * 2; return st * 1024 + (ob ^ (((ob >> 9) & 1) << 5)); }
__host__ __device__ __forceinline__ void stage_rc(int b, int& R, int& C) { const int st = b / 1024, sb = b % 1024, swz = sb ^ (((sb >> 9) & 1) << 5); R = (st >> 1) * 16 + swz / 64; C = (st & 1) * 32 + (swz % 64) / 2; }
__host__ __device__ __forceinline__ int perm32(int rho) { const int n = rho >> 4, i = rho & 15; return 8 * (i >> 2) + 4 * n + (i & 3); }
struct Unit { int pm, pn; };
struct Gemm { const bf16_t* A; const bf16_t* Bt; int M, N, K; };
struct StaticOrder {
    int nM, nN, nwg, G, c;
    __host__ __device__ void init(int M, int N, int G_, int c_) { nM = M / BM; nN = N / BM; nwg = nM * nN; G = G_; c = c_; }
    __host__ __device__ bool next(int i, Unit& u) const {
        const long L = (long)i * G + c; if (L >= nwg) return false;
        int wgid = (int)L; { const int q = nwg / NXCD, r = nwg % NXCD, xcd = wgid % NXCD, off = wgid / NXCD; wgid = (xcd < r ? xcd * (q + 1) : r * (q + 1) + (xcd - r) * q) + off; }
        const int nig = WGM * nN, gid = wgid / nig, fm = gid * WGM, gsz = (nM - fm) < WGM ? (nM - fm) : WGM;
        u.pm = fm + ((wgid % nig) % gsz); u.pn = (wgid % nig) / gsz; return true;
    }
    __device__ __forceinline__ void a_ready(const Unit&) const {}
    __device__ __forceinline__ void done(const Unit&) const {}
};
struct GroupedOrder {
    int nNl, total, G, c;
    __host__ __device__ void init(int nNl_, int G_, int c_) { nNl = nNl_; total = 16 * 8 * nNl_; G = G_; c = c_; }
    __host__ __device__ bool next(int i, Unit& u) const {
        const long L = (long)i * G + c; if (L >= total) return false;
        const int per_e = 8 * nNl, e = (int)L / per_e, r = (int)L % per_e;
        u.pm = e * 8 + (r % 8); u.pn = e * nNl + (r / 8); return true;
    }
    __device__ __forceinline__ void a_ready(const Unit&) const {}
    __device__ __forceinline__ void done(const Unit&) const {}
};
__device__ __forceinline__ unsigned cvt_pk_bf16(float lo, float hi) { f32x2 v = {lo, hi}; bf16x2_t b = __builtin_convertvector(v, bf16x2_t); return __builtin_bit_cast(unsigned, b); }

struct EpiBf16 {
    static constexpr bool PERM = true, AFTER_DRAIN = false;
    bf16_t* O; int ldc; int ntn;
    __device__ __forceinline__ void operator()(const f32x4 (&acc)[2][2][4][2], const Unit& u, int wr, int wc, int fr, int fq) const {
        const int row0 = u.pm * BM + wr * 64 + fr; const int colt = (u.pn % ntn) * BM;
        const int col0 = colt + wc * 32 + 8 * fq;
#pragma unroll
        for (int ai = 0; ai < 2; ++ai)
#pragma unroll
            for (int m = 0; m < 4; ++m) { bf16_t* rowp = O + (size_t)(row0 + ai * HALF + m * 16) * ldc + col0;
#pragma unroll
                for (int bj = 0; bj < 2; ++bj) { const f32x4 v0 = acc[ai][bj][m][0], v1 = acc[ai][bj][m][1];
                    u32x4 w; w.x = cvt_pk_bf16(v0[0], v0[1]); w.y = cvt_pk_bf16(v0[2], v0[3]); w.z = cvt_pk_bf16(v1[0], v1[1]); w.w = cvt_pk_bf16(v1[2], v1[3]);
                    *(u32x4*)(rowp + bj * HALF) = w; } }
    }
};
struct EpiF32 {
    static constexpr bool PERM = false, AFTER_DRAIN = false;
    float* O; int ldc;
    __device__ __forceinline__ void operator()(const f32x4 (&acc)[2][2][4][2], const Unit& u, int wr, int wc, int fr, int fq) const {
        const int col0 = u.pn * BM + wc * 32 + 4 * fq;
#pragma unroll
        for (int ai = 0; ai < 2; ++ai)
#pragma unroll
            for (int m = 0; m < 4; ++m) { float* rowp = O + (size_t)(u.pm * BM + ai * HALF + wr * 64 + m * 16 + fr) * ldc + col0;
#pragma unroll
                for (int bj = 0; bj < 2; ++bj)
#pragma unroll
                    for (int n = 0; n < 2; ++n) *(f32x4*)(rowp + bj * HALF + n * 16) = acc[ai][bj][m][n]; }
    }
};
__device__ __forceinline__ float silu_f(float a) { return a * __builtin_amdgcn_rcpf(1.0f + __builtin_amdgcn_exp2f(-1.4426950408889634f * a)); }
struct EpiSwiGLU {
    static constexpr bool PERM = true, AFTER_DRAIN = false;
    bf16_t* O; int ldc;
    __device__ __forceinline__ void operator()(const f32x4 (&acc)[2][2][4][2], const Unit& u, int wr, int wc, int fr, int fq) const {
        const int row0 = u.pm * BM + wr * 64 + fr; const int col0 = (u.pn % 16) * HALF + wc * 32 + 8 * fq;
#pragma unroll
        for (int ai = 0; ai < 2; ++ai)
#pragma unroll
            for (int m = 0; m < 4; ++m) { bf16_t* rowp = O + (size_t)(row0 + ai * HALF + m * 16) * ldc + col0;
                const f32x4 g0 = acc[ai][0][m][0], g1 = acc[ai][0][m][1], u0 = acc[ai][1][m][0], u1 = acc[ai][1][m][1];
                u32x4 w;
                w.x = cvt_pk_bf16(silu_f(g0[0]) * u0[0], silu_f(g0[1]) * u0[1]); w.y = cvt_pk_bf16(silu_f(g0[2]) * u0[2], silu_f(g0[3]) * u0[3]);
                w.z = cvt_pk_bf16(silu_f(g1[0]) * u1[0], silu_f(g1[1]) * u1[1]); w.w = cvt_pk_bf16(silu_f(g1[2]) * u1[2], silu_f(g1[3]) * u1[3]);
                *(u32x4*)rowp = w; }
    }
};

template <class Epi, class Sched, bool ALIGN_EPI = false, bool SP2 = false>
__device__ __forceinline__ void gemm_phase(PG8_LAS unsigned char* lds, const Gemm g, const Sched& S, const Epi& E, const int tid) {
    const int wid = __builtin_amdgcn_readfirstlane(tid >> 6), lane = tid & 63, wr = wid >> 2, wc = wid & 3, fr = lane & 15, fq = lane >> 4;
    int K_ = g.K; asm volatile("" : "+s"(K_));
    const int K = K_, nt = K / BK;
    unsigned voffA[2], voffB[2];
#pragma unroll
    for (int i = 0; i < 2; ++i) { int R, C; stage_rc(tid * 16 + i * 8192, R, C); const int Rb = Epi::PERM ? ((R & ~31) + perm32(R & 31)) : R;
        voffA[i] = (unsigned)(R * K + C) * 2u; voffB[i] = (unsigned)(Rb * K + C) * 2u; }
    const size_t kstep = (size_t)(BK * 2);
    const size_t hstep = (size_t)HALF * K * 2;
    const size_t tstep = 2 * hstep;
    const unsigned ldsw = (unsigned)wid * 1024u;
    const int aoff = lds_byte(wr * 64 + fr, fq * 8), boff = lds_byte(wc * 32 + fr, fq * 8);
#define PG8_SA(b, h) (((b) * 2 + (h)) * HTB)
#define PG8_SB(b, h) ((4 + (b) * 2 + (h)) * HTB)
#define PG8_STAGE(bufoff, gbase, voff) do { _Pragma("unroll") for (int _i = 0; _i < 2; ++_i) \
        __builtin_amdgcn_global_load_lds((const unsigned*)((const char*)(gbase) + (voff)[_i]), (PG8_LAS unsigned*)(lds + (bufoff) + ldsw + _i * 8192), 16, 0, 0); } while (0)
#define PG8_LDA(dst, b, h) do { _Pragma("unroll") for (int m = 0; m < 4; ++m) _Pragma("unroll") for (int k = 0; k < 2; ++k) dst[m][k] = *(const PG8_LAS bf16x8*)(lds + PG8_SA(b, h) + aoff + m * 2048 + k * 1024); } while (0)
#define PG8_LDB(dst, b, h) do { _Pragma("unroll") for (int n = 0; n < 2; ++n) _Pragma("unroll") for (int k = 0; k < 2; ++k) dst[n][k] = *(const PG8_LAS bf16x8*)(lds + PG8_SB(b, h) + boff + n * 2048 + k * 1024); } while (0)
#define PG8_MMA(ai, bj, At, Bt) do { __builtin_amdgcn_s_setprio(1); _Pragma("unroll") for (int m = 0; m < 4; ++m) _Pragma("unroll") for (int n = 0; n < 2; ++n) _Pragma("unroll") for (int k = 0; k < 2; ++k) \
        acc[ai][bj][m][n] = __builtin_amdgcn_mfma_f32_16x16x32_bf16(Bt[n][k], At[m][k], acc[ai][bj][m][n], 0, 0, 0); __builtin_amdgcn_s_setprio(0); } while (0)
#define PG8_WAIT_V(n) asm volatile("s_waitcnt vmcnt(" #n ")" ::: "memory")
#define PG8_WAIT_L(n) asm volatile("s_waitcnt lgkmcnt(" #n ")" ::: "memory")
#define PG8_BAR __builtin_amdgcn_s_barrier()
#define PG8_SCHED __builtin_amdgcn_sched_barrier(0)
    Unit cur, nxt; int ui = 0;
    if (!S.next(0, cur)) return;
    f32x4 acc[2][2][4][2];
#pragma unroll
    for (int a = 0; a < 2; ++a)
#pragma unroll
        for (int b = 0; b < 2; ++b)
#pragma unroll
            for (int m = 0; m < 4; ++m)
#pragma unroll
                for (int n = 0; n < 2; ++n) acc[a][b][m][n] = (f32x4){0.f, 0.f, 0.f, 0.f};
    bf16x8 At[4][2], B0[2][2], B1[2][2];
    const char* cA = (const char*)g.A + (size_t)cur.pm * tstep; const char* cB = (const char*)g.Bt + (size_t)cur.pn * tstep;
    S.a_ready(cur);
    if constexpr (SP2) {
        PG8_STAGE(PG8_SB(0, 0), cB, voffB); PG8_STAGE(PG8_SB(0, 1), cB + hstep, voffB); PG8_STAGE(PG8_SA(0, 0), cA, voffA); PG8_STAGE(PG8_SA(0, 1), cA + hstep, voffA);
        if (wr == 1) PG8_BAR;
        PG8_WAIT_V(2); PG8_BAR;
        PG8_STAGE(PG8_SB(1, 0), cB + kstep, voffB); PG8_STAGE(PG8_SA(1, 0), cA + kstep, voffA); PG8_STAGE(PG8_SB(1, 1), cB + hstep + kstep, voffB);
        PG8_WAIT_V(6); PG8_BAR;
    } else {
        PG8_STAGE(PG8_SB(0, 0), cB, voffB); PG8_STAGE(PG8_SA(0, 0), cA, voffA); PG8_STAGE(PG8_SB(0, 1), cB + hstep, voffB); PG8_STAGE(PG8_SA(0, 1), cA + hstep, voffA);
        if (wr == 1) PG8_BAR;
        PG8_WAIT_V(4); PG8_BAR;
        PG8_STAGE(PG8_SB(1, 0), cB + kstep, voffB); PG8_STAGE(PG8_SA(1, 0), cA + kstep, voffA); PG8_STAGE(PG8_SB(1, 1), cB + hstep + kstep, voffB);
        PG8_WAIT_V(6); PG8_BAR;
    }
    for (;;) {
        const bool has_next = S.next(ui + 1, nxt);
        const char* nA = has_next ? (const char*)g.A + (size_t)nxt.pm * tstep : cA; const char* nB = has_next ? (const char*)g.Bt + (size_t)nxt.pn * tstep : cB;
        for (int t = 0; t < nt; t += 2) {
            const bool last = (t == nt - 2);
            const char* a1 = cA + (size_t)(t + 1) * kstep;
            const char* a2 = last ? nA : cA + (size_t)(t + 2) * kstep; const char* b2 = last ? nB : cB + (size_t)(t + 2) * kstep;
            const char* a3 = a2 + kstep; const char* b3 = b2 + kstep;
            if (last && has_next) S.a_ready(nxt);
            if constexpr (SP2) {
            PG8_LDB(B0, 0, 0); PG8_LDB(B1, 0, 1); PG8_SCHED; PG8_LDA(At, 0, 0); PG8_STAGE(PG8_SA(1, 1), a1 + hstep, voffA);
            PG8_WAIT_V(8); PG8_WAIT_L(0); PG8_BAR; PG8_MMA(0, 0, At, B0); PG8_MMA(0, 1, At, B1); PG8_BAR; PG8_SCHED;
            PG8_LDA(At, 0, 1); PG8_STAGE(PG8_SB(0, 0), b2, voffB); PG8_STAGE(PG8_SB(0, 1), b2 + hstep, voffB); PG8_STAGE(PG8_SA(0, 0), a2, voffA);
            PG8_WAIT_V(8); PG8_WAIT_L(0); PG8_BAR; PG8_MMA(1, 0, At, B0); PG8_MMA(1, 1, At, B1); PG8_BAR; PG8_SCHED;
            PG8_LDB(B0, 1, 0); PG8_LDB(B1, 1, 1); PG8_SCHED; PG8_LDA(At, 1, 0); PG8_STAGE(PG8_SA(0, 1), a2 + hstep, voffA);
            PG8_WAIT_V(8); PG8_WAIT_L(0); PG8_BAR; PG8_MMA(0, 0, At, B0); PG8_MMA(0, 1, At, B1); PG8_BAR; PG8_SCHED;
            PG8_LDA(At, 1, 1); PG8_STAGE(PG8_SB(1, 0), b3, voffB); PG8_STAGE(PG8_SB(1, 1), b3 + hstep, voffB); PG8_STAGE(PG8_SA(1, 0), a3, voffA);
            PG8_WAIT_V(8); PG8_WAIT_L(0); PG8_BAR; PG8_MMA(1, 0, At, B0); PG8_MMA(1, 1, At, B1); PG8_BAR; PG8_SCHED;
            } else {
            PG8_LDB(B0, 0, 0); PG8_SCHED; PG8_LDA(At, 0, 0); PG8_STAGE(PG8_SA(1, 1), a1 + hstep, voffA);
            PG8_WAIT_L(8); PG8_BAR; PG8_WAIT_L(0); PG8_MMA(0, 0, At, B0); PG8_BAR; PG8_SCHED;
            PG8_LDB(B1, 0, 1); PG8_STAGE(PG8_SB(0, 0), b2, voffB);
            PG8_BAR; PG8_WAIT_L(0); PG8_MMA(0, 1, At, B1); PG8_BAR;
            PG8_LDA(At, 0, 1); PG8_STAGE(PG8_SA(0, 0), a2, voffA);
            PG8_BAR; PG8_WAIT_L(0); PG8_MMA(1, 0, At, B0); PG8_BAR; PG8_SCHED;
            PG8_STAGE(PG8_SB(0, 1), b2 + hstep, voffB);
            PG8_WAIT_V(6); PG8_BAR; PG8_MMA(1, 1, At, B1); PG8_BAR;
            PG8_LDB(B0, 1, 0); PG8_SCHED; PG8_LDA(At, 1, 0); PG8_STAGE(PG8_SA(0, 1), a2 + hstep, voffA);
            PG8_WAIT_L(8); PG8_BAR; PG8_WAIT_L(0); PG8_MMA(0, 0, At, B0); PG8_BAR; PG8_SCHED;
            PG8_LDB(B1, 1, 1); PG8_STAGE(PG8_SB(1, 0), b3, voffB);
            PG8_BAR; PG8_WAIT_L(0); PG8_MMA(0, 1, At, B1); PG8_BAR;
            PG8_LDA(At, 1, 1); PG8_STAGE(PG8_SA(1, 0), a3, voffA);
            PG8_BAR; PG8_WAIT_L(0); PG8_MMA(1, 0, At, B0); PG8_BAR; PG8_SCHED;
            PG8_STAGE(PG8_SB(1, 1), b3 + hstep, voffB);
            PG8_WAIT_V(6); PG8_BAR; PG8_MMA(1, 1, At, B1); PG8_BAR;
            }
        }
        if constexpr (ALIGN_EPI) { if (wr == 0) PG8_BAR; }
        if constexpr (!Epi::AFTER_DRAIN) { E(acc, cur, wr, wc, fr, fq); S.done(cur); }
        if (!has_next) break;
#pragma unroll
        for (int a = 0; a < 2; ++a)
#pragma unroll
            for (int b = 0; b < 2; ++b)
#pragma unroll
                for (int m = 0; m < 4; ++m)
#pragma unroll
                    for (int n = 0; n < 2; ++n) acc[a][b][m][n] = (f32x4){0.f, 0.f, 0.f, 0.f};
        cur = nxt; cA = nA; cB = nB; ++ui;
        if constexpr (ALIGN_EPI) { if (wr == 1) PG8_BAR; }
    }
    PG8_WAIT_V(0);
    if constexpr (!ALIGN_EPI) { if (wr == 0) PG8_BAR; }
    PG8_BAR;
#undef PG8_SA
#undef PG8_SB
#undef PG8_STAGE
#undef PG8_LDA
#undef PG8_LDB
#undef PG8_MMA
#undef PG8_WAIT_V
#undef PG8_WAIT_L
#undef PG8_BAR
#undef PG8_SCHED
}
}

constexpr int NWAVES = 8, NTHR = 512;
constexpr int BATCH = 2, SEQ = 8192, DM = 1024, MTOK = BATCH * SEQ;
constexpr int DIN = 2960, DINP = 3072;
constexpr int NEXP = 16, CAP = 1024, EFF = 2048;
constexpr float EPS = 1e-6f;
constexpr int U_MLQ = 0, U_MLK = 256, U_MLV = 512, U_MLO = 768, U_MLG = 1024, U_CQ = 1040, U_CKV = 1264, U_KR = 1392, U_HY = 1424, U_SC = 2192;
constexpr float LOG2E = 1.4426950408889634f;

constexpr size_t MiB = 1u << 20;
constexpr size_t WS_CTL = 0, CTL_ZERO_BYTES = 1 * MiB;
constexpr size_t WS_MOD = 1 * MiB;
constexpr size_t WS_MLS = 1 * MiB + 128 * 1024;
constexpr size_t WS_MLN = 1 * MiB + 256 * 1024;
constexpr size_t WS_AFF = 2 * MiB;
constexpr size_t WS_SLOT = 3 * MiB;
constexpr size_t WS_IDX = 4 * MiB;
constexpr size_t WS_HID = 5 * MiB;
constexpr size_t WS_WMLA = 9 * MiB;
constexpr size_t WS_WOUT = 11 * MiB;
constexpr size_t WS_WIN = 15 * MiB;
constexpr size_t WS_WGU = 28 * MiB;
constexpr size_t WS_WDN = 284 * MiB;
constexpr size_t WS_XN = 412 * MiB;
constexpr size_t WS_AMLA = 444 * MiB;
constexpr size_t WS_Q = 456 * MiB;
constexpr size_t WS_KIMG = 468 * MiB;
constexpr size_t WS_VIMG = 480 * MiB;
constexpr size_t WS_MLC = 488 * MiB;
constexpr size_t WS_HF = 504 * MiB;
constexpr size_t WS_HB = 520 * MiB;
constexpr size_t WS_YMIX = 536 * MiB;
constexpr size_t WS_YN = 552 * MiB;
constexpr size_t WS_X1 = 584 * MiB;
constexpr size_t WS_U = 648 * MiB;
constexpr size_t WS_OMLA = 744 * MiB;
constexpr size_t WS_ACT = 648 * MiB;
constexpr size_t WS_KF = 776 * MiB;
constexpr size_t WS_Y2 = 776 * MiB;
constexpr size_t WS_XE = 776 * MiB;
constexpr size_t WS_YE = 840 * MiB;
constexpr size_t WS_END = 904 * MiB;
constexpr int CW_BAR = 4096;

constexpr int RING_BYTES = 131072;
constexpr int LDSCTL_OFF = RING_BYTES, MISC_OFF = LDSCTL_OFF + 320;
constexpr int XTRA_OFF = RING_BYTES + 1024;
constexpr int LDS_BYTES = 147456;

__device__ __forceinline__ float bf2f(unsigned short u) { return __uint_as_float((unsigned)u << 16); }
__device__ __forceinline__ unsigned pk2(float lo, float hi) { f32x2 v = {lo, hi}; bf16x2_t b = __builtin_convertvector(v, bf16x2_t); return __builtin_bit_cast(unsigned, b); }
__device__ __forceinline__ float bflo(unsigned w) { return __uint_as_float(w << 16); }
__device__ __forceinline__ float bfhi(unsigned w) { return __uint_as_float(w & 0xffff0000u); }
__device__ __forceinline__ float wave_sum(float v) {
#pragma unroll
    for (int o = 1; o < 64; o <<= 1) v += __shfl_xor(v, o);
    return v;
}
__device__ __forceinline__ float fexp(float x) { return __builtin_amdgcn_exp2f(x * LOG2E); }
__device__ __forceinline__ float flog(float x) { return __builtin_amdgcn_logf(x) * 0.6931471805599453f; }
__device__ __forceinline__ float sin_rev(float r) { return __builtin_amdgcn_sinf(r); }
__device__ __forceinline__ float cos_rev(float r) { return __builtin_amdgcn_cosf(r); }
__device__ __forceinline__ float sin_rad(float x) { float r = x * 0.15915494309189535f; r = r - __builtin_rintf(r); return __builtin_amdgcn_sinf(r); }
__device__ __forceinline__ int crow(int r, int hi) { return (r & 3) + 8 * (r >> 2) + 4 * hi; }
#define LDS_WAIT() asm volatile("s_waitcnt lgkmcnt(0)" ::: "memory")
#define VM_WAIT() asm volatile("s_waitcnt vmcnt(0)" ::: "memory")

#define XB_TMO      128
#define XB_XCNT(j)  (256  + 64 * (j))
#define XB_XSUB(j)  (1280 + 64 * (j))
#define XB_XGEN(j)  (2304 + 64 * (j))
#define XB_TOP      3328
#define XB_TOPGEN   3392
#define XCD_BAR_WORDS 3456
#define XB_SPIN_CAP (1u << 18)
__device__ __forceinline__ unsigned xb_ld(unsigned* p)              { return __hip_atomic_load(p, __ATOMIC_RELAXED, __HIP_MEMORY_SCOPE_AGENT); }
__device__ __forceinline__ unsigned xb_add(unsigned* p, unsigned v) { return __hip_atomic_fetch_add(p, v, __ATOMIC_RELAXED, __HIP_MEMORY_SCOPE_AGENT); }
__device__ __forceinline__ unsigned xb_xcc_id() { return (unsigned)__builtin_amdgcn_s_getreg((3 << 11) | 20) & 0xFu; }
#define XB_SPIN(cond, bar) do { unsigned _sp = 0; while (cond) { __builtin_amdgcn_s_sleep(1); \
    if ((++_sp & 255u) == 0u) { if (xb_ld(&(bar)[XB_TMO])) break; if (_sp > XB_SPIN_CAP) { atomicAdd(&(bar)[XB_TMO], 1u); break; } } } } while (0)
struct XcdBarrier { unsigned* bar; unsigned x; volatile LAS unsigned* st; };
__device__ __forceinline__ XcdBarrier xcd_barrier_post(unsigned* bar, volatile LAS unsigned* st) {
    XcdBarrier b; b.bar = bar; b.x = xb_xcc_id(); b.st = st;
    if (threadIdx.x == 0) (void)xb_add(&bar[XB_XCNT(b.x)], 1u);
    return b;
}
__device__ __forceinline__ void xcd_barrier_complete(unsigned* bar, unsigned x, unsigned& nloc, unsigned& nx) {
    const unsigned G = gridDim.x * gridDim.y * gridDim.z;
    unsigned sum, cnt, mine, sp = 0u;
    for (;;) {
        sum = 0u; cnt = 0u; mine = 0u;
#pragma unroll
        for (unsigned j = 0; j < 16; ++j) { const unsigned c = xb_ld(&bar[XB_XCNT(j)]); sum += c; cnt += (c > 0u) ? 1u : 0u; mine = (j == x) ? c : mine; }
        if (sum == G) break;
        __builtin_amdgcn_s_sleep(1);
        if ((++sp & 255u) == 0u) { if (xb_ld(&bar[XB_TMO])) break; if (sp > XB_SPIN_CAP) { atomicAdd(&bar[XB_TMO], 1u); break; } }
    }
    nloc = mine > 0u ? mine : 1u; nx = cnt > 0u ? cnt : 1u;
}
__device__ __forceinline__ void xcd_barrier(const XcdBarrier& b) {
    asm volatile("s_waitcnt vmcnt(0)" ::: "memory");
    __syncthreads();
    if (threadIdx.x == 0) {
        unsigned* bar = b.bar;
        __builtin_amdgcn_s_waitcnt(0);
        unsigned nloc = b.st[0], nx = b.st[1];
        if (nloc == 0u) { xcd_barrier_complete(bar, b.x, nloc, nx); b.st[0] = nloc; b.st[1] = nx; }
        const unsigned old = xb_add(&bar[XB_XSUB(b.x)], 1u);
        const unsigned gen = old / nloc;
        if (old + 1u == (gen + 1u) * nloc) {
            __builtin_amdgcn_fence(__ATOMIC_RELEASE, "agent");
            asm volatile("s_waitcnt vmcnt(0)" ::: "memory");
            const unsigned og = xb_add(&bar[XB_TOP], 1u);
            const unsigned tg = og / nx;
            if (og + 1u == (tg + 1u) * nx) xb_add(&bar[XB_TOPGEN], 1u);
            else XB_SPIN(xb_ld(&bar[XB_TOPGEN]) == tg, bar);
            __builtin_amdgcn_fence(__ATOMIC_ACQUIRE, "agent");
            xb_add(&bar[XB_XGEN(b.x)], 1u);
            asm volatile("s_waitcnt vmcnt(0)" ::: "memory");
        } else {
            XB_SPIN(xb_ld(&bar[XB_XGEN(b.x)]) == gen, bar);
            __builtin_amdgcn_fence(__ATOMIC_ACQUIRE, "agent");
            asm volatile("s_waitcnt vmcnt(0)" ::: "memory");
        }
    }
    __syncthreads();
}

struct Args { const void* in[35]; float* out; unsigned char* ws; int ph_lo, ph_hi; };
struct Frame {
    LAS unsigned char* lds;
    int tid, lane, wave, vcu, G;
    const Args* a;
    unsigned char* ws;
};
#define INF(i) ((const float*)F.a->in[i])
#define WSP(T, off) ((T*)(F.ws + (off)))

__device__ __forceinline__ void tr_item(const float* W, int ldw, int Kvalid, int Nvalid, int k0, int n0, bf16_t* dst, int dpitch, int drow0, int dk0, LAS float* scr, int lane) {
    f32x4 v[16];
    const int nn = n0 + 4 * (lane & 15);
#pragma unroll
    for (int i = 0; i < 16; ++i) { const int kk = 4 * i + (lane >> 4);
        v[i] = (f32x4){0.f, 0.f, 0.f, 0.f};
        if (W != nullptr && (k0 + kk) < Kvalid && nn < Nvalid) v[i] = *(const GAS f32x4*)(W + (size_t)(k0 + kk) * ldw + nn); }
#pragma unroll
    for (int i = 0; i < 16; ++i) { const int kk = 4 * i + (lane >> 4);
        *(LAS f32x4*)(scr + kk * 64 + ((4 * (lane & 15)) ^ (4 * ((kk >> 3) & 7)))) = v[i]; }
    LDS_WAIT(); asm volatile("" ::: "memory");
    const int kc = lane & 7, nl = lane >> 3;
#pragma unroll
    for (int j = 0; j < 8; ++j) { const int n = 8 * j + nl; const LAS float* sp = scr + (8 * kc) * 64 + (n ^ (4 * kc));
        u32x4 o; o.x = pk2(sp[0 * 64], sp[1 * 64]); o.y = pk2(sp[2 * 64], sp[3 * 64]); o.z = pk2(sp[4 * 64], sp[5 * 64]); o.w = pk2(sp[6 * 64], sp[7 * 64]);
        *(GAS u32x4*)(dst + (size_t)(drow0 + n) * dpitch + dk0 + k0 + 8 * kc) = o; }
    LDS_WAIT(); asm volatile("" ::: "memory");
}

__device__ __forceinline__ void p0_phase(Frame& F) {
    const int tid = F.tid, lane = F.lane, wave = F.wave;
    {
        LAS float* cs = (LAS float*)(F.lds);
        LAS float* red = (LAS float*)(F.lds + 8192);
        const float* c = INF(1);
        for (int i = tid; i < 2048; i += NTHR) { const float v = c[i]; cs[i] = v / (1.0f + fexp(-v)); }
        __syncthreads();
        for (int cb = blockIdx.x; cb < 256; cb += F.G) {
            const int j = tid % 48, kg = tid / 48;
            const int col = cb * 48 + j, l = col / 6144, n = col % 6144;
            if (kg < 10) {
                const float* w = INF(3) + (size_t)l * 1024 * 6144 + n;
                float a0 = 0.f, a1 = 0.f;
#pragma unroll 4
                for (int k = kg; k < 1024; k += 10) { const float wv = w[(size_t)k * 6144]; a0 += cs[k] * wv; a1 += cs[1024 + k] * wv; }
                red[(kg * 48 + j) * 2] = a0; red[(kg * 48 + j) * 2 + 1] = a1;
            }
            __syncthreads();
            if (tid < 96) { const int jj = tid >> 1, b = tid & 1; float s = 0.f;
                for (int g = 0; g < 10; ++g) s += red[(g * 48 + jj) * 2 + b];
                const int col2 = cb * 48 + jj, l2 = col2 / 6144, n2 = col2 % 6144;
                WSP(float, WS_MOD)[(l2 * 2 + b) * 6144 + n2] = s + INF(4)[l2 * 6144 + n2]; }
            __syncthreads();
        }
    }
    {
        const int gw = F.vcu * NWAVES + wave, NGW = F.G * NWAVES;
        for (int l = 0; l < 2; ++l) {
            const float* w1 = INF(18) + l * 17 * 64; const float* w2 = INF(21) + l * 64 * 64;
            float w1c[17], w2c[64];
#pragma unroll
            for (int i = 0; i < 17; ++i) w1c[i] = w1[i * 64 + lane];
#pragma unroll
            for (int k = 0; k < 64; ++k) w2c[k] = w2[k * 64 + lane];
            const float b1 = INF(19)[l * 64 + lane], fr1 = INF(20)[l * 64 + lane], b2 = INF(22)[l * 64 + lane], fr2 = INF(23)[l * 64 + lane];
            for (int t = gw; t < SEQ; t += NGW) {
                const float tt = (float)t * (1.0f / SEQ);
                float a = b1 + tt * w1c[0];
#pragma unroll
                for (int bnd = 1; bnd <= 8; ++bnd) { float r = (float)((t * bnd) & (SEQ - 1)) * (1.0f / SEQ); a += sin_rev(r) * w1c[bnd] + cos_rev(r) * w1c[8 + bnd]; }
                const float h1 = sin_rad(fr1 * a);
                float a2 = b2;
#pragma unroll
                for (int k = 0; k < 64; ++k) a2 += __shfl(h1, k) * w2c[k];
                WSP(float, WS_HID)[((size_t)l * SEQ + t) * 64 + lane] = sin_rad(fr2 * a2);
            }
        }
    }
    {
        LAS float* scr = (LAS float*)(F.lds + wave * 16384);
        const int gw = F.vcu * NWAVES + wave, NGW = F.G * NWAVES;
        constexpr int I_WIN = 16 * 48, I_WOUT = 16 * 16, I_WMLA = 6 * 16, I_GU = 16 * 2 * 16 * 32, I_DN = 16 * 32 * 16;
        constexpr int I_LAYER = I_WIN + I_WOUT + I_WMLA + I_GU + I_DN;
        for (int it = gw; it < 2 * I_LAYER; it += NGW) {
            const int l = it / I_LAYER; int r = it % I_LAYER;
            if (r < I_WIN) { const int kb = r / 48, nb = r % 48;
                tr_item(INF(9) + (size_t)l * 1024 * DIN, DIN, 1024, DIN, kb * 64, nb * 64, WSP(bf16_t, WS_WIN) + (size_t)l * DINP * 1024, 1024, nb * 64, 0, scr, lane); continue; }
            r -= I_WIN;
            if (r < I_WOUT) { const int kb = r / 16, nb = r % 16;
                tr_item(INF(30) + (size_t)l * 1024 * 1024, 1024, 1024, 1024, kb * 64, nb * 64, WSP(bf16_t, WS_WOUT) + (size_t)l * 1024 * 1024, 1024, nb * 64, 0, scr, lane); continue; }
            r -= I_WOUT;
            if (r < I_WMLA) { const int kb = r / 16, nb = r % 16;
                bf16_t* dst = WSP(bf16_t, WS_WMLA) + (size_t)l * 1024 * 384;
                const float* W = nullptr; int ldw = 4, Kv = 0, Nv = 0, ksrc = 0, nsrc = 0;
                if (nb < 6 && kb < 4) { W = INF(13) + (size_t)l * 224 * 384; ldw = 384; Kv = 224; Nv = 384; ksrc = kb * 64; nsrc = nb * 64; }
                else if (nb >= 6 && nb < 10 && kb >= 4) { W = INF(14) + (size_t)l * 128 * 256; ldw = 256; Kv = 128; Nv = 256; ksrc = (kb - 4) * 64; nsrc = (nb - 6) * 64; }
                else if (nb >= 10 && nb < 14 && kb >= 4) { W = INF(15) + (size_t)l * 128 * 256; ldw = 256; Kv = 128; Nv = 256; ksrc = (kb - 4) * 64; nsrc = (nb - 10) * 64; }
                tr_item(W, ldw, Kv, Nv, ksrc, nsrc, dst, 384, nb * 64, kb * 64 - ksrc, scr, lane); continue; }
            r -= I_WMLA;
            if (r < I_GU) { const int e = r / (2 * 16 * 32); int q = r % (2 * 16 * 32); const int which = q / (16 * 32); q %= (16 * 32); const int kb = q / 32, nb = q % 32;
                const float* W = INF(which ? 33 : 32) + ((size_t)l * NEXP + e) * 1024 * 2048;
                const int n0 = nb * 64, drow = (n0 >> 7) * 256 + (n0 & 127) + (which ? 128 : 0);
                tr_item(W, 2048, 1024, 2048, kb * 64, n0, WSP(bf16_t, WS_WGU) + ((size_t)l * NEXP + e) * 4096 * 1024, 1024, drow, 0, scr, lane); continue; }
            r -= I_GU;
            { const int e = r / (32 * 16); const int q = r % (32 * 16); const int kb = q / 16, nb = q % 16;
                const float* W = INF(34) + ((size_t)l * NEXP + e) * 2048 * 1024;
                tr_item(W, 1024, 2048, 1024, kb * 64, nb * 64, WSP(bf16_t, WS_WDN) + ((size_t)l * NEXP + e) * 1024 * 2048, 2048, nb * 64, 0, scr, lane); }
        }
    }
}

__device__ __forceinline__ void ld_row_f32(const float* p, int lane, f32x4 (&v)[4]) {
    const GAS f32x4* r = (const GAS f32x4*)p + lane;
#pragma unroll
    for (int j = 0; j < 4; ++j) v[j] = r[64 * j];
}
__device__ __forceinline__ void st_row_f32(float* p, int lane, const f32x4 (&v)[4]) {
    GAS f32x4* r = (GAS f32x4*)p + lane;
#pragma unroll
    for (int j = 0; j < 4; ++j) r[64 * j] = v[j];
}
__device__ __forceinline__ void st_row_bf16(bf16_t* p, int lane, const f32x4 (&v)[4]) {
    GAS u32x2* r = (GAS u32x2*)p + lane;
#pragma unroll
    for (int j = 0; j < 4; ++j) { u32x2 w; w.x = pk2(v[j].x, v[j].y); w.y = pk2(v[j].z, v[j].w); r[64 * j] = w; }
}
__device__ __forceinline__ float row_ss(const f32x4 (&v)[4]) {
    float s = 0.f;
#pragma unroll
    for (int j = 0; j < 4; ++j) s += (v[j].x * v[j].x + v[j].y * v[j].y) + (v[j].z * v[j].z + v[j].w * v[j].w);
    return wave_sum(s);
}
__device__ __forceinline__ void modnorm(const f32x4 (&x)[4], const float* g, const float* sc, const float* sh, int lane, f32x4 (&h)[4]) {
    const float rstd = __builtin_amdgcn_rsqf(row_ss(x) * (1.0f / DM) + EPS);
    f32x4 gv[4], scv[4], shv[4];
    ld_row_f32(g, lane, gv); ld_row_f32(sc, lane, scv); ld_row_f32(sh, lane, shv);
#pragma unroll
    for (int j = 0; j < 4; ++j) h[j] = (x[j] * rstd) * gv[j] * (scv[j] + 1.0f) + shv[j];
}

__device__ __forceinline__ void p1_phase(Frame& F) {
    const int gw = F.vcu * NWAVES + F.wave, NGW = F.G * NWAVES;
    const float* mod = WSP(float, WS_MOD);
    for (int m = gw; m < MTOK; m += NGW) {
        const int b = m >> 13; f32x4 x[4], h[4];
        ld_row_f32(INF(0) + (size_t)m * DM, F.lane, x);
        modnorm(x, INF(5), mod + (0 * 2 + b) * 6144 + 1024, mod + (0 * 2 + b) * 6144, F.lane, h);
        st_row_bf16(WSP(bf16_t, WS_XN) + (size_t)m * DM, F.lane, h);
    }
}

__device__ __forceinline__ float logsigmoid(float x) { return fminf(x, 0.f) - flog(1.0f + fexp(-fabsf(x))); }
struct MlItem { int b, h, dir, n, t0; };
__device__ __forceinline__ MlItem ml_decode(int item) { MlItem I; I.b = item >> 9; I.h = (item >> 7) & 3; I.dir = (item >> 6) & 1; I.n = item & 63;
    I.t0 = I.b * SEQ + (I.dir ? SEQ - 128 * (I.n + 1) : 128 * I.n); return I; }

__device__ __forceinline__ void ml_local_item(Frame& F, int item, int l) {
    const int tid = F.tid; const MlItem I = ml_decode(item);
    const bf16_t* U = WSP(bf16_t, WS_U);
    LAS float* EK = (LAS float*)(F.lds);
    LAS float* VV = (LAS float*)(F.lds + 32768);
    LAS float* LF = (LAS float*)(F.lds + 65536);
    LAS float* IG = LF + 128; LAS float* WW = LF + 256; LAS float* EST = LF + 384;
    const float* gb = INF(10) + l * 16;
    if (tid < 128) { const int j = tid, r = I.dir ? 127 - j : j; const size_t t = (size_t)(I.t0 + r);
        const float ipre = bf2f(U[t * DINP + U_MLG + (I.dir ? 2 : 0) * 4 + I.h]) + gb[(I.dir ? 2 : 0) * 4 + I.h];
        const float fpre = bf2f(U[t * DINP + U_MLG + (I.dir ? 3 : 1) * 4 + I.h]) + gb[(I.dir ? 3 : 1) * 4 + I.h];
        LF[j] = logsigmoid(fpre); IG[j] = ipre; }
    __syncthreads();
    float a = 0.f, aend = 0.f;
    if (tid < 128) { for (int i = 0; i < 128; ++i) { const float v = LF[i]; aend += v; if (i <= tid) a += v; }
        WW[tid] = aend - a + IG[tid]; }
    __syncthreads();
    float mloc = -3.0e38f;
    if (tid < 128) { for (int i = 0; i < 128; ++i) mloc = fmaxf(mloc, WW[i]);
        const int r = I.dir ? 127 - tid : tid; EST[r] = fexp(WW[tid] - mloc); }
    __syncthreads();
#pragma unroll
    for (int i = 0; i < 2; ++i) { const int p = tid + 512 * i, row = p >> 3, c8 = p & 7;
        const u32x4 kq = *(const GAS u32x4*)(U + (size_t)(I.t0 + row) * DINP + U_MLK + I.h * 64 + c8 * 8);
        const u32x4 vq = *(const GAS u32x4*)(U + (size_t)(I.t0 + row) * DINP + U_MLV + I.h * 64 + c8 * 8);
        const float es = EST[row] * 0.125f;
        LAS f32x4* ek = (LAS f32x4*)(EK + row * 64 + c8 * 8); LAS f32x4* vv = (LAS f32x4*)(VV + row * 64 + c8 * 8);
        ek[0] = (f32x4){bflo(kq.x) * es, bfhi(kq.x) * es, bflo(kq.y) * es, bfhi(kq.y) * es};
        ek[1] = (f32x4){bflo(kq.z) * es, bfhi(kq.z) * es, bflo(kq.w) * es, bfhi(kq.w) * es};
        vv[0] = (f32x4){bflo(vq.x), bfhi(vq.x), bflo(vq.y), bfhi(vq.y)};
        vv[1] = (f32x4){bflo(vq.z), bfhi(vq.z), bflo(vq.w), bfhi(vq.w)}; }
    __syncthreads();
    {
        const int d = tid >> 3, e0 = (tid & 7) * 8;
        f32x4 c0 = {0.f, 0.f, 0.f, 0.f}, c1 = {0.f, 0.f, 0.f, 0.f};
#pragma unroll 4
        for (int j = 0; j < 128; ++j) { const float ek = EK[j * 64 + d]; const f32x4 v0 = *(const LAS f32x4*)(VV + j * 64 + e0), v1 = *(const LAS f32x4*)(VV + j * 64 + e0 + 4);
            c0 += v0 * ek; c1 += v1 * ek; }
        GAS f32x4* dst = (GAS f32x4*)(WSP(float, WS_MLC) + (size_t)item * 4096 + d * 64 + e0);
        dst[0] = c0; dst[1] = c1;
        if (tid < 64) { float s = 0.f; for (int j = 0; j < 128; ++j) s += EK[j * 64 + tid]; WSP(float, WS_MLN)[item * 64 + tid] = s; }
        if (tid == 0) { WSP(float, WS_MLS)[item * 4] = mloc; WSP(float, WS_MLS)[item * 4 + 1] = aend; }
    }
    __syncthreads();
}

__device__ __forceinline__ void ml_scan(Frame& F) {
    float* MLC = WSP(float, WS_MLC); float* MLN = WSP(float, WS_MLN); float* MLS = WSP(float, WS_MLS);
    for (int idx = blockIdx.x * NTHR + F.tid; idx < 16 * 4160; idx += F.G * NTHR) {
        const int seq = idx / 4160, el = idx % 4160;
        float mst = 0.f, st = 0.f;
#pragma unroll 4
        for (int n = 0; n < 64; ++n) { const int item = seq * 64 + n;
            const float ml = MLS[item * 4], ae = MLS[item * 4 + 1];
            float* p = el < 4096 ? (MLC + (size_t)item * 4096 + el) : (MLN + item * 64 + (el - 4096));
            const float cl = *p; *p = st;
            if (el == 0) MLS[item * 4 + 2] = mst;
            const float mnew = fmaxf(ae + mst, ml), sp = fexp(ae + mst - mnew), sl = fexp(ml - mnew);
            st = sp * st + sl * cl; mst = mnew; }
    }
}

#define MFMA32(a, b, c) __builtin_amdgcn_mfma_f32_32x32x16_bf16((a), (b), (c), 0, 0, 0)
template <int NK>
__device__ __forceinline__ void qkt_tile(f32x16& p0, f32x16& p1, LAS const unsigned char* Kt, const bf16x8 (&qr)[NK], int r32, int hi) {
#pragma unroll
    for (int r = 0; r < 16; ++r) { p0[r] = 0.f; p1[r] = 0.f; }
#pragma unroll
    for (int d0 = 0; d0 < NK; ++d0) {
        const bf16x8 b0 = *(const LAS bf16x8*)(Kt + (2 * d0 + hi) * 1024 + r32 * 16);
        const bf16x8 b1 = *(const LAS bf16x8*)(Kt + (2 * d0 + hi) * 1024 + r32 * 16 + 512);
        p0 = MFMA32(b0, qr[d0], p0); p1 = MFMA32(b1, qr[d0], p1);
    }
}
typedef short v4i16_t __attribute__((ext_vector_type(4)));
__device__ __forceinline__ s16x4 vtr(LAS const unsigned char* p) { return __builtin_bit_cast(s16x4, __builtin_amdgcn_ds_read_tr16_b64_v4i16((LAS v4i16_t*)p)); }
__device__ __forceinline__ void pv_tile(f32x16 (&o)[2], LAS const unsigned char* Vt, const bf16x8 (&pa)[4], int lane) {
    const int hi = lane >> 5;
    LAS const unsigned char* vb = Vt + ((lane >> 4) & 1) * 32 + (lane & 3) * 8 + (4 * hi + ((lane & 15) >> 2)) * 64;
#pragma unroll
    for (int d0 = 0; d0 < 2; ++d0)
#pragma unroll
        for (int ks = 0; ks < 4; ++ks) {
            const s16x4 lo = vtr(vb + d0 * 4096 + ks * 1024), hh = vtr(vb + d0 * 4096 + ks * 1024 + 512);
            const bf16x8 vf = (bf16x8){lo[0], lo[1], lo[2], lo[3], hh[0], hh[1], hh[2], hh[3]};
            o[d0] = MFMA32(pa[ks], vf, o[d0]);
        }
}
__device__ __forceinline__ void pack_p(const f32x16& p0, const f32x16& p1, bf16x8 (&pa)[4]) {
    u32x4 w0, w1, w2, w3;
    w0 = (u32x4){pk2(p0[0], p0[1]), pk2(p0[2], p0[3]), pk2(p0[4], p0[5]), pk2(p0[6], p0[7])};
    w1 = (u32x4){pk2(p0[8], p0[9]), pk2(p0[10], p0[11]), pk2(p0[12], p0[13]), pk2(p0[14], p0[15])};
    w2 = (u32x4){pk2(p1[0], p1[1]), pk2(p1[2], p1[3]), pk2(p1[4], p1[5]), pk2(p1[6], p1[7])};
    w3 = (u32x4){pk2(p1[8], p1[9]), pk2(p1[10], p1[11]), pk2(p1[12], p1[13]), pk2(p1[14], p1[15])};
    pa[0] = __builtin_bit_cast(bf16x8, w0); pa[1] = __builtin_bit_cast(bf16x8, w1); pa[2] = __builtin_bit_cast(bf16x8, w2); pa[3] = __builtin_bit_cast(bf16x8, w3);
}

__device__ __forceinline__ void ml_out_pair(Frame& F, int pair, int l) {
    const int tid = F.tid, lane = F.lane, wid = F.wave, half = wid >> 2, wq = wid & 3, th = tid & 255, r32 = lane & 31, hi = lane >> 5;
    const int item = pair * 2 + half; const MlItem I = ml_decode(item);
    const bf16_t* U = WSP(bf16_t, WS_U);
    LAS unsigned char* base = F.lds + half * 49152;
    LAS unsigned char* KI = base;
    LAS unsigned char* VI = base + 16384;
    LAS unsigned char* CT = base + 32768;
    LAS float* vec = (LAS float*)(base + 32768 + 9216);
    LAS float* LF = vec; LAS float* IG = vec + 128; LAS float* BL = vec + 256; LAS float* SA = vec + 384; LAS float* SCI = vec + 512; LAS float* EDEN = vec + 640;
    LAS float* NPV = vec + 768; LAS float* wsf = vec + 832 + wq * 64;
    const float* gb = INF(10) + l * 16;
    if (th < 128) { const int j = th, r = I.dir ? 127 - j : j; const size_t t = (size_t)(I.t0 + r);
        const float ipre = bf2f(U[t * DINP + U_MLG + (I.dir ? 2 : 0) * 4 + I.h]) + gb[(I.dir ? 2 : 0) * 4 + I.h];
        const float fpre = bf2f(U[t * DINP + U_MLG + (I.dir ? 3 : 1) * 4 + I.h]) + gb[(I.dir ? 3 : 1) * 4 + I.h];
        LF[j] = logsigmoid(fpre); IG[j] = ipre; }
    __syncthreads();
    float a = 0.f;
    if (th < 128) { for (int i = 0; i <= th; ++i) a += LF[i]; BL[th] = IG[th] - a; }
    __syncthreads();
    if (th < 128) { float bm = -3.0e38f; for (int i = 0; i <= th; ++i) bm = fmaxf(bm, BL[i]);
        const float mprev = WSP(float, WS_MLS)[item * 4 + 2];
        const float mt = a + fmaxf(mprev, bm);
        SA[th] = (a - mt) * LOG2E; SCI[th] = fexp(a + mprev - mt); EDEN[th] = fexp(-mt); }
    __syncthreads();
    if (th < 128) BL[th] = BL[th] * LOG2E;
#pragma unroll
    for (int i = 0; i < 4; ++i) { const int p = th + 256 * i;
        { const int tt = p >> 9, c = (p >> 6) & 7, kv = p & 63, j = 64 * tt + kv, r = I.dir ? 127 - j : j;
          *(LAS u32x4*)(KI + tt * 8192 + c * 1024 + kv * 16) = *(const GAS u32x4*)(U + (size_t)(I.t0 + r) * DINP + U_MLK + I.h * 64 + c * 8); }
        { const int tt = p >> 9, dh = (p >> 8) & 1, kv = (p >> 2) & 63, c4 = p & 3, j = 64 * tt + kv, r = I.dir ? 127 - j : j;
          *(LAS u32x4*)(VI + tt * 8192 + dh * 4096 + kv * 64 + c4 * 16) = *(const GAS u32x4*)(U + (size_t)(I.t0 + r) * DINP + U_MLV + I.h * 64 + dh * 32 + c4 * 8); } }
    { const float* cp = WSP(float, WS_MLC) + (size_t)item * 4096;
#pragma unroll
      for (int i = 0; i < 16; ++i) { const int idx = th + 256 * i, d = idx >> 6, e = idx & 63;
          *(LAS unsigned short*)(CT + e * 144 + d * 2) = (unsigned short)(pk2(cp[idx], 0.f) & 0xffffu); }
      if (th < 64) NPV[th] = WSP(float, WS_MLN)[item * 64 + th]; }
    __syncthreads();
    {
        const int q = 32 * wq + r32;
        const int rq = I.dir ? 127 - q : q;
        bf16x8 qr[4];
        const bf16_t* qp = U + (size_t)(I.t0 + rq) * DINP + U_MLQ + I.h * 64 + hi * 8;
#pragma unroll
        for (int d0 = 0; d0 < 4; ++d0) qr[d0] = *(const GAS bf16x8*)(qp + d0 * 16);
        f32x16 o[2];
#pragma unroll
        for (int r = 0; r < 16; ++r) { o[0][r] = 0.f; o[1][r] = 0.f; }
        const float saq = SA[q], scq = SCI[q];
        float den = 0.f;
        for (int tt = 0; tt < 2; ++tt) {
            if (64 * tt > 32 * wq + 31) break;
            f32x16 p0, p1;
            qkt_tile<4>(p0, p1, KI + tt * 8192, qr, r32, hi);
#pragma unroll
            for (int g = 0; g < 4; ++g) {
                const f32x4 b0 = *(const LAS f32x4*)(BL + 64 * tt + 8 * g + 4 * hi), b1 = *(const LAS f32x4*)(BL + 64 * tt + 32 + 8 * g + 4 * hi);
#pragma unroll
                for (int i = 0; i < 4; ++i) { const int r = 4 * g + i; const int kv0 = 64 * tt + 8 * g + 4 * hi + i, kv1 = kv0 + 32;
                    const float e0 = (kv0 <= q) ? __builtin_amdgcn_exp2f(saq + b0[i]) * 0.125f : 0.f, e1 = (kv1 <= q) ? __builtin_amdgcn_exp2f(saq + b1[i]) * 0.125f : 0.f;
                    p0[r] *= e0; p1[r] *= e1; den += p0[r] + p1[r]; }
            }
            bf16x8 pa[4]; pack_p(p0, p1, pa);
            pv_tile(o, VI + tt * 8192, pa, lane);
        }
        float dot = 0.f;
#pragma unroll
        for (int ks = 0; ks < 4; ++ks) {
            const u32x4 qw = __builtin_bit_cast(u32x4, qr[ks]);
            const f32x4 n0 = *(const LAS f32x4*)(NPV + 16 * ks + 8 * hi), n1 = *(const LAS f32x4*)(NPV + 16 * ks + 8 * hi + 4);
            const float q0 = bflo(qw.x), q1 = bfhi(qw.x), q2 = bflo(qw.y), q3 = bfhi(qw.y), q4 = bflo(qw.z), q5 = bfhi(qw.z), q6 = bflo(qw.w), q7 = bfhi(qw.w);
            dot += q0 * n0[0] + q1 * n0[1] + q2 * n0[2] + q3 * n0[3] + q4 * n1[0] + q5 * n1[1] + q6 * n1[2] + q7 * n1[3];
            const u32x4 sw = (u32x4){pk2(q0 * scq, q1 * scq), pk2(q2 * scq, q3 * scq), pk2(q4 * scq, q5 * scq), pk2(q6 * scq, q7 * scq)};
            const bf16x8 qs = __builtin_bit_cast(bf16x8, sw);
#pragma unroll
            for (int de = 0; de < 2; ++de) {
                const bf16x8 cf = *(const LAS bf16x8*)(CT + (de * 32 + r32) * 144 + (16 * ks + 8 * hi) * 2);
                o[de] = MFMA32(qs, cf, o[de]);
            }
        }
        den += scq * dot;
        den += __shfl_xor(den, 32);
        const float rinv = 1.0f / fmaxf(fabsf(den), EDEN[q]);
        if (hi == 0) wsf[r32] = rinv;
        LDS_WAIT();
        float* dst = WSP(float, I.dir ? WS_HB : WS_HF);
#pragma unroll
        for (int r = 0; r < 16; ++r) { const int jq = 32 * wq + crow(r, hi), row = I.dir ? 127 - jq : jq; const float rr = wsf[crow(r, hi)];
            float* dp = dst + (size_t)(I.t0 + row) * 256 + I.h * 64 + r32;
            dp[0] = o[0][r] * rr; dp[32] = o[1][r] * rr; }
    }
    __syncthreads();
}

__device__ __forceinline__ void mla_prep_rows(Frame& F, int l) {
    const int gw = F.vcu * NWAVES + F.wave, NGW = F.G * NWAVES, lane = F.lane;
    const bf16_t* U = WSP(bf16_t, WS_U); bf16_t* A = WSP(bf16_t, WS_AMLA);
    const float* qn = INF(11) + l * 224; const float* kn = INF(12) + l * 128;
    for (int m = gw; m < MTOK; m += NGW) {
        const bf16_t* ur = U + (size_t)m * DINP;
        float q0 = 0.f, q1 = 0.f, q2 = 0.f, q3 = 0.f;
        if (lane < 56) { const u32x2 w = *(const GAS u32x2*)(ur + U_CQ + 4 * lane); q0 = bflo(w.x); q1 = bfhi(w.x); q2 = bflo(w.y); q3 = bfhi(w.y); }
        const unsigned kw = *(const GAS unsigned*)(ur + U_CKV + 2 * lane); const float k0 = bflo(kw), k1 = bfhi(kw);
        const float rq = __builtin_amdgcn_rsqf(wave_sum(q0 * q0 + q1 * q1 + q2 * q2 + q3 * q3) * (1.0f / 224.0f) + EPS);
        const float rk = __builtin_amdgcn_rsqf(wave_sum(k0 * k0 + k1 * k1) * (1.0f / 128.0f) + EPS);
        bf16_t* ar = A + (size_t)m * 384;
        u32x2 qo = {0u, 0u};
        if (lane < 56) { const f32x4 g = *(const GAS f32x4*)(qn + 4 * lane); qo.x = pk2(q0 * rq * g.x, q1 * rq * g.y); qo.y = pk2(q2 * rq * g.z, q3 * rq * g.w); }
        *(GAS u32x2*)(ar + 4 * lane) = qo;
        const f32x2 g2 = *(const GAS f32x2*)(kn + 2 * lane);
        *(GAS unsigned*)(ar + 256 + 2 * lane) = pk2(k0 * rk * g2.x, k1 * rk * g2.y);
    }
}

__device__ __forceinline__ void rope_cs(int pos, int i, float& c, float& s) {
    const double inv = __builtin_exp2(-(double)i * (13.287712379549449 / 16.0));
    double rev = (double)pos * inv * 0.15915494309189535;
    rev -= __builtin_floor(rev);
    const float r = (float)rev;
    c = cos_rev(r); s = sin_rev(r);
}
__device__ __forceinline__ void relayout_phase(Frame& F) {
    const bf16_t* O = WSP(bf16_t, WS_OMLA); const bf16_t* U = WSP(bf16_t, WS_U);
    const int* pos = (const int*)F.a->in[2];
    const float qscale = 0.10206207261596577f * LOG2E;
    for (int idx = blockIdx.x * NTHR + F.tid; idx < MTOK * 4; idx += F.G * NTHR) {
        const int t = idx >> 2, h = idx & 3, b = t >> 13, s = t & 8191, bh = b * 4 + h;
        const int p = pos[t];
        float cs[16], sn[16];
#pragma unroll
        for (int i = 0; i < 16; ++i) rope_cs(p, i, cs[i], sn[i]);
        const bf16_t* qsrc = O + (size_t)t * 1024 + h * 96;
        bf16_t* qdst = WSP(bf16_t, WS_Q) + ((size_t)bh * SEQ + s) * 96;
#pragma unroll
        for (int c = 0; c < 8; ++c) { const u32x4 w = *(const GAS u32x4*)(qsrc + c * 8);
            u32x4 o; o.x = pk2(bflo(w.x) * qscale, bfhi(w.x) * qscale); o.y = pk2(bflo(w.y) * qscale, bfhi(w.y) * qscale); o.z = pk2(bflo(w.z) * qscale, bfhi(w.z) * qscale); o.w = pk2(bflo(w.w) * qscale, bfhi(w.w) * qscale);
            *(GAS u32x4*)(qdst + c * 8) = o; }
        {
            float x1[16], x2[16];
#pragma unroll
            for (int c = 0; c < 2; ++c) { const u32x4 w = *(const GAS u32x4*)(qsrc + 64 + c * 8); const u32x4 v = *(const GAS u32x4*)(qsrc + 80 + c * 8);
                x1[c * 8 + 0] = bflo(w.x); x1[c * 8 + 1] = bfhi(w.x); x1[c * 8 + 2] = bflo(w.y); x1[c * 8 + 3] = bfhi(w.y); x1[c * 8 + 4] = bflo(w.z); x1[c * 8 + 5] = bfhi(w.z); x1[c * 8 + 6] = bflo(w.w); x1[c * 8 + 7] = bfhi(w.w);
                x2[c * 8 + 0] = bflo(v.x); x2[c * 8 + 1] = bfhi(v.x); x2[c * 8 + 2] = bflo(v.y); x2[c * 8 + 3] = bfhi(v.y); x2[c * 8 + 4] = bflo(v.z); x2[c * 8 + 5] = bfhi(v.z); x2[c * 8 + 6] = bflo(v.w); x2[c * 8 + 7] = bfhi(v.w); }
#pragma unroll
            for (int c = 0; c < 2; ++c) { u32x4 o1, o2;
#define RQ1(i) ((x1[i] * cs[i] - x2[i] * sn[i]) * qscale)
#define RQ2(i) ((x2[i] * cs[i] + x1[i] * sn[i]) * qscale)
                o1.x = pk2(RQ1(c * 8 + 0), RQ1(c * 8 + 1)); o1.y = pk2(RQ1(c * 8 + 2), RQ1(c * 8 + 3)); o1.z = pk2(RQ1(c * 8 + 4), RQ1(c * 8 + 5)); o1.w = pk2(RQ1(c * 8 + 6), RQ1(c * 8 + 7));
                o2.x = pk2(RQ2(c * 8 + 0), RQ2(c * 8 + 1)); o2.y = pk2(RQ2(c * 8 + 2), RQ2(c * 8 + 3)); o2.z = pk2(RQ2(c * 8 + 4), RQ2(c * 8 + 5)); o2.w = pk2(RQ2(c * 8 + 6), RQ2(c * 8 + 7));
                *(GAS u32x4*)(qdst + 64 + c * 8) = o1; *(GAS u32x4*)(qdst + 80 + c * 8) = o2; }
#undef RQ1
#undef RQ2
        }
        bf16_t* kdst = WSP(bf16_t, WS_KIMG) + ((size_t)bh * 128 + (s >> 6)) * 6144 + (s & 63) * 8;
        const bf16_t* ksrc = O + (size_t)t * 1024 + 384 + h * 64;
#pragma unroll
        for (int c = 0; c < 8; ++c) *(GAS u32x4*)(kdst + c * 512) = *(const GAS u32x4*)(ksrc + c * 8);
        {
            const bf16_t* krs = U + (size_t)t * DINP + U_KR;
            float x1[16], x2[16];
#pragma unroll
            for (int c = 0; c < 2; ++c) { const u32x4 w = *(const GAS u32x4*)(krs + c * 8); const u32x4 v = *(const GAS u32x4*)(krs + 16 + c * 8);
                x1[c * 8 + 0] = bflo(w.x); x1[c * 8 + 1] = bfhi(w.x); x1[c * 8 + 2] = bflo(w.y); x1[c * 8 + 3] = bfhi(w.y); x1[c * 8 + 4] = bflo(w.z); x1[c * 8 + 5] = bfhi(w.z); x1[c * 8 + 6] = bflo(w.w); x1[c * 8 + 7] = bfhi(w.w);
                x2[c * 8 + 0] = bflo(v.x); x2[c * 8 + 1] = bfhi(v.x); x2[c * 8 + 2] = bflo(v.y); x2[c * 8 + 3] = bfhi(v.y); x2[c * 8 + 4] = bflo(v.z); x2[c * 8 + 5] = bfhi(v.z); x2[c * 8 + 6] = bflo(v.w); x2[c * 8 + 7] = bfhi(v.w); }
#pragma unroll
            for (int c = 0; c < 2; ++c) { u32x4 o1, o2;
#define RK1(i) (x1[i] * cs[i] - x2[i] * sn[i])
#define RK2(i) (x2[i] * cs[i] + x1[i] * sn[i])
                o1.x = pk2(RK1(c * 8 + 0), RK1(c * 8 + 1)); o1.y = pk2(RK1(c * 8 + 2), RK1(c * 8 + 3)); o1.z = pk2(RK1(c * 8 + 4), RK1(c * 8 + 5)); o1.w = pk2(RK1(c * 8 + 6), RK1(c * 8 + 7));
                o2.x = pk2(RK2(c * 8 + 0), RK2(c * 8 + 1)); o2.y = pk2(RK2(c * 8 + 2), RK2(c * 8 + 3)); o2.z = pk2(RK2(c * 8 + 4), RK2(c * 8 + 5)); o2.w = pk2(RK2(c * 8 + 6), RK2(c * 8 + 7));
                *(GAS u32x4*)(kdst + (8 + c) * 512) = o1; *(GAS u32x4*)(kdst + (10 + c) * 512) = o2; }
#undef RK1
#undef RK2
        }
        bf16_t* vdst = WSP(bf16_t, WS_VIMG) + ((size_t)bh * 128 + (s >> 6)) * 4096 + (s & 63) * 32;
        const bf16_t* vsrc = O + (size_t)t * 1024 + 640 + h * 64;
#pragma unroll
        for (int c = 0; c < 8; ++c) *(GAS u32x4*)(vdst + (c >> 2) * 2048 + (c & 3) * 8) = *(const GAS u32x4*)(vsrc + c * 8);
    }
}

__device__ __forceinline__ void attn_unit(Frame& F, int bh, int qb) {
    const int tid = F.tid, lane = F.lane, wid = F.wave, r32 = lane & 31, hi = lane >> 5;
    LAS unsigned char* KB = F.lds;
    LAS unsigned char* VB = F.lds + 24576;
    LAS float* wsf = (LAS float*)(F.lds + 40960) + wid * 64;
    const int b = bh >> 2, h = bh & 3;
    const bf16_t* Qp = WSP(bf16_t, WS_Q) + ((size_t)bh * SEQ + qb * 256 + wid * 32 + r32) * 96 + hi * 8;
    bf16x8 qr[6];
#pragma unroll
    for (int d0 = 0; d0 < 6; ++d0) qr[d0] = *(const GAS bf16x8*)(Qp + d0 * 16);
    const GAS u32x4* Kg = (const GAS u32x4*)(WSP(bf16_t, WS_KIMG) + (size_t)bh * 128 * 6144);
    const GAS u32x4* Vg = (const GAS u32x4*)(WSP(bf16_t, WS_VIMG) + (size_t)bh * 128 * 4096);
    u32x4 k0 = Kg[tid], k1 = (tid < 256) ? Kg[512 + tid] : (u32x4){0u, 0u, 0u, 0u}, v0 = Vg[tid];
    *(LAS u32x4*)(KB + tid * 16) = k0; if (tid < 256) *(LAS u32x4*)(KB + (512 + tid) * 16) = k1; *(LAS u32x4*)(VB + tid * 16) = v0;
    __syncthreads();
    float m = -1.0e30f, lsum = 0.f;
    f32x16 o[2];
#pragma unroll
    for (int r = 0; r < 16; ++r) { o[0][r] = 0.f; o[1][r] = 0.f; }
    for (int t = 0; t < 128; ++t) {
        const int cur = t & 1;
        if (t + 1 < 128) { k0 = Kg[(t + 1) * 768 + tid]; if (tid < 256) k1 = Kg[(t + 1) * 768 + 512 + tid]; v0 = Vg[(t + 1) * 512 + tid]; }
        f32x16 p0, p1;
        qkt_tile<6>(p0, p1, KB + cur * 12288, qr, r32, hi);
        float rm = fmaxf(p0[0], p1[0]);
#pragma unroll
        for (int r = 1; r < 16; ++r) rm = fmaxf(rm, fmaxf(p0[r], p1[r]));
        rm = fmaxf(rm, __shfl_xor(rm, 32));
        if (__any(rm > m + 8.0f)) {
            const float mn = fmaxf(m, rm), f = __builtin_amdgcn_exp2f(m - mn);
            m = mn; lsum *= f;
            if (hi == 0) wsf[r32] = f;
            LDS_WAIT();
#pragma unroll
            for (int r = 0; r < 16; ++r) { const float fr = wsf[crow(r, hi)]; o[0][r] *= fr; o[1][r] *= fr; }
        }
#pragma unroll
        for (int r = 0; r < 16; ++r) { p0[r] = __builtin_amdgcn_exp2f(p0[r] - m); p1[r] = __builtin_amdgcn_exp2f(p1[r] - m); lsum += p0[r] + p1[r]; }
        bf16x8 pa[4]; pack_p(p0, p1, pa);
        pv_tile(o, VB + cur * 8192, pa, lane);
        if (t + 1 < 128) { const int nb = cur ^ 1;
            *(LAS u32x4*)(KB + nb * 12288 + tid * 16) = k0; if (tid < 256) *(LAS u32x4*)(KB + nb * 12288 + (512 + tid) * 16) = k1; *(LAS u32x4*)(VB + nb * 8192 + tid * 16) = v0; }
        __syncthreads();
    }
    lsum += __shfl_xor(lsum, 32);
    if (hi == 0) wsf[r32] = 1.0f / lsum;
    LDS_WAIT();
    bf16_t* Y = WSP(bf16_t, WS_YMIX);
#pragma unroll
    for (int r = 0; r < 16; ++r) { const float rl = wsf[crow(r, hi)]; const int q = qb * 256 + wid * 32 + crow(r, hi);
        bf16_t* yp = Y + ((size_t)b * SEQ + q) * 512 + h * 64 + r32;
        yp[0] = (bf16_t)(pk2(o[0][r] * rl, 0.f) & 0xffffu); yp[32] = (bf16_t)(pk2(o[1][r] * rl, 0.f) & 0xffffu); }
    __syncthreads();
}

template <bool INV>
__device__ __forceinline__ void fft16k(LAS f32x2* X, int tid) {
#pragma unroll 1
    for (int s = 0; s < 7; ++s) {
        const int lq = INV ? 2 * s : 12 - 2 * s; const int q = 1 << lq;
        const float rq = 1.0f / (float)(4 * q);
#pragma unroll 2
        for (int i = 0; i < 8; ++i) {
            const int t = tid + 512 * i; const int j = t & (q - 1); const int base = ((t >> lq) << (lq + 2)) + j;
            f32x2 x0 = X[base], x1 = X[base + q], x2 = X[base + 2 * q], x3 = X[base + 3 * q];
            const float ang = (float)j * rq;
            const float c1 = cos_rev(ang), s1 = INV ? sin_rev(ang) : -sin_rev(ang);
            const float c2 = c1 * c1 - s1 * s1, s2 = 2.0f * c1 * s1;
            const float c3 = c2 * c1 - s2 * s1, s3 = c2 * s1 + s2 * c1;
            if (!INV) {
                const f32x2 a = x0 + x2, b = x0 - x2, c = x1 + x3, d = x1 - x3;
                const f32x2 y0 = a + c, y2 = a - c, y1 = (f32x2){b.x + d.y, b.y - d.x}, y3 = (f32x2){b.x - d.y, b.y + d.x};
                X[base] = y0;
                X[base + q] = (f32x2){y1.x * c1 - y1.y * s1, y1.x * s1 + y1.y * c1};
                X[base + 2 * q] = (f32x2){y2.x * c2 - y2.y * s2, y2.x * s2 + y2.y * c2};
                X[base + 3 * q] = (f32x2){y3.x * c3 - y3.y * s3, y3.x * s3 + y3.y * c3};
            } else {
                x1 = (f32x2){x1.x * c1 - x1.y * s1, x1.x * s1 + x1.y * c1};
                x2 = (f32x2){x2.x * c2 - x2.y * s2, x2.x * s2 + x2.y * c2};
                x3 = (f32x2){x3.x * c3 - x3.y * s3, x3.x * s3 + x3.y * c3};
                const f32x2 a = x0 + x2, b = x0 - x2, c = x1 + x3, d = x1 - x3;
                X[base] = a + c; X[base + 2 * q] = a - c;
                X[base + q] = (f32x2){b.x - d.y, b.y + d.x};
                X[base + 3 * q] = (f32x2){b.x + d.y, b.y - d.x};
            }
        }
        __syncthreads();
    }
}
__device__ __forceinline__ float block_sum(Frame& F, float v, LAS float* red) {
    v = wave_sum(v);
    if (F.lane == 0) red[F.wave] = v;
    __syncthreads();
    float s = 0.f;
#pragma unroll
    for (int w = 0; w < NWAVES; ++w) s += red[w];
    __syncthreads();
    return s;
}
__device__ __forceinline__ void hyena_item(Frame& F, int c, int l) {
    const int tid = F.tid;
    LAS f32x2* X = (LAS f32x2*)F.lds;
    LAS float* W3F = (LAS float*)(F.lds + XTRA_OFF); LAS float* W3B = W3F + 64; LAS float* red = W3F + 128;
    f32x2* KF = WSP(f32x2, WS_KF) + (size_t)c * 2 * 16384;
    const float* HID = WSP(float, WS_HID) + (size_t)l * SEQ * 64;
    for (int o = 0; o < 2; ++o) {
        const int cf = o * 512 + c, cb = cf + 256;
        if (tid < 64) W3F[tid] = INF(24)[(size_t)l * 64 * 1024 + tid * 1024 + cf];
        else if (tid < 128) W3B[tid - 64] = INF(24)[(size_t)l * 64 * 1024 + (tid - 64) * 1024 + cb];
        const float b3f = INF(25)[l * 1024 + cf], b3b = INF(25)[l * 1024 + cb];
        const float df = fexp(INF(26)[l * 1024 + cf]), db = fexp(INF(26)[l * 1024 + cb]);
        __syncthreads();
        float ssum = 0.f;
#pragma unroll 1
        for (int i = 0; i < 16; ++i) { const int t = tid + 512 * i;
            const GAS f32x4* hv = (const GAS f32x4*)(HID + (size_t)t * 64);
            float ff = b3f, fb = b3b;
#pragma unroll
            for (int m4 = 0; m4 < 16; ++m4) { const f32x4 h = hv[m4]; const f32x4 wf = *(const LAS f32x4*)(W3F + 4 * m4), wb = *(const LAS f32x4*)(W3B + 4 * m4);
                ff += h.x * wf.x + h.y * wf.y + h.z * wf.z + h.w * wf.w; fb += h.x * wb.x + h.y * wb.y + h.z * wb.z + h.w * wb.w; }
            const float tt = (float)t * (1.0f / SEQ);
            ff *= fexp(-tt * df); fb *= fexp(-tt * db);
            ssum += fabsf(ff) + fabsf(fb);
            X[t] = (f32x2){ff, 0.f}; X[16383 - t] = (f32x2){fb, 0.f}; }
        const float inv = 1.0f / block_sum(F, ssum, red);
        fft16k<false>(X, tid);
#pragma unroll 4
        for (int i = 0; i < 32; ++i) { const int p = tid + 512 * i; const f32x2 v = X[p]; KF[o * 16384 + p] = (f32x2){v.x * inv, v.y * inv}; }
        __syncthreads();
    }
    const bf16_t* U = WSP(bf16_t, WS_U);
    float wx1[3], wx2[3], wz[3];
#pragma unroll
    for (int j = 0; j < 3; ++j) { wx1[j] = INF(16)[(size_t)l * 768 * 3 + c * 3 + j]; wx2[j] = INF(16)[(size_t)l * 768 * 3 + (256 + c) * 3 + j]; wz[j] = INF(16)[(size_t)l * 768 * 3 + (512 + c) * 3 + j]; }
    const float bx1 = INF(17)[l * 768 + c], bx2 = INF(17)[l * 768 + 256 + c], bz = INF(17)[l * 768 + 512 + c];
    const float hb0 = INF(27)[l * 512 + c], hb1 = INF(27)[l * 512 + 256 + c];
    float zz[16][2];
#define HY_CONV(dst, colofs, w, bias) do { const bf16_t* up_ = U + ((size_t)b * SEQ + t) * DINP + U_HY + (colofs) + c; \
        const float a_m = (t > 0) ? bf2f(up_[-DINP]) : 0.f, a_0 = bf2f(up_[0]), a_p = (t < SEQ - 1) ? bf2f(up_[DINP]) : 0.f; \
        dst = w[0] * a_m + w[1] * a_0 + w[2] * a_p + (bias); } while (0)
#pragma unroll
    for (int i = 0; i < 16; ++i) { int t = tid + 512 * i; asm volatile("" : "+v"(t));
#pragma unroll
        for (int b = 0; b < 2; ++b) HY_CONV(zz[i][b], 512, wz, bz);
        X[t] = (f32x2){zz[i][0], zz[i][1]}; X[8192 + t] = (f32x2){0.f, 0.f}; asm volatile("" ::: "memory"); }
    __syncthreads();
    const float invn = 1.0f / 16384.0f;
    for (int o = 0; o < 2; ++o) {
        fft16k<false>(X, tid);
#pragma unroll 4
        for (int i = 0; i < 32; ++i) { const int p = tid + 512 * i; const f32x2 v = X[p]; const f32x2 k = KF[o * 16384 + p]; X[p] = (f32x2){v.x * k.x - v.y * k.y, v.x * k.y + v.y * k.x}; }
        __syncthreads();
        fft16k<true>(X, tid);
        if (o == 0) {
#pragma unroll
            for (int i = 0; i < 16; ++i) { int t = tid + 512 * i; asm volatile("" : "+v"(t)); const f32x2 y = X[t];
                float ga, gb2; { const int b = 0; HY_CONV(ga, 0, wx1, bx1); } { const int b = 1; HY_CONV(gb2, 0, wx1, bx1); }
                zz[i][0] = ga * (y.x * invn + zz[i][0] * hb0); zz[i][1] = gb2 * (y.y * invn + zz[i][1] * hb0);
                X[t] = (f32x2){zz[i][0], zz[i][1]}; X[8192 + t] = (f32x2){0.f, 0.f}; asm volatile("" ::: "memory"); }
            __syncthreads();
        } else {
            bf16_t* Y = WSP(bf16_t, WS_YMIX);
#pragma unroll
            for (int i = 0; i < 16; ++i) { int t = tid + 512 * i; asm volatile("" : "+v"(t)); const f32x2 y = X[t];
                float ga, gb2; { const int b = 0; HY_CONV(ga, 256, wx2, bx2); } { const int b = 1; HY_CONV(gb2, 256, wx2, bx2); }
                const float r0 = ga * (y.x * invn + zz[i][0] * hb1), r1 = gb2 * (y.y * invn + zz[i][1] * hb1);
                Y[((size_t)t) * 512 + 256 + c] = (bf16_t)(pk2(r0, 0.f) & 0xffffu); Y[((size_t)SEQ + t) * 512 + 256 + c] = (bf16_t)(pk2(r1, 0.f) & 0xffffu); asm volatile("" ::: "memory"); }
            __syncthreads();
        }
    }
#undef HY_CONV
}

__device__ __forceinline__ void headnorm_phase(Frame& F, int l) {
    const int gw = F.vcu * NWAVES + F.wave, NGW = F.G * NWAVES, lane = F.lane;
    const bf16_t* U = WSP(bf16_t, WS_U); const bf16_t* YM = WSP(bf16_t, WS_YMIX);
    const float* og = INF(29) + l * 1024;
    for (int m = gw; m < MTOK; m += NGW) {
        float y[16];
        const int ch = 16 * lane;
        if (lane < 16) {
            const bf16_t* op = U + (size_t)m * DINP + U_MLO + ch;
            const u32x4 o0 = *(const GAS u32x4*)op, o1 = *(const GAS u32x4*)(op + 8);
            const unsigned ow[8] = {o0.x, o0.y, o0.z, o0.w, o1.x, o1.y, o1.z, o1.w};
            const GAS f32x4* hf = (const GAS f32x4*)(WSP(float, WS_HF) + (size_t)m * 256 + ch);
            const GAS f32x4* hb = (const GAS f32x4*)(WSP(float, WS_HB) + (size_t)m * 256 + ch);
#pragma unroll
            for (int j = 0; j < 4; ++j) { const f32x4 s = hf[j] + hb[j];
                const float oa = bflo(ow[2 * j]), ob = bfhi(ow[2 * j]), oc = bflo(ow[2 * j + 1]), od = bfhi(ow[2 * j + 1]);
                y[4 * j + 0] = s.x / (1.0f + fexp(-oa)); y[4 * j + 1] = s.y / (1.0f + fexp(-ob)); y[4 * j + 2] = s.z / (1.0f + fexp(-oc)); y[4 * j + 3] = s.w / (1.0f + fexp(-od)); }
        } else if (lane < 48) {
            const bf16_t* yp = YM + (size_t)m * 512 + (ch - 256);
            const u32x4 o0 = *(const GAS u32x4*)yp, o1 = *(const GAS u32x4*)(yp + 8);
            const unsigned ow[8] = {o0.x, o0.y, o0.z, o0.w, o1.x, o1.y, o1.z, o1.w};
#pragma unroll
            for (int j = 0; j < 8; ++j) { y[2 * j] = bflo(ow[j]); y[2 * j + 1] = bfhi(ow[j]); }
        } else {
            const int c = ch - 768, s = m & 8191;
            const bf16_t* up = U + (size_t)m * DINP + U_SC + c;
            float acc[16];
#pragma unroll
            for (int j = 0; j < 16; ++j) acc[j] = 0.f;
#pragma unroll
            for (int dt = -1; dt <= 1; ++dt) {
                if ((s + dt) < 0 || (s + dt) >= SEQ) continue;
                const bf16_t* rp = up + (ptrdiff_t)dt * DINP;
                const u32x4 c0 = *(const GAS u32x4*)(rp + 256), c1 = *(const GAS u32x4*)(rp + 264), x0 = *(const GAS u32x4*)(rp + 512), x1 = *(const GAS u32x4*)(rp + 520);
                const unsigned cw[8] = {c0.x, c0.y, c0.z, c0.w, c1.x, c1.y, c1.z, c1.w}, xw[8] = {x0.x, x0.y, x0.z, x0.w, x1.x, x1.y, x1.z, x1.w};
#pragma unroll
                for (int j = 0; j < 8; ++j) { acc[2 * j] += bflo(cw[j]) * bflo(xw[j]) * INF(28)[(size_t)l * 768 + (c + 2 * j) * 3 + dt + 1]; acc[2 * j + 1] += bfhi(cw[j]) * bfhi(xw[j]) * INF(28)[(size_t)l * 768 + (c + 2 * j + 1) * 3 + dt + 1]; }
            }
            const u32x4 b0 = *(const GAS u32x4*)up, b1 = *(const GAS u32x4*)(up + 8);
            const unsigned bw[8] = {b0.x, b0.y, b0.z, b0.w, b1.x, b1.y, b1.z, b1.w};
#pragma unroll
            for (int j = 0; j < 8; ++j) { y[2 * j] = bflo(bw[j]) * acc[2 * j]; y[2 * j + 1] = bfhi(bw[j]) * acc[2 * j + 1]; }
        }
        float ss = 0.f;
#pragma unroll
        for (int j = 0; j < 16; ++j) ss += y[j] * y[j];
        ss += __shfl_xor(ss, 1); ss += __shfl_xor(ss, 2);
        const float rstd = __builtin_amdgcn_rsqf(ss * (1.0f / 64.0f) + EPS);
        const GAS f32x4* gp = (const GAS f32x4*)(og + ch);
        u32x4 w0, w1;
        { const f32x4 ga = gp[0], gb2 = gp[1], gc = gp[2], gd = gp[3];
          w0.x = pk2(y[0] * rstd * ga.x, y[1] * rstd * ga.y); w0.y = pk2(y[2] * rstd * ga.z, y[3] * rstd * ga.w); w0.z = pk2(y[4] * rstd * gb2.x, y[5] * rstd * gb2.y); w0.w = pk2(y[6] * rstd * gb2.z, y[7] * rstd * gb2.w);
          w1.x = pk2(y[8] * rstd * gc.x, y[9] * rstd * gc.y); w1.y = pk2(y[10] * rstd * gc.z, y[11] * rstd * gc.w); w1.z = pk2(y[12] * rstd * gd.x, y[13] * rstd * gd.y); w1.w = pk2(y[14] * rstd * gd.z, y[15] * rstd * gd.w); }
        bf16_t* yn = WSP(bf16_t, WS_YN) + (size_t)m * DM + ch;
        *(GAS u32x4*)yn = w0; *(GAS u32x4*)(yn + 8) = w1;
    }
}

__device__ __forceinline__ void post_mixer_phase(Frame& F, int l, const float* xin) {
    const int gw = F.vcu * NWAVES + F.wave, NGW = F.G * NWAVES, lane = F.lane, tid = F.tid;
    LAS float* RWT = (LAS float*)F.lds;
    { const GAS f32x4* src = (const GAS f32x4*)(INF(31) + (size_t)l * 1024 * 16);
      for (int i = tid; i < 4096; i += NTHR) { const f32x4 w = src[i]; const int k = i >> 2, e4 = (i & 3) * 4;
          RWT[(e4 + 0) * 1024 + k] = w.x; RWT[(e4 + 1) * 1024 + k] = w.y; RWT[(e4 + 2) * 1024 + k] = w.z; RWT[(e4 + 3) * 1024 + k] = w.w; } }
    __syncthreads();
    const float* mod = WSP(float, WS_MOD);
    for (int m = gw; m < MTOK; m += NGW) {
        const int b = m >> 13, s = m & 8191; const float* md = mod + (l * 2 + b) * 6144;
        f32x4 y2[4], x[4], pg[4], g1[4];
        ld_row_f32(WSP(float, WS_Y2) + (size_t)m * DM, lane, y2);
        ld_row_f32(xin + (size_t)m * DM, lane, x);
        ld_row_f32(INF(6) + l * 1024, lane, pg); ld_row_f32(md + 2048, lane, g1);
        const float rstd = __builtin_amdgcn_rsqf(row_ss(y2) * (1.0f / DM) + EPS);
#pragma unroll
        for (int j = 0; j < 4; ++j) x[j] = x[j] + g1[j] * (y2[j] * rstd * pg[j]);
        st_row_f32(WSP(float, WS_X1) + (size_t)m * DM, lane, x);
        f32x4 h[4];
        modnorm(x, INF(7) + l * 1024, md + 4096, md + 3072, lane, h);
        st_row_bf16(WSP(bf16_t, WS_XN) + (size_t)m * DM, lane, h);
        float part[16];
#pragma unroll
        for (int e = 0; e < 16; ++e) part[e] = 0.f;
#pragma unroll
        for (int j = 0; j < 4; ++j) {
#pragma unroll
            for (int e = 0; e < 16; ++e) { const f32x4 w = *(const LAS f32x4*)(RWT + e * 1024 + 4 * lane + 256 * j);
                part[e] += (h[j].x * w.x + h[j].y * w.y) + (h[j].z * w.z + h[j].w * w.w); }
            asm volatile("" ::: "memory"); }
        float a8[8], a4[4], a2[2], lg;
        { const bool up = (lane & 32) != 0;
#pragma unroll
          for (int i = 0; i < 8; ++i) { const float keep = up ? part[8 + i] : part[i], send = up ? part[i] : part[8 + i]; a8[i] = keep + __shfl_xor(send, 32); } }
        { const bool up = (lane & 16) != 0;
#pragma unroll
          for (int i = 0; i < 4; ++i) { const float keep = up ? a8[4 + i] : a8[i], send = up ? a8[i] : a8[4 + i]; a4[i] = keep + __shfl_xor(send, 16); } }
        { const bool up = (lane & 8) != 0;
#pragma unroll
          for (int i = 0; i < 2; ++i) { const float keep = up ? a4[2 + i] : a4[i], send = up ? a4[i] : a4[2 + i]; a2[i] = keep + __shfl_xor(send, 8); } }
        { const bool up = (lane & 4) != 0; const float keep = up ? a2[1] : a2[0], send = up ? a2[0] : a2[1]; lg = keep + __shfl_xor(send, 4); }
        lg += __shfl_xor(lg, 2); lg += __shfl_xor(lg, 1);
        float mx = lg;
#pragma unroll
        for (int o = 4; o < 64; o <<= 1) mx = fmaxf(mx, __shfl_xor(mx, o));
        const float ex = fexp(lg - mx); float sm = ex;
#pragma unroll
        for (int o = 4; o < 64; o <<= 1) sm += __shfl_xor(sm, o);
        if ((lane & 3) == 0) WSP(float, WS_AFF)[((size_t)b * 16 + (lane >> 2)) * SEQ + s] = ex / sm;
        if (lane < 16) WSP(int, WS_SLOT)[(size_t)m * 16 + lane] = -1;
    }
    __syncthreads();
}

__device__ __forceinline__ void topk_item(Frame& F, int it) {
    const int tid = F.tid, lane = F.lane, wave = F.wave;
    const int b = it >> 4, e = it & 15;
    LAS unsigned* keys = (LAS unsigned*)F.lds;
    LAS unsigned* hist = (LAS unsigned*)(F.lds + 32768);
    LAS unsigned* ctl = hist + 256;
    LAS unsigned* wtot = hist + 320;
    const unsigned* src = (const unsigned*)(WSP(float, WS_AFF) + (size_t)it * SEQ);
#pragma unroll
    for (int i = 0; i < 16; ++i) keys[tid + 512 * i] = src[tid + 512 * i];
    unsigned prefix = 0u, mask = 0u, need = CAP;
    for (int pass = 0; pass < 4; ++pass) {
        const int shift = 24 - 8 * pass;
        if (tid < 256) hist[tid] = 0u;
        __syncthreads();
#pragma unroll
        for (int i = 0; i < 16; ++i) { const unsigned k = keys[tid + 512 * i]; if ((k & mask) == prefix) atomicAdd((unsigned*)&hist[(k >> shift) & 255u], 1u); }
        __syncthreads();
        if (tid == 0) { unsigned cum = 0u; int bin = 255; for (; bin > 0; --bin) { const unsigned hcount = hist[bin]; if (cum + hcount >= need) break; cum += hcount; }
            ctl[0] = (unsigned)bin; ctl[1] = need - cum; }
        __syncthreads();
        prefix |= ctl[0] << shift; mask |= 0xffu << shift; need = ctl[1];
        __syncthreads();
    }
    unsigned cg = 0u, ce = 0u;
#pragma unroll
    for (int i = 0; i < 16; ++i) { const unsigned k = keys[tid * 16 + i]; cg += (k > prefix) ? 1u : 0u; ce += (k == prefix) ? 1u : 0u; }
    unsigned v = cg | (ce << 16), inc = v;
#pragma unroll
    for (int o = 1; o < 64; o <<= 1) { const unsigned n = __shfl_up(inc, o); if (lane >= o) inc += n; }
    if (lane == 63) wtot[wave] = inc;
    __syncthreads();
    unsigned off = 0u;
    for (int w = 0; w < wave; ++w) off += wtot[w];
    const unsigned excl = off + inc - v;
    unsigned ng = excl & 0xffffu, ne = excl >> 16;
    int* IDX = WSP(int, WS_IDX) + it * CAP; int* SLOT = WSP(int, WS_SLOT);
#pragma unroll
    for (int i = 0; i < 16; ++i) { const int idx = tid * 16 + i; const unsigned k = keys[idx];
        const bool gt = k > prefix, eq = k == prefix; const bool sel = gt || (eq && ne < need);
        if (sel) { const int slot = (int)(ng + (ne < need ? ne : need)); IDX[slot] = idx; SLOT[((size_t)b * SEQ + idx) * 16 + e] = slot; }
        ng += gt ? 1u : 0u; ne += eq ? 1u : 0u; }
    __syncthreads();
}

__device__ __forceinline__ void gather_phase(Frame& F) {
    const int gw = F.vcu * NWAVES + F.wave, NGW = F.G * NWAVES, lane = F.lane;
    const int* IDX = WSP(int, WS_IDX);
    for (int r = gw; r < NEXP * 2 * CAP; r += NGW) {
        const int e = r >> 11, b = (r >> 10) & 1, j = r & 1023;
        const int tok = IDX[(b * 16 + e) * CAP + j];
        const GAS u32x4* src = (const GAS u32x4*)(WSP(bf16_t, WS_XN) + ((size_t)b * SEQ + tok) * DM);
        GAS u32x4* dst = (GAS u32x4*)(WSP(bf16_t, WS_XE) + (size_t)r * DM);
        dst[lane] = src[lane]; dst[64 + lane] = src[64 + lane];
    }
}

__device__ __forceinline__ void combine_phase(Frame& F, int l) {
    const int gw = F.vcu * NWAVES + F.wave, NGW = F.G * NWAVES, lane = F.lane;
    const float* mod = WSP(float, WS_MOD);
    const bf16_t* YE = WSP(bf16_t, WS_YE);
    for (int m = gw; m < MTOK; m += NGW) {
        const int b = m >> 13, s = m & 8191; const float* md = mod + (l * 2 + b) * 6144;
        int sl = -1; float gv = 0.f;
        if (lane < 16) { sl = WSP(int, WS_SLOT)[(size_t)m * 16 + lane]; gv = WSP(float, WS_AFF)[((size_t)b * 16 + lane) * SEQ + s]; }
        f32x4 acc[4];
#pragma unroll
        for (int j = 0; j < 4; ++j) acc[j] = (f32x4){0.f, 0.f, 0.f, 0.f};
#pragma unroll 1
        for (int e = 0; e < 16; ++e) {
            const int se = __shfl(sl, e);
            if (se >= 0) { const float ge = __shfl(gv, e);
                const GAS u32x2* rp = (const GAS u32x2*)(YE + ((size_t)e * 2048 + b * CAP + se) * DM) + lane;
#pragma unroll
                for (int j = 0; j < 4; ++j) { const u32x2 w = rp[64 * j]; acc[j] += (f32x4){bflo(w.x), bfhi(w.x), bflo(w.y), bfhi(w.y)} * ge; } }
        }
        f32x4 x1[4], pg[4], g2[4];
        ld_row_f32(WSP(float, WS_X1) + (size_t)m * DM, lane, x1);
        ld_row_f32(INF(8) + l * 1024, lane, pg); ld_row_f32(md + 5120, lane, g2);
        const float rstd = __builtin_amdgcn_rsqf(row_ss(acc) * (1.0f / DM) + EPS);
#pragma unroll
        for (int j = 0; j < 4; ++j) x1[j] = x1[j] + g2[j] * (acc[j] * rstd * pg[j]);
        st_row_f32(F.a->out + (size_t)m * DM, lane, x1);
        if (l == 0) { f32x4 h[4]; const float* md1 = mod + (1 * 2 + b) * 6144;
            modnorm(x1, INF(5) + 1024, md1 + 1024, md1, lane, h);
            st_row_bf16(WSP(bf16_t, WS_XN) + (size_t)m * DM, lane, h); }
    }
}

constexpr int PH_PER_LAYER = 13, N_PHASES = 2 + 2 * PH_PER_LAYER;
__global__ void __launch_bounds__(NTHR, 2) mega_fwd(Args args) {
    extern __shared__ __attribute__((aligned(16))) unsigned char lds_raw[];
    Frame F;
    F.lds = (LAS unsigned char*)lds_raw;
    F.tid = threadIdx.x; F.lane = F.tid & 63; F.wave = __builtin_amdgcn_readfirstlane(F.tid >> 6);
    F.G = gridDim.x; { const int bx = blockIdx.x; F.vcu = (F.G % 8 == 0) ? (bx % 8) * (F.G / 8) + bx / 8 : bx; }
    F.a = &args; F.ws = args.ws;
    volatile LAS unsigned* MISC = (volatile LAS unsigned*)(F.lds + MISC_OFF);
    for (int u = F.tid; u < (LDS_BYTES - LDSCTL_OFF) / 4; u += NTHR) ((LAS unsigned*)(F.lds + LDSCTL_OFF))[u] = 0u;
    __syncthreads();
    gu32* ctl = (gu32*)(F.ws + WS_CTL);
    XcdBarrier bar; bar.bar = (unsigned*)(ctl + CW_BAR); bar.x = 0; bar.st = nullptr;
#if !MK_SPLIT
    bar = xcd_barrier_post((unsigned*)(ctl + CW_BAR), MISC + 8);
#endif
    const int lo = args.ph_lo, hi = args.ph_hi;
    int ph = 0;
#if MK_SPLIT
#define SEAM() do { } while (0)
#else
#define SEAM() do { if (ph + 1 < hi) xcd_barrier(bar); } while (0)
#endif
#ifndef PHSEL
#define PHSEL -1
#endif
#ifndef PHMASK
#define PHMASK 0x7fff
#endif
#ifndef DBL_MASK
#define DBL_MASK 0
#endif
#define PHASE_BEGIN(id) if ((PHSEL < 0 || PHSEL == (id)) && ((PHMASK >> (id)) & 1) && lo <= ph && ph < hi) for (int rep_ = 0; rep_ < (((DBL_MASK >> (id)) & 1) ? 2 : 1); ++rep_) { if (rep_) xcd_barrier(bar); { int t_ = threadIdx.x; asm volatile("" : "+v"(t_)); F.tid = t_; F.lane = t_ & 63; F.wave = __builtin_amdgcn_readfirstlane(t_ >> 6); }
#define PHASE_END   SEAM(); } ++ph;

    PHASE_BEGIN(0) p0_phase(F); PHASE_END
    PHASE_BEGIN(1) p1_phase(F); PHASE_END
#pragma unroll 1
    for (int l = 0; l < 2; ++l) {
        const float* xin = (l == 0) ? (const float*)args.in[0] : (const float*)args.out;
        PHASE_BEGIN(2) {
            pg8::Gemm g{WSP(bf16_t, WS_XN), WSP(bf16_t, WS_WIN) + (size_t)l * DINP * 1024, MTOK, DINP, 1024}; pg8::StaticOrder S; S.init(MTOK, DINP, F.G, (int)blockIdx.x);
            pg8::EpiBf16 E{WSP(bf16_t, WS_U), DINP, DINP / 256};
            pg8::gemm_phase<pg8::EpiBf16, pg8::StaticOrder, true, true>(F.lds, g, S, E, F.tid);
        } PHASE_END
        PHASE_BEGIN(3) {
#ifndef SUBSEL
#define SUBSEL 0
#endif
            if (SUBSEL == 0 || SUBSEL == 1) for (int it = F.vcu; it < 1024; it += F.G) ml_local_item(F, it, l);
            if (SUBSEL == 0 || SUBSEL == 2) mla_prep_rows(F, l);
#ifndef HY_REP
#define HY_REP 1
#endif
            for (int rep2_ = 0; rep2_ < HY_REP; ++rep2_) for (int c = F.vcu; c < 256; c += F.G) hyena_item(F, c, l);
        } PHASE_END
        PHASE_BEGIN(4) {
            pg8::Gemm g{WSP(bf16_t, WS_AMLA), WSP(bf16_t, WS_WMLA) + (size_t)l * 1024 * 384, MTOK, 1024, 384}; pg8::StaticOrder S; S.init(MTOK, 1024, F.G, (int)blockIdx.x);
            pg8::EpiBf16 E{WSP(bf16_t, WS_OMLA), 1024, 4};
            if (SUBSEL == 0 || SUBSEL == 1) pg8::gemm_phase<pg8::EpiBf16, pg8::StaticOrder, true, true>(F.lds, g, S, E, F.tid);
            if (SUBSEL == 0 || SUBSEL == 2) ml_scan(F);
        } PHASE_END
        PHASE_BEGIN(5) relayout_phase(F); PHASE_END
        PHASE_BEGIN(6) {
            if (SUBSEL == 0 || SUBSEL == 1) for (int u = F.vcu; u < 256; u += F.G) attn_unit(F, u >> 5, u & 31);
            if (SUBSEL == 0 || SUBSEL == 2) for (int p = F.vcu; p < 512; p += F.G) ml_out_pair(F, p, l);
        } PHASE_END
        PHASE_BEGIN(7) headnorm_phase(F, l); PHASE_END
        PHASE_BEGIN(8) {
            pg8::Gemm g{WSP(bf16_t, WS_YN), WSP(bf16_t, WS_WOUT) + (size_t)l * 1024 * 1024, MTOK, 1024, 1024}; pg8::StaticOrder S; S.init(MTOK, 1024, F.G, (int)blockIdx.x);
            pg8::EpiF32 E{WSP(float, WS_Y2), 1024};
            pg8::gemm_phase<pg8::EpiF32, pg8::StaticOrder, true, true>(F.lds, g, S, E, F.tid);
        } PHASE_END
        PHASE_BEGIN(9) post_mixer_phase(F, l, xin); PHASE_END
        PHASE_BEGIN(10) { for (int it = F.vcu; it < 32; it += F.G) topk_item(F, it); } PHASE_END
        PHASE_BEGIN(11) gather_phase(F); PHASE_END
        PHASE_BEGIN(12) {
            pg8::Gemm g{WSP(bf16_t, WS_XE), WSP(bf16_t, WS_WGU) + (size_t)l * NEXP * 4096 * 1024, NEXP * 2048, NEXP * 4096, 1024}; pg8::GroupedOrder S; S.init(16, F.G, (int)blockIdx.x);
            pg8::EpiSwiGLU E{WSP(bf16_t, WS_ACT), EFF};
            pg8::gemm_phase<pg8::EpiSwiGLU, pg8::GroupedOrder, true, true>(F.lds, g, S, E, F.tid);
        } PHASE_END
        PHASE_BEGIN(13) {
            pg8::Gemm g{WSP(bf16_t, WS_ACT), WSP(bf16_t, WS_WDN) + (size_t)l * NEXP * 1024 * 2048, NEXP * 2048, NEXP * 1024, 2048}; pg8::GroupedOrder S; S.init(4, F.G, (int)blockIdx.x);
            pg8::EpiBf16 E{WSP(bf16_t, WS_YE), 1024, 4};
            pg8::gemm_phase<pg8::EpiBf16, pg8::GroupedOrder, true, true>(F.lds, g, S, E, F.tid);
        } PHASE_END
        PHASE_BEGIN(14) combine_phase(F, l); PHASE_END
    }
}

extern "C" void kernel_launch(void* const* d_in, const int* in_sizes, int n_in, void* d_out, int out_size, void* d_ws, size_t ws_size, hipStream_t stream) {
    static int grid = 0;
    if (grid == 0) {
        if (n_in != 35 || out_size != MTOK * DM || ws_size < WS_END) { fprintf(stderr, "kernel_launch: unexpected shapes: n_in %d out %d ws %zu (need %zu)\n", n_in, out_size, ws_size, (size_t)WS_END); grid = -1; return; }
        int dev = 0, cus = 0, per_cu = 0;
        if (hipGetDevice(&dev) != hipSuccess || hipDeviceGetAttribute(&cus, hipDeviceAttributeMultiprocessorCount, dev) != hipSuccess) { grid = -1; return; }
        if (hipFuncSetAttribute((const void*)mega_fwd, hipFuncAttributeMaxDynamicSharedMemorySize, LDS_BYTES) != hipSuccess) { fprintf(stderr, "kernel_launch: hipFuncSetAttribute failed\n"); grid = -1; return; }
        (void)hipOccupancyMaxActiveBlocksPerMultiprocessor(&per_cu, (const void*)mega_fwd, NTHR, LDS_BYTES);
        (void)hipGetLastError();
        grid = cus > 0 ? cus : 256;
        if (per_cu < 1) fprintf(stderr, "kernel_launch: occupancy query reports %d\n", per_cu);
    }
    if (grid < 0) return;
    (void)hipMemsetAsync((char*)d_ws + WS_CTL, 0, CTL_ZERO_BYTES, stream);
    Args a{};
    for (int i = 0; i < 35; ++i) a.in[i] = d_in[i];
    a.out = (float*)d_out; a.ws = (unsigned char*)d_ws;
#if MK_SPLIT
    for (int p = 0; p < N_PHASES; ++p) { a.ph_lo = p; a.ph_hi = p + 1; hipLaunchKernelGGL(mega_fwd, dim3(grid), dim3(NTHR), LDS_BYTES, stream, a); }
#else
    a.ph_lo = 0; a.ph_hi = N_PHASES;
    hipLaunchKernelGGL(mega_fwd, dim3(grid), dim3(NTHR), LDS_BYTES, stream, a);
#endif
}
```

```cpp
#include <hip/hip_runtime.h>
#include <cstdio>
#include <cstdint>

#ifndef MK_SPLIT
#define MK_SPLIT 0
#endif

#define GAS __attribute__((address_space(1)))
#define LAS __attribute__((address_space(3)))
typedef GAS unsigned gu32;
#define RLX_AGENT __ATOMIC_RELAXED, __HIP_MEMORY_SCOPE_AGENT
typedef unsigned short bf16_t;
typedef short bf16x8 __attribute__((ext_vector_type(8)));
typedef short s16x4 __attribute__((ext_vector_type(4)));
typedef float f32x4 __attribute__((ext_vector_type(4)));
typedef float f32x2 __attribute__((ext_vector_type(2)));
typedef float f32x16 __attribute__((ext_vector_type(16)));
typedef unsigned u32x4 __attribute__((ext_vector_type(4)));
typedef unsigned u32x2 __attribute__((ext_vector_type(2)));
typedef __bf16 bf16x2_t __attribute__((ext_vector_type(2)));

namespace pg8 {
#define PG8_LAS __attribute__((address_space(3)))
constexpr int BM = 256, BK = 64, HALF = 128, HTB = HALF * BK * 2, STAGE_BYTES = 8 * HTB, NXCD = 8, WGM = 8;
__host__ __device__ __forceinline__ int lds_byte(int r, int c) { const int st = (r >> 4) * 2 + (c >> 5), rr = r & 15, cc = c & 31, ob = rr * 64 + cc * 2; return st * 1024 + (ob ^ (((ob >> 9) & 1) << 5)); }
__host__ __device__ __forceinline__ void stage_rc(int b, int& R, int& C) { const int st = b / 1024, sb = b % 1024, swz = sb ^ (((sb >> 9) & 1) << 5); R = (st >> 1) * 16 + swz / 64; C = (st & 1) * 32 + (swz % 64) / 2; }
__host__ __device__ __forceinline__ int perm32(int rho) { const int n = rho >> 4, i = rho & 15; return 8 * (i >> 2) + 4 * n + (i & 3); }
struct Unit { int pm, pn; };
struct Gemm { const bf16_t* A; const bf16_t* Bt; int M, N, K; };
struct StaticOrder {
    int nM, nN, nwg, G, c;
    __host__ __device__ void init(int M, int N, int G_, int c_) { nM = M / BM; nN = N / BM; nwg = nM * nN; G = G_; c = c_; }
    __host__ __device__ bool next(int i, Unit& u) const {
        const long L = (long)i * G + c; if (L >= nwg) return false;
        int wgid = (int)L; { const int q = nwg / NXCD, r = nwg % NXCD, xcd = wgid % NXCD, off = wgid / NXCD; wgid = (xcd < r ? xcd * (q + 1) : r * (q + 1) + (xcd - r) * q) + off; }
        const int nig = WGM * nN, gid = wgid / nig, fm = gid * WGM, gsz = (nM - fm) < WGM ? (nM - fm) : WGM;
        u.pm = fm + ((wgid % nig) % gsz); u.pn = (wgid % nig) / gsz; return true;
    }
    __device__ __forceinline__ void a_ready(const Unit&) const {}
    __device__ __forceinline__ void done(const Unit&) const {}
};
struct GroupedOrder {
    int nNl, total, G, c;
    __host__ __device__ void init(int nNl_, int G_, int c_) { nNl = nNl_; total = 16 * 8 * nNl_; G = G_; c = c_; }
    __host__ __device__ bool next(int i, Unit& u) const {
        const long L = (long)i * G + c; if (L >= total) return false;
        const int per_e = 8 * nNl, e = (int)L / per_e, r = (int)L % per_e;
        u.pm = e * 8 + (r % 8); u.pn = e * nNl + (r / 8); return true;
    }
    __device__ __forceinline__ void a_ready(const Unit&) const {}
    __device__ __forceinline__ void done(const Unit&) const {}
};
__device__ __forceinline__ unsigned cvt_pk_bf16(float lo, float hi) { f32x2 v = {lo, hi}; bf16x2_t b = __builtin_convertvector(v, bf16x2_t); return __builtin_bit_cast(unsigned, b); }

struct EpiBf16 {
    static constexpr bool PERM = true, AFTER_DRAIN = false;
    bf16_t* O; int ldc; int ntn;
    __device__ __forceinline__ void operator()(const f32x4 (&acc)[2][2][4][2], const Unit& u, int wr, int wc, int fr, int fq) const {
        const int row0 = u.pm * BM + wr * 64 + fr; const int colt = (u.pn % ntn) * BM;
        const int col0 = colt + wc * 32 + 8 * fq;
#pragma unroll
        for (int ai = 0; ai < 2; ++ai)
#pragma unroll
            for (int m = 0; m < 4; ++m) { bf16_t* rowp = O + (size_t)(row0 + ai * HALF + m * 16) * ldc + col0;
#pragma unroll
                for (int bj = 0; bj < 2; ++bj) { const f32x4 v0 = acc[ai][bj][m][0], v1 = acc[ai][bj][m][1];
                    u32x4 w; w.x = cvt_pk_bf16(v0[0], v0[1]); w.y = cvt_pk_bf16(v0[2], v0[3]); w.z = cvt_pk_bf16(v1[0], v1[1]); w.w = cvt_pk_bf16(v1[2], v1[3]);
                    *(u32x4*)(rowp + bj * HALF) = w; } }
    }
};
struct EpiF32 {
    static constexpr bool PERM = false, AFTER_DRAIN = false;
    float* O; int ldc;
    __device__ __forceinline__ void operator()(const f32x4 (&acc)[2][2][4][2], const Unit& u, int wr, int wc, int fr, int fq) const {
        const int col0 = u.pn * BM + wc * 32 + 4 * fq;
#pragma unroll
        for (int ai = 0; ai < 2; ++ai)
#pragma unroll
            for (int m = 0; m < 4; ++m) { float* rowp = O + (size_t)(u.pm * BM + ai * HALF + wr * 64 + m * 16 + fr) * ldc + col0;
#pragma unroll
                for (int bj = 0; bj < 2; ++bj)
#pragma unroll
                    for (int n = 0; n < 2; ++n) *(f32x4*)(rowp + bj * HALF + n * 16) = acc[ai][bj][m][n]; }
    }
};
__device__ __forceinline__ float silu_f(float a) { return a * __builtin_amdgcn_rcpf(1.0f + __builtin_amdgcn_exp2f(-1.4426950408889634f * a)); }
struct EpiSwiGLU {
    static constexpr bool PERM = true, AFTER_DRAIN = false;
    bf16_t* O; int ldc;
    __device__ __forceinline__ void operator()(const f32x4 (&acc)[2][2][4][2], const Unit& u, int wr, int wc, int fr, int fq) const {
        const int row0 = u.pm * BM + wr * 64 + fr; const int col0 = (u.pn % 16) * HALF + wc * 32 + 8 * fq;
#pragma unroll
        for (int ai = 0; ai < 2; ++ai)
#pragma unroll
            for (int m = 0; m < 4; ++m) { bf16_t* rowp = O + (size_t)(row0 + ai * HALF + m * 16) * ldc + col0;
                const f32x4 g0 = acc[ai][0][m][0], g1 = acc[ai][0][m][1], u0 = acc[ai][1][m][0], u1 = acc[ai][1][m][1];
                u32x4 w;
                w.x = cvt_pk_bf16(silu_f(g0[0]) * u0[0], silu_f(g0[1]) * u0[1]); w.y = cvt_pk_bf16(silu_f(g0[2]) * u0[2], silu_f(g0[3]) * u0[3]);
                w.z = cvt_pk_bf16(silu_f(g1[0]) * u1[0], silu_f(g1[1]) * u1[1]); w.w = cvt_pk_bf16(silu_f(g1[2]) * u1[2], silu_f(g1[3]) * u1[3]);
                *(u32x4*)rowp = w; }
    }
};

template <class Epi, class Sched, bool ALIGN_EPI = false, bool SP2 = false>
__device__ __forceinline__ void gemm_phase(PG8_LAS unsigned char* lds, const Gemm g, const Sched& S, const Epi& E, const int tid) {
    const int wid = __builtin_amdgcn_readfirstlane(tid >> 6), lane = tid & 63, wr = wid >> 2, wc = wid & 3, fr = lane & 15, fq = lane >> 4;
    int K_ = g.K; asm volatile("" : "+s"(K_));
    const int K = K_, nt = K / BK;
    unsigned voffA[2], voffB[2];
#pragma unroll
    for (int i = 0; i < 2; ++i) { int R, C; stage_rc(tid * 16 + i * 8192, R, C); const int Rb = Epi::PERM ? ((R & ~31) + perm32(R & 31)) : R;
        voffA[i] = (unsigned)(R * K + C) * 2u; voffB[i] = (unsigned)(Rb * K + C) * 2u; }
    const size_t kstep = (size_t)(BK * 2);
    const size_t hstep = (size_t)HALF * K * 2;
    const size_t tstep = 2 * hstep;
    const unsigned ldsw = (unsigned)wid * 1024u;
    const int aoff = lds_byte(wr * 64 + fr, fq * 8), boff = lds_byte(wc * 32 + fr, fq * 8);
#define PG8_SA(b, h) (((b) * 2 + (h)) * HTB)
#define PG8_SB(b, h) ((4 + (b) * 2 + (h)) * HTB)
#define PG8_STAGE(bufoff, gbase, voff) do { _Pragma("unroll") for (int _i = 0; _i < 2; ++_i) \
        __builtin_amdgcn_global_load_lds((const unsigned*)((const char*)(gbase) + (voff)[_i]), (PG8_LAS unsigned*)(lds + (bufoff) + ldsw + _i * 8192), 16, 0, 0); } while (0)
#define PG8_LDA(dst, b, h) do { _Pragma("unroll") for (int m = 0; m < 4; ++m) _Pragma("unroll") for (int k = 0; k < 2; ++k) dst[m][k] = *(const PG8_LAS bf16x8*)(lds + PG8_SA(b, h) + aoff + m * 2048 + k * 1024); } while (0)
#define PG8_LDB(dst, b, h) do { _Pragma("unroll") for (int n = 0; n < 2; ++n) _Pragma("unroll") for (int k = 0; k < 2; ++k) dst[n][k] = *(const PG8_LAS bf16x8*)(lds + PG8_SB(b, h) + boff + n * 2048 + k * 1024); } while (0)
#define PG8_MMA(ai, bj, At, Bt) do { __builtin_amdgcn_s_setprio(1); _Pragma("unroll") for (int m = 0; m < 4; ++m) _Pragma("unroll") for (int n = 0; n < 2; ++n) _Pragma("unroll") for (int k = 0; k < 2; ++k) \
        acc[ai][bj][m][n] = __builtin_amdgcn_mfma_f32_16x16x32_bf16(Bt[n][k], At[m][k], acc[ai][bj][m][n], 0, 0, 0); __builtin_amdgcn_s_setprio(0); } while (0)
#define PG8_WAIT_V(n) asm volatile("s_waitcnt vmcnt(" #n ")" ::: "memory")
#define PG8_WAIT_L(n) asm volatile("s_waitcnt lgkmcnt(" #n ")" ::: "memory")
#define PG8_BAR __builtin_amdgcn_s_barrier()
#define PG8_SCHED __builtin_amdgcn_sched_barrier(0)
    Unit cur, nxt; int ui = 0;
    if (!S.next(0, cur)) return;
    f32x4 acc[2][2][4][2];
#pragma unroll
    for (int a = 0; a < 2; ++a)
#pragma unroll
        for (int b = 0; b < 2; ++b)
#pragma unroll
            for (int m = 0; m < 4; ++m)
#pragma unroll
                for (int n = 0; n < 2; ++n) acc[a][b][m][n] = (f32x4){0.f, 0.f, 0.f, 0.f};
    bf16x8 At[4][2], B0[2][2], B1[2][2];
    const char* cA = (const char*)g.A + (size_t)cur.pm * tstep; const char* cB = (const char*)g.Bt + (size_t)cur.pn * tstep;
    S.a_ready(cur);
    if constexpr (SP2) {
        PG8_STAGE(PG8_SB(0, 0), cB, voffB); PG8_STAGE(PG8_SB(0, 1), cB + hstep, voffB); PG8_STAGE(PG8_SA(0, 0), cA, voffA); PG8_STAGE(PG8_SA(0, 1), cA + hstep, voffA);
        if (wr == 1) PG8_BAR;
        PG8_WAIT_V(2); PG8_BAR;
        PG8_STAGE(PG8_SB(1, 0), cB + kstep, voffB); PG8_STAGE(PG8_SA(1, 0), cA + kstep, voffA); PG8_STAGE(PG8_SB(1, 1), cB + hstep + kstep, voffB);
        PG8_WAIT_V(6); PG8_BAR;
    } else {
        PG8_STAGE(PG8_SB(0, 0), cB, voffB); PG8_STAGE(PG8_SA(0, 0), cA, voffA); PG8_STAGE(PG8_SB(0, 1), cB + hstep, voffB); PG8_STAGE(PG8_SA(0, 1), cA + hstep, voffA);
        if (wr == 1) PG8_BAR;
        PG8_WAIT_V(4); PG8_BAR;
        PG8_STAGE(PG8_SB(1, 0), cB + kstep, voffB); PG8_STAGE(PG8_SA(1, 0), cA + kstep, voffA); PG8_STAGE(PG8_SB(1, 1), cB + hstep + kstep, voffB);
        PG8_WAIT_V(6); PG8_BAR;
    }
    for (;;) {
        const bool has_next = S.next(ui + 1, nxt);
        const char* nA = has_next ? (const char*)g.A + (size_t)nxt.pm * tstep : cA; const char* nB = has_next ? (const char*)g.Bt + (size_t)nxt.pn * tstep : cB;
        for (int t = 0; t < nt; t += 2) {
            const bool last = (t == nt - 2);
            const char* a1 = cA + (size_t)(t + 1) * kstep;
            const char* a2 = last ? nA : cA + (size_t)(t + 2) * kstep; const char* b2 = last ? nB : cB + (size_t)(t + 2) * kstep;
            const char* a3 = a2 + kstep; const char* b3 = b2 + kstep;
            if (last && has_next) S.a_ready(nxt);
            if constexpr (SP2) {
            PG8_LDB(B0, 0, 0); PG8_LDB(B1, 0, 1); PG8_SCHED; PG8_LDA(At, 0, 0); PG8_STAGE(PG8_SA(1, 1), a1 + hstep, voffA);
            PG8_WAIT_V(8); PG8_WAIT_L(0); PG8_BAR; PG8_MMA(0, 0, At, B0); PG8_MMA(0, 1, At, B1); PG8_BAR; PG8_SCHED;
            PG8_LDA(At, 0, 1); PG8_STAGE(PG8_SB(0, 0), b2, voffB); PG8_STAGE(PG8_SB(0, 1), b2 + hstep, voffB); PG8_STAGE(PG8_SA(0, 0), a2, voffA);
            PG8_WAIT_V(8); PG8_WAIT_L(0); PG8_BAR; PG8_MMA(1, 0, At, B0); PG8_MMA(1, 1, At, B1); PG8_BAR; PG8_SCHED;
            PG8_LDB(B0, 1, 0); PG8_LDB(B1, 1, 1); PG8_SCHED; PG8_LDA(At, 1, 0); PG8_STAGE(PG8_SA(0, 1), a2 + hstep, voffA);
            PG8_WAIT_V(8); PG8_WAIT_L(0); PG8_BAR; PG8_MMA(0, 0, At, B0); PG8_MMA(0, 1, At, B1); PG8_BAR; PG8_SCHED;
            PG8_LDA(At, 1, 1); PG8_STAGE(PG8_SB(1, 0), b3, voffB); PG8_STAGE(PG8_SB(1, 1), b3 + hstep, voffB); PG8_STAGE(PG8_SA(1, 0), a3, voffA);
            PG8_WAIT_V(8); PG8_WAIT_L(0); PG8_BAR; PG8_MMA(1, 0, At, B0); PG8_MMA(1, 1, At, B1); PG8_BAR; PG8_SCHED;
            } else {
            PG8_LDB(B0, 0, 0); PG8_SCHED; PG8_LDA(At, 0, 0); PG8_STAGE(PG8_SA(1, 1), a1 + hstep, voffA);
            PG8_WAIT_L(8); PG8_BAR; PG8_WAIT_L(0); PG8_MMA(0, 0, At, B0); PG8_BAR; PG8_SCHED;
            PG8_LDB(B1, 0, 1); PG8_STAGE(PG8_SB(0, 0), b2, voffB);
            PG8_BAR; PG8_WAIT_L(0); PG8_MMA(0, 1, At, B1); PG8_BAR;
            PG8_LDA(At, 0, 1); PG8_STAGE(PG8_SA(0, 0), a2, voffA);
            PG8_BAR; PG8_WAIT_L(0); PG8_MMA(1, 0, At, B0); PG8_BAR; PG8_SCHED;
            PG8_STAGE(PG8_SB(0, 1), b2 + hstep, voffB);
            PG8_WAIT_V(6); PG8_BAR; PG8_MMA(1, 1, At, B1); PG8_BAR;
            PG8_LDB(B0, 1, 0); PG8_SCHED; PG8_LDA(At, 1, 0); PG8_STAGE(PG8_SA(0, 1), a2 + hstep, voffA);
            PG8_WAIT_L(8); PG8_BAR; PG8_WAIT_L(0); PG8_MMA(0, 0, At, B0); PG8_BAR; PG8_SCHED;
            PG8_LDB(B1, 1, 1); PG8_STAGE(PG8_SB(1, 0), b3, voffB);
            PG8_BAR; PG8_WAIT_L(0); PG8_MMA(0, 1, At, B1); PG8_BAR;
            PG8_LDA(At, 1, 1); PG8_STAGE(PG8_SA(1, 0), a3, voffA);
            PG8_BAR; PG8_WAIT_L(0); PG8_MMA(1, 0, At, B0); PG8_BAR; PG8_SCHED;
            PG8_STAGE(PG8_SB(1, 1), b3 + hstep, voffB);
            PG8_WAIT_V(6); PG8_BAR; PG8_MMA(1, 1, At, B1); PG8_BAR;
            }
        }
        if constexpr (ALIGN_EPI) { if (wr == 0) PG8_BAR; }
        if constexpr (!Epi::AFTER_DRAIN) { E(acc, cur, wr, wc, fr, fq); S.done(cur); }
        if (!has_next) break;
#pragma unroll
        for (int a = 0; a < 2; ++a)
#pragma unroll
            for (int b = 0; b < 2; ++b)
#pragma unroll
                for (int m = 0; m < 4; ++m)
#pragma unroll
                    for (int n = 0; n < 2; ++n) acc[a][b][m][n] = (f32x4){0.f, 0.f, 0.f, 0.f};
        cur = nxt; cA = nA; cB = nB; ++ui;
        if constexpr (ALIGN_EPI) { if (wr == 1) PG8_BAR; }
    }
    PG8_WAIT_V(0);
    if constexpr (!ALIGN_EPI) { if (wr == 0) PG8_BAR; }
    PG8_BAR;
#undef PG8_SA
#undef PG8_SB
#undef PG8_STAGE
#undef PG8_LDA
#undef PG8_LDB
#undef PG8_MMA
#undef PG8_WAIT_V
#undef PG8_WAIT_L
#undef PG8_BAR
#undef PG8_SCHED
}
}

constexpr int NWAVES = 8, NTHR = 512;
constexpr int BATCH = 2, SEQ = 8192, DM = 1024, MTOK = BATCH * SEQ;
constexpr int DIN = 2960, DINP = 3072;
constexpr int NEXP = 16, CAP = 1024, EFF = 2048;
constexpr float EPS = 1e-6f;
constexpr int U_MLQ = 0, U_MLK = 256, U_MLV = 512, U_MLO = 768, U_MLG = 1024, U_CQ = 1040, U_CKV = 1264, U_KR = 1392, U_HY = 1424, U_SC = 2192;
constexpr float LOG2E = 1.4426950408889634f;

constexpr size_t MiB = 1u << 20;
constexpr size_t WS_CTL = 0, CTL_ZERO_BYTES = 1 * MiB;
constexpr size_t WS_MOD = 1 * MiB;
constexpr size_t WS_MLS = 1 * MiB + 128 * 1024;
constexpr size_t WS_MLN = 1 * MiB + 256 * 1024;
constexpr size_t WS_AFF = 2 * MiB;
constexpr size_t WS_SLOT = 3 * MiB;
constexpr size_t WS_IDX = 4 * MiB;
constexpr size_t WS_HID = 5 * MiB;
constexpr size_t WS_WMLA = 9 * MiB;
constexpr size_t WS_WOUT = 11 * MiB;
constexpr size_t WS_WIN = 15 * MiB;
constexpr size_t WS_WGU = 28 * MiB;
constexpr size_t WS_WDN = 284 * MiB;
constexpr size_t WS_XN = 412 * MiB;
constexpr size_t WS_AMLA = 444 * MiB;
constexpr size_t WS_Q = 456 * MiB;
constexpr size_t WS_KIMG = 468 * MiB;
constexpr size_t WS_VIMG = 480 * MiB;
constexpr size_t WS_MLC = 488 * MiB;
constexpr size_t WS_HF = 504 * MiB;
constexpr size_t WS_HB = 520 * MiB;
constexpr size_t WS_YATT = 536 * MiB;
constexpr size_t WS_YHT = 544 * MiB;
constexpr size_t WS_YN = 552 * MiB;
constexpr size_t WS_X1 = 584 * MiB;
constexpr size_t WS_U = 648 * MiB;
constexpr size_t WS_OMLA = 744 * MiB;
constexpr size_t WS_ACT = 648 * MiB;
constexpr size_t WS_KF = 776 * MiB;
constexpr size_t WS_Y2 = 776 * MiB;
constexpr size_t WS_XE = 776 * MiB;
constexpr size_t WS_YE = 840 * MiB;
constexpr size_t WS_HYT = 904 * MiB;
constexpr size_t WS_FILT = 956 * MiB;
constexpr size_t WS_END = 1020 * MiB;
constexpr int CW_BAR = 4096;

constexpr int RING_BYTES = 131072;
constexpr int LDSCTL_OFF = RING_BYTES, MISC_OFF = LDSCTL_OFF + 320;
constexpr int XTRA_OFF = RING_BYTES + 1024;
constexpr int LDS_BYTES = 147456;

__device__ __forceinline__ float bf2f(unsigned short u) { return __uint_as_float((unsigned)u << 16); }
__device__ __forceinline__ unsigned pk2(float lo, float hi) { f32x2 v = {lo, hi}; bf16x2_t b = __builtin_convertvector(v, bf16x2_t); return __builtin_bit_cast(unsigned, b); }
__device__ __forceinline__ float bflo(unsigned w) { return __uint_as_float(w << 16); }
__device__ __forceinline__ float bfhi(unsigned w) { return __uint_as_float(w & 0xffff0000u); }
__device__ __forceinline__ float wave_sum(float v) {
#pragma unroll
    for (int o = 1; o < 64; o <<= 1) v += __shfl_xor(v, o);
    return v;
}
__device__ __forceinline__ float fexp(float x) { return __builtin_amdgcn_exp2f(x * LOG2E); }
__device__ __forceinline__ float flog(float x) { return __builtin_amdgcn_logf(x) * 0.6931471805599453f; }
__device__ __forceinline__ float sin_rev(float r) { return __builtin_amdgcn_sinf(r); }
__device__ __forceinline__ float cos_rev(float r) { return __builtin_amdgcn_cosf(r); }
__device__ __forceinline__ float sin_rad(float x) { float r = x * 0.15915494309189535f; r = r - __builtin_rintf(r); return __builtin_amdgcn_sinf(r); }
__device__ __forceinline__ int crow(int r, int hi) { return (r & 3) + 8 * (r >> 2) + 4 * hi; }
#define LDS_WAIT() asm volatile("s_waitcnt lgkmcnt(0)" ::: "memory")
#define VM_WAIT() asm volatile("s_waitcnt vmcnt(0)" ::: "memory")

#define XB_TMO      128
#define XB_XCNT(j)  (256  + 64 * (j))
#define XB_XSUB(j)  (1280 + 64 * (j))
#define XB_XGEN(j)  (2304 + 64 * (j))
#define XB_TOP      3328
#define XB_TOPGEN   3392
#define XCD_BAR_WORDS 3456
#define XB_SPIN_CAP (1u << 18)
__device__ __forceinline__ unsigned xb_ld(unsigned* p)              { return __hip_atomic_load(p, __ATOMIC_RELAXED, __HIP_MEMORY_SCOPE_AGENT); }
__device__ __forceinline__ unsigned xb_add(unsigned* p, unsigned v) { return __hip_atomic_fetch_add(p, v, __ATOMIC_RELAXED, __HIP_MEMORY_SCOPE_AGENT); }
__device__ __forceinline__ unsigned xb_xcc_id() { return (unsigned)__builtin_amdgcn_s_getreg((3 << 11) | 20) & 0xFu; }
#define XB_SPIN(cond, bar) do { unsigned _sp = 0; while (cond) { __builtin_amdgcn_s_sleep(1); \
    if ((++_sp & 255u) == 0u) { if (xb_ld(&(bar)[XB_TMO])) break; if (_sp > XB_SPIN_CAP) { atomicAdd(&(bar)[XB_TMO], 1u); break; } } } } while (0)
struct XcdBarrier { unsigned* bar; unsigned x; volatile LAS unsigned* st; };
__device__ __forceinline__ XcdBarrier xcd_barrier_post(unsigned* bar, volatile LAS unsigned* st) {
    XcdBarrier b; b.bar = bar; b.x = xb_xcc_id(); b.st = st;
    if (threadIdx.x == 0) (void)xb_add(&bar[XB_XCNT(b.x)], 1u);
    return b;
}
__device__ __forceinline__ void xcd_barrier_complete(unsigned* bar, unsigned x, unsigned& nloc, unsigned& nx) {
    const unsigned G = gridDim.x * gridDim.y * gridDim.z;
    unsigned sum, cnt, mine, sp = 0u;
    for (;;) {
        sum = 0u; cnt = 0u; mine = 0u;
#pragma unroll
        for (unsigned j = 0; j < 16; ++j) { const unsigned c = xb_ld(&bar[XB_XCNT(j)]); sum += c; cnt += (c > 0u) ? 1u : 0u; mine = (j == x) ? c : mine; }
        if (sum == G) break;
        __builtin_amdgcn_s_sleep(1);
        if ((++sp & 255u) == 0u) { if (xb_ld(&bar[XB_TMO])) break; if (sp > XB_SPIN_CAP) { atomicAdd(&bar[XB_TMO], 1u); break; } }
    }
    nloc = mine > 0u ? mine : 1u; nx = cnt > 0u ? cnt : 1u;
}
__device__ __forceinline__ void xcd_barrier(const XcdBarrier& b) {
    asm volatile("s_waitcnt vmcnt(0)" ::: "memory");
    __syncthreads();
    if (threadIdx.x == 0) {
        unsigned* bar = b.bar;
        __builtin_amdgcn_s_waitcnt(0);
        unsigned nloc = b.st[0], nx = b.st[1];
        if (nloc == 0u) { xcd_barrier_complete(bar, b.x, nloc, nx); b.st[0] = nloc; b.st[1] = nx; }
        const unsigned old = xb_add(&bar[XB_XSUB(b.x)], 1u);
        const unsigned gen = old / nloc;
        if (old + 1u == (gen + 1u) * nloc) {
            __builtin_amdgcn_fence(__ATOMIC_RELEASE, "agent");
            asm volatile("s_waitcnt vmcnt(0)" ::: "memory");
            const unsigned og = xb_add(&bar[XB_TOP], 1u);
            const unsigned tg = og / nx;
            if (og + 1u == (tg + 1u) * nx) xb_add(&bar[XB_TOPGEN], 1u);
            else XB_SPIN(xb_ld(&bar[XB_TOPGEN]) == tg, bar);
            __builtin_amdgcn_fence(__ATOMIC_ACQUIRE, "agent");
            xb_add(&bar[XB_XGEN(b.x)], 1u);
            asm volatile("s_waitcnt vmcnt(0)" ::: "memory");
        } else {
            XB_SPIN(xb_ld(&bar[XB_XGEN(b.x)]) == gen, bar);
            __builtin_amdgcn_fence(__ATOMIC_ACQUIRE, "agent");
            asm volatile("s_waitcnt vmcnt(0)" ::: "memory");
        }
    }
    __syncthreads();
}

struct Args { const void* in[35]; float* out; unsigned char* ws; int ph_lo, ph_hi; };
struct Frame {
    LAS unsigned char* lds;
    int tid, lane, wave, vcu, G;
    const Args* a;
    unsigned char* ws;
};
#define INF(i) ((const float*)F.a->in[i])
#define WSP(T, off) ((T*)(F.ws + (off)))

__device__ __forceinline__ void tr_item(const float* W, int ldw, int Kvalid, int Nvalid, int k0, int n0, bf16_t* dst, int dpitch, int drow0, int dk0, LAS float* scr, int lane) {
    f32x4 v[16];
    const int nn = n0 + 4 * (lane & 15);
#pragma unroll
    for (int i = 0; i < 16; ++i) { const int kk = 4 * i + (lane >> 4);
        v[i] = (f32x4){0.f, 0.f, 0.f, 0.f};
        if (W != nullptr && (k0 + kk) < Kvalid && nn < Nvalid) v[i] = *(const GAS f32x4*)(W + (size_t)(k0 + kk) * ldw + nn); }
#pragma unroll
    for (int i = 0; i < 16; ++i) { const int kk = 4 * i + (lane >> 4);
        *(LAS f32x4*)(scr + kk * 64 + ((4 * (lane & 15)) ^ (4 * ((kk >> 3) & 7)))) = v[i]; }
    LDS_WAIT(); asm volatile("" ::: "memory");
    const int kc = lane & 7, nl = lane >> 3;
#pragma unroll
    for (int j = 0; j < 8; ++j) { const int n = 8 * j + nl; const LAS float* sp = scr + (8 * kc) * 64 + (n ^ (4 * kc));
        u32x4 o; o.x = pk2(sp[0 * 64], sp[1 * 64]); o.y = pk2(sp[2 * 64], sp[3 * 64]); o.z = pk2(sp[4 * 64], sp[5 * 64]); o.w = pk2(sp[6 * 64], sp[7 * 64]);
        *(GAS u32x4*)(dst + (size_t)(drow0 + n) * dpitch + dk0 + k0 + 8 * kc) = o; }
    LDS_WAIT(); asm volatile("" ::: "memory");
}

__device__ __forceinline__ void p0_phase(Frame& F) {
    const int tid = F.tid, lane = F.lane, wave = F.wave;
    {
        LAS float* cs = (LAS float*)(F.lds);
        LAS float* red = (LAS float*)(F.lds + 8192);
        const float* c = INF(1);
        for (int i = tid; i < 2048; i += NTHR) { const float v = c[i]; cs[i] = v / (1.0f + fexp(-v)); }
        __syncthreads();
        for (int cb = blockIdx.x; cb < 256; cb += F.G) {
            const int j = tid % 48, kg = tid / 48;
            const int col = cb * 48 + j, l = col / 6144, n = col % 6144;
            if (kg < 10) {
                const float* w = INF(3) + (size_t)l * 1024 * 6144 + n;
                float a0 = 0.f, a1 = 0.f;
#pragma unroll 4
                for (int k = kg; k < 1024; k += 10) { const float wv = w[(size_t)k * 6144]; a0 += cs[k] * wv; a1 += cs[1024 + k] * wv; }
                red[(kg * 48 + j) * 2] = a0; red[(kg * 48 + j) * 2 + 1] = a1;
            }
            __syncthreads();
            if (tid < 96) { const int jj = tid >> 1, b = tid & 1; float s = 0.f;
                for (int g = 0; g < 10; ++g) s += red[(g * 48 + jj) * 2 + b];
                const int col2 = cb * 48 + jj, l2 = col2 / 6144, n2 = col2 % 6144;
                WSP(float, WS_MOD)[(l2 * 2 + b) * 6144 + n2] = s + INF(4)[l2 * 6144 + n2]; }
            __syncthreads();
        }
    }
    {
        const int gw = F.vcu * NWAVES + wave, NGW = F.G * NWAVES;
        for (int l = 0; l < 2; ++l) {
            const float* w1 = INF(18) + l * 17 * 64; const float* w2 = INF(21) + l * 64 * 64;
            float w1c[17], w2c[64];
#pragma unroll
            for (int i = 0; i < 17; ++i) w1c[i] = w1[i * 64 + lane];
#pragma unroll
            for (int k = 0; k < 64; ++k) w2c[k] = w2[k * 64 + lane];
            const float b1 = INF(19)[l * 64 + lane], fr1 = INF(20)[l * 64 + lane], b2 = INF(22)[l * 64 + lane], fr2 = INF(23)[l * 64 + lane];
            for (int t = gw; t < SEQ; t += NGW) {
                const float tt = (float)t * (1.0f / SEQ);
                float a = b1 + tt * w1c[0];
#pragma unroll
                for (int bnd = 1; bnd <= 8; ++bnd) { float r = (float)((t * bnd) & (SEQ - 1)) * (1.0f / SEQ); a += sin_rev(r) * w1c[bnd] + cos_rev(r) * w1c[8 + bnd]; }
                const float h1 = sin_rad(fr1 * a);
                float a2 = b2;
#pragma unroll
                for (int k = 0; k < 64; ++k) a2 += __shfl(h1, k) * w2c[k];
                WSP(float, WS_HID)[((size_t)l * SEQ + t) * 64 + lane] = sin_rad(fr2 * a2);
            }
        }
    }
    {
        LAS float* scr = (LAS float*)(F.lds + wave * 16384);
        const int gw = F.vcu * NWAVES + wave, NGW = F.G * NWAVES;
        constexpr int I_WIN = 16 * 48, I_WOUT = 16 * 16, I_WMLA = 6 * 16, I_GU = 16 * 2 * 16 * 32, I_DN = 16 * 32 * 16;
        constexpr int I_LAYER = I_WIN + I_WOUT + I_WMLA + I_GU + I_DN;
        for (int it = gw; it < 2 * I_LAYER; it += NGW) {
            const int l = it / I_LAYER; int r = it % I_LAYER;
            if (r < I_WIN) { const int kb = r / 48, nb = r % 48;
                tr_item(INF(9) + (size_t)l * 1024 * DIN, DIN, 1024, DIN, kb * 64, nb * 64, WSP(bf16_t, WS_WIN) + (size_t)l * DINP * 1024, 1024, nb * 64, 0, scr, lane); continue; }
            r -= I_WIN;
            if (r < I_WOUT) { const int kb = r / 16, nb = r % 16;
                tr_item(INF(30) + (size_t)l * 1024 * 1024, 1024, 1024, 1024, kb * 64, nb * 64, WSP(bf16_t, WS_WOUT) + (size_t)l * 1024 * 1024, 1024, nb * 64, 0, scr, lane); continue; }
            r -= I_WOUT;
            if (r < I_WMLA) { const int kb = r / 16, nb = r % 16;
                bf16_t* dst = WSP(bf16_t, WS_WMLA) + (size_t)l * 1024 * 384;
                const float* W = nullptr; int ldw = 4, Kv = 0, Nv = 0, ksrc = 0, nsrc = 0;
                if (nb < 6 && kb < 4) { W = INF(13) + (size_t)l * 224 * 384; ldw = 384; Kv = 224; Nv = 384; ksrc = kb * 64; nsrc = nb * 64; }
                else if (nb >= 6 && nb < 10 && kb >= 4) { W = INF(14) + (size_t)l * 128 * 256; ldw = 256; Kv = 128; Nv = 256; ksrc = (kb - 4) * 64; nsrc = (nb - 6) * 64; }
                else if (nb >= 10 && nb < 14 && kb >= 4) { W = INF(15) + (size_t)l * 128 * 256; ldw = 256; Kv = 128; Nv = 256; ksrc = (kb - 4) * 64; nsrc = (nb - 10) * 64; }
                tr_item(W, ldw, Kv, Nv, ksrc, nsrc, dst, 384, nb * 64, kb * 64 - ksrc, scr, lane); continue; }
            r -= I_WMLA;
            if (r < I_GU) { const int e = r / (2 * 16 * 32); int q = r % (2 * 16 * 32); const int which = q / (16 * 32); q %= (16 * 32); const int kb = q / 32, nb = q % 32;
                const float* W = INF(which ? 33 : 32) + ((size_t)l * NEXP + e) * 1024 * 2048;
                const int n0 = nb * 64, drow = (n0 >> 7) * 256 + (n0 & 127) + (which ? 128 : 0);
                tr_item(W, 2048, 1024, 2048, kb * 64, n0, WSP(bf16_t, WS_WGU) + ((size_t)l * NEXP + e) * 4096 * 1024, 1024, drow, 0, scr, lane); continue; }
            r -= I_GU;
            { const int e = r / (32 * 16); const int q = r % (32 * 16); const int kb = q / 16, nb = q % 16;
                const float* W = INF(34) + ((size_t)l * NEXP + e) * 2048 * 1024;
                tr_item(W, 1024, 2048, 1024, kb * 64, nb * 64, WSP(bf16_t, WS_WDN) + ((size_t)l * NEXP + e) * 1024 * 2048, 2048, nb * 64, 0, scr, lane); }
        }
    }
}

__device__ __forceinline__ void ld_row_f32(const float* p, int lane, f32x4 (&v)[4]) {
    const GAS f32x4* r = (const GAS f32x4*)p + lane;
#pragma unroll
    for (int j = 0; j < 4; ++j) v[j] = r[64 * j];
}
__device__ __forceinline__ void st_row_f32(float* p, int lane, const f32x4 (&v)[4]) {
    GAS f32x4* r = (GAS f32x4*)p + lane;
#pragma unroll
    for (int j = 0; j < 4; ++j) r[64 * j] = v[j];
}
__device__ __forceinline__ void st_row_bf16(bf16_t* p, int lane, const f32x4 (&v)[4]) {
    GAS u32x2* r = (GAS u32x2*)p + lane;
#pragma unroll
    for (int j = 0; j < 4; ++j) { u32x2 w; w.x = pk2(v[j].x, v[j].y); w.y = pk2(v[j].z, v[j].w); r[64 * j] = w; }
}
__device__ __forceinline__ float row_ss(const f32x4 (&v)[4]) {
    float s = 0.f;
#pragma unroll
    for (int j = 0; j < 4; ++j) s += (v[j].x * v[j].x + v[j].y * v[j].y) + (v[j].z * v[j].z + v[j].w * v[j].w);
    return wave_sum(s);
}
__device__ __forceinline__ void modnorm(const f32x4 (&x)[4], const float* g, const float* sc, const float* sh, int lane, f32x4 (&h)[4]) {
    const float rstd = __builtin_amdgcn_rsqf(row_ss(x) * (1.0f / DM) + EPS);
    f32x4 gv[4], scv[4], shv[4];
    ld_row_f32(g, lane, gv); ld_row_f32(sc, lane, scv); ld_row_f32(sh, lane, shv);
#pragma unroll
    for (int j = 0; j < 4; ++j) h[j] = (x[j] * rstd) * gv[j] * (scv[j] + 1.0f) + shv[j];
}

__device__ __forceinline__ void filt_gemm_tile(Frame& F, int wt) {
    const int lane = F.lane, hi = lane >> 5, l31 = lane & 31;
    const int l = wt >> 11, r = wt & 2047, t0 = (r >> 3) * 32, col0 = (r & 7) * 128;
    f32x16 acc[4];
#pragma unroll
    for (int jb = 0; jb < 4; ++jb)
#pragma unroll
        for (int q = 0; q < 16; ++q) acc[jb][q] = 0.f;
    const float* hid = WSP(float, WS_HID) + ((size_t)l * SEQ + t0 + l31) * 64 + hi;
    const float* w3 = INF(24) + (size_t)l * 64 * 1024 + (size_t)hi * 1024 + col0 + l31;
#pragma unroll 4
    for (int s2 = 0; s2 < 32; ++s2) {
        const float bv = hid[2 * s2];
#pragma unroll
        for (int jb = 0; jb < 4; ++jb) { const float av = w3[(size_t)(2 * s2) * 1024 + 32 * jb]; acc[jb] = __builtin_amdgcn_mfma_f32_32x32x2f32(av, bv, acc[jb], 0, 0, 0); }
    }
    const float tt = (float)(t0 + l31) * (1.0f / SEQ);
    float* FT = WSP(float, WS_FILT) + (size_t)l * 1024 * SEQ + t0 + l31;
#pragma unroll
    for (int jb = 0; jb < 4; ++jb)
#pragma unroll
        for (int q = 0; q < 16; ++q) { const int col = col0 + 32 * jb + crow(q, hi);
            const float v = (acc[jb][q] + INF(25)[l * 1024 + col]) * fexp(-tt * fexp(INF(26)[l * 1024 + col]));
            FT[(size_t)col * SEQ] = v; }
}

__device__ __forceinline__ void p1_phase(Frame& F) {
    const int gw = F.vcu * NWAVES + F.wave, NGW = F.G * NWAVES;
    const float* mod = WSP(float, WS_MOD);
    for (int m = gw; m < MTOK; m += NGW) {
        const int b = m >> 13; f32x4 x[4], h[4];
        ld_row_f32(INF(0) + (size_t)m * DM, F.lane, x);
        modnorm(x, INF(5), mod + (0 * 2 + b) * 6144 + 1024, mod + (0 * 2 + b) * 6144, F.lane, h);
        st_row_bf16(WSP(bf16_t, WS_XN) + (size_t)m * DM, F.lane, h);
    }
    for (int wt = gw; wt < 4096; wt += NGW) filt_gemm_tile(F, wt);
}

__device__ __forceinline__ float logsigmoid(float x) { return fminf(x, 0.f) - flog(1.0f + fexp(-fabsf(x))); }
struct MlItem { int b, h, dir, n, t0; };
__device__ __forceinline__ MlItem ml_decode(int item) { MlItem I; I.b = item >> 9; I.h = (item >> 7) & 3; I.dir = (item >> 6) & 1; I.n = item & 63;
    I.t0 = I.b * SEQ + (I.dir ? SEQ - 128 * (I.n + 1) : 128 * I.n); return I; }

__device__ __forceinline__ void ml_local_item(Frame& F, int item, int l) {
    const int tid = F.tid; const MlItem I = ml_decode(item);
    const bf16_t* U = WSP(bf16_t, WS_U);
    LAS float* EK = (LAS float*)(F.lds);
    LAS float* VV = (LAS float*)(F.lds + 32768);
    LAS float* LF = (LAS float*)(F.lds + 65536);
    LAS float* IG = LF + 128; LAS float* WW = LF + 256; LAS float* EST = LF + 384;
    const float* gb = INF(10) + l * 16;
    if (tid < 128) { const int j = tid, r = I.dir ? 127 - j : j; const size_t t = (size_t)(I.t0 + r);
        const float ipre = bf2f(U[t * DINP + U_MLG + (I.dir ? 2 : 0) * 4 + I.h]) + gb[(I.dir ? 2 : 0) * 4 + I.h];
        const float fpre = bf2f(U[t * DINP + U_MLG + (I.dir ? 3 : 1) * 4 + I.h]) + gb[(I.dir ? 3 : 1) * 4 + I.h];
        LF[j] = logsigmoid(fpre); IG[j] = ipre; }
    __syncthreads();
    float a = 0.f, aend = 0.f;
    if (tid < 128) { for (int i = 0; i < 128; ++i) { const float v = LF[i]; aend += v; if (i <= tid) a += v; }
        WW[tid] = aend - a + IG[tid]; }
    __syncthreads();
    float mloc = -3.0e38f;
    if (tid < 128) { for (int i = 0; i < 128; ++i) mloc = fmaxf(mloc, WW[i]);
        const int r = I.dir ? 127 - tid : tid; EST[r] = fexp(WW[tid] - mloc); }
    __syncthreads();
#pragma unroll
    for (int i = 0; i < 2; ++i) { const int p = tid + 512 * i, row = p >> 3, c8 = p & 7;
        const u32x4 kq = *(const GAS u32x4*)(U + (size_t)(I.t0 + row) * DINP + U_MLK + I.h * 64 + c8 * 8);
        const u32x4 vq = *(const GAS u32x4*)(U + (size_t)(I.t0 + row) * DINP + U_MLV + I.h * 64 + c8 * 8);
        const float es = EST[row] * 0.125f;
        LAS f32x4* ek = (LAS f32x4*)(EK + row * 64 + c8 * 8); LAS f32x4* vv = (LAS f32x4*)(VV + row * 64 + c8 * 8);
        ek[0] = (f32x4){bflo(kq.x) * es, bfhi(kq.x) * es, bflo(kq.y) * es, bfhi(kq.y) * es};
        ek[1] = (f32x4){bflo(kq.z) * es, bfhi(kq.z) * es, bflo(kq.w) * es, bfhi(kq.w) * es};
        vv[0] = (f32x4){bflo(vq.x), bfhi(vq.x), bflo(vq.y), bfhi(vq.y)};
        vv[1] = (f32x4){bflo(vq.z), bfhi(vq.z), bflo(vq.w), bfhi(vq.w)}; }
    __syncthreads();
    {
        const int d = tid >> 3, e0 = (tid & 7) * 8;
        f32x4 c0 = {0.f, 0.f, 0.f, 0.f}, c1 = {0.f, 0.f, 0.f, 0.f};
#pragma unroll 4
        for (int j = 0; j < 128; ++j) { const float ek = EK[j * 64 + d]; const f32x4 v0 = *(const LAS f32x4*)(VV + j * 64 + e0), v1 = *(const LAS f32x4*)(VV + j * 64 + e0 + 4);
            c0 += v0 * ek; c1 += v1 * ek; }
        GAS f32x4* dst = (GAS f32x4*)(WSP(float, WS_MLC) + (size_t)item * 4096 + d * 64 + e0);
        dst[0] = c0; dst[1] = c1;
        if (tid < 64) { float s = 0.f; for (int j = 0; j < 128; ++j) s += EK[j * 64 + tid]; WSP(float, WS_MLN)[item * 64 + tid] = s; }
        if (tid == 0) { WSP(float, WS_MLS)[item * 4] = mloc; WSP(float, WS_MLS)[item * 4 + 1] = aend; }
    }
    __syncthreads();
}

__device__ __forceinline__ void ml_scan(Frame& F) {
    float* MLC = WSP(float, WS_MLC); float* MLN = WSP(float, WS_MLN); float* MLS = WSP(float, WS_MLS);
    for (int idx = blockIdx.x * NTHR + F.tid; idx < 16 * 4160; idx += F.G * NTHR) {
        const int seq = idx / 4160, el = idx % 4160;
        float* p0 = el < 4096 ? (MLC + (size_t)seq * 64 * 4096 + el) : (MLN + seq * 64 * 64 + (el - 4096));
        const int pstr = el < 4096 ? 4096 : 64;
        float mst = 0.f, st = 0.f;
#pragma unroll 1
        for (int n0 = 0; n0 < 64; n0 += 16) {
            float cl[16], mlv[16], aev[16];
#pragma unroll
            for (int i = 0; i < 16; ++i) { cl[i] = p0[(size_t)(n0 + i) * pstr]; mlv[i] = MLS[(seq * 64 + n0 + i) * 4]; aev[i] = MLS[(seq * 64 + n0 + i) * 4 + 1]; }
#pragma unroll
            for (int i = 0; i < 16; ++i) { const int item = seq * 64 + n0 + i;
                p0[(size_t)(n0 + i) * pstr] = st;
                if (el == 0) MLS[item * 4 + 2] = mst;
                const float mnew = fmaxf(aev[i] + mst, mlv[i]), sp = fexp(aev[i] + mst - mnew), sl = fexp(mlv[i] - mnew);
                st = sp * st + sl * cl[i]; mst = mnew; }
        }
    }
}

#define MFMA32(a, b, c) __builtin_amdgcn_mfma_f32_32x32x16_bf16((a), (b), (c), 0, 0, 0)
template <int NK>
__device__ __forceinline__ void qkt_tile(f32x16& p0, f32x16& p1, LAS const unsigned char* Kt, const bf16x8 (&qr)[NK], int r32, int hi) {
#pragma unroll
    for (int r = 0; r < 16; ++r) { p0[r] = 0.f; p1[r] = 0.f; }
#pragma unroll
    for (int d0 = 0; d0 < NK; ++d0) {
        const bf16x8 b0 = *(const LAS bf16x8*)(Kt + (2 * d0 + hi) * 1024 + r32 * 16);
        const bf16x8 b1 = *(const LAS bf16x8*)(Kt + (2 * d0 + hi) * 1024 + r32 * 16 + 512);
        p0 = MFMA32(b0, qr[d0], p0); p1 = MFMA32(b1, qr[d0], p1);
    }
}
typedef short v4i16_t __attribute__((ext_vector_type(4)));
__device__ __forceinline__ s16x4 vtr(LAS const unsigned char* p) { return __builtin_bit_cast(s16x4, __builtin_amdgcn_ds_read_tr16_b64_v4i16((LAS v4i16_t*)p)); }
__device__ __forceinline__ void pv_tile(f32x16 (&o)[2], LAS const unsigned char* Vt, const bf16x8 (&pa)[4], int lane) {
    const int hi = lane >> 5;
    LAS const unsigned char* vb = Vt + ((lane >> 4) & 1) * 32 + (lane & 3) * 8 + (4 * hi + ((lane & 15) >> 2)) * 64;
#pragma unroll
    for (int d0 = 0; d0 < 2; ++d0)
#pragma unroll
        for (int ks = 0; ks < 4; ++ks) {
            const s16x4 lo = vtr(vb + d0 * 4096 + ks * 1024), hh = vtr(vb + d0 * 4096 + ks * 1024 + 512);
            const bf16x8 vf = (bf16x8){lo[0], lo[1], lo[2], lo[3], hh[0], hh[1], hh[2], hh[3]};
            o[d0] = MFMA32(pa[ks], vf, o[d0]);
        }
}
__device__ __forceinline__ void pack_p(const f32x16& p0, const f32x16& p1, bf16x8 (&pa)[4]) {
    u32x4 w0, w1, w2, w3;
    w0 = (u32x4){pk2(p0[0], p0[1]), pk2(p0[2], p0[3]), pk2(p0[4], p0[5]), pk2(p0[6], p0[7])};
    w1 = (u32x4){pk2(p0[8], p0[9]), pk2(p0[10], p0[11]), pk2(p0[12], p0[13]), pk2(p0[14], p0[15])};
    w2 = (u32x4){pk2(p1[0], p1[1]), pk2(p1[2], p1[3]), pk2(p1[4], p1[5]), pk2(p1[6], p1[7])};
    w3 = (u32x4){pk2(p1[8], p1[9]), pk2(p1[10], p1[11]), pk2(p1[12], p1[13]), pk2(p1[14], p1[15])};
    pa[0] = __builtin_bit_cast(bf16x8, w0); pa[1] = __builtin_bit_cast(bf16x8, w1); pa[2] = __builtin_bit_cast(bf16x8, w2); pa[3] = __builtin_bit_cast(bf16x8, w3);
}

__device__ __forceinline__ void ml_local_pair(Frame& F, int pair, int l) {
    const int tid = F.tid, lane = F.lane, wid = F.wave, half = wid >> 2, wq = wid & 3, th = tid & 255, hi = lane >> 5;
    const int item = pair * 2 + half; const MlItem I = ml_decode(item);
    const bf16_t* U = WSP(bf16_t, WS_U);
    LAS unsigned char* base = F.lds + half * 49152;
    LAS unsigned char* EKI = base;
    LAS unsigned char* VI = base + 16384;
    LAS float* LF = (LAS float*)(base + 32768); LAS float* IG = LF + 128; LAS float* WW = LF + 256; LAS float* EST = LF + 384;
    const float* gb = INF(10) + l * 16;
    if (th < 128) { const int j = th, r = I.dir ? 127 - j : j; const size_t t = (size_t)(I.t0 + r);
        const float ipre = bf2f(U[t * DINP + U_MLG + (I.dir ? 2 : 0) * 4 + I.h]) + gb[(I.dir ? 2 : 0) * 4 + I.h];
        const float fpre = bf2f(U[t * DINP + U_MLG + (I.dir ? 3 : 1) * 4 + I.h]) + gb[(I.dir ? 3 : 1) * 4 + I.h];
        LF[j] = logsigmoid(fpre); IG[j] = ipre; }
    __syncthreads();
    float a = 0.f, aend = 0.f;
    if (th < 128) { for (int i = 0; i < 128; ++i) { const float v = LF[i]; aend += v; if (i <= th) a += v; }
        WW[th] = aend - a + IG[th]; }
    __syncthreads();
    float mloc = -3.0e38f;
    if (th < 128) { for (int i = 0; i < 128; ++i) mloc = fmaxf(mloc, WW[i]);
        const int r = I.dir ? 127 - th : th; EST[r] = fexp(WW[th] - mloc) * 0.125f; }
    __syncthreads();
#pragma unroll
    for (int i = 0; i < 4; ++i) { const int p = th + 256 * i; const int tt = p >> 9, dh = (p >> 8) & 1, row = (p >> 2) & 63, c4 = p & 3, r = 64 * tt + row;
        const bf16_t* src = U + (size_t)(I.t0 + r) * DINP + I.h * 64 + dh * 32 + c4 * 8;
        const u32x4 kq = *(const GAS u32x4*)(src + U_MLK); const u32x4 vq = *(const GAS u32x4*)(src + U_MLV);
        const float es = EST[r];
        u32x4 ek; ek.x = pk2(bflo(kq.x) * es, bfhi(kq.x) * es); ek.y = pk2(bflo(kq.y) * es, bfhi(kq.y) * es); ek.z = pk2(bflo(kq.z) * es, bfhi(kq.z) * es); ek.w = pk2(bflo(kq.w) * es, bfhi(kq.w) * es);
        const int off = tt * 8192 + dh * 4096 + row * 64 + c4 * 16;
        *(LAS u32x4*)(EKI + off) = ek; *(LAS u32x4*)(VI + off) = vq; }
    __syncthreads();
    {
        const int da = wq >> 1, eb = wq & 1;
        f32x16 acc;
#pragma unroll
        for (int r = 0; r < 16; ++r) acc[r] = 0.f;
        const int lo_off = ((lane >> 4) & 1) * 32 + (lane & 3) * 8 + (4 * hi + ((lane & 15) >> 2)) * 64;
#pragma unroll
        for (int tt = 0; tt < 2; ++tt)
#pragma unroll
            for (int ks = 0; ks < 4; ++ks) {
                LAS const unsigned char* ap = EKI + tt * 8192 + da * 4096 + lo_off + ks * 1024; LAS const unsigned char* bp = VI + tt * 8192 + eb * 4096 + lo_off + ks * 1024;
                const s16x4 a0 = vtr(ap), a1 = vtr(ap + 512), b0 = vtr(bp), b1 = vtr(bp + 512);
                const bf16x8 af = (bf16x8){a0[0], a0[1], a0[2], a0[3], a1[0], a1[1], a1[2], a1[3]}, bf = (bf16x8){b0[0], b0[1], b0[2], b0[3], b1[0], b1[1], b1[2], b1[3]};
                acc = MFMA32(af, bf, acc); }
        float* dst = WSP(float, WS_MLC) + (size_t)item * 4096 + eb * 32 + (lane & 31);
#pragma unroll
        for (int r = 0; r < 16; ++r) dst[(da * 32 + crow(r, hi)) * 64] = acc[r];
        if (th < 64) { const int dh = th >> 5, col = th & 31; float sacc = 0.f;
            for (int tt = 0; tt < 2; ++tt) for (int row = 0; row < 64; ++row) sacc += bf2f(*(const LAS unsigned short*)(EKI + tt * 8192 + dh * 4096 + row * 64 + col * 2));
            WSP(float, WS_MLN)[item * 64 + th] = sacc; }
        if (th == 0) { WSP(float, WS_MLS)[item * 4] = mloc; WSP(float, WS_MLS)[item * 4 + 1] = aend; }
    }
    __syncthreads();
}

__device__ __forceinline__ void ml_out_pair(Frame& F, int pair, int l) {
    const int tid = F.tid, lane = F.lane, wid = F.wave, half = wid >> 2, wq = wid & 3, th = tid & 255, r32 = lane & 31, hi = lane >> 5;
    const int item = pair * 2 + half; const MlItem I = ml_decode(item);
    const bf16_t* U = WSP(bf16_t, WS_U);
    LAS unsigned char* base = F.lds + half * 49152;
    LAS unsigned char* KI = base;
    LAS unsigned char* VI = base + 16384;
    LAS unsigned char* CT = base + 32768;
    LAS float* vec = (LAS float*)(base + 32768 + 9216);
    LAS float* LF = vec; LAS float* IG = vec + 128; LAS float* BL = vec + 256; LAS float* SA = vec + 384; LAS float* SCI = vec + 512; LAS float* EDEN = vec + 640;
    LAS float* NPV = vec + 768; LAS float* wsf = vec + 832 + wq * 64;
    const float* gb = INF(10) + l * 16;
    if (th < 128) { const int j = th, r = I.dir ? 127 - j : j; const size_t t = (size_t)(I.t0 + r);
        const float ipre = bf2f(U[t * DINP + U_MLG + (I.dir ? 2 : 0) * 4 + I.h]) + gb[(I.dir ? 2 : 0) * 4 + I.h];
        const float fpre = bf2f(U[t * DINP + U_MLG + (I.dir ? 3 : 1) * 4 + I.h]) + gb[(I.dir ? 3 : 1) * 4 + I.h];
        LF[j] = logsigmoid(fpre); IG[j] = ipre; }
    __syncthreads();
    float a = 0.f;
    if (th < 128) { for (int i = 0; i <= th; ++i) a += LF[i]; BL[th] = IG[th] - a; }
    __syncthreads();
    if (th < 128) { float bm = -3.0e38f; for (int i = 0; i <= th; ++i) bm = fmaxf(bm, BL[i]);
        const float mprev = WSP(float, WS_MLS)[item * 4 + 2];
        const float mt = a + fmaxf(mprev, bm);
        SA[th] = (a - mt) * LOG2E; SCI[th] = fexp(a + mprev - mt); EDEN[th] = fexp(-mt); }
    __syncthreads();
    if (th < 128) BL[th] = BL[th] * LOG2E;
#pragma unroll
    for (int i = 0; i < 4; ++i) { const int p = th + 256 * i;
        { const int tt = p >> 9, c = (p >> 6) & 7, kv = p & 63, j = 64 * tt + kv, r = I.dir ? 127 - j : j;
          *(LAS u32x4*)(KI + tt * 8192 + c * 1024 + kv * 16) = *(const GAS u32x4*)(U + (size_t)(I.t0 + r) * DINP + U_MLK + I.h * 64 + c * 8); }
        { const int tt = p >> 9, dh = (p >> 8) & 1, kv = (p >> 2) & 63, c4 = p & 3, j = 64 * tt + kv, r = I.dir ? 127 - j : j;
          *(LAS u32x4*)(VI + tt * 8192 + dh * 4096 + kv * 64 + c4 * 16) = *(const GAS u32x4*)(U + (size_t)(I.t0 + r) * DINP + U_MLV + I.h * 64 + dh * 32 + c4 * 8); } }
    { const float* cp = WSP(float, WS_MLC) + (size_t)item * 4096;
#pragma unroll
      for (int i = 0; i < 16; ++i) { const int idx = th + 256 * i, d = idx >> 6, e = idx & 63;
          *(LAS unsigned short*)(CT + e * 144 + d * 2) = (unsigned short)(pk2(cp[idx], 0.f) & 0xffffu); }
      if (th < 64) NPV[th] = WSP(float, WS_MLN)[item * 64 + th]; }
    __syncthreads();
    {
        const int q = 32 * wq + r32;
        const int rq = I.dir ? 127 - q : q;
        bf16x8 qr[4];
        const bf16_t* qp = U + (size_t)(I.t0 + rq) * DINP + U_MLQ + I.h * 64 + hi * 8;
#pragma unroll
        for (int d0 = 0; d0 < 4; ++d0) qr[d0] = *(const GAS bf16x8*)(qp + d0 * 16);
        f32x16 o[2];
#pragma unroll
        for (int r = 0; r < 16; ++r) { o[0][r] = 0.f; o[1][r] = 0.f; }
        const float saq = SA[q], scq = SCI[q];
        float den = 0.f;
        for (int tt = 0; tt < 2; ++tt) {
            if (64 * tt > 32 * wq + 31) break;
            f32x16 p0, p1;
            qkt_tile<4>(p0, p1, KI + tt * 8192, qr, r32, hi);
#pragma unroll
            for (int g = 0; g < 4; ++g) {
                const f32x4 b0 = *(const LAS f32x4*)(BL + 64 * tt + 8 * g + 4 * hi), b1 = *(const LAS f32x4*)(BL + 64 * tt + 32 + 8 * g + 4 * hi);
#pragma unroll
                for (int i = 0; i < 4; ++i) { const int r = 4 * g + i; const int kv0 = 64 * tt + 8 * g + 4 * hi + i, kv1 = kv0 + 32;
                    const float e0 = (kv0 <= q) ? __builtin_amdgcn_exp2f(saq + b0[i]) * 0.125f : 0.f, e1 = (kv1 <= q) ? __builtin_amdgcn_exp2f(saq + b1[i]) * 0.125f : 0.f;
                    p0[r] *= e0; p1[r] *= e1; den += p0[r] + p1[r]; }
            }
            bf16x8 pa[4]; pack_p(p0, p1, pa);
            pv_tile(o, VI + tt * 8192, pa, lane);
        }
        float dot = 0.f;
#pragma unroll
        for (int ks = 0; ks < 4; ++ks) {
            const u32x4 qw = __builtin_bit_cast(u32x4, qr[ks]);
            const f32x4 n0 = *(const LAS f32x4*)(NPV + 16 * ks + 8 * hi), n1 = *(const LAS f32x4*)(NPV + 16 * ks + 8 * hi + 4);
            const float q0 = bflo(qw.x), q1 = bfhi(qw.x), q2 = bflo(qw.y), q3 = bfhi(qw.y), q4 = bflo(qw.z), q5 = bfhi(qw.z), q6 = bflo(qw.w), q7 = bfhi(qw.w);
            dot += q0 * n0[0] + q1 * n0[1] + q2 * n0[2] + q3 * n0[3] + q4 * n1[0] + q5 * n1[1] + q6 * n1[2] + q7 * n1[3];
            const u32x4 sw = (u32x4){pk2(q0 * scq, q1 * scq), pk2(q2 * scq, q3 * scq), pk2(q4 * scq, q5 * scq), pk2(q6 * scq, q7 * scq)};
            const bf16x8 qs = __builtin_bit_cast(bf16x8, sw);
#pragma unroll
            for (int de = 0; de < 2; ++de) {
                const bf16x8 cf = *(const LAS bf16x8*)(CT + (de * 32 + r32) * 144 + (16 * ks + 8 * hi) * 2);
                o[de] = MFMA32(qs, cf, o[de]);
            }
        }
        den += scq * dot;
        den += __shfl_xor(den, 32);
        const float rinv = 1.0f / fmaxf(fabsf(den), EDEN[q]);
        if (hi == 0) wsf[r32] = rinv;
        LDS_WAIT();
        float* dst = WSP(float, I.dir ? WS_HB : WS_HF);
#pragma unroll
        for (int r = 0; r < 16; ++r) { const int jq = 32 * wq + crow(r, hi), row = I.dir ? 127 - jq : jq; const float rr = wsf[crow(r, hi)];
            float* dp = dst + (size_t)(I.t0 + row) * 256 + I.h * 64 + r32;
            dp[0] = o[0][r] * rr; dp[32] = o[1][r] * rr; }
    }
    __syncthreads();
}

__device__ __forceinline__ void mla_prep_rows(Frame& F, int l) {
    const int gw = F.vcu * NWAVES + F.wave, NGW = F.G * NWAVES, lane = F.lane;
    const bf16_t* U = WSP(bf16_t, WS_U); bf16_t* A = WSP(bf16_t, WS_AMLA);
    const float* qn = INF(11) + l * 224; const float* kn = INF(12) + l * 128;
    for (int m = gw; m < MTOK; m += NGW) {
        const bf16_t* ur = U + (size_t)m * DINP;
        float q0 = 0.f, q1 = 0.f, q2 = 0.f, q3 = 0.f;
        if (lane < 56) { const u32x2 w = *(const GAS u32x2*)(ur + U_CQ + 4 * lane); q0 = bflo(w.x); q1 = bfhi(w.x); q2 = bflo(w.y); q3 = bfhi(w.y); }
        const unsigned kw = *(const GAS unsigned*)(ur + U_CKV + 2 * lane); const float k0 = bflo(kw), k1 = bfhi(kw);
        const float rq = __builtin_amdgcn_rsqf(wave_sum(q0 * q0 + q1 * q1 + q2 * q2 + q3 * q3) * (1.0f / 224.0f) + EPS);
        const float rk = __builtin_amdgcn_rsqf(wave_sum(k0 * k0 + k1 * k1) * (1.0f / 128.0f) + EPS);
        bf16_t* ar = A + (size_t)m * 384;
        u32x2 qo = {0u, 0u};
        if (lane < 56) { const f32x4 g = *(const GAS f32x4*)(qn + 4 * lane); qo.x = pk2(q0 * rq * g.x, q1 * rq * g.y); qo.y = pk2(q2 * rq * g.z, q3 * rq * g.w); }
        *(GAS u32x2*)(ar + 4 * lane) = qo;
        const f32x2 g2 = *(const GAS f32x2*)(kn + 2 * lane);
        *(GAS unsigned*)(ar + 256 + 2 * lane) = pk2(k0 * rk * g2.x, k1 * rk * g2.y);
    }
}

__device__ __forceinline__ void rope_cs(int pos, int i, float& c, float& s) {
    const double inv = __builtin_exp2(-(double)i * (13.287712379549449 / 16.0));
    double rev = (double)pos * inv * 0.15915494309189535;
    rev -= __builtin_floor(rev);
    const float r = (float)rev;
    c = cos_rev(r); s = sin_rev(r);
}
__device__ __forceinline__ void relayout_phase(Frame& F) {
    const bf16_t* O = WSP(bf16_t, WS_OMLA); const bf16_t* U = WSP(bf16_t, WS_U);
    const int* pos = (const int*)F.a->in[2];
    const float qscale = 0.10206207261596577f * LOG2E;
    for (int idx = blockIdx.x * NTHR + F.tid; idx < MTOK * 4; idx += F.G * NTHR) {
        const int t = idx >> 2, h = idx & 3, b = t >> 13, s = t & 8191, bh = b * 4 + h;
        const int p = pos[t];
        float cs[16], sn[16];
#pragma unroll
        for (int i = 0; i < 16; ++i) rope_cs(p, i, cs[i], sn[i]);
        const bf16_t* qsrc = O + (size_t)t * 1024 + h * 96;
        bf16_t* qdst = WSP(bf16_t, WS_Q) + ((size_t)bh * SEQ + s) * 96;
#pragma unroll
        for (int c = 0; c < 8; ++c) { const u32x4 w = *(const GAS u32x4*)(qsrc + c * 8);
            u32x4 o; o.x = pk2(bflo(w.x) * qscale, bfhi(w.x) * qscale); o.y = pk2(bflo(w.y) * qscale, bfhi(w.y) * qscale); o.z = pk2(bflo(w.z) * qscale, bfhi(w.z) * qscale); o.w = pk2(bflo(w.w) * qscale, bfhi(w.w) * qscale);
            *(GAS u32x4*)(qdst + c * 8) = o; }
        {
            float x1[16], x2[16];
#pragma unroll
            for (int c = 0; c < 2; ++c) { const u32x4 w = *(const GAS u32x4*)(qsrc + 64 + c * 8); const u32x4 v = *(const GAS u32x4*)(qsrc + 80 + c * 8);
                x1[c * 8 + 0] = bflo(w.x); x1[c * 8 + 1] = bfhi(w.x); x1[c * 8 + 2] = bflo(w.y); x1[c * 8 + 3] = bfhi(w.y); x1[c * 8 + 4] = bflo(w.z); x1[c * 8 + 5] = bfhi(w.z); x1[c * 8 + 6] = bflo(w.w); x1[c * 8 + 7] = bfhi(w.w);
                x2[c * 8 + 0] = bflo(v.x); x2[c * 8 + 1] = bfhi(v.x); x2[c * 8 + 2] = bflo(v.y); x2[c * 8 + 3] = bfhi(v.y); x2[c * 8 + 4] = bflo(v.z); x2[c * 8 + 5] = bfhi(v.z); x2[c * 8 + 6] = bflo(v.w); x2[c * 8 + 7] = bfhi(v.w); }
#pragma unroll
            for (int c = 0; c < 2; ++c) { u32x4 o1, o2;
#define RQ1(i) ((x1[i] * cs[i] - x2[i] * sn[i]) * qscale)
#define RQ2(i) ((x2[i] * cs[i] + x1[i] * sn[i]) * qscale)
                o1.x = pk2(RQ1(c * 8 + 0), RQ1(c * 8 + 1)); o1.y = pk2(RQ1(c * 8 + 2), RQ1(c * 8 + 3)); o1.z = pk2(RQ1(c * 8 + 4), RQ1(c * 8 + 5)); o1.w = pk2(RQ1(c * 8 + 6), RQ1(c * 8 + 7));
                o2.x = pk2(RQ2(c * 8 + 0), RQ2(c * 8 + 1)); o2.y = pk2(RQ2(c * 8 + 2), RQ2(c * 8 + 3)); o2.z = pk2(RQ2(c * 8 + 4), RQ2(c * 8 + 5)); o2.w = pk2(RQ2(c * 8 + 6), RQ2(c * 8 + 7));
                *(GAS u32x4*)(qdst + 64 + c * 8) = o1; *(GAS u32x4*)(qdst + 80 + c * 8) = o2; }
#undef RQ1
#undef RQ2
        }
        bf16_t* kdst = WSP(bf16_t, WS_KIMG) + ((size_t)bh * 128 + (s >> 6)) * 6144 + (s & 63) * 8;
        const bf16_t* ksrc = O + (size_t)t * 1024 + 384 + h * 64;
#pragma unroll
        for (int c = 0; c < 8; ++c) *(GAS u32x4*)(kdst + c * 512) = *(const GAS u32x4*)(ksrc + c * 8);
        {
            const bf16_t* krs = U + (size_t)t * DINP + U_KR;
            float x1[16], x2[16];
#pragma unroll
            for (int c = 0; c < 2; ++c) { const u32x4 w = *(const GAS u32x4*)(krs + c * 8); const u32x4 v = *(const GAS u32x4*)(krs + 16 + c * 8);
                x1[c * 8 + 0] = bflo(w.x); x1[c * 8 + 1] = bfhi(w.x); x1[c * 8 + 2] = bflo(w.y); x1[c * 8 + 3] = bfhi(w.y); x1[c * 8 + 4] = bflo(w.z); x1[c * 8 + 5] = bfhi(w.z); x1[c * 8 + 6] = bflo(w.w); x1[c * 8 + 7] = bfhi(w.w);
                x2[c * 8 + 0] = bflo(v.x); x2[c * 8 + 1] = bfhi(v.x); x2[c * 8 + 2] = bflo(v.y); x2[c * 8 + 3] = bfhi(v.y); x2[c * 8 + 4] = bflo(v.z); x2[c * 8 + 5] = bfhi(v.z); x2[c * 8 + 6] = bflo(v.w); x2[c * 8 + 7] = bfhi(v.w); }
#pragma unroll
            for (int c = 0; c < 2; ++c) { u32x4 o1, o2;
#define RK1(i) (x1[i] * cs[i] - x2[i] * sn[i])
#define RK2(i) (x2[i] * cs[i] + x1[i] * sn[i])
                o1.x = pk2(RK1(c * 8 + 0), RK1(c * 8 + 1)); o1.y = pk2(RK1(c * 8 + 2), RK1(c * 8 + 3)); o1.z = pk2(RK1(c * 8 + 4), RK1(c * 8 + 5)); o1.w = pk2(RK1(c * 8 + 6), RK1(c * 8 + 7));
                o2.x = pk2(RK2(c * 8 + 0), RK2(c * 8 + 1)); o2.y = pk2(RK2(c * 8 + 2), RK2(c * 8 + 3)); o2.z = pk2(RK2(c * 8 + 4), RK2(c * 8 + 5)); o2.w = pk2(RK2(c * 8 + 6), RK2(c * 8 + 7));
                *(GAS u32x4*)(kdst + (8 + c) * 512) = o1; *(GAS u32x4*)(kdst + (10 + c) * 512) = o2; }
#undef RK1
#undef RK2
        }
        bf16_t* vdst = WSP(bf16_t, WS_VIMG) + ((size_t)bh * 128 + (s >> 6)) * 4096 + (s & 63) * 32;
        const bf16_t* vsrc = O + (size_t)t * 1024 + 640 + h * 64;
#pragma unroll
        for (int c = 0; c < 8; ++c) *(GAS u32x4*)(vdst + (c >> 2) * 2048 + (c & 3) * 8) = *(const GAS u32x4*)(vsrc + c * 8);
    }
}

__device__ __forceinline__ void attn_unit(Frame& F, int bh, int qb) {
    const int tid = F.tid, lane = F.lane, wid = F.wave, r32 = lane & 31, hi = lane >> 5;
    LAS unsigned char* KB = F.lds;
    LAS unsigned char* VB = F.lds + 24576;
    LAS float* wsf = (LAS float*)(F.lds + 40960) + wid * 64;
    const int b = bh >> 2, h = bh & 3;
    const bf16_t* Qp = WSP(bf16_t, WS_Q) + ((size_t)bh * SEQ + qb * 256 + wid * 32 + r32) * 96 + hi * 8;
    bf16x8 qr[6];
#pragma unroll
    for (int d0 = 0; d0 < 6; ++d0) qr[d0] = *(const GAS bf16x8*)(Qp + d0 * 16);
    const GAS u32x4* Kg = (const GAS u32x4*)(WSP(bf16_t, WS_KIMG) + (size_t)bh * 128 * 6144);
    const GAS u32x4* Vg = (const GAS u32x4*)(WSP(bf16_t, WS_VIMG) + (size_t)bh * 128 * 4096);
    u32x4 k0 = Kg[tid], k1 = (tid < 256) ? Kg[512 + tid] : (u32x4){0u, 0u, 0u, 0u}, v0 = Vg[tid];
    *(LAS u32x4*)(KB + tid * 16) = k0; if (tid < 256) *(LAS u32x4*)(KB + (512 + tid) * 16) = k1; *(LAS u32x4*)(VB + tid * 16) = v0;
    __syncthreads();
    float m = -1.0e30f, lsum = 0.f;
    f32x16 o[2];
#pragma unroll
    for (int r = 0; r < 16; ++r) { o[0][r] = 0.f; o[1][r] = 0.f; }
    for (int t = 0; t < 128; ++t) {
        const int cur = t & 1;
        if (t + 1 < 128) { k0 = Kg[(t + 1) * 768 + tid]; if (tid < 256) k1 = Kg[(t + 1) * 768 + 512 + tid]; v0 = Vg[(t + 1) * 512 + tid]; }
        f32x16 p0, p1;
        qkt_tile<6>(p0, p1, KB + cur * 12288, qr, r32, hi);
        float rm = fmaxf(p0[0], p1[0]);
#pragma unroll
        for (int r = 1; r < 16; ++r) rm = fmaxf(rm, fmaxf(p0[r], p1[r]));
        rm = fmaxf(rm, __shfl_xor(rm, 32));
        if (__any(rm > m + 8.0f)) {
            const float mn = fmaxf(m, rm), f = __builtin_amdgcn_exp2f(m - mn);
            m = mn; lsum *= f;
            if (hi == 0) wsf[r32] = f;
            LDS_WAIT();
#pragma unroll
            for (int r = 0; r < 16; ++r) { const float fr = wsf[crow(r, hi)]; o[0][r] *= fr; o[1][r] *= fr; }
        }
#pragma unroll
        for (int r = 0; r < 16; ++r) { p0[r] = __builtin_amdgcn_exp2f(p0[r] - m); p1[r] = __builtin_amdgcn_exp2f(p1[r] - m); lsum += p0[r] + p1[r]; }
        bf16x8 pa[4]; pack_p(p0, p1, pa);
        pv_tile(o, VB + cur * 8192, pa, lane);
        if (t + 1 < 128) { const int nb = cur ^ 1;
            *(LAS u32x4*)(KB + nb * 12288 + tid * 16) = k0; if (tid < 256) *(LAS u32x4*)(KB + nb * 12288 + (512 + tid) * 16) = k1; *(LAS u32x4*)(VB + nb * 8192 + tid * 16) = v0; }
        __syncthreads();
    }
    lsum += __shfl_xor(lsum, 32);
    if (hi == 0) wsf[r32] = 1.0f / lsum;
    LDS_WAIT();
    bf16_t* Y = WSP(bf16_t, WS_YATT);
#pragma unroll
    for (int r = 0; r < 16; ++r) { const float rl = wsf[crow(r, hi)]; const int q = qb * 256 + wid * 32 + crow(r, hi);
        bf16_t* yp = Y + ((size_t)b * SEQ + q) * 256 + h * 64 + r32;
        yp[0] = (bf16_t)(pk2(o[0][r] * rl, 0.f) & 0xffffu); yp[32] = (bf16_t)(pk2(o[1][r] * rl, 0.f) & 0xffffu); }
    __syncthreads();
}

template <bool INV>
__device__ __forceinline__ void fft16k(LAS f32x2* X, int tid) {
#pragma unroll 1
    for (int s = 0; s < 7; ++s) {
        const int lq = INV ? 2 * s : 12 - 2 * s; const int q = 1 << lq;
        const float rq = 1.0f / (float)(4 * q);
#pragma unroll 2
        for (int i = 0; i < 8; ++i) {
            const int t = tid + 512 * i; const int j = t & (q - 1); const int base = ((t >> lq) << (lq + 2)) + j;
            f32x2 x0 = X[base], x1 = X[base + q], x2 = X[base + 2 * q], x3 = X[base + 3 * q];
            const float ang = (float)j * rq;
            const float c1 = cos_rev(ang), s1 = INV ? sin_rev(ang) : -sin_rev(ang);
            const float c2 = c1 * c1 - s1 * s1, s2 = 2.0f * c1 * s1;
            const float c3 = c2 * c1 - s2 * s1, s3 = c2 * s1 + s2 * c1;
            if (!INV) {
                const f32x2 a = x0 + x2, b = x0 - x2, c = x1 + x3, d = x1 - x3;
                const f32x2 y0 = a + c, y2 = a - c, y1 = (f32x2){b.x + d.y, b.y - d.x}, y3 = (f32x2){b.x - d.y, b.y + d.x};
                X[base] = y0;
                X[base + q] = (f32x2){y1.x * c1 - y1.y * s1, y1.x * s1 + y1.y * c1};
                X[base + 2 * q] = (f32x2){y2.x * c2 - y2.y * s2, y2.x * s2 + y2.y * c2};
                X[base + 3 * q] = (f32x2){y3.x * c3 - y3.y * s3, y3.x * s3 + y3.y * c3};
            } else {
                x1 = (f32x2){x1.x * c1 - x1.y * s1, x1.x * s1 + x1.y * c1};
                x2 = (f32x2){x2.x * c2 - x2.y * s2, x2.x * s2 + x2.y * c2};
                x3 = (f32x2){x3.x * c3 - x3.y * s3, x3.x * s3 + x3.y * c3};
                const f32x2 a = x0 + x2, b = x0 - x2, c = x1 + x3, d = x1 - x3;
                X[base] = a + c; X[base + 2 * q] = a - c;
                X[base + q] = (f32x2){b.x - d.y, b.y + d.x};
                X[base + 3 * q] = (f32x2){b.x + d.y, b.y - d.x};
            }
        }
        __syncthreads();
    }
}
__device__ __forceinline__ float block_sum(Frame& F, float v, LAS float* red) {
    v = wave_sum(v);
    if (F.lane == 0) red[F.wave] = v;
    __syncthreads();
    float s = 0.f;
#pragma unroll
    for (int w = 0; w < NWAVES; ++w) s += red[w];
    __syncthreads();
    return s;
}
__device__ __forceinline__ void hyena_item(Frame& F, int c, int l) {
    const int tid = F.tid;
    LAS f32x2* X = (LAS f32x2*)F.lds;
    LAS float* red = (LAS float*)(F.lds + XTRA_OFF);
    f32x2* KF = WSP(f32x2, WS_KF) + (size_t)c * 2 * 16384;
    for (int o = 0; o < 2; ++o) {
        const float* Ff = WSP(float, WS_FILT) + ((size_t)l * 1024 + o * 512 + c) * SEQ; const float* Fb = Ff + (size_t)256 * SEQ;
        float ssum = 0.f;
        { float ffv[16], fbv[16];
#pragma unroll
          for (int i = 0; i < 16; ++i) { ffv[i] = Ff[tid + 512 * i]; fbv[i] = Fb[tid + 512 * i]; }
#pragma unroll
          for (int i = 0; i < 16; ++i) { const int t = tid + 512 * i; ssum += fabsf(ffv[i]) + fabsf(fbv[i]);
              X[t] = (f32x2){ffv[i], 0.f}; X[16383 - t] = (f32x2){fbv[i], 0.f}; } }
        const float inv = 1.0f / block_sum(F, ssum, red);
        fft16k<false>(X, tid);
#pragma unroll 8
        for (int i = 0; i < 32; ++i) { const int p = tid + 512 * i; const f32x2 v = X[p]; KF[o * 16384 + p] = (f32x2){v.x * inv, v.y * inv}; }
        __syncthreads();
    }
    const float* HT0 = WSP(float, WS_HYT);
    const float hb0 = INF(27)[l * 512 + c], hb1 = INF(27)[l * 512 + 256 + c];
    float zz[16][2];
    { const float* z0p = HT0 + (size_t)(0 * 768 + 512 + c) * SEQ; const float* z1p = HT0 + (size_t)(1 * 768 + 512 + c) * SEQ;
#pragma unroll
      for (int i = 0; i < 16; ++i) { zz[i][0] = z0p[tid + 512 * i]; zz[i][1] = z1p[tid + 512 * i]; }
#pragma unroll
      for (int i = 0; i < 16; ++i) { const int t = tid + 512 * i; X[t] = (f32x2){zz[i][0], zz[i][1]}; X[8192 + t] = (f32x2){0.f, 0.f}; } }
    __syncthreads();
    const float invn = 1.0f / 16384.0f;
#pragma unroll 1
    for (int o = 0; o < 2; ++o) {
        fft16k<false>(X, tid);
        { const f32x2* kp = KF + o * 16384;
#pragma unroll 1
          for (int i0 = 0; i0 < 32; i0 += 8) { f32x2 kv[8];
#pragma unroll
              for (int i = 0; i < 8; ++i) kv[i] = kp[tid + 512 * (i0 + i)];
#pragma unroll
              for (int i = 0; i < 8; ++i) { const int p = tid + 512 * (i0 + i); const f32x2 v = X[p]; X[p] = (f32x2){v.x * kv[i].x - v.y * kv[i].y, v.x * kv[i].y + v.y * kv[i].x}; } } }
        __syncthreads();
        fft16k<true>(X, tid);
        float ga[16], gb[16];
        { const float* g0p = HT0 + (size_t)(0 * 768 + o * 256 + c) * SEQ; const float* g1p = HT0 + (size_t)(1 * 768 + o * 256 + c) * SEQ;
#pragma unroll
          for (int i = 0; i < 16; ++i) { ga[i] = g0p[tid + 512 * i]; gb[i] = g1p[tid + 512 * i]; } }
        const float hbo = o ? hb1 : hb0;
        if (o == 0) {
#pragma unroll
            for (int i = 0; i < 16; ++i) { const int t = tid + 512 * i; const f32x2 y = X[t];
                zz[i][0] = ga[i] * (y.x * invn + zz[i][0] * hbo); zz[i][1] = gb[i] * (y.y * invn + zz[i][1] * hbo);
                X[t] = (f32x2){zz[i][0], zz[i][1]}; X[8192 + t] = (f32x2){0.f, 0.f}; }
            __syncthreads();
        } else {
            bf16_t* Y0 = WSP(bf16_t, WS_YHT) + (size_t)(0 * 256 + c) * SEQ; bf16_t* Y1 = WSP(bf16_t, WS_YHT) + (size_t)(1 * 256 + c) * SEQ;
#pragma unroll
            for (int i = 0; i < 16; ++i) { const int t = tid + 512 * i; const f32x2 y = X[t];
                const float r0 = ga[i] * (y.x * invn + zz[i][0] * hbo), r1 = gb[i] * (y.y * invn + zz[i][1] * hbo);
                Y0[t] = (bf16_t)(pk2(r0, 0.f) & 0xffffu); Y1[t] = (bf16_t)(pk2(r1, 0.f) & 0xffffu); }
            __syncthreads();
        }
    }
}

__device__ __forceinline__ void hy_prep_tile(Frame& F, int tile, int l) {
    const int tid = F.tid, lane = F.lane, wave = F.wave;
    const int b = tile >> 7, t0 = (tile & 127) * 64;
    constexpr int RS = 1552;
    const bf16_t* U = WSP(bf16_t, WS_U);
#pragma unroll 1
    for (int i = 0; i < 13; ++i) { const int idx = tid + 512 * i; const int row = idx / 96, pc = idx % 96;
        if (row < 66) { const int tok = t0 - 1 + row; u32x4 v = {0u, 0u, 0u, 0u};
            if (tok >= 0 && tok < SEQ) v = *(const GAS u32x4*)(U + ((size_t)b * SEQ + tok) * DINP + U_HY + pc * 8);
            *(LAS u32x4*)(F.lds + row * RS + pc * 16) = v; } }
    __syncthreads();
    const float* cw = INF(16) + (size_t)l * 768 * 3; const float* cb = INF(17) + l * 768;
    float* HT = WSP(float, WS_HYT);
#pragma unroll 2
    for (int cp = wave; cp < 384; cp += 8) { const int ch = 2 * cp;
        const float w00 = cw[ch * 3], w01 = cw[ch * 3 + 1], w02 = cw[ch * 3 + 2], w10 = cw[ch * 3 + 3], w11 = cw[ch * 3 + 4], w12 = cw[ch * 3 + 5], b0 = cb[ch], b1 = cb[ch + 1];
        const unsigned r0 = *(const LAS unsigned*)(F.lds + lane * RS + cp * 4), r1 = *(const LAS unsigned*)(F.lds + (lane + 1) * RS + cp * 4), r2 = *(const LAS unsigned*)(F.lds + (lane + 2) * RS + cp * 4);
        HT[((size_t)(b * 768 + ch)) * SEQ + t0 + lane] = w00 * bflo(r0) + w01 * bflo(r1) + w02 * bflo(r2) + b0;
        HT[((size_t)(b * 768 + ch + 1)) * SEQ + t0 + lane] = w10 * bfhi(r0) + w11 * bfhi(r1) + w12 * bfhi(r2) + b1; }
    __syncthreads();
}

__device__ __forceinline__ void headnorm_phase(Frame& F, int l) {
    const int lane = F.lane, tid = F.tid, wave = F.wave;
    const bf16_t* U = WSP(bf16_t, WS_U); const bf16_t* YA = WSP(bf16_t, WS_YATT); const bf16_t* YH = WSP(bf16_t, WS_YHT);
    const float* og = INF(29) + l * 1024;
    constexpr int RS2 = 528;
    for (int tile = F.vcu; tile < 256; tile += F.G) {
      const int tb = tile >> 7, t0 = (tile & 127) * 64;
#pragma unroll
      for (int i = 0; i < 4; ++i) { const int idx = tid + 512 * i, c = idx >> 3, p8 = idx & 7;
          const u32x4 v = *(const GAS u32x4*)(YH + ((size_t)(tb * 256 + c)) * SEQ + t0 + p8 * 8);
          LAS unsigned char* hp = F.lds + (8 * p8) * RS2 + 2 * c;
          *(LAS unsigned short*)(hp + 0 * RS2) = (unsigned short)(v.x & 0xffffu); *(LAS unsigned short*)(hp + 1 * RS2) = (unsigned short)(v.x >> 16);
          *(LAS unsigned short*)(hp + 2 * RS2) = (unsigned short)(v.y & 0xffffu); *(LAS unsigned short*)(hp + 3 * RS2) = (unsigned short)(v.y >> 16);
          *(LAS unsigned short*)(hp + 4 * RS2) = (unsigned short)(v.z & 0xffffu); *(LAS unsigned short*)(hp + 5 * RS2) = (unsigned short)(v.z >> 16);
          *(LAS unsigned short*)(hp + 6 * RS2) = (unsigned short)(v.w & 0xffffu); *(LAS unsigned short*)(hp + 7 * RS2) = (unsigned short)(v.w >> 16); }
      __syncthreads();
#pragma unroll 1
      for (int rr = 0; rr < 8; ++rr) {
        const int trow = wave * 8 + rr; const int m = tb * SEQ + t0 + trow;
        float y[16];
        const int ch = 16 * lane;
        if (lane < 16) {
            const bf16_t* op = U + (size_t)m * DINP + U_MLO + ch;
            const u32x4 o0 = *(const GAS u32x4*)op, o1 = *(const GAS u32x4*)(op + 8);
            const unsigned ow[8] = {o0.x, o0.y, o0.z, o0.w, o1.x, o1.y, o1.z, o1.w};
            const GAS f32x4* hf = (const GAS f32x4*)(WSP(float, WS_HF) + (size_t)m * 256 + ch);
            const GAS f32x4* hb = (const GAS f32x4*)(WSP(float, WS_HB) + (size_t)m * 256 + ch);
#pragma unroll
            for (int j = 0; j < 4; ++j) { const f32x4 s = hf[j] + hb[j];
                const float oa = bflo(ow[2 * j]), ob = bfhi(ow[2 * j]), oc = bflo(ow[2 * j + 1]), od = bfhi(ow[2 * j + 1]);
                y[4 * j + 0] = s.x / (1.0f + fexp(-oa)); y[4 * j + 1] = s.y / (1.0f + fexp(-ob)); y[4 * j + 2] = s.z / (1.0f + fexp(-oc)); y[4 * j + 3] = s.w / (1.0f + fexp(-od)); }
        } else if (lane < 48) {
            u32x4 o0, o1;
            if (lane < 32) { const bf16_t* yp = YA + (size_t)m * 256 + (ch - 256); o0 = *(const GAS u32x4*)yp; o1 = *(const GAS u32x4*)(yp + 8); }
            else { const LAS unsigned char* hp = F.lds + trow * RS2 + (ch - 512) * 2; o0 = *(const LAS u32x4*)hp; o1 = *(const LAS u32x4*)(hp + 16); }
            const unsigned ow[8] = {o0.x, o0.y, o0.z, o0.w, o1.x, o1.y, o1.z, o1.w};
#pragma unroll
            for (int j = 0; j < 8; ++j) { y[2 * j] = bflo(ow[j]); y[2 * j + 1] = bfhi(ow[j]); }
        } else {
            const int c = ch - 768, s = m & 8191;
            const bf16_t* up = U + (size_t)m * DINP + U_SC + c;
            float acc[16];
#pragma unroll
            for (int j = 0; j < 16; ++j) acc[j] = 0.f;
#pragma unroll
            for (int dt = -1; dt <= 1; ++dt) {
                if ((s + dt) < 0 || (s + dt) >= SEQ) continue;
                const bf16_t* rp = up + (ptrdiff_t)dt * DINP;
                const u32x4 c0 = *(const GAS u32x4*)(rp + 256), c1 = *(const GAS u32x4*)(rp + 264), x0 = *(const GAS u32x4*)(rp + 512), x1 = *(const GAS u32x4*)(rp + 520);
                const unsigned cw[8] = {c0.x, c0.y, c0.z, c0.w, c1.x, c1.y, c1.z, c1.w}, xw[8] = {x0.x, x0.y, x0.z, x0.w, x1.x, x1.y, x1.z, x1.w};
#pragma unroll
                for (int j = 0; j < 8; ++j) { acc[2 * j] += bflo(cw[j]) * bflo(xw[j]) * INF(28)[(size_t)l * 768 + (c + 2 * j) * 3 + dt + 1]; acc[2 * j + 1] += bfhi(cw[j]) * bfhi(xw[j]) * INF(28)[(size_t)l * 768 + (c + 2 * j + 1) * 3 + dt + 1]; }
            }
            const u32x4 b0 = *(const GAS u32x4*)up, b1 = *(const GAS u32x4*)(up + 8);
            const unsigned bw[8] = {b0.x, b0.y, b0.z, b0.w, b1.x, b1.y, b1.z, b1.w};
#pragma unroll
            for (int j = 0; j < 8; ++j) { y[2 * j] = bflo(bw[j]) * acc[2 * j]; y[2 * j + 1] = bfhi(bw[j]) * acc[2 * j + 1]; }
        }
        float ss = 0.f;
#pragma unroll
        for (int j = 0; j < 16; ++j) ss += y[j] * y[j];
        ss += __shfl_xor(ss, 1); ss += __shfl_xor(ss, 2);
        const float rstd = __builtin_amdgcn_rsqf(ss * (1.0f / 64.0f) + EPS);
        const GAS f32x4* gp = (const GAS f32x4*)(og + ch);
        u32x4 w0, w1;
        { const f32x4 ga = gp[0], gb2 = gp[1], gc = gp[2], gd = gp[3];
          w0.x = pk2(y[0] * rstd * ga.x, y[1] * rstd * ga.y); w0.y = pk2(y[2] * rstd * ga.z, y[3] * rstd * ga.w); w0.z = pk2(y[4] * rstd * gb2.x, y[5] * rstd * gb2.y); w0.w = pk2(y[6] * rstd * gb2.z, y[7] * rstd * gb2.w);
          w1.x = pk2(y[8] * rstd * gc.x, y[9] * rstd * gc.y); w1.y = pk2(y[10] * rstd * gc.z, y[11] * rstd * gc.w); w1.z = pk2(y[12] * rstd * gd.x, y[13] * rstd * gd.y); w1.w = pk2(y[14] * rstd * gd.z, y[15] * rstd * gd.w); }
        bf16_t* yn = WSP(bf16_t, WS_YN) + (size_t)m * DM + ch;
        *(GAS u32x4*)yn = w0; *(GAS u32x4*)(yn + 8) = w1;
      }
      __syncthreads();
    }
}

__device__ __forceinline__ void post_mixer_phase(Frame& F, int l, const float* xin) {
    const int gw = F.vcu * NWAVES + F.wave, NGW = F.G * NWAVES, lane = F.lane, tid = F.tid;
    LAS float* RWT = (LAS float*)F.lds;
    { const GAS f32x4* src = (const GAS f32x4*)(INF(31) + (size_t)l * 1024 * 16);
      for (int i = tid; i < 4096; i += NTHR) { const f32x4 w = src[i]; const int k = i >> 2, e4 = (i & 3) * 4;
          RWT[(e4 + 0) * 1024 + k] = w.x; RWT[(e4 + 1) * 1024 + k] = w.y; RWT[(e4 + 2) * 1024 + k] = w.z; RWT[(e4 + 3) * 1024 + k] = w.w; } }
    __syncthreads();
    const float* mod = WSP(float, WS_MOD);
    for (int m = gw; m < MTOK; m += NGW) {
        const int b = m >> 13, s = m & 8191; const float* md = mod + (l * 2 + b) * 6144;
        f32x4 y2[4], x[4], pg[4], g1[4];
        ld_row_f32(WSP(float, WS_Y2) + (size_t)m * DM, lane, y2);
        ld_row_f32(xin + (size_t)m * DM, lane, x);
        ld_row_f32(INF(6) + l * 1024, lane, pg); ld_row_f32(md + 2048, lane, g1);
        const float rstd = __builtin_amdgcn_rsqf(row_ss(y2) * (1.0f / DM) + EPS);
#pragma unroll
        for (int j = 0; j < 4; ++j) x[j] = x[j] + g1[j] * (y2[j] * rstd * pg[j]);
        st_row_f32(WSP(float, WS_X1) + (size_t)m * DM, lane, x);
        f32x4 h[4];
        modnorm(x, INF(7) + l * 1024, md + 4096, md + 3072, lane, h);
        st_row_bf16(WSP(bf16_t, WS_XN) + (size_t)m * DM, lane, h);
        float part[16];
#pragma unroll
        for (int e = 0; e < 16; ++e) part[e] = 0.f;
#pragma unroll
        for (int j = 0; j < 4; ++j) {
#pragma unroll
            for (int e = 0; e < 16; ++e) { const f32x4 w = *(const LAS f32x4*)(RWT + e * 1024 + 4 * lane + 256 * j);
                part[e] += (h[j].x * w.x + h[j].y * w.y) + (h[j].z * w.z + h[j].w * w.w); }
            asm volatile("" ::: "memory"); }
        float a8[8], a4[4], a2[2], lg;
        { const bool up = (lane & 32) != 0;
#pragma unroll
          for (int i = 0; i < 8; ++i) { const float keep = up ? part[8 + i] : part[i], send = up ? part[i] : part[8 + i]; a8[i] = keep + __shfl_xor(send, 32); } }
        { const bool up = (lane & 16) != 0;
#pragma unroll
          for (int i = 0; i < 4; ++i) { const float keep = up ? a8[4 + i] : a8[i], send = up ? a8[i] : a8[4 + i]; a4[i] = keep + __shfl_xor(send, 16); } }
        { const bool up = (lane & 8) != 0;
#pragma unroll
          for (int i = 0; i < 2; ++i) { const float keep = up ? a4[2 + i] : a4[i], send = up ? a4[i] : a4[2 + i]; a2[i] = keep + __shfl_xor(send, 8); } }
        { const bool up = (lane & 4) != 0; const float keep = up ? a2[1] : a2[0], send = up ? a2[0] : a2[1]; lg = keep + __shfl_xor(send, 4); }
        lg += __shfl_xor(lg, 2); lg += __shfl_xor(lg, 1);
        float mx = lg;
#pragma unroll
        for (int o = 4; o < 64; o <<= 1) mx = fmaxf(mx, __shfl_xor(mx, o));
        const float ex = fexp(lg - mx); float sm = ex;
#pragma unroll
        for (int o = 4; o < 64; o <<= 1) sm += __shfl_xor(sm, o);
        if ((lane & 3) == 0) WSP(float, WS_AFF)[((size_t)b * 16 + (lane >> 2)) * SEQ + s] = ex / sm;
        if (lane < 16) WSP(int, WS_SLOT)[(size_t)m * 16 + lane] = -1;
    }
    __syncthreads();
}

__device__ __forceinline__ void topk_item(Frame& F, int it) {
    const int tid = F.tid, lane = F.lane, wave = F.wave;
    const int b = it >> 4, e = it & 15;
    LAS unsigned* keys = (LAS unsigned*)F.lds;
    LAS unsigned* hist = (LAS unsigned*)(F.lds + 32768);
    LAS unsigned* ctl = hist + 256;
    LAS unsigned* wtot = hist + 320;
    const unsigned* src = (const unsigned*)(WSP(float, WS_AFF) + (size_t)it * SEQ);
#pragma unroll
    for (int i = 0; i < 16; ++i) keys[tid + 512 * i] = src[tid + 512 * i];
    unsigned prefix = 0u, mask = 0u, need = CAP;
    for (int pass = 0; pass < 4; ++pass) {
        const int shift = 24 - 8 * pass;
        if (tid < 256) hist[tid] = 0u;
        __syncthreads();
#pragma unroll
        for (int i = 0; i < 16; ++i) { const unsigned k = keys[tid + 512 * i]; if ((k & mask) == prefix) atomicAdd((unsigned*)&hist[(k >> shift) & 255u], 1u); }
        __syncthreads();
        if (wave == 0) { const unsigned c0 = hist[4 * lane], c1 = hist[4 * lane + 1], c2 = hist[4 * lane + 2], c3 = hist[4 * lane + 3];
            const unsigned sl = c0 + c1 + c2 + c3; unsigned T = sl;
#pragma unroll
            for (int o = 1; o < 64; o <<= 1) { const unsigned n = __shfl_down(T, o); if (lane + o < 64) T += n; }
            unsigned cum = T - sl;
            if (cum < need && cum + c3 >= need) { ctl[0] = 4u * lane + 3u; ctl[1] = need - cum; } cum += c3;
            if (cum < need && cum + c2 >= need) { ctl[0] = 4u * lane + 2u; ctl[1] = need - cum; } cum += c2;
            if (cum < need && cum + c1 >= need) { ctl[0] = 4u * lane + 1u; ctl[1] = need - cum; } cum += c1;
            if (cum < need && cum + c0 >= need) { ctl[0] = 4u * lane; ctl[1] = need - cum; } }
        __syncthreads();
        prefix |= ctl[0] << shift; mask |= 0xffu << shift; need = ctl[1];
        __syncthreads();
    }
    unsigned cg = 0u, ce = 0u;
#pragma unroll
    for (int i = 0; i < 16; ++i) { const unsigned k = keys[tid * 16 + i]; cg += (k > prefix) ? 1u : 0u; ce += (k == prefix) ? 1u : 0u; }
    unsigned v = cg | (ce << 16), inc = v;
#pragma unroll
    for (int o = 1; o < 64; o <<= 1) { const unsigned n = __shfl_up(inc, o); if (lane >= o) inc += n; }
    if (lane == 63) wtot[wave] = inc;
    __syncthreads();
    unsigned off = 0u;
    for (int w = 0; w < wave; ++w) off += wtot[w];
    const unsigned excl = off + inc - v;
    unsigned ng = excl & 0xffffu, ne = excl >> 16;
    int* IDX = WSP(int, WS_IDX) + it * CAP; int* SLOT = WSP(int, WS_SLOT);
#pragma unroll
    for (int i = 0; i < 16; ++i) { const int idx = tid * 16 + i; const unsigned k = keys[idx];
        const bool gt = k > prefix, eq = k == prefix; const bool sel = gt || (eq && ne < need);
        if (sel) { const int slot = (int)(ng + (ne < need ? ne : need)); IDX[slot] = idx; SLOT[((size_t)b * SEQ + idx) * 16 + e] = slot; }
        ng += gt ? 1u : 0u; ne += eq ? 1u : 0u; }
    __syncthreads();
}

__device__ __forceinline__ void gather_phase(Frame& F) {
    const int gw = F.vcu * NWAVES + F.wave, NGW = F.G * NWAVES, lane = F.lane;
    const int* IDX = WSP(int, WS_IDX);
    for (int r = gw; r < NEXP * 2 * CAP; r += NGW) {
        const int e = r >> 11, b = (r >> 10) & 1, j = r & 1023;
        const int tok = IDX[(b * 16 + e) * CAP + j];
        const GAS u32x4* src = (const GAS u32x4*)(WSP(bf16_t, WS_XN) + ((size_t)b * SEQ + tok) * DM);
        GAS u32x4* dst = (GAS u32x4*)(WSP(bf16_t, WS_XE) + (size_t)r * DM);
        dst[lane] = src[lane]; dst[64 + lane] = src[64 + lane];
    }
}

__device__ __forceinline__ void combine_phase(Frame& F, int l) {
    const int gw = F.vcu * NWAVES + F.wave, NGW = F.G * NWAVES, lane = F.lane;
    const float* mod = WSP(float, WS_MOD);
    const bf16_t* YE = WSP(bf16_t, WS_YE);
    for (int m = gw; m < MTOK; m += NGW) {
        const int b = m >> 13, s = m & 8191; const float* md = mod + (l * 2 + b) * 6144;
        int sl = -1; float gv = 0.f;
        if (lane < 16) { sl = WSP(int, WS_SLOT)[(size_t)m * 16 + lane]; gv = WSP(float, WS_AFF)[((size_t)b * 16 + lane) * SEQ + s]; }
        f32x4 acc[4];
#pragma unroll
        for (int j = 0; j < 4; ++j) acc[j] = (f32x4){0.f, 0.f, 0.f, 0.f};
#pragma unroll 1
        for (int e = 0; e < 16; ++e) {
            const int se = __shfl(sl, e);
            if (se >= 0) { const float ge = __shfl(gv, e);
                const GAS u32x2* rp = (const GAS u32x2*)(YE + ((size_t)e * 2048 + b * CAP + se) * DM) + lane;
#pragma unroll
                for (int j = 0; j < 4; ++j) { const u32x2 w = rp[64 * j]; acc[j] += (f32x4){bflo(w.x), bfhi(w.x), bflo(w.y), bfhi(w.y)} * ge; } }
        }
        f32x4 x1[4], pg[4], g2[4];
        ld_row_f32(WSP(float, WS_X1) + (size_t)m * DM, lane, x1);
        ld_row_f32(INF(8) + l * 1024, lane, pg); ld_row_f32(md + 5120, lane, g2);
        const float rstd = __builtin_amdgcn_rsqf(row_ss(acc) * (1.0f / DM) + EPS);
#pragma unroll
        for (int j = 0; j < 4; ++j) x1[j] = x1[j] + g2[j] * (acc[j] * rstd * pg[j]);
        st_row_f32(F.a->out + (size_t)m * DM, lane, x1);
        if (l == 0) { f32x4 h[4]; const float* md1 = mod + (1 * 2 + b) * 6144;
            modnorm(x1, INF(5) + 1024, md1 + 1024, md1, lane, h);
            st_row_bf16(WSP(bf16_t, WS_XN) + (size_t)m * DM, lane, h); }
    }
}

constexpr int PH_PER_LAYER = 13, N_PHASES = 2 + 2 * PH_PER_LAYER;
__global__ void __launch_bounds__(NTHR, 2) mega_fwd(Args args) {
    extern __shared__ __attribute__((aligned(16))) unsigned char lds_raw[];
    Frame F;
    F.lds = (LAS unsigned char*)lds_raw;
    F.tid = threadIdx.x; F.lane = F.tid & 63; F.wave = __builtin_amdgcn_readfirstlane(F.tid >> 6);
    F.G = gridDim.x; { const int bx = blockIdx.x; F.vcu = (F.G % 8 == 0) ? (bx % 8) * (F.G / 8) + bx / 8 : bx; }
    F.a = &args; F.ws = args.ws;
    volatile LAS unsigned* MISC = (volatile LAS unsigned*)(F.lds + MISC_OFF);
    for (int u = F.tid; u < (LDS_BYTES - LDSCTL_OFF) / 4; u += NTHR) ((LAS unsigned*)(F.lds + LDSCTL_OFF))[u] = 0u;
    __syncthreads();
    gu32* ctl = (gu32*)(F.ws + WS_CTL);
    XcdBarrier bar; bar.bar = (unsigned*)(ctl + CW_BAR); bar.x = 0; bar.st = nullptr;
#if !MK_SPLIT
    bar = xcd_barrier_post((unsigned*)(ctl + CW_BAR), MISC + 8);
#endif
    const int lo = args.ph_lo, hi = args.ph_hi;
    int ph = 0;
#if MK_SPLIT
#define SEAM() do { } while (0)
#else
#define SEAM() do { if (ph + 1 < hi) xcd_barrier(bar); } while (0)
#endif
#ifndef PHSEL
#define PHSEL -1
#endif
#ifndef PHMASK
#define PHMASK 0x7fff
#endif
#ifndef DBL_MASK
#define DBL_MASK 0
#endif
#define PHASE_BEGIN(id) if ((PHSEL < 0 || PHSEL == (id)) && ((PHMASK >> (id)) & 1) && lo <= ph && ph < hi) for (int rep_ = 0; rep_ < (((DBL_MASK >> (id)) & 1) ? 2 : 1); ++rep_) { if (rep_) xcd_barrier(bar); { int t_ = threadIdx.x; asm volatile("" : "+v"(t_)); F.tid = t_; F.lane = t_ & 63; F.wave = __builtin_amdgcn_readfirstlane(t_ >> 6); }
#define PHASE_END   SEAM(); } ++ph;

    PHASE_BEGIN(0) p0_phase(F); PHASE_END
    PHASE_BEGIN(1) p1_phase(F); PHASE_END
#pragma unroll 1
    for (int l = 0; l < 2; ++l) {
        const float* xin = (l == 0) ? (const float*)args.in[0] : (const float*)args.out;
        PHASE_BEGIN(2) {
            pg8::Gemm g{WSP(bf16_t, WS_XN), WSP(bf16_t, WS_WIN) + (size_t)l * DINP * 1024, MTOK, DINP, 1024}; pg8::StaticOrder S; S.init(MTOK, DINP, F.G, (int)blockIdx.x);
            pg8::EpiBf16 E{WSP(bf16_t, WS_U), DINP, DINP / 256};
            pg8::gemm_phase<pg8::EpiBf16, pg8::StaticOrder, true, true>(F.lds, g, S, E, F.tid);
        } PHASE_END
        PHASE_BEGIN(3) {
#ifndef SUBSEL
#define SUBSEL 0
#endif
#ifndef REP_A
#define REP_A 1
#define REP_B 1
#define REP_C 1
#define REP_D 1
#define REP_E 1
#endif
            for (int q_ = 0; q_ < REP_A; ++q_) for (int tl = F.vcu; tl < 256; tl += F.G) hy_prep_tile(F, tl, l);
            for (int q_ = 0; q_ < REP_B; ++q_) for (int p = F.vcu; p < 512; p += F.G) ml_local_pair(F, p, l);
            for (int q_ = 0; q_ < REP_C; ++q_) mla_prep_rows(F, l);
        } PHASE_END
        PHASE_BEGIN(4) {
            pg8::Gemm g{WSP(bf16_t, WS_AMLA), WSP(bf16_t, WS_WMLA) + (size_t)l * 1024 * 384, MTOK, 1024, 384}; pg8::StaticOrder S; S.init(MTOK, 1024, F.G, (int)blockIdx.x);
            pg8::EpiBf16 E{WSP(bf16_t, WS_OMLA), 1024, 4};
            pg8::gemm_phase<pg8::EpiBf16, pg8::StaticOrder, true, true>(F.lds, g, S, E, F.tid);
#define REFRESH_TID() do { int t_ = threadIdx.x; asm volatile("" : "+v"(t_)); F.tid = t_; F.lane = t_ & 63; F.wave = __builtin_amdgcn_readfirstlane(t_ >> 6); } while (0)
            REFRESH_TID();
            ml_scan(F);
            REFRESH_TID();
#ifndef HY_REP
#define HY_REP 1
#endif
            for (int rep2_ = 0; rep2_ < HY_REP; ++rep2_) for (int c = F.vcu; c < 256; c += F.G) hyena_item(F, c, l);
        } PHASE_END
        PHASE_BEGIN(5) relayout_phase(F); PHASE_END
        PHASE_BEGIN(6) {
            for (int q_ = 0; q_ < REP_D; ++q_) for (int u = F.vcu; u < 256; u += F.G) attn_unit(F, u >> 5, u & 31);
            for (int q_ = 0; q_ < REP_E; ++q_) for (int p = F.vcu; p < 512; p += F.G) ml_out_pair(F, p, l);
        } PHASE_END
        PHASE_BEGIN(7) headnorm_phase(F, l); PHASE_END
        PHASE_BEGIN(8) {
            pg8::Gemm g{WSP(bf16_t, WS_YN), WSP(bf16_t, WS_WOUT) + (size_t)l * 1024 * 1024, MTOK, 1024, 1024}; pg8::StaticOrder S; S.init(MTOK, 1024, F.G, (int)blockIdx.x);
            pg8::EpiF32 E{WSP(float, WS_Y2), 1024};
            pg8::gemm_phase<pg8::EpiF32, pg8::StaticOrder, true, true>(F.lds, g, S, E, F.tid);
        } PHASE_END
        PHASE_BEGIN(9) post_mixer_phase(F, l, xin); PHASE_END
        PHASE_BEGIN(10) { for (int it = F.vcu; it < 32; it += F.G) topk_item(F, it); } PHASE_END
        PHASE_BEGIN(11) gather_phase(F); PHASE_END
        PHASE_BEGIN(12) {
            pg8::Gemm g{WSP(bf16_t, WS_XE), WSP(bf16_t, WS_WGU) + (size_t)l * NEXP * 4096 * 1024, NEXP * 2048, NEXP * 4096, 1024}; pg8::GroupedOrder S; S.init(16, F.G, (int)blockIdx.x);
            pg8::EpiSwiGLU E{WSP(bf16_t, WS_ACT), EFF};
            pg8::gemm_phase<pg8::EpiSwiGLU, pg8::GroupedOrder, true, true>(F.lds, g, S, E, F.tid);
        } PHASE_END
        PHASE_BEGIN(13) {
            pg8::Gemm g{WSP(bf16_t, WS_ACT), WSP(bf16_t, WS_WDN) + (size_t)l * NEXP * 1024 * 2048, NEXP * 2048, NEXP * 1024, 2048}; pg8::GroupedOrder S; S.init(4, F.G, (int)blockIdx.x);
            pg8::EpiBf16 E{WSP(bf16_t, WS_YE), 1024, 4};
            pg8::gemm_phase<pg8::EpiBf16, pg8::GroupedOrder, true, true>(F.lds, g, S, E, F.tid);
        } PHASE_END
        PHASE_BEGIN(14) combine_phase(F, l); PHASE_END
    }
}

extern "C" void kernel_launch(void* const* d_in, const int* in_sizes, int n_in, void* d_out, int out_size, void* d_ws, size_t ws_size, hipStream_t stream) {
    static int grid = 0;
    if (grid == 0) {
        if (n_in != 35 || out_size != MTOK * DM || ws_size < WS_END) { fprintf(stderr, "kernel_launch: unexpected shapes: n_in %d out %d ws %zu (need %zu)\n", n_in, out_size, ws_size, (size_t)WS_END); grid = -1; return; }
        int dev = 0, cus = 0, per_cu = 0;
        if (hipGetDevice(&dev) != hipSuccess || hipDeviceGetAttribute(&cus, hipDeviceAttributeMultiprocessorCount, dev) != hipSuccess) { grid = -1; return; }
        if (hipFuncSetAttribute((const void*)mega_fwd, hipFuncAttributeMaxDynamicSharedMemorySize, LDS_BYTES) != hipSuccess) { fprintf(stderr, "kernel_launch: hipFuncSetAttribute failed\n"); grid = -1; return; }
        (void)hipOccupancyMaxActiveBlocksPerMultiprocessor(&per_cu, (const void*)mega_fwd, NTHR, LDS_BYTES);
        (void)hipGetLastError();
        grid = cus > 0 ? cus : 256;
        if (per_cu < 1) fprintf(stderr, "kernel_launch: occupancy query reports %d\n", per_cu);
    }
    if (grid < 0) return;
    (void)hipMemsetAsync((char*)d_ws + WS_CTL, 0, CTL_ZERO_BYTES, stream);
    Args a{};
    for (int i = 0; i < 35; ++i) a.in[i] = d_in[i];
    a.out = (float*)d_out; a.ws = (unsigned char*)d_ws;
#if MK_SPLIT
    for (int p = 0; p < N_PHASES; ++p) { a.ph_lo = p; a.ph_hi = p + 1; hipLaunchKernelGGL(mega_fwd, dim3(grid), dim3(NTHR), LDS_BYTES, stream, a); }
#else
    a.ph_lo = 0; a.ph_hi = N_PHASES;
    hipLaunchKernelGGL(mega_fwd, dim3(grid), dim3(NTHR), LDS_BYTES, stream, a);
#endif
}
```

```cpp
#include <hip/hip_runtime.h>
#include <cstdio>
#include <cstdint>

#ifndef MK_SPLIT
#define MK_SPLIT 0
#endif

#define GAS __attribute__((address_space(1)))
#define LAS __attribute__((address_space(3)))
typedef GAS unsigned gu32;
#define RLX_AGENT __ATOMIC_RELAXED, __HIP_MEMORY_SCOPE_AGENT
typedef unsigned short bf16_t;
typedef short bf16x8 __attribute__((ext_vector_type(8)));
typedef short s16x4 __attribute__((ext_vector_type(4)));
typedef float f32x4 __attribute__((ext_vector_type(4)));
typedef float f32x2 __attribute__((ext_vector_type(2)));
typedef float f32x16 __attribute__((ext_vector_type(16)));
typedef unsigned u32x4 __attribute__((ext_vector_type(4)));
typedef unsigned u32x2 __attribute__((ext_vector_type(2)));
typedef __bf16 bf16x2_t __attribute__((ext_vector_type(2)));

namespace pg8 {
#define PG8_LAS __attribute__((address_space(3)))
constexpr int BM = 256, BK = 64, HALF = 128, HTB = HALF * BK * 2, STAGE_BYTES = 8 * HTB, NXCD = 8, WGM = 8;
__host__ __device__ __forceinline__ int lds_byte(int r, int c) { const int st = (r >> 4) * 2 + (c >> 5), rr = r & 15, cc = c & 31, ob = rr * 64 + cc * 2; return st * 1024 + (ob ^ (((ob >> 9) & 1) << 5)); }
__host__ __device__ __forceinline__ void stage_rc(int b, int& R, int& C) { const int st = b / 1024, sb = b % 1024, swz = sb ^ (((sb >> 9) & 1) << 5); R = (st >> 1) * 16 + swz / 64; C = (st & 1) * 32 + (swz % 64) / 2; }
__host__ __device__ __forceinline__ int perm32(int rho) { const int n = rho >> 4, i = rho & 15; return 8 * (i >> 2) + 4 * n + (i & 3); }
struct Unit { int pm, pn; };
struct Gemm { const bf16_t* A; const bf16_t* Bt; int M, N, K; };
struct StaticOrder {
    int nM, nN, nwg, G, c;
    __host__ __device__ void init(int M, int N, int G_, int c_) { nM = M / BM; nN = N / BM; nwg = nM * nN; G = G_; c = c_; }
    __host__ __device__ bool next(int i, Unit& u) const {
        const long L = (long)i * G + c; if (L >= nwg) return false;
        int wgid = (int)L; { const int q = nwg / NXCD, r = nwg % NXCD, xcd = wgid % NXCD, off = wgid / NXCD; wgid = (xcd < r ? xcd * (q + 1) : r * (q + 1) + (xcd - r) * q) + off; }
        const int nig = WGM * nN, gid = wgid / nig, fm = gid * WGM, gsz = (nM - fm) < WGM ? (nM - fm) : WGM;
        u.pm = fm + ((wgid % nig) % gsz); u.pn = (wgid % nig) / gsz; return true;
    }
    __device__ __forceinline__ void a_ready(const Unit&) const {}
    __device__ __forceinline__ void done(const Unit&) const {}
};
struct GroupedOrder {
    int nNl, total, G, c;
    __host__ __device__ void init(int nNl_, int G_, int c_) { nNl = nNl_; total = 16 * 8 * nNl_; G = G_; c = c_; }
    __host__ __device__ bool next(int i, Unit& u) const {
        const long L = (long)i * G + c; if (L >= total) return false;
        const int per_e = 8 * nNl, e = (int)L / per_e, r = (int)L % per_e;
        u.pm = e * 8 + (r % 8); u.pn = e * nNl + (r / 8); return true;
    }
    __device__ __forceinline__ void a_ready(const Unit&) const {}
    __device__ __forceinline__ void done(const Unit&) const {}
};
__device__ __forceinline__ unsigned cvt_pk_bf16(float lo, float hi) { f32x2 v = {lo, hi}; bf16x2_t b = __builtin_convertvector(v, bf16x2_t); return __builtin_bit_cast(unsigned, b); }

struct EpiBf16 {
    static constexpr bool PERM = true, AFTER_DRAIN = false;
    bf16_t* O; int ldc; int ntn;
    __device__ __forceinline__ void operator()(const f32x4 (&acc)[2][2][4][2], const Unit& u, int wr, int wc, int fr, int fq) const {
        const int row0 = u.pm * BM + wr * 64 + fr; const int colt = (u.pn % ntn) * BM;
        const int col0 = colt + wc * 32 + 8 * fq;
#pragma unroll
        for (int ai = 0; ai < 2; ++ai)
#pragma unroll
            for (int m = 0; m < 4; ++m) { bf16_t* rowp = O + (size_t)(row0 + ai * HALF + m * 16) * ldc + col0;
#pragma unroll
                for (int bj = 0; bj < 2; ++bj) { const f32x4 v0 = acc[ai][bj][m][0], v1 = acc[ai][bj][m][1];
                    u32x4 w; w.x = cvt_pk_bf16(v0[0], v0[1]); w.y = cvt_pk_bf16(v0[2], v0[3]); w.z = cvt_pk_bf16(v1[0], v1[1]); w.w = cvt_pk_bf16(v1[2], v1[3]);
                    *(u32x4*)(rowp + bj * HALF) = w; } }
    }
};
struct EpiF32 {
    static constexpr bool PERM = false, AFTER_DRAIN = false;
    float* O; int ldc;
    __device__ __forceinline__ void operator()(const f32x4 (&acc)[2][2][4][2], const Unit& u, int wr, int wc, int fr, int fq) const {
        const int col0 = u.pn * BM + wc * 32 + 4 * fq;
#pragma unroll
        for (int ai = 0; ai < 2; ++ai)
#pragma unroll
            for (int m = 0; m < 4; ++m) { float* rowp = O + (size_t)(u.pm * BM + ai * HALF + wr * 64 + m * 16 + fr) * ldc + col0;
#pragma unroll
                for (int bj = 0; bj < 2; ++bj)
#pragma unroll
                    for (int n = 0; n < 2; ++n) *(f32x4*)(rowp + bj * HALF + n * 16) = acc[ai][bj][m][n]; }
    }
};
__device__ __forceinline__ float silu_f(float a) { return a * __builtin_amdgcn_rcpf(1.0f + __builtin_amdgcn_exp2f(-1.4426950408889634f * a)); }
struct EpiSwiGLU {
    static constexpr bool PERM = true, AFTER_DRAIN = false;
    bf16_t* O; int ldc;
    __device__ __forceinline__ void operator()(const f32x4 (&acc)[2][2][4][2], const Unit& u, int wr, int wc, int fr, int fq) const {
        const int row0 = u.pm * BM + wr * 64 + fr; const int col0 = (u.pn % 16) * HALF + wc * 32 + 8 * fq;
#pragma unroll
        for (int ai = 0; ai < 2; ++ai)
#pragma unroll
            for (int m = 0; m < 4; ++m) { bf16_t* rowp = O + (size_t)(row0 + ai * HALF + m * 16) * ldc + col0;
                const f32x4 g0 = acc[ai][0][m][0], g1 = acc[ai][0][m][1], u0 = acc[ai][1][m][0], u1 = acc[ai][1][m][1];
                u32x4 w;
                w.x = cvt_pk_bf16(silu_f(g0[0]) * u0[0], silu_f(g0[1]) * u0[1]); w.y = cvt_pk_bf16(silu_f(g0[2]) * u0[2], silu_f(g0[3]) * u0[3]);
                w.z = cvt_pk_bf16(silu_f(g1[0]) * u1[0], silu_f(g1[1]) * u1[1]); w.w = cvt_pk_bf16(silu_f(g1[2]) * u1[2], silu_f(g1[3]) * u1[3]);
                *(u32x4*)rowp = w; }
    }
};

template <class Epi, class Sched, bool ALIGN_EPI = false, bool SP2 = false>
__device__ __forceinline__ void gemm_phase(PG8_LAS unsigned char* lds, const Gemm g, const Sched& S, const Epi& E, const int tid) {
    const int wid = __builtin_amdgcn_readfirstlane(tid >> 6), lane = tid & 63, wr = wid >> 2, wc = wid & 3, fr = lane & 15, fq = lane >> 4;
    int K_ = g.K; asm volatile("" : "+s"(K_));
    const int K = K_, nt = K / BK;
    unsigned voffA[2], voffB[2];
#pragma unroll
    for (int i = 0; i < 2; ++i) { int R, C; stage_rc(tid * 16 + i * 8192, R, C); const int Rb = Epi::PERM ? ((R & ~31) + perm32(R & 31)) : R;
        voffA[i] = (unsigned)(R * K + C) * 2u; voffB[i] = (unsigned)(Rb * K + C) * 2u; }
    const size_t kstep = (size_t)(BK * 2);
    const size_t hstep = (size_t)HALF * K * 2;
    const size_t tstep = 2 * hstep;
    const unsigned ldsw = (unsigned)wid * 1024u;
    const int aoff = lds_byte(wr * 64 + fr, fq * 8), boff = lds_byte(wc * 32 + fr, fq * 8);
#define PG8_SA(b, h) (((b) * 2 + (h)) * HTB)
#define PG8_SB(b, h) ((4 + (b) * 2 + (h)) * HTB)
#define PG8_STAGE(bufoff, gbase, voff) do { _Pragma("unroll") for (int _i = 0; _i < 2; ++_i) \
        __builtin_amdgcn_global_load_lds((const unsigned*)((const char*)(gbase) + (voff)[_i]), (PG8_LAS unsigned*)(lds + (bufoff) + ldsw + _i * 8192), 16, 0, 0); } while (0)
#define PG8_LDA(dst, b, h) do { _Pragma("unroll") for (int m = 0; m < 4; ++m) _Pragma("unroll") for (int k = 0; k < 2; ++k) dst[m][k] = *(const PG8_LAS bf16x8*)(lds + PG8_SA(b, h) + aoff + m * 2048 + k * 1024); } while (0)
#define PG8_LDB(dst, b, h) do { _Pragma("unroll") for (int n = 0; n < 2; ++n) _Pragma("unroll") for (int k = 0; k < 2; ++k) dst[n][k] = *(const PG8_LAS bf16x8*)(lds + PG8_SB(b, h) + boff + n * 2048 + k * 1024); } while (0)
#define PG8_MMA(ai, bj, At, Bt) do { __builtin_amdgcn_s_setprio(1); _Pragma("unroll") for (int m = 0; m < 4; ++m) _Pragma("unroll") for (int n = 0; n < 2; ++n) _Pragma("unroll") for (int k = 0; k < 2; ++k) \
        acc[ai][bj][m][n] = __builtin_amdgcn_mfma_f32_16x16x32_bf16(Bt[n][k], At[m][k], acc[ai][bj][m][n], 0, 0, 0); __builtin_amdgcn_s_setprio(0); } while (0)
#define PG8_WAIT_V(n) asm volatile("s_waitcnt vmcnt(" #n ")" ::: "memory")
#define PG8_WAIT_L(n) asm volatile("s_waitcnt lgkmcnt(" #n ")" ::: "memory")
#define PG8_BAR __builtin_amdgcn_s_barrier()
#define PG8_SCHED __builtin_amdgcn_sched_barrier(0)
    Unit cur, nxt; int ui = 0;
    if (!S.next(0, cur)) return;
    f32x4 acc[2][2][4][2];
#pragma unroll
    for (int a = 0; a < 2; ++a)
#pragma unroll
        for (int b = 0; b < 2; ++b)
#pragma unroll
            for (int m = 0; m < 4; ++m)
#pragma unroll
                for (int n = 0; n < 2; ++n) acc[a][b][m][n] = (f32x4){0.f, 0.f, 0.f, 0.f};
    bf16x8 At[4][2], B0[2][2], B1[2][2];
    const char* cA = (const char*)g.A + (size_t)cur.pm * tstep; const char* cB = (const char*)g.Bt + (size_t)cur.pn * tstep;
    S.a_ready(cur);
    if constexpr (SP2) {
        PG8_STAGE(PG8_SB(0, 0), cB, voffB); PG8_STAGE(PG8_SB(0, 1), cB + hstep, voffB); PG8_STAGE(PG8_SA(0, 0), cA, voffA); PG8_STAGE(PG8_SA(0, 1), cA + hstep, voffA);
        if (wr == 1) PG8_BAR;
        PG8_WAIT_V(2); PG8_BAR;
        PG8_STAGE(PG8_SB(1, 0), cB + kstep, voffB); PG8_STAGE(PG8_SA(1, 0), cA + kstep, voffA); PG8_STAGE(PG8_SB(1, 1), cB + hstep + kstep, voffB);
        PG8_WAIT_V(6); PG8_BAR;
    } else {
        PG8_STAGE(PG8_SB(0, 0), cB, voffB); PG8_STAGE(PG8_SA(0, 0), cA, voffA); PG8_STAGE(PG8_SB(0, 1), cB + hstep, voffB); PG8_STAGE(PG8_SA(0, 1), cA + hstep, voffA);
        if (wr == 1) PG8_BAR;
        PG8_WAIT_V(4); PG8_BAR;
        PG8_STAGE(PG8_SB(1, 0), cB + kstep, voffB); PG8_STAGE(PG8_SA(1, 0), cA + kstep, voffA); PG8_STAGE(PG8_SB(1, 1), cB + hstep + kstep, voffB);
        PG8_WAIT_V(6); PG8_BAR;
    }
    for (;;) {
        const bool has_next = S.next(ui + 1, nxt);
        const char* nA = has_next ? (const char*)g.A + (size_t)nxt.pm * tstep : cA; const char* nB = has_next ? (const char*)g.Bt + (size_t)nxt.pn * tstep : cB;
        for (int t = 0; t < nt; t += 2) {
            const bool last = (t == nt - 2);
            const char* a1 = cA + (size_t)(t + 1) * kstep;
            const char* a2 = last ? nA : cA + (size_t)(t + 2) * kstep; const char* b2 = last ? nB : cB + (size_t)(t + 2) * kstep;
            const char* a3 = a2 + kstep; const char* b3 = b2 + kstep;
            if (last && has_next) S.a_ready(nxt);
            if constexpr (SP2) {
            PG8_LDB(B0, 0, 0); PG8_LDB(B1, 0, 1); PG8_SCHED; PG8_LDA(At, 0, 0); PG8_STAGE(PG8_SA(1, 1), a1 + hstep, voffA);
            PG8_WAIT_V(8); PG8_WAIT_L(0); PG8_BAR; PG8_MMA(0, 0, At, B0); PG8_MMA(0, 1, At, B1); PG8_BAR; PG8_SCHED;
            PG8_LDA(At, 0, 1); PG8_STAGE(PG8_SB(0, 0), b2, voffB); PG8_STAGE(PG8_SB(0, 1), b2 + hstep, voffB); PG8_STAGE(PG8_SA(0, 0), a2, voffA);
            PG8_WAIT_V(8); PG8_WAIT_L(0); PG8_BAR; PG8_MMA(1, 0, At, B0); PG8_MMA(1, 1, At, B1); PG8_BAR; PG8_SCHED;
            PG8_LDB(B0, 1, 0); PG8_LDB(B1, 1, 1); PG8_SCHED; PG8_LDA(At, 1, 0); PG8_STAGE(PG8_SA(0, 1), a2 + hstep, voffA);
            PG8_WAIT_V(8); PG8_WAIT_L(0); PG8_BAR; PG8_MMA(0, 0, At, B0); PG8_MMA(0, 1, At, B1); PG8_BAR; PG8_SCHED;
            PG8_LDA(At, 1, 1); PG8_STAGE(PG8_SB(1, 0), b3, voffB); PG8_STAGE(PG8_SB(1, 1), b3 + hstep, voffB); PG8_STAGE(PG8_SA(1, 0), a3, voffA);
            PG8_WAIT_V(8); PG8_WAIT_L(0); PG8_BAR; PG8_MMA(1, 0, At, B0); PG8_MMA(1, 1, At, B1); PG8_BAR; PG8_SCHED;
            } else {
            PG8_LDB(B0, 0, 0); PG8_SCHED; PG8_LDA(At, 0, 0); PG8_STAGE(PG8_SA(1, 1), a1 + hstep, voffA);
            PG8_WAIT_L(8); PG8_BAR; PG8_WAIT_L(0); PG8_MMA(0, 0, At, B0); PG8_BAR; PG8_SCHED;
            PG8_LDB(B1, 0, 1); PG8_STAGE(PG8_SB(0, 0), b2, voffB);
            PG8_BAR; PG8_WAIT_L(0); PG8_MMA(0, 1, At, B1); PG8_BAR;
            PG8_LDA(At, 0, 1); PG8_STAGE(PG8_SA(0, 0), a2, voffA);
            PG8_BAR; PG8_WAIT_L(0); PG8_MMA(1, 0, At, B0); PG8_BAR; PG8_SCHED;
            PG8_STAGE(PG8_SB(0, 1), b2 + hstep, voffB);
            PG8_WAIT_V(6); PG8_BAR; PG8_MMA(1, 1, At, B1); PG8_BAR;
            PG8_LDB(B0, 1, 0); PG8_SCHED; PG8_LDA(At, 1, 0); PG8_STAGE(PG8_SA(0, 1), a2 + hstep, voffA);
            PG8_WAIT_L(8); PG8_BAR; PG8_WAIT_L(0); PG8_MMA(0, 0, At, B0); PG8_BAR; PG8_SCHED;
            PG8_LDB(B1, 1, 1); PG8_STAGE(PG8_SB(1, 0), b3, voffB);
            PG8_BAR; PG8_WAIT_L(0); PG8_MMA(0, 1, At, B1); PG8_BAR;
            PG8_LDA(At, 1, 1); PG8_STAGE(PG8_SA(1, 0), a3, voffA);
            PG8_BAR; PG8_WAIT_L(0); PG8_MMA(1, 0, At, B0); PG8_BAR; PG8_SCHED;
            PG8_STAGE(PG8_SB(1, 1), b3 + hstep, voffB);
            PG8_WAIT_V(6); PG8_BAR; PG8_MMA(1, 1, At, B1); PG8_BAR;
            }
        }
        if constexpr (ALIGN_EPI) { if (wr == 0) PG8_BAR; }
        if constexpr (!Epi::AFTER_DRAIN) { E(acc, cur, wr, wc, fr, fq); S.done(cur); }
        if (!has_next) break;
#pragma unroll
        for (int a = 0; a < 2; ++a)
#pragma unroll
            for (int b = 0; b < 2; ++b)
#pragma unroll
                for (int m = 0; m < 4; ++m)
#pragma unroll
                    for (int n = 0; n < 2; ++n) acc[a][b][m][n] = (f32x4){0.f, 0.f, 0.f, 0.f};
        cur = nxt; cA = nA; cB = nB; ++ui;
        if constexpr (ALIGN_EPI) { if (wr == 1) PG8_BAR; }
    }
    PG8_WAIT_V(0);
    if constexpr (!ALIGN_EPI) { if (wr == 0) PG8_BAR; }
    PG8_BAR;
#undef PG8_SA
#undef PG8_SB
#undef PG8_STAGE
#undef PG8_LDA
#undef PG8_LDB
#undef PG8_MMA
#undef PG8_WAIT_V
#undef PG8_WAIT_L
#undef PG8_BAR
#undef PG8_SCHED
}
}

constexpr int NWAVES = 8, NTHR = 512;
constexpr int BATCH = 2, SEQ = 8192, DM = 1024, MTOK = BATCH * SEQ;
constexpr int DIN = 2960, DINP = 3072;
constexpr int NEXP = 16, CAP = 1024, EFF = 2048;
constexpr float EPS = 1e-6f;
constexpr int U_MLQ = 0, U_MLK = 256, U_MLV = 512, U_MLO = 768, U_MLG = 1024, U_CQ = 1040, U_CKV = 1264, U_KR = 1392, U_HY = 1424, U_SC = 2192;
constexpr float LOG2E = 1.4426950408889634f;

constexpr size_t MiB = 1u << 20;
constexpr size_t WS_CTL = 0, CTL_ZERO_BYTES = 1 * MiB;
constexpr size_t WS_MOD = 1 * MiB;
constexpr size_t WS_MLS = 1 * MiB + 128 * 1024;
constexpr size_t WS_MLN = 1 * MiB + 256 * 1024;
constexpr size_t WS_AFF = 2 * MiB;
constexpr size_t WS_SLOT = 3 * MiB;
constexpr size_t WS_IDX = 4 * MiB;
constexpr size_t WS_HID = 5 * MiB;
constexpr size_t WS_WMLA = 9 * MiB;
constexpr size_t WS_WOUT = 11 * MiB;
constexpr size_t WS_WIN = 15 * MiB;
constexpr size_t WS_WGU = 28 * MiB;
constexpr size_t WS_WDN = 284 * MiB;
constexpr size_t WS_XN = 412 * MiB;
constexpr size_t WS_AMLA = 444 * MiB;
constexpr size_t WS_Q = 456 * MiB;
constexpr size_t WS_KIMG = 468 * MiB;
constexpr size_t WS_VIMG = 480 * MiB;
constexpr size_t WS_MLC = 488 * MiB;
constexpr size_t WS_HF = 504 * MiB;
constexpr size_t WS_HB = 520 * MiB;
constexpr size_t WS_YATT = 536 * MiB;
constexpr size_t WS_YHT = 544 * MiB;
constexpr size_t WS_YN = 552 * MiB;
constexpr size_t WS_X1 = 584 * MiB;
constexpr size_t WS_U = 648 * MiB;
constexpr size_t WS_OMLA = 744 * MiB;
constexpr size_t WS_ACT = 648 * MiB;
constexpr size_t WS_KF = 776 * MiB;
constexpr size_t WS_Y2 = 776 * MiB;
constexpr size_t WS_XE = 776 * MiB;
constexpr size_t WS_YE = 840 * MiB;
constexpr size_t WS_HYT = 904 * MiB;
constexpr size_t WS_FILT = 956 * MiB;
constexpr size_t WS_END = 1020 * MiB;
constexpr int CW_BAR = 4096;

constexpr int RING_BYTES = 139264;
constexpr int LDSCTL_OFF = RING_BYTES, MISC_OFF = LDSCTL_OFF + 320;
constexpr int XTRA_OFF = RING_BYTES + 1024;
constexpr int LDS_BYTES = 147456;

__device__ __forceinline__ float bf2f(unsigned short u) { return __uint_as_float((unsigned)u << 16); }
__device__ __forceinline__ unsigned pk2(float lo, float hi) { f32x2 v = {lo, hi}; bf16x2_t b = __builtin_convertvector(v, bf16x2_t); return __builtin_bit_cast(unsigned, b); }
__device__ __forceinline__ float bflo(unsigned w) { return __uint_as_float(w << 16); }
__device__ __forceinline__ float bfhi(unsigned w) { return __uint_as_float(w & 0xffff0000u); }
__device__ __forceinline__ float wave_sum(float v) {
#pragma unroll
    for (int o = 1; o < 64; o <<= 1) v += __shfl_xor(v, o);
    return v;
}
__device__ __forceinline__ float fexp(float x) { return __builtin_amdgcn_exp2f(x * LOG2E); }
__device__ __forceinline__ float flog(float x) { return __builtin_amdgcn_logf(x) * 0.6931471805599453f; }
__device__ __forceinline__ float sin_rev(float r) { return __builtin_amdgcn_sinf(r); }
__device__ __forceinline__ float cos_rev(float r) { return __builtin_amdgcn_cosf(r); }
__device__ __forceinline__ float sin_rad(float x) { float r = x * 0.15915494309189535f; r = r - __builtin_rintf(r); return __builtin_amdgcn_sinf(r); }
__device__ __forceinline__ int crow(int r, int hi) { return (r & 3) + 8 * (r >> 2) + 4 * hi; }
#define LDS_WAIT() asm volatile("s_waitcnt lgkmcnt(0)" ::: "memory")
#define VM_WAIT() asm volatile("s_waitcnt vmcnt(0)" ::: "memory")

#define XB_TMO      128
#define XB_XCNT(j)  (256  + 64 * (j))
#define XB_XSUB(j)  (1280 + 64 * (j))
#define XB_XGEN(j)  (2304 + 64 * (j))
#define XB_TOP      3328
#define XB_TOPGEN   3392
#define XCD_BAR_WORDS 3456
#define XB_SPIN_CAP (1u << 18)
__device__ __forceinline__ unsigned xb_ld(unsigned* p)              { return __hip_atomic_load(p, __ATOMIC_RELAXED, __HIP_MEMORY_SCOPE_AGENT); }
__device__ __forceinline__ unsigned xb_add(unsigned* p, unsigned v) { return __hip_atomic_fetch_add(p, v, __ATOMIC_RELAXED, __HIP_MEMORY_SCOPE_AGENT); }
__device__ __forceinline__ unsigned xb_xcc_id() { return (unsigned)__builtin_amdgcn_s_getreg((3 << 11) | 20) & 0xFu; }
#define XB_SPIN(cond, bar) do { unsigned _sp = 0; while (cond) { __builtin_amdgcn_s_sleep(1); \
    if ((++_sp & 255u) == 0u) { if (xb_ld(&(bar)[XB_TMO])) break; if (_sp > XB_SPIN_CAP) { atomicAdd(&(bar)[XB_TMO], 1u); break; } } } } while (0)
struct XcdBarrier { unsigned* bar; unsigned x; volatile LAS unsigned* st; };
__device__ __forceinline__ XcdBarrier xcd_barrier_post(unsigned* bar, volatile LAS unsigned* st) {
    XcdBarrier b; b.bar = bar; b.x = xb_xcc_id(); b.st = st;
    if (threadIdx.x == 0) (void)xb_add(&bar[XB_XCNT(b.x)], 1u);
    return b;
}
__device__ __forceinline__ void xcd_barrier_complete(unsigned* bar, unsigned x, unsigned& nloc, unsigned& nx) {
    const unsigned G = gridDim.x * gridDim.y * gridDim.z;
    unsigned sum, cnt, mine, sp = 0u;
    for (;;) {
        sum = 0u; cnt = 0u; mine = 0u;
#pragma unroll
        for (unsigned j = 0; j < 16; ++j) { const unsigned c = xb_ld(&bar[XB_XCNT(j)]); sum += c; cnt += (c > 0u) ? 1u : 0u; mine = (j == x) ? c : mine; }
        if (sum == G) break;
        __builtin_amdgcn_s_sleep(1);
        if ((++sp & 255u) == 0u) { if (xb_ld(&bar[XB_TMO])) break; if (sp > XB_SPIN_CAP) { atomicAdd(&bar[XB_TMO], 1u); break; } }
    }
    nloc = mine > 0u ? mine : 1u; nx = cnt > 0u ? cnt : 1u;
}
__device__ __forceinline__ void xcd_barrier(const XcdBarrier& b) {
    asm volatile("s_waitcnt vmcnt(0)" ::: "memory");
    __syncthreads();
    if (threadIdx.x == 0) {
        unsigned* bar = b.bar;
        __builtin_amdgcn_s_waitcnt(0);
        unsigned nloc = b.st[0], nx = b.st[1];
        if (nloc == 0u) { xcd_barrier_complete(bar, b.x, nloc, nx); b.st[0] = nloc; b.st[1] = nx; }
        const unsigned old = xb_add(&bar[XB_XSUB(b.x)], 1u);
        const unsigned gen = old / nloc;
        if (old + 1u == (gen + 1u) * nloc) {
            __builtin_amdgcn_fence(__ATOMIC_RELEASE, "agent");
            asm volatile("s_waitcnt vmcnt(0)" ::: "memory");
            const unsigned og = xb_add(&bar[XB_TOP], 1u);
            const unsigned tg = og / nx;
            if (og + 1u == (tg + 1u) * nx) xb_add(&bar[XB_TOPGEN], 1u);
            else XB_SPIN(xb_ld(&bar[XB_TOPGEN]) == tg, bar);
            __builtin_amdgcn_fence(__ATOMIC_ACQUIRE, "agent");
            xb_add(&bar[XB_XGEN(b.x)], 1u);
            asm volatile("s_waitcnt vmcnt(0)" ::: "memory");
        } else {
            XB_SPIN(xb_ld(&bar[XB_XGEN(b.x)]) == gen, bar);
            __builtin_amdgcn_fence(__ATOMIC_ACQUIRE, "agent");
            asm volatile("s_waitcnt vmcnt(0)" ::: "memory");
        }
    }
    __syncthreads();
}

struct Args { const void* in[35]; float* out; unsigned char* ws; int ph_lo, ph_hi; };
struct Frame {
    LAS unsigned char* lds;
    int tid, lane, wave, vcu, G;
    const Args* a;
    unsigned char* ws;
};
#define INF(i) ((const float*)F.a->in[i])
#define WSP(T, off) ((T*)(F.ws + (off)))

__device__ __forceinline__ void tr_item(const float* W, int ldw, int Kvalid, int Nvalid, int k0, int n0, bf16_t* dst, int dpitch, int drow0, int dk0, LAS float* scr, int lane) {
    f32x4 v[16];
    const int nn = n0 + 4 * (lane & 15);
#pragma unroll
    for (int i = 0; i < 16; ++i) { const int kk = 4 * i + (lane >> 4);
        v[i] = (f32x4){0.f, 0.f, 0.f, 0.f};
        if (W != nullptr && (k0 + kk) < Kvalid && nn < Nvalid) v[i] = *(const GAS f32x4*)(W + (size_t)(k0 + kk) * ldw + nn); }
#pragma unroll
    for (int i = 0; i < 16; ++i) { const int kk = 4 * i + (lane >> 4);
        *(LAS f32x4*)(scr + kk * 64 + ((4 * (lane & 15)) ^ (4 * ((kk >> 3) & 7)))) = v[i]; }
    LDS_WAIT(); asm volatile("" ::: "memory");
    const int kc = lane & 7, nl = lane >> 3;
#pragma unroll
    for (int j = 0; j < 8; ++j) { const int n = 8 * j + nl; const LAS float* sp = scr + (8 * kc) * 64 + (n ^ (4 * kc));
        u32x4 o; o.x = pk2(sp[0 * 64], sp[1 * 64]); o.y = pk2(sp[2 * 64], sp[3 * 64]); o.z = pk2(sp[4 * 64], sp[5 * 64]); o.w = pk2(sp[6 * 64], sp[7 * 64]);
        *(GAS u32x4*)(dst + (size_t)(drow0 + n) * dpitch + dk0 + k0 + 8 * kc) = o; }
    LDS_WAIT(); asm volatile("" ::: "memory");
}

__device__ __forceinline__ void p0_phase(Frame& F) {
    const int tid = F.tid, lane = F.lane, wave = F.wave;
    {
        LAS float* cs = (LAS float*)(F.lds);
        LAS float* red = (LAS float*)(F.lds + 8192);
        const float* c = INF(1);
        for (int i = tid; i < 2048; i += NTHR) { const float v = c[i]; cs[i] = v / (1.0f + fexp(-v)); }
        __syncthreads();
        for (int cb = blockIdx.x; cb < 256; cb += F.G) {
            const int j = tid % 48, kg = tid / 48;
            const int col = cb * 48 + j, l = col / 6144, n = col % 6144;
            if (kg < 10) {
                const float* w = INF(3) + (size_t)l * 1024 * 6144 + n;
                float a0 = 0.f, a1 = 0.f;
#pragma unroll 4
                for (int k = kg; k < 1024; k += 10) { const float wv = w[(size_t)k * 6144]; a0 += cs[k] * wv; a1 += cs[1024 + k] * wv; }
                red[(kg * 48 + j) * 2] = a0; red[(kg * 48 + j) * 2 + 1] = a1;
            }
            __syncthreads();
            if (tid < 96) { const int jj = tid >> 1, b = tid & 1; float s = 0.f;
                for (int g = 0; g < 10; ++g) s += red[(g * 48 + jj) * 2 + b];
                const int col2 = cb * 48 + jj, l2 = col2 / 6144, n2 = col2 % 6144;
                WSP(float, WS_MOD)[(l2 * 2 + b) * 6144 + n2] = s + INF(4)[l2 * 6144 + n2]; }
            __syncthreads();
        }
    }
    {
        const int gw = F.vcu * NWAVES + wave, NGW = F.G * NWAVES;
        for (int l = 0; l < 2; ++l) {
            const float* w1 = INF(18) + l * 17 * 64; const float* w2 = INF(21) + l * 64 * 64;
            float w1c[17], w2c[64];
#pragma unroll
            for (int i = 0; i < 17; ++i) w1c[i] = w1[i * 64 + lane];
#pragma unroll
            for (int k = 0; k < 64; ++k) w2c[k] = w2[k * 64 + lane];
            const float b1 = INF(19)[l * 64 + lane], fr1 = INF(20)[l * 64 + lane], b2 = INF(22)[l * 64 + lane], fr2 = INF(23)[l * 64 + lane];
            for (int t = gw; t < SEQ; t += NGW) {
                const float tt = (float)t * (1.0f / SEQ);
                float a = b1 + tt * w1c[0];
#pragma unroll
                for (int bnd = 1; bnd <= 8; ++bnd) { float r = (float)((t * bnd) & (SEQ - 1)) * (1.0f / SEQ); a += sin_rev(r) * w1c[bnd] + cos_rev(r) * w1c[8 + bnd]; }
                const float h1 = sin_rad(fr1 * a);
                float a2 = b2;
#pragma unroll
                for (int k = 0; k < 64; ++k) a2 += __shfl(h1, k) * w2c[k];
                WSP(float, WS_HID)[((size_t)l * SEQ + t) * 64 + lane] = sin_rad(fr2 * a2);
            }
        }
    }
    {
        LAS float* scr = (LAS float*)(F.lds + wave * 16384);
        const int gw = F.vcu * NWAVES + wave, NGW = F.G * NWAVES;
        constexpr int I_WIN = 16 * 48, I_WOUT = 16 * 16, I_WMLA = 6 * 16, I_GU = 16 * 2 * 16 * 32, I_DN = 16 * 32 * 16;
        constexpr int I_LAYER = I_WIN + I_WOUT + I_WMLA + I_GU + I_DN;
        for (int it = gw; it < 2 * I_LAYER; it += NGW) {
            const int l = it / I_LAYER; int r = it % I_LAYER;
            if (r < I_WIN) { const int kb = r / 48, nb = r % 48;
                tr_item(INF(9) + (size_t)l * 1024 * DIN, DIN, 1024, DIN, kb * 64, nb * 64, WSP(bf16_t, WS_WIN) + (size_t)l * DINP * 1024, 1024, nb * 64, 0, scr, lane); continue; }
            r -= I_WIN;
            if (r < I_WOUT) { const int kb = r / 16, nb = r % 16;
                tr_item(INF(30) + (size_t)l * 1024 * 1024, 1024, 1024, 1024, kb * 64, nb * 64, WSP(bf16_t, WS_WOUT) + (size_t)l * 1024 * 1024, 1024, nb * 64, 0, scr, lane); continue; }
            r -= I_WOUT;
            if (r < I_WMLA) { const int kb = r / 16, nb = r % 16;
                bf16_t* dst = WSP(bf16_t, WS_WMLA) + (size_t)l * 1024 * 384;
                const float* W = nullptr; int ldw = 4, Kv = 0, Nv = 0, ksrc = 0, nsrc = 0;
                if (nb < 6 && kb < 4) { W = INF(13) + (size_t)l * 224 * 384; ldw = 384; Kv = 224; Nv = 384; ksrc = kb * 64; nsrc = nb * 64; }
                else if (nb >= 6 && nb < 10 && kb >= 4) { W = INF(14) + (size_t)l * 128 * 256; ldw = 256; Kv = 128; Nv = 256; ksrc = (kb - 4) * 64; nsrc = (nb - 6) * 64; }
                else if (nb >= 10 && nb < 14 && kb >= 4) { W = INF(15) + (size_t)l * 128 * 256; ldw = 256; Kv = 128; Nv = 256; ksrc = (kb - 4) * 64; nsrc = (nb - 10) * 64; }
                tr_item(W, ldw, Kv, Nv, ksrc, nsrc, dst, 384, nb * 64, kb * 64 - ksrc, scr, lane); continue; }
            r -= I_WMLA;
            if (r < I_GU) { const int e = r / (2 * 16 * 32); int q = r % (2 * 16 * 32); const int which = q / (16 * 32); q %= (16 * 32); const int kb = q / 32, nb = q % 32;
                const float* W = INF(which ? 33 : 32) + ((size_t)l * NEXP + e) * 1024 * 2048;
                const int n0 = nb * 64, drow = (n0 >> 7) * 256 + (n0 & 127) + (which ? 128 : 0);
                tr_item(W, 2048, 1024, 2048, kb * 64, n0, WSP(bf16_t, WS_WGU) + ((size_t)l * NEXP + e) * 4096 * 1024, 1024, drow, 0, scr, lane); continue; }
            r -= I_GU;
            { const int e = r / (32 * 16); const int q = r % (32 * 16); const int kb = q / 16, nb = q % 16;
                const float* W = INF(34) + ((size_t)l * NEXP + e) * 2048 * 1024;
                tr_item(W, 1024, 2048, 1024, kb * 64, nb * 64, WSP(bf16_t, WS_WDN) + ((size_t)l * NEXP + e) * 1024 * 2048, 2048, nb * 64, 0, scr, lane); }
        }
    }
}

__device__ __forceinline__ void ld_row_f32(const float* p, int lane, f32x4 (&v)[4]) {
    const GAS f32x4* r = (const GAS f32x4*)p + lane;
#pragma unroll
    for (int j = 0; j < 4; ++j) v[j] = r[64 * j];
}
__device__ __forceinline__ void st_row_f32(float* p, int lane, const f32x4 (&v)[4]) {
    GAS f32x4* r = (GAS f32x4*)p + lane;
#pragma unroll
    for (int j = 0; j < 4; ++j) r[64 * j] = v[j];
}
__device__ __forceinline__ void st_row_bf16(bf16_t* p, int lane, const f32x4 (&v)[4]) {
    GAS u32x2* r = (GAS u32x2*)p + lane;
#pragma unroll
    for (int j = 0; j < 4; ++j) { u32x2 w; w.x = pk2(v[j].x, v[j].y); w.y = pk2(v[j].z, v[j].w); r[64 * j] = w; }
}
__device__ __forceinline__ float row_ss(const f32x4 (&v)[4]) {
    float s = 0.f;
#pragma unroll
    for (int j = 0; j < 4; ++j) s += (v[j].x * v[j].x + v[j].y * v[j].y) + (v[j].z * v[j].z + v[j].w * v[j].w);
    return wave_sum(s);
}
__device__ __forceinline__ void modnorm(const f32x4 (&x)[4], const float* g, const float* sc, const float* sh, int lane, f32x4 (&h)[4]) {
    const float rstd = __builtin_amdgcn_rsqf(row_ss(x) * (1.0f / DM) + EPS);
    f32x4 gv[4], scv[4], shv[4];
    ld_row_f32(g, lane, gv); ld_row_f32(sc, lane, scv); ld_row_f32(sh, lane, shv);
#pragma unroll
    for (int j = 0; j < 4; ++j) h[j] = (x[j] * rstd) * gv[j] * (scv[j] + 1.0f) + shv[j];
}

__device__ __forceinline__ void filt_gemm_tile(Frame& F, int wt) {
    const int lane = F.lane, hi = lane >> 5, l31 = lane & 31;
    const int l = wt >> 11, r = wt & 2047, t0 = (r >> 3) * 32, col0 = (r & 7) * 128;
    f32x16 acc[4];
#pragma unroll
    for (int jb = 0; jb < 4; ++jb)
#pragma unroll
        for (int q = 0; q < 16; ++q) acc[jb][q] = 0.f;
    const float* hid = WSP(float, WS_HID) + ((size_t)l * SEQ + t0 + l31) * 64 + hi;
    const float* w3 = INF(24) + (size_t)l * 64 * 1024 + (size_t)hi * 1024 + col0 + l31;
#pragma unroll 4
    for (int s2 = 0; s2 < 32; ++s2) {
        const float bv = hid[2 * s2];
#pragma unroll
        for (int jb = 0; jb < 4; ++jb) { const float av = w3[(size_t)(2 * s2) * 1024 + 32 * jb]; acc[jb] = __builtin_amdgcn_mfma_f32_32x32x2f32(av, bv, acc[jb], 0, 0, 0); }
    }
    const float tt = (float)(t0 + l31) * (1.0f / SEQ);
    float* FT = WSP(float, WS_FILT) + (size_t)l * 1024 * SEQ + t0 + l31;
#pragma unroll
    for (int jb = 0; jb < 4; ++jb)
#pragma unroll
        for (int q = 0; q < 16; ++q) { const int col = col0 + 32 * jb + crow(q, hi);
            const float v = (acc[jb][q] + INF(25)[l * 1024 + col]) * fexp(-tt * fexp(INF(26)[l * 1024 + col]));
            FT[(size_t)col * SEQ] = v; }
}

__device__ __forceinline__ void p1_phase(Frame& F) {
    const int gw = F.vcu * NWAVES + F.wave, NGW = F.G * NWAVES;
    const float* mod = WSP(float, WS_MOD);
    for (int m = gw; m < MTOK; m += NGW) {
        const int b = m >> 13; f32x4 x[4], h[4];
        ld_row_f32(INF(0) + (size_t)m * DM, F.lane, x);
        modnorm(x, INF(5), mod + (0 * 2 + b) * 6144 + 1024, mod + (0 * 2 + b) * 6144, F.lane, h);
        st_row_bf16(WSP(bf16_t, WS_XN) + (size_t)m * DM, F.lane, h);
    }
    for (int wt = gw; wt < 4096; wt += NGW) filt_gemm_tile(F, wt);
}

__device__ __forceinline__ float logsigmoid(float x) { return fminf(x, 0.f) - flog(1.0f + fexp(-fabsf(x))); }
struct MlItem { int b, h, dir, n, t0; };
__device__ __forceinline__ MlItem ml_decode(int item) { MlItem I; I.b = item >> 9; I.h = (item >> 7) & 3; I.dir = (item >> 6) & 1; I.n = item & 63;
    I.t0 = I.b * SEQ + (I.dir ? SEQ - 128 * (I.n + 1) : 128 * I.n); return I; }

__device__ __forceinline__ void ml_local_item(Frame& F, int item, int l) {
    const int tid = F.tid; const MlItem I = ml_decode(item);
    const bf16_t* U = WSP(bf16_t, WS_U);
    LAS float* EK = (LAS float*)(F.lds);
    LAS float* VV = (LAS float*)(F.lds + 32768);
    LAS float* LF = (LAS float*)(F.lds + 65536);
    LAS float* IG = LF + 128; LAS float* WW = LF + 256; LAS float* EST = LF + 384;
    const float* gb = INF(10) + l * 16;
    if (tid < 128) { const int j = tid, r = I.dir ? 127 - j : j; const size_t t = (size_t)(I.t0 + r);
        const float ipre = bf2f(U[t * DINP + U_MLG + (I.dir ? 2 : 0) * 4 + I.h]) + gb[(I.dir ? 2 : 0) * 4 + I.h];
        const float fpre = bf2f(U[t * DINP + U_MLG + (I.dir ? 3 : 1) * 4 + I.h]) + gb[(I.dir ? 3 : 1) * 4 + I.h];
        LF[j] = logsigmoid(fpre); IG[j] = ipre; }
    __syncthreads();
    float a = 0.f, aend = 0.f;
    if (tid < 128) { for (int i = 0; i < 128; ++i) { const float v = LF[i]; aend += v; if (i <= tid) a += v; }
        WW[tid] = aend - a + IG[tid]; }
    __syncthreads();
    float mloc = -3.0e38f;
    if (tid < 128) { for (int i = 0; i < 128; ++i) mloc = fmaxf(mloc, WW[i]);
        const int r = I.dir ? 127 - tid : tid; EST[r] = fexp(WW[tid] - mloc); }
    __syncthreads();
#pragma unroll
    for (int i = 0; i < 2; ++i) { const int p = tid + 512 * i, row = p >> 3, c8 = p & 7;
        const u32x4 kq = *(const GAS u32x4*)(U + (size_t)(I.t0 + row) * DINP + U_MLK + I.h * 64 + c8 * 8);
        const u32x4 vq = *(const GAS u32x4*)(U + (size_t)(I.t0 + row) * DINP + U_MLV + I.h * 64 + c8 * 8);
        const float es = EST[row] * 0.125f;
        LAS f32x4* ek = (LAS f32x4*)(EK + row * 64 + c8 * 8); LAS f32x4* vv = (LAS f32x4*)(VV + row * 64 + c8 * 8);
        ek[0] = (f32x4){bflo(kq.x) * es, bfhi(kq.x) * es, bflo(kq.y) * es, bfhi(kq.y) * es};
        ek[1] = (f32x4){bflo(kq.z) * es, bfhi(kq.z) * es, bflo(kq.w) * es, bfhi(kq.w) * es};
        vv[0] = (f32x4){bflo(vq.x), bfhi(vq.x), bflo(vq.y), bfhi(vq.y)};
        vv[1] = (f32x4){bflo(vq.z), bfhi(vq.z), bflo(vq.w), bfhi(vq.w)}; }
    __syncthreads();
    {
        const int d = tid >> 3, e0 = (tid & 7) * 8;
        f32x4 c0 = {0.f, 0.f, 0.f, 0.f}, c1 = {0.f, 0.f, 0.f, 0.f};
#pragma unroll 4
        for (int j = 0; j < 128; ++j) { const float ek = EK[j * 64 + d]; const f32x4 v0 = *(const LAS f32x4*)(VV + j * 64 + e0), v1 = *(const LAS f32x4*)(VV + j * 64 + e0 + 4);
            c0 += v0 * ek; c1 += v1 * ek; }
        GAS f32x4* dst = (GAS f32x4*)(WSP(float, WS_MLC) + (size_t)item * 4096 + d * 64 + e0);
        dst[0] = c0; dst[1] = c1;
        if (tid < 64) { float s = 0.f; for (int j = 0; j < 128; ++j) s += EK[j * 64 + tid]; WSP(float, WS_MLN)[item * 64 + tid] = s; }
        if (tid == 0) { WSP(float, WS_MLS)[item * 4] = mloc; WSP(float, WS_MLS)[item * 4 + 1] = aend; }
    }
    __syncthreads();
}

__device__ __forceinline__ void ml_scan(Frame& F) {
    float* MLC = WSP(float, WS_MLC); float* MLN = WSP(float, WS_MLN); float* MLS = WSP(float, WS_MLS);
    for (int idx = blockIdx.x * NTHR + F.tid; idx < 16 * 4160; idx += F.G * NTHR) {
        const int seq = idx / 4160, el = idx % 4160;
        float* p0 = el < 4096 ? (MLC + (size_t)seq * 64 * 4096 + el) : (MLN + seq * 64 * 64 + (el - 4096));
        const int pstr = el < 4096 ? 4096 : 64;
        float mst = 0.f, st = 0.f;
#pragma unroll 1
        for (int n0 = 0; n0 < 64; n0 += 16) {
            float cl[16], mlv[16], aev[16];
#pragma unroll
            for (int i = 0; i < 16; ++i) { cl[i] = p0[(size_t)(n0 + i) * pstr]; mlv[i] = MLS[(seq * 64 + n0 + i) * 4]; aev[i] = MLS[(seq * 64 + n0 + i) * 4 + 1]; }
#pragma unroll
            for (int i = 0; i < 16; ++i) { const int item = seq * 64 + n0 + i;
                p0[(size_t)(n0 + i) * pstr] = st;
                if (el == 0) MLS[item * 4 + 2] = mst;
                const float mnew = fmaxf(aev[i] + mst, mlv[i]), sp = fexp(aev[i] + mst - mnew), sl = fexp(mlv[i] - mnew);
                st = sp * st + sl * cl[i]; mst = mnew; }
        }
    }
}

#define MFMA32(a, b, c) __builtin_amdgcn_mfma_f32_32x32x16_bf16((a), (b), (c), 0, 0, 0)
template <int NK>
__device__ __forceinline__ void qkt_tile(f32x16& p0, f32x16& p1, LAS const unsigned char* Kt, const bf16x8 (&qr)[NK], int r32, int hi) {
#pragma unroll
    for (int r = 0; r < 16; ++r) { p0[r] = 0.f; p1[r] = 0.f; }
#pragma unroll
    for (int d0 = 0; d0 < NK; ++d0) {
        const bf16x8 b0 = *(const LAS bf16x8*)(Kt + (2 * d0 + hi) * 1024 + r32 * 16);
        const bf16x8 b1 = *(const LAS bf16x8*)(Kt + (2 * d0 + hi) * 1024 + r32 * 16 + 512);
        p0 = MFMA32(b0, qr[d0], p0); p1 = MFMA32(b1, qr[d0], p1);
    }
}
typedef short v4i16_t __attribute__((ext_vector_type(4)));
__device__ __forceinline__ s16x4 vtr(LAS const unsigned char* p) { return __builtin_bit_cast(s16x4, __builtin_amdgcn_ds_read_tr16_b64_v4i16((LAS v4i16_t*)p)); }
__device__ __forceinline__ void pv_tile(f32x16 (&o)[2], LAS const unsigned char* Vt, const bf16x8 (&pa)[4], int lane) {
    const int hi = lane >> 5;
    LAS const unsigned char* vb = Vt + ((lane >> 4) & 1) * 32 + (lane & 3) * 8 + (4 * hi + ((lane & 15) >> 2)) * 64;
#pragma unroll
    for (int d0 = 0; d0 < 2; ++d0)
#pragma unroll
        for (int ks = 0; ks < 4; ++ks) {
            const s16x4 lo = vtr(vb + d0 * 4096 + ks * 1024), hh = vtr(vb + d0 * 4096 + ks * 1024 + 512);
            const bf16x8 vf = (bf16x8){lo[0], lo[1], lo[2], lo[3], hh[0], hh[1], hh[2], hh[3]};
            o[d0] = MFMA32(pa[ks], vf, o[d0]);
        }
}
__device__ __forceinline__ void pack_p(const f32x16& p0, const f32x16& p1, bf16x8 (&pa)[4]) {
    u32x4 w0, w1, w2, w3;
    w0 = (u32x4){pk2(p0[0], p0[1]), pk2(p0[2], p0[3]), pk2(p0[4], p0[5]), pk2(p0[6], p0[7])};
    w1 = (u32x4){pk2(p0[8], p0[9]), pk2(p0[10], p0[11]), pk2(p0[12], p0[13]), pk2(p0[14], p0[15])};
    w2 = (u32x4){pk2(p1[0], p1[1]), pk2(p1[2], p1[3]), pk2(p1[4], p1[5]), pk2(p1[6], p1[7])};
    w3 = (u32x4){pk2(p1[8], p1[9]), pk2(p1[10], p1[11]), pk2(p1[12], p1[13]), pk2(p1[14], p1[15])};
    pa[0] = __builtin_bit_cast(bf16x8, w0); pa[1] = __builtin_bit_cast(bf16x8, w1); pa[2] = __builtin_bit_cast(bf16x8, w2); pa[3] = __builtin_bit_cast(bf16x8, w3);
}

__device__ __forceinline__ void ml_local_pair(Frame& F, int pair, int l) {
    const int tid = F.tid, lane = F.lane, wid = F.wave, half = wid >> 2, wq = wid & 3, th = tid & 255, hi = lane >> 5;
    const int item = pair * 2 + half; const MlItem I = ml_decode(item);
    const bf16_t* U = WSP(bf16_t, WS_U);
    LAS unsigned char* base = F.lds + half * 49152;
    LAS unsigned char* EKI = base;
    LAS unsigned char* VI = base + 16384;
    LAS float* LF = (LAS float*)(base + 32768); LAS float* IG = LF + 128; LAS float* WW = LF + 256; LAS float* EST = LF + 384;
    const float* gb = INF(10) + l * 16;
    if (th < 128) { const int j = th, r = I.dir ? 127 - j : j; const size_t t = (size_t)(I.t0 + r);
        const float ipre = bf2f(U[t * DINP + U_MLG + (I.dir ? 2 : 0) * 4 + I.h]) + gb[(I.dir ? 2 : 0) * 4 + I.h];
        const float fpre = bf2f(U[t * DINP + U_MLG + (I.dir ? 3 : 1) * 4 + I.h]) + gb[(I.dir ? 3 : 1) * 4 + I.h];
        LF[j] = logsigmoid(fpre); IG[j] = ipre; }
    __syncthreads();
    float a = 0.f, aend = 0.f;
    if (th < 128) { for (int i = 0; i < 128; ++i) { const float v = LF[i]; aend += v; if (i <= th) a += v; }
        WW[th] = aend - a + IG[th]; }
    __syncthreads();
    float mloc = -3.0e38f;
    if (th < 128) { for (int i = 0; i < 128; ++i) mloc = fmaxf(mloc, WW[i]);
        const int r = I.dir ? 127 - th : th; EST[r] = fexp(WW[th] - mloc) * 0.125f; }
    __syncthreads();
#pragma unroll
    for (int i = 0; i < 4; ++i) { const int p = th + 256 * i; const int tt = p >> 9, dh = (p >> 8) & 1, row = (p >> 2) & 63, c4 = p & 3, r = 64 * tt + row;
        const bf16_t* src = U + (size_t)(I.t0 + r) * DINP + I.h * 64 + dh * 32 + c4 * 8;
        const u32x4 kq = *(const GAS u32x4*)(src + U_MLK); const u32x4 vq = *(const GAS u32x4*)(src + U_MLV);
        const float es = EST[r];
        u32x4 ek; ek.x = pk2(bflo(kq.x) * es, bfhi(kq.x) * es); ek.y = pk2(bflo(kq.y) * es, bfhi(kq.y) * es); ek.z = pk2(bflo(kq.z) * es, bfhi(kq.z) * es); ek.w = pk2(bflo(kq.w) * es, bfhi(kq.w) * es);
        const int off = tt * 8192 + dh * 4096 + row * 64 + c4 * 16;
        *(LAS u32x4*)(EKI + off) = ek; *(LAS u32x4*)(VI + off) = vq; }
    __syncthreads();
    {
        const int da = wq >> 1, eb = wq & 1;
        f32x16 acc;
#pragma unroll
        for (int r = 0; r < 16; ++r) acc[r] = 0.f;
        const int lo_off = ((lane >> 4) & 1) * 32 + (lane & 3) * 8 + (4 * hi + ((lane & 15) >> 2)) * 64;
#pragma unroll
        for (int tt = 0; tt < 2; ++tt)
#pragma unroll
            for (int ks = 0; ks < 4; ++ks) {
                LAS const unsigned char* ap = EKI + tt * 8192 + da * 4096 + lo_off + ks * 1024; LAS const unsigned char* bp = VI + tt * 8192 + eb * 4096 + lo_off + ks * 1024;
                const s16x4 a0 = vtr(ap), a1 = vtr(ap + 512), b0 = vtr(bp), b1 = vtr(bp + 512);
                const bf16x8 af = (bf16x8){a0[0], a0[1], a0[2], a0[3], a1[0], a1[1], a1[2], a1[3]}, bf = (bf16x8){b0[0], b0[1], b0[2], b0[3], b1[0], b1[1], b1[2], b1[3]};
                acc = MFMA32(af, bf, acc); }
        float* dst = WSP(float, WS_MLC) + (size_t)item * 4096 + eb * 32 + (lane & 31);
#pragma unroll
        for (int r = 0; r < 16; ++r) dst[(da * 32 + crow(r, hi)) * 64] = acc[r];
        if (th < 64) { const int dh = th >> 5, col = th & 31; float sacc = 0.f;
            for (int tt = 0; tt < 2; ++tt) for (int row = 0; row < 64; ++row) sacc += bf2f(*(const LAS unsigned short*)(EKI + tt * 8192 + dh * 4096 + row * 64 + col * 2));
            WSP(float, WS_MLN)[item * 64 + th] = sacc; }
        if (th == 0) { WSP(float, WS_MLS)[item * 4] = mloc; WSP(float, WS_MLS)[item * 4 + 1] = aend; }
    }
    __syncthreads();
}

__device__ __forceinline__ void ml_out_pair(Frame& F, int pair, int l) {
    const int tid = F.tid, lane = F.lane, wid = F.wave, half = wid >> 2, wq = wid & 3, th = tid & 255, r32 = lane & 31, hi = lane >> 5;
    const int item = pair * 2 + half; const MlItem I = ml_decode(item);
    const bf16_t* U = WSP(bf16_t, WS_U);
    LAS unsigned char* base = F.lds + half * 49152;
    LAS unsigned char* KI = base;
    LAS unsigned char* VI = base + 16384;
    LAS unsigned char* CT = base + 32768;
    LAS float* vec = (LAS float*)(base + 32768 + 9216);
    LAS float* LF = vec; LAS float* IG = vec + 128; LAS float* BL = vec + 256; LAS float* SA = vec + 384; LAS float* SCI = vec + 512; LAS float* EDEN = vec + 640;
    LAS float* NPV = vec + 768; LAS float* wsf = vec + 832 + wq * 64;
    const float* gb = INF(10) + l * 16;
    if (th < 128) { const int j = th, r = I.dir ? 127 - j : j; const size_t t = (size_t)(I.t0 + r);
        const float ipre = bf2f(U[t * DINP + U_MLG + (I.dir ? 2 : 0) * 4 + I.h]) + gb[(I.dir ? 2 : 0) * 4 + I.h];
        const float fpre = bf2f(U[t * DINP + U_MLG + (I.dir ? 3 : 1) * 4 + I.h]) + gb[(I.dir ? 3 : 1) * 4 + I.h];
        LF[j] = logsigmoid(fpre); IG[j] = ipre; }
    __syncthreads();
    float a = 0.f;
    if (th < 128) { for (int i = 0; i <= th; ++i) a += LF[i]; BL[th] = IG[th] - a; }
    __syncthreads();
    if (th < 128) { float bm = -3.0e38f; for (int i = 0; i <= th; ++i) bm = fmaxf(bm, BL[i]);
        const float mprev = WSP(float, WS_MLS)[item * 4 + 2];
        const float mt = a + fmaxf(mprev, bm);
        SA[th] = (a - mt) * LOG2E; SCI[th] = fexp(a + mprev - mt); EDEN[th] = fexp(-mt); }
    __syncthreads();
    if (th < 128) BL[th] = BL[th] * LOG2E;
#pragma unroll
    for (int i = 0; i < 4; ++i) { const int p = th + 256 * i;
        { const int tt = p >> 9, c = (p >> 6) & 7, kv = p & 63, j = 64 * tt + kv, r = I.dir ? 127 - j : j;
          *(LAS u32x4*)(KI + tt * 8192 + c * 1024 + kv * 16) = *(const GAS u32x4*)(U + (size_t)(I.t0 + r) * DINP + U_MLK + I.h * 64 + c * 8); }
        { const int tt = p >> 9, dh = (p >> 8) & 1, kv = (p >> 2) & 63, c4 = p & 3, j = 64 * tt + kv, r = I.dir ? 127 - j : j;
          *(LAS u32x4*)(VI + tt * 8192 + dh * 4096 + kv * 64 + c4 * 16) = *(const GAS u32x4*)(U + (size_t)(I.t0 + r) * DINP + U_MLV + I.h * 64 + dh * 32 + c4 * 8); } }
    { const float* cp = WSP(float, WS_MLC) + (size_t)item * 4096;
#pragma unroll
      for (int i = 0; i < 16; ++i) { const int idx = th + 256 * i, d = idx >> 6, e = idx & 63;
          *(LAS unsigned short*)(CT + e * 144 + d * 2) = (unsigned short)(pk2(cp[idx], 0.f) & 0xffffu); }
      if (th < 64) NPV[th] = WSP(float, WS_MLN)[item * 64 + th]; }
    __syncthreads();
    {
        const int q = 32 * wq + r32;
        const int rq = I.dir ? 127 - q : q;
        bf16x8 qr[4];
        const bf16_t* qp = U + (size_t)(I.t0 + rq) * DINP + U_MLQ + I.h * 64 + hi * 8;
#pragma unroll
        for (int d0 = 0; d0 < 4; ++d0) qr[d0] = *(const GAS bf16x8*)(qp + d0 * 16);
        f32x16 o[2];
#pragma unroll
        for (int r = 0; r < 16; ++r) { o[0][r] = 0.f; o[1][r] = 0.f; }
        const float saq = SA[q], scq = SCI[q];
        float den = 0.f;
        for (int tt = 0; tt < 2; ++tt) {
            if (64 * tt > 32 * wq + 31) break;
            f32x16 p0, p1;
            qkt_tile<4>(p0, p1, KI + tt * 8192, qr, r32, hi);
#pragma unroll
            for (int g = 0; g < 4; ++g) {
                const f32x4 b0 = *(const LAS f32x4*)(BL + 64 * tt + 8 * g + 4 * hi), b1 = *(const LAS f32x4*)(BL + 64 * tt + 32 + 8 * g + 4 * hi);
#pragma unroll
                for (int i = 0; i < 4; ++i) { const int r = 4 * g + i; const int kv0 = 64 * tt + 8 * g + 4 * hi + i, kv1 = kv0 + 32;
                    const float e0 = (kv0 <= q) ? __builtin_amdgcn_exp2f(saq + b0[i]) * 0.125f : 0.f, e1 = (kv1 <= q) ? __builtin_amdgcn_exp2f(saq + b1[i]) * 0.125f : 0.f;
                    p0[r] *= e0; p1[r] *= e1; den += p0[r] + p1[r]; }
            }
            bf16x8 pa[4]; pack_p(p0, p1, pa);
            pv_tile(o, VI + tt * 8192, pa, lane);
        }
        float dot = 0.f;
#pragma unroll
        for (int ks = 0; ks < 4; ++ks) {
            const u32x4 qw = __builtin_bit_cast(u32x4, qr[ks]);
            const f32x4 n0 = *(const LAS f32x4*)(NPV + 16 * ks + 8 * hi), n1 = *(const LAS f32x4*)(NPV + 16 * ks + 8 * hi + 4);
            const float q0 = bflo(qw.x), q1 = bfhi(qw.x), q2 = bflo(qw.y), q3 = bfhi(qw.y), q4 = bflo(qw.z), q5 = bfhi(qw.z), q6 = bflo(qw.w), q7 = bfhi(qw.w);
            dot += q0 * n0[0] + q1 * n0[1] + q2 * n0[2] + q3 * n0[3] + q4 * n1[0] + q5 * n1[1] + q6 * n1[2] + q7 * n1[3];
            const u32x4 sw = (u32x4){pk2(q0 * scq, q1 * scq), pk2(q2 * scq, q3 * scq), pk2(q4 * scq, q5 * scq), pk2(q6 * scq, q7 * scq)};
            const bf16x8 qs = __builtin_bit_cast(bf16x8, sw);
#pragma unroll
            for (int de = 0; de < 2; ++de) {
                const bf16x8 cf = *(const LAS bf16x8*)(CT + (de * 32 + r32) * 144 + (16 * ks + 8 * hi) * 2);
                o[de] = MFMA32(qs, cf, o[de]);
            }
        }
        den += scq * dot;
        den += __shfl_xor(den, 32);
        const float rinv = 1.0f / fmaxf(fabsf(den), EDEN[q]);
        if (hi == 0) wsf[r32] = rinv;
        LDS_WAIT();
        float* dst = WSP(float, I.dir ? WS_HB : WS_HF);
#pragma unroll
        for (int r = 0; r < 16; ++r) { const int jq = 32 * wq + crow(r, hi), row = I.dir ? 127 - jq : jq; const float rr = wsf[crow(r, hi)];
            float* dp = dst + (size_t)(I.t0 + row) * 256 + I.h * 64 + r32;
            dp[0] = o[0][r] * rr; dp[32] = o[1][r] * rr; }
    }
    __syncthreads();
}

__device__ __forceinline__ void mla_prep_rows(Frame& F, int l) {
    const int gw = F.vcu * NWAVES + F.wave, NGW = F.G * NWAVES, lane = F.lane;
    const bf16_t* U = WSP(bf16_t, WS_U); bf16_t* A = WSP(bf16_t, WS_AMLA);
    const float* qn = INF(11) + l * 224; const float* kn = INF(12) + l * 128;
    for (int m = gw; m < MTOK; m += NGW) {
        const bf16_t* ur = U + (size_t)m * DINP;
        float q0 = 0.f, q1 = 0.f, q2 = 0.f, q3 = 0.f;
        if (lane < 56) { const u32x2 w = *(const GAS u32x2*)(ur + U_CQ + 4 * lane); q0 = bflo(w.x); q1 = bfhi(w.x); q2 = bflo(w.y); q3 = bfhi(w.y); }
        const unsigned kw = *(const GAS unsigned*)(ur + U_CKV + 2 * lane); const float k0 = bflo(kw), k1 = bfhi(kw);
        const float rq = __builtin_amdgcn_rsqf(wave_sum(q0 * q0 + q1 * q1 + q2 * q2 + q3 * q3) * (1.0f / 224.0f) + EPS);
        const float rk = __builtin_amdgcn_rsqf(wave_sum(k0 * k0 + k1 * k1) * (1.0f / 128.0f) + EPS);
        bf16_t* ar = A + (size_t)m * 384;
        u32x2 qo = {0u, 0u};
        if (lane < 56) { const f32x4 g = *(const GAS f32x4*)(qn + 4 * lane); qo.x = pk2(q0 * rq * g.x, q1 * rq * g.y); qo.y = pk2(q2 * rq * g.z, q3 * rq * g.w); }
        *(GAS u32x2*)(ar + 4 * lane) = qo;
        const f32x2 g2 = *(const GAS f32x2*)(kn + 2 * lane);
        *(GAS unsigned*)(ar + 256 + 2 * lane) = pk2(k0 * rk * g2.x, k1 * rk * g2.y);
    }
}

__device__ __forceinline__ double rope_k(int i) {
    switch (i) { case 0: return 0.15915494309189535; case 1: return 0.08949940160889101; case 2: return 0.050329212104487035; case 3: return 0.0283021958306234;
        case 4: return 0.015915494309189534; case 5: return 0.008949940160889102; case 6: return 0.005032921210448704; case 7: return 0.00283021958306234;
        case 8: return 0.0015915494309189536; case 9: return 0.0008949940160889102; case 10: return 0.0005032921210448703; case 11: return 0.00028302195830623395;
        case 12: return 0.00015915494309189535; case 13: return 8.949940160889102e-05; case 14: return 5.0329212104487035e-05; default: return 2.8302195830623396e-05; }
}
__device__ __forceinline__ void rope_cs(int pos, int i, float& c, float& s) {
    double rev = (double)pos * rope_k(i);
    rev -= __builtin_floor(rev);
    const float r = (float)rev;
    c = cos_rev(r); s = sin_rev(r);
}
__device__ __forceinline__ void relayout_phase(Frame& F) {
    const bf16_t* O = WSP(bf16_t, WS_OMLA); const bf16_t* U = WSP(bf16_t, WS_U);
    const int* pos = (const int*)F.a->in[2];
    const float qscale = 0.10206207261596577f * LOG2E;
    for (int idx = blockIdx.x * NTHR + F.tid; idx < MTOK * 4; idx += F.G * NTHR) {
        const int t = idx >> 2, h = idx & 3, b = t >> 13, s = t & 8191, bh = b * 4 + h;
        const int p = pos[t];
        float cs[16], sn[16];
#pragma unroll
        for (int i = 0; i < 16; ++i) rope_cs(p, i, cs[i], sn[i]);
        const bf16_t* qsrc = O + (size_t)t * 1024 + h * 96;
        bf16_t* qdst = WSP(bf16_t, WS_Q) + ((size_t)bh * SEQ + s) * 96;
#pragma unroll
        for (int c = 0; c < 8; ++c) { const u32x4 w = *(const GAS u32x4*)(qsrc + c * 8);
            u32x4 o; o.x = pk2(bflo(w.x) * qscale, bfhi(w.x) * qscale); o.y = pk2(bflo(w.y) * qscale, bfhi(w.y) * qscale); o.z = pk2(bflo(w.z) * qscale, bfhi(w.z) * qscale); o.w = pk2(bflo(w.w) * qscale, bfhi(w.w) * qscale);
            *(GAS u32x4*)(qdst + c * 8) = o; }
        {
            float x1[16], x2[16];
#pragma unroll
            for (int c = 0; c < 2; ++c) { const u32x4 w = *(const GAS u32x4*)(qsrc + 64 + c * 8); const u32x4 v = *(const GAS u32x4*)(qsrc + 80 + c * 8);
                x1[c * 8 + 0] = bflo(w.x); x1[c * 8 + 1] = bfhi(w.x); x1[c * 8 + 2] = bflo(w.y); x1[c * 8 + 3] = bfhi(w.y); x1[c * 8 + 4] = bflo(w.z); x1[c * 8 + 5] = bfhi(w.z); x1[c * 8 + 6] = bflo(w.w); x1[c * 8 + 7] = bfhi(w.w);
                x2[c * 8 + 0] = bflo(v.x); x2[c * 8 + 1] = bfhi(v.x); x2[c * 8 + 2] = bflo(v.y); x2[c * 8 + 3] = bfhi(v.y); x2[c * 8 + 4] = bflo(v.z); x2[c * 8 + 5] = bfhi(v.z); x2[c * 8 + 6] = bflo(v.w); x2[c * 8 + 7] = bfhi(v.w); }
#pragma unroll
            for (int c = 0; c < 2; ++c) { u32x4 o1, o2;
#define RQ1(i) ((x1[i] * cs[i] - x2[i] * sn[i]) * qscale)
#define RQ2(i) ((x2[i] * cs[i] + x1[i] * sn[i]) * qscale)
                o1.x = pk2(RQ1(c * 8 + 0), RQ1(c * 8 + 1)); o1.y = pk2(RQ1(c * 8 + 2), RQ1(c * 8 + 3)); o1.z = pk2(RQ1(c * 8 + 4), RQ1(c * 8 + 5)); o1.w = pk2(RQ1(c * 8 + 6), RQ1(c * 8 + 7));
                o2.x = pk2(RQ2(c * 8 + 0), RQ2(c * 8 + 1)); o2.y = pk2(RQ2(c * 8 + 2), RQ2(c * 8 + 3)); o2.z = pk2(RQ2(c * 8 + 4), RQ2(c * 8 + 5)); o2.w = pk2(RQ2(c * 8 + 6), RQ2(c * 8 + 7));
                *(GAS u32x4*)(qdst + 64 + c * 8) = o1; *(GAS u32x4*)(qdst + 80 + c * 8) = o2; }
#undef RQ1
#undef RQ2
        }
        bf16_t* kdst = WSP(bf16_t, WS_KIMG) + ((size_t)bh * 128 + (s >> 6)) * 6144 + (s & 63) * 8;
        const bf16_t* ksrc = O + (size_t)t * 1024 + 384 + h * 64;
#pragma unroll
        for (int c = 0; c < 8; ++c) *(GAS u32x4*)(kdst + c * 512) = *(const GAS u32x4*)(ksrc + c * 8);
        {
            const bf16_t* krs = U + (size_t)t * DINP + U_KR;
            float x1[16], x2[16];
#pragma unroll
            for (int c = 0; c < 2; ++c) { const u32x4 w = *(const GAS u32x4*)(krs + c * 8); const u32x4 v = *(const GAS u32x4*)(krs + 16 + c * 8);
                x1[c * 8 + 0] = bflo(w.x); x1[c * 8 + 1] = bfhi(w.x); x1[c * 8 + 2] = bflo(w.y); x1[c * 8 + 3] = bfhi(w.y); x1[c * 8 + 4] = bflo(w.z); x1[c * 8 + 5] = bfhi(w.z); x1[c * 8 + 6] = bflo(w.w); x1[c * 8 + 7] = bfhi(w.w);
                x2[c * 8 + 0] = bflo(v.x); x2[c * 8 + 1] = bfhi(v.x); x2[c * 8 + 2] = bflo(v.y); x2[c * 8 + 3] = bfhi(v.y); x2[c * 8 + 4] = bflo(v.z); x2[c * 8 + 5] = bfhi(v.z); x2[c * 8 + 6] = bflo(v.w); x2[c * 8 + 7] = bfhi(v.w); }
#pragma unroll
            for (int c = 0; c < 2; ++c) { u32x4 o1, o2;
#define RK1(i) (x1[i] * cs[i] - x2[i] * sn[i])
#define RK2(i) (x2[i] * cs[i] + x1[i] * sn[i])
                o1.x = pk2(RK1(c * 8 + 0), RK1(c * 8 + 1)); o1.y = pk2(RK1(c * 8 + 2), RK1(c * 8 + 3)); o1.z = pk2(RK1(c * 8 + 4), RK1(c * 8 + 5)); o1.w = pk2(RK1(c * 8 + 6), RK1(c * 8 + 7));
                o2.x = pk2(RK2(c * 8 + 0), RK2(c * 8 + 1)); o2.y = pk2(RK2(c * 8 + 2), RK2(c * 8 + 3)); o2.z = pk2(RK2(c * 8 + 4), RK2(c * 8 + 5)); o2.w = pk2(RK2(c * 8 + 6), RK2(c * 8 + 7));
                *(GAS u32x4*)(kdst + (8 + c) * 512) = o1; *(GAS u32x4*)(kdst + (10 + c) * 512) = o2; }
#undef RK1
#undef RK2
        }
        bf16_t* vdst = WSP(bf16_t, WS_VIMG) + ((size_t)bh * 128 + (s >> 6)) * 4096 + (s & 63) * 32;
        const bf16_t* vsrc = O + (size_t)t * 1024 + 640 + h * 64;
#pragma unroll
        for (int c = 0; c < 8; ++c) *(GAS u32x4*)(vdst + (c >> 2) * 2048 + (c & 3) * 8) = *(const GAS u32x4*)(vsrc + c * 8);
    }
}

__device__ __forceinline__ void attn_unit(Frame& F, int bh, int qb) {
    const int tid = F.tid, lane = F.lane, wid = F.wave, r32 = lane & 31, hi = lane >> 5;
    LAS unsigned char* KB = F.lds;
    LAS unsigned char* VB = F.lds + 24576;
    LAS float* wsf = (LAS float*)(F.lds + 40960) + wid * 64;
    const int b = bh >> 2, h = bh & 3;
    const bf16_t* Qp = WSP(bf16_t, WS_Q) + ((size_t)bh * SEQ + qb * 256 + wid * 32 + r32) * 96 + hi * 8;
    bf16x8 qr[6];
#pragma unroll
    for (int d0 = 0; d0 < 6; ++d0) qr[d0] = *(const GAS bf16x8*)(Qp + d0 * 16);
    const GAS u32x4* Kg = (const GAS u32x4*)(WSP(bf16_t, WS_KIMG) + (size_t)bh * 128 * 6144);
    const GAS u32x4* Vg = (const GAS u32x4*)(WSP(bf16_t, WS_VIMG) + (size_t)bh * 128 * 4096);
    const bool kx = tid < 256;
    u32x4 k0 = Kg[tid], k1 = kx ? Kg[512 + tid] : (u32x4){0u, 0u, 0u, 0u}, v0 = Vg[tid];
    u32x4 k2 = Kg[768 + tid], k3 = kx ? Kg[768 + 512 + tid] : (u32x4){0u, 0u, 0u, 0u};
    *(LAS u32x4*)(KB + tid * 16) = k0; if (kx) *(LAS u32x4*)(KB + (512 + tid) * 16) = k1; *(LAS u32x4*)(VB + tid * 16) = v0;
    *(LAS u32x4*)(KB + 12288 + tid * 16) = k2; if (kx) *(LAS u32x4*)(KB + 12288 + (512 + tid) * 16) = k3;
    __syncthreads();
    f32x16 s0, s1;
    qkt_tile<6>(s0, s1, KB, qr, r32, hi);
    __syncthreads();
    f32x16 o[2]; float lsum = 0.f;
#pragma unroll
    for (int r = 0; r < 16; ++r) { o[0][r] = 0.f; o[1][r] = 0.f; }
    float m;
    { float rm = fmaxf(fmaxf(s0[0], s1[0]), fmaxf(s0[1], s1[1]));
#pragma unroll
      for (int r = 2; r < 16; r += 2) rm = fmaxf(fmaxf(rm, s0[r]), fmaxf(s1[r], fmaxf(s0[r + 1], s1[r + 1])));
      m = fmaxf(rm, __shfl_xor(rm, 32));
#pragma unroll
      for (int r = 0; r < 16; ++r) { s0[r] -= m; s1[r] -= m; } }
    LAS const unsigned char* vbl = VB + ((lane >> 4) & 1) * 32 + (lane & 3) * 8 + (4 * hi + ((lane & 15) >> 2)) * 64;
    u32x4 kb0 = Kg[2 * 768 + tid], kb1 = kx ? Kg[2 * 768 + 512 + tid] : (u32x4){0u, 0u, 0u, 0u}, vb0 = Vg[512 + tid];
#define ATT_ITER(T, LK0, LK1, LV, WK0, WK1, WV) do { \
        const int t = (T); const int cur = t & 1; \
        const int tv = (t + 2 < 128) ? t + 2 : 127, tk = (t + 3 < 128) ? t + 3 : 127; \
        LK0 = Kg[tk * 768 + tid]; if (kx) LK1 = Kg[tk * 768 + 512 + tid]; \
        LV = Vg[tv * 512 + tid]; \
        LAS const unsigned char* Kt = KB + (cur ^ 1) * 12288 + hi * 1024 + r32 * 16; \
        bf16x8 kf[12]; \
        _Pragma("unroll") for (int d0 = 0; d0 < 6; ++d0) { kf[2 * d0] = *(const LAS bf16x8*)(Kt + d0 * 2048); kf[2 * d0 + 1] = *(const LAS bf16x8*)(Kt + d0 * 2048 + 512); } \
        _Pragma("unroll") for (int r = 0; r < 16; ++r) { s0[r] = __builtin_amdgcn_exp2f(s0[r]); s1[r] = __builtin_amdgcn_exp2f(s1[r]); } \
        { float ls_ = 0.f; _Pragma("unroll") for (int r = 0; r < 16; ++r) ls_ += s0[r] + s1[r]; lsum += ls_; } \
        bf16x8 pa[4]; pack_p(s0, s1, pa); \
        f32x16 n0, n1; { const float nm_ = -m; _Pragma("unroll") for (int r = 0; r < 16; ++r) { n0[r] = nm_; n1[r] = nm_; } } \
        n0 = MFMA32(kf[0], qr[0], n0); n1 = MFMA32(kf[1], qr[0], n1); \
        _Pragma("unroll") for (int d0 = 1; d0 < 6; ++d0) { n0 = MFMA32(kf[2 * d0], qr[d0], n0); n1 = MFMA32(kf[2 * d0 + 1], qr[d0], n1); } \
        LAS const unsigned char* vb = vbl + cur * 8192; \
        _Pragma("unroll") for (int ks = 0; ks < 4; ++ks) { \
            _Pragma("unroll") for (int d0 = 0; d0 < 2; ++d0) { \
                const s16x4 lo = vtr(vb + d0 * 4096 + ks * 1024), hh = vtr(vb + d0 * 4096 + ks * 1024 + 512); \
                const bf16x8 vf = (bf16x8){lo[0], lo[1], lo[2], lo[3], hh[0], hh[1], hh[2], hh[3]}; \
                o[d0] = MFMA32(pa[ks], vf, o[d0]); } } \
        float rm = fmaxf(fmaxf(n0[0], n1[0]), fmaxf(n0[1], n1[1])); \
        _Pragma("unroll") for (int r = 2; r < 16; r += 2) rm = fmaxf(fmaxf(rm, n0[r]), fmaxf(n1[r], fmaxf(n0[r + 1], n1[r + 1]))); \
        rm = fmaxf(rm, __shfl_xor(rm, 32)); \
        _Pragma("unroll") for (int i = 0; i < 12; ++i) { __builtin_amdgcn_sched_group_barrier(0x008, 1, 0); __builtin_amdgcn_sched_group_barrier(0x002, 7, 0); } \
        if (__any(rm > 8.0f)) { \
            const float dl = fmaxf(rm, 0.f), f = __builtin_amdgcn_exp2f(-dl); \
            m += dl; lsum *= f; \
            _Pragma("unroll") for (int r = 0; r < 16; ++r) { n0[r] -= dl; n1[r] -= dl; } \
            if (hi == 0) wsf[r32] = f; \
            LDS_WAIT(); \
            _Pragma("unroll") for (int r = 0; r < 16; ++r) { const float fr = wsf[crow(r, hi)]; o[0][r] *= fr; o[1][r] *= fr; } \
        } \
        *(LAS u32x4*)(KB + cur * 12288 + tid * 16) = WK0; if (kx) *(LAS u32x4*)(KB + cur * 12288 + (512 + tid) * 16) = WK1; \
        *(LAS u32x4*)(VB + (cur ^ 1) * 8192 + tid * 16) = WV; \
        __syncthreads(); \
        s0 = n0; s1 = n1; } while (0)
#pragma unroll 1
    for (int t2 = 0; t2 < 128; t2 += 2) {
        ATT_ITER(t2, k0, k1, v0, kb0, kb1, vb0);
        ATT_ITER(t2 + 1, kb0, kb1, vb0, k0, k1, v0);
    }
#undef ATT_ITER
    lsum += __shfl_xor(lsum, 32);
    if (hi == 0) wsf[r32] = 1.0f / lsum;
    LDS_WAIT();
    bf16_t* Y = WSP(bf16_t, WS_YATT);
#pragma unroll
    for (int r = 0; r < 16; ++r) { const float rl = wsf[crow(r, hi)]; const int q = qb * 256 + wid * 32 + crow(r, hi);
        bf16_t* yp = Y + ((size_t)b * SEQ + q) * 256 + h * 64 + r32;
        yp[0] = (bf16_t)(pk2(o[0][r] * rl, 0.f) & 0xffffu); yp[32] = (bf16_t)(pk2(o[1][r] * rl, 0.f) & 0xffffu); }
    __syncthreads();
}

#define PX(e) ((e) + ((e) >> 5))
__device__ __forceinline__ f32x2 cmul(f32x2 a, float c, float s) { return (f32x2){a.x * c - a.y * s, a.x * s + a.y * c}; }
__device__ __forceinline__ void bf4_fwd(f32x2& x0, f32x2& x1, f32x2& x2, f32x2& x3, float c1, float s1) {
    const float c2 = c1 * c1 - s1 * s1, s2 = 2.0f * c1 * s1, c3 = c2 * c1 - s2 * s1, s3 = c2 * s1 + s2 * c1;
    const f32x2 a = x0 + x2, b = x0 - x2, c = x1 + x3, d = x1 - x3;
    x0 = a + c;
    x1 = cmul((f32x2){b.x + d.y, b.y - d.x}, c1, s1);
    x2 = cmul(a - c, c2, s2);
    x3 = cmul((f32x2){b.x - d.y, b.y + d.x}, c3, s3);
}
__device__ __forceinline__ void bf4_inv(f32x2& x0, f32x2& x1, f32x2& x2, f32x2& x3, float c1, float s1) {
    const float c2 = c1 * c1 - s1 * s1, s2 = 2.0f * c1 * s1, c3 = c2 * c1 - s2 * s1, s3 = c2 * s1 + s2 * c1;
    const f32x2 t1 = cmul(x1, c1, s1), t2 = cmul(x2, c2, s2), t3 = cmul(x3, c3, s3);
    const f32x2 a = x0 + t2, b = x0 - t2, c = t1 + t3, d = t1 - t3;
    x0 = a + c; x2 = a - c;
    x1 = (f32x2){b.x - d.y, b.y + d.x};
    x3 = (f32x2){b.x + d.y, b.y - d.x};
}
template <bool INV>
__device__ __forceinline__ void fft_r4_last(LAS f32x2* X, int tid) {
#pragma unroll 2
    for (int i = 0; i < 8; ++i) { int base = 4 * (tid + 512 * i); asm volatile("" : "+v"(base));
        f32x2 x0 = X[PX(base)], x1 = X[PX(base + 1)], x2 = X[PX(base + 2)], x3 = X[PX(base + 3)];
        if (!INV) bf4_fwd(x0, x1, x2, x3, 1.0f, 0.0f); else bf4_inv(x0, x1, x2, x3, 1.0f, 0.0f);
        X[PX(base)] = x0; X[PX(base + 1)] = x1; X[PX(base + 2)] = x2; X[PX(base + 3)] = x3; }
    __syncthreads();
}
template <bool INV>
__device__ __forceinline__ void fft_r16_pass(LAS f32x2* X, int tid, int lq) {
    const int qp = 1 << lq;
    const float r16 = 1.0f / (float)(16 * qp), r4 = 1.0f / (float)(4 * qp);
    int nrep = 2; asm volatile("" : "+s"(nrep));
#pragma unroll 1
    for (int i = 0; i < nrep; ++i) {
        int u = tid + 512 * i; asm volatile("" : "+v"(u)); const int j = u & (qp - 1), base = ((u >> lq) << (lq + 4)) + j;
        f32x2 x[16];
#pragma unroll
        for (int r = 0; r < 16; ++r) x[r] = X[PX(base + (r << lq))];
        const float angB = (float)j * r4;
        if (!INV) {
#pragma unroll
            for (int r = 0; r < 4; ++r) { const float ang = (float)(j + (r << lq)) * r16; bf4_fwd(x[r], x[r + 4], x[r + 8], x[r + 12], cos_rev(ang), -sin_rev(ang)); }
            const float cb = cos_rev(angB), sb = -sin_rev(angB);
#pragma unroll
            for (int k = 0; k < 4; ++k) bf4_fwd(x[4 * k], x[4 * k + 1], x[4 * k + 2], x[4 * k + 3], cb, sb);
        } else {
            const float cb = cos_rev(angB), sb = sin_rev(angB);
#pragma unroll
            for (int k = 0; k < 4; ++k) bf4_inv(x[4 * k], x[4 * k + 1], x[4 * k + 2], x[4 * k + 3], cb, sb);
#pragma unroll
            for (int r = 0; r < 4; ++r) { const float ang = (float)(j + (r << lq)) * r16; bf4_inv(x[r], x[r + 4], x[r + 8], x[r + 12], cos_rev(ang), sin_rev(ang)); }
        }
#pragma unroll
        for (int r = 0; r < 16; ++r) X[PX(base + (r << lq))] = x[r];
    }
    __syncthreads();
}
template <bool INV>
__device__ __forceinline__ void fft16k(LAS f32x2* X, int tid) {
    if (!INV) { fft_r16_pass<false>(X, tid, 10); fft_r16_pass<false>(X, tid, 6); fft_r16_pass<false>(X, tid, 2); fft_r4_last<false>(X, tid); }
    else { fft_r4_last<true>(X, tid); fft_r16_pass<true>(X, tid, 2); fft_r16_pass<true>(X, tid, 6); fft_r16_pass<true>(X, tid, 10); }
}
__device__ __forceinline__ int drev4(int x) { unsigned y = __builtin_bitreverse32((unsigned)x) >> 18; return (int)(((y & 0x2AAAu) >> 1) | ((y & 0x1555u) << 1)); }
__device__ __forceinline__ float block_sum(Frame& F, float v, LAS float* red) {
    v = wave_sum(v);
    if (F.lane == 0) red[F.wave] = v;
    __syncthreads();
    float s = 0.f;
#pragma unroll
    for (int w = 0; w < NWAVES; ++w) s += red[w];
    __syncthreads();
    return s;
}
__device__ __forceinline__ void hyena_item(Frame& F, int c_in, int l) {
    int c = c_in; asm volatile("" : "+s"(c));
    const int tid = F.tid;
    LAS f32x2* X = (LAS f32x2*)F.lds;
    LAS float* red = (LAS float*)(F.lds + XTRA_OFF);
    f32x2* KF = WSP(f32x2, WS_KF) + (size_t)c * 2 * 16384;
    {
        const float* F0f = WSP(float, WS_FILT) + ((size_t)l * 1024 + c) * SEQ; const float* F0b = F0f + (size_t)256 * SEQ;
        const float* F1f = F0f + (size_t)512 * SEQ; const float* F1b = F0f + (size_t)768 * SEQ;
        float s0 = 0.f, s1 = 0.f;
#pragma unroll 1
        for (int i0 = 0; i0 < 16; i0 += 8) { float a0[8], b0[8], a1[8], b1[8];
#pragma unroll
            for (int i = 0; i < 8; ++i) { int t = tid + 512 * (i0 + i); asm volatile("" : "+v"(t)); a0[i] = F0f[t]; b0[i] = F0b[t]; a1[i] = F1f[t]; b1[i] = F1b[t]; }
#pragma unroll
            for (int i = 0; i < 8; ++i) { const int t = tid + 512 * (i0 + i); s0 += fabsf(a0[i]) + fabsf(b0[i]); s1 += fabsf(a1[i]) + fabsf(b1[i]);
                X[PX(t)] = (f32x2){a0[i], a1[i]}; X[PX(16383 - t)] = (f32x2){b0[i], b1[i]}; } }
        const float inv0 = 0.5f / block_sum(F, s0, red), inv1 = 0.5f / block_sum(F, s1, red);
        fft16k<false>(X, tid);
#pragma unroll 2
        for (int i = 0; i < 32; ++i) { int p = tid + 512 * i; asm volatile("" : "+v"(p)); const int f = drev4(p), pp = drev4((16384 - f) & 16383);
            const f32x2 w = X[PX(p)], wp = X[PX(pp)];
            KF[p] = (f32x2){(w.x + wp.x) * inv0, (w.y - wp.y) * inv0};
            KF[16384 + p] = (f32x2){(w.y + wp.y) * inv1, (wp.x - w.x) * inv1}; }
        __syncthreads();
    }
    const float* HT0 = WSP(float, WS_HYT);
    const float hb0 = INF(27)[l * 512 + c], hb1 = INF(27)[l * 512 + 256 + c];
    float zz[16][2];
    { const float* z0p = HT0 + (size_t)(0 * 768 + 512 + c) * SEQ; const float* z1p = HT0 + (size_t)(1 * 768 + 512 + c) * SEQ;
#pragma unroll
      for (int i = 0; i < 16; ++i) { zz[i][0] = z0p[tid + 512 * i]; zz[i][1] = z1p[tid + 512 * i]; }
#pragma unroll
      for (int i = 0; i < 16; ++i) { int t = tid + 512 * i; asm volatile("" : "+v"(t)); X[PX(t)] = (f32x2){zz[i][0], zz[i][1]}; X[PX(8192 + t)] = (f32x2){0.f, 0.f}; } }
    __syncthreads();
    const float invn = 1.0f / 16384.0f;
#pragma unroll 1
    for (int o = 0; o < 2; ++o) {
        fft16k<false>(X, tid);
        { const f32x2* kp = KF + o * 16384;
#pragma unroll 1
          for (int i0 = 0; i0 < 32; i0 += 8) { f32x2 kv[8];
#pragma unroll
              for (int i = 0; i < 8; ++i) kv[i] = kp[tid + 512 * (i0 + i)];
#pragma unroll
              for (int i = 0; i < 8; ++i) { int p = tid + 512 * (i0 + i); asm volatile("" : "+v"(p)); const f32x2 v = X[PX(p)]; X[PX(p)] = (f32x2){v.x * kv[i].x - v.y * kv[i].y, v.x * kv[i].y + v.y * kv[i].x}; } } }
        __syncthreads();
        fft16k<true>(X, tid);
        float ga[16], gb[16];
        { const float* g0p = HT0 + (size_t)(0 * 768 + o * 256 + c) * SEQ; const float* g1p = HT0 + (size_t)(1 * 768 + o * 256 + c) * SEQ;
#pragma unroll
          for (int i = 0; i < 16; ++i) { ga[i] = g0p[tid + 512 * i]; gb[i] = g1p[tid + 512 * i]; } }
        const float hbo = o ? hb1 : hb0;
        if (o == 0) {
#pragma unroll
            for (int i = 0; i < 16; ++i) { int t = tid + 512 * i; asm volatile("" : "+v"(t)); const f32x2 y = X[PX(t)];
                zz[i][0] = ga[i] * (y.x * invn + zz[i][0] * hbo); zz[i][1] = gb[i] * (y.y * invn + zz[i][1] * hbo);
                X[PX(t)] = (f32x2){zz[i][0], zz[i][1]}; X[PX(8192 + t)] = (f32x2){0.f, 0.f}; }
            __syncthreads();
        } else {
            bf16_t* Y0 = WSP(bf16_t, WS_YHT) + (size_t)(0 * 256 + c) * SEQ; bf16_t* Y1 = WSP(bf16_t, WS_YHT) + (size_t)(1 * 256 + c) * SEQ;
#pragma unroll
            for (int i = 0; i < 16; ++i) { int t = tid + 512 * i; asm volatile("" : "+v"(t)); const f32x2 y = X[PX(t)];
                const float r0 = ga[i] * (y.x * invn + zz[i][0] * hbo), r1 = gb[i] * (y.y * invn + zz[i][1] * hbo);
                Y0[t] = (bf16_t)(pk2(r0, 0.f) & 0xffffu); Y1[t] = (bf16_t)(pk2(r1, 0.f) & 0xffffu); }
            __syncthreads();
        }
    }
}

__device__ __forceinline__ void hy_prep_tile(Frame& F, int tile, int l) {
    const int tid = F.tid, lane = F.lane, wave = F.wave;
    const int b = tile >> 7, t0 = (tile & 127) * 64;
    constexpr int RS = 1552;
    const bf16_t* U = WSP(bf16_t, WS_U);
#pragma unroll 1
    for (int i = 0; i < 13; ++i) { const int idx = tid + 512 * i; const int row = idx / 96, pc = idx % 96;
        if (row < 66) { const int tok = t0 - 1 + row; u32x4 v = {0u, 0u, 0u, 0u};
            if (tok >= 0 && tok < SEQ) v = *(const GAS u32x4*)(U + ((size_t)b * SEQ + tok) * DINP + U_HY + pc * 8);
            *(LAS u32x4*)(F.lds + row * RS + pc * 16) = v; } }
    __syncthreads();
    const float* cw = INF(16) + (size_t)l * 768 * 3; const float* cb = INF(17) + l * 768;
    float* HT = WSP(float, WS_HYT);
#pragma unroll 2
    for (int cp = wave; cp < 384; cp += 8) { const int ch = 2 * cp;
        const float w00 = cw[ch * 3], w01 = cw[ch * 3 + 1], w02 = cw[ch * 3 + 2], w10 = cw[ch * 3 + 3], w11 = cw[ch * 3 + 4], w12 = cw[ch * 3 + 5], b0 = cb[ch], b1 = cb[ch + 1];
        const unsigned r0 = *(const LAS unsigned*)(F.lds + lane * RS + cp * 4), r1 = *(const LAS unsigned*)(F.lds + (lane + 1) * RS + cp * 4), r2 = *(const LAS unsigned*)(F.lds + (lane + 2) * RS + cp * 4);
        HT[((size_t)(b * 768 + ch)) * SEQ + t0 + lane] = w00 * bflo(r0) + w01 * bflo(r1) + w02 * bflo(r2) + b0;
        HT[((size_t)(b * 768 + ch + 1)) * SEQ + t0 + lane] = w10 * bfhi(r0) + w11 * bfhi(r1) + w12 * bfhi(r2) + b1; }
    __syncthreads();
}

__device__ __forceinline__ void headnorm_phase(Frame& F, int l) {
    const int lane = F.lane, tid = F.tid, wave = F.wave;
    const bf16_t* U = WSP(bf16_t, WS_U); const bf16_t* YA = WSP(bf16_t, WS_YATT); const bf16_t* YH = WSP(bf16_t, WS_YHT);
    constexpr int RS2 = 528;
    const int g = wave >> 1, sub = wave & 1, cg = 4 * lane, ch = g * 256 + cg;
    const f32x4 og = *(const GAS f32x4*)(INF(29) + l * 1024 + ch);
    float scw[12];
#pragma unroll
    for (int j = 0; j < 12; ++j) scw[j] = INF(28)[(size_t)l * 768 + cg * 3 + j];
    for (int tile = F.vcu; tile < 256; tile += F.G) {
      const int tb = tile >> 7, t0 = (tile & 127) * 64;
#pragma unroll
      for (int i = 0; i < 4; ++i) { const int idx = tid + 512 * i, c = idx >> 3, p8 = idx & 7;
          const u32x4 v = *(const GAS u32x4*)(YH + ((size_t)(tb * 256 + c)) * SEQ + t0 + p8 * 8);
          LAS unsigned char* hp = F.lds + (8 * p8) * RS2 + 2 * c;
          *(LAS unsigned short*)(hp + 0 * RS2) = (unsigned short)(v.x & 0xffffu); *(LAS unsigned short*)(hp + 1 * RS2) = (unsigned short)(v.x >> 16);
          *(LAS unsigned short*)(hp + 2 * RS2) = (unsigned short)(v.y & 0xffffu); *(LAS unsigned short*)(hp + 3 * RS2) = (unsigned short)(v.y >> 16);
          *(LAS unsigned short*)(hp + 4 * RS2) = (unsigned short)(v.z & 0xffffu); *(LAS unsigned short*)(hp + 5 * RS2) = (unsigned short)(v.z >> 16);
          *(LAS unsigned short*)(hp + 6 * RS2) = (unsigned short)(v.w & 0xffffu); *(LAS unsigned short*)(hp + 7 * RS2) = (unsigned short)(v.w >> 16); }
      __syncthreads();
#pragma unroll 4
      for (int rr = 0; rr < 32; ++rr) {
        const int trow = sub * 32 + rr; const int m = tb * SEQ + t0 + trow;
        float y0, y1, y2, y3;
        if (g == 0) {
            const u32x2 ow = *(const GAS u32x2*)(U + (size_t)m * DINP + U_MLO + cg);
            const f32x4 hs = *(const GAS f32x4*)(WSP(float, WS_HF) + (size_t)m * 256 + cg) + *(const GAS f32x4*)(WSP(float, WS_HB) + (size_t)m * 256 + cg);
            y0 = hs.x / (1.0f + fexp(-bflo(ow.x))); y1 = hs.y / (1.0f + fexp(-bfhi(ow.x))); y2 = hs.z / (1.0f + fexp(-bflo(ow.y))); y3 = hs.w / (1.0f + fexp(-bfhi(ow.y)));
        } else if (g == 1) {
            const u32x2 w = *(const GAS u32x2*)(YA + (size_t)m * 256 + cg);
            y0 = bflo(w.x); y1 = bfhi(w.x); y2 = bflo(w.y); y3 = bfhi(w.y);
        } else if (g == 2) {
            const u32x2 w = *(const LAS u32x2*)(F.lds + trow * RS2 + cg * 2);
            y0 = bflo(w.x); y1 = bfhi(w.x); y2 = bflo(w.y); y3 = bfhi(w.y);
        } else {
            const int s = t0 + trow;
            const bf16_t* up = U + (size_t)m * DINP + U_SC + cg;
            const u32x2 bw = *(const GAS u32x2*)up;
            u32x2 c0 = {0u, 0u}, x0 = {0u, 0u}, c2 = {0u, 0u}, x2 = {0u, 0u};
            if (s > 0) { c0 = *(const GAS u32x2*)(up - DINP + 256); x0 = *(const GAS u32x2*)(up - DINP + 512); }
            const u32x2 c1 = *(const GAS u32x2*)(up + 256), x1 = *(const GAS u32x2*)(up + 512);
            if (s < SEQ - 1) { c2 = *(const GAS u32x2*)(up + DINP + 256); x2 = *(const GAS u32x2*)(up + DINP + 512); }
            y0 = bflo(bw.x) * (scw[0] * bflo(c0.x) * bflo(x0.x) + scw[1] * bflo(c1.x) * bflo(x1.x) + scw[2] * bflo(c2.x) * bflo(x2.x));
            y1 = bfhi(bw.x) * (scw[3] * bfhi(c0.x) * bfhi(x0.x) + scw[4] * bfhi(c1.x) * bfhi(x1.x) + scw[5] * bfhi(c2.x) * bfhi(x2.x));
            y2 = bflo(bw.y) * (scw[6] * bflo(c0.y) * bflo(x0.y) + scw[7] * bflo(c1.y) * bflo(x1.y) + scw[8] * bflo(c2.y) * bflo(x2.y));
            y3 = bfhi(bw.y) * (scw[9] * bfhi(c0.y) * bfhi(x0.y) + scw[10] * bfhi(c1.y) * bfhi(x1.y) + scw[11] * bfhi(c2.y) * bfhi(x2.y));
        }
        float ss = (y0 * y0 + y1 * y1) + (y2 * y2 + y3 * y3);
        ss += __shfl_xor(ss, 1); ss += __shfl_xor(ss, 2); ss += __shfl_xor(ss, 4); ss += __shfl_xor(ss, 8);
        const float rstd = __builtin_amdgcn_rsqf(ss * (1.0f / 64.0f) + EPS);
        u32x2 w; w.x = pk2(y0 * rstd * og.x, y1 * rstd * og.y); w.y = pk2(y2 * rstd * og.z, y3 * rstd * og.w);
        *(GAS u32x2*)(WSP(bf16_t, WS_YN) + (size_t)m * DM + ch) = w;
      }
      __syncthreads();
    }
}

__device__ __forceinline__ void post_mixer_phase(Frame& F, int l, const float* xin) {
    const int gw = F.vcu * NWAVES + F.wave, NGW = F.G * NWAVES, lane = F.lane, tid = F.tid;
    LAS float* RWT = (LAS float*)F.lds;
    { const GAS f32x4* src = (const GAS f32x4*)(INF(31) + (size_t)l * 1024 * 16);
      for (int i = tid; i < 4096; i += NTHR) { const f32x4 w = src[i]; const int k = i >> 2, e4 = (i & 3) * 4;
          RWT[(e4 + 0) * 1024 + k] = w.x; RWT[(e4 + 1) * 1024 + k] = w.y; RWT[(e4 + 2) * 1024 + k] = w.z; RWT[(e4 + 3) * 1024 + k] = w.w; } }
    __syncthreads();
    const float* mod = WSP(float, WS_MOD);
    for (int m = gw; m < MTOK; m += NGW) {
        const int b = m >> 13, s = m & 8191; const float* md = mod + (l * 2 + b) * 6144;
        f32x4 y2[4], x[4], pg[4], g1[4];
        ld_row_f32(WSP(float, WS_Y2) + (size_t)m * DM, lane, y2);
        ld_row_f32(xin + (size_t)m * DM, lane, x);
        ld_row_f32(INF(6) + l * 1024, lane, pg); ld_row_f32(md + 2048, lane, g1);
        const float rstd = __builtin_amdgcn_rsqf(row_ss(y2) * (1.0f / DM) + EPS);
#pragma unroll
        for (int j = 0; j < 4; ++j) x[j] = x[j] + g1[j] * (y2[j] * rstd * pg[j]);
        st_row_f32(WSP(float, WS_X1) + (size_t)m * DM, lane, x);
        f32x4 h[4];
        modnorm(x, INF(7) + l * 1024, md + 4096, md + 3072, lane, h);
        st_row_bf16(WSP(bf16_t, WS_XN) + (size_t)m * DM, lane, h);
        float part[16];
#pragma unroll
        for (int e = 0; e < 16; ++e) part[e] = 0.f;
#pragma unroll
        for (int j = 0; j < 4; ++j) {
#pragma unroll
            for (int e = 0; e < 16; ++e) { const f32x4 w = *(const LAS f32x4*)(RWT + e * 1024 + 4 * lane + 256 * j);
                part[e] += (h[j].x * w.x + h[j].y * w.y) + (h[j].z * w.z + h[j].w * w.w); }
            asm volatile("" ::: "memory"); }
        float a8[8], a4[4], a2[2], lg;
        { const bool up = (lane & 32) != 0;
#pragma unroll
          for (int i = 0; i < 8; ++i) { const float keep = up ? part[8 + i] : part[i], send = up ? part[i] : part[8 + i]; a8[i] = keep + __shfl_xor(send, 32); } }
        { const bool up = (lane & 16) != 0;
#pragma unroll
          for (int i = 0; i < 4; ++i) { const float keep = up ? a8[4 + i] : a8[i], send = up ? a8[i] : a8[4 + i]; a4[i] = keep + __shfl_xor(send, 16); } }
        { const bool up = (lane & 8) != 0;
#pragma unroll
          for (int i = 0; i < 2; ++i) { const float keep = up ? a4[2 + i] : a4[i], send = up ? a4[i] : a4[2 + i]; a2[i] = keep + __shfl_xor(send, 8); } }
        { const bool up = (lane & 4) != 0; const float keep = up ? a2[1] : a2[0], send = up ? a2[0] : a2[1]; lg = keep + __shfl_xor(send, 4); }
        lg += __shfl_xor(lg, 2); lg += __shfl_xor(lg, 1);
        float mx = lg;
#pragma unroll
        for (int o = 4; o < 64; o <<= 1) mx = fmaxf(mx, __shfl_xor(mx, o));
        const float ex = fexp(lg - mx); float sm = ex;
#pragma unroll
        for (int o = 4; o < 64; o <<= 1) sm += __shfl_xor(sm, o);
        if ((lane & 3) == 0) WSP(float, WS_AFF)[((size_t)b * 16 + (lane >> 2)) * SEQ + s] = ex / sm;
        if (lane < 16) WSP(int, WS_SLOT)[(size_t)m * 16 + lane] = -1;
    }
    __syncthreads();
}

__device__ __forceinline__ void topk_item(Frame& F, int it) {
    const int tid = F.tid, lane = F.lane, wave = F.wave;
    const int b = it >> 4, e = it & 15;
    LAS unsigned* keys = (LAS unsigned*)F.lds;
    LAS unsigned* hist = (LAS unsigned*)(F.lds + 32768);
    LAS unsigned* ctl = hist + 256;
    LAS unsigned* wtot = hist + 320;
    const unsigned* src = (const unsigned*)(WSP(float, WS_AFF) + (size_t)it * SEQ);
#pragma unroll
    for (int i = 0; i < 16; ++i) keys[tid + 512 * i] = src[tid + 512 * i];
    unsigned prefix = 0u, mask = 0u, need = CAP;
    for (int pass = 0; pass < 4; ++pass) {
        const int shift = 24 - 8 * pass;
        if (tid < 256) hist[tid] = 0u;
        __syncthreads();
#pragma unroll
        for (int i = 0; i < 16; ++i) { const unsigned k = keys[tid + 512 * i]; if ((k & mask) == prefix) atomicAdd((unsigned*)&hist[(k >> shift) & 255u], 1u); }
        __syncthreads();
        if (wave == 0) { const unsigned c0 = hist[4 * lane], c1 = hist[4 * lane + 1], c2 = hist[4 * lane + 2], c3 = hist[4 * lane + 3];
            const unsigned sl = c0 + c1 + c2 + c3; unsigned T = sl;
#pragma unroll
            for (int o = 1; o < 64; o <<= 1) { const unsigned n = __shfl_down(T, o); if (lane + o < 64) T += n; }
            unsigned cum = T - sl;
            if (cum < need && cum + c3 >= need) { ctl[0] = 4u * lane + 3u; ctl[1] = need - cum; } cum += c3;
            if (cum < need && cum + c2 >= need) { ctl[0] = 4u * lane + 2u; ctl[1] = need - cum; } cum += c2;
            if (cum < need && cum + c1 >= need) { ctl[0] = 4u * lane + 1u; ctl[1] = need - cum; } cum += c1;
            if (cum < need && cum + c0 >= need) { ctl[0] = 4u * lane; ctl[1] = need - cum; } }
        __syncthreads();
        prefix |= ctl[0] << shift; mask |= 0xffu << shift; need = ctl[1];
        __syncthreads();
    }
    unsigned cg = 0u, ce = 0u;
#pragma unroll
    for (int i = 0; i < 16; ++i) { const unsigned k = keys[tid * 16 + i]; cg += (k > prefix) ? 1u : 0u; ce += (k == prefix) ? 1u : 0u; }
    unsigned v = cg | (ce << 16), inc = v;
#pragma unroll
    for (int o = 1; o < 64; o <<= 1) { const unsigned n = __shfl_up(inc, o); if (lane >= o) inc += n; }
    if (lane == 63) wtot[wave] = inc;
    __syncthreads();
    unsigned off = 0u;
    for (int w = 0; w < wave; ++w) off += wtot[w];
    const unsigned excl = off + inc - v;
    unsigned ng = excl & 0xffffu, ne = excl >> 16;
    int* IDX = WSP(int, WS_IDX) + it * CAP; int* SLOT = WSP(int, WS_SLOT);
#pragma unroll
    for (int i = 0; i < 16; ++i) { const int idx = tid * 16 + i; const unsigned k = keys[idx];
        const bool gt = k > prefix, eq = k == prefix; const bool sel = gt || (eq && ne < need);
        if (sel) { const int slot = (int)(ng + (ne < need ? ne : need)); IDX[slot] = idx; SLOT[((size_t)b * SEQ + idx) * 16 + e] = slot; }
        ng += gt ? 1u : 0u; ne += eq ? 1u : 0u; }
    __syncthreads();
}

__device__ __forceinline__ void gather_phase(Frame& F) {
    const int gw = F.vcu * NWAVES + F.wave, NGW = F.G * NWAVES, lane = F.lane;
    const int* IDX = WSP(int, WS_IDX);
    for (int r = gw; r < NEXP * 2 * CAP; r += NGW) {
        const int e = r >> 11, b = (r >> 10) & 1, j = r & 1023;
        const int tok = IDX[(b * 16 + e) * CAP + j];
        const GAS u32x4* src = (const GAS u32x4*)(WSP(bf16_t, WS_XN) + ((size_t)b * SEQ + tok) * DM);
        GAS u32x4* dst = (GAS u32x4*)(WSP(bf16_t, WS_XE) + (size_t)r * DM);
        dst[lane] = src[lane]; dst[64 + lane] = src[64 + lane];
    }
}

__device__ __forceinline__ void combine_phase(Frame& F, int l) {
    const int gw = F.vcu * NWAVES + F.wave, NGW = F.G * NWAVES, lane = F.lane;
    const float* mod = WSP(float, WS_MOD);
    const bf16_t* YE = WSP(bf16_t, WS_YE);
    for (int m = gw; m < MTOK; m += NGW) {
        const int b = m >> 13, s = m & 8191; const float* md = mod + (l * 2 + b) * 6144;
        int sl = -1; float gv = 0.f;
        if (lane < 16) { sl = WSP(int, WS_SLOT)[(size_t)m * 16 + lane]; gv = WSP(float, WS_AFF)[((size_t)b * 16 + lane) * SEQ + s]; }
        f32x4 acc[4];
#pragma unroll
        for (int j = 0; j < 4; ++j) acc[j] = (f32x4){0.f, 0.f, 0.f, 0.f};
#pragma unroll 1
        for (int e = 0; e < 16; ++e) {
            const int se = __shfl(sl, e);
            if (se >= 0) { const float ge = __shfl(gv, e);
                const GAS u32x2* rp = (const GAS u32x2*)(YE + ((size_t)e * 2048 + b * CAP + se) * DM) + lane;
#pragma unroll
                for (int j = 0; j < 4; ++j) { const u32x2 w = rp[64 * j]; acc[j] += (f32x4){bflo(w.x), bfhi(w.x), bflo(w.y), bfhi(w.y)} * ge; } }
        }
        f32x4 x1[4], pg[4], g2[4];
        ld_row_f32(WSP(float, WS_X1) + (size_t)m * DM, lane, x1);
        ld_row_f32(INF(8) + l * 1024, lane, pg); ld_row_f32(md + 5120, lane, g2);
        const float rstd = __builtin_amdgcn_rsqf(row_ss(acc) * (1.0f / DM) + EPS);
#pragma unroll
        for (int j = 0; j < 4; ++j) x1[j] = x1[j] + g2[j] * (acc[j] * rstd * pg[j]);
        st_row_f32(F.a->out + (size_t)m * DM, lane, x1);
        if (l == 0) { f32x4 h[4]; const float* md1 = mod + (1 * 2 + b) * 6144;
            modnorm(x1, INF(5) + 1024, md1 + 1024, md1, lane, h);
            st_row_bf16(WSP(bf16_t, WS_XN) + (size_t)m * DM, lane, h); }
    }
}

constexpr int PH_PER_LAYER = 13, N_PHASES = 2 + 2 * PH_PER_LAYER;
__global__ void __launch_bounds__(NTHR, 2) mega_fwd(Args args) {
    extern __shared__ __attribute__((aligned(16))) unsigned char lds_raw[];
    Frame F;
    F.lds = (LAS unsigned char*)lds_raw;
    F.tid = threadIdx.x; F.lane = F.tid & 63; F.wave = __builtin_amdgcn_readfirstlane(F.tid >> 6);
    F.G = gridDim.x; { const int bx = blockIdx.x; F.vcu = (F.G % 8 == 0) ? (bx % 8) * (F.G / 8) + bx / 8 : bx; }
    F.a = &args; F.ws = args.ws;
    volatile LAS unsigned* MISC = (volatile LAS unsigned*)(F.lds + MISC_OFF);
    for (int u = F.tid; u < (LDS_BYTES - LDSCTL_OFF) / 4; u += NTHR) ((LAS unsigned*)(F.lds + LDSCTL_OFF))[u] = 0u;
    __syncthreads();
    gu32* ctl = (gu32*)(F.ws + WS_CTL);
    XcdBarrier bar; bar.bar = (unsigned*)(ctl + CW_BAR); bar.x = 0; bar.st = nullptr;
#if !MK_SPLIT
    bar = xcd_barrier_post((unsigned*)(ctl + CW_BAR), MISC + 8);
#endif
    const int lo = args.ph_lo, hi = args.ph_hi;
    int ph = 0;
#if MK_SPLIT
#define SEAM() do { } while (0)
#else
#define SEAM() do { if (ph + 1 < hi) xcd_barrier(bar); } while (0)
#endif
#ifndef PHSEL
#define PHSEL -1
#endif
#ifndef PHMASK
#define PHMASK 0x7fff
#endif
#ifndef DBL_MASK
#define DBL_MASK 0
#endif
#define PHASE_BEGIN(id) if ((PHSEL < 0 || PHSEL == (id)) && ((PHMASK >> (id)) & 1) && lo <= ph && ph < hi) for (int rep_ = 0; rep_ < (((DBL_MASK >> (id)) & 1) ? 2 : 1); ++rep_) { if (rep_) xcd_barrier(bar); { int t_ = threadIdx.x; asm volatile("" : "+v"(t_)); F.tid = t_; F.lane = t_ & 63; F.wave = __builtin_amdgcn_readfirstlane(t_ >> 6); }
#define PHASE_END   SEAM(); } ++ph;

    PHASE_BEGIN(0) p0_phase(F); PHASE_END
    PHASE_BEGIN(1) p1_phase(F); PHASE_END
#pragma unroll 1
    for (int l = 0; l < 2; ++l) {
        const float* xin = (l == 0) ? (const float*)args.in[0] : (const float*)args.out;
        PHASE_BEGIN(2) {
            pg8::Gemm g{WSP(bf16_t, WS_XN), WSP(bf16_t, WS_WIN) + (size_t)l * DINP * 1024, MTOK, DINP, 1024}; pg8::StaticOrder S; S.init(MTOK, DINP, F.G, (int)blockIdx.x);
            pg8::EpiBf16 E{WSP(bf16_t, WS_U), DINP, DINP / 256};
            pg8::gemm_phase<pg8::EpiBf16, pg8::StaticOrder, true, true>(F.lds, g, S, E, F.tid);
        } PHASE_END
        PHASE_BEGIN(3) {
#ifndef SUBSEL
#define SUBSEL 0
#endif
#ifndef REP_A
#define REP_A 1
#define REP_B 1
#define REP_C 1
#define REP_D 1
#define REP_E 1
#endif
            for (int q_ = 0; q_ < REP_A; ++q_) for (int tl = F.vcu; tl < 256; tl += F.G) hy_prep_tile(F, tl, l);
            for (int q_ = 0; q_ < REP_B; ++q_) for (int p = F.vcu; p < 512; p += F.G) ml_local_pair(F, p, l);
            for (int q_ = 0; q_ < REP_C; ++q_) mla_prep_rows(F, l);
        } PHASE_END
        PHASE_BEGIN(4) {
            pg8::Gemm g{WSP(bf16_t, WS_AMLA), WSP(bf16_t, WS_WMLA) + (size_t)l * 1024 * 384, MTOK, 1024, 384}; pg8::StaticOrder S; S.init(MTOK, 1024, F.G, (int)blockIdx.x);
            pg8::EpiBf16 E{WSP(bf16_t, WS_OMLA), 1024, 4};
            pg8::gemm_phase<pg8::EpiBf16, pg8::StaticOrder, true, true>(F.lds, g, S, E, F.tid);
#define REFRESH_TID() do { int t_ = threadIdx.x; asm volatile("" : "+v"(t_)); F.tid = t_; F.lane = t_ & 63; F.wave = __builtin_amdgcn_readfirstlane(t_ >> 6); } while (0)
            REFRESH_TID();
            ml_scan(F);
            REFRESH_TID();
#ifndef HY_REP
#define HY_REP 1
#endif
            for (int rep2_ = 0; rep2_ < HY_REP; ++rep2_) for (int c = F.vcu; c < 256; c += F.G) hyena_item(F, c, l);
        } PHASE_END
        PHASE_BEGIN(5) relayout_phase(F); PHASE_END
        PHASE_BEGIN(6) {
            for (int q_ = 0; q_ < REP_D; ++q_) for (int u = F.vcu; u < 256; u += F.G) attn_unit(F, u >> 5, u & 31);
            for (int q_ = 0; q_ < REP_E; ++q_) for (int p = F.vcu; p < 512; p += F.G) ml_out_pair(F, p, l);
        } PHASE_END
        PHASE_BEGIN(7) headnorm_phase(F, l); PHASE_END
        PHASE_BEGIN(8) {
            pg8::Gemm g{WSP(bf16_t, WS_YN), WSP(bf16_t, WS_WOUT) + (size_t)l * 1024 * 1024, MTOK, 1024, 1024}; pg8::StaticOrder S; S.init(MTOK, 1024, F.G, (int)blockIdx.x);
            pg8::EpiF32 E{WSP(float, WS_Y2), 1024};
            pg8::gemm_phase<pg8::EpiF32, pg8::StaticOrder, true, true>(F.lds, g, S, E, F.tid);
        } PHASE_END
        PHASE_BEGIN(9) post_mixer_phase(F, l, xin); PHASE_END
        PHASE_BEGIN(10) { for (int it = F.vcu; it < 32; it += F.G) topk_item(F, it); } PHASE_END
        PHASE_BEGIN(11) gather_phase(F); PHASE_END
        PHASE_BEGIN(12) {
            pg8::Gemm g{WSP(bf16_t, WS_XE), WSP(bf16_t, WS_WGU) + (size_t)l * NEXP * 4096 * 1024, NEXP * 2048, NEXP * 4096, 1024}; pg8::GroupedOrder S; S.init(16, F.G, (int)blockIdx.x);
            pg8::EpiSwiGLU E{WSP(bf16_t, WS_ACT), EFF};
            pg8::gemm_phase<pg8::EpiSwiGLU, pg8::GroupedOrder, true, true>(F.lds, g, S, E, F.tid);
        } PHASE_END
        PHASE_BEGIN(13) {
            pg8::Gemm g{WSP(bf16_t, WS_ACT), WSP(bf16_t, WS_WDN) + (size_t)l * NEXP * 1024 * 2048, NEXP * 2048, NEXP * 1024, 2048}; pg8::GroupedOrder S; S.init(4, F.G, (int)blockIdx.x);
            pg8::EpiBf16 E{WSP(bf16_t, WS_YE), 1024, 4};
            pg8::gemm_phase<pg8::EpiBf16, pg8::GroupedOrder, true, true>(F.lds, g, S, E, F.tid);
        } PHASE_END
        PHASE_BEGIN(14) combine_phase(F, l); PHASE_END
    }
}

extern "C" void kernel_launch(void* const* d_in, const int* in_sizes, int n_in, void* d_out, int out_size, void* d_ws, size_t ws_size, hipStream_t stream) {
    static int grid = 0;
    if (grid == 0) {
        if (n_in != 35 || out_size != MTOK * DM || ws_size < WS_END) { fprintf(stderr, "kernel_launch: unexpected shapes: n_in %d out %d ws %zu (need %zu)\n", n_in, out_size, ws_size, (size_t)WS_END); grid = -1; return; }
        int dev = 0, cus = 0, per_cu = 0;
        if (hipGetDevice(&dev) != hipSuccess || hipDeviceGetAttribute(&cus, hipDeviceAttributeMultiprocessorCount, dev) != hipSuccess) { grid = -1; return; }
        if (hipFuncSetAttribute((const void*)mega_fwd, hipFuncAttributeMaxDynamicSharedMemorySize, LDS_BYTES) != hipSuccess) { fprintf(stderr, "kernel_launch: hipFuncSetAttribute failed\n"); grid = -1; return; }
        (void)hipOccupancyMaxActiveBlocksPerMultiprocessor(&per_cu, (const void*)mega_fwd, NTHR, LDS_BYTES);
        (void)hipGetLastError();
        grid = cus > 0 ? cus : 256;
        if (per_cu < 1) fprintf(stderr, "kernel_launch: occupancy query reports %d\n", per_cu);
    }
    if (grid < 0) return;
    (void)hipMemsetAsync((char*)d_ws + WS_CTL, 0, CTL_ZERO_BYTES, stream);
    Args a{};
    for (int i = 0; i < 35; ++i) a.in[i] = d_in[i];
    a.out = (float*)d_out; a.ws = (unsigned char*)d_ws;
#if MK_SPLIT
    for (int p = 0; p < N_PHASES; ++p) { a.ph_lo = p; a.ph_hi = p + 1; hipLaunchKernelGGL(mega_fwd, dim3(grid), dim3(NTHR), LDS_BYTES, stream, a); }
#else
    a.ph_lo = 0; a.ph_hi = N_PHASES;
    hipLaunchKernelGGL(mega_fwd, dim3(grid), dim3(NTHR), LDS_BYTES, stream, a);
#endif
}
```

```cpp
#include <hip/hip_runtime.h>
#include <cstdio>
#include <cstdint>

#ifndef MK_SPLIT
#define MK_SPLIT 0
#endif

#define GAS __attribute__((address_space(1)))
#define LAS __attribute__((address_space(3)))
typedef GAS unsigned gu32;
#define RLX_AGENT __ATOMIC_RELAXED, __HIP_MEMORY_SCOPE_AGENT
typedef unsigned short bf16_t;
typedef short bf16x8 __attribute__((ext_vector_type(8)));
typedef short s16x4 __attribute__((ext_vector_type(4)));
typedef float f32x4 __attribute__((ext_vector_type(4)));
typedef float f32x2 __attribute__((ext_vector_type(2)));
typedef float f32x16 __attribute__((ext_vector_type(16)));
typedef unsigned u32x4 __attribute__((ext_vector_type(4)));
typedef unsigned u32x2 __attribute__((ext_vector_type(2)));
typedef __bf16 bf16x2_t __attribute__((ext_vector_type(2)));

namespace pg8 {
#define PG8_LAS __attribute__((address_space(3)))
constexpr int BM = 256, BK = 64, HALF = 128, HTB = HALF * BK * 2, STAGE_BYTES = 8 * HTB, NXCD = 8, WGM = 8;
__host__ __device__ __forceinline__ int lds_byte(int r, int c) { const int st = (r >> 4) * 2 + (c >> 5), rr = r & 15, cc = c & 31, ob = rr * 64 + cc * 2; return st * 1024 + (ob ^ (((ob >> 9) & 1) << 5)); }
__host__ __device__ __forceinline__ void stage_rc(int b, int& R, int& C) { const int st = b / 1024, sb = b % 1024, swz = sb ^ (((sb >> 9) & 1) << 5); R = (st >> 1) * 16 + swz / 64; C = (st & 1) * 32 + (swz % 64) / 2; }
__host__ __device__ __forceinline__ int perm32(int rho) { const int n = rho >> 4, i = rho & 15; return 8 * (i >> 2) + 4 * n + (i & 3); }
struct Unit { int pm, pn; };
struct Gemm { const bf16_t* A; const bf16_t* Bt; int M, N, K; const int* rowidx; };
struct StaticOrder {
    int nM, nN, nwg, G, c;
    __host__ __device__ void init(int M, int N, int G_, int c_) { nM = M / BM; nN = N / BM; nwg = nM * nN; G = G_; c = c_; }
    __host__ __device__ bool next(int i, Unit& u) const {
        const long L = (long)i * G + c; if (L >= nwg) return false;
        int wgid = (int)L; { const int q = nwg / NXCD, r = nwg % NXCD, xcd = wgid % NXCD, off = wgid / NXCD; wgid = (xcd < r ? xcd * (q + 1) : r * (q + 1) + (xcd - r) * q) + off; }
        const int nig = WGM * nN, gid = wgid / nig, fm = gid * WGM, gsz = (nM - fm) < WGM ? (nM - fm) : WGM;
        u.pm = fm + ((wgid % nig) % gsz); u.pn = (wgid % nig) / gsz; return true;
    }
    __device__ __forceinline__ void a_ready(const Unit&) const {}
    __device__ __forceinline__ void done(const Unit&) const {}
};
struct GroupedOrder {
    int nNl, total, G, c;
    __host__ __device__ void init(int nNl_, int G_, int c_) { nNl = nNl_; total = 16 * 8 * nNl_; G = G_; c = c_; }
    __host__ __device__ bool next(int i, Unit& u) const {
        const long L = (long)i * G + c; if (L >= total) return false;
        if (G == 256 && (nNl == 16 || nNl == 4)) {
            const int x = c & 7, w = c >> 3;
            if (nNl == 16) { const int e = 2 * i + (w >> 4), q = w & 15; u.pm = e * 8 + 4 * (x & 1) + (q & 3); u.pn = e * 16 + 4 * (x >> 1) + (q >> 2); }
            else { const int e = 8 * i + x; u.pm = e * 8 + (w & 7); u.pn = e * 4 + (w >> 3); }
            return true;
        }
        const int per_e = 8 * nNl, e = (int)L / per_e, r = (int)L % per_e;
        u.pm = e * 8 + (r % 8); u.pn = e * nNl + (r / 8); return true;
    }
    __device__ __forceinline__ void a_ready(const Unit&) const {}
    __device__ __forceinline__ void done(const Unit&) const {}
};
__device__ __forceinline__ unsigned cvt_pk_bf16(float lo, float hi) { f32x2 v = {lo, hi}; bf16x2_t b = __builtin_convertvector(v, bf16x2_t); return __builtin_bit_cast(unsigned, b); }

struct EpiBf16 {
    static constexpr bool PERM = true, AFTER_DRAIN = false;
    bf16_t* O; int ldc; int ntn;
    __device__ __forceinline__ void operator()(const f32x4 (&acc)[2][2][4][2], const Unit& u, int wr, int wc, int fr, int fq) const {
        const int row0 = u.pm * BM + wr * 64 + fr; const int colt = (u.pn % ntn) * BM;
        const int col0 = colt + wc * 32 + 8 * fq;
#pragma unroll
        for (int ai = 0; ai < 2; ++ai)
#pragma unroll
            for (int m = 0; m < 4; ++m) { bf16_t* rowp = O + (size_t)(row0 + ai * HALF + m * 16) * ldc + col0;
#pragma unroll
                for (int bj = 0; bj < 2; ++bj) { const f32x4 v0 = acc[ai][bj][m][0], v1 = acc[ai][bj][m][1];
                    u32x4 w; w.x = cvt_pk_bf16(v0[0], v0[1]); w.y = cvt_pk_bf16(v0[2], v0[3]); w.z = cvt_pk_bf16(v1[0], v1[1]); w.w = cvt_pk_bf16(v1[2], v1[3]);
                    *(u32x4*)(rowp + bj * HALF) = w; } }
    }
};
struct EpiF32 {
    static constexpr bool PERM = false, AFTER_DRAIN = false;
    float* O; int ldc;
    __device__ __forceinline__ void operator()(const f32x4 (&acc)[2][2][4][2], const Unit& u, int wr, int wc, int fr, int fq) const {
        const int col0 = u.pn * BM + wc * 32 + 4 * fq;
#pragma unroll
        for (int ai = 0; ai < 2; ++ai)
#pragma unroll
            for (int m = 0; m < 4; ++m) { float* rowp = O + (size_t)(u.pm * BM + ai * HALF + wr * 64 + m * 16 + fr) * ldc + col0;
#pragma unroll
                for (int bj = 0; bj < 2; ++bj)
#pragma unroll
                    for (int n = 0; n < 2; ++n) *(f32x4*)(rowp + bj * HALF + n * 16) = acc[ai][bj][m][n]; }
    }
};
__device__ __forceinline__ float silu_f(float a) { return a * __builtin_amdgcn_rcpf(1.0f + __builtin_amdgcn_exp2f(-1.4426950408889634f * a)); }
struct EpiSwiGLU {
    static constexpr bool PERM = true, AFTER_DRAIN = false;
    bf16_t* O; int ldc;
    __device__ __forceinline__ void operator()(const f32x4 (&acc)[2][2][4][2], const Unit& u, int wr, int wc, int fr, int fq) const {
        const int row0 = u.pm * BM + wr * 64 + fr; const int col0 = (u.pn % 16) * HALF + wc * 32 + 8 * fq;
#pragma unroll
        for (int ai = 0; ai < 2; ++ai)
#pragma unroll
            for (int m = 0; m < 4; ++m) { bf16_t* rowp = O + (size_t)(row0 + ai * HALF + m * 16) * ldc + col0;
                const f32x4 g0 = acc[ai][0][m][0], g1 = acc[ai][0][m][1], u0 = acc[ai][1][m][0], u1 = acc[ai][1][m][1];
                u32x4 w;
                w.x = cvt_pk_bf16(silu_f(g0[0]) * u0[0], silu_f(g0[1]) * u0[1]); w.y = cvt_pk_bf16(silu_f(g0[2]) * u0[2], silu_f(g0[3]) * u0[3]);
                w.z = cvt_pk_bf16(silu_f(g1[0]) * u1[0], silu_f(g1[1]) * u1[1]); w.w = cvt_pk_bf16(silu_f(g1[2]) * u1[2], silu_f(g1[3]) * u1[3]);
                *(u32x4*)rowp = w; }
    }
};

template <class Epi, class Sched, bool ALIGN_EPI = false, bool SP2 = false, bool GATHER = false>
__device__ __forceinline__ void gemm_phase(PG8_LAS unsigned char* lds, const Gemm g, const Sched& S, const Epi& E, const int tid) {
    const int wid = __builtin_amdgcn_readfirstlane(tid >> 6), lane = tid & 63, wr = wid >> 2, wc = wid & 3, fr = lane & 15, fq = lane >> 4;
    int K_ = g.K; asm volatile("" : "+s"(K_));
    const int K = K_, nt = K / BK;
    unsigned voffA[2], voffB[2];
#pragma unroll
    for (int i = 0; i < 2; ++i) { int R, C; stage_rc(tid * 16 + i * 8192, R, C); const int Rb = Epi::PERM ? ((R & ~31) + perm32(R & 31)) : R;
        voffA[i] = (unsigned)(R * K + C) * 2u; voffB[i] = (unsigned)(Rb * K + C) * 2u; }
    const size_t kstep = (size_t)(BK * 2);
    const size_t hstep = (size_t)HALF * K * 2;
    const size_t tstep = 2 * hstep;
    const unsigned ldsw = (unsigned)wid * 1024u;
    const int aoff = lds_byte(wr * 64 + fr, fq * 8), boff = lds_byte(wc * 32 + fr, fq * 8);
#define PG8_SA(b, h) (((b) * 2 + (h)) * HTB)
#define PG8_SB(b, h) ((4 + (b) * 2 + (h)) * HTB)
#define PG8_STAGE(bufoff, gbase, voff) do { _Pragma("unroll") for (int _i = 0; _i < 2; ++_i) \
        __builtin_amdgcn_global_load_lds((const unsigned*)((const char*)(gbase) + (voff)[_i]), (PG8_LAS unsigned*)(lds + (bufoff) + ldsw + _i * 8192), 16, 0, 0); } while (0)
#define PG8_LDA(dst, b, h) do { _Pragma("unroll") for (int m = 0; m < 4; ++m) _Pragma("unroll") for (int k = 0; k < 2; ++k) dst[m][k] = *(const PG8_LAS bf16x8*)(lds + PG8_SA(b, h) + aoff + m * 2048 + k * 1024); } while (0)
#define PG8_LDB(dst, b, h) do { _Pragma("unroll") for (int n = 0; n < 2; ++n) _Pragma("unroll") for (int k = 0; k < 2; ++k) dst[n][k] = *(const PG8_LAS bf16x8*)(lds + PG8_SB(b, h) + boff + n * 2048 + k * 1024); } while (0)
#define PG8_MMA(ai, bj, At, Bt) do { __builtin_amdgcn_s_setprio(1); _Pragma("unroll") for (int m = 0; m < 4; ++m) _Pragma("unroll") for (int n = 0; n < 2; ++n) _Pragma("unroll") for (int k = 0; k < 2; ++k) \
        acc[ai][bj][m][n] = __builtin_amdgcn_mfma_f32_16x16x32_bf16(Bt[n][k], At[m][k], acc[ai][bj][m][n], 0, 0, 0); __builtin_amdgcn_s_setprio(0); } while (0)
#define PG8_WAIT_V(n) asm volatile("s_waitcnt vmcnt(" #n ")" ::: "memory")
#define PG8_WAIT_L(n) asm volatile("s_waitcnt lgkmcnt(" #n ")" ::: "memory")
#define PG8_BAR __builtin_amdgcn_s_barrier()
#define PG8_SCHED __builtin_amdgcn_sched_barrier(0)
    Unit cur, nxt; int ui = 0;
    if (!S.next(0, cur)) return;
    f32x4 acc[2][2][4][2];
#pragma unroll
    for (int a = 0; a < 2; ++a)
#pragma unroll
        for (int b = 0; b < 2; ++b)
#pragma unroll
            for (int m = 0; m < 4; ++m)
#pragma unroll
                for (int n = 0; n < 2; ++n) acc[a][b][m][n] = (f32x4){0.f, 0.f, 0.f, 0.f};
    bf16x8 At[4][2], B0[2][2], B1[2][2];
    const char* cA = GATHER ? (const char*)g.A : (const char*)g.A + (size_t)cur.pm * tstep; const char* cB = (const char*)g.Bt + (size_t)cur.pn * tstep;
    unsigned gc0[2] = {0u, 0u}, gc1[2] = {0u, 0u}, gn0[2] = {0u, 0u}, gn1[2] = {0u, 0u}; int gR[2] = {0, 0}; unsigned gC[2] = {0u, 0u};
    if constexpr (GATHER) {
#pragma unroll
        for (int i = 0; i < 2; ++i) { int R, C; stage_rc(tid * 16 + i * 8192, R, C); gR[i] = R; gC[i] = (unsigned)C * 2u;
            gc0[i] = (unsigned)g.rowidx[cur.pm * BM + R] * (unsigned)(K * 2) + gC[i]; gc1[i] = (unsigned)g.rowidx[cur.pm * BM + HALF + R] * (unsigned)(K * 2) + gC[i]; }
    }
#define PG8_STAGE_A(bufoff, base, half, o0, o1) do { if constexpr (GATHER) { if ((half) == 0) PG8_STAGE(bufoff, base, o0); else PG8_STAGE(bufoff, base, o1); } \
        else PG8_STAGE(bufoff, (base) + ((half) ? hstep : 0), voffA); } while (0)
    S.a_ready(cur);
    if constexpr (SP2) {
        PG8_STAGE(PG8_SB(0, 0), cB, voffB); PG8_STAGE(PG8_SB(0, 1), cB + hstep, voffB); PG8_STAGE_A(PG8_SA(0, 0), cA, 0, gc0, gc1); PG8_STAGE_A(PG8_SA(0, 1), cA, 1, gc0, gc1);
        if (wr == 1) PG8_BAR;
        PG8_WAIT_V(2); PG8_BAR;
        PG8_STAGE(PG8_SB(1, 0), cB + kstep, voffB); PG8_STAGE_A(PG8_SA(1, 0), cA + kstep, 0, gc0, gc1); PG8_STAGE(PG8_SB(1, 1), cB + hstep + kstep, voffB);
        PG8_WAIT_V(6); PG8_BAR;
    } else {
        PG8_STAGE(PG8_SB(0, 0), cB, voffB); PG8_STAGE(PG8_SA(0, 0), cA, voffA); PG8_STAGE(PG8_SB(0, 1), cB + hstep, voffB); PG8_STAGE(PG8_SA(0, 1), cA + hstep, voffA);
        if (wr == 1) PG8_BAR;
        PG8_WAIT_V(4); PG8_BAR;
        PG8_STAGE(PG8_SB(1, 0), cB + kstep, voffB); PG8_STAGE(PG8_SA(1, 0), cA + kstep, voffA); PG8_STAGE(PG8_SB(1, 1), cB + hstep + kstep, voffB);
        PG8_WAIT_V(6); PG8_BAR;
    }
    for (;;) {
        const bool has_next = S.next(ui + 1, nxt);
        const char* nA = GATHER ? cA : (has_next ? (const char*)g.A + (size_t)nxt.pm * tstep : cA); const char* nB = has_next ? (const char*)g.Bt + (size_t)nxt.pn * tstep : cB;
        if constexpr (GATHER) { const int npm = has_next ? nxt.pm : cur.pm;
#pragma unroll
            for (int i = 0; i < 2; ++i) { gn0[i] = (unsigned)g.rowidx[npm * BM + gR[i]] * (unsigned)(K * 2) + gC[i]; gn1[i] = (unsigned)g.rowidx[npm * BM + HALF + gR[i]] * (unsigned)(K * 2) + gC[i]; } }
        for (int t = 0; t < nt; t += 2) {
            const bool last = (t == nt - 2);
            const char* a1 = cA + (size_t)(t + 1) * kstep;
            const char* a2 = last ? nA : cA + (size_t)(t + 2) * kstep; const char* b2 = last ? nB : cB + (size_t)(t + 2) * kstep;
            const char* a3 = a2 + kstep; const char* b3 = b2 + kstep;
            if (last && has_next) S.a_ready(nxt);
            if constexpr (SP2) {
            unsigned gs0[2], gs1[2];
#pragma unroll
            for (int i = 0; i < 2; ++i) { gs0[i] = last ? gn0[i] : gc0[i]; gs1[i] = last ? gn1[i] : gc1[i]; }
            PG8_LDB(B0, 0, 0); PG8_LDB(B1, 0, 1); PG8_SCHED; PG8_LDA(At, 0, 0); PG8_STAGE_A(PG8_SA(1, 1), a1, 1, gc0, gc1);
            PG8_WAIT_V(8); PG8_WAIT_L(0); PG8_BAR; PG8_MMA(0, 0, At, B0); PG8_MMA(0, 1, At, B1); PG8_BAR; PG8_SCHED;
            PG8_LDA(At, 0, 1); PG8_STAGE(PG8_SB(0, 0), b2, voffB); PG8_STAGE(PG8_SB(0, 1), b2 + hstep, voffB); PG8_STAGE_A(PG8_SA(0, 0), a2, 0, gs0, gs1);
            PG8_WAIT_V(8); PG8_WAIT_L(0); PG8_BAR; PG8_MMA(1, 0, At, B0); PG8_MMA(1, 1, At, B1); PG8_BAR; PG8_SCHED;
            PG8_LDB(B0, 1, 0); PG8_LDB(B1, 1, 1); PG8_SCHED; PG8_LDA(At, 1, 0); PG8_STAGE_A(PG8_SA(0, 1), a2, 1, gs0, gs1);
            PG8_WAIT_V(8); PG8_WAIT_L(0); PG8_BAR; PG8_MMA(0, 0, At, B0); PG8_MMA(0, 1, At, B1); PG8_BAR; PG8_SCHED;
            PG8_LDA(At, 1, 1); PG8_STAGE(PG8_SB(1, 0), b3, voffB); PG8_STAGE(PG8_SB(1, 1), b3 + hstep, voffB); PG8_STAGE_A(PG8_SA(1, 0), a3, 0, gs0, gs1);
            PG8_WAIT_V(8); PG8_WAIT_L(0); PG8_BAR; PG8_MMA(1, 0, At, B0); PG8_MMA(1, 1, At, B1); PG8_BAR; PG8_SCHED;
            } else {
            PG8_LDB(B0, 0, 0); PG8_SCHED; PG8_LDA(At, 0, 0); PG8_STAGE(PG8_SA(1, 1), a1 + hstep, voffA);
            PG8_WAIT_L(8); PG8_BAR; PG8_WAIT_L(0); PG8_MMA(0, 0, At, B0); PG8_BAR; PG8_SCHED;
            PG8_LDB(B1, 0, 1); PG8_STAGE(PG8_SB(0, 0), b2, voffB);
            PG8_BAR; PG8_WAIT_L(0); PG8_MMA(0, 1, At, B1); PG8_BAR;
            PG8_LDA(At, 0, 1); PG8_STAGE(PG8_SA(0, 0), a2, voffA);
            PG8_BAR; PG8_WAIT_L(0); PG8_MMA(1, 0, At, B0); PG8_BAR; PG8_SCHED;
            PG8_STAGE(PG8_SB(0, 1), b2 + hstep, voffB);
            PG8_WAIT_V(6); PG8_BAR; PG8_MMA(1, 1, At, B1); PG8_BAR;
            PG8_LDB(B0, 1, 0); PG8_SCHED; PG8_LDA(At, 1, 0); PG8_STAGE(PG8_SA(0, 1), a2 + hstep, voffA);
            PG8_WAIT_L(8); PG8_BAR; PG8_WAIT_L(0); PG8_MMA(0, 0, At, B0); PG8_BAR; PG8_SCHED;
            PG8_LDB(B1, 1, 1); PG8_STAGE(PG8_SB(1, 0), b3, voffB);
            PG8_BAR; PG8_WAIT_L(0); PG8_MMA(0, 1, At, B1); PG8_BAR;
            PG8_LDA(At, 1, 1); PG8_STAGE(PG8_SA(1, 0), a3, voffA);
            PG8_BAR; PG8_WAIT_L(0); PG8_MMA(1, 0, At, B0); PG8_BAR; PG8_SCHED;
            PG8_STAGE(PG8_SB(1, 1), b3 + hstep, voffB);
            PG8_WAIT_V(6); PG8_BAR; PG8_MMA(1, 1, At, B1); PG8_BAR;
            }
        }
        if constexpr (ALIGN_EPI) { if (wr == 0) PG8_BAR; }
        if constexpr (!Epi::AFTER_DRAIN) { E(acc, cur, wr, wc, fr, fq); S.done(cur); }
        if (!has_next) break;
#pragma unroll
        for (int a = 0; a < 2; ++a)
#pragma unroll
            for (int b = 0; b < 2; ++b)
#pragma unroll
                for (int m = 0; m < 4; ++m)
#pragma unroll
                    for (int n = 0; n < 2; ++n) acc[a][b][m][n] = (f32x4){0.f, 0.f, 0.f, 0.f};
        cur = nxt; cA = nA; cB = nB; ++ui;
        if constexpr (GATHER) { gc0[0] = gn0[0]; gc0[1] = gn0[1]; gc1[0] = gn1[0]; gc1[1] = gn1[1]; }
        if constexpr (ALIGN_EPI) { if (wr == 1) PG8_BAR; }
    }
    PG8_WAIT_V(0);
    if constexpr (!ALIGN_EPI) { if (wr == 0) PG8_BAR; }
    PG8_BAR;
#undef PG8_SA
#undef PG8_SB
#undef PG8_STAGE
#undef PG8_STAGE_A
#undef PG8_LDA
#undef PG8_LDB
#undef PG8_MMA
#undef PG8_WAIT_V
#undef PG8_WAIT_L
#undef PG8_BAR
#undef PG8_SCHED
}
}

constexpr int NWAVES = 8, NTHR = 512;
constexpr int BATCH = 2, SEQ = 8192, DM = 1024, MTOK = BATCH * SEQ;
constexpr int DIN = 2960, DINP = 3072;
constexpr int NEXP = 16, CAP = 1024, EFF = 2048;
constexpr float EPS = 1e-6f;
constexpr int U_MLQ = 0, U_MLK = 256, U_MLV = 512, U_MLO = 768, U_MLG = 1024, U_CQ = 1040, U_CKV = 1264, U_KR = 1392, U_HY = 1424, U_SC = 2192;
constexpr float LOG2E = 1.4426950408889634f;

constexpr size_t MiB = 1u << 20;
constexpr size_t WS_CTL = 0, CTL_ZERO_BYTES = 1 * MiB;
constexpr size_t WS_MOD = 1 * MiB;
constexpr size_t WS_MLS = 1 * MiB + 128 * 1024;
constexpr size_t WS_MLN = 1 * MiB + 256 * 1024;
constexpr size_t WS_AFF = 2 * MiB;
constexpr size_t WS_SLOT = 3 * MiB;
constexpr size_t WS_IDX = 4 * MiB;
constexpr size_t WS_HID = 5 * MiB;
constexpr size_t WS_WMLA = 9 * MiB;
constexpr size_t WS_WOUT = 11 * MiB;
constexpr size_t WS_WIN = 15 * MiB;
constexpr size_t WS_WGU = 28 * MiB;
constexpr size_t WS_WDN = 284 * MiB;
constexpr size_t WS_XN = 412 * MiB;
constexpr size_t WS_AMLA = 444 * MiB;
constexpr size_t WS_Q = 456 * MiB;
constexpr size_t WS_KIMG = 468 * MiB;
constexpr size_t WS_VIMG = 480 * MiB;
constexpr size_t WS_MLC = 488 * MiB;
constexpr size_t WS_HF = 504 * MiB;
constexpr size_t WS_HB = 520 * MiB;
constexpr size_t WS_YATT = 536 * MiB;
constexpr size_t WS_YHT = 544 * MiB;
constexpr size_t WS_YN = 552 * MiB;
constexpr size_t WS_X1 = 584 * MiB;
constexpr size_t WS_U = 648 * MiB;
constexpr size_t WS_OMLA = 744 * MiB;
constexpr size_t WS_ACT = 648 * MiB;
constexpr size_t WS_KF = 776 * MiB;
constexpr size_t WS_Y2 = 776 * MiB;
constexpr size_t WS_XE = 776 * MiB;
constexpr size_t WS_YE = 840 * MiB;
constexpr size_t WS_HYT = 904 * MiB;
constexpr size_t WS_FILT = 956 * MiB;
constexpr size_t WS_END = 1020 * MiB;
constexpr int CW_BAR = 4096;

constexpr int RING_BYTES = 139264;
constexpr int LDSCTL_OFF = RING_BYTES, MISC_OFF = LDSCTL_OFF + 320;
constexpr int XTRA_OFF = RING_BYTES + 1024;
constexpr int LDS_BYTES = 147456;

__device__ __forceinline__ float bf2f(unsigned short u) { return __uint_as_float((unsigned)u << 16); }
__device__ __forceinline__ unsigned pk2(float lo, float hi) { f32x2 v = {lo, hi}; bf16x2_t b = __builtin_convertvector(v, bf16x2_t); return __builtin_bit_cast(unsigned, b); }
__device__ __forceinline__ float bflo(unsigned w) { return __uint_as_float(w << 16); }
__device__ __forceinline__ float bfhi(unsigned w) { return __uint_as_float(w & 0xffff0000u); }
__device__ __forceinline__ float wave_sum(float v) {
#pragma unroll
    for (int o = 1; o < 64; o <<= 1) v += __shfl_xor(v, o);
    return v;
}
__device__ __forceinline__ float fexp(float x) { return __builtin_amdgcn_exp2f(x * LOG2E); }
__device__ __forceinline__ float flog(float x) { return __builtin_amdgcn_logf(x) * 0.6931471805599453f; }
__device__ __forceinline__ float sin_rev(float r) { return __builtin_amdgcn_sinf(r); }
__device__ __forceinline__ float cos_rev(float r) { return __builtin_amdgcn_cosf(r); }
__device__ __forceinline__ float sin_rad(float x) { float r = x * 0.15915494309189535f; r = r - __builtin_rintf(r); return __builtin_amdgcn_sinf(r); }
__device__ __forceinline__ int crow(int r, int hi) { return (r & 3) + 8 * (r >> 2) + 4 * hi; }
#define LDS_WAIT() asm volatile("s_waitcnt lgkmcnt(0)" ::: "memory")
#define VM_WAIT() asm volatile("s_waitcnt vmcnt(0)" ::: "memory")

#define XB_TMO      128
#define XB_XCNT(j)  (256  + 64 * (j))
#define XB_XSUB(j)  (1280 + 64 * (j))
#define XB_XGEN(j)  (2304 + 64 * (j))
#define XB_TOP      3328
#define XB_TOPGEN   3392
#define XCD_BAR_WORDS 3456
#define XB_SPIN_CAP (1u << 18)
__device__ __forceinline__ unsigned xb_ld(unsigned* p)              { return __hip_atomic_load(p, __ATOMIC_RELAXED, __HIP_MEMORY_SCOPE_AGENT); }
__device__ __forceinline__ unsigned xb_add(unsigned* p, unsigned v) { return __hip_atomic_fetch_add(p, v, __ATOMIC_RELAXED, __HIP_MEMORY_SCOPE_AGENT); }
__device__ __forceinline__ unsigned xb_xcc_id() { return (unsigned)__builtin_amdgcn_s_getreg((3 << 11) | 20) & 0xFu; }
#define XB_SPIN(cond, bar) do { unsigned _sp = 0; while (cond) { __builtin_amdgcn_s_sleep(1); \
    if ((++_sp & 255u) == 0u) { if (xb_ld(&(bar)[XB_TMO])) break; if (_sp > XB_SPIN_CAP) { atomicAdd(&(bar)[XB_TMO], 1u); break; } } } } while (0)
struct XcdBarrier { unsigned* bar; unsigned x; volatile LAS unsigned* st; };
__device__ __forceinline__ XcdBarrier xcd_barrier_post(unsigned* bar, volatile LAS unsigned* st) {
    XcdBarrier b; b.bar = bar; b.x = xb_xcc_id(); b.st = st;
    if (threadIdx.x == 0) (void)xb_add(&bar[XB_XCNT(b.x)], 1u);
    return b;
}
__device__ __forceinline__ void xcd_barrier_complete(unsigned* bar, unsigned x, unsigned& nloc, unsigned& nx) {
    const unsigned G = gridDim.x * gridDim.y * gridDim.z;
    unsigned sum, cnt, mine, sp = 0u;
    for (;;) {
        sum = 0u; cnt = 0u; mine = 0u;
#pragma unroll
        for (unsigned j = 0; j < 16; ++j) { const unsigned c = xb_ld(&bar[XB_XCNT(j)]); sum += c; cnt += (c > 0u) ? 1u : 0u; mine = (j == x) ? c : mine; }
        if (sum == G) break;
        __builtin_amdgcn_s_sleep(1);
        if ((++sp & 255u) == 0u) { if (xb_ld(&bar[XB_TMO])) break; if (sp > XB_SPIN_CAP) { atomicAdd(&bar[XB_TMO], 1u); break; } }
    }
    nloc = mine > 0u ? mine : 1u; nx = cnt > 0u ? cnt : 1u;
}
__device__ __forceinline__ void xcd_barrier(const XcdBarrier& b) {
    asm volatile("s_waitcnt vmcnt(0)" ::: "memory");
    __syncthreads();
    if (threadIdx.x == 0) {
        unsigned* bar = b.bar;
        __builtin_amdgcn_s_waitcnt(0);
        unsigned nloc = b.st[0], nx = b.st[1];
        if (nloc == 0u) { xcd_barrier_complete(bar, b.x, nloc, nx); b.st[0] = nloc; b.st[1] = nx; }
        const unsigned old = xb_add(&bar[XB_XSUB(b.x)], 1u);
        const unsigned gen = old / nloc;
        if (old + 1u == (gen + 1u) * nloc) {
            __builtin_amdgcn_fence(__ATOMIC_RELEASE, "agent");
            asm volatile("s_waitcnt vmcnt(0)" ::: "memory");
            const unsigned og = xb_add(&bar[XB_TOP], 1u);
            const unsigned tg = og / nx;
            if (og + 1u == (tg + 1u) * nx) xb_add(&bar[XB_TOPGEN], 1u);
            else XB_SPIN(xb_ld(&bar[XB_TOPGEN]) == tg, bar);
            __builtin_amdgcn_fence(__ATOMIC_ACQUIRE, "agent");
            xb_add(&bar[XB_XGEN(b.x)], 1u);
            asm volatile("s_waitcnt vmcnt(0)" ::: "memory");
        } else {
            XB_SPIN(xb_ld(&bar[XB_XGEN(b.x)]) == gen, bar);
            __builtin_amdgcn_fence(__ATOMIC_ACQUIRE, "agent");
            asm volatile("s_waitcnt vmcnt(0)" ::: "memory");
        }
    }
    __syncthreads();
}

struct Args { const void* in[35]; float* out; unsigned char* ws; int ph_lo, ph_hi; };
struct Frame {
    LAS unsigned char* lds;
    int tid, lane, wave, vcu, G;
    const Args* a;
    unsigned char* ws;
};
#define INF(i) ((const float*)F.a->in[i])
#define WSP(T, off) ((T*)(F.ws + (off)))

__device__ __forceinline__ void tr_item(const float* W, int ldw, int Kvalid, int Nvalid, int k0, int n0, bf16_t* dst, int dpitch, int drow0, int dk0, LAS float* scr, int lane) {
    f32x4 v[16];
    const int nn = n0 + 4 * (lane & 15);
#pragma unroll
    for (int i = 0; i < 16; ++i) { const int kk = 4 * i + (lane >> 4);
        v[i] = (f32x4){0.f, 0.f, 0.f, 0.f};
        if (W != nullptr && (k0 + kk) < Kvalid && nn < Nvalid) v[i] = *(const GAS f32x4*)(W + (size_t)(k0 + kk) * ldw + nn); }
#pragma unroll
    for (int i = 0; i < 16; ++i) { const int kk = 4 * i + (lane >> 4);
        *(LAS f32x4*)(scr + kk * 64 + ((4 * (lane & 15)) ^ (4 * ((kk >> 3) & 7)))) = v[i]; }
    LDS_WAIT(); asm volatile("" ::: "memory");
    const int kc = lane & 7, nl = lane >> 3;
#pragma unroll
    for (int j = 0; j < 8; ++j) { const int n = 8 * j + nl; const LAS float* sp = scr + (8 * kc) * 64 + (n ^ (4 * kc));
        u32x4 o; o.x = pk2(sp[0 * 64], sp[1 * 64]); o.y = pk2(sp[2 * 64], sp[3 * 64]); o.z = pk2(sp[4 * 64], sp[5 * 64]); o.w = pk2(sp[6 * 64], sp[7 * 64]);
        *(GAS u32x4*)(dst + (size_t)(drow0 + n) * dpitch + dk0 + k0 + 8 * kc) = o; }
    LDS_WAIT(); asm volatile("" ::: "memory");
}

__device__ __forceinline__ void p0_phase(Frame& F) {
    const int tid = F.tid, lane = F.lane, wave = F.wave;
    {
        LAS float* cs = (LAS float*)(F.lds);
        LAS float* red = (LAS float*)(F.lds + 8192);
        const float* c = INF(1);
        for (int i = tid; i < 2048; i += NTHR) { const float v = c[i]; cs[i] = v / (1.0f + fexp(-v)); }
        __syncthreads();
        for (int cb = blockIdx.x; cb < 256; cb += F.G) {
            const int j = tid % 48, kg = tid / 48;
            const int col = cb * 48 + j, l = col / 6144, n = col % 6144;
            if (kg < 10) {
                const float* w = INF(3) + (size_t)l * 1024 * 6144 + n;
                float a0 = 0.f, a1 = 0.f;
#pragma unroll 4
                for (int k = kg; k < 1024; k += 10) { const float wv = w[(size_t)k * 6144]; a0 += cs[k] * wv; a1 += cs[1024 + k] * wv; }
                red[(kg * 48 + j) * 2] = a0; red[(kg * 48 + j) * 2 + 1] = a1;
            }
            __syncthreads();
            if (tid < 96) { const int jj = tid >> 1, b = tid & 1; float s = 0.f;
                for (int g = 0; g < 10; ++g) s += red[(g * 48 + jj) * 2 + b];
                const int col2 = cb * 48 + jj, l2 = col2 / 6144, n2 = col2 % 6144;
                WSP(float, WS_MOD)[(l2 * 2 + b) * 6144 + n2] = s + INF(4)[l2 * 6144 + n2]; }
            __syncthreads();
        }
    }
    {
        const int gw = F.vcu * NWAVES + wave, NGW = F.G * NWAVES;
        for (int l = 0; l < 2; ++l) {
            const float* w1 = INF(18) + l * 17 * 64; const float* w2 = INF(21) + l * 64 * 64;
            float w1c[17], w2c[64];
#pragma unroll
            for (int i = 0; i < 17; ++i) w1c[i] = w1[i * 64 + lane];
#pragma unroll
            for (int k = 0; k < 64; ++k) w2c[k] = w2[k * 64 + lane];
            const float b1 = INF(19)[l * 64 + lane], fr1 = INF(20)[l * 64 + lane], b2 = INF(22)[l * 64 + lane], fr2 = INF(23)[l * 64 + lane];
            for (int t = gw; t < SEQ; t += NGW) {
                const float tt = (float)t * (1.0f / SEQ);
                float a = b1 + tt * w1c[0];
#pragma unroll
                for (int bnd = 1; bnd <= 8; ++bnd) { float r = (float)((t * bnd) & (SEQ - 1)) * (1.0f / SEQ); a += sin_rev(r) * w1c[bnd] + cos_rev(r) * w1c[8 + bnd]; }
                const float h1 = sin_rad(fr1 * a);
                float a2 = b2;
#pragma unroll
                for (int k = 0; k < 64; ++k) a2 += __shfl(h1, k) * w2c[k];
                WSP(float, WS_HID)[((size_t)l * SEQ + t) * 64 + lane] = sin_rad(fr2 * a2);
            }
        }
    }
    {
        LAS float* scr = (LAS float*)(F.lds + wave * 16384);
        const int gw = F.vcu * NWAVES + wave, NGW = F.G * NWAVES;
        constexpr int I_WIN = 16 * 48, I_WOUT = 16 * 16, I_WMLA = 6 * 16, I_GU = 16 * 2 * 16 * 32, I_DN = 16 * 32 * 16;
        constexpr int I_LAYER = I_WIN + I_WOUT + I_WMLA + I_GU + I_DN;
        for (int it = gw; it < 2 * I_LAYER; it += NGW) {
            const int l = it / I_LAYER; int r = it % I_LAYER;
            if (r < I_WIN) { const int kb = r / 48, nb = r % 48;
                tr_item(INF(9) + (size_t)l * 1024 * DIN, DIN, 1024, DIN, kb * 64, nb * 64, WSP(bf16_t, WS_WIN) + (size_t)l * DINP * 1024, 1024, nb * 64, 0, scr, lane); continue; }
            r -= I_WIN;
            if (r < I_WOUT) { const int kb = r / 16, nb = r % 16;
                tr_item(INF(30) + (size_t)l * 1024 * 1024, 1024, 1024, 1024, kb * 64, nb * 64, WSP(bf16_t, WS_WOUT) + (size_t)l * 1024 * 1024, 1024, nb * 64, 0, scr, lane); continue; }
            r -= I_WOUT;
            if (r < I_WMLA) { const int kb = r / 16, nb = r % 16;
                bf16_t* dst = WSP(bf16_t, WS_WMLA) + (size_t)l * 1024 * 384;
                const float* W = nullptr; int ldw = 4, Kv = 0, Nv = 0, ksrc = 0, nsrc = 0;
                if (nb < 6 && kb < 4) { W = INF(13) + (size_t)l * 224 * 384; ldw = 384; Kv = 224; Nv = 384; ksrc = kb * 64; nsrc = nb * 64; }
                else if (nb >= 6 && nb < 10 && kb >= 4) { W = INF(14) + (size_t)l * 128 * 256; ldw = 256; Kv = 128; Nv = 256; ksrc = (kb - 4) * 64; nsrc = (nb - 6) * 64; }
                else if (nb >= 10 && nb < 14 && kb >= 4) { W = INF(15) + (size_t)l * 128 * 256; ldw = 256; Kv = 128; Nv = 256; ksrc = (kb - 4) * 64; nsrc = (nb - 10) * 64; }
                tr_item(W, ldw, Kv, Nv, ksrc, nsrc, dst, 384, nb * 64, kb * 64 - ksrc, scr, lane); continue; }
            r -= I_WMLA;
            if (r < I_GU) { const int e = r / (2 * 16 * 32); int q = r % (2 * 16 * 32); const int which = q / (16 * 32); q %= (16 * 32); const int kb = q / 32, nb = q % 32;
                const float* W = INF(which ? 33 : 32) + ((size_t)l * NEXP + e) * 1024 * 2048;
                const int n0 = nb * 64, drow = (n0 >> 7) * 256 + (n0 & 127) + (which ? 128 : 0);
                tr_item(W, 2048, 1024, 2048, kb * 64, n0, WSP(bf16_t, WS_WGU) + ((size_t)l * NEXP + e) * 4096 * 1024, 1024, drow, 0, scr, lane); continue; }
            r -= I_GU;
            { const int e = r / (32 * 16); const int q = r % (32 * 16); const int kb = q / 16, nb = q % 16;
                const float* W = INF(34) + ((size_t)l * NEXP + e) * 2048 * 1024;
                tr_item(W, 1024, 2048, 1024, kb * 64, nb * 64, WSP(bf16_t, WS_WDN) + ((size_t)l * NEXP + e) * 1024 * 2048, 2048, nb * 64, 0, scr, lane); }
        }
    }
}

__device__ __forceinline__ void ld_row_f32(const float* p, int lane, f32x4 (&v)[4]) {
    const GAS f32x4* r = (const GAS f32x4*)p + lane;
#pragma unroll
    for (int j = 0; j < 4; ++j) v[j] = r[64 * j];
}
__device__ __forceinline__ void st_row_f32(float* p, int lane, const f32x4 (&v)[4]) {
    GAS f32x4* r = (GAS f32x4*)p + lane;
#pragma unroll
    for (int j = 0; j < 4; ++j) r[64 * j] = v[j];
}
__device__ __forceinline__ void st_row_bf16(bf16_t* p, int lane, const f32x4 (&v)[4]) {
    GAS u32x2* r = (GAS u32x2*)p + lane;
#pragma unroll
    for (int j = 0; j < 4; ++j) { u32x2 w; w.x = pk2(v[j].x, v[j].y); w.y = pk2(v[j].z, v[j].w); r[64 * j] = w; }
}
__device__ __forceinline__ float row_ss(const f32x4 (&v)[4]) {
    float s = 0.f;
#pragma unroll
    for (int j = 0; j < 4; ++j) s += (v[j].x * v[j].x + v[j].y * v[j].y) + (v[j].z * v[j].z + v[j].w * v[j].w);
    return wave_sum(s);
}
__device__ __forceinline__ void modnorm(const f32x4 (&x)[4], const float* g, const float* sc, const float* sh, int lane, f32x4 (&h)[4]) {
    const float rstd = __builtin_amdgcn_rsqf(row_ss(x) * (1.0f / DM) + EPS);
    f32x4 gv[4], scv[4], shv[4];
    ld_row_f32(g, lane, gv); ld_row_f32(sc, lane, scv); ld_row_f32(sh, lane, shv);
#pragma unroll
    for (int j = 0; j < 4; ++j) h[j] = (x[j] * rstd) * gv[j] * (scv[j] + 1.0f) + shv[j];
}

__device__ __forceinline__ void filt_gemm_tile(Frame& F, int wt) {
    const int lane = F.lane, hi = lane >> 5, l31 = lane & 31;
    const int l = wt >> 11, r = wt & 2047, t0 = (r >> 3) * 32, col0 = (r & 7) * 128;
    f32x16 acc[4];
#pragma unroll
    for (int jb = 0; jb < 4; ++jb)
#pragma unroll
        for (int q = 0; q < 16; ++q) acc[jb][q] = 0.f;
    const float* hid = WSP(float, WS_HID) + ((size_t)l * SEQ + t0 + l31) * 64 + hi;
    const float* w3 = INF(24) + (size_t)l * 64 * 1024 + (size_t)hi * 1024 + col0 + l31;
#pragma unroll 4
    for (int s2 = 0; s2 < 32; ++s2) {
        const float bv = hid[2 * s2];
#pragma unroll
        for (int jb = 0; jb < 4; ++jb) { const float av = w3[(size_t)(2 * s2) * 1024 + 32 * jb]; acc[jb] = __builtin_amdgcn_mfma_f32_32x32x2f32(av, bv, acc[jb], 0, 0, 0); }
    }
    const float tt = (float)(t0 + l31) * (1.0f / SEQ);
    float* FT = WSP(float, WS_FILT) + (size_t)l * 1024 * SEQ + t0 + l31;
#pragma unroll
    for (int jb = 0; jb < 4; ++jb)
#pragma unroll
        for (int q = 0; q < 16; ++q) { const int col = col0 + 32 * jb + crow(q, hi);
            const float v = (acc[jb][q] + INF(25)[l * 1024 + col]) * fexp(-tt * fexp(INF(26)[l * 1024 + col]));
            FT[(size_t)col * SEQ] = v; }
}

__device__ __forceinline__ void p1_phase(Frame& F) {
    const int gw = F.vcu * NWAVES + F.wave, NGW = F.G * NWAVES;
    const float* mod = WSP(float, WS_MOD);
    for (int m = gw; m < MTOK; m += 2 * NGW) {
        const int m2 = (m + NGW < MTOK) ? m + NGW : m; f32x4 xa[4], xb[4], h[4];
        ld_row_f32(INF(0) + (size_t)m * DM, F.lane, xa); ld_row_f32(INF(0) + (size_t)m2 * DM, F.lane, xb);
        { const int b = m >> 13; modnorm(xa, INF(5), mod + (0 * 2 + b) * 6144 + 1024, mod + (0 * 2 + b) * 6144, F.lane, h); st_row_bf16(WSP(bf16_t, WS_XN) + (size_t)m * DM, F.lane, h); }
        { const int b = m2 >> 13; modnorm(xb, INF(5), mod + (0 * 2 + b) * 6144 + 1024, mod + (0 * 2 + b) * 6144, F.lane, h); st_row_bf16(WSP(bf16_t, WS_XN) + (size_t)m2 * DM, F.lane, h); }
    }
    for (int wt = gw; wt < 4096; wt += NGW) filt_gemm_tile(F, wt);
}

__device__ __forceinline__ float logsigmoid(float x) { return fminf(x, 0.f) - flog(1.0f + fexp(-fabsf(x))); }
struct MlItem { int b, h, dir, n, t0; };
__device__ __forceinline__ MlItem ml_decode(int item) { MlItem I; I.b = item >> 9; I.h = (item >> 7) & 3; I.dir = (item >> 6) & 1; I.n = item & 63;
    I.t0 = I.b * SEQ + (I.dir ? SEQ - 128 * (I.n + 1) : 128 * I.n); return I; }

__device__ __forceinline__ void ml_local_item(Frame& F, int item, int l) {
    const int tid = F.tid; const MlItem I = ml_decode(item);
    const bf16_t* U = WSP(bf16_t, WS_U);
    LAS float* EK = (LAS float*)(F.lds);
    LAS float* VV = (LAS float*)(F.lds + 32768);
    LAS float* LF = (LAS float*)(F.lds + 65536);
    LAS float* IG = LF + 128; LAS float* WW = LF + 256; LAS float* EST = LF + 384;
    const float* gb = INF(10) + l * 16;
    if (tid < 128) { const int j = tid, r = I.dir ? 127 - j : j; const size_t t = (size_t)(I.t0 + r);
        const float ipre = bf2f(U[t * DINP + U_MLG + (I.dir ? 2 : 0) * 4 + I.h]) + gb[(I.dir ? 2 : 0) * 4 + I.h];
        const float fpre = bf2f(U[t * DINP + U_MLG + (I.dir ? 3 : 1) * 4 + I.h]) + gb[(I.dir ? 3 : 1) * 4 + I.h];
        LF[j] = logsigmoid(fpre); IG[j] = ipre; }
    __syncthreads();
    float a = 0.f, aend = 0.f;
    if (tid < 128) { for (int i = 0; i < 128; ++i) { const float v = LF[i]; aend += v; if (i <= tid) a += v; }
        WW[tid] = aend - a + IG[tid]; }
    __syncthreads();
    float mloc = -3.0e38f;
    if (tid < 128) { for (int i = 0; i < 128; ++i) mloc = fmaxf(mloc, WW[i]);
        const int r = I.dir ? 127 - tid : tid; EST[r] = fexp(WW[tid] - mloc); }
    __syncthreads();
#pragma unroll
    for (int i = 0; i < 2; ++i) { const int p = tid + 512 * i, row = p >> 3, c8 = p & 7;
        const u32x4 kq = *(const GAS u32x4*)(U + (size_t)(I.t0 + row) * DINP + U_MLK + I.h * 64 + c8 * 8);
        const u32x4 vq = *(const GAS u32x4*)(U + (size_t)(I.t0 + row) * DINP + U_MLV + I.h * 64 + c8 * 8);
        const float es = EST[row] * 0.125f;
        LAS f32x4* ek = (LAS f32x4*)(EK + row * 64 + c8 * 8); LAS f32x4* vv = (LAS f32x4*)(VV + row * 64 + c8 * 8);
        ek[0] = (f32x4){bflo(kq.x) * es, bfhi(kq.x) * es, bflo(kq.y) * es, bfhi(kq.y) * es};
        ek[1] = (f32x4){bflo(kq.z) * es, bfhi(kq.z) * es, bflo(kq.w) * es, bfhi(kq.w) * es};
        vv[0] = (f32x4){bflo(vq.x), bfhi(vq.x), bflo(vq.y), bfhi(vq.y)};
        vv[1] = (f32x4){bflo(vq.z), bfhi(vq.z), bflo(vq.w), bfhi(vq.w)}; }
    __syncthreads();
    {
        const int d = tid >> 3, e0 = (tid & 7) * 8;
        f32x4 c0 = {0.f, 0.f, 0.f, 0.f}, c1 = {0.f, 0.f, 0.f, 0.f};
#pragma unroll 4
        for (int j = 0; j < 128; ++j) { const float ek = EK[j * 64 + d]; const f32x4 v0 = *(const LAS f32x4*)(VV + j * 64 + e0), v1 = *(const LAS f32x4*)(VV + j * 64 + e0 + 4);
            c0 += v0 * ek; c1 += v1 * ek; }
        GAS f32x4* dst = (GAS f32x4*)(WSP(float, WS_MLC) + (size_t)item * 4096 + d * 64 + e0);
        dst[0] = c0; dst[1] = c1;
        if (tid < 64) { float s = 0.f; for (int j = 0; j < 128; ++j) s += EK[j * 64 + tid]; WSP(float, WS_MLN)[item * 64 + tid] = s; }
        if (tid == 0) { WSP(float, WS_MLS)[item * 4] = mloc; WSP(float, WS_MLS)[item * 4 + 1] = aend; }
    }
    __syncthreads();
}

__device__ __forceinline__ void ml_scan(Frame& F) {
    float* MLC = WSP(float, WS_MLC); float* MLN = WSP(float, WS_MLN); float* MLS = WSP(float, WS_MLS);
    for (int blk = blockIdx.x; blk < 256; blk += F.G) { if (F.tid >= 260) continue; const int idx = blk * 260 + F.tid;
        const int seq = idx / 4160, el = idx % 4160;
        float* p0 = el < 4096 ? (MLC + (size_t)seq * 64 * 4096 + el) : (MLN + seq * 64 * 64 + (el - 4096));
        const int pstr = el < 4096 ? 4096 : 64;
        float mst = 0.f, st = 0.f;
#pragma unroll 1
        for (int n0 = 0; n0 < 64; n0 += 16) {
            float cl[16], mlv[16], aev[16];
#pragma unroll
            for (int i = 0; i < 16; ++i) { cl[i] = p0[(size_t)(n0 + i) * pstr]; mlv[i] = MLS[(seq * 64 + n0 + i) * 4]; aev[i] = MLS[(seq * 64 + n0 + i) * 4 + 1]; }
#pragma unroll
            for (int i = 0; i < 16; ++i) { const int item = seq * 64 + n0 + i;
                p0[(size_t)(n0 + i) * pstr] = st;
                if (el == 0) MLS[item * 4 + 2] = mst;
                const float mnew = fmaxf(aev[i] + mst, mlv[i]), sp = fexp(aev[i] + mst - mnew), sl = fexp(mlv[i] - mnew);
                st = sp * st + sl * cl[i]; mst = mnew; }
        }
    }
}

#define MFMA32(a, b, c) __builtin_amdgcn_mfma_f32_32x32x16_bf16((a), (b), (c), 0, 0, 0)
template <int NK>
__device__ __forceinline__ void qkt_tile(f32x16& p0, f32x16& p1, LAS const unsigned char* Kt, const bf16x8 (&qr)[NK], int r32, int hi) {
#pragma unroll
    for (int r = 0; r < 16; ++r) { p0[r] = 0.f; p1[r] = 0.f; }
#pragma unroll
    for (int d0 = 0; d0 < NK; ++d0) {
        const bf16x8 b0 = *(const LAS bf16x8*)(Kt + (2 * d0 + hi) * 1024 + r32 * 16);
        const bf16x8 b1 = *(const LAS bf16x8*)(Kt + (2 * d0 + hi) * 1024 + r32 * 16 + 512);
        p0 = MFMA32(b0, qr[d0], p0); p1 = MFMA32(b1, qr[d0], p1);
    }
}
typedef short v4i16_t __attribute__((ext_vector_type(4)));
__device__ __forceinline__ s16x4 vtr(LAS const unsigned char* p) { return __builtin_bit_cast(s16x4, __builtin_amdgcn_ds_read_tr16_b64_v4i16((LAS v4i16_t*)p)); }
__device__ __forceinline__ void pv_tile(f32x16 (&o)[2], LAS const unsigned char* Vt, const bf16x8 (&pa)[4], int lane) {
    const int hi = lane >> 5;
    LAS const unsigned char* vb = Vt + ((lane >> 4) & 1) * 32 + (lane & 3) * 8 + (4 * hi + ((lane & 15) >> 2)) * 64;
#pragma unroll
    for (int d0 = 0; d0 < 2; ++d0)
#pragma unroll
        for (int ks = 0; ks < 4; ++ks) {
            const s16x4 lo = vtr(vb + d0 * 4096 + ks * 1024), hh = vtr(vb + d0 * 4096 + ks * 1024 + 512);
            const bf16x8 vf = (bf16x8){lo[0], lo[1], lo[2], lo[3], hh[0], hh[1], hh[2], hh[3]};
            o[d0] = MFMA32(pa[ks], vf, o[d0]);
        }
}
__device__ __forceinline__ void pack_p(const f32x16& p0, const f32x16& p1, bf16x8 (&pa)[4]) {
    u32x4 w0, w1, w2, w3;
    w0 = (u32x4){pk2(p0[0], p0[1]), pk2(p0[2], p0[3]), pk2(p0[4], p0[5]), pk2(p0[6], p0[7])};
    w1 = (u32x4){pk2(p0[8], p0[9]), pk2(p0[10], p0[11]), pk2(p0[12], p0[13]), pk2(p0[14], p0[15])};
    w2 = (u32x4){pk2(p1[0], p1[1]), pk2(p1[2], p1[3]), pk2(p1[4], p1[5]), pk2(p1[6], p1[7])};
    w3 = (u32x4){pk2(p1[8], p1[9]), pk2(p1[10], p1[11]), pk2(p1[12], p1[13]), pk2(p1[14], p1[15])};
    pa[0] = __builtin_bit_cast(bf16x8, w0); pa[1] = __builtin_bit_cast(bf16x8, w1); pa[2] = __builtin_bit_cast(bf16x8, w2); pa[3] = __builtin_bit_cast(bf16x8, w3);
}

__device__ __forceinline__ void ml_local_pair(Frame& F, int pair, int l) {
    const int tid = F.tid, lane = F.lane, wid = F.wave, half = wid >> 2, wq = wid & 3, th = tid & 255, hi = lane >> 5;
    const int item = pair * 2 + half; const MlItem I = ml_decode(item);
    const bf16_t* U = WSP(bf16_t, WS_U);
    LAS unsigned char* base = F.lds + half * 49152;
    LAS unsigned char* EKI = base;
    LAS unsigned char* VI = base + 16384;
    LAS float* LF = (LAS float*)(base + 32768); LAS float* IG = LF + 128; LAS float* WW = LF + 256; LAS float* EST = LF + 384;
    const float* gb = INF(10) + l * 16;
    unsigned short graw_i = 0, graw_f = 0;
    if (th < 128) { const int r = I.dir ? 127 - th : th; const size_t t = (size_t)(I.t0 + r);
        graw_i = U[t * DINP + U_MLG + (I.dir ? 2 : 0) * 4 + I.h]; graw_f = U[t * DINP + U_MLG + (I.dir ? 3 : 1) * 4 + I.h]; }
    u32x4 kpc[4], vpc[4];
#pragma unroll
    for (int i = 0; i < 4; ++i) { const int p = th + 256 * i; const int tt = p >> 9, dh = (p >> 8) & 1, row = (p >> 2) & 63, c4 = p & 3, r = 64 * tt + row;
        const bf16_t* src = U + (size_t)(I.t0 + r) * DINP + I.h * 64 + dh * 32 + c4 * 8;
        kpc[i] = *(const GAS u32x4*)(src + U_MLK); vpc[i] = *(const GAS u32x4*)(src + U_MLV); }
    if (th < 128) { LF[th] = logsigmoid(bf2f(graw_f) + gb[(I.dir ? 3 : 1) * 4 + I.h]); IG[th] = bf2f(graw_i) + gb[(I.dir ? 2 : 0) * 4 + I.h]; }
    __syncthreads();
    float a = 0.f, aend = 0.f;
    if (th < 128) { for (int i = 0; i < 128; ++i) { const float v = LF[i]; aend += v; if (i <= th) a += v; }
        WW[th] = aend - a + IG[th]; }
    __syncthreads();
    float mloc = -3.0e38f;
    if (th < 128) { for (int i = 0; i < 128; ++i) mloc = fmaxf(mloc, WW[i]);
        const int r = I.dir ? 127 - th : th; EST[r] = fexp(WW[th] - mloc) * 0.125f; }
    __syncthreads();
#pragma unroll
    for (int i = 0; i < 4; ++i) { const int p = th + 256 * i; const int tt = p >> 9, dh = (p >> 8) & 1, row = (p >> 2) & 63, c4 = p & 3, r = 64 * tt + row;
        const u32x4 kq = kpc[i];
        const float es = EST[r];
        u32x4 ek; ek.x = pk2(bflo(kq.x) * es, bfhi(kq.x) * es); ek.y = pk2(bflo(kq.y) * es, bfhi(kq.y) * es); ek.z = pk2(bflo(kq.z) * es, bfhi(kq.z) * es); ek.w = pk2(bflo(kq.w) * es, bfhi(kq.w) * es);
        const int off = tt * 8192 + dh * 4096 + row * 64 + c4 * 16;
        *(LAS u32x4*)(EKI + off) = ek; *(LAS u32x4*)(VI + off) = vpc[i]; }
    __syncthreads();
    {
        const int da = wq >> 1, eb = wq & 1;
        f32x16 acc;
#pragma unroll
        for (int r = 0; r < 16; ++r) acc[r] = 0.f;
        const int lo_off = ((lane >> 4) & 1) * 32 + (lane & 3) * 8 + (4 * hi + ((lane & 15) >> 2)) * 64;
#pragma unroll
        for (int tt = 0; tt < 2; ++tt)
#pragma unroll
            for (int ks = 0; ks < 4; ++ks) {
                LAS const unsigned char* ap = EKI + tt * 8192 + da * 4096 + lo_off + ks * 1024; LAS const unsigned char* bp = VI + tt * 8192 + eb * 4096 + lo_off + ks * 1024;
                const s16x4 a0 = vtr(ap), a1 = vtr(ap + 512), b0 = vtr(bp), b1 = vtr(bp + 512);
                const bf16x8 af = (bf16x8){a0[0], a0[1], a0[2], a0[3], a1[0], a1[1], a1[2], a1[3]}, bf = (bf16x8){b0[0], b0[1], b0[2], b0[3], b1[0], b1[1], b1[2], b1[3]};
                acc = MFMA32(af, bf, acc); }
        float* dst = WSP(float, WS_MLC) + (size_t)item * 4096 + eb * 32 + (lane & 31);
#pragma unroll
        for (int r = 0; r < 16; ++r) dst[(da * 32 + crow(r, hi)) * 64] = acc[r];
        if (th < 64) { const int dh = th >> 5, col = th & 31; float sacc = 0.f;
            for (int tt = 0; tt < 2; ++tt) for (int row = 0; row < 64; ++row) sacc += bf2f(*(const LAS unsigned short*)(EKI + tt * 8192 + dh * 4096 + row * 64 + col * 2));
            WSP(float, WS_MLN)[item * 64 + th] = sacc; }
        if (th == 0) { WSP(float, WS_MLS)[item * 4] = mloc; WSP(float, WS_MLS)[item * 4 + 1] = aend; }
    }
    __syncthreads();
}

__device__ __forceinline__ void ml_out_pair(Frame& F, int pair, int l) {
    const int tid = F.tid, lane = F.lane, wid = F.wave, half = wid >> 2, wq = wid & 3, th = tid & 255, r32 = lane & 31, hi = lane >> 5;
    const int item = pair * 2 + half; const MlItem I = ml_decode(item);
    const bf16_t* U = WSP(bf16_t, WS_U);
    LAS unsigned char* base = F.lds + half * 49152;
    LAS unsigned char* KI = base;
    LAS unsigned char* VI = base + 16384;
    LAS unsigned char* CT = base + 32768;
    LAS float* vec = (LAS float*)(base + 32768 + 9216);
    LAS float* LF = vec; LAS float* IG = vec + 128; LAS float* BL = vec + 256; LAS float* SA = vec + 384; LAS float* SCI = vec + 512; LAS float* EDEN = vec + 640;
    LAS float* NPV = vec + 768; LAS float* wsf = vec + 832 + wq * 64;
    const float* gb = INF(10) + l * 16;
    unsigned short graw_i = 0, graw_f = 0; float mprev = 0.f;
    if (th < 128) { const int r = I.dir ? 127 - th : th; const size_t t = (size_t)(I.t0 + r);
        graw_i = U[t * DINP + U_MLG + (I.dir ? 2 : 0) * 4 + I.h]; graw_f = U[t * DINP + U_MLG + (I.dir ? 3 : 1) * 4 + I.h];
        mprev = WSP(float, WS_MLS)[item * 4 + 2]; }
    u32x4 kpc[4], vpc[4];
#pragma unroll
    for (int i = 0; i < 4; ++i) { const int p = th + 256 * i;
        { const int tt = p >> 9, c = (p >> 6) & 7, kv = p & 63, j = 64 * tt + kv, r = I.dir ? 127 - j : j;
          kpc[i] = *(const GAS u32x4*)(U + (size_t)(I.t0 + r) * DINP + U_MLK + I.h * 64 + c * 8); }
        { const int tt = p >> 9, dh = (p >> 8) & 1, kv = (p >> 2) & 63, c4 = p & 3, j = 64 * tt + kv, r = I.dir ? 127 - j : j;
          vpc[i] = *(const GAS u32x4*)(U + (size_t)(I.t0 + r) * DINP + U_MLV + I.h * 64 + dh * 32 + c4 * 8); } }
    float cpv[16];
    { const float* cp = WSP(float, WS_MLC) + (size_t)item * 4096;
#pragma unroll
      for (int i = 0; i < 16; ++i) cpv[i] = cp[th + 256 * i]; }
    const float npv = (th < 64) ? WSP(float, WS_MLN)[item * 64 + th] : 0.f;
    const int q = 32 * wq + r32;
    const int rq = I.dir ? 127 - q : q;
    bf16x8 qr[4];
    { const bf16_t* qp = U + (size_t)(I.t0 + rq) * DINP + U_MLQ + I.h * 64 + hi * 8;
#pragma unroll
      for (int d0 = 0; d0 < 4; ++d0) qr[d0] = *(const GAS bf16x8*)(qp + d0 * 16); }
    if (th < 128) { LF[th] = logsigmoid(bf2f(graw_f) + gb[(I.dir ? 3 : 1) * 4 + I.h]); IG[th] = bf2f(graw_i) + gb[(I.dir ? 2 : 0) * 4 + I.h]; }
#pragma unroll
    for (int i = 0; i < 4; ++i) { const int p = th + 256 * i;
        { const int tt = p >> 9, c = (p >> 6) & 7, kv = p & 63; *(LAS u32x4*)(KI + tt * 8192 + c * 1024 + kv * 16) = kpc[i]; }
        { const int tt = p >> 9, dh = (p >> 8) & 1, kv = (p >> 2) & 63, c4 = p & 3; *(LAS u32x4*)(VI + tt * 8192 + dh * 4096 + kv * 64 + c4 * 16) = vpc[i]; } }
#pragma unroll
    for (int i = 0; i < 16; ++i) { const int idx = th + 256 * i, d = idx >> 6, e = idx & 63;
        *(LAS unsigned short*)(CT + e * 144 + d * 2) = (unsigned short)(pk2(cpv[i], 0.f) & 0xffffu); }
    if (th < 64) NPV[th] = npv;
    __syncthreads();
    float a = 0.f;
    if (th < 128) { for (int i = 0; i <= th; ++i) a += LF[i]; BL[th] = IG[th] - a; }
    __syncthreads();
    if (th < 128) { float bm = -3.0e38f; for (int i = 0; i <= th; ++i) bm = fmaxf(bm, BL[i]);
        const float mt = a + fmaxf(mprev, bm);
        SA[th] = (a - mt) * LOG2E; SCI[th] = fexp(a + mprev - mt); EDEN[th] = fexp(-mt); }
    __syncthreads();
    if (th < 128) BL[th] = BL[th] * LOG2E;
    __syncthreads();
    {
        f32x16 o[2];
#pragma unroll
        for (int r = 0; r < 16; ++r) { o[0][r] = 0.f; o[1][r] = 0.f; }
        const float saq = SA[q], scq = SCI[q];
        float den = 0.f;
        for (int tt = 0; tt < 2; ++tt) {
            if (64 * tt > 32 * wq + 31) break;
            f32x16 p0, p1;
            qkt_tile<4>(p0, p1, KI + tt * 8192, qr, r32, hi);
#pragma unroll
            for (int g = 0; g < 4; ++g) {
                const f32x4 b0 = *(const LAS f32x4*)(BL + 64 * tt + 8 * g + 4 * hi), b1 = *(const LAS f32x4*)(BL + 64 * tt + 32 + 8 * g + 4 * hi);
#pragma unroll
                for (int i = 0; i < 4; ++i) { const int r = 4 * g + i; const int kv0 = 64 * tt + 8 * g + 4 * hi + i, kv1 = kv0 + 32;
                    const float e0 = (kv0 <= q) ? __builtin_amdgcn_exp2f(saq + b0[i]) * 0.125f : 0.f, e1 = (kv1 <= q) ? __builtin_amdgcn_exp2f(saq + b1[i]) * 0.125f : 0.f;
                    p0[r] *= e0; p1[r] *= e1; den += p0[r] + p1[r]; }
            }
            bf16x8 pa[4]; pack_p(p0, p1, pa);
            pv_tile(o, VI + tt * 8192, pa, lane);
        }
        float dot = 0.f;
#pragma unroll
        for (int ks = 0; ks < 4; ++ks) {
            const u32x4 qw = __builtin_bit_cast(u32x4, qr[ks]);
            const f32x4 n0 = *(const LAS f32x4*)(NPV + 16 * ks + 8 * hi), n1 = *(const LAS f32x4*)(NPV + 16 * ks + 8 * hi + 4);
            const float q0 = bflo(qw.x), q1 = bfhi(qw.x), q2 = bflo(qw.y), q3 = bfhi(qw.y), q4 = bflo(qw.z), q5 = bfhi(qw.z), q6 = bflo(qw.w), q7 = bfhi(qw.w);
            dot += q0 * n0[0] + q1 * n0[1] + q2 * n0[2] + q3 * n0[3] + q4 * n1[0] + q5 * n1[1] + q6 * n1[2] + q7 * n1[3];
            const u32x4 sw = (u32x4){pk2(q0 * scq, q1 * scq), pk2(q2 * scq, q3 * scq), pk2(q4 * scq, q5 * scq), pk2(q6 * scq, q7 * scq)};
            const bf16x8 qs = __builtin_bit_cast(bf16x8, sw);
#pragma unroll
            for (int de = 0; de < 2; ++de) {
                const bf16x8 cf = *(const LAS bf16x8*)(CT + (de * 32 + r32) * 144 + (16 * ks + 8 * hi) * 2);
                o[de] = MFMA32(qs, cf, o[de]);
            }
        }
        den += scq * dot;
        den += __shfl_xor(den, 32);
        const float rinv = 1.0f / fmaxf(fabsf(den), EDEN[q]);
        if (hi == 0) wsf[r32] = rinv;
        LDS_WAIT();
        float* dst = WSP(float, I.dir ? WS_HB : WS_HF);
#pragma unroll
        for (int r = 0; r < 16; ++r) { const int jq = 32 * wq + crow(r, hi), row = I.dir ? 127 - jq : jq; const float rr = wsf[crow(r, hi)];
            float* dp = dst + (size_t)(I.t0 + row) * 256 + I.h * 64 + r32;
            dp[0] = o[0][r] * rr; dp[32] = o[1][r] * rr; }
    }
    __syncthreads();
}

__device__ __forceinline__ void mla_prep_rows(Frame& F, int l) {
    const int gw = F.vcu * NWAVES + F.wave, NGW = F.G * NWAVES, lane = F.lane;
    const bf16_t* U = WSP(bf16_t, WS_U); bf16_t* A = WSP(bf16_t, WS_AMLA);
    f32x4 gq = {0.f, 0.f, 0.f, 0.f}; if (lane < 56) gq = *(const GAS f32x4*)(INF(11) + l * 224 + 4 * lane);
    const f32x2 gk = *(const GAS f32x2*)(INF(12) + l * 128 + 2 * lane);
    for (int m0 = gw; m0 < MTOK; m0 += 4 * NGW) {
        u32x2 qw[4]; unsigned kw[4];
#pragma unroll
        for (int r = 0; r < 4; ++r) { const int m = m0 + r * NGW; const bf16_t* ur = U + (size_t)(m < MTOK ? m : 0) * DINP;
            qw[r] = (u32x2){0u, 0u}; if (lane < 56) qw[r] = *(const GAS u32x2*)(ur + U_CQ + 4 * lane);
            kw[r] = *(const GAS unsigned*)(ur + U_CKV + 2 * lane); }
#pragma unroll
        for (int r = 0; r < 4; ++r) { const int m = m0 + r * NGW; if (m >= MTOK) break;
            const float q0 = bflo(qw[r].x), q1 = bfhi(qw[r].x), q2 = bflo(qw[r].y), q3 = bfhi(qw[r].y), k0 = bflo(kw[r]), k1 = bfhi(kw[r]);
            const float rq = __builtin_amdgcn_rsqf(wave_sum(q0 * q0 + q1 * q1 + q2 * q2 + q3 * q3) * (1.0f / 224.0f) + EPS);
            const float rk = __builtin_amdgcn_rsqf(wave_sum(k0 * k0 + k1 * k1) * (1.0f / 128.0f) + EPS);
            bf16_t* ar = A + (size_t)m * 384;
            u32x2 qo; qo.x = pk2(q0 * rq * gq.x, q1 * rq * gq.y); qo.y = pk2(q2 * rq * gq.z, q3 * rq * gq.w);
            *(GAS u32x2*)(ar + 4 * lane) = qo;
            *(GAS unsigned*)(ar + 256 + 2 * lane) = pk2(k0 * rk * gk.x, k1 * rk * gk.y); }
    }
}

__device__ __forceinline__ double rope_k(int i) {
    switch (i) { case 0: return 0.15915494309189535; case 1: return 0.08949940160889101; case 2: return 0.050329212104487035; case 3: return 0.0283021958306234;
        case 4: return 0.015915494309189534; case 5: return 0.008949940160889102; case 6: return 0.005032921210448704; case 7: return 0.00283021958306234;
        case 8: return 0.0015915494309189536; case 9: return 0.0008949940160889102; case 10: return 0.0005032921210448703; case 11: return 0.00028302195830623395;
        case 12: return 0.00015915494309189535; case 13: return 8.949940160889102e-05; case 14: return 5.0329212104487035e-05; default: return 2.8302195830623396e-05; }
}
__device__ __forceinline__ void rope_cs(int pos, int i, float& c, float& s) {
    double rev = (double)pos * rope_k(i);
    rev -= __builtin_floor(rev);
    const float r = (float)rev;
    c = cos_rev(r); s = sin_rev(r);
}
__device__ __forceinline__ void relayout_phase(Frame& F) {
    const bf16_t* O = WSP(bf16_t, WS_OMLA); const bf16_t* U = WSP(bf16_t, WS_U);
    const int* pos = (const int*)F.a->in[2];
    const float qscale = 0.10206207261596577f * LOG2E;
    for (int idx = blockIdx.x * NTHR + F.tid; idx < MTOK * 4; idx += F.G * NTHR) {
        const int t = idx >> 2, h = idx & 3, b = t >> 13, s = t & 8191, bh = b * 4 + h;
        const int p = pos[t];
        float cs[16], sn[16];
#pragma unroll
        for (int i = 0; i < 16; ++i) rope_cs(p, i, cs[i], sn[i]);
        const bf16_t* qsrc = O + (size_t)t * 1024 + h * 96;
        bf16_t* qdst = WSP(bf16_t, WS_Q) + ((size_t)bh * SEQ + s) * 96;
#pragma unroll
        for (int c = 0; c < 8; ++c) { const u32x4 w = *(const GAS u32x4*)(qsrc + c * 8);
            u32x4 o; o.x = pk2(bflo(w.x) * qscale, bfhi(w.x) * qscale); o.y = pk2(bflo(w.y) * qscale, bfhi(w.y) * qscale); o.z = pk2(bflo(w.z) * qscale, bfhi(w.z) * qscale); o.w = pk2(bflo(w.w) * qscale, bfhi(w.w) * qscale);
            *(GAS u32x4*)(qdst + c * 8) = o; }
        {
            float x1[16], x2[16];
#pragma unroll
            for (int c = 0; c < 2; ++c) { const u32x4 w = *(const GAS u32x4*)(qsrc + 64 + c * 8); const u32x4 v = *(const GAS u32x4*)(qsrc + 80 + c * 8);
                x1[c * 8 + 0] = bflo(w.x); x1[c * 8 + 1] = bfhi(w.x); x1[c * 8 + 2] = bflo(w.y); x1[c * 8 + 3] = bfhi(w.y); x1[c * 8 + 4] = bflo(w.z); x1[c * 8 + 5] = bfhi(w.z); x1[c * 8 + 6] = bflo(w.w); x1[c * 8 + 7] = bfhi(w.w);
                x2[c * 8 + 0] = bflo(v.x); x2[c * 8 + 1] = bfhi(v.x); x2[c * 8 + 2] = bflo(v.y); x2[c * 8 + 3] = bfhi(v.y); x2[c * 8 + 4] = bflo(v.z); x2[c * 8 + 5] = bfhi(v.z); x2[c * 8 + 6] = bflo(v.w); x2[c * 8 + 7] = bfhi(v.w); }
#pragma unroll
            for (int c = 0; c < 2; ++c) { u32x4 o1, o2;
#define RQ1(i) ((x1[i] * cs[i] - x2[i] * sn[i]) * qscale)
#define RQ2(i) ((x2[i] * cs[i] + x1[i] * sn[i]) * qscale)
                o1.x = pk2(RQ1(c * 8 + 0), RQ1(c * 8 + 1)); o1.y = pk2(RQ1(c * 8 + 2), RQ1(c * 8 + 3)); o1.z = pk2(RQ1(c * 8 + 4), RQ1(c * 8 + 5)); o1.w = pk2(RQ1(c * 8 + 6), RQ1(c * 8 + 7));
                o2.x = pk2(RQ2(c * 8 + 0), RQ2(c * 8 + 1)); o2.y = pk2(RQ2(c * 8 + 2), RQ2(c * 8 + 3)); o2.z = pk2(RQ2(c * 8 + 4), RQ2(c * 8 + 5)); o2.w = pk2(RQ2(c * 8 + 6), RQ2(c * 8 + 7));
                *(GAS u32x4*)(qdst + 64 + c * 8) = o1; *(GAS u32x4*)(qdst + 80 + c * 8) = o2; }
#undef RQ1
#undef RQ2
        }
        bf16_t* kdst = WSP(bf16_t, WS_KIMG) + ((size_t)bh * 128 + (s >> 6)) * 6144 + (s & 63) * 8;
        const bf16_t* ksrc = O + (size_t)t * 1024 + 384 + h * 64;
#pragma unroll
        for (int c = 0; c < 8; ++c) *(GAS u32x4*)(kdst + c * 512) = *(const GAS u32x4*)(ksrc + c * 8);
        {
            const bf16_t* krs = U + (size_t)t * DINP + U_KR;
            float x1[16], x2[16];
#pragma unroll
            for (int c = 0; c < 2; ++c) { const u32x4 w = *(const GAS u32x4*)(krs + c * 8); const u32x4 v = *(const GAS u32x4*)(krs + 16 + c * 8);
                x1[c * 8 + 0] = bflo(w.x); x1[c * 8 + 1] = bfhi(w.x); x1[c * 8 + 2] = bflo(w.y); x1[c * 8 + 3] = bfhi(w.y); x1[c * 8 + 4] = bflo(w.z); x1[c * 8 + 5] = bfhi(w.z); x1[c * 8 + 6] = bflo(w.w); x1[c * 8 + 7] = bfhi(w.w);
                x2[c * 8 + 0] = bflo(v.x); x2[c * 8 + 1] = bfhi(v.x); x2[c * 8 + 2] = bflo(v.y); x2[c * 8 + 3] = bfhi(v.y); x2[c * 8 + 4] = bflo(v.z); x2[c * 8 + 5] = bfhi(v.z); x2[c * 8 + 6] = bflo(v.w); x2[c * 8 + 7] = bfhi(v.w); }
#pragma unroll
            for (int c = 0; c < 2; ++c) { u32x4 o1, o2;
#define RK1(i) (x1[i] * cs[i] - x2[i] * sn[i])
#define RK2(i) (x2[i] * cs[i] + x1[i] * sn[i])
                o1.x = pk2(RK1(c * 8 + 0), RK1(c * 8 + 1)); o1.y = pk2(RK1(c * 8 + 2), RK1(c * 8 + 3)); o1.z = pk2(RK1(c * 8 + 4), RK1(c * 8 + 5)); o1.w = pk2(RK1(c * 8 + 6), RK1(c * 8 + 7));
                o2.x = pk2(RK2(c * 8 + 0), RK2(c * 8 + 1)); o2.y = pk2(RK2(c * 8 + 2), RK2(c * 8 + 3)); o2.z = pk2(RK2(c * 8 + 4), RK2(c * 8 + 5)); o2.w = pk2(RK2(c * 8 + 6), RK2(c * 8 + 7));
                *(GAS u32x4*)(kdst + (8 + c) * 512) = o1; *(GAS u32x4*)(kdst + (10 + c) * 512) = o2; }
#undef RK1
#undef RK2
        }
        bf16_t* vdst = WSP(bf16_t, WS_VIMG) + ((size_t)bh * 128 + (s >> 6)) * 4096 + (s & 63) * 32;
        const bf16_t* vsrc = O + (size_t)t * 1024 + 640 + h * 64;
#pragma unroll
        for (int c = 0; c < 8; ++c) *(GAS u32x4*)(vdst + (c >> 2) * 2048 + (c & 3) * 8) = *(const GAS u32x4*)(vsrc + c * 8);
    }
}

__device__ __forceinline__ void attn_unit(Frame& F, int bh, int qb) {
    const int tid = F.tid, lane = F.lane, wid = F.wave, r32 = lane & 31, hi = lane >> 5;
    LAS unsigned char* KB = F.lds;
    LAS unsigned char* VB = F.lds + 24576;
    LAS float* wsf = (LAS float*)(F.lds + 40960) + wid * 64;
    const int b = bh >> 2, h = bh & 3;
    const bf16_t* Qp = WSP(bf16_t, WS_Q) + ((size_t)bh * SEQ + qb * 256 + wid * 32 + r32) * 96 + hi * 8;
    bf16x8 qr[6];
#pragma unroll
    for (int d0 = 0; d0 < 6; ++d0) qr[d0] = *(const GAS bf16x8*)(Qp + d0 * 16);
    const GAS u32x4* Kg = (const GAS u32x4*)(WSP(bf16_t, WS_KIMG) + (size_t)bh * 128 * 6144);
    const GAS u32x4* Vg = (const GAS u32x4*)(WSP(bf16_t, WS_VIMG) + (size_t)bh * 128 * 4096);
    const bool kx = tid < 256;
    u32x4 k0 = Kg[tid], k1 = kx ? Kg[512 + tid] : (u32x4){0u, 0u, 0u, 0u}, v0 = Vg[tid];
    u32x4 k2 = Kg[768 + tid], k3 = kx ? Kg[768 + 512 + tid] : (u32x4){0u, 0u, 0u, 0u};
    *(LAS u32x4*)(KB + tid * 16) = k0; if (kx) *(LAS u32x4*)(KB + (512 + tid) * 16) = k1; *(LAS u32x4*)(VB + tid * 16) = v0;
    *(LAS u32x4*)(KB + 12288 + tid * 16) = k2; if (kx) *(LAS u32x4*)(KB + 12288 + (512 + tid) * 16) = k3;
    __syncthreads();
    f32x16 s0, s1;
    qkt_tile<6>(s0, s1, KB, qr, r32, hi);
    __syncthreads();
    f32x16 o[2]; float lsum = 0.f;
#pragma unroll
    for (int r = 0; r < 16; ++r) { o[0][r] = 0.f; o[1][r] = 0.f; }
    float m;
    { float rm = fmaxf(fmaxf(s0[0], s1[0]), fmaxf(s0[1], s1[1]));
#pragma unroll
      for (int r = 2; r < 16; r += 2) rm = fmaxf(fmaxf(rm, s0[r]), fmaxf(s1[r], fmaxf(s0[r + 1], s1[r + 1])));
      m = fmaxf(rm, __shfl_xor(rm, 32));
#pragma unroll
      for (int r = 0; r < 16; ++r) { s0[r] -= m; s1[r] -= m; } }
    LAS const unsigned char* vbl = VB + ((lane >> 4) & 1) * 32 + (lane & 3) * 8 + (4 * hi + ((lane & 15) >> 2)) * 64;
    u32x4 kb0 = Kg[2 * 768 + tid], kb1 = kx ? Kg[2 * 768 + 512 + tid] : (u32x4){0u, 0u, 0u, 0u}, vb0 = Vg[512 + tid];
#define ATT_ITER(T, LK0, LK1, LV, WK0, WK1, WV) do { \
        const int t = (T); const int cur = t & 1; \
        const int tv = (t + 2 < 128) ? t + 2 : 127, tk = (t + 3 < 128) ? t + 3 : 127; \
        LK0 = Kg[tk * 768 + tid]; if (kx) LK1 = Kg[tk * 768 + 512 + tid]; \
        LV = Vg[tv * 512 + tid]; \
        LAS const unsigned char* Kt = KB + (cur ^ 1) * 12288 + hi * 1024 + r32 * 16; \
        bf16x8 kf[12]; \
        _Pragma("unroll") for (int d0 = 0; d0 < 6; ++d0) { kf[2 * d0] = *(const LAS bf16x8*)(Kt + d0 * 2048); kf[2 * d0 + 1] = *(const LAS bf16x8*)(Kt + d0 * 2048 + 512); } \
        _Pragma("unroll") for (int r = 0; r < 16; ++r) { s0[r] = __builtin_amdgcn_exp2f(s0[r]); s1[r] = __builtin_amdgcn_exp2f(s1[r]); } \
        { float ls_ = 0.f; _Pragma("unroll") for (int r = 0; r < 16; ++r) ls_ += s0[r] + s1[r]; lsum += ls_; } \
        bf16x8 pa[4]; pack_p(s0, s1, pa); \
        f32x16 n0, n1; { const float nm_ = -m; _Pragma("unroll") for (int r = 0; r < 16; ++r) { n0[r] = nm_; n1[r] = nm_; } } \
        n0 = MFMA32(kf[0], qr[0], n0); n1 = MFMA32(kf[1], qr[0], n1); \
        _Pragma("unroll") for (int d0 = 1; d0 < 6; ++d0) { n0 = MFMA32(kf[2 * d0], qr[d0], n0); n1 = MFMA32(kf[2 * d0 + 1], qr[d0], n1); } \
        LAS const unsigned char* vb = vbl + cur * 8192; \
        _Pragma("unroll") for (int ks = 0; ks < 4; ++ks) { \
            _Pragma("unroll") for (int d0 = 0; d0 < 2; ++d0) { \
                const s16x4 lo = vtr(vb + d0 * 4096 + ks * 1024), hh = vtr(vb + d0 * 4096 + ks * 1024 + 512); \
                const bf16x8 vf = (bf16x8){lo[0], lo[1], lo[2], lo[3], hh[0], hh[1], hh[2], hh[3]}; \
                o[d0] = MFMA32(pa[ks], vf, o[d0]); } } \
        float rm = fmaxf(fmaxf(n0[0], n1[0]), fmaxf(n0[1], n1[1])); \
        _Pragma("unroll") for (int r = 2; r < 16; r += 2) rm = fmaxf(fmaxf(rm, n0[r]), fmaxf(n1[r], fmaxf(n0[r + 1], n1[r + 1]))); \
        rm = fmaxf(rm, __shfl_xor(rm, 32)); \
        _Pragma("unroll") for (int i = 0; i < 12; ++i) { __builtin_amdgcn_sched_group_barrier(0x008, 1, 0); __builtin_amdgcn_sched_group_barrier(0x002, 7, 0); } \
        if (__any(rm > 8.0f)) { \
            const float dl = fmaxf(rm, 0.f), f = __builtin_amdgcn_exp2f(-dl); \
            m += dl; lsum *= f; \
            _Pragma("unroll") for (int r = 0; r < 16; ++r) { n0[r] -= dl; n1[r] -= dl; } \
            if (hi == 0) wsf[r32] = f; \
            LDS_WAIT(); \
            _Pragma("unroll") for (int r = 0; r < 16; ++r) { const float fr = wsf[crow(r, hi)]; o[0][r] *= fr; o[1][r] *= fr; } \
        } \
        *(LAS u32x4*)(KB + cur * 12288 + tid * 16) = WK0; if (kx) *(LAS u32x4*)(KB + cur * 12288 + (512 + tid) * 16) = WK1; \
        *(LAS u32x4*)(VB + (cur ^ 1) * 8192 + tid * 16) = WV; \
        __syncthreads(); \
        s0 = n0; s1 = n1; } while (0)
#pragma unroll 1
    for (int t2 = 0; t2 < 128; t2 += 2) {
        ATT_ITER(t2, k0, k1, v0, kb0, kb1, vb0);
        ATT_ITER(t2 + 1, kb0, kb1, vb0, k0, k1, v0);
    }
#undef ATT_ITER
    lsum += __shfl_xor(lsum, 32);
    if (hi == 0) wsf[r32] = 1.0f / lsum;
    LDS_WAIT();
    bf16_t* Y = WSP(bf16_t, WS_YATT);
#pragma unroll
    for (int r = 0; r < 16; ++r) { const float rl = wsf[crow(r, hi)]; const int q = qb * 256 + wid * 32 + crow(r, hi);
        bf16_t* yp = Y + ((size_t)b * SEQ + q) * 256 + h * 64 + r32;
        yp[0] = (bf16_t)(pk2(o[0][r] * rl, 0.f) & 0xffffu); yp[32] = (bf16_t)(pk2(o[1][r] * rl, 0.f) & 0xffffu); }
    __syncthreads();
}

#define PX(e) ((e) + ((e) >> 5))
__device__ __forceinline__ f32x2 cmul(f32x2 a, float c, float s) { return (f32x2){a.x * c - a.y * s, a.x * s + a.y * c}; }
__device__ __forceinline__ void bf4_fwd(f32x2& x0, f32x2& x1, f32x2& x2, f32x2& x3, float c1, float s1) {
    const float c2 = c1 * c1 - s1 * s1, s2 = 2.0f * c1 * s1, c3 = c2 * c1 - s2 * s1, s3 = c2 * s1 + s2 * c1;
    const f32x2 a = x0 + x2, b = x0 - x2, c = x1 + x3, d = x1 - x3;
    x0 = a + c;
    x1 = cmul((f32x2){b.x + d.y, b.y - d.x}, c1, s1);
    x2 = cmul(a - c, c2, s2);
    x3 = cmul((f32x2){b.x - d.y, b.y + d.x}, c3, s3);
}
__device__ __forceinline__ void bf4_inv(f32x2& x0, f32x2& x1, f32x2& x2, f32x2& x3, float c1, float s1) {
    const float c2 = c1 * c1 - s1 * s1, s2 = 2.0f * c1 * s1, c3 = c2 * c1 - s2 * s1, s3 = c2 * s1 + s2 * c1;
    const f32x2 t1 = cmul(x1, c1, s1), t2 = cmul(x2, c2, s2), t3 = cmul(x3, c3, s3);
    const f32x2 a = x0 + t2, b = x0 - t2, c = t1 + t3, d = t1 - t3;
    x0 = a + c; x2 = a - c;
    x1 = (f32x2){b.x - d.y, b.y + d.x};
    x3 = (f32x2){b.x + d.y, b.y - d.x};
}
template <bool INV>
__device__ __forceinline__ void fft_r4_last(LAS f32x2* X, int tid) {
#pragma unroll 2
    for (int i = 0; i < 8; ++i) { int base = 4 * (tid + 512 * i); asm volatile("" : "+v"(base));
        f32x2 x0 = X[PX(base)], x1 = X[PX(base + 1)], x2 = X[PX(base + 2)], x3 = X[PX(base + 3)];
        if (!INV) bf4_fwd(x0, x1, x2, x3, 1.0f, 0.0f); else bf4_inv(x0, x1, x2, x3, 1.0f, 0.0f);
        X[PX(base)] = x0; X[PX(base + 1)] = x1; X[PX(base + 2)] = x2; X[PX(base + 3)] = x3; }
    __syncthreads();
}
template <bool INV>
__device__ __forceinline__ void fft_r16_pass(LAS f32x2* X, int tid, int lq) {
    const int qp = 1 << lq;
    const float r16 = 1.0f / (float)(16 * qp), r4 = 1.0f / (float)(4 * qp);
    int nrep = 2; asm volatile("" : "+s"(nrep));
#pragma unroll 1
    for (int i = 0; i < nrep; ++i) {
        int u = tid + 512 * i; asm volatile("" : "+v"(u)); const int j = u & (qp - 1), base = ((u >> lq) << (lq + 4)) + j;
        f32x2 x[16];
#pragma unroll
        for (int r = 0; r < 16; ++r) x[r] = X[PX(base + (r << lq))];
        const float angB = (float)j * r4;
        if (!INV) {
#pragma unroll
            for (int r = 0; r < 4; ++r) { const float ang = (float)(j + (r << lq)) * r16; bf4_fwd(x[r], x[r + 4], x[r + 8], x[r + 12], cos_rev(ang), -sin_rev(ang)); }
            const float cb = cos_rev(angB), sb = -sin_rev(angB);
#pragma unroll
            for (int k = 0; k < 4; ++k) bf4_fwd(x[4 * k], x[4 * k + 1], x[4 * k + 2], x[4 * k + 3], cb, sb);
        } else {
            const float cb = cos_rev(angB), sb = sin_rev(angB);
#pragma unroll
            for (int k = 0; k < 4; ++k) bf4_inv(x[4 * k], x[4 * k + 1], x[4 * k + 2], x[4 * k + 3], cb, sb);
#pragma unroll
            for (int r = 0; r < 4; ++r) { const float ang = (float)(j + (r << lq)) * r16; bf4_inv(x[r], x[r + 4], x[r + 8], x[r + 12], cos_rev(ang), sin_rev(ang)); }
        }
#pragma unroll
        for (int r = 0; r < 16; ++r) X[PX(base + (r << lq))] = x[r];
    }
    __syncthreads();
}
template <bool INV>
__device__ __forceinline__ void fft16k(LAS f32x2* X, int tid) {
    if (!INV) { fft_r16_pass<false>(X, tid, 10); fft_r16_pass<false>(X, tid, 6); fft_r16_pass<false>(X, tid, 2); fft_r4_last<false>(X, tid); }
    else { fft_r4_last<true>(X, tid); fft_r16_pass<true>(X, tid, 2); fft_r16_pass<true>(X, tid, 6); fft_r16_pass<true>(X, tid, 10); }
}
__device__ __forceinline__ int drev4(int x) { unsigned y = __builtin_bitreverse32((unsigned)x) >> 18; return (int)(((y & 0x2AAAu) >> 1) | ((y & 0x1555u) << 1)); }
__device__ __forceinline__ float block_sum(Frame& F, float v, LAS float* red) {
    v = wave_sum(v);
    if (F.lane == 0) red[F.wave] = v;
    __syncthreads();
    float s = 0.f;
#pragma unroll
    for (int w = 0; w < NWAVES; ++w) s += red[w];
    __syncthreads();
    return s;
}
__device__ __forceinline__ void hyena_item(Frame& F, int c_in, int l) {
    int c = c_in; asm volatile("" : "+s"(c));
    const int tid = F.tid;
    LAS f32x2* X = (LAS f32x2*)F.lds;
    LAS float* red = (LAS float*)(F.lds + XTRA_OFF);
    f32x2* KF = WSP(f32x2, WS_KF) + (size_t)c * 2 * 16384;
    {
        const float* F0f = WSP(float, WS_FILT) + ((size_t)l * 1024 + c) * SEQ; const float* F0b = F0f + (size_t)256 * SEQ;
        const float* F1f = F0f + (size_t)512 * SEQ; const float* F1b = F0f + (size_t)768 * SEQ;
        float s0 = 0.f, s1 = 0.f;
#pragma unroll 1
        for (int i0 = 0; i0 < 16; i0 += 8) { float a0[8], b0[8], a1[8], b1[8];
#pragma unroll
            for (int i = 0; i < 8; ++i) { int t = tid + 512 * (i0 + i); asm volatile("" : "+v"(t)); a0[i] = F0f[t]; b0[i] = F0b[t]; a1[i] = F1f[t]; b1[i] = F1b[t]; }
#pragma unroll
            for (int i = 0; i < 8; ++i) { const int t = tid + 512 * (i0 + i); s0 += fabsf(a0[i]) + fabsf(b0[i]); s1 += fabsf(a1[i]) + fabsf(b1[i]);
                X[PX(t)] = (f32x2){a0[i], a1[i]}; X[PX(16383 - t)] = (f32x2){b0[i], b1[i]}; } }
        const float inv0 = 0.5f / block_sum(F, s0, red), inv1 = 0.5f / block_sum(F, s1, red);
        fft16k<false>(X, tid);
#pragma unroll 2
        for (int i = 0; i < 32; ++i) { int p = tid + 512 * i; asm volatile("" : "+v"(p)); const int f = drev4(p), pp = drev4((16384 - f) & 16383);
            const f32x2 w = X[PX(p)], wp = X[PX(pp)];
            KF[p] = (f32x2){(w.x + wp.x) * inv0, (w.y - wp.y) * inv0};
            KF[16384 + p] = (f32x2){(w.y + wp.y) * inv1, (wp.x - w.x) * inv1}; }
        __syncthreads();
    }
    const float* HT0 = WSP(float, WS_HYT);
    const float hb0 = INF(27)[l * 512 + c], hb1 = INF(27)[l * 512 + 256 + c];
    float zz[16][2];
    { const float* z0p = HT0 + (size_t)(0 * 768 + 512 + c) * SEQ; const float* z1p = HT0 + (size_t)(1 * 768 + 512 + c) * SEQ;
#pragma unroll
      for (int i = 0; i < 16; ++i) { zz[i][0] = z0p[tid + 512 * i]; zz[i][1] = z1p[tid + 512 * i]; }
#pragma unroll
      for (int i = 0; i < 16; ++i) { int t = tid + 512 * i; asm volatile("" : "+v"(t)); X[PX(t)] = (f32x2){zz[i][0], zz[i][1]}; X[PX(8192 + t)] = (f32x2){0.f, 0.f}; } }
    __syncthreads();
    const float invn = 1.0f / 16384.0f;
#pragma unroll 1
    for (int o = 0; o < 2; ++o) {
        fft16k<false>(X, tid);
        { const f32x2* kp = KF + o * 16384;
#pragma unroll 1
          for (int i0 = 0; i0 < 32; i0 += 8) { f32x2 kv[8];
#pragma unroll
              for (int i = 0; i < 8; ++i) kv[i] = kp[tid + 512 * (i0 + i)];
#pragma unroll
              for (int i = 0; i < 8; ++i) { int p = tid + 512 * (i0 + i); asm volatile("" : "+v"(p)); const f32x2 v = X[PX(p)]; X[PX(p)] = (f32x2){v.x * kv[i].x - v.y * kv[i].y, v.x * kv[i].y + v.y * kv[i].x}; } } }
        __syncthreads();
        fft16k<true>(X, tid);
        float ga[16], gb[16];
        { const float* g0p = HT0 + (size_t)(0 * 768 + o * 256 + c) * SEQ; const float* g1p = HT0 + (size_t)(1 * 768 + o * 256 + c) * SEQ;
#pragma unroll
          for (int i = 0; i < 16; ++i) { ga[i] = g0p[tid + 512 * i]; gb[i] = g1p[tid + 512 * i]; } }
        const float hbo = o ? hb1 : hb0;
        if (o == 0) {
#pragma unroll
            for (int i = 0; i < 16; ++i) { int t = tid + 512 * i; asm volatile("" : "+v"(t)); const f32x2 y = X[PX(t)];
                zz[i][0] = ga[i] * (y.x * invn + zz[i][0] * hbo); zz[i][1] = gb[i] * (y.y * invn + zz[i][1] * hbo);
                X[PX(t)] = (f32x2){zz[i][0], zz[i][1]}; X[PX(8192 + t)] = (f32x2){0.f, 0.f}; }
            __syncthreads();
        } else {
            bf16_t* Y0 = WSP(bf16_t, WS_YHT) + (size_t)(0 * 256 + c) * SEQ; bf16_t* Y1 = WSP(bf16_t, WS_YHT) + (size_t)(1 * 256 + c) * SEQ;
#pragma unroll
            for (int i = 0; i < 16; ++i) { int t = tid + 512 * i; asm volatile("" : "+v"(t)); const f32x2 y = X[PX(t)];
                const float r0 = ga[i] * (y.x * invn + zz[i][0] * hbo), r1 = gb[i] * (y.y * invn + zz[i][1] * hbo);
                Y0[t] = (bf16_t)(pk2(r0, 0.f) & 0xffffu); Y1[t] = (bf16_t)(pk2(r1, 0.f) & 0xffffu); }
            __syncthreads();
        }
    }
}

__device__ __forceinline__ void hy_prep_tile(Frame& F, int tile, int l) {
    const int tid = F.tid, lane = F.lane, wave = F.wave;
    const int b = tile >> 7, t0 = (tile & 127) * 64;
    constexpr int RS = 1552;
    const bf16_t* U = WSP(bf16_t, WS_U);
    { u32x4 hv[13];
#pragma unroll
      for (int i = 0; i < 13; ++i) { const int idx = tid + 512 * i; const int row = idx / 96, pc = idx % 96; const int tok = t0 - 1 + row;
          hv[i] = (u32x4){0u, 0u, 0u, 0u};
          if (row < 66 && tok >= 0 && tok < SEQ) hv[i] = *(const GAS u32x4*)(U + ((size_t)b * SEQ + tok) * DINP + U_HY + pc * 8); }
#pragma unroll
      for (int i = 0; i < 13; ++i) { const int idx = tid + 512 * i; const int row = idx / 96, pc = idx % 96;
          if (row < 66) *(LAS u32x4*)(F.lds + row * RS + pc * 16) = hv[i]; } }
    __syncthreads();
    const float* cw = INF(16) + (size_t)l * 768 * 3; const float* cb = INF(17) + l * 768;
    float* HT = WSP(float, WS_HYT);
#pragma unroll 2
    for (int cp = wave; cp < 384; cp += 8) { const int ch = 2 * cp;
        const float w00 = cw[ch * 3], w01 = cw[ch * 3 + 1], w02 = cw[ch * 3 + 2], w10 = cw[ch * 3 + 3], w11 = cw[ch * 3 + 4], w12 = cw[ch * 3 + 5], b0 = cb[ch], b1 = cb[ch + 1];
        const unsigned r0 = *(const LAS unsigned*)(F.lds + lane * RS + cp * 4), r1 = *(const LAS unsigned*)(F.lds + (lane + 1) * RS + cp * 4), r2 = *(const LAS unsigned*)(F.lds + (lane + 2) * RS + cp * 4);
        HT[((size_t)(b * 768 + ch)) * SEQ + t0 + lane] = w00 * bflo(r0) + w01 * bflo(r1) + w02 * bflo(r2) + b0;
        HT[((size_t)(b * 768 + ch + 1)) * SEQ + t0 + lane] = w10 * bfhi(r0) + w11 * bfhi(r1) + w12 * bfhi(r2) + b1; }
    __syncthreads();
}

__device__ __forceinline__ void headnorm_phase(Frame& F, int l) {
    const int lane = F.lane, tid = F.tid, wave = F.wave;
    const bf16_t* U = WSP(bf16_t, WS_U); const bf16_t* YA = WSP(bf16_t, WS_YATT); const bf16_t* YH = WSP(bf16_t, WS_YHT);
    constexpr int RS2 = 528;
    const int g = wave >> 1, sub = wave & 1, cg = 4 * lane, ch = g * 256 + cg;
    const f32x4 og = *(const GAS f32x4*)(INF(29) + l * 1024 + ch);
    float scw[12];
#pragma unroll
    for (int j = 0; j < 12; ++j) scw[j] = INF(28)[(size_t)l * 768 + cg * 3 + j];
    for (int tile = F.vcu; tile < 256; tile += F.G) {
      const int tb = tile >> 7, t0 = (tile & 127) * 64;
#pragma unroll
      for (int i = 0; i < 4; ++i) { const int idx = tid + 512 * i, c = idx >> 3, p8 = idx & 7;
          const u32x4 v = *(const GAS u32x4*)(YH + ((size_t)(tb * 256 + c)) * SEQ + t0 + p8 * 8);
          LAS unsigned char* hp = F.lds + (8 * p8) * RS2 + 2 * c;
          *(LAS unsigned short*)(hp + 0 * RS2) = (unsigned short)(v.x & 0xffffu); *(LAS unsigned short*)(hp + 1 * RS2) = (unsigned short)(v.x >> 16);
          *(LAS unsigned short*)(hp + 2 * RS2) = (unsigned short)(v.y & 0xffffu); *(LAS unsigned short*)(hp + 3 * RS2) = (unsigned short)(v.y >> 16);
          *(LAS unsigned short*)(hp + 4 * RS2) = (unsigned short)(v.z & 0xffffu); *(LAS unsigned short*)(hp + 5 * RS2) = (unsigned short)(v.z >> 16);
          *(LAS unsigned short*)(hp + 6 * RS2) = (unsigned short)(v.w & 0xffffu); *(LAS unsigned short*)(hp + 7 * RS2) = (unsigned short)(v.w >> 16); }
      __syncthreads();
#pragma unroll 4
      for (int rr = 0; rr < 32; ++rr) {
        const int trow = sub * 32 + rr; const int m = tb * SEQ + t0 + trow;
        float y0, y1, y2, y3;
        if (g == 0) {
            const u32x2 ow = *(const GAS u32x2*)(U + (size_t)m * DINP + U_MLO + cg);
            const f32x4 hs = *(const GAS f32x4*)(WSP(float, WS_HF) + (size_t)m * 256 + cg) + *(const GAS f32x4*)(WSP(float, WS_HB) + (size_t)m * 256 + cg);
            y0 = hs.x / (1.0f + fexp(-bflo(ow.x))); y1 = hs.y / (1.0f + fexp(-bfhi(ow.x))); y2 = hs.z / (1.0f + fexp(-bflo(ow.y))); y3 = hs.w / (1.0f + fexp(-bfhi(ow.y)));
        } else if (g == 1) {
            const u32x2 w = *(const GAS u32x2*)(YA + (size_t)m * 256 + cg);
            y0 = bflo(w.x); y1 = bfhi(w.x); y2 = bflo(w.y); y3 = bfhi(w.y);
        } else if (g == 2) {
            const u32x2 w = *(const LAS u32x2*)(F.lds + trow * RS2 + cg * 2);
            y0 = bflo(w.x); y1 = bfhi(w.x); y2 = bflo(w.y); y3 = bfhi(w.y);
        } else {
            const int s = t0 + trow;
            const bf16_t* up = U + (size_t)m * DINP + U_SC + cg;
            const u32x2 bw = *(const GAS u32x2*)up;
            u32x2 c0 = {0u, 0u}, x0 = {0u, 0u}, c2 = {0u, 0u}, x2 = {0u, 0u};
            if (s > 0) { c0 = *(const GAS u32x2*)(up - DINP + 256); x0 = *(const GAS u32x2*)(up - DINP + 512); }
            const u32x2 c1 = *(const GAS u32x2*)(up + 256), x1 = *(const GAS u32x2*)(up + 512);
            if (s < SEQ - 1) { c2 = *(const GAS u32x2*)(up + DINP + 256); x2 = *(const GAS u32x2*)(up + DINP + 512); }
            y0 = bflo(bw.x) * (scw[0] * bflo(c0.x) * bflo(x0.x) + scw[1] * bflo(c1.x) * bflo(x1.x) + scw[2] * bflo(c2.x) * bflo(x2.x));
            y1 = bfhi(bw.x) * (scw[3] * bfhi(c0.x) * bfhi(x0.x) + scw[4] * bfhi(c1.x) * bfhi(x1.x) + scw[5] * bfhi(c2.x) * bfhi(x2.x));
            y2 = bflo(bw.y) * (scw[6] * bflo(c0.y) * bflo(x0.y) + scw[7] * bflo(c1.y) * bflo(x1.y) + scw[8] * bflo(c2.y) * bflo(x2.y));
            y3 = bfhi(bw.y) * (scw[9] * bfhi(c0.y) * bfhi(x0.y) + scw[10] * bfhi(c1.y) * bfhi(x1.y) + scw[11] * bfhi(c2.y) * bfhi(x2.y));
        }
        float ss = (y0 * y0 + y1 * y1) + (y2 * y2 + y3 * y3);
        ss += __shfl_xor(ss, 1); ss += __shfl_xor(ss, 2); ss += __shfl_xor(ss, 4); ss += __shfl_xor(ss, 8);
        const float rstd = __builtin_amdgcn_rsqf(ss * (1.0f / 64.0f) + EPS);
        u32x2 w; w.x = pk2(y0 * rstd * og.x, y1 * rstd * og.y); w.y = pk2(y2 * rstd * og.z, y3 * rstd * og.w);
        *(GAS u32x2*)(WSP(bf16_t, WS_YN) + (size_t)m * DM + ch) = w;
      }
      __syncthreads();
    }
}

__device__ __forceinline__ void post_mixer_phase(Frame& F, int l, const float* xin) {
    const int gw = F.vcu * NWAVES + F.wave, NGW = F.G * NWAVES, lane = F.lane, tid = F.tid;
    LAS float* RWT = (LAS float*)F.lds;
    { const GAS f32x4* src = (const GAS f32x4*)(INF(31) + (size_t)l * 1024 * 16);
      for (int i = tid; i < 4096; i += NTHR) { const f32x4 w = src[i]; const int k = i >> 2, e4 = (i & 3) * 4;
          RWT[(e4 + 0) * 1024 + k] = w.x; RWT[(e4 + 1) * 1024 + k] = w.y; RWT[(e4 + 2) * 1024 + k] = w.z; RWT[(e4 + 3) * 1024 + k] = w.w; } }
    __syncthreads();
    const float* mod = WSP(float, WS_MOD);
    for (int m0 = gw; m0 < MTOK; m0 += 2 * NGW) {
        u32x2 yw[2][4]; f32x4 xr[2][4];
#pragma unroll
        for (int r = 0; r < 2; ++r) { const int mm = (m0 + r * NGW < MTOK) ? m0 + r * NGW : m0;
            const GAS u32x2* yr = (const GAS u32x2*)(WSP(bf16_t, WS_Y2) + (size_t)mm * DM) + lane;
#pragma unroll
            for (int j = 0; j < 4; ++j) yw[r][j] = yr[64 * j];
            ld_row_f32(xin + (size_t)mm * DM, lane, xr[r]); }
#pragma unroll
        for (int r = 0; r < 2; ++r) { const int m = m0 + r * NGW; if (m >= MTOK) break;
        const int b = m >> 13, s = m & 8191; const float* md = mod + (l * 2 + b) * 6144;
        f32x4 y2[4], x[4], pg[4], g1[4];
#pragma unroll
        for (int j = 0; j < 4; ++j) { y2[j] = (f32x4){bflo(yw[r][j].x), bfhi(yw[r][j].x), bflo(yw[r][j].y), bfhi(yw[r][j].y)}; x[j] = xr[r][j]; }
        ld_row_f32(INF(6) + l * 1024, lane, pg); ld_row_f32(md + 2048, lane, g1);
        const float rstd = __builtin_amdgcn_rsqf(row_ss(y2) * (1.0f / DM) + EPS);
#pragma unroll
        for (int j = 0; j < 4; ++j) x[j] = x[j] + g1[j] * (y2[j] * rstd * pg[j]);
        st_row_f32(WSP(float, WS_X1) + (size_t)m * DM, lane, x);
        f32x4 h[4];
        modnorm(x, INF(7) + l * 1024, md + 4096, md + 3072, lane, h);
        st_row_bf16(WSP(bf16_t, WS_XN) + (size_t)m * DM, lane, h);
        float part[16];
#pragma unroll
        for (int e = 0; e < 16; ++e) part[e] = 0.f;
#pragma unroll
        for (int j = 0; j < 4; ++j) {
#pragma unroll
            for (int e = 0; e < 16; ++e) { const f32x4 w = *(const LAS f32x4*)(RWT + e * 1024 + 4 * lane + 256 * j);
                part[e] += (h[j].x * w.x + h[j].y * w.y) + (h[j].z * w.z + h[j].w * w.w); }
            asm volatile("" ::: "memory"); }
        float a8[8], a4[4], a2[2], lg;
        { const bool up = (lane & 32) != 0;
#pragma unroll
          for (int i = 0; i < 8; ++i) { const float keep = up ? part[8 + i] : part[i], send = up ? part[i] : part[8 + i]; a8[i] = keep + __shfl_xor(send, 32); } }
        { const bool up = (lane & 16) != 0;
#pragma unroll
          for (int i = 0; i < 4; ++i) { const float keep = up ? a8[4 + i] : a8[i], send = up ? a8[i] : a8[4 + i]; a4[i] = keep + __shfl_xor(send, 16); } }
        { const bool up = (lane & 8) != 0;
#pragma unroll
          for (int i = 0; i < 2; ++i) { const float keep = up ? a4[2 + i] : a4[i], send = up ? a4[i] : a4[2 + i]; a2[i] = keep + __shfl_xor(send, 8); } }
        { const bool up = (lane & 4) != 0; const float keep = up ? a2[1] : a2[0], send = up ? a2[0] : a2[1]; lg = keep + __shfl_xor(send, 4); }
        lg += __shfl_xor(lg, 2); lg += __shfl_xor(lg, 1);
        float mx = lg;
#pragma unroll
        for (int o = 4; o < 64; o <<= 1) mx = fmaxf(mx, __shfl_xor(mx, o));
        const float ex = fexp(lg - mx); float sm = ex;
#pragma unroll
        for (int o = 4; o < 64; o <<= 1) sm += __shfl_xor(sm, o);
        if ((lane & 3) == 0) WSP(float, WS_AFF)[((size_t)b * 16 + (lane >> 2)) * SEQ + s] = ex / sm;
        if (lane < 16) WSP(int, WS_SLOT)[(size_t)m * 16 + lane] = -1;
            }
    }
    __syncthreads();
}

__device__ __forceinline__ void topk_item(Frame& F, int it) {
    const int tid = F.tid, lane = F.lane, wave = F.wave;
    const int b = it >> 4, e = it & 15;
    LAS unsigned* keys = (LAS unsigned*)F.lds;
    LAS unsigned* hist = (LAS unsigned*)(F.lds + 32768);
    LAS unsigned* ctl = hist + 256;
    LAS unsigned* wtot = hist + 320;
    const unsigned* src = (const unsigned*)(WSP(float, WS_AFF) + (size_t)it * SEQ);
#pragma unroll
    for (int i = 0; i < 16; ++i) keys[tid + 512 * i] = src[tid + 512 * i];
    unsigned prefix = 0u, mask = 0u, need = CAP;
    for (int pass = 0; pass < 4; ++pass) {
        const int shift = 24 - 8 * pass;
        if (tid < 256) hist[tid] = 0u;
        __syncthreads();
#pragma unroll
        for (int i = 0; i < 16; ++i) { const unsigned k = keys[tid + 512 * i]; if ((k & mask) == prefix) atomicAdd((unsigned*)&hist[(k >> shift) & 255u], 1u); }
        __syncthreads();
        if (wave == 0) { const unsigned c0 = hist[4 * lane], c1 = hist[4 * lane + 1], c2 = hist[4 * lane + 2], c3 = hist[4 * lane + 3];
            const unsigned sl = c0 + c1 + c2 + c3; unsigned T = sl;
#pragma unroll
            for (int o = 1; o < 64; o <<= 1) { const unsigned n = __shfl_down(T, o); if (lane + o < 64) T += n; }
            unsigned cum = T - sl;
            if (cum < need && cum + c3 >= need) { ctl[0] = 4u * lane + 3u; ctl[1] = need - cum; } cum += c3;
            if (cum < need && cum + c2 >= need) { ctl[0] = 4u * lane + 2u; ctl[1] = need - cum; } cum += c2;
            if (cum < need && cum + c1 >= need) { ctl[0] = 4u * lane + 1u; ctl[1] = need - cum; } cum += c1;
            if (cum < need && cum + c0 >= need) { ctl[0] = 4u * lane; ctl[1] = need - cum; } }
        __syncthreads();
        prefix |= ctl[0] << shift; mask |= 0xffu << shift; need = ctl[1];
        __syncthreads();
    }
    unsigned cg = 0u, ce = 0u;
#pragma unroll
    for (int i = 0; i < 16; ++i) { const unsigned k = keys[tid * 16 + i]; cg += (k > prefix) ? 1u : 0u; ce += (k == prefix) ? 1u : 0u; }
    unsigned v = cg | (ce << 16), inc = v;
#pragma unroll
    for (int o = 1; o < 64; o <<= 1) { const unsigned n = __shfl_up(inc, o); if (lane >= o) inc += n; }
    if (lane == 63) wtot[wave] = inc;
    __syncthreads();
    unsigned off = 0u;
    for (int w = 0; w < wave; ++w) off += wtot[w];
    const unsigned excl = off + inc - v;
    unsigned ng = excl & 0xffffu, ne = excl >> 16;
    int* IDX = WSP(int, WS_IDX) + (e * 2 + b) * CAP; int* SLOT = WSP(int, WS_SLOT);
#pragma unroll
    for (int i = 0; i < 16; ++i) { const int idx = tid * 16 + i; const unsigned k = keys[idx];
        const bool gt = k > prefix, eq = k == prefix; const bool sel = gt || (eq && ne < need);
        if (sel) { const int slot = (int)(ng + (ne < need ? ne : need)); IDX[slot] = b * SEQ + idx; SLOT[((size_t)b * SEQ + idx) * 16 + e] = slot; }
        ng += gt ? 1u : 0u; ne += eq ? 1u : 0u; }
    __syncthreads();
}

__device__ __forceinline__ void gather_phase(Frame& F) {
    const int gw = F.vcu * NWAVES + F.wave, NGW = F.G * NWAVES, lane = F.lane;
    const int* IDX = WSP(int, WS_IDX);
    for (int r = gw; r < NEXP * 2 * CAP; r += NGW) {
        const int e = r >> 11, b = (r >> 10) & 1, j = r & 1023;
        const int tok = IDX[(b * 16 + e) * CAP + j];
        const GAS u32x4* src = (const GAS u32x4*)(WSP(bf16_t, WS_XN) + ((size_t)b * SEQ + tok) * DM);
        GAS u32x4* dst = (GAS u32x4*)(WSP(bf16_t, WS_XE) + (size_t)r * DM);
        dst[lane] = src[lane]; dst[64 + lane] = src[64 + lane];
    }
}

__device__ __forceinline__ void combine_phase(Frame& F, int l) {
    const int gw = F.vcu * NWAVES + F.wave, NGW = F.G * NWAVES, lane = F.lane;
    const float* mod = WSP(float, WS_MOD);
    const bf16_t* YE = WSP(bf16_t, WS_YE);
    f32x4 pg[4]; ld_row_f32(INF(8) + l * 1024, lane, pg);
    for (int m0 = gw; m0 < MTOK; m0 += 2 * NGW) {
        int sl[2]; float gv[2]; f32x4 x1[2][4];
#pragma unroll
        for (int r = 0; r < 2; ++r) { const int mm = (m0 + r * NGW < MTOK) ? m0 + r * NGW : m0; const int b = mm >> 13, s = mm & 8191;
            sl[r] = -1; gv[r] = 0.f;
            if (lane < 16) { sl[r] = WSP(int, WS_SLOT)[(size_t)mm * 16 + lane]; gv[r] = WSP(float, WS_AFF)[((size_t)b * 16 + lane) * SEQ + s]; }
            ld_row_f32(WSP(float, WS_X1) + (size_t)mm * DM, lane, x1[r]); }
#pragma unroll
        for (int r = 0; r < 2; ++r) { const int m = m0 + r * NGW; if (m >= MTOK) break;
            const int b = m >> 13; const float* md = mod + (l * 2 + b) * 6144;
            f32x4 acc[4];
#pragma unroll
            for (int j = 0; j < 4; ++j) acc[j] = (f32x4){0.f, 0.f, 0.f, 0.f};
            unsigned long long msk = __ballot(sl[r] >= 0) & 0xffffull;
            while (msk) {
                const int e0 = __builtin_ctzll(msk); msk &= msk - 1;
                int e1 = -1; if (msk) { e1 = __builtin_ctzll(msk); msk &= msk - 1; }
                const int s0 = __shfl(sl[r], e0); const float g0 = __shfl(gv[r], e0);
                const int s1 = __shfl(sl[r], e1 < 0 ? e0 : e1); const float g1 = (e1 < 0) ? 0.f : __shfl(gv[r], e1 < 0 ? e0 : e1);
                const GAS u32x2* r0 = (const GAS u32x2*)(YE + ((size_t)e0 * 2048 + b * CAP + s0) * DM) + lane;
                const GAS u32x2* r1 = (const GAS u32x2*)(YE + ((size_t)(e1 < 0 ? e0 : e1) * 2048 + b * CAP + s1) * DM) + lane;
                u32x2 w0[4], w1[4];
#pragma unroll
                for (int j = 0; j < 4; ++j) { w0[j] = r0[64 * j]; w1[j] = r1[64 * j]; }
#pragma unroll
                for (int j = 0; j < 4; ++j) { acc[j] += (f32x4){bflo(w0[j].x), bfhi(w0[j].x), bflo(w0[j].y), bfhi(w0[j].y)} * g0;
                                              acc[j] += (f32x4){bflo(w1[j].x), bfhi(w1[j].x), bflo(w1[j].y), bfhi(w1[j].y)} * g1; }
            }
            f32x4 g2[4]; ld_row_f32(md + 5120, lane, g2);
            const float rstd = __builtin_amdgcn_rsqf(row_ss(acc) * (1.0f / DM) + EPS);
            f32x4 xo[4];
#pragma unroll
            for (int j = 0; j < 4; ++j) xo[j] = x1[r][j] + g2[j] * (acc[j] * rstd * pg[j]);
            st_row_f32(F.a->out + (size_t)m * DM, lane, xo);
            if (l == 0) { f32x4 h[4]; const float* md1 = mod + (1 * 2 + b) * 6144;
                modnorm(xo, INF(5) + 1024, md1 + 1024, md1, lane, h);
                st_row_bf16(WSP(bf16_t, WS_XN) + (size_t)m * DM, lane, h); }
        }
    }
}

constexpr int PH_PER_LAYER = 12, N_PHASES = 2 + 2 * PH_PER_LAYER;
__global__ void __launch_bounds__(NTHR, 2) mega_fwd(Args args) {
    extern __shared__ __attribute__((aligned(16))) unsigned char lds_raw[];
    Frame F;
    F.lds = (LAS unsigned char*)lds_raw;
    F.tid = threadIdx.x; F.lane = F.tid & 63; F.wave = __builtin_amdgcn_readfirstlane(F.tid >> 6);
    F.G = gridDim.x; { const int bx = blockIdx.x; F.vcu = (F.G % 8 == 0) ? (bx % 8) * (F.G / 8) + bx / 8 : bx; }
    F.a = &args; F.ws = args.ws;
    volatile LAS unsigned* MISC = (volatile LAS unsigned*)(F.lds + MISC_OFF);
    for (int u = F.tid; u < (LDS_BYTES - LDSCTL_OFF) / 4; u += NTHR) ((LAS unsigned*)(F.lds + LDSCTL_OFF))[u] = 0u;
    __syncthreads();
    gu32* ctl = (gu32*)(F.ws + WS_CTL);
    XcdBarrier bar; bar.bar = (unsigned*)(ctl + CW_BAR); bar.x = 0; bar.st = nullptr;
#if !MK_SPLIT
    bar = xcd_barrier_post((unsigned*)(ctl + CW_BAR), MISC + 8);
#endif
    const int lo = args.ph_lo, hi = args.ph_hi;
    int ph = 0;
#if MK_SPLIT
#define SEAM() do { } while (0)
#else
#define SEAM() do { if (ph + 1 < hi) xcd_barrier(bar); } while (0)
#endif
#ifndef PHSEL
#define PHSEL -1
#endif
#ifndef PHMASK
#define PHMASK 0x7fff
#endif
#ifndef DBL_MASK
#define DBL_MASK 0
#endif
#define PHASE_BEGIN(id) if ((PHSEL < 0 || PHSEL == (id)) && ((PHMASK >> (id)) & 1) && lo <= ph && ph < hi) for (int rep_ = 0; rep_ < (((DBL_MASK >> (id)) & 1) ? 2 : 1); ++rep_) { if (rep_) xcd_barrier(bar); { int t_ = threadIdx.x; asm volatile("" : "+v"(t_)); F.tid = t_; F.lane = t_ & 63; F.wave = __builtin_amdgcn_readfirstlane(t_ >> 6); }
#define PHASE_END   SEAM(); } ++ph;

    PHASE_BEGIN(0) p0_phase(F); PHASE_END
    PHASE_BEGIN(1) p1_phase(F); PHASE_END
#pragma unroll 1
    for (int l = 0; l < 2; ++l) {
        const float* xin = (l == 0) ? (const float*)args.in[0] : (const float*)args.out;
        PHASE_BEGIN(2) {
            pg8::Gemm g{WSP(bf16_t, WS_XN), WSP(bf16_t, WS_WIN) + (size_t)l * DINP * 1024, MTOK, DINP, 1024}; pg8::StaticOrder S; S.init(MTOK, DINP, F.G, (int)blockIdx.x);
            pg8::EpiBf16 E{WSP(bf16_t, WS_U), DINP, DINP / 256};
            pg8::gemm_phase<pg8::EpiBf16, pg8::StaticOrder, true, true>(F.lds, g, S, E, F.tid);
        } PHASE_END
        PHASE_BEGIN(3) {
#ifndef SUBSEL
#define SUBSEL 0
#endif
#ifndef REP_A
#define REP_A 1
#define REP_B 1
#define REP_C 1
#define REP_D 1
#define REP_E 1
#endif
            for (int q_ = 0; q_ < REP_A; ++q_) for (int tl = F.vcu; tl < 256; tl += F.G) hy_prep_tile(F, tl, l);
            for (int q_ = 0; q_ < REP_B; ++q_) for (int p = F.vcu; p < 512; p += F.G) ml_local_pair(F, p, l);
            for (int q_ = 0; q_ < REP_C; ++q_) mla_prep_rows(F, l);
        } PHASE_END
        PHASE_BEGIN(4) {
            pg8::Gemm g{WSP(bf16_t, WS_AMLA), WSP(bf16_t, WS_WMLA) + (size_t)l * 1024 * 384, MTOK, 1024, 384}; pg8::StaticOrder S; S.init(MTOK, 1024, F.G, (int)blockIdx.x);
            pg8::EpiBf16 E{WSP(bf16_t, WS_OMLA), 1024, 4};
            pg8::gemm_phase<pg8::EpiBf16, pg8::StaticOrder, true, true>(F.lds, g, S, E, F.tid);
#define REFRESH_TID() do { int t_ = threadIdx.x; asm volatile("" : "+v"(t_)); F.tid = t_; F.lane = t_ & 63; F.wave = __builtin_amdgcn_readfirstlane(t_ >> 6); } while (0)
            REFRESH_TID();
            ml_scan(F);
            REFRESH_TID();
#ifndef HY_REP
#define HY_REP 1
#endif
            for (int rep2_ = 0; rep2_ < HY_REP; ++rep2_) for (int c = F.vcu; c < 256; c += F.G) hyena_item(F, c, l);
        } PHASE_END
        PHASE_BEGIN(5) relayout_phase(F); PHASE_END
        PHASE_BEGIN(6) {
            for (int q_ = 0; q_ < REP_D; ++q_) for (int u = F.vcu; u < 256; u += F.G) attn_unit(F, u >> 5, u & 31);
            for (int q_ = 0; q_ < REP_E; ++q_) for (int p = F.vcu; p < 512; p += F.G) ml_out_pair(F, p, l);
        } PHASE_END
        PHASE_BEGIN(7) headnorm_phase(F, l); PHASE_END
        PHASE_BEGIN(8) {
            pg8::Gemm g{WSP(bf16_t, WS_YN), WSP(bf16_t, WS_WOUT) + (size_t)l * 1024 * 1024, MTOK, 1024, 1024}; pg8::StaticOrder S; S.init(MTOK, 1024, F.G, (int)blockIdx.x);
            pg8::EpiBf16 E{WSP(bf16_t, WS_Y2), 1024, 4};
            pg8::gemm_phase<pg8::EpiBf16, pg8::StaticOrder, true, true>(F.lds, g, S, E, F.tid);
        } PHASE_END
        PHASE_BEGIN(9) post_mixer_phase(F, l, xin); PHASE_END
        PHASE_BEGIN(10) { for (int it = F.vcu; it < 32; it += F.G) topk_item(F, it); } PHASE_END
        PHASE_BEGIN(11) {
            pg8::Gemm g{WSP(bf16_t, WS_XN), WSP(bf16_t, WS_WGU) + (size_t)l * NEXP * 4096 * 1024, NEXP * 2048, NEXP * 4096, 1024, WSP(int, WS_IDX)}; pg8::GroupedOrder S; S.init(16, F.G, (int)blockIdx.x);
            pg8::EpiSwiGLU E{WSP(bf16_t, WS_ACT), EFF};
            pg8::gemm_phase<pg8::EpiSwiGLU, pg8::GroupedOrder, true, true, true>(F.lds, g, S, E, F.tid);
        } PHASE_END
        PHASE_BEGIN(12) {
            pg8::Gemm g{WSP(bf16_t, WS_ACT), WSP(bf16_t, WS_WDN) + (size_t)l * NEXP * 1024 * 2048, NEXP * 2048, NEXP * 1024, 2048}; pg8::GroupedOrder S; S.init(4, F.G, (int)blockIdx.x);
            pg8::EpiBf16 E{WSP(bf16_t, WS_YE), 1024, 4};
            pg8::gemm_phase<pg8::EpiBf16, pg8::GroupedOrder, true, true>(F.lds, g, S, E, F.tid);
        } PHASE_END
        PHASE_BEGIN(13) combine_phase(F, l); PHASE_END
    }
}

extern "C" void kernel_launch(void* const* d_in, const int* in_sizes, int n_in, void* d_out, int out_size, void* d_ws, size_t ws_size, hipStream_t stream) {
    static int grid = 0;
    if (grid == 0) {
        if (n_in != 35 || out_size != MTOK * DM || ws_size < WS_END) { fprintf(stderr, "kernel_launch: unexpected shapes: n_in %d out %d ws %zu (need %zu)\n", n_in, out_size, ws_size, (size_t)WS_END); grid = -1; return; }
        int dev = 0, cus = 0, per_cu = 0;
        if (hipGetDevice(&dev) != hipSuccess || hipDeviceGetAttribute(&cus, hipDeviceAttributeMultiprocessorCount, dev) != hipSuccess) { grid = -1; return; }
        if (hipFuncSetAttribute((const void*)mega_fwd, hipFuncAttributeMaxDynamicSharedMemorySize, LDS_BYTES) != hipSuccess) { fprintf(stderr, "kernel_launch: hipFuncSetAttribute failed\n"); grid = -1; return; }
        (void)hipOccupancyMaxActiveBlocksPerMultiprocessor(&per_cu, (const void*)mega_fwd, NTHR, LDS_BYTES);
        (void)hipGetLastError();
        grid = cus > 0 ? cus : 256;
        if (per_cu < 1) fprintf(stderr, "kernel_launch: occupancy query reports %d\n", per_cu);
    }
    if (grid < 0) return;
    (void)hipMemsetAsync((char*)d_ws + WS_CTL, 0, CTL_ZERO_BYTES, stream);
    Args a{};
    for (int i = 0; i < 35; ++i) a.in[i] = d_in[i];
    a.out = (float*)d_out; a.ws = (unsigned char*)d_ws;
#if MK_SPLIT
    for (int p = 0; p < N_PHASES; ++p) { a.ph_lo = p; a.ph_hi = p + 1; hipLaunchKernelGGL(mega_fwd, dim3(grid), dim3(NTHR), LDS_BYTES, stream, a); }
#else
    a.ph_lo = 0; a.ph_hi = N_PHASES;
    hipLaunchKernelGGL(mega_fwd, dim3(grid), dim3(NTHR), LDS_BYTES, stream, a);
#endif
}
```

```cpp
#include <hip/hip_runtime.h>
#include <cstdio>
#include <cstdint>

#ifndef MK_SPLIT
#define MK_SPLIT 0
#endif

#define GAS __attribute__((address_space(1)))
#define LAS __attribute__((address_space(3)))
typedef GAS unsigned gu32;
#define RLX_AGENT __ATOMIC_RELAXED, __HIP_MEMORY_SCOPE_AGENT
typedef unsigned short bf16_t;
typedef short bf16x8 __attribute__((ext_vector_type(8)));
typedef short s16x4 __attribute__((ext_vector_type(4)));
typedef float f32x4 __attribute__((ext_vector_type(4)));
typedef float f32x2 __attribute__((ext_vector_type(2)));
typedef float f32x16 __attribute__((ext_vector_type(16)));
typedef unsigned u32x4 __attribute__((ext_vector_type(4)));
typedef unsigned u32x2 __attribute__((ext_vector_type(2)));
typedef __bf16 bf16x2_t __attribute__((ext_vector_type(2)));

namespace pg8 {
#define PG8_LAS __attribute__((address_space(3)))
constexpr int BM = 256, BK = 64, HALF = 128, HTB = HALF * BK * 2, STAGE_BYTES = 8 * HTB, NXCD = 8, WGM = 8;
__host__ __device__ __forceinline__ int lds_byte(int r, int c) { const int st = (r >> 4) * 2 + (c >> 5), rr = r & 15, cc = c & 31, ob = rr * 64 + cc * 2; return st * 1024 + (ob ^ (((ob >> 9) & 1) << 5)); }
__host__ __device__ __forceinline__ void stage_rc(int b, int& R, int& C) { const int st = b / 1024, sb = b % 1024, swz = sb ^ (((sb >> 9) & 1) << 5); R = (st >> 1) * 16 + swz / 64; C = (st & 1) * 32 + (swz % 64) / 2; }
__host__ __device__ __forceinline__ int perm32(int rho) { const int n = rho >> 4, i = rho & 15; return 8 * (i >> 2) + 4 * n + (i & 3); }
struct Unit { int pm, pn; };
struct Gemm { const bf16_t* A; const bf16_t* Bt; int M, N, K; const int* rowidx; };
struct StaticOrder {
    int nM, nN, nwg, G, c;
    __host__ __device__ void init(int M, int N, int G_, int c_) { nM = M / BM; nN = N / BM; nwg = nM * nN; G = G_; c = c_; }
    __host__ __device__ bool next(int i, Unit& u) const {
        const long L = (long)i * G + c; if (L >= nwg) return false;
        int wgid = (int)L; { const int q = nwg / NXCD, r = nwg % NXCD, xcd = wgid % NXCD, off = wgid / NXCD; wgid = (xcd < r ? xcd * (q + 1) : r * (q + 1) + (xcd - r) * q) + off; }
        const int nig = WGM * nN, gid = wgid / nig, fm = gid * WGM, gsz = (nM - fm) < WGM ? (nM - fm) : WGM;
        u.pm = fm + ((wgid % nig) % gsz); u.pn = (wgid % nig) / gsz; return true;
    }
    __device__ __forceinline__ void a_ready(const Unit&) const {}
    __device__ __forceinline__ void done(const Unit&) const {}
};
struct GroupedOrder {
    int nNl, total, G, c;
    __host__ __device__ void init(int nNl_, int G_, int c_) { nNl = nNl_; total = 16 * 8 * nNl_; G = G_; c = c_; }
    __host__ __device__ bool next(int i, Unit& u) const {
        const long L = (long)i * G + c; if (L >= total) return false;
        if (G == 256 && (nNl == 16 || nNl == 4)) {
            const int x = c & 7, w = c >> 3;
            if (nNl == 16) { const int e = 2 * i + (w >> 4), q = w & 15; u.pm = e * 8 + 4 * (x & 1) + (q & 3); u.pn = e * 16 + 4 * (x >> 1) + (q >> 2); }
            else { const int e = 8 * i + x; u.pm = e * 8 + (w & 7); u.pn = e * 4 + (w >> 3); }
            return true;
        }
        const int per_e = 8 * nNl, e = (int)L / per_e, r = (int)L % per_e;
        u.pm = e * 8 + (r % 8); u.pn = e * nNl + (r / 8); return true;
    }
    __device__ __forceinline__ void a_ready(const Unit&) const {}
    __device__ __forceinline__ void done(const Unit&) const {}
};
__device__ __forceinline__ unsigned cvt_pk_bf16(float lo, float hi) { f32x2 v = {lo, hi}; bf16x2_t b = __builtin_convertvector(v, bf16x2_t); return __builtin_bit_cast(unsigned, b); }

struct EpiBf16 {
    static constexpr bool PERM = true, AFTER_DRAIN = false;
    bf16_t* O; int ldc; int ntn;
    __device__ __forceinline__ void operator()(const f32x4 (&acc)[2][2][4][2], const Unit& u, int wr, int wc, int fr, int fq) const {
        const int row0 = u.pm * BM + wr * 64 + fr; const int colt = (u.pn % ntn) * BM;
        const int col0 = colt + wc * 32 + 8 * fq;
#pragma unroll
        for (int ai = 0; ai < 2; ++ai)
#pragma unroll
            for (int m = 0; m < 4; ++m) { bf16_t* rowp = O + (size_t)(row0 + ai * HALF + m * 16) * ldc + col0;
#pragma unroll
                for (int bj = 0; bj < 2; ++bj) { const f32x4 v0 = acc[ai][bj][m][0], v1 = acc[ai][bj][m][1];
                    u32x4 w; w.x = cvt_pk_bf16(v0[0], v0[1]); w.y = cvt_pk_bf16(v0[2], v0[3]); w.z = cvt_pk_bf16(v1[0], v1[1]); w.w = cvt_pk_bf16(v1[2], v1[3]);
                    *(u32x4*)(rowp + bj * HALF) = w; } }
    }
};
struct EpiF32 {
    static constexpr bool PERM = false, AFTER_DRAIN = false;
    float* O; int ldc;
    __device__ __forceinline__ void operator()(const f32x4 (&acc)[2][2][4][2], const Unit& u, int wr, int wc, int fr, int fq) const {
        const int col0 = u.pn * BM + wc * 32 + 4 * fq;
#pragma unroll
        for (int ai = 0; ai < 2; ++ai)
#pragma unroll
            for (int m = 0; m < 4; ++m) { float* rowp = O + (size_t)(u.pm * BM + ai * HALF + wr * 64 + m * 16 + fr) * ldc + col0;
#pragma unroll
                for (int bj = 0; bj < 2; ++bj)
#pragma unroll
                    for (int n = 0; n < 2; ++n) *(f32x4*)(rowp + bj * HALF + n * 16) = acc[ai][bj][m][n]; }
    }
};
__device__ __forceinline__ float silu_f(float a) { return a * __builtin_amdgcn_rcpf(1.0f + __builtin_amdgcn_exp2f(-1.4426950408889634f * a)); }
struct EpiSwiGLU {
    static constexpr bool PERM = true, AFTER_DRAIN = false;
    bf16_t* O; int ldc;
    __device__ __forceinline__ void operator()(const f32x4 (&acc)[2][2][4][2], const Unit& u, int wr, int wc, int fr, int fq) const {
        const int row0 = u.pm * BM + wr * 64 + fr; const int col0 = (u.pn % 16) * HALF + wc * 32 + 8 * fq;
#pragma unroll
        for (int ai = 0; ai < 2; ++ai)
#pragma unroll
            for (int m = 0; m < 4; ++m) { bf16_t* rowp = O + (size_t)(row0 + ai * HALF + m * 16) * ldc + col0;
                const f32x4 g0 = acc[ai][0][m][0], g1 = acc[ai][0][m][1], u0 = acc[ai][1][m][0], u1 = acc[ai][1][m][1];
                u32x4 w;
                w.x = cvt_pk_bf16(silu_f(g0[0]) * u0[0], silu_f(g0[1]) * u0[1]); w.y = cvt_pk_bf16(silu_f(g0[2]) * u0[2], silu_f(g0[3]) * u0[3]);
                w.z = cvt_pk_bf16(silu_f(g1[0]) * u1[0], silu_f(g1[1]) * u1[1]); w.w = cvt_pk_bf16(silu_f(g1[2]) * u1[2], silu_f(g1[3]) * u1[3]);
                *(u32x4*)rowp = w; }
    }
};

template <class Epi, class Sched, bool ALIGN_EPI = false, bool SP2 = false, bool GATHER = false>
__device__ __forceinline__ void gemm_phase(PG8_LAS unsigned char* lds, const Gemm g, const Sched& S, const Epi& E, const int tid) {
    const int wid = __builtin_amdgcn_readfirstlane(tid >> 6), lane = tid & 63, wr = wid >> 2, wc = wid & 3, fr = lane & 15, fq = lane >> 4;
    int K_ = g.K; asm volatile("" : "+s"(K_));
    const int K = K_, nt = K / BK;
    unsigned voffA[2], voffB[2];
#pragma unroll
    for (int i = 0; i < 2; ++i) { int R, C; stage_rc(tid * 16 + i * 8192, R, C); const int Rb = Epi::PERM ? ((R & ~31) + perm32(R & 31)) : R;
        voffA[i] = (unsigned)(R * K + C) * 2u; voffB[i] = (unsigned)(Rb * K + C) * 2u; }
    const size_t kstep = (size_t)(BK * 2);
    const size_t hstep = (size_t)HALF * K * 2;
    const size_t tstep = 2 * hstep;
    const unsigned ldsw = (unsigned)wid * 1024u;
    const int aoff = lds_byte(wr * 64 + fr, fq * 8), boff = lds_byte(wc * 32 + fr, fq * 8);
#define PG8_SA(b, h) (((b) * 2 + (h)) * HTB)
#define PG8_SB(b, h) ((4 + (b) * 2 + (h)) * HTB)
#define PG8_STAGE(bufoff, gbase, voff) do { _Pragma("unroll") for (int _i = 0; _i < 2; ++_i) \
        __builtin_amdgcn_global_load_lds((const unsigned*)((const char*)(gbase) + (voff)[_i]), (PG8_LAS unsigned*)(lds + (bufoff) + ldsw + _i * 8192), 16, 0, 0); } while (0)
#define PG8_LDA(dst, b, h) do { _Pragma("unroll") for (int m = 0; m < 4; ++m) _Pragma("unroll") for (int k = 0; k < 2; ++k) dst[m][k] = *(const PG8_LAS bf16x8*)(lds + PG8_SA(b, h) + aoff + m * 2048 + k * 1024); } while (0)
#define PG8_LDB(dst, b, h) do { _Pragma("unroll") for (int n = 0; n < 2; ++n) _Pragma("unroll") for (int k = 0; k < 2; ++k) dst[n][k] = *(const PG8_LAS bf16x8*)(lds + PG8_SB(b, h) + boff + n * 2048 + k * 1024); } while (0)
#define PG8_MMA(ai, bj, At, Bt) do { __builtin_amdgcn_s_setprio(1); _Pragma("unroll") for (int m = 0; m < 4; ++m) _Pragma("unroll") for (int n = 0; n < 2; ++n) _Pragma("unroll") for (int k = 0; k < 2; ++k) \
        acc[ai][bj][m][n] = __builtin_amdgcn_mfma_f32_16x16x32_bf16(Bt[n][k], At[m][k], acc[ai][bj][m][n], 0, 0, 0); __builtin_amdgcn_s_setprio(0); } while (0)
#define PG8_WAIT_V(n) asm volatile("s_waitcnt vmcnt(" #n ")" ::: "memory")
#define PG8_WAIT_L(n) asm volatile("s_waitcnt lgkmcnt(" #n ")" ::: "memory")
#define PG8_BAR __builtin_amdgcn_s_barrier()
#define PG8_SCHED __builtin_amdgcn_sched_barrier(0)
    Unit cur, nxt; int ui = 0;
    if (!S.next(0, cur)) return;
    f32x4 acc[2][2][4][2];
#pragma unroll
    for (int a = 0; a < 2; ++a)
#pragma unroll
        for (int b = 0; b < 2; ++b)
#pragma unroll
            for (int m = 0; m < 4; ++m)
#pragma unroll
                for (int n = 0; n < 2; ++n) acc[a][b][m][n] = (f32x4){0.f, 0.f, 0.f, 0.f};
    bf16x8 At[4][2], B0[2][2], B1[2][2];
    const char* cA = GATHER ? (const char*)g.A : (const char*)g.A + (size_t)cur.pm * tstep; const char* cB = (const char*)g.Bt + (size_t)cur.pn * tstep;
    unsigned gc0[2] = {0u, 0u}, gc1[2] = {0u, 0u}, gn0[2] = {0u, 0u}, gn1[2] = {0u, 0u}; int gR[2] = {0, 0}; unsigned gC[2] = {0u, 0u};
    if constexpr (GATHER) {
#pragma unroll
        for (int i = 0; i < 2; ++i) { int R, C; stage_rc(tid * 16 + i * 8192, R, C); gR[i] = R; gC[i] = (unsigned)C * 2u;
            gc0[i] = (unsigned)g.rowidx[cur.pm * BM + R] * (unsigned)(K * 2) + gC[i]; gc1[i] = (unsigned)g.rowidx[cur.pm * BM + HALF + R] * (unsigned)(K * 2) + gC[i]; }
    }
#define PG8_STAGE_A(bufoff, base, half, o0, o1) do { if constexpr (GATHER) { if ((half) == 0) PG8_STAGE(bufoff, base, o0); else PG8_STAGE(bufoff, base, o1); } \
        else PG8_STAGE(bufoff, (base) + ((half) ? hstep : 0), voffA); } while (0)
    S.a_ready(cur);
    if constexpr (SP2) {
        PG8_STAGE(PG8_SB(0, 0), cB, voffB); PG8_STAGE(PG8_SB(0, 1), cB + hstep, voffB); PG8_STAGE_A(PG8_SA(0, 0), cA, 0, gc0, gc1); PG8_STAGE_A(PG8_SA(0, 1), cA, 1, gc0, gc1);
        if (wr == 1) PG8_BAR;
        PG8_WAIT_V(2); PG8_BAR;
        PG8_STAGE(PG8_SB(1, 0), cB + kstep, voffB); PG8_STAGE_A(PG8_SA(1, 0), cA + kstep, 0, gc0, gc1); PG8_STAGE(PG8_SB(1, 1), cB + hstep + kstep, voffB);
        PG8_WAIT_V(6); PG8_BAR;
    } else {
        PG8_STAGE(PG8_SB(0, 0), cB, voffB); PG8_STAGE(PG8_SA(0, 0), cA, voffA); PG8_STAGE(PG8_SB(0, 1), cB + hstep, voffB); PG8_STAGE(PG8_SA(0, 1), cA + hstep, voffA);
        if (wr == 1) PG8_BAR;
        PG8_WAIT_V(4); PG8_BAR;
        PG8_STAGE(PG8_SB(1, 0), cB + kstep, voffB); PG8_STAGE(PG8_SA(1, 0), cA + kstep, voffA); PG8_STAGE(PG8_SB(1, 1), cB + hstep + kstep, voffB);
        PG8_WAIT_V(6); PG8_BAR;
    }
    for (;;) {
        const bool has_next = S.next(ui + 1, nxt);
        const char* nA = GATHER ? cA : (has_next ? (const char*)g.A + (size_t)nxt.pm * tstep : cA); const char* nB = has_next ? (const char*)g.Bt + (size_t)nxt.pn * tstep : cB;
        if constexpr (GATHER) { const int npm = has_next ? nxt.pm : cur.pm;
#pragma unroll
            for (int i = 0; i < 2; ++i) { gn0[i] = (unsigned)g.rowidx[npm * BM + gR[i]] * (unsigned)(K * 2) + gC[i]; gn1[i] = (unsigned)g.rowidx[npm * BM + HALF + gR[i]] * (unsigned)(K * 2) + gC[i]; } }
        for (int t = 0; t < nt; t += 2) {
            const bool last = (t == nt - 2);
            const char* a1 = cA + (size_t)(t + 1) * kstep;
            const char* a2 = last ? nA : cA + (size_t)(t + 2) * kstep; const char* b2 = last ? nB : cB + (size_t)(t + 2) * kstep;
            const char* a3 = a2 + kstep; const char* b3 = b2 + kstep;
            if (last && has_next) S.a_ready(nxt);
            if constexpr (SP2) {
            unsigned gs0[2], gs1[2];
#pragma unroll
            for (int i = 0; i < 2; ++i) { gs0[i] = last ? gn0[i] : gc0[i]; gs1[i] = last ? gn1[i] : gc1[i]; }
            PG8_LDB(B0, 0, 0); PG8_LDB(B1, 0, 1); PG8_SCHED; PG8_LDA(At, 0, 0); PG8_STAGE_A(PG8_SA(1, 1), a1, 1, gc0, gc1);
            PG8_WAIT_V(8); PG8_WAIT_L(0); PG8_BAR; PG8_MMA(0, 0, At, B0); PG8_MMA(0, 1, At, B1); PG8_BAR; PG8_SCHED;
            PG8_LDA(At, 0, 1); PG8_STAGE(PG8_SB(0, 0), b2, voffB); PG8_STAGE(PG8_SB(0, 1), b2 + hstep, voffB); PG8_STAGE_A(PG8_SA(0, 0), a2, 0, gs0, gs1);
            PG8_WAIT_V(8); PG8_WAIT_L(0); PG8_BAR; PG8_MMA(1, 0, At, B0); PG8_MMA(1, 1, At, B1); PG8_BAR; PG8_SCHED;
            PG8_LDB(B0, 1, 0); PG8_LDB(B1, 1, 1); PG8_SCHED; PG8_LDA(At, 1, 0); PG8_STAGE_A(PG8_SA(0, 1), a2, 1, gs0, gs1);
            PG8_WAIT_V(8); PG8_WAIT_L(0); PG8_BAR; PG8_MMA(0, 0, At, B0); PG8_MMA(0, 1, At, B1); PG8_BAR; PG8_SCHED;
            PG8_LDA(At, 1, 1); PG8_STAGE(PG8_SB(1, 0), b3, voffB); PG8_STAGE(PG8_SB(1, 1), b3 + hstep, voffB); PG8_STAGE_A(PG8_SA(1, 0), a3, 0, gs0, gs1);
            PG8_WAIT_V(8); PG8_WAIT_L(0); PG8_BAR; PG8_MMA(1, 0, At, B0); PG8_MMA(1, 1, At, B1); PG8_BAR; PG8_SCHED;
            } else {
            PG8_LDB(B0, 0, 0); PG8_SCHED; PG8_LDA(At, 0, 0); PG8_STAGE(PG8_SA(1, 1), a1 + hstep, voffA);
            PG8_WAIT_L(8); PG8_BAR; PG8_WAIT_L(0); PG8_MMA(0, 0, At, B0); PG8_BAR; PG8_SCHED;
            PG8_LDB(B1, 0, 1); PG8_STAGE(PG8_SB(0, 0), b2, voffB);
            PG8_BAR; PG8_WAIT_L(0); PG8_MMA(0, 1, At, B1); PG8_BAR;
            PG8_LDA(At, 0, 1); PG8_STAGE(PG8_SA(0, 0), a2, voffA);
            PG8_BAR; PG8_WAIT_L(0); PG8_MMA(1, 0, At, B0); PG8_BAR; PG8_SCHED;
            PG8_STAGE(PG8_SB(0, 1), b2 + hstep, voffB);
            PG8_WAIT_V(6); PG8_BAR; PG8_MMA(1, 1, At, B1); PG8_BAR;
            PG8_LDB(B0, 1, 0); PG8_SCHED; PG8_LDA(At, 1, 0); PG8_STAGE(PG8_SA(0, 1), a2 + hstep, voffA);
            PG8_WAIT_L(8); PG8_BAR; PG8_WAIT_L(0); PG8_MMA(0, 0, At, B0); PG8_BAR; PG8_SCHED;
            PG8_LDB(B1, 1, 1); PG8_STAGE(PG8_SB(1, 0), b3, voffB);
            PG8_BAR; PG8_WAIT_L(0); PG8_MMA(0, 1, At, B1); PG8_BAR;
            PG8_LDA(At, 1, 1); PG8_STAGE(PG8_SA(1, 0), a3, voffA);
            PG8_BAR; PG8_WAIT_L(0); PG8_MMA(1, 0, At, B0); PG8_BAR; PG8_SCHED;
            PG8_STAGE(PG8_SB(1, 1), b3 + hstep, voffB);
            PG8_WAIT_V(6); PG8_BAR; PG8_MMA(1, 1, At, B1); PG8_BAR;
            }
        }
        if constexpr (ALIGN_EPI) { if (wr == 0) PG8_BAR; }
        if constexpr (!Epi::AFTER_DRAIN) { E(acc, cur, wr, wc, fr, fq); S.done(cur); }
        if (!has_next) break;
#pragma unroll
        for (int a = 0; a < 2; ++a)
#pragma unroll
            for (int b = 0; b < 2; ++b)
#pragma unroll
                for (int m = 0; m < 4; ++m)
#pragma unroll
                    for (int n = 0; n < 2; ++n) acc[a][b][m][n] = (f32x4){0.f, 0.f, 0.f, 0.f};
        cur = nxt; cA = nA; cB = nB; ++ui;
        if constexpr (GATHER) { gc0[0] = gn0[0]; gc0[1] = gn0[1]; gc1[0] = gn1[0]; gc1[1] = gn1[1]; }
        if constexpr (ALIGN_EPI) { if (wr == 1) PG8_BAR; }
    }
    PG8_WAIT_V(0);
    if constexpr (!ALIGN_EPI) { if (wr == 0) PG8_BAR; }
    PG8_BAR;
#undef PG8_SA
#undef PG8_SB
#undef PG8_STAGE
#undef PG8_STAGE_A
#undef PG8_LDA
#undef PG8_LDB
#undef PG8_MMA
#undef PG8_WAIT_V
#undef PG8_WAIT_L
#undef PG8_BAR
#undef PG8_SCHED
}
}

constexpr int NWAVES = 8, NTHR = 512;
constexpr int BATCH = 2, SEQ = 8192, DM = 1024, MTOK = BATCH * SEQ;
constexpr int DIN = 2960, DINP = 3072;
constexpr int NEXP = 16, CAP = 1024, EFF = 2048;
constexpr float EPS = 1e-6f;
constexpr int U_MLQ = 0, U_MLK = 256, U_MLV = 512, U_MLO = 768, U_MLG = 1024, U_CQ = 1040, U_CKV = 1264, U_KR = 1392, U_HY = 1424, U_SC = 2192;
constexpr float LOG2E = 1.4426950408889634f;

constexpr size_t MiB = 1u << 20;
constexpr size_t WS_CTL = 0, CTL_ZERO_BYTES = 1 * MiB;
constexpr size_t WS_MOD = 1 * MiB;
constexpr size_t WS_MLS = 1 * MiB + 128 * 1024;
constexpr size_t WS_MLN = 1 * MiB + 256 * 1024;
constexpr size_t WS_AFF = 2 * MiB;
constexpr size_t WS_SLOT = 3 * MiB;
constexpr size_t WS_IDX = 4 * MiB;
constexpr size_t WS_HID = 5 * MiB;
constexpr size_t WS_WMLA = 9 * MiB;
constexpr size_t WS_WOUT = 11 * MiB;
constexpr size_t WS_WIN = 15 * MiB;
constexpr size_t WS_WGU = 28 * MiB;
constexpr size_t WS_WDN = 284 * MiB;
constexpr size_t WS_XN = 412 * MiB;
constexpr size_t WS_AMLA = 444 * MiB;
constexpr size_t WS_Q = 456 * MiB;
constexpr size_t WS_KIMG = 468 * MiB;
constexpr size_t WS_VIMG = 480 * MiB;
constexpr size_t WS_MLC = 488 * MiB;
constexpr size_t WS_HF = 504 * MiB;
constexpr size_t WS_HB = 520 * MiB;
constexpr size_t WS_YATT = 536 * MiB;
constexpr size_t WS_YHT = 544 * MiB;
constexpr size_t WS_YN = 552 * MiB;
constexpr size_t WS_X1 = 584 * MiB;
constexpr size_t WS_U = 648 * MiB;
constexpr size_t WS_OMLA = 744 * MiB;
constexpr size_t WS_ACT = 648 * MiB;
constexpr size_t WS_KF = 776 * MiB;
constexpr size_t WS_Y2 = 776 * MiB;
constexpr size_t WS_XE = 776 * MiB;
constexpr size_t WS_YE = 840 * MiB;
constexpr size_t WS_HYT = 904 * MiB;
constexpr size_t WS_FILT = 956 * MiB;
constexpr size_t WS_END = 1020 * MiB;
constexpr int CW_BAR = 4096;

constexpr int RING_BYTES = 139264;
constexpr int LDSCTL_OFF = RING_BYTES, MISC_OFF = LDSCTL_OFF + 320;
constexpr int XTRA_OFF = RING_BYTES + 1024;
constexpr int LDS_BYTES = 147456;

__device__ __forceinline__ float bf2f(unsigned short u) { return __uint_as_float((unsigned)u << 16); }
__device__ __forceinline__ unsigned pk2(float lo, float hi) { f32x2 v = {lo, hi}; bf16x2_t b = __builtin_convertvector(v, bf16x2_t); return __builtin_bit_cast(unsigned, b); }
__device__ __forceinline__ float bflo(unsigned w) { return __uint_as_float(w << 16); }
__device__ __forceinline__ float bfhi(unsigned w) { return __uint_as_float(w & 0xffff0000u); }
__device__ __forceinline__ float wave_sum(float v) {
#pragma unroll
    for (int o = 1; o < 64; o <<= 1) v += __shfl_xor(v, o);
    return v;
}
__device__ __forceinline__ float fexp(float x) { return __builtin_amdgcn_exp2f(x * LOG2E); }
__device__ __forceinline__ float flog(float x) { return __builtin_amdgcn_logf(x) * 0.6931471805599453f; }
__device__ __forceinline__ float sin_rev(float r) { return __builtin_amdgcn_sinf(r); }
__device__ __forceinline__ float cos_rev(float r) { return __builtin_amdgcn_cosf(r); }
__device__ __forceinline__ float sin_rad(float x) { float r = x * 0.15915494309189535f; r = r - __builtin_rintf(r); return __builtin_amdgcn_sinf(r); }
__device__ __forceinline__ int crow(int r, int hi) { return (r & 3) + 8 * (r >> 2) + 4 * hi; }
#define LDS_WAIT() asm volatile("s_waitcnt lgkmcnt(0)" ::: "memory")
#define VM_WAIT() asm volatile("s_waitcnt vmcnt(0)" ::: "memory")

#define XB_TMO      128
#define XB_XCNT(j)  (256  + 64 * (j))
#define XB_XSUB(j)  (1280 + 64 * (j))
#define XB_XGEN(j)  (2304 + 64 * (j))
#define XB_TOP      3328
#define XB_TOPGEN   3392
#define XCD_BAR_WORDS 3456
#define XB_SPIN_CAP (1u << 18)
__device__ __forceinline__ unsigned xb_ld(unsigned* p)              { return __hip_atomic_load(p, __ATOMIC_RELAXED, __HIP_MEMORY_SCOPE_AGENT); }
__device__ __forceinline__ unsigned xb_add(unsigned* p, unsigned v) { return __hip_atomic_fetch_add(p, v, __ATOMIC_RELAXED, __HIP_MEMORY_SCOPE_AGENT); }
__device__ __forceinline__ unsigned xb_xcc_id() { return (unsigned)__builtin_amdgcn_s_getreg((3 << 11) | 20) & 0xFu; }
#define XB_SPIN(cond, bar) do { unsigned _sp = 0; while (cond) { __builtin_amdgcn_s_sleep(1); \
    if ((++_sp & 255u) == 0u) { if (xb_ld(&(bar)[XB_TMO])) break; if (_sp > XB_SPIN_CAP) { atomicAdd(&(bar)[XB_TMO], 1u); break; } } } } while (0)
struct XcdBarrier { unsigned* bar; unsigned x; volatile LAS unsigned* st; };
__device__ __forceinline__ XcdBarrier xcd_barrier_post(unsigned* bar, volatile LAS unsigned* st) {
    XcdBarrier b; b.bar = bar; b.x = xb_xcc_id(); b.st = st;
    if (threadIdx.x == 0) (void)xb_add(&bar[XB_XCNT(b.x)], 1u);
    return b;
}
__device__ __forceinline__ void xcd_barrier_complete(unsigned* bar, unsigned x, unsigned& nloc, unsigned& nx) {
    const unsigned G = gridDim.x * gridDim.y * gridDim.z;
    unsigned sum, cnt, mine, sp = 0u;
    for (;;) {
        sum = 0u; cnt = 0u; mine = 0u;
#pragma unroll
        for (unsigned j = 0; j < 16; ++j) { const unsigned c = xb_ld(&bar[XB_XCNT(j)]); sum += c; cnt += (c > 0u) ? 1u : 0u; mine = (j == x) ? c : mine; }
        if (sum == G) break;
        __builtin_amdgcn_s_sleep(1);
        if ((++sp & 255u) == 0u) { if (xb_ld(&bar[XB_TMO])) break; if (sp > XB_SPIN_CAP) { atomicAdd(&bar[XB_TMO], 1u); break; } }
    }
    nloc = mine > 0u ? mine : 1u; nx = cnt > 0u ? cnt : 1u;
}
__device__ __forceinline__ void xcd_barrier(const XcdBarrier& b) {
    asm volatile("s_waitcnt vmcnt(0)" ::: "memory");
    __syncthreads();
    if (threadIdx.x == 0) {
        unsigned* bar = b.bar;
        __builtin_amdgcn_s_waitcnt(0);
        unsigned nloc = b.st[0], nx = b.st[1];
        if (nloc == 0u) { xcd_barrier_complete(bar, b.x, nloc, nx); b.st[0] = nloc; b.st[1] = nx; }
        const unsigned old = xb_add(&bar[XB_XSUB(b.x)], 1u);
        const unsigned gen = old / nloc;
        if (old + 1u == (gen + 1u) * nloc) {
            __builtin_amdgcn_fence(__ATOMIC_RELEASE, "agent");
            asm volatile("s_waitcnt vmcnt(0)" ::: "memory");
            const unsigned og = xb_add(&bar[XB_TOP], 1u);
            const unsigned tg = og / nx;
            if (og + 1u == (tg + 1u) * nx) xb_add(&bar[XB_TOPGEN], 1u);
            else XB_SPIN(xb_ld(&bar[XB_TOPGEN]) == tg, bar);
            __builtin_amdgcn_fence(__ATOMIC_ACQUIRE, "agent");
            xb_add(&bar[XB_XGEN(b.x)], 1u);
            asm volatile("s_waitcnt vmcnt(0)" ::: "memory");
        } else {
            XB_SPIN(xb_ld(&bar[XB_XGEN(b.x)]) == gen, bar);
            __builtin_amdgcn_fence(__ATOMIC_ACQUIRE, "agent");
            asm volatile("s_waitcnt vmcnt(0)" ::: "memory");
        }
    }
    __syncthreads();
}

struct Args { const void* in[35]; float* out; unsigned char* ws; int ph_lo, ph_hi; };
struct Frame {
    LAS unsigned char* lds;
    int tid, lane, wave, vcu, G;
    const Args* a;
    unsigned char* ws;
};
#define INF(i) ((const float*)F.a->in[i])
#define WSP(T, off) ((T*)(F.ws + (off)))

__device__ __forceinline__ void tr_item(const float* W, int ldw, int Kvalid, int Nvalid, int k0, int n0, bf16_t* dst, int dpitch, int drow0, int dk0, LAS float* scr, int lane) {
    f32x4 v[16];
    const int nn = n0 + 4 * (lane & 15);
#pragma unroll
    for (int i = 0; i < 16; ++i) { const int kk = 4 * i + (lane >> 4);
        v[i] = (f32x4){0.f, 0.f, 0.f, 0.f};
        if (W != nullptr && (k0 + kk) < Kvalid && nn < Nvalid) v[i] = *(const GAS f32x4*)(W + (size_t)(k0 + kk) * ldw + nn); }
#pragma unroll
    for (int i = 0; i < 16; ++i) { const int kk = 4 * i + (lane >> 4);
        *(LAS f32x4*)(scr + kk * 64 + ((4 * (lane & 15)) ^ (4 * ((kk >> 3) & 7)))) = v[i]; }
    LDS_WAIT(); asm volatile("" ::: "memory");
    const int kc = lane & 7, nl = lane >> 3;
#pragma unroll
    for (int j = 0; j < 8; ++j) { const int n = 8 * j + nl; const LAS float* sp = scr + (8 * kc) * 64 + (n ^ (4 * kc));
        u32x4 o; o.x = pk2(sp[0 * 64], sp[1 * 64]); o.y = pk2(sp[2 * 64], sp[3 * 64]); o.z = pk2(sp[4 * 64], sp[5 * 64]); o.w = pk2(sp[6 * 64], sp[7 * 64]);
        *(GAS u32x4*)(dst + (size_t)(drow0 + n) * dpitch + dk0 + k0 + 8 * kc) = o; }
    LDS_WAIT(); asm volatile("" ::: "memory");
}

__device__ __forceinline__ void p0_phase(Frame& F) {
    const int tid = F.tid, lane = F.lane, wave = F.wave;
    {
        LAS float* cs = (LAS float*)(F.lds);
        LAS float* red = (LAS float*)(F.lds + 8192);
        const float* c = INF(1);
        for (int i = tid; i < 2048; i += NTHR) { const float v = c[i]; cs[i] = v / (1.0f + fexp(-v)); }
        __syncthreads();
        for (int cb = blockIdx.x; cb < 256; cb += F.G) {
            const int j = tid % 48, kg = tid / 48;
            const int col = cb * 48 + j, l = col / 6144, n = col % 6144;
            if (kg < 10) {
                const float* w = INF(3) + (size_t)l * 1024 * 6144 + n;
                float a0 = 0.f, a1 = 0.f;
#pragma unroll 26
                for (int k = kg; k < 1024; k += 10) { const float wv = w[(size_t)k * 6144]; a0 += cs[k] * wv; a1 += cs[1024 + k] * wv; }
                red[(kg * 48 + j) * 2] = a0; red[(kg * 48 + j) * 2 + 1] = a1;
            }
            __syncthreads();
            if (tid < 96) { const int jj = tid >> 1, b = tid & 1; float s = 0.f;
                for (int g = 0; g < 10; ++g) s += red[(g * 48 + jj) * 2 + b];
                const int col2 = cb * 48 + jj, l2 = col2 / 6144, n2 = col2 % 6144;
                WSP(float, WS_MOD)[(l2 * 2 + b) * 6144 + n2] = s + INF(4)[l2 * 6144 + n2]; }
            __syncthreads();
        }
    }
    {
        const int gw = F.vcu * NWAVES + wave, NGW = F.G * NWAVES;
        for (int l = 0; l < 2; ++l) {
            const float* w1 = INF(18) + l * 17 * 64; const float* w2 = INF(21) + l * 64 * 64;
            float w1c[17], w2c[64];
#pragma unroll
            for (int i = 0; i < 17; ++i) w1c[i] = w1[i * 64 + lane];
#pragma unroll
            for (int k = 0; k < 64; ++k) w2c[k] = w2[k * 64 + lane];
            const float b1 = INF(19)[l * 64 + lane], fr1 = INF(20)[l * 64 + lane], b2 = INF(22)[l * 64 + lane], fr2 = INF(23)[l * 64 + lane];
            for (int t = gw; t < SEQ; t += NGW) {
                const float tt = (float)t * (1.0f / SEQ);
                float a = b1 + tt * w1c[0];
#pragma unroll
                for (int bnd = 1; bnd <= 8; ++bnd) { float r = (float)((t * bnd) & (SEQ - 1)) * (1.0f / SEQ); a += sin_rev(r) * w1c[bnd] + cos_rev(r) * w1c[8 + bnd]; }
                const float h1 = sin_rad(fr1 * a);
                float a2 = b2;
#pragma unroll
                for (int k = 0; k < 64; ++k) a2 += __shfl(h1, k) * w2c[k];
                WSP(float, WS_HID)[((size_t)l * SEQ + t) * 64 + lane] = sin_rad(fr2 * a2);
            }
        }
    }
    {
        LAS float* scr = (LAS float*)(F.lds + wave * 16384);
        const int gw = F.vcu * NWAVES + wave, NGW = F.G * NWAVES;
        constexpr int I_WIN = 16 * 48, I_WOUT = 16 * 16, I_WMLA = 6 * 16, I_GU = 16 * 2 * 16 * 32, I_DN = 16 * 32 * 16;
        constexpr int I_LAYER = I_WIN + I_WOUT + I_WMLA + I_GU + I_DN;
        for (int it = gw; it < 2 * I_LAYER; it += NGW) {
            const int l = it / I_LAYER; int r = it % I_LAYER;
            if (r < I_WIN) { const int kb = r / 48, nb = r % 48;
                tr_item(INF(9) + (size_t)l * 1024 * DIN, DIN, 1024, DIN, kb * 64, nb * 64, WSP(bf16_t, WS_WIN) + (size_t)l * DINP * 1024, 1024, nb * 64, 0, scr, lane); continue; }
            r -= I_WIN;
            if (r < I_WOUT) { const int kb = r / 16, nb = r % 16;
                tr_item(INF(30) + (size_t)l * 1024 * 1024, 1024, 1024, 1024, kb * 64, nb * 64, WSP(bf16_t, WS_WOUT) + (size_t)l * 1024 * 1024, 1024, nb * 64, 0, scr, lane); continue; }
            r -= I_WOUT;
            if (r < I_WMLA) { const int kb = r / 16, nb = r % 16;
                bf16_t* dst = WSP(bf16_t, WS_WMLA) + (size_t)l * 1024 * 384;
                const float* W = nullptr; int ldw = 4, Kv = 0, Nv = 0, ksrc = 0, nsrc = 0;
                if (nb < 6 && kb < 4) { W = INF(13) + (size_t)l * 224 * 384; ldw = 384; Kv = 224; Nv = 384; ksrc = kb * 64; nsrc = nb * 64; }
                else if (nb >= 6 && nb < 10 && kb >= 4) { W = INF(14) + (size_t)l * 128 * 256; ldw = 256; Kv = 128; Nv = 256; ksrc = (kb - 4) * 64; nsrc = (nb - 6) * 64; }
                else if (nb >= 10 && nb < 14 && kb >= 4) { W = INF(15) + (size_t)l * 128 * 256; ldw = 256; Kv = 128; Nv = 256; ksrc = (kb - 4) * 64; nsrc = (nb - 10) * 64; }
                tr_item(W, ldw, Kv, Nv, ksrc, nsrc, dst, 384, nb * 64, kb * 64 - ksrc, scr, lane); continue; }
            r -= I_WMLA;
            if (r < I_GU) { const int e = r / (2 * 16 * 32); int q = r % (2 * 16 * 32); const int which = q / (16 * 32); q %= (16 * 32); const int kb = q / 32, nb = q % 32;
                const float* W = INF(which ? 33 : 32) + ((size_t)l * NEXP + e) * 1024 * 2048;
                const int n0 = nb * 64, drow = (n0 >> 7) * 256 + (n0 & 127) + (which ? 128 : 0);
                tr_item(W, 2048, 1024, 2048, kb * 64, n0, WSP(bf16_t, WS_WGU) + ((size_t)l * NEXP + e) * 4096 * 1024, 1024, drow, 0, scr, lane); continue; }
            r -= I_GU;
            { const int e = r / (32 * 16); const int q = r % (32 * 16); const int kb = q / 16, nb = q % 16;
                const float* W = INF(34) + ((size_t)l * NEXP + e) * 2048 * 1024;
                tr_item(W, 1024, 2048, 1024, kb * 64, nb * 64, WSP(bf16_t, WS_WDN) + ((size_t)l * NEXP + e) * 1024 * 2048, 2048, nb * 64, 0, scr, lane); }
        }
    }
}

__device__ __forceinline__ void ld_row_f32(const float* p, int lane, f32x4 (&v)[4]) {
    const GAS f32x4* r = (const GAS f32x4*)p + lane;
#pragma unroll
    for (int j = 0; j < 4; ++j) v[j] = r[64 * j];
}
__device__ __forceinline__ void st_row_f32(float* p, int lane, const f32x4 (&v)[4]) {
    GAS f32x4* r = (GAS f32x4*)p + lane;
#pragma unroll
    for (int j = 0; j < 4; ++j) r[64 * j] = v[j];
}
__device__ __forceinline__ void st_row_bf16(bf16_t* p, int lane, const f32x4 (&v)[4]) {
    GAS u32x2* r = (GAS u32x2*)p + lane;
#pragma unroll
    for (int j = 0; j < 4; ++j) { u32x2 w; w.x = pk2(v[j].x, v[j].y); w.y = pk2(v[j].z, v[j].w); r[64 * j] = w; }
}
__device__ __forceinline__ float row_ss(const f32x4 (&v)[4]) {
    float s = 0.f;
#pragma unroll
    for (int j = 0; j < 4; ++j) s += (v[j].x * v[j].x + v[j].y * v[j].y) + (v[j].z * v[j].z + v[j].w * v[j].w);
    return wave_sum(s);
}
__device__ __forceinline__ void modnorm(const f32x4 (&x)[4], const float* g, const float* sc, const float* sh, int lane, f32x4 (&h)[4]) {
    const float rstd = __builtin_amdgcn_rsqf(row_ss(x) * (1.0f / DM) + EPS);
    f32x4 gv[4], scv[4], shv[4];
    ld_row_f32(g, lane, gv); ld_row_f32(sc, lane, scv); ld_row_f32(sh, lane, shv);
#pragma unroll
    for (int j = 0; j < 4; ++j) h[j] = (x[j] * rstd) * gv[j] * (scv[j] + 1.0f) + shv[j];
}

__device__ __forceinline__ void filt_gemm_tile(Frame& F, int wt) {
    const int lane = F.lane, hi = lane >> 5, l31 = lane & 31;
    const int l = wt >> 11, r = wt & 2047, t0 = (r >> 3) * 32, col0 = (r & 7) * 128;
    f32x16 acc[4];
#pragma unroll
    for (int jb = 0; jb < 4; ++jb)
#pragma unroll
        for (int q = 0; q < 16; ++q) acc[jb][q] = 0.f;
    const float* hid = WSP(float, WS_HID) + ((size_t)l * SEQ + t0 + l31) * 64 + hi;
    const float* w3 = INF(24) + (size_t)l * 64 * 1024 + (size_t)hi * 1024 + col0 + l31;
#pragma unroll
    for (int s2 = 0; s2 < 32; ++s2) {
        const float bv = hid[2 * s2];
#pragma unroll
        for (int jb = 0; jb < 4; ++jb) { const float av = w3[(size_t)(2 * s2) * 1024 + 32 * jb]; acc[jb] = __builtin_amdgcn_mfma_f32_32x32x2f32(av, bv, acc[jb], 0, 0, 0); }
    }
    const float tt = (float)(t0 + l31) * (1.0f / SEQ);
    float* FT = WSP(float, WS_FILT) + (size_t)l * 1024 * SEQ + t0 + l31;
#pragma unroll
    for (int jb = 0; jb < 4; ++jb)
#pragma unroll
        for (int q = 0; q < 16; ++q) { const int col = col0 + 32 * jb + crow(q, hi);
            const float v = (acc[jb][q] + INF(25)[l * 1024 + col]) * fexp(-tt * fexp(INF(26)[l * 1024 + col]));
            FT[(size_t)col * SEQ] = v; }
}

__device__ __forceinline__ void p1_phase(Frame& F) {
    const int gw = F.vcu * NWAVES + F.wave, NGW = F.G * NWAVES;
    const float* mod = WSP(float, WS_MOD);
    for (int m = gw; m < MTOK; m += 2 * NGW) {
        const int m2 = (m + NGW < MTOK) ? m + NGW : m; f32x4 xa[4], xb[4], h[4];
        ld_row_f32(INF(0) + (size_t)m * DM, F.lane, xa); ld_row_f32(INF(0) + (size_t)m2 * DM, F.lane, xb);
        { const int b = m >> 13; modnorm(xa, INF(5), mod + (0 * 2 + b) * 6144 + 1024, mod + (0 * 2 + b) * 6144, F.lane, h); st_row_bf16(WSP(bf16_t, WS_XN) + (size_t)m * DM, F.lane, h); }
        { const int b = m2 >> 13; modnorm(xb, INF(5), mod + (0 * 2 + b) * 6144 + 1024, mod + (0 * 2 + b) * 6144, F.lane, h); st_row_bf16(WSP(bf16_t, WS_XN) + (size_t)m2 * DM, F.lane, h); }
    }
    for (int wt = gw; wt < 4096; wt += NGW) filt_gemm_tile(F, wt);
}

__device__ __forceinline__ float wave_scan_add(float v, int lane) {
#pragma unroll
    for (int o = 1; o < 64; o <<= 1) { const float n = __shfl_up(v, o); if (lane >= o) v += n; }
    return v;
}
__device__ __forceinline__ float wave_scan_max(float v, int lane) {
#pragma unroll
    for (int o = 1; o < 64; o <<= 1) { const float n = __shfl_up(v, o); if (lane >= o) v = fmaxf(v, n); }
    return v;
}
__device__ __forceinline__ float wave_max(float v) {
#pragma unroll
    for (int o = 1; o < 64; o <<= 1) v = fmaxf(v, __shfl_xor(v, o));
    return v;
}
__device__ __forceinline__ float logsigmoid(float x) { return fminf(x, 0.f) - flog(1.0f + fexp(-fabsf(x))); }
struct MlItem { int b, h, dir, n, t0; };
__device__ __forceinline__ MlItem ml_decode(int item) { MlItem I; I.b = item >> 9; I.h = (item >> 7) & 3; I.dir = (item >> 6) & 1; I.n = item & 63;
    I.t0 = I.b * SEQ + (I.dir ? SEQ - 128 * (I.n + 1) : 128 * I.n); return I; }

__device__ __forceinline__ void ml_local_item(Frame& F, int item, int l) {
    const int tid = F.tid; const MlItem I = ml_decode(item);
    const bf16_t* U = WSP(bf16_t, WS_U);
    LAS float* EK = (LAS float*)(F.lds);
    LAS float* VV = (LAS float*)(F.lds + 32768);
    LAS float* LF = (LAS float*)(F.lds + 65536);
    LAS float* IG = LF + 128; LAS float* WW = LF + 256; LAS float* EST = LF + 384;
    const float* gb = INF(10) + l * 16;
    if (tid < 128) { const int j = tid, r = I.dir ? 127 - j : j; const size_t t = (size_t)(I.t0 + r);
        const float ipre = bf2f(U[t * DINP + U_MLG + (I.dir ? 2 : 0) * 4 + I.h]) + gb[(I.dir ? 2 : 0) * 4 + I.h];
        const float fpre = bf2f(U[t * DINP + U_MLG + (I.dir ? 3 : 1) * 4 + I.h]) + gb[(I.dir ? 3 : 1) * 4 + I.h];
        LF[j] = logsigmoid(fpre); IG[j] = ipre; }
    __syncthreads();
    float a = 0.f, aend = 0.f;
    if (tid < 128) { for (int i = 0; i < 128; ++i) { const float v = LF[i]; aend += v; if (i <= tid) a += v; }
        WW[tid] = aend - a + IG[tid]; }
    __syncthreads();
    float mloc = -3.0e38f;
    if (tid < 128) { for (int i = 0; i < 128; ++i) mloc = fmaxf(mloc, WW[i]);
        const int r = I.dir ? 127 - tid : tid; EST[r] = fexp(WW[tid] - mloc); }
    __syncthreads();
#pragma unroll
    for (int i = 0; i < 2; ++i) { const int p = tid + 512 * i, row = p >> 3, c8 = p & 7;
        const u32x4 kq = *(const GAS u32x4*)(U + (size_t)(I.t0 + row) * DINP + U_MLK + I.h * 64 + c8 * 8);
        const u32x4 vq = *(const GAS u32x4*)(U + (size_t)(I.t0 + row) * DINP + U_MLV + I.h * 64 + c8 * 8);
        const float es = EST[row] * 0.125f;
        LAS f32x4* ek = (LAS f32x4*)(EK + row * 64 + c8 * 8); LAS f32x4* vv = (LAS f32x4*)(VV + row * 64 + c8 * 8);
        ek[0] = (f32x4){bflo(kq.x) * es, bfhi(kq.x) * es, bflo(kq.y) * es, bfhi(kq.y) * es};
        ek[1] = (f32x4){bflo(kq.z) * es, bfhi(kq.z) * es, bflo(kq.w) * es, bfhi(kq.w) * es};
        vv[0] = (f32x4){bflo(vq.x), bfhi(vq.x), bflo(vq.y), bfhi(vq.y)};
        vv[1] = (f32x4){bflo(vq.z), bfhi(vq.z), bflo(vq.w), bfhi(vq.w)}; }
    __syncthreads();
    {
        const int d = tid >> 3, e0 = (tid & 7) * 8;
        f32x4 c0 = {0.f, 0.f, 0.f, 0.f}, c1 = {0.f, 0.f, 0.f, 0.f};
#pragma unroll 4
        for (int j = 0; j < 128; ++j) { const float ek = EK[j * 64 + d]; const f32x4 v0 = *(const LAS f32x4*)(VV + j * 64 + e0), v1 = *(const LAS f32x4*)(VV + j * 64 + e0 + 4);
            c0 += v0 * ek; c1 += v1 * ek; }
        GAS f32x4* dst = (GAS f32x4*)(WSP(float, WS_MLC) + (size_t)item * 4096 + d * 64 + e0);
        dst[0] = c0; dst[1] = c1;
        if (tid < 64) { float s = 0.f; for (int j = 0; j < 128; ++j) s += EK[j * 64 + tid]; WSP(float, WS_MLN)[item * 64 + tid] = s; }
        if (tid == 0) { WSP(float, WS_MLS)[item * 4] = mloc; WSP(float, WS_MLS)[item * 4 + 1] = aend; }
    }
    __syncthreads();
}

__device__ __forceinline__ void ml_scan(Frame& F) {
    float* MLC = WSP(float, WS_MLC); float* MLN = WSP(float, WS_MLN); float* MLS = WSP(float, WS_MLS);
    for (int blk = blockIdx.x; blk < 256; blk += F.G) { if (F.tid >= 260) continue; const int idx = blk * 260 + F.tid;
        const int seq = idx / 4160, el = idx % 4160;
        float* p0 = el < 4096 ? (MLC + (size_t)seq * 64 * 4096 + el) : (MLN + seq * 64 * 64 + (el - 4096));
        const int pstr = el < 4096 ? 4096 : 64;
        float mst = 0.f, st = 0.f;
#pragma unroll 1
        for (int n0 = 0; n0 < 64; n0 += 16) {
            float cl[16], mlv[16], aev[16];
#pragma unroll
            for (int i = 0; i < 16; ++i) { cl[i] = p0[(size_t)(n0 + i) * pstr]; mlv[i] = MLS[(seq * 64 + n0 + i) * 4]; aev[i] = MLS[(seq * 64 + n0 + i) * 4 + 1]; }
#pragma unroll
            for (int i = 0; i < 16; ++i) { const int item = seq * 64 + n0 + i;
                p0[(size_t)(n0 + i) * pstr] = st;
                if (el == 0) MLS[item * 4 + 2] = mst;
                const float mnew = fmaxf(aev[i] + mst, mlv[i]), sp = fexp(aev[i] + mst - mnew), sl = fexp(mlv[i] - mnew);
                st = sp * st + sl * cl[i]; mst = mnew; }
        }
    }
}

#define MFMA32(a, b, c) __builtin_amdgcn_mfma_f32_32x32x16_bf16((a), (b), (c), 0, 0, 0)
template <int NK>
__device__ __forceinline__ void qkt_tile(f32x16& p0, f32x16& p1, LAS const unsigned char* Kt, const bf16x8 (&qr)[NK], int r32, int hi) {
#pragma unroll
    for (int r = 0; r < 16; ++r) { p0[r] = 0.f; p1[r] = 0.f; }
#pragma unroll
    for (int d0 = 0; d0 < NK; ++d0) {
        const bf16x8 b0 = *(const LAS bf16x8*)(Kt + (2 * d0 + hi) * 1024 + r32 * 16);
        const bf16x8 b1 = *(const LAS bf16x8*)(Kt + (2 * d0 + hi) * 1024 + r32 * 16 + 512);
        p0 = MFMA32(b0, qr[d0], p0); p1 = MFMA32(b1, qr[d0], p1);
    }
}
typedef short v4i16_t __attribute__((ext_vector_type(4)));
__device__ __forceinline__ s16x4 vtr(LAS const unsigned char* p) { return __builtin_bit_cast(s16x4, __builtin_amdgcn_ds_read_tr16_b64_v4i16((LAS v4i16_t*)p)); }
__device__ __forceinline__ void pv_tile(f32x16 (&o)[2], LAS const unsigned char* Vt, const bf16x8 (&pa)[4], int lane) {
    const int hi = lane >> 5;
    LAS const unsigned char* vb = Vt + ((lane >> 4) & 1) * 32 + (lane & 3) * 8 + (4 * hi + ((lane & 15) >> 2)) * 64;
#pragma unroll
    for (int d0 = 0; d0 < 2; ++d0)
#pragma unroll
        for (int ks = 0; ks < 4; ++ks) {
            const s16x4 lo = vtr(vb + d0 * 4096 + ks * 1024), hh = vtr(vb + d0 * 4096 + ks * 1024 + 512);
            const bf16x8 vf = (bf16x8){lo[0], lo[1], lo[2], lo[3], hh[0], hh[1], hh[2], hh[3]};
            o[d0] = MFMA32(pa[ks], vf, o[d0]);
        }
}
__device__ __forceinline__ void pack_p(const f32x16& p0, const f32x16& p1, bf16x8 (&pa)[4]) {
    u32x4 w0, w1, w2, w3;
    w0 = (u32x4){pk2(p0[0], p0[1]), pk2(p0[2], p0[3]), pk2(p0[4], p0[5]), pk2(p0[6], p0[7])};
    w1 = (u32x4){pk2(p0[8], p0[9]), pk2(p0[10], p0[11]), pk2(p0[12], p0[13]), pk2(p0[14], p0[15])};
    w2 = (u32x4){pk2(p1[0], p1[1]), pk2(p1[2], p1[3]), pk2(p1[4], p1[5]), pk2(p1[6], p1[7])};
    w3 = (u32x4){pk2(p1[8], p1[9]), pk2(p1[10], p1[11]), pk2(p1[12], p1[13]), pk2(p1[14], p1[15])};
    pa[0] = __builtin_bit_cast(bf16x8, w0); pa[1] = __builtin_bit_cast(bf16x8, w1); pa[2] = __builtin_bit_cast(bf16x8, w2); pa[3] = __builtin_bit_cast(bf16x8, w3);
}

__device__ __forceinline__ void ml_local_pair(Frame& F, int pair, int l) {
    const int tid = F.tid, lane = F.lane, wid = F.wave, half = wid >> 2, wq = wid & 3, th = tid & 255, hi = lane >> 5;
    const int item = pair * 2 + half; const MlItem I = ml_decode(item);
    const bf16_t* U = WSP(bf16_t, WS_U);
    LAS unsigned char* base = F.lds + half * 49152;
    LAS unsigned char* EKI = base;
    LAS unsigned char* VI = base + 16384;
    LAS float* LF = (LAS float*)(base + 32768); LAS float* IG = LF + 128; LAS float* WW = LF + 256; LAS float* EST = LF + 384;
    const float* gb = INF(10) + l * 16;
    unsigned short graw_i = 0, graw_f = 0;
    if (th < 128) { const int r = I.dir ? 127 - th : th; const size_t t = (size_t)(I.t0 + r);
        graw_i = U[t * DINP + U_MLG + (I.dir ? 2 : 0) * 4 + I.h]; graw_f = U[t * DINP + U_MLG + (I.dir ? 3 : 1) * 4 + I.h]; }
    u32x4 kpc[4], vpc[4];
#pragma unroll
    for (int i = 0; i < 4; ++i) { const int p = th + 256 * i; const int tt = p >> 9, dh = (p >> 8) & 1, row = (p >> 2) & 63, c4 = p & 3, r = 64 * tt + row;
        const bf16_t* src = U + (size_t)(I.t0 + r) * DINP + I.h * 64 + dh * 32 + c4 * 8;
        kpc[i] = *(const GAS u32x4*)(src + U_MLK); vpc[i] = *(const GAS u32x4*)(src + U_MLV); }
    float a = 0.f, aend = 0.f, mloc = -3.0e38f;
    const float lfv = (th < 128) ? logsigmoid(bf2f(graw_f) + gb[(I.dir ? 3 : 1) * 4 + I.h]) : 0.f, igv = (th < 128) ? bf2f(graw_i) + gb[(I.dir ? 2 : 0) * 4 + I.h] : 0.f;
    if (th < 128) { a = wave_scan_add(lfv, lane); if (lane == 63) LF[wq] = a; }
    __syncthreads();
    float wv = 0.f;
    if (th < 128) { aend = LF[0] + LF[1]; if (wq == 1) a += LF[0]; wv = aend - a + igv; const float wm = wave_max(wv); if (lane == 0) IG[wq] = wm; }
    __syncthreads();
    if (th < 128) { mloc = fmaxf(IG[0], IG[1]); const int r = I.dir ? 127 - th : th; EST[r] = fexp(wv - mloc) * 0.125f; }
    __syncthreads();
#pragma unroll
    for (int i = 0; i < 4; ++i) { const int p = th + 256 * i; const int tt = p >> 9, dh = (p >> 8) & 1, row = (p >> 2) & 63, c4 = p & 3, r = 64 * tt + row;
        const u32x4 kq = kpc[i];
        const float es = EST[r];
        u32x4 ek; ek.x = pk2(bflo(kq.x) * es, bfhi(kq.x) * es); ek.y = pk2(bflo(kq.y) * es, bfhi(kq.y) * es); ek.z = pk2(bflo(kq.z) * es, bfhi(kq.z) * es); ek.w = pk2(bflo(kq.w) * es, bfhi(kq.w) * es);
        const int off = tt * 8192 + dh * 4096 + row * 64 + c4 * 16;
        *(LAS u32x4*)(EKI + off) = ek; *(LAS u32x4*)(VI + off) = vpc[i]; }
    __syncthreads();
    {
        const int da = wq >> 1, eb = wq & 1;
        f32x16 acc;
#pragma unroll
        for (int r = 0; r < 16; ++r) acc[r] = 0.f;
        const int lo_off = ((lane >> 4) & 1) * 32 + (lane & 3) * 8 + (4 * hi + ((lane & 15) >> 2)) * 64;
#pragma unroll
        for (int tt = 0; tt < 2; ++tt)
#pragma unroll
            for (int ks = 0; ks < 4; ++ks) {
                LAS const unsigned char* ap = EKI + tt * 8192 + da * 4096 + lo_off + ks * 1024; LAS const unsigned char* bp = VI + tt * 8192 + eb * 4096 + lo_off + ks * 1024;
                const s16x4 a0 = vtr(ap), a1 = vtr(ap + 512), b0 = vtr(bp), b1 = vtr(bp + 512);
                const bf16x8 af = (bf16x8){a0[0], a0[1], a0[2], a0[3], a1[0], a1[1], a1[2], a1[3]}, bf = (bf16x8){b0[0], b0[1], b0[2], b0[3], b1[0], b1[1], b1[2], b1[3]};
                acc = MFMA32(af, bf, acc); }
        float* dst = WSP(float, WS_MLC) + (size_t)item * 4096 + eb * 32 + (lane & 31);
#pragma unroll
        for (int r = 0; r < 16; ++r) dst[(da * 32 + crow(r, hi)) * 64] = acc[r];
        if (th < 64) { const int dh = th >> 5, col = th & 31; float sacc = 0.f;
            for (int tt = 0; tt < 2; ++tt) for (int row = 0; row < 64; ++row) sacc += bf2f(*(const LAS unsigned short*)(EKI + tt * 8192 + dh * 4096 + row * 64 + col * 2));
            WSP(float, WS_MLN)[item * 64 + th] = sacc; }
        if (th == 0) { WSP(float, WS_MLS)[item * 4] = mloc; WSP(float, WS_MLS)[item * 4 + 1] = aend; }
    }
    __syncthreads();
}

__device__ __forceinline__ void ml_out_pair(Frame& F, int pair, int l) {
    const int tid = F.tid, lane = F.lane, wid = F.wave, half = wid >> 2, wq = wid & 3, th = tid & 255, r32 = lane & 31, hi = lane >> 5;
    const int item = pair * 2 + half; const MlItem I = ml_decode(item);
    const bf16_t* U = WSP(bf16_t, WS_U);
    LAS unsigned char* base = F.lds + half * 49152;
    LAS unsigned char* KI = base;
    LAS unsigned char* VI = base + 16384;
    LAS unsigned char* CT = base + 32768;
    LAS float* vec = (LAS float*)(base + 32768 + 9216);
    LAS float* LF = vec; LAS float* IG = vec + 128; LAS float* BL = vec + 256; LAS float* SA = vec + 384; LAS float* SCI = vec + 512; LAS float* EDEN = vec + 640;
    LAS float* NPV = vec + 768; LAS float* wsf = vec + 832 + wq * 64;
    const float* gb = INF(10) + l * 16;
    unsigned short graw_i = 0, graw_f = 0; float mprev = 0.f;
    if (th < 128) { const int r = I.dir ? 127 - th : th; const size_t t = (size_t)(I.t0 + r);
        graw_i = U[t * DINP + U_MLG + (I.dir ? 2 : 0) * 4 + I.h]; graw_f = U[t * DINP + U_MLG + (I.dir ? 3 : 1) * 4 + I.h];
        mprev = WSP(float, WS_MLS)[item * 4 + 2]; }
    u32x4 kpc[4], vpc[4];
#pragma unroll
    for (int i = 0; i < 4; ++i) { const int p = th + 256 * i;
        { const int tt = p >> 9, c = (p >> 6) & 7, kv = p & 63, j = 64 * tt + kv, r = I.dir ? 127 - j : j;
          kpc[i] = *(const GAS u32x4*)(U + (size_t)(I.t0 + r) * DINP + U_MLK + I.h * 64 + c * 8); }
        { const int tt = p >> 9, dh = (p >> 8) & 1, kv = (p >> 2) & 63, c4 = p & 3, j = 64 * tt + kv, r = I.dir ? 127 - j : j;
          vpc[i] = *(const GAS u32x4*)(U + (size_t)(I.t0 + r) * DINP + U_MLV + I.h * 64 + dh * 32 + c4 * 8); } }
    float cpv[16];
    { const float* cp = WSP(float, WS_MLC) + (size_t)item * 4096;
#pragma unroll
      for (int i = 0; i < 16; ++i) cpv[i] = cp[th + 256 * i]; }
    const float npv = (th < 64) ? WSP(float, WS_MLN)[item * 64 + th] : 0.f;
    const int q = 32 * wq + r32;
    const int rq = I.dir ? 127 - q : q;
    bf16x8 qr[4];
    { const bf16_t* qp = U + (size_t)(I.t0 + rq) * DINP + U_MLQ + I.h * 64 + hi * 8;
#pragma unroll
      for (int d0 = 0; d0 < 4; ++d0) qr[d0] = *(const GAS bf16x8*)(qp + d0 * 16); }
    const float lfv = (th < 128) ? logsigmoid(bf2f(graw_f) + gb[(I.dir ? 3 : 1) * 4 + I.h]) : 0.f, igv = (th < 128) ? bf2f(graw_i) + gb[(I.dir ? 2 : 0) * 4 + I.h] : 0.f;
    float a = 0.f;
    if (th < 128) { a = wave_scan_add(lfv, lane); if (lane == 63) LF[wq] = a; }
#pragma unroll
    for (int i = 0; i < 4; ++i) { const int p = th + 256 * i;
        { const int tt = p >> 9, c = (p >> 6) & 7, kv = p & 63; *(LAS u32x4*)(KI + tt * 8192 + c * 1024 + kv * 16) = kpc[i]; }
        { const int tt = p >> 9, dh = (p >> 8) & 1, kv = (p >> 2) & 63, c4 = p & 3; *(LAS u32x4*)(VI + tt * 8192 + dh * 4096 + kv * 64 + c4 * 16) = vpc[i]; } }
#pragma unroll
    for (int i = 0; i < 16; ++i) { const int idx = th + 256 * i, d = idx >> 6, e = idx & 63;
        *(LAS unsigned short*)(CT + e * 144 + d * 2) = (unsigned short)(pk2(cpv[i], 0.f) & 0xffffu); }
    if (th < 64) NPV[th] = npv;
    __syncthreads();
    float bv = 0.f, bm = -3.0e38f;
    if (th < 128) { if (wq == 1) a += LF[0]; bv = igv - a; bm = wave_scan_max(bv, lane); if (lane == 63) IG[wq] = bm; }
    __syncthreads();
    if (th < 128) { if (wq == 1) bm = fmaxf(bm, IG[0]);
        const float mt = a + fmaxf(mprev, bm);
        SA[th] = (a - mt) * LOG2E; SCI[th] = fexp(a + mprev - mt); EDEN[th] = fexp(-mt); BL[th] = bv * LOG2E; }
    __syncthreads();
    {
        f32x16 o[2];
#pragma unroll
        for (int r = 0; r < 16; ++r) { o[0][r] = 0.f; o[1][r] = 0.f; }
        const float saq = SA[q], scq = SCI[q];
        float den = 0.f;
        for (int tt = 0; tt < 2; ++tt) {
            if (64 * tt > 32 * wq + 31) break;
            f32x16 p0, p1;
            qkt_tile<4>(p0, p1, KI + tt * 8192, qr, r32, hi);
#pragma unroll
            for (int g = 0; g < 4; ++g) {
                const f32x4 b0 = *(const LAS f32x4*)(BL + 64 * tt + 8 * g + 4 * hi), b1 = *(const LAS f32x4*)(BL + 64 * tt + 32 + 8 * g + 4 * hi);
#pragma unroll
                for (int i = 0; i < 4; ++i) { const int r = 4 * g + i; const int kv0 = 64 * tt + 8 * g + 4 * hi + i, kv1 = kv0 + 32;
                    const float e0 = (kv0 <= q) ? __builtin_amdgcn_exp2f(saq + b0[i]) * 0.125f : 0.f, e1 = (kv1 <= q) ? __builtin_amdgcn_exp2f(saq + b1[i]) * 0.125f : 0.f;
                    p0[r] *= e0; p1[r] *= e1; den += p0[r] + p1[r]; }
            }
            bf16x8 pa[4]; pack_p(p0, p1, pa);
            pv_tile(o, VI + tt * 8192, pa, lane);
        }
        float dot = 0.f;
#pragma unroll
        for (int ks = 0; ks < 4; ++ks) {
            const u32x4 qw = __builtin_bit_cast(u32x4, qr[ks]);
            const f32x4 n0 = *(const LAS f32x4*)(NPV + 16 * ks + 8 * hi), n1 = *(const LAS f32x4*)(NPV + 16 * ks + 8 * hi + 4);
            const float q0 = bflo(qw.x), q1 = bfhi(qw.x), q2 = bflo(qw.y), q3 = bfhi(qw.y), q4 = bflo(qw.z), q5 = bfhi(qw.z), q6 = bflo(qw.w), q7 = bfhi(qw.w);
            dot += q0 * n0[0] + q1 * n0[1] + q2 * n0[2] + q3 * n0[3] + q4 * n1[0] + q5 * n1[1] + q6 * n1[2] + q7 * n1[3];
            const u32x4 sw = (u32x4){pk2(q0 * scq, q1 * scq), pk2(q2 * scq, q3 * scq), pk2(q4 * scq, q5 * scq), pk2(q6 * scq, q7 * scq)};
            const bf16x8 qs = __builtin_bit_cast(bf16x8, sw);
#pragma unroll
            for (int de = 0; de < 2; ++de) {
                const bf16x8 cf = *(const LAS bf16x8*)(CT + (de * 32 + r32) * 144 + (16 * ks + 8 * hi) * 2);
                o[de] = MFMA32(qs, cf, o[de]);
            }
        }
        den += scq * dot;
        den += __shfl_xor(den, 32);
        const float rinv = 1.0f / fmaxf(fabsf(den), EDEN[q]);
        if (hi == 0) wsf[r32] = rinv;
        LDS_WAIT();
        float* dst = WSP(float, I.dir ? WS_HB : WS_HF);
#pragma unroll
        for (int r = 0; r < 16; ++r) { const int jq = 32 * wq + crow(r, hi), row = I.dir ? 127 - jq : jq; const float rr = wsf[crow(r, hi)];
            float* dp = dst + (size_t)(I.t0 + row) * 256 + I.h * 64 + r32;
            dp[0] = o[0][r] * rr; dp[32] = o[1][r] * rr; }
    }
    __syncthreads();
}

__device__ __forceinline__ void mla_prep_rows(Frame& F, int l) {
    const int gw = F.vcu * NWAVES + F.wave, NGW = F.G * NWAVES, lane = F.lane;
    const bf16_t* U = WSP(bf16_t, WS_U); bf16_t* A = WSP(bf16_t, WS_AMLA);
    f32x4 gq = {0.f, 0.f, 0.f, 0.f}; if (lane < 56) gq = *(const GAS f32x4*)(INF(11) + l * 224 + 4 * lane);
    const f32x2 gk = *(const GAS f32x2*)(INF(12) + l * 128 + 2 * lane);
    for (int m0 = gw; m0 < MTOK; m0 += 4 * NGW) {
        u32x2 qw[4]; unsigned kw[4];
#pragma unroll
        for (int r = 0; r < 4; ++r) { const int m = m0 + r * NGW; const bf16_t* ur = U + (size_t)(m < MTOK ? m : 0) * DINP;
            qw[r] = (u32x2){0u, 0u}; if (lane < 56) qw[r] = *(const GAS u32x2*)(ur + U_CQ + 4 * lane);
            kw[r] = *(const GAS unsigned*)(ur + U_CKV + 2 * lane); }
#pragma unroll
        for (int r = 0; r < 4; ++r) { const int m = m0 + r * NGW; if (m >= MTOK) break;
            const float q0 = bflo(qw[r].x), q1 = bfhi(qw[r].x), q2 = bflo(qw[r].y), q3 = bfhi(qw[r].y), k0 = bflo(kw[r]), k1 = bfhi(kw[r]);
            const float rq = __builtin_amdgcn_rsqf(wave_sum(q0 * q0 + q1 * q1 + q2 * q2 + q3 * q3) * (1.0f / 224.0f) + EPS);
            const float rk = __builtin_amdgcn_rsqf(wave_sum(k0 * k0 + k1 * k1) * (1.0f / 128.0f) + EPS);
            bf16_t* ar = A + (size_t)m * 384;
            u32x2 qo; qo.x = pk2(q0 * rq * gq.x, q1 * rq * gq.y); qo.y = pk2(q2 * rq * gq.z, q3 * rq * gq.w);
            *(GAS u32x2*)(ar + 4 * lane) = qo;
            *(GAS unsigned*)(ar + 256 + 2 * lane) = pk2(k0 * rk * gk.x, k1 * rk * gk.y); }
    }
}

__device__ __forceinline__ double rope_k(int i) {
    switch (i) { case 0: return 0.15915494309189535; case 1: return 0.08949940160889101; case 2: return 0.050329212104487035; case 3: return 0.0283021958306234;
        case 4: return 0.015915494309189534; case 5: return 0.008949940160889102; case 6: return 0.005032921210448704; case 7: return 0.00283021958306234;
        case 8: return 0.0015915494309189536; case 9: return 0.0008949940160889102; case 10: return 0.0005032921210448703; case 11: return 0.00028302195830623395;
        case 12: return 0.00015915494309189535; case 13: return 8.949940160889102e-05; case 14: return 5.0329212104487035e-05; default: return 2.8302195830623396e-05; }
}
__device__ __forceinline__ void rope_cs(int pos, int i, float& c, float& s) {
    double rev = (double)pos * rope_k(i);
    rev -= __builtin_floor(rev);
    const float r = (float)rev;
    c = cos_rev(r); s = sin_rev(r);
}
__device__ __forceinline__ void relayout_phase(Frame& F) {
    const bf16_t* O = WSP(bf16_t, WS_OMLA); const bf16_t* U = WSP(bf16_t, WS_U);
    const int* pos = (const int*)F.a->in[2];
    const float qscale = 0.10206207261596577f * LOG2E;
    for (int idx = blockIdx.x * NTHR + F.tid; idx < MTOK * 4; idx += F.G * NTHR) {
        const int t = idx >> 2, h = idx & 3, b = t >> 13, s = t & 8191, bh = b * 4 + h;
        const int p = pos[t];
        float cs[16], sn[16];
#pragma unroll
        for (int i = 0; i < 16; ++i) rope_cs(p, i, cs[i], sn[i]);
        const bf16_t* qsrc = O + (size_t)t * 1024 + h * 96;
        bf16_t* qdst = WSP(bf16_t, WS_Q) + ((size_t)bh * SEQ + s) * 96;
#pragma unroll
        for (int c = 0; c < 8; ++c) { const u32x4 w = *(const GAS u32x4*)(qsrc + c * 8);
            u32x4 o; o.x = pk2(bflo(w.x) * qscale, bfhi(w.x) * qscale); o.y = pk2(bflo(w.y) * qscale, bfhi(w.y) * qscale); o.z = pk2(bflo(w.z) * qscale, bfhi(w.z) * qscale); o.w = pk2(bflo(w.w) * qscale, bfhi(w.w) * qscale);
            *(GAS u32x4*)(qdst + c * 8) = o; }
        {
            float x1[16], x2[16];
#pragma unroll
            for (int c = 0; c < 2; ++c) { const u32x4 w = *(const GAS u32x4*)(qsrc + 64 + c * 8); const u32x4 v = *(const GAS u32x4*)(qsrc + 80 + c * 8);
                x1[c * 8 + 0] = bflo(w.x); x1[c * 8 + 1] = bfhi(w.x); x1[c * 8 + 2] = bflo(w.y); x1[c * 8 + 3] = bfhi(w.y); x1[c * 8 + 4] = bflo(w.z); x1[c * 8 + 5] = bfhi(w.z); x1[c * 8 + 6] = bflo(w.w); x1[c * 8 + 7] = bfhi(w.w);
                x2[c * 8 + 0] = bflo(v.x); x2[c * 8 + 1] = bfhi(v.x); x2[c * 8 + 2] = bflo(v.y); x2[c * 8 + 3] = bfhi(v.y); x2[c * 8 + 4] = bflo(v.z); x2[c * 8 + 5] = bfhi(v.z); x2[c * 8 + 6] = bflo(v.w); x2[c * 8 + 7] = bfhi(v.w); }
#pragma unroll
            for (int c = 0; c < 2; ++c) { u32x4 o1, o2;
#define RQ1(i) ((x1[i] * cs[i] - x2[i] * sn[i]) * qscale)
#define RQ2(i) ((x2[i] * cs[i] + x1[i] * sn[i]) * qscale)
                o1.x = pk2(RQ1(c * 8 + 0), RQ1(c * 8 + 1)); o1.y = pk2(RQ1(c * 8 + 2), RQ1(c * 8 + 3)); o1.z = pk2(RQ1(c * 8 + 4), RQ1(c * 8 + 5)); o1.w = pk2(RQ1(c * 8 + 6), RQ1(c * 8 + 7));
                o2.x = pk2(RQ2(c * 8 + 0), RQ2(c * 8 + 1)); o2.y = pk2(RQ2(c * 8 + 2), RQ2(c * 8 + 3)); o2.z = pk2(RQ2(c * 8 + 4), RQ2(c * 8 + 5)); o2.w = pk2(RQ2(c * 8 + 6), RQ2(c * 8 + 7));
                *(GAS u32x4*)(qdst + 64 + c * 8) = o1; *(GAS u32x4*)(qdst + 80 + c * 8) = o2; }
#undef RQ1
#undef RQ2
        }
        bf16_t* kdst = WSP(bf16_t, WS_KIMG) + ((size_t)bh * 128 + (s >> 6)) * 6144 + (s & 63) * 8;
        const bf16_t* ksrc = O + (size_t)t * 1024 + 384 + h * 64;
#pragma unroll
        for (int c = 0; c < 8; ++c) *(GAS u32x4*)(kdst + c * 512) = *(const GAS u32x4*)(ksrc + c * 8);
        {
            const bf16_t* krs = U + (size_t)t * DINP + U_KR;
            float x1[16], x2[16];
#pragma unroll
            for (int c = 0; c < 2; ++c) { const u32x4 w = *(const GAS u32x4*)(krs + c * 8); const u32x4 v = *(const GAS u32x4*)(krs + 16 + c * 8);
                x1[c * 8 + 0] = bflo(w.x); x1[c * 8 + 1] = bfhi(w.x); x1[c * 8 + 2] = bflo(w.y); x1[c * 8 + 3] = bfhi(w.y); x1[c * 8 + 4] = bflo(w.z); x1[c * 8 + 5] = bfhi(w.z); x1[c * 8 + 6] = bflo(w.w); x1[c * 8 + 7] = bfhi(w.w);
                x2[c * 8 + 0] = bflo(v.x); x2[c * 8 + 1] = bfhi(v.x); x2[c * 8 + 2] = bflo(v.y); x2[c * 8 + 3] = bfhi(v.y); x2[c * 8 + 4] = bflo(v.z); x2[c * 8 + 5] = bfhi(v.z); x2[c * 8 + 6] = bflo(v.w); x2[c * 8 + 7] = bfhi(v.w); }
#pragma unroll
            for (int c = 0; c < 2; ++c) { u32x4 o1, o2;
#define RK1(i) (x1[i] * cs[i] - x2[i] * sn[i])
#define RK2(i) (x2[i] * cs[i] + x1[i] * sn[i])
                o1.x = pk2(RK1(c * 8 + 0), RK1(c * 8 + 1)); o1.y = pk2(RK1(c * 8 + 2), RK1(c * 8 + 3)); o1.z = pk2(RK1(c * 8 + 4), RK1(c * 8 + 5)); o1.w = pk2(RK1(c * 8 + 6), RK1(c * 8 + 7));
                o2.x = pk2(RK2(c * 8 + 0), RK2(c * 8 + 1)); o2.y = pk2(RK2(c * 8 + 2), RK2(c * 8 + 3)); o2.z = pk2(RK2(c * 8 + 4), RK2(c * 8 + 5)); o2.w = pk2(RK2(c * 8 + 6), RK2(c * 8 + 7));
                *(GAS u32x4*)(kdst + (8 + c) * 512) = o1; *(GAS u32x4*)(kdst + (10 + c) * 512) = o2; }
#undef RK1
#undef RK2
        }
        bf16_t* vdst = WSP(bf16_t, WS_VIMG) + ((size_t)bh * 128 + (s >> 6)) * 4096 + (s & 63) * 32;
        const bf16_t* vsrc = O + (size_t)t * 1024 + 640 + h * 64;
#pragma unroll
        for (int c = 0; c < 8; ++c) *(GAS u32x4*)(vdst + (c >> 2) * 2048 + (c & 3) * 8) = *(const GAS u32x4*)(vsrc + c * 8);
    }
}

__device__ __forceinline__ void attn_unit(Frame& F, int bh, int qb) {
    const int tid = F.tid, lane = F.lane, wid = F.wave, r32 = lane & 31, hi = lane >> 5;
    LAS unsigned char* KB = F.lds;
    LAS unsigned char* VB = F.lds + 24576;
    LAS float* wsf = (LAS float*)(F.lds + 40960) + wid * 64;
    const int b = bh >> 2, h = bh & 3;
    const bf16_t* Qp = WSP(bf16_t, WS_Q) + ((size_t)bh * SEQ + qb * 256 + wid * 32 + r32) * 96 + hi * 8;
    bf16x8 qr[6];
#pragma unroll
    for (int d0 = 0; d0 < 6; ++d0) qr[d0] = *(const GAS bf16x8*)(Qp + d0 * 16);
    const GAS u32x4* Kg = (const GAS u32x4*)(WSP(bf16_t, WS_KIMG) + (size_t)bh * 128 * 6144);
    const GAS u32x4* Vg = (const GAS u32x4*)(WSP(bf16_t, WS_VIMG) + (size_t)bh * 128 * 4096);
    const bool kx = tid < 256;
    u32x4 k0 = Kg[tid], k1 = kx ? Kg[512 + tid] : (u32x4){0u, 0u, 0u, 0u}, v0 = Vg[tid];
    u32x4 k2 = Kg[768 + tid], k3 = kx ? Kg[768 + 512 + tid] : (u32x4){0u, 0u, 0u, 0u};
    *(LAS u32x4*)(KB + tid * 16) = k0; if (kx) *(LAS u32x4*)(KB + (512 + tid) * 16) = k1; *(LAS u32x4*)(VB + tid * 16) = v0;
    *(LAS u32x4*)(KB + 12288 + tid * 16) = k2; if (kx) *(LAS u32x4*)(KB + 12288 + (512 + tid) * 16) = k3;
    __syncthreads();
    f32x16 s0, s1;
    qkt_tile<6>(s0, s1, KB, qr, r32, hi);
    __syncthreads();
    f32x16 o[2]; float lsum = 0.f;
#pragma unroll
    for (int r = 0; r < 16; ++r) { o[0][r] = 0.f; o[1][r] = 0.f; }
    float m;
    { float rm = fmaxf(fmaxf(s0[0], s1[0]), fmaxf(s0[1], s1[1]));
#pragma unroll
      for (int r = 2; r < 16; r += 2) rm = fmaxf(fmaxf(rm, s0[r]), fmaxf(s1[r], fmaxf(s0[r + 1], s1[r + 1])));
      m = fmaxf(rm, __shfl_xor(rm, 32));
#pragma unroll
      for (int r = 0; r < 16; ++r) { s0[r] -= m; s1[r] -= m; } }
    LAS const unsigned char* vbl = VB + ((lane >> 4) & 1) * 32 + (lane & 3) * 8 + (4 * hi + ((lane & 15) >> 2)) * 64;
    u32x4 kb0 = Kg[2 * 768 + tid], kb1 = kx ? Kg[2 * 768 + 512 + tid] : (u32x4){0u, 0u, 0u, 0u}, vb0 = Vg[512 + tid];
#define ATT_ITER(T, LK0, LK1, LV, WK0, WK1, WV) do { \
        const int t = (T); const int cur = t & 1; \
        const int tv = (t + 2 < 128) ? t + 2 : 127, tk = (t + 3 < 128) ? t + 3 : 127; \
        LK0 = Kg[tk * 768 + tid]; if (kx) LK1 = Kg[tk * 768 + 512 + tid]; \
        LV = Vg[tv * 512 + tid]; \
        LAS const unsigned char* Kt = KB + (cur ^ 1) * 12288 + hi * 1024 + r32 * 16; \
        bf16x8 kf[12]; \
        _Pragma("unroll") for (int d0 = 0; d0 < 6; ++d0) { kf[2 * d0] = *(const LAS bf16x8*)(Kt + d0 * 2048); kf[2 * d0 + 1] = *(const LAS bf16x8*)(Kt + d0 * 2048 + 512); } \
        _Pragma("unroll") for (int r = 0; r < 16; ++r) { s0[r] = __builtin_amdgcn_exp2f(s0[r]); s1[r] = __builtin_amdgcn_exp2f(s1[r]); } \
        { float ls_ = 0.f; _Pragma("unroll") for (int r = 0; r < 16; ++r) ls_ += s0[r] + s1[r]; lsum += ls_; } \
        bf16x8 pa[4]; pack_p(s0, s1, pa); \
        f32x16 n0, n1; { const float nm_ = -m; _Pragma("unroll") for (int r = 0; r < 16; ++r) { n0[r] = nm_; n1[r] = nm_; } } \
        n0 = MFMA32(kf[0], qr[0], n0); n1 = MFMA32(kf[1], qr[0], n1); \
        _Pragma("unroll") for (int d0 = 1; d0 < 6; ++d0) { n0 = MFMA32(kf[2 * d0], qr[d0], n0); n1 = MFMA32(kf[2 * d0 + 1], qr[d0], n1); } \
        LAS const unsigned char* vb = vbl + cur * 8192; \
        _Pragma("unroll") for (int ks = 0; ks < 4; ++ks) { \
            _Pragma("unroll") for (int d0 = 0; d0 < 2; ++d0) { \
                const s16x4 lo = vtr(vb + d0 * 4096 + ks * 1024), hh = vtr(vb + d0 * 4096 + ks * 1024 + 512); \
                const bf16x8 vf = (bf16x8){lo[0], lo[1], lo[2], lo[3], hh[0], hh[1], hh[2], hh[3]}; \
                o[d0] = MFMA32(pa[ks], vf, o[d0]); } } \
        float rm = fmaxf(fmaxf(n0[0], n1[0]), fmaxf(n0[1], n1[1])); \
        _Pragma("unroll") for (int r = 2; r < 16; r += 2) rm = fmaxf(fmaxf(rm, n0[r]), fmaxf(n1[r], fmaxf(n0[r + 1], n1[r + 1]))); \
        rm = fmaxf(rm, __shfl_xor(rm, 32)); \
        _Pragma("unroll") for (int i = 0; i < 12; ++i) { __builtin_amdgcn_sched_group_barrier(0x008, 1, 0); __builtin_amdgcn_sched_group_barrier(0x002, 7, 0); } \
        if (__any(rm > 8.0f)) { \
            const float dl = fmaxf(rm, 0.f), f = __builtin_amdgcn_exp2f(-dl); \
            m += dl; lsum *= f; \
            _Pragma("unroll") for (int r = 0; r < 16; ++r) { n0[r] -= dl; n1[r] -= dl; } \
            if (hi == 0) wsf[r32] = f; \
            LDS_WAIT(); \
            _Pragma("unroll") for (int r = 0; r < 16; ++r) { const float fr = wsf[crow(r, hi)]; o[0][r] *= fr; o[1][r] *= fr; } \
        } \
        *(LAS u32x4*)(KB + cur * 12288 + tid * 16) = WK0; if (kx) *(LAS u32x4*)(KB + cur * 12288 + (512 + tid) * 16) = WK1; \
        *(LAS u32x4*)(VB + (cur ^ 1) * 8192 + tid * 16) = WV; \
        __syncthreads(); \
        s0 = n0; s1 = n1; } while (0)
#pragma unroll 1
    for (int t2 = 0; t2 < 128; t2 += 2) {
        ATT_ITER(t2, k0, k1, v0, kb0, kb1, vb0);
        ATT_ITER(t2 + 1, kb0, kb1, vb0, k0, k1, v0);
    }
#undef ATT_ITER
    lsum += __shfl_xor(lsum, 32);
    if (hi == 0) wsf[r32] = 1.0f / lsum;
    LDS_WAIT();
    bf16_t* Y = WSP(bf16_t, WS_YATT);
#pragma unroll
    for (int r = 0; r < 16; ++r) { const float rl = wsf[crow(r, hi)]; const int q = qb * 256 + wid * 32 + crow(r, hi);
        bf16_t* yp = Y + ((size_t)b * SEQ + q) * 256 + h * 64 + r32;
        yp[0] = (bf16_t)(pk2(o[0][r] * rl, 0.f) & 0xffffu); yp[32] = (bf16_t)(pk2(o[1][r] * rl, 0.f) & 0xffffu); }
    __syncthreads();
}

#define PX(e) ((e) + ((e) >> 5))
__device__ __forceinline__ f32x2 cmul(f32x2 a, float c, float s) { return (f32x2){a.x * c - a.y * s, a.x * s + a.y * c}; }
__device__ __forceinline__ void bf4_fwd(f32x2& x0, f32x2& x1, f32x2& x2, f32x2& x3, float c1, float s1) {
    const float c2 = c1 * c1 - s1 * s1, s2 = 2.0f * c1 * s1, c3 = c2 * c1 - s2 * s1, s3 = c2 * s1 + s2 * c1;
    const f32x2 a = x0 + x2, b = x0 - x2, c = x1 + x3, d = x1 - x3;
    x0 = a + c;
    x1 = cmul((f32x2){b.x + d.y, b.y - d.x}, c1, s1);
    x2 = cmul(a - c, c2, s2);
    x3 = cmul((f32x2){b.x - d.y, b.y + d.x}, c3, s3);
}
__device__ __forceinline__ void bf4_inv(f32x2& x0, f32x2& x1, f32x2& x2, f32x2& x3, float c1, float s1) {
    const float c2 = c1 * c1 - s1 * s1, s2 = 2.0f * c1 * s1, c3 = c2 * c1 - s2 * s1, s3 = c2 * s1 + s2 * c1;
    const f32x2 t1 = cmul(x1, c1, s1), t2 = cmul(x2, c2, s2), t3 = cmul(x3, c3, s3);
    const f32x2 a = x0 + t2, b = x0 - t2, c = t1 + t3, d = t1 - t3;
    x0 = a + c; x2 = a - c;
    x1 = (f32x2){b.x - d.y, b.y + d.x};
    x3 = (f32x2){b.x + d.y, b.y - d.x};
}
template <bool INV>
__device__ __forceinline__ void fft_r4_last(LAS f32x2* X, int tid) {
#pragma unroll 2
    for (int i = 0; i < 8; ++i) { int base = 4 * (tid + 512 * i); asm volatile("" : "+v"(base));
        f32x2 x0 = X[PX(base)], x1 = X[PX(base + 1)], x2 = X[PX(base + 2)], x3 = X[PX(base + 3)];
        if (!INV) bf4_fwd(x0, x1, x2, x3, 1.0f, 0.0f); else bf4_inv(x0, x1, x2, x3, 1.0f, 0.0f);
        X[PX(base)] = x0; X[PX(base + 1)] = x1; X[PX(base + 2)] = x2; X[PX(base + 3)] = x3; }
    __syncthreads();
}
template <bool INV>
__device__ __forceinline__ void fft_r16_pass(LAS f32x2* X, int tid, int lq) {
    const int qp = 1 << lq;
    const float r16 = 1.0f / (float)(16 * qp), r4 = 1.0f / (float)(4 * qp);
    int nrep = 2; asm volatile("" : "+s"(nrep));
#pragma unroll 1
    for (int i = 0; i < nrep; ++i) {
        int u = tid + 512 * i; asm volatile("" : "+v"(u)); const int j = u & (qp - 1), base = ((u >> lq) << (lq + 4)) + j;
        f32x2 x[16];
#pragma unroll
        for (int r = 0; r < 16; ++r) x[r] = X[PX(base + (r << lq))];
        const float angB = (float)j * r4;
        if (!INV) {
#pragma unroll
            for (int r = 0; r < 4; ++r) { const float ang = (float)(j + (r << lq)) * r16; bf4_fwd(x[r], x[r + 4], x[r + 8], x[r + 12], cos_rev(ang), -sin_rev(ang)); }
            const float cb = cos_rev(angB), sb = -sin_rev(angB);
#pragma unroll
            for (int k = 0; k < 4; ++k) bf4_fwd(x[4 * k], x[4 * k + 1], x[4 * k + 2], x[4 * k + 3], cb, sb);
        } else {
            const float cb = cos_rev(angB), sb = sin_rev(angB);
#pragma unroll
            for (int k = 0; k < 4; ++k) bf4_inv(x[4 * k], x[4 * k + 1], x[4 * k + 2], x[4 * k + 3], cb, sb);
#pragma unroll
            for (int r = 0; r < 4; ++r) { const float ang = (float)(j + (r << lq)) * r16; bf4_inv(x[r], x[r + 4], x[r + 8], x[r + 12], cos_rev(ang), sin_rev(ang)); }
        }
#pragma unroll
        for (int r = 0; r < 16; ++r) X[PX(base + (r << lq))] = x[r];
    }
    __syncthreads();
}
template <bool INV>
__device__ __forceinline__ void fft16k(LAS f32x2* X, int tid) {
    if (!INV) { fft_r16_pass<false>(X, tid, 10); fft_r16_pass<false>(X, tid, 6); fft_r16_pass<false>(X, tid, 2); fft_r4_last<false>(X, tid); }
    else { fft_r4_last<true>(X, tid); fft_r16_pass<true>(X, tid, 2); fft_r16_pass<true>(X, tid, 6); fft_r16_pass<true>(X, tid, 10); }
}
__device__ __forceinline__ int drev4(int x) { unsigned y = __builtin_bitreverse32((unsigned)x) >> 18; return (int)(((y & 0x2AAAu) >> 1) | ((y & 0x1555u) << 1)); }
__device__ __forceinline__ float block_sum(Frame& F, float v, LAS float* red) {
    v = wave_sum(v);
    if (F.lane == 0) red[F.wave] = v;
    __syncthreads();
    float s = 0.f;
#pragma unroll
    for (int w = 0; w < NWAVES; ++w) s += red[w];
    __syncthreads();
    return s;
}
__device__ __forceinline__ void hyena_item(Frame& F, int c_in, int l) {
    int c = c_in; asm volatile("" : "+s"(c));
    const int tid = F.tid;
    LAS f32x2* X = (LAS f32x2*)F.lds;
    LAS float* red = (LAS float*)(F.lds + XTRA_OFF);
    f32x2* KF = WSP(f32x2, WS_KF) + (size_t)c * 2 * 16384;
    {
        const float* F0f = WSP(float, WS_FILT) + ((size_t)l * 1024 + c) * SEQ; const float* F0b = F0f + (size_t)256 * SEQ;
        const float* F1f = F0f + (size_t)512 * SEQ; const float* F1b = F0f + (size_t)768 * SEQ;
        float s0 = 0.f, s1 = 0.f;
#pragma unroll 1
        for (int i0 = 0; i0 < 16; i0 += 8) { float a0[8], b0[8], a1[8], b1[8];
#pragma unroll
            for (int i = 0; i < 8; ++i) { int t = tid + 512 * (i0 + i); asm volatile("" : "+v"(t)); a0[i] = F0f[t]; b0[i] = F0b[t]; a1[i] = F1f[t]; b1[i] = F1b[t]; }
#pragma unroll
            for (int i = 0; i < 8; ++i) { const int t = tid + 512 * (i0 + i); s0 += fabsf(a0[i]) + fabsf(b0[i]); s1 += fabsf(a1[i]) + fabsf(b1[i]);
                X[PX(t)] = (f32x2){a0[i], a1[i]}; X[PX(16383 - t)] = (f32x2){b0[i], b1[i]}; } }
        const float inv0 = 0.5f / block_sum(F, s0, red), inv1 = 0.5f / block_sum(F, s1, red);
        fft16k<false>(X, tid);
#pragma unroll 2
        for (int i = 0; i < 32; ++i) { int p = tid + 512 * i; asm volatile("" : "+v"(p)); const int f = drev4(p), pp = drev4((16384 - f) & 16383);
            const f32x2 w = X[PX(p)], wp = X[PX(pp)];
            KF[p] = (f32x2){(w.x + wp.x) * inv0, (w.y - wp.y) * inv0};
            KF[16384 + p] = (f32x2){(w.y + wp.y) * inv1, (wp.x - w.x) * inv1}; }
        __syncthreads();
    }
    const float* HT0 = WSP(float, WS_HYT);
    const float hb0 = INF(27)[l * 512 + c], hb1 = INF(27)[l * 512 + 256 + c];
    float zz[16][2];
    { const float* z0p = HT0 + (size_t)(0 * 768 + 512 + c) * SEQ; const float* z1p = HT0 + (size_t)(1 * 768 + 512 + c) * SEQ;
#pragma unroll
      for (int i = 0; i < 16; ++i) { zz[i][0] = z0p[tid + 512 * i]; zz[i][1] = z1p[tid + 512 * i]; }
#pragma unroll
      for (int i = 0; i < 16; ++i) { int t = tid + 512 * i; asm volatile("" : "+v"(t)); X[PX(t)] = (f32x2){zz[i][0], zz[i][1]}; X[PX(8192 + t)] = (f32x2){0.f, 0.f}; } }
    __syncthreads();
    const float invn = 1.0f / 16384.0f;
#pragma unroll 1
    for (int o = 0; o < 2; ++o) {
        fft16k<false>(X, tid);
        { const f32x2* kp = KF + o * 16384;
#pragma unroll 1
          for (int i0 = 0; i0 < 32; i0 += 8) { f32x2 kv[8];
#pragma unroll
              for (int i = 0; i < 8; ++i) kv[i] = kp[tid + 512 * (i0 + i)];
#pragma unroll
              for (int i = 0; i < 8; ++i) { int p = tid + 512 * (i0 + i); asm volatile("" : "+v"(p)); const f32x2 v = X[PX(p)]; X[PX(p)] = (f32x2){v.x * kv[i].x - v.y * kv[i].y, v.x * kv[i].y + v.y * kv[i].x}; } } }
        __syncthreads();
        fft16k<true>(X, tid);
        float ga[16], gb[16];
        { const float* g0p = HT0 + (size_t)(0 * 768 + o * 256 + c) * SEQ; const float* g1p = HT0 + (size_t)(1 * 768 + o * 256 + c) * SEQ;
#pragma unroll
          for (int i = 0; i < 16; ++i) { ga[i] = g0p[tid + 512 * i]; gb[i] = g1p[tid + 512 * i]; } }
        const float hbo = o ? hb1 : hb0;
        if (o == 0) {
#pragma unroll
            for (int i = 0; i < 16; ++i) { int t = tid + 512 * i; asm volatile("" : "+v"(t)); const f32x2 y = X[PX(t)];
                zz[i][0] = ga[i] * (y.x * invn + zz[i][0] * hbo); zz[i][1] = gb[i] * (y.y * invn + zz[i][1] * hbo);
                X[PX(t)] = (f32x2){zz[i][0], zz[i][1]}; X[PX(8192 + t)] = (f32x2){0.f, 0.f}; }
            __syncthreads();
        } else {
            bf16_t* Y0 = WSP(bf16_t, WS_YHT) + (size_t)(0 * 256 + c) * SEQ; bf16_t* Y1 = WSP(bf16_t, WS_YHT) + (size_t)(1 * 256 + c) * SEQ;
#pragma unroll
            for (int i = 0; i < 16; ++i) { int t = tid + 512 * i; asm volatile("" : "+v"(t)); const f32x2 y = X[PX(t)];
                const float r0 = ga[i] * (y.x * invn + zz[i][0] * hbo), r1 = gb[i] * (y.y * invn + zz[i][1] * hbo);
                Y0[t] = (bf16_t)(pk2(r0, 0.f) & 0xffffu); Y1[t] = (bf16_t)(pk2(r1, 0.f) & 0xffffu); }
            __syncthreads();
        }
    }
}

__device__ __forceinline__ void hy_prep_tile(Frame& F, int tile, int l) {
    const int tid = F.tid, lane = F.lane, wave = F.wave;
    const int b = tile >> 7, t0 = (tile & 127) * 64;
    constexpr int RS = 1552;
    const bf16_t* U = WSP(bf16_t, WS_U);
    { u32x4 hv[13];
#pragma unroll
      for (int i = 0; i < 13; ++i) { const int idx = tid + 512 * i; const int row = idx / 96, pc = idx % 96; const int tok = t0 - 1 + row;
          hv[i] = (u32x4){0u, 0u, 0u, 0u};
          if (row < 66 && tok >= 0 && tok < SEQ) hv[i] = *(const GAS u32x4*)(U + ((size_t)b * SEQ + tok) * DINP + U_HY + pc * 8); }
#pragma unroll
      for (int i = 0; i < 13; ++i) { const int idx = tid + 512 * i; const int row = idx / 96, pc = idx % 96;
          if (row < 66) *(LAS u32x4*)(F.lds + row * RS + pc * 16) = hv[i]; } }
    __syncthreads();
    const float* cw = INF(16) + (size_t)l * 768 * 3; const float* cb = INF(17) + l * 768;
    float* HT = WSP(float, WS_HYT);
#pragma unroll 2
    for (int cp = wave; cp < 384; cp += 8) { const int ch = 2 * cp;
        const float w00 = cw[ch * 3], w01 = cw[ch * 3 + 1], w02 = cw[ch * 3 + 2], w10 = cw[ch * 3 + 3], w11 = cw[ch * 3 + 4], w12 = cw[ch * 3 + 5], b0 = cb[ch], b1 = cb[ch + 1];
        const unsigned r0 = *(const LAS unsigned*)(F.lds + lane * RS + cp * 4), r1 = *(const LAS unsigned*)(F.lds + (lane + 1) * RS + cp * 4), r2 = *(const LAS unsigned*)(F.lds + (lane + 2) * RS + cp * 4);
        HT[((size_t)(b * 768 + ch)) * SEQ + t0 + lane] = w00 * bflo(r0) + w01 * bflo(r1) + w02 * bflo(r2) + b0;
        HT[((size_t)(b * 768 + ch + 1)) * SEQ + t0 + lane] = w10 * bfhi(r0) + w11 * bfhi(r1) + w12 * bfhi(r2) + b1; }
    __syncthreads();
}

__device__ __forceinline__ void headnorm_phase(Frame& F, int l) {
    const int lane = F.lane, tid = F.tid, wave = F.wave;
    const bf16_t* U = WSP(bf16_t, WS_U); const bf16_t* YA = WSP(bf16_t, WS_YATT); const bf16_t* YH = WSP(bf16_t, WS_YHT);
    constexpr int RS2 = 528;
    const int g = wave >> 1, sub = wave & 1, cg = 4 * lane, ch = g * 256 + cg;
    const f32x4 og = *(const GAS f32x4*)(INF(29) + l * 1024 + ch);
    float scw[12];
#pragma unroll
    for (int j = 0; j < 12; ++j) scw[j] = INF(28)[(size_t)l * 768 + cg * 3 + j];
    for (int tile = F.vcu; tile < 256; tile += F.G) {
      const int tb = tile >> 7, t0 = (tile & 127) * 64;
#pragma unroll
      for (int i = 0; i < 4; ++i) { const int idx = tid + 512 * i, c = idx >> 3, p8 = idx & 7;
          const u32x4 v = *(const GAS u32x4*)(YH + ((size_t)(tb * 256 + c)) * SEQ + t0 + p8 * 8);
          LAS unsigned char* hp = F.lds + (8 * p8) * RS2 + 2 * c;
          *(LAS unsigned short*)(hp + 0 * RS2) = (unsigned short)(v.x & 0xffffu); *(LAS unsigned short*)(hp + 1 * RS2) = (unsigned short)(v.x >> 16);
          *(LAS unsigned short*)(hp + 2 * RS2) = (unsigned short)(v.y & 0xffffu); *(LAS unsigned short*)(hp + 3 * RS2) = (unsigned short)(v.y >> 16);
          *(LAS unsigned short*)(hp + 4 * RS2) = (unsigned short)(v.z & 0xffffu); *(LAS unsigned short*)(hp + 5 * RS2) = (unsigned short)(v.z >> 16);
          *(LAS unsigned short*)(hp + 6 * RS2) = (unsigned short)(v.w & 0xffffu); *(LAS unsigned short*)(hp + 7 * RS2) = (unsigned short)(v.w >> 16); }
      __syncthreads();
#pragma unroll 4
      for (int rr = 0; rr < 32; ++rr) {
        const int trow = sub * 32 + rr; const int m = tb * SEQ + t0 + trow;
        float y0, y1, y2, y3;
        if (g == 0) {
            const u32x2 ow = *(const GAS u32x2*)(U + (size_t)m * DINP + U_MLO + cg);
            const f32x4 hs = *(const GAS f32x4*)(WSP(float, WS_HF) + (size_t)m * 256 + cg) + *(const GAS f32x4*)(WSP(float, WS_HB) + (size_t)m * 256 + cg);
            y0 = hs.x / (1.0f + fexp(-bflo(ow.x))); y1 = hs.y / (1.0f + fexp(-bfhi(ow.x))); y2 = hs.z / (1.0f + fexp(-bflo(ow.y))); y3 = hs.w / (1.0f + fexp(-bfhi(ow.y)));
        } else if (g == 1) {
            const u32x2 w = *(const GAS u32x2*)(YA + (size_t)m * 256 + cg);
            y0 = bflo(w.x); y1 = bfhi(w.x); y2 = bflo(w.y); y3 = bfhi(w.y);
        } else if (g == 2) {
            const u32x2 w = *(const LAS u32x2*)(F.lds + trow * RS2 + cg * 2);
            y0 = bflo(w.x); y1 = bfhi(w.x); y2 = bflo(w.y); y3 = bfhi(w.y);
        } else {
            const int s = t0 + trow;
            const bf16_t* up = U + (size_t)m * DINP + U_SC + cg;
            const u32x2 bw = *(const GAS u32x2*)up;
            u32x2 c0 = {0u, 0u}, x0 = {0u, 0u}, c2 = {0u, 0u}, x2 = {0u, 0u};
            if (s > 0) { c0 = *(const GAS u32x2*)(up - DINP + 256); x0 = *(const GAS u32x2*)(up - DINP + 512); }
            const u32x2 c1 = *(const GAS u32x2*)(up + 256), x1 = *(const GAS u32x2*)(up + 512);
            if (s < SEQ - 1) { c2 = *(const GAS u32x2*)(up + DINP + 256); x2 = *(const GAS u32x2*)(up + DINP + 512); }
            y0 = bflo(bw.x) * (scw[0] * bflo(c0.x) * bflo(x0.x) + scw[1] * bflo(c1.x) * bflo(x1.x) + scw[2] * bflo(c2.x) * bflo(x2.x));
            y1 = bfhi(bw.x) * (scw[3] * bfhi(c0.x) * bfhi(x0.x) + scw[4] * bfhi(c1.x) * bfhi(x1.x) + scw[5] * bfhi(c2.x) * bfhi(x2.x));
            y2 = bflo(bw.y) * (scw[6] * bflo(c0.y) * bflo(x0.y) + scw[7] * bflo(c1.y) * bflo(x1.y) + scw[8] * bflo(c2.y) * bflo(x2.y));
            y3 = bfhi(bw.y) * (scw[9] * bfhi(c0.y) * bfhi(x0.y) + scw[10] * bfhi(c1.y) * bfhi(x1.y) + scw[11] * bfhi(c2.y) * bfhi(x2.y));
        }
        float ss = (y0 * y0 + y1 * y1) + (y2 * y2 + y3 * y3);
        ss += __shfl_xor(ss, 1); ss += __shfl_xor(ss, 2); ss += __shfl_xor(ss, 4); ss += __shfl_xor(ss, 8);
        const float rstd = __builtin_amdgcn_rsqf(ss * (1.0f / 64.0f) + EPS);
        u32x2 w; w.x = pk2(y0 * rstd * og.x, y1 * rstd * og.y); w.y = pk2(y2 * rstd * og.z, y3 * rstd * og.w);
        *(GAS u32x2*)(WSP(bf16_t, WS_YN) + (size_t)m * DM + ch) = w;
      }
      __syncthreads();
    }
}

__device__ __forceinline__ void post_mixer_phase(Frame& F, int l, const float* xin) {
    const int gw = F.vcu * NWAVES + F.wave, NGW = F.G * NWAVES, lane = F.lane, tid = F.tid;
    LAS float* RWT = (LAS float*)F.lds;
    { const GAS f32x4* src = (const GAS f32x4*)(INF(31) + (size_t)l * 1024 * 16);
      f32x4 wv[8];
#pragma unroll
      for (int q = 0; q < 8; ++q) wv[q] = src[tid + NTHR * q];
#pragma unroll
      for (int q = 0; q < 8; ++q) { const int i = tid + NTHR * q; const f32x4 w = wv[q]; const int k = i >> 2, e4 = (i & 3) * 4;
          RWT[(e4 + 0) * 1024 + k] = w.x; RWT[(e4 + 1) * 1024 + k] = w.y; RWT[(e4 + 2) * 1024 + k] = w.z; RWT[(e4 + 3) * 1024 + k] = w.w; } }
    __syncthreads();
    const float* mod = WSP(float, WS_MOD);
    for (int m0 = gw; m0 < MTOK; m0 += 2 * NGW) {
        u32x2 yw[2][4]; f32x4 xr[2][4];
#pragma unroll
        for (int r = 0; r < 2; ++r) { const int mm = (m0 + r * NGW < MTOK) ? m0 + r * NGW : m0;
            const GAS u32x2* yr = (const GAS u32x2*)(WSP(bf16_t, WS_Y2) + (size_t)mm * DM) + lane;
#pragma unroll
            for (int j = 0; j < 4; ++j) yw[r][j] = yr[64 * j];
            ld_row_f32(xin + (size_t)mm * DM, lane, xr[r]); }
#pragma unroll
        for (int r = 0; r < 2; ++r) { const int m = m0 + r * NGW; if (m >= MTOK) break;
        const int b = m >> 13, s = m & 8191; const float* md = mod + (l * 2 + b) * 6144;
        f32x4 y2[4], x[4], pg[4], g1[4];
#pragma unroll
        for (int j = 0; j < 4; ++j) { y2[j] = (f32x4){bflo(yw[r][j].x), bfhi(yw[r][j].x), bflo(yw[r][j].y), bfhi(yw[r][j].y)}; x[j] = xr[r][j]; }
        ld_row_f32(INF(6) + l * 1024, lane, pg); ld_row_f32(md + 2048, lane, g1);
        const float rstd = __builtin_amdgcn_rsqf(row_ss(y2) * (1.0f / DM) + EPS);
#pragma unroll
        for (int j = 0; j < 4; ++j) x[j] = x[j] + g1[j] * (y2[j] * rstd * pg[j]);
        st_row_f32(WSP(float, WS_X1) + (size_t)m * DM, lane, x);
        f32x4 h[4];
        modnorm(x, INF(7) + l * 1024, md + 4096, md + 3072, lane, h);
        st_row_bf16(WSP(bf16_t, WS_XN) + (size_t)m * DM, lane, h);
        float part[16];
#pragma unroll
        for (int e = 0; e < 16; ++e) part[e] = 0.f;
#pragma unroll
        for (int j = 0; j < 4; ++j) {
#pragma unroll
            for (int e = 0; e < 16; ++e) { const f32x4 w = *(const LAS f32x4*)(RWT + e * 1024 + 4 * lane + 256 * j);
                part[e] += (h[j].x * w.x + h[j].y * w.y) + (h[j].z * w.z + h[j].w * w.w); }
            asm volatile("" ::: "memory"); }
        float a8[8], a4[4], a2[2], lg;
        { const bool up = (lane & 32) != 0;
#pragma unroll
          for (int i = 0; i < 8; ++i) { const float keep = up ? part[8 + i] : part[i], send = up ? part[i] : part[8 + i]; a8[i] = keep + __shfl_xor(send, 32); } }
        { const bool up = (lane & 16) != 0;
#pragma unroll
          for (int i = 0; i < 4; ++i) { const float keep = up ? a8[4 + i] : a8[i], send = up ? a8[i] : a8[4 + i]; a4[i] = keep + __shfl_xor(send, 16); } }
        { const bool up = (lane & 8) != 0;
#pragma unroll
          for (int i = 0; i < 2; ++i) { const float keep = up ? a4[2 + i] : a4[i], send = up ? a4[i] : a4[2 + i]; a2[i] = keep + __shfl_xor(send, 8); } }
        { const bool up = (lane & 4) != 0; const float keep = up ? a2[1] : a2[0], send = up ? a2[0] : a2[1]; lg = keep + __shfl_xor(send, 4); }
        lg += __shfl_xor(lg, 2); lg += __shfl_xor(lg, 1);
        float mx = lg;
#pragma unroll
        for (int o = 4; o < 64; o <<= 1) mx = fmaxf(mx, __shfl_xor(mx, o));
        const float ex = fexp(lg - mx); float sm = ex;
#pragma unroll
        for (int o = 4; o < 64; o <<= 1) sm += __shfl_xor(sm, o);
        if ((lane & 3) == 0) WSP(float, WS_AFF)[((size_t)b * 16 + (lane >> 2)) * SEQ + s] = ex / sm;
        if (lane < 16) WSP(int, WS_SLOT)[(size_t)m * 16 + lane] = -1;
            }
    }
    __syncthreads();
}

__device__ __forceinline__ void topk_item(Frame& F, int it) {
    const int tid = F.tid, lane = F.lane, wave = F.wave;
    const int b = it >> 4, e = it & 15;
    LAS unsigned* keys = (LAS unsigned*)F.lds;
    LAS unsigned* hist = (LAS unsigned*)(F.lds + 32768);
    LAS unsigned* ctl = hist + 256;
    LAS unsigned* wtot = hist + 320;
    const unsigned* src = (const unsigned*)(WSP(float, WS_AFF) + (size_t)it * SEQ);
#pragma unroll
    for (int i = 0; i < 16; ++i) keys[tid + 512 * i] = src[tid + 512 * i];
    unsigned prefix = 0u, mask = 0u, need = CAP;
    for (int pass = 0; pass < 4; ++pass) {
        const int shift = 24 - 8 * pass;
        if (tid < 256) hist[tid] = 0u;
        __syncthreads();
#pragma unroll
        for (int i = 0; i < 16; ++i) { const unsigned k = keys[tid + 512 * i]; if ((k & mask) == prefix) atomicAdd((unsigned*)&hist[(k >> shift) & 255u], 1u); }
        __syncthreads();
        if (wave == 0) { const unsigned c0 = hist[4 * lane], c1 = hist[4 * lane + 1], c2 = hist[4 * lane + 2], c3 = hist[4 * lane + 3];
            const unsigned sl = c0 + c1 + c2 + c3; unsigned T = sl;
#pragma unroll
            for (int o = 1; o < 64; o <<= 1) { const unsigned n = __shfl_down(T, o); if (lane + o < 64) T += n; }
            unsigned cum = T - sl;
            if (cum < need && cum + c3 >= need) { ctl[0] = 4u * lane + 3u; ctl[1] = need - cum; } cum += c3;
            if (cum < need && cum + c2 >= need) { ctl[0] = 4u * lane + 2u; ctl[1] = need - cum; } cum += c2;
            if (cum < need && cum + c1 >= need) { ctl[0] = 4u * lane + 1u; ctl[1] = need - cum; } cum += c1;
            if (cum < need && cum + c0 >= need) { ctl[0] = 4u * lane; ctl[1] = need - cum; } }
        __syncthreads();
        prefix |= ctl[0] << shift; mask |= 0xffu << shift; need = ctl[1];
        __syncthreads();
    }
    unsigned cg = 0u, ce = 0u;
#pragma unroll
    for (int i = 0; i < 16; ++i) { const unsigned k = keys[tid * 16 + i]; cg += (k > prefix) ? 1u : 0u; ce += (k == prefix) ? 1u : 0u; }
    unsigned v = cg | (ce << 16), inc = v;
#pragma unroll
    for (int o = 1; o < 64; o <<= 1) { const unsigned n = __shfl_up(inc, o); if (lane >= o) inc += n; }
    if (lane == 63) wtot[wave] = inc;
    __syncthreads();
    unsigned off = 0u;
    for (int w = 0; w < wave; ++w) off += wtot[w];
    const unsigned excl = off + inc - v;
    unsigned ng = excl & 0xffffu, ne = excl >> 16;
    int* IDX = WSP(int, WS_IDX) + (e * 2 + b) * CAP; int* SLOT = WSP(int, WS_SLOT);
#pragma unroll
    for (int i = 0; i < 16; ++i) { const int idx = tid * 16 + i; const unsigned k = keys[idx];
        const bool gt = k > prefix, eq = k == prefix; const bool sel = gt || (eq && ne < need);
        if (sel) { const int slot = (int)(ng + (ne < need ? ne : need)); IDX[slot] = b * SEQ + idx; SLOT[((size_t)b * SEQ + idx) * 16 + e] = slot; }
        ng += gt ? 1u : 0u; ne += eq ? 1u : 0u; }
    __syncthreads();
}

__device__ __forceinline__ void gather_phase(Frame& F) {
    const int gw = F.vcu * NWAVES + F.wave, NGW = F.G * NWAVES, lane = F.lane;
    const int* IDX = WSP(int, WS_IDX);
    for (int r = gw; r < NEXP * 2 * CAP; r += NGW) {
        const int e = r >> 11, b = (r >> 10) & 1, j = r & 1023;
        const int tok = IDX[(b * 16 + e) * CAP + j];
        const GAS u32x4* src = (const GAS u32x4*)(WSP(bf16_t, WS_XN) + ((size_t)b * SEQ + tok) * DM);
        GAS u32x4* dst = (GAS u32x4*)(WSP(bf16_t, WS_XE) + (size_t)r * DM);
        dst[lane] = src[lane]; dst[64 + lane] = src[64 + lane];
    }
}

__device__ __forceinline__ void combine_phase(Frame& F, int l) {
    const int gw = F.vcu * NWAVES + F.wave, NGW = F.G * NWAVES, lane = F.lane;
    const float* mod = WSP(float, WS_MOD);
    const bf16_t* YE = WSP(bf16_t, WS_YE);
    f32x4 pg[4]; ld_row_f32(INF(8) + l * 1024, lane, pg);
    for (int m0 = gw; m0 < MTOK; m0 += 2 * NGW) {
        int sl[2]; float gv[2]; f32x4 x1[2][4];
#pragma unroll
        for (int r = 0; r < 2; ++r) { const int mm = (m0 + r * NGW < MTOK) ? m0 + r * NGW : m0; const int b = mm >> 13, s = mm & 8191;
            sl[r] = -1; gv[r] = 0.f;
            if (lane < 16) { sl[r] = WSP(int, WS_SLOT)[(size_t)mm * 16 + lane]; gv[r] = WSP(float, WS_AFF)[((size_t)b * 16 + lane) * SEQ + s]; }
            ld_row_f32(WSP(float, WS_X1) + (size_t)mm * DM, lane, x1[r]); }
#pragma unroll
        for (int r = 0; r < 2; ++r) { const int m = m0 + r * NGW; if (m >= MTOK) break;
            const int b = m >> 13; const float* md = mod + (l * 2 + b) * 6144;
            f32x4 acc[4];
#pragma unroll
            for (int j = 0; j < 4; ++j) acc[j] = (f32x4){0.f, 0.f, 0.f, 0.f};
            unsigned long long msk = __ballot(sl[r] >= 0) & 0xffffull;
            while (msk) {
                const int e0 = __builtin_ctzll(msk); msk &= msk - 1;
                int e1 = -1; if (msk) { e1 = __builtin_ctzll(msk); msk &= msk - 1; }
                const int s0 = __shfl(sl[r], e0); const float g0 = __shfl(gv[r], e0);
                const int s1 = __shfl(sl[r], e1 < 0 ? e0 : e1); const float g1 = (e1 < 0) ? 0.f : __shfl(gv[r], e1 < 0 ? e0 : e1);
                const GAS u32x2* r0 = (const GAS u32x2*)(YE + ((size_t)e0 * 2048 + b * CAP + s0) * DM) + lane;
                const GAS u32x2* r1 = (const GAS u32x2*)(YE + ((size_t)(e1 < 0 ? e0 : e1) * 2048 + b * CAP + s1) * DM) + lane;
                u32x2 w0[4], w1[4];
#pragma unroll
                for (int j = 0; j < 4; ++j) { w0[j] = r0[64 * j]; w1[j] = r1[64 * j]; }
#pragma unroll
                for (int j = 0; j < 4; ++j) { acc[j] += (f32x4){bflo(w0[j].x), bfhi(w0[j].x), bflo(w0[j].y), bfhi(w0[j].y)} * g0;
                                              acc[j] += (f32x4){bflo(w1[j].x), bfhi(w1[j].x), bflo(w1[j].y), bfhi(w1[j].y)} * g1; }
            }
            f32x4 g2[4]; ld_row_f32(md + 5120, lane, g2);
            const float rstd = __builtin_amdgcn_rsqf(row_ss(acc) * (1.0f / DM) + EPS);
            f32x4 xo[4];
#pragma unroll
            for (int j = 0; j < 4; ++j) xo[j] = x1[r][j] + g2[j] * (acc[j] * rstd * pg[j]);
            st_row_f32(F.a->out + (size_t)m * DM, lane, xo);
            if (l == 0) { f32x4 h[4]; const float* md1 = mod + (1 * 2 + b) * 6144;
                modnorm(xo, INF(5) + 1024, md1 + 1024, md1, lane, h);
                st_row_bf16(WSP(bf16_t, WS_XN) + (size_t)m * DM, lane, h); }
        }
    }
}

constexpr int PH_PER_LAYER = 12, N_PHASES = 2 + 2 * PH_PER_LAYER;
__global__ void __launch_bounds__(NTHR, 2) mega_fwd(Args args) {
    extern __shared__ __attribute__((aligned(16))) unsigned char lds_raw[];
    Frame F;
    F.lds = (LAS unsigned char*)lds_raw;
    F.tid = threadIdx.x; F.lane = F.tid & 63; F.wave = __builtin_amdgcn_readfirstlane(F.tid >> 6);
    F.G = gridDim.x; { const int bx = blockIdx.x; F.vcu = (F.G % 8 == 0) ? (bx % 8) * (F.G / 8) + bx / 8 : bx; }
    F.a = &args; F.ws = args.ws;
    volatile LAS unsigned* MISC = (volatile LAS unsigned*)(F.lds + MISC_OFF);
    for (int u = F.tid; u < (LDS_BYTES - LDSCTL_OFF) / 4; u += NTHR) ((LAS unsigned*)(F.lds + LDSCTL_OFF))[u] = 0u;
    __syncthreads();
    gu32* ctl = (gu32*)(F.ws + WS_CTL);
    XcdBarrier bar; bar.bar = (unsigned*)(ctl + CW_BAR); bar.x = 0; bar.st = nullptr;
#if !MK_SPLIT
    bar = xcd_barrier_post((unsigned*)(ctl + CW_BAR), MISC + 8);
#endif
    const int lo = args.ph_lo, hi = args.ph_hi;
    int ph = 0;
#if MK_SPLIT
#define SEAM() do { } while (0)
#else
#define SEAM() do { if (ph + 1 < hi) xcd_barrier(bar); } while (0)
#endif
#ifndef PHSEL
#define PHSEL -1
#endif
#ifndef PHMASK
#define PHMASK 0x7fff
#endif
#ifndef DBL_MASK
#define DBL_MASK 0
#endif
#define PHASE_BEGIN(id) if ((PHSEL < 0 || PHSEL == (id)) && ((PHMASK >> (id)) & 1) && lo <= ph && ph < hi) for (int rep_ = 0; rep_ < (((DBL_MASK >> (id)) & 1) ? 2 : 1); ++rep_) { if (rep_) xcd_barrier(bar); { int t_ = threadIdx.x; asm volatile("" : "+v"(t_)); F.tid = t_; F.lane = t_ & 63; F.wave = __builtin_amdgcn_readfirstlane(t_ >> 6); }
#define PHASE_END   SEAM(); } ++ph;

    PHASE_BEGIN(0) p0_phase(F); PHASE_END
    PHASE_BEGIN(1) p1_phase(F); PHASE_END
#pragma unroll 1
    for (int l = 0; l < 2; ++l) {
        const float* xin = (l == 0) ? (const float*)args.in[0] : (const float*)args.out;
        PHASE_BEGIN(2) {
            pg8::Gemm g{WSP(bf16_t, WS_XN), WSP(bf16_t, WS_WIN) + (size_t)l * DINP * 1024, MTOK, DINP, 1024}; pg8::StaticOrder S; S.init(MTOK, DINP, F.G, (int)blockIdx.x);
            pg8::EpiBf16 E{WSP(bf16_t, WS_U), DINP, DINP / 256};
            pg8::gemm_phase<pg8::EpiBf16, pg8::StaticOrder, true, true>(F.lds, g, S, E, F.tid);
        } PHASE_END
        PHASE_BEGIN(3) {
#ifndef SUBSEL
#define SUBSEL 0
#endif
#ifndef REP_A
#define REP_A 1
#define REP_B 1
#define REP_C 1
#define REP_D 1
#define REP_E 1
#endif
            for (int q_ = 0; q_ < REP_A; ++q_) for (int tl = F.vcu; tl < 256; tl += F.G) hy_prep_tile(F, tl, l);
            for (int q_ = 0; q_ < REP_B; ++q_) for (int p = F.vcu; p < 512; p += F.G) ml_local_pair(F, p, l);
            for (int q_ = 0; q_ < REP_C; ++q_) mla_prep_rows(F, l);
        } PHASE_END
        PHASE_BEGIN(4) {
            pg8::Gemm g{WSP(bf16_t, WS_AMLA), WSP(bf16_t, WS_WMLA) + (size_t)l * 1024 * 384, MTOK, 1024, 384}; pg8::StaticOrder S; S.init(MTOK, 1024, F.G, (int)blockIdx.x);
            pg8::EpiBf16 E{WSP(bf16_t, WS_OMLA), 1024, 4};
            pg8::gemm_phase<pg8::EpiBf16, pg8::StaticOrder, true, true>(F.lds, g, S, E, F.tid);
#define REFRESH_TID() do { int t_ = threadIdx.x; asm volatile("" : "+v"(t_)); F.tid = t_; F.lane = t_ & 63; F.wave = __builtin_amdgcn_readfirstlane(t_ >> 6); } while (0)
            REFRESH_TID();
            ml_scan(F);
            REFRESH_TID();
#ifndef HY_REP
#define HY_REP 1
#endif
            for (int rep2_ = 0; rep2_ < HY_REP; ++rep2_) for (int c = F.vcu; c < 256; c += F.G) hyena_item(F, c, l);
        } PHASE_END
        PHASE_BEGIN(5) relayout_phase(F); PHASE_END
        PHASE_BEGIN(6) {
            for (int q_ = 0; q_ < REP_D; ++q_) for (int u = F.vcu; u < 256; u += F.G) attn_unit(F, u >> 5, u & 31);
            for (int q_ = 0; q_ < REP_E; ++q_) for (int p = F.vcu; p < 512; p += F.G) ml_out_pair(F, p, l);
        } PHASE_END
        PHASE_BEGIN(7) headnorm_phase(F, l); PHASE_END
        PHASE_BEGIN(8) {
            pg8::Gemm g{WSP(bf16_t, WS_YN), WSP(bf16_t, WS_WOUT) + (size_t)l * 1024 * 1024, MTOK, 1024, 1024}; pg8::StaticOrder S; S.init(MTOK, 1024, F.G, (int)blockIdx.x);
            pg8::EpiBf16 E{WSP(bf16_t, WS_Y2), 1024, 4};
            pg8::gemm_phase<pg8::EpiBf16, pg8::StaticOrder, true, true>(F.lds, g, S, E, F.tid);
        } PHASE_END
        PHASE_BEGIN(9) post_mixer_phase(F, l, xin); PHASE_END
        PHASE_BEGIN(10) { for (int it = F.vcu; it < 32; it += F.G) topk_item(F, it); } PHASE_END
        PHASE_BEGIN(11) {
            pg8::Gemm g{WSP(bf16_t, WS_XN), WSP(bf16_t, WS_WGU) + (size_t)l * NEXP * 4096 * 1024, NEXP * 2048, NEXP * 4096, 1024, WSP(int, WS_IDX)}; pg8::GroupedOrder S; S.init(16, F.G, (int)blockIdx.x);
            pg8::EpiSwiGLU E{WSP(bf16_t, WS_ACT), EFF};
            pg8::gemm_phase<pg8::EpiSwiGLU, pg8::GroupedOrder, true, true, true>(F.lds, g, S, E, F.tid);
        } PHASE_END
        PHASE_BEGIN(12) {
            pg8::Gemm g{WSP(bf16_t, WS_ACT), WSP(bf16_t, WS_WDN) + (size_t)l * NEXP * 1024 * 2048, NEXP * 2048, NEXP * 1024, 2048}; pg8::GroupedOrder S; S.init(4, F.G, (int)blockIdx.x);
            pg8::EpiBf16 E{WSP(bf16_t, WS_YE), 1024, 4};
            pg8::gemm_phase<pg8::EpiBf16, pg8::GroupedOrder, true, true>(F.lds, g, S, E, F.tid);
        } PHASE_END
        PHASE_BEGIN(13) combine_phase(F, l); PHASE_END
    }
}

extern "C" void kernel_launch(void* const* d_in, const int* in_sizes, int n_in, void* d_out, int out_size, void* d_ws, size_t ws_size, hipStream_t stream) {
    static int grid = 0;
    if (grid == 0) {
        if (n_in != 35 || out_size != MTOK * DM || ws_size < WS_END) { fprintf(stderr, "kernel_launch: unexpected shapes: n_in %d out %d ws %zu (need %zu)\n", n_in, out_size, ws_size, (size_t)WS_END); grid = -1; return; }
        int dev = 0, cus = 0, per_cu = 0;
        if (hipGetDevice(&dev) != hipSuccess || hipDeviceGetAttribute(&cus, hipDeviceAttributeMultiprocessorCount, dev) != hipSuccess) { grid = -1; return; }
        if (hipFuncSetAttribute((const void*)mega_fwd, hipFuncAttributeMaxDynamicSharedMemorySize, LDS_BYTES) != hipSuccess) { fprintf(stderr, "kernel_launch: hipFuncSetAttribute failed\n"); grid = -1; return; }
        (void)hipOccupancyMaxActiveBlocksPerMultiprocessor(&per_cu, (const void*)mega_fwd, NTHR, LDS_BYTES);
        (void)hipGetLastError();
        grid = cus > 0 ? cus : 256;
        if (per_cu < 1) fprintf(stderr, "kernel_launch: occupancy query reports %d\n", per_cu);
    }
    if (grid < 0) return;
    (void)hipMemsetAsync((char*)d_ws + WS_CTL, 0, CTL_ZERO_BYTES, stream);
    Args a{};
    for (int i = 0; i < 35; ++i) a.in[i] = d_in[i];
    a.out = (float*)d_out; a.ws = (unsigned char*)d_ws;
#if MK_SPLIT
    for (int p = 0; p < N_PHASES; ++p) { a.ph_lo = p; a.ph_hi = p + 1; hipLaunchKernelGGL(mega_fwd, dim3(grid), dim3(NTHR), LDS_BYTES, stream, a); }
#else
    a.ph_lo = 0; a.ph_hi = N_PHASES;
    hipLaunchKernelGGL(mega_fwd, dim3(grid), dim3(NTHR), LDS_BYTES, stream, a);
#endif
}
```

```cpp
#include <hip/hip_runtime.h>
#include <cstdio>
#include <cstdint>

#ifndef MK_SPLIT
#define MK_SPLIT 0
#endif

#define GAS __attribute__((address_space(1)))
#define LAS __attribute__((address_space(3)))
typedef GAS unsigned gu32;
#define RLX_AGENT __ATOMIC_RELAXED, __HIP_MEMORY_SCOPE_AGENT
typedef unsigned short bf16_t;
typedef short bf16x8 __attribute__((ext_vector_type(8)));
typedef short s16x4 __attribute__((ext_vector_type(4)));
typedef float f32x4 __attribute__((ext_vector_type(4)));
typedef float f32x2 __attribute__((ext_vector_type(2)));
typedef float f32x16 __attribute__((ext_vector_type(16)));
typedef unsigned u32x4 __attribute__((ext_vector_type(4)));
typedef unsigned u32x2 __attribute__((ext_vector_type(2)));
typedef __bf16 bf16x2_t __attribute__((ext_vector_type(2)));

namespace pg8 {
#define PG8_LAS __attribute__((address_space(3)))
constexpr int BM = 256, BK = 64, HALF = 128, HTB = HALF * BK * 2, STAGE_BYTES = 8 * HTB, NXCD = 8, WGM = 8;
__host__ __device__ __forceinline__ int lds_byte(int r, int c) { const int st = (r >> 4) * 2 + (c >> 5), rr = r & 15, cc = c & 31, ob = rr * 64 + cc * 2; return st * 1024 + (ob ^ (((ob >> 9) & 1) << 5)); }
__host__ __device__ __forceinline__ void stage_rc(int b, int& R, int& C) { const int st = b / 1024, sb = b % 1024, swz = sb ^ (((sb >> 9) & 1) << 5); R = (st >> 1) * 16 + swz / 64; C = (st & 1) * 32 + (swz % 64) / 2; }
__host__ __device__ __forceinline__ int perm32(int rho) { const int n = rho >> 4, i = rho & 15; return 8 * (i >> 2) + 4 * n + (i & 3); }
struct Unit { int pm, pn; };
struct Gemm { const bf16_t* A; const bf16_t* Bt; int M, N, K; const int* rowidx; };
struct StaticOrder {
    int nM, nN, nwg, G, c;
    __host__ __device__ void init(int M, int N, int G_, int c_) { nM = M / BM; nN = N / BM; nwg = nM * nN; G = G_; c = c_; }
    __host__ __device__ bool next(int i, Unit& u) const {
        const long L = (long)i * G + c; if (L >= nwg) return false;
        int wgid = (int)L; { const int q = nwg / NXCD, r = nwg % NXCD, xcd = wgid % NXCD, off = wgid / NXCD; wgid = (xcd < r ? xcd * (q + 1) : r * (q + 1) + (xcd - r) * q) + off; }
        const int nig = WGM * nN, gid = wgid / nig, fm = gid * WGM, gsz = (nM - fm) < WGM ? (nM - fm) : WGM;
        u.pm = fm + ((wgid % nig) % gsz); u.pn = (wgid % nig) / gsz; return true;
    }
    __device__ __forceinline__ void a_ready(const Unit&) const {}
    __device__ __forceinline__ void done(const Unit&) const {}
};
struct GroupedOrder {
    int nNl, total, G, c;
    __host__ __device__ void init(int nNl_, int G_, int c_) { nNl = nNl_; total = 16 * 8 * nNl_; G = G_; c = c_; }
    __host__ __device__ bool next(int i, Unit& u) const {
        const long L = (long)i * G + c; if (L >= total) return false;
        if (G == 256 && (nNl == 16 || nNl == 4)) {
            const int x = c & 7, w = c >> 3;
            if (nNl == 16) { const int e = 2 * i + (w >> 4), q = w & 15; u.pm = e * 8 + 4 * (x & 1) + (q & 3); u.pn = e * 16 + 4 * (x >> 1) + (q >> 2); }
            else { const int e = 8 * i + x; u.pm = e * 8 + (w & 7); u.pn = e * 4 + (w >> 3); }
            return true;
        }
        const int per_e = 8 * nNl, e = (int)L / per_e, r = (int)L % per_e;
        u.pm = e * 8 + (r % 8); u.pn = e * nNl + (r / 8); return true;
    }
    __device__ __forceinline__ void a_ready(const Unit&) const {}
    __device__ __forceinline__ void done(const Unit&) const {}
};
__device__ __forceinline__ unsigned cvt_pk_bf16(float lo, float hi) { f32x2 v = {lo, hi}; bf16x2_t b = __builtin_convertvector(v, bf16x2_t); return __builtin_bit_cast(unsigned, b); }

struct EpiBf16 {
    static constexpr bool PERM = true, AFTER_DRAIN = false;
    bf16_t* O; int ldc; int ntn;
    __device__ __forceinline__ void operator()(const f32x4 (&acc)[2][2][4][2], const Unit& u, int wr, int wc, int fr, int fq) const {
        const int row0 = u.pm * BM + wr * 64 + fr; const int colt = (u.pn % ntn) * BM;
        const int col0 = colt + wc * 32 + 8 * fq;
#pragma unroll
        for (int ai = 0; ai < 2; ++ai)
#pragma unroll
            for (int m = 0; m < 4; ++m) { bf16_t* rowp = O + (size_t)(row0 + ai * HALF + m * 16) * ldc + col0;
#pragma unroll
                for (int bj = 0; bj < 2; ++bj) { const f32x4 v0 = acc[ai][bj][m][0], v1 = acc[ai][bj][m][1];
                    u32x4 w; w.x = cvt_pk_bf16(v0[0], v0[1]); w.y = cvt_pk_bf16(v0[2], v0[3]); w.z = cvt_pk_bf16(v1[0], v1[1]); w.w = cvt_pk_bf16(v1[2], v1[3]);
                    *(u32x4*)(rowp + bj * HALF) = w; } }
    }
};
struct EpiF32 {
    static constexpr bool PERM = false, AFTER_DRAIN = false;
    float* O; int ldc;
    __device__ __forceinline__ void operator()(const f32x4 (&acc)[2][2][4][2], const Unit& u, int wr, int wc, int fr, int fq) const {
        const int col0 = u.pn * BM + wc * 32 + 4 * fq;
#pragma unroll
        for (int ai = 0; ai < 2; ++ai)
#pragma unroll
            for (int m = 0; m < 4; ++m) { float* rowp = O + (size_t)(u.pm * BM + ai * HALF + wr * 64 + m * 16 + fr) * ldc + col0;
#pragma unroll
                for (int bj = 0; bj < 2; ++bj)
#pragma unroll
                    for (int n = 0; n < 2; ++n) *(f32x4*)(rowp + bj * HALF + n * 16) = acc[ai][bj][m][n]; }
    }
};
__device__ __forceinline__ float silu_f(float a) { return a * __builtin_amdgcn_rcpf(1.0f + __builtin_amdgcn_exp2f(-1.4426950408889634f * a)); }
struct EpiSwiGLU {
    static constexpr bool PERM = true, AFTER_DRAIN = false;
    bf16_t* O; int ldc;
    __device__ __forceinline__ void operator()(const f32x4 (&acc)[2][2][4][2], const Unit& u, int wr, int wc, int fr, int fq) const {
        const int row0 = u.pm * BM + wr * 64 + fr; const int col0 = (u.pn % 16) * HALF + wc * 32 + 8 * fq;
#pragma unroll
        for (int ai = 0; ai < 2; ++ai)
#pragma unroll
            for (int m = 0; m < 4; ++m) { bf16_t* rowp = O + (size_t)(row0 + ai * HALF + m * 16) * ldc + col0;
                const f32x4 g0 = acc[ai][0][m][0], g1 = acc[ai][0][m][1], u0 = acc[ai][1][m][0], u1 = acc[ai][1][m][1];
                u32x4 w;
                w.x = cvt_pk_bf16(silu_f(g0[0]) * u0[0], silu_f(g0[1]) * u0[1]); w.y = cvt_pk_bf16(silu_f(g0[2]) * u0[2], silu_f(g0[3]) * u0[3]);
                w.z = cvt_pk_bf16(silu_f(g1[0]) * u1[0], silu_f(g1[1]) * u1[1]); w.w = cvt_pk_bf16(silu_f(g1[2]) * u1[2], silu_f(g1[3]) * u1[3]);
                *(u32x4*)rowp = w; }
    }
};

template <class Epi, class Sched, bool ALIGN_EPI = false, bool SP2 = false, bool GATHER = false>
__device__ __forceinline__ void gemm_phase(PG8_LAS unsigned char* lds, const Gemm g, const Sched& S, const Epi& E, const int tid) {
    const int wid = __builtin_amdgcn_readfirstlane(tid >> 6), lane = tid & 63, wr = wid >> 2, wc = wid & 3, fr = lane & 15, fq = lane >> 4;
    int K_ = g.K; asm volatile("" : "+s"(K_));
    const int K = K_, nt = K / BK;
    unsigned voffA[2], voffB[2];
#pragma unroll
    for (int i = 0; i < 2; ++i) { int R, C; stage_rc(tid * 16 + i * 8192, R, C); const int Rb = Epi::PERM ? ((R & ~31) + perm32(R & 31)) : R;
        voffA[i] = (unsigned)(R * K + C) * 2u; voffB[i] = (unsigned)(Rb * K + C) * 2u; }
    const size_t kstep = (size_t)(BK * 2);
    const size_t hstep = (size_t)HALF * K * 2;
    const size_t tstep = 2 * hstep;
    const unsigned ldsw = (unsigned)wid * 1024u;
    const int aoff = lds_byte(wr * 64 + fr, fq * 8), boff = lds_byte(wc * 32 + fr, fq * 8);
#define PG8_SA(b, h) (((b) * 2 + (h)) * HTB)
#define PG8_SB(b, h) ((4 + (b) * 2 + (h)) * HTB)
#define PG8_STAGE(bufoff, gbase, voff) do { _Pragma("unroll") for (int _i = 0; _i < 2; ++_i) \
        __builtin_amdgcn_global_load_lds((const unsigned*)((const char*)(gbase) + (voff)[_i]), (PG8_LAS unsigned*)(lds + (bufoff) + ldsw + _i * 8192), 16, 0, 0); } while (0)
#define PG8_LDA(dst, b, h) do { _Pragma("unroll") for (int m = 0; m < 4; ++m) _Pragma("unroll") for (int k = 0; k < 2; ++k) dst[m][k] = *(const PG8_LAS bf16x8*)(lds + PG8_SA(b, h) + aoff + m * 2048 + k * 1024); } while (0)
#define PG8_LDB(dst, b, h) do { _Pragma("unroll") for (int n = 0; n < 2; ++n) _Pragma("unroll") for (int k = 0; k < 2; ++k) dst[n][k] = *(const PG8_LAS bf16x8*)(lds + PG8_SB(b, h) + boff + n * 2048 + k * 1024); } while (0)
#define PG8_MMA(ai, bj, At, Bt) do { __builtin_amdgcn_s_setprio(1); _Pragma("unroll") for (int m = 0; m < 4; ++m) _Pragma("unroll") for (int n = 0; n < 2; ++n) _Pragma("unroll") for (int k = 0; k < 2; ++k) \
        acc[ai][bj][m][n] = __builtin_amdgcn_mfma_f32_16x16x32_bf16(Bt[n][k], At[m][k], acc[ai][bj][m][n], 0, 0, 0); __builtin_amdgcn_s_setprio(0); } while (0)
#define PG8_WAIT_V(n) asm volatile("s_waitcnt vmcnt(" #n ")" ::: "memory")
#define PG8_WAIT_L(n) asm volatile("s_waitcnt lgkmcnt(" #n ")" ::: "memory")
#define PG8_BAR __builtin_amdgcn_s_barrier()
#define PG8_SCHED __builtin_amdgcn_sched_barrier(0)
    Unit cur, nxt; int ui = 0;
    if (!S.next(0, cur)) return;
    f32x4 acc[2][2][4][2];
#pragma unroll
    for (int a = 0; a < 2; ++a)
#pragma unroll
        for (int b = 0; b < 2; ++b)
#pragma unroll
            for (int m = 0; m < 4; ++m)
#pragma unroll
                for (int n = 0; n < 2; ++n) acc[a][b][m][n] = (f32x4){0.f, 0.f, 0.f, 0.f};
    bf16x8 At[4][2], B0[2][2], B1[2][2];
    const char* cA = GATHER ? (const char*)g.A : (const char*)g.A + (size_t)cur.pm * tstep; const char* cB = (const char*)g.Bt + (size_t)cur.pn * tstep;
    unsigned gc0[2] = {0u, 0u}, gc1[2] = {0u, 0u}, gn0[2] = {0u, 0u}, gn1[2] = {0u, 0u}; int gR[2] = {0, 0}; unsigned gC[2] = {0u, 0u};
    if constexpr (GATHER) {
#pragma unroll
        for (int i = 0; i < 2; ++i) { int R, C; stage_rc(tid * 16 + i * 8192, R, C); gR[i] = R; gC[i] = (unsigned)C * 2u;
            gc0[i] = (unsigned)g.rowidx[cur.pm * BM + R] * (unsigned)(K * 2) + gC[i]; gc1[i] = (unsigned)g.rowidx[cur.pm * BM + HALF + R] * (unsigned)(K * 2) + gC[i]; }
    }
#define PG8_STAGE_A(bufoff, base, half, o0, o1) do { if constexpr (GATHER) { if ((half) == 0) PG8_STAGE(bufoff, base, o0); else PG8_STAGE(bufoff, base, o1); } \
        else PG8_STAGE(bufoff, (base) + ((half) ? hstep : 0), voffA); } while (0)
    S.a_ready(cur);
    if constexpr (SP2) {
        PG8_STAGE(PG8_SB(0, 0), cB, voffB); PG8_STAGE(PG8_SB(0, 1), cB + hstep, voffB); PG8_STAGE_A(PG8_SA(0, 0), cA, 0, gc0, gc1); PG8_STAGE_A(PG8_SA(0, 1), cA, 1, gc0, gc1);
        if (wr == 1) PG8_BAR;
        PG8_WAIT_V(2); PG8_BAR;
        PG8_STAGE(PG8_SB(1, 0), cB + kstep, voffB); PG8_STAGE_A(PG8_SA(1, 0), cA + kstep, 0, gc0, gc1); PG8_STAGE(PG8_SB(1, 1), cB + hstep + kstep, voffB);
        PG8_WAIT_V(6); PG8_BAR;
    } else {
        PG8_STAGE(PG8_SB(0, 0), cB, voffB); PG8_STAGE(PG8_SA(0, 0), cA, voffA); PG8_STAGE(PG8_SB(0, 1), cB + hstep, voffB); PG8_STAGE(PG8_SA(0, 1), cA + hstep, voffA);
        if (wr == 1) PG8_BAR;
        PG8_WAIT_V(4); PG8_BAR;
        PG8_STAGE(PG8_SB(1, 0), cB + kstep, voffB); PG8_STAGE(PG8_SA(1, 0), cA + kstep, voffA); PG8_STAGE(PG8_SB(1, 1), cB + hstep + kstep, voffB);
        PG8_WAIT_V(6); PG8_BAR;
    }
    for (;;) {
        const bool has_next = S.next(ui + 1, nxt);
        const char* nA = GATHER ? cA : (has_next ? (const char*)g.A + (size_t)nxt.pm * tstep : cA); const char* nB = has_next ? (const char*)g.Bt + (size_t)nxt.pn * tstep : cB;
        if constexpr (GATHER) { const int npm = has_next ? nxt.pm : cur.pm;
#pragma unroll
            for (int i = 0; i < 2; ++i) { gn0[i] = (unsigned)g.rowidx[npm * BM + gR[i]] * (unsigned)(K * 2) + gC[i]; gn1[i] = (unsigned)g.rowidx[npm * BM + HALF + gR[i]] * (unsigned)(K * 2) + gC[i]; } }
        for (int t = 0; t < nt; t += 2) {
            const bool last = (t == nt - 2);
            const char* a1 = cA + (size_t)(t + 1) * kstep;
            const char* a2 = last ? nA : cA + (size_t)(t + 2) * kstep; const char* b2 = last ? nB : cB + (size_t)(t + 2) * kstep;
            const char* a3 = a2 + kstep; const char* b3 = b2 + kstep;
            if (last && has_next) S.a_ready(nxt);
            if constexpr (SP2) {
            unsigned gs0[2], gs1[2];
#pragma unroll
            for (int i = 0; i < 2; ++i) { gs0[i] = last ? gn0[i] : gc0[i]; gs1[i] = last ? gn1[i] : gc1[i]; }
            PG8_LDB(B0, 0, 0); PG8_LDB(B1, 0, 1); PG8_SCHED; PG8_LDA(At, 0, 0); PG8_STAGE_A(PG8_SA(1, 1), a1, 1, gc0, gc1);
            PG8_WAIT_V(8); PG8_WAIT_L(0); PG8_BAR; PG8_MMA(0, 0, At, B0); PG8_MMA(0, 1, At, B1); PG8_BAR; PG8_SCHED;
            PG8_LDA(At, 0, 1); PG8_STAGE(PG8_SB(0, 0), b2, voffB); PG8_STAGE(PG8_SB(0, 1), b2 + hstep, voffB); PG8_STAGE_A(PG8_SA(0, 0), a2, 0, gs0, gs1);
            PG8_WAIT_V(8); PG8_WAIT_L(0); PG8_BAR; PG8_MMA(1, 0, At, B0); PG8_MMA(1, 1, At, B1); PG8_BAR; PG8_SCHED;
            PG8_LDB(B0, 1, 0); PG8_LDB(B1, 1, 1); PG8_SCHED; PG8_LDA(At, 1, 0); PG8_STAGE_A(PG8_SA(0, 1), a2, 1, gs0, gs1);
            PG8_WAIT_V(8); PG8_WAIT_L(0); PG8_BAR; PG8_MMA(0, 0, At, B0); PG8_MMA(0, 1, At, B1); PG8_BAR; PG8_SCHED;
            PG8_LDA(At, 1, 1); PG8_STAGE(PG8_SB(1, 0), b3, voffB); PG8_STAGE(PG8_SB(1, 1), b3 + hstep, voffB); PG8_STAGE_A(PG8_SA(1, 0), a3, 0, gs0, gs1);
            PG8_WAIT_V(8); PG8_WAIT_L(0); PG8_BAR; PG8_MMA(1, 0, At, B0); PG8_MMA(1, 1, At, B1); PG8_BAR; PG8_SCHED;
            } else {
            PG8_LDB(B0, 0, 0); PG8_SCHED; PG8_LDA(At, 0, 0); PG8_STAGE(PG8_SA(1, 1), a1 + hstep, voffA);
            PG8_WAIT_L(8); PG8_BAR; PG8_WAIT_L(0); PG8_MMA(0, 0, At, B0); PG8_BAR; PG8_SCHED;
            PG8_LDB(B1, 0, 1); PG8_STAGE(PG8_SB(0, 0), b2, voffB);
            PG8_BAR; PG8_WAIT_L(0); PG8_MMA(0, 1, At, B1); PG8_BAR;
            PG8_LDA(At, 0, 1); PG8_STAGE(PG8_SA(0, 0), a2, voffA);
            PG8_BAR; PG8_WAIT_L(0); PG8_MMA(1, 0, At, B0); PG8_BAR; PG8_SCHED;
            PG8_STAGE(PG8_SB(0, 1), b2 + hstep, voffB);
            PG8_WAIT_V(6); PG8_BAR; PG8_MMA(1, 1, At, B1); PG8_BAR;
            PG8_LDB(B0, 1, 0); PG8_SCHED; PG8_LDA(At, 1, 0); PG8_STAGE(PG8_SA(0, 1), a2 + hstep, voffA);
            PG8_WAIT_L(8); PG8_BAR; PG8_WAIT_L(0); PG8_MMA(0, 0, At, B0); PG8_BAR; PG8_SCHED;
            PG8_LDB(B1, 1, 1); PG8_STAGE(PG8_SB(1, 0), b3, voffB);
            PG8_BAR; PG8_WAIT_L(0); PG8_MMA(0, 1, At, B1); PG8_BAR;
            PG8_LDA(At, 1, 1); PG8_STAGE(PG8_SA(1, 0), a3, voffA);
            PG8_BAR; PG8_WAIT_L(0); PG8_MMA(1, 0, At, B0); PG8_BAR; PG8_SCHED;
            PG8_STAGE(PG8_SB(1, 1), b3 + hstep, voffB);
            PG8_WAIT_V(6); PG8_BAR; PG8_MMA(1, 1, At, B1); PG8_BAR;
            }
        }
        if constexpr (ALIGN_EPI) { if (wr == 0) PG8_BAR; }
        if constexpr (!Epi::AFTER_DRAIN) { E(acc, cur, wr, wc, fr, fq); S.done(cur); }
        if (!has_next) break;
#pragma unroll
        for (int a = 0; a < 2; ++a)
#pragma unroll
            for (int b = 0; b < 2; ++b)
#pragma unroll
                for (int m = 0; m < 4; ++m)
#pragma unroll
                    for (int n = 0; n < 2; ++n) acc[a][b][m][n] = (f32x4){0.f, 0.f, 0.f, 0.f};
        cur = nxt; cA = nA; cB = nB; ++ui;
        if constexpr (GATHER) { gc0[0] = gn0[0]; gc0[1] = gn0[1]; gc1[0] = gn1[0]; gc1[1] = gn1[1]; }
        if constexpr (ALIGN_EPI) { if (wr == 1) PG8_BAR; }
    }
    PG8_WAIT_V(0);
    if constexpr (!ALIGN_EPI) { if (wr == 0) PG8_BAR; }
    PG8_BAR;
#undef PG8_SA
#undef PG8_SB
#undef PG8_STAGE
#undef PG8_STAGE_A
#undef PG8_LDA
#undef PG8_LDB
#undef PG8_MMA
#undef PG8_WAIT_V
#undef PG8_WAIT_L
#undef PG8_BAR
#undef PG8_SCHED
}
}

__device__ __forceinline__ double rope_kd(int i) {
    switch (i) { case 0: return 0.15915494309189535; case 1: return 0.08949940160889101; case 2: return 0.050329212104487035; case 3: return 0.0283021958306234;
        case 4: return 0.015915494309189534; case 5: return 0.008949940160889102; case 6: return 0.005032921210448704; case 7: return 0.00283021958306234;
        case 8: return 0.0015915494309189536; case 9: return 0.0008949940160889102; case 10: return 0.0005032921210448703; case 11: return 0.00028302195830623395;
        case 12: return 0.00015915494309189535; case 13: return 8.949940160889102e-05; case 14: return 5.0329212104487035e-05; default: return 2.8302195830623396e-05; }
}
__device__ __forceinline__ float rope_frac(int p, int i) {
    const double kd = rope_kd(i); const float kh = (float)kd, kl = (float)(kd - (double)kh), pf = (float)p;
    const float r1 = pf * kh, e1 = __builtin_fmaf(pf, kh, -r1) + pf * kl;
    float fr = (r1 - __builtin_floorf(r1)) + e1;
    return fr - __builtin_floorf(fr);
}
struct EpiMla {
    static constexpr bool PERM = true, AFTER_DRAIN = false;
    bf16_t* Q; bf16_t* KI; bf16_t* VI; const int* pos; float qscale;
    __device__ __forceinline__ void operator()(const f32x4 (&acc)[2][2][4][2], const pg8::Unit& u, int wr, int wc, int fr, int fq) const {
        const int tile = u.pn & 3;
#pragma unroll
        for (int ai = 0; ai < 2; ++ai)
#pragma unroll
            for (int m = 0; m < 4; ++m) {
                int t = u.pm * 256 + ai * 128 + wr * 64 + m * 16 + fr; asm volatile("" : "+v"(t)); const int b = t >> 13, sq = t & 8191;
                if (tile == 1) {
                    const int p = pos[t]; const float sgn = (fq < 2) ? -1.0f : 1.0f;
                    u32x4 w;
#pragma unroll
                    for (int n = 0; n < 2; ++n) { const f32x4 vv = acc[ai][0][m][n]; float o4[4];
#pragma unroll
                        for (int j = 0; j < 4; ++j) { const float own = vv[j], oth = __shfl_xor(own, 32);
                            const float rr = (fq & 1) ? rope_frac(p, 8 + 4 * n + j) : rope_frac(p, 4 * n + j), c = __builtin_amdgcn_cosf(rr), sn = __builtin_amdgcn_sinf(rr);
                            o4[j] = (own * c + sgn * oth * sn) * qscale; }
                        if (n == 0) { w.x = pg8::cvt_pk_bf16(o4[0], o4[1]); w.y = pg8::cvt_pk_bf16(o4[2], o4[3]); } else { w.z = pg8::cvt_pk_bf16(o4[0], o4[1]); w.w = pg8::cvt_pk_bf16(o4[2], o4[3]); }
                        asm volatile("" ::: "memory"); }
                    *(u32x4*)(Q + ((size_t)(b * 4 + wc) * 8192 + sq) * 96 + 64 + 8 * fq) = w;
                    asm volatile("" ::: "memory");
                } else {
#pragma unroll
                    for (int bj = 0; bj < 2; ++bj) { const f32x4 v0 = acc[ai][bj][m][0], v1 = acc[ai][bj][m][1];
                        const int h = 2 * bj + (wc >> 1), bh = b * 4 + h;
                        if (tile == 0) { u32x4 w; w.x = pg8::cvt_pk_bf16(v0[0] * qscale, v0[1] * qscale); w.y = pg8::cvt_pk_bf16(v0[2] * qscale, v0[3] * qscale); w.z = pg8::cvt_pk_bf16(v1[0] * qscale, v1[1] * qscale); w.w = pg8::cvt_pk_bf16(v1[2] * qscale, v1[3] * qscale);
                            *(u32x4*)(Q + ((size_t)bh * 8192 + sq) * 96 + 32 * (wc & 1) + 8 * fq) = w; }
                        else { u32x4 w; w.x = pg8::cvt_pk_bf16(v0[0], v0[1]); w.y = pg8::cvt_pk_bf16(v0[2], v0[3]); w.z = pg8::cvt_pk_bf16(v1[0], v1[1]); w.w = pg8::cvt_pk_bf16(v1[2], v1[3]);
                            if (tile == 2) *(u32x4*)(KI + ((size_t)bh * 128 + (sq >> 6)) * 6144 + (4 * (wc & 1) + fq) * 512 + (sq & 63) * 8) = w;
                            else *(u32x4*)(VI + ((size_t)bh * 128 + (sq >> 6)) * 4096 + (wc & 1) * 2048 + (sq & 63) * 32 + 8 * fq) = w; } }
                }
            }
    }
};

constexpr int NWAVES = 8, NTHR = 512;
constexpr int BATCH = 2, SEQ = 8192, DM = 1024, MTOK = BATCH * SEQ;
constexpr int DIN = 2960, DINP = 3072;
constexpr int NEXP = 16, CAP = 1024, EFF = 2048;
constexpr float EPS = 1e-6f;
constexpr int U_MLQ = 0, U_MLK = 256, U_MLV = 512, U_MLO = 768, U_MLG = 1024, U_CQ = 1040, U_CKV = 1264, U_KR = 1392, U_HY = 1424, U_SC = 2192;
constexpr float LOG2E = 1.4426950408889634f;

constexpr size_t MiB = 1u << 20;
constexpr size_t WS_CTL = 0, CTL_ZERO_BYTES = 1 * MiB;
constexpr size_t WS_MOD = 1 * MiB;
constexpr size_t WS_MLS = 1 * MiB + 128 * 1024;
constexpr size_t WS_MLN = 1 * MiB + 256 * 1024;
constexpr size_t WS_AFF = 2 * MiB;
constexpr size_t WS_SLOT = 3 * MiB;
constexpr size_t WS_IDX = 4 * MiB;
constexpr size_t WS_HID = 5 * MiB;
constexpr size_t WS_WMLA = 9 * MiB;
constexpr size_t WS_WOUT = 11 * MiB;
constexpr size_t WS_WIN = 15 * MiB;
constexpr size_t WS_WGU = 28 * MiB;
constexpr size_t WS_WDN = 284 * MiB;
constexpr size_t WS_XN = 412 * MiB;
constexpr size_t WS_AMLA = 444 * MiB;
constexpr size_t WS_Q = 456 * MiB;
constexpr size_t WS_KIMG = 468 * MiB;
constexpr size_t WS_VIMG = 480 * MiB;
constexpr size_t WS_MLC = 488 * MiB;
constexpr size_t WS_HF = 504 * MiB;
constexpr size_t WS_HB = 520 * MiB;
constexpr size_t WS_YATT = 536 * MiB;
constexpr size_t WS_YHT = 544 * MiB;
constexpr size_t WS_YN = 552 * MiB;
constexpr size_t WS_X1 = 584 * MiB;
constexpr size_t WS_U = 648 * MiB;
constexpr size_t WS_OMLA = 744 * MiB;
constexpr size_t WS_ACT = 648 * MiB;
constexpr size_t WS_KF = 776 * MiB;
constexpr size_t WS_Y2 = 776 * MiB;
constexpr size_t WS_XE = 776 * MiB;
constexpr size_t WS_YE = 840 * MiB;
constexpr size_t WS_HYT = 904 * MiB;
constexpr size_t WS_FILT = 956 * MiB;
constexpr size_t WS_END = 1020 * MiB;
constexpr int CW_BAR = 4096;

constexpr int RING_BYTES = 139264;
constexpr int LDSCTL_OFF = RING_BYTES, MISC_OFF = LDSCTL_OFF + 320;
constexpr int XTRA_OFF = RING_BYTES + 1024;
constexpr int LDS_BYTES = 147456;

__device__ __forceinline__ float bf2f(unsigned short u) { return __uint_as_float((unsigned)u << 16); }
__device__ __forceinline__ unsigned pk2(float lo, float hi) { f32x2 v = {lo, hi}; bf16x2_t b = __builtin_convertvector(v, bf16x2_t); return __builtin_bit_cast(unsigned, b); }
__device__ __forceinline__ float bflo(unsigned w) { return __uint_as_float(w << 16); }
__device__ __forceinline__ float bfhi(unsigned w) { return __uint_as_float(w & 0xffff0000u); }
__device__ __forceinline__ float wave_sum(float v) {
#pragma unroll
    for (int o = 1; o < 64; o <<= 1) v += __shfl_xor(v, o);
    return v;
}
__device__ __forceinline__ float fexp(float x) { return __builtin_amdgcn_exp2f(x * LOG2E); }
__device__ __forceinline__ float flog(float x) { return __builtin_amdgcn_logf(x) * 0.6931471805599453f; }
__device__ __forceinline__ float sin_rev(float r) { return __builtin_amdgcn_sinf(r); }
__device__ __forceinline__ float cos_rev(float r) { return __builtin_amdgcn_cosf(r); }
__device__ __forceinline__ float sin_rad(float x) { float r = x * 0.15915494309189535f; r = r - __builtin_rintf(r); return __builtin_amdgcn_sinf(r); }
__device__ __forceinline__ int crow(int r, int hi) { return (r & 3) + 8 * (r >> 2) + 4 * hi; }
#define LDS_WAIT() asm volatile("s_waitcnt lgkmcnt(0)" ::: "memory")
#define VM_WAIT() asm volatile("s_waitcnt vmcnt(0)" ::: "memory")

#define XB_TMO      128
#define XB_XCNT(j)  (256  + 64 * (j))
#define XB_XSUB(j)  (1280 + 64 * (j))
#define XB_XGEN(j)  (2304 + 64 * (j))
#define XB_TOP      3328
#define XB_TOPGEN   3392
#define XCD_BAR_WORDS 3456
#define XB_SPIN_CAP (1u << 18)
__device__ __forceinline__ unsigned xb_ld(unsigned* p)              { return __hip_atomic_load(p, __ATOMIC_RELAXED, __HIP_MEMORY_SCOPE_AGENT); }
__device__ __forceinline__ unsigned xb_add(unsigned* p, unsigned v) { return __hip_atomic_fetch_add(p, v, __ATOMIC_RELAXED, __HIP_MEMORY_SCOPE_AGENT); }
__device__ __forceinline__ unsigned xb_xcc_id() { return (unsigned)__builtin_amdgcn_s_getreg((3 << 11) | 20) & 0xFu; }
#define XB_SPIN(cond, bar) do { unsigned _sp = 0; while (cond) { __builtin_amdgcn_s_sleep(1); \
    if ((++_sp & 255u) == 0u) { if (xb_ld(&(bar)[XB_TMO])) break; if (_sp > XB_SPIN_CAP) { atomicAdd(&(bar)[XB_TMO], 1u); break; } } } } while (0)
struct XcdBarrier { unsigned* bar; unsigned x; volatile LAS unsigned* st; };
__device__ __forceinline__ XcdBarrier xcd_barrier_post(unsigned* bar, volatile LAS unsigned* st) {
    XcdBarrier b; b.bar = bar; b.x = xb_xcc_id(); b.st = st;
    if (threadIdx.x == 0) (void)xb_add(&bar[XB_XCNT(b.x)], 1u);
    return b;
}
__device__ __forceinline__ void xcd_barrier_complete(unsigned* bar, unsigned x, unsigned& nloc, unsigned& nx) {
    const unsigned G = gridDim.x * gridDim.y * gridDim.z;
    unsigned sum, cnt, mine, sp = 0u;
    for (;;) {
        sum = 0u; cnt = 0u; mine = 0u;
#pragma unroll
        for (unsigned j = 0; j < 16; ++j) { const unsigned c = xb_ld(&bar[XB_XCNT(j)]); sum += c; cnt += (c > 0u) ? 1u : 0u; mine = (j == x) ? c : mine; }
        if (sum == G) break;
        __builtin_amdgcn_s_sleep(1);
        if ((++sp & 255u) == 0u) { if (xb_ld(&bar[XB_TMO])) break; if (sp > XB_SPIN_CAP) { atomicAdd(&bar[XB_TMO], 1u); break; } }
    }
    nloc = mine > 0u ? mine : 1u; nx = cnt > 0u ? cnt : 1u;
}
__device__ __forceinline__ void xcd_barrier(const XcdBarrier& b) {
    asm volatile("s_waitcnt vmcnt(0)" ::: "memory");
    __syncthreads();
    if (threadIdx.x == 0) {
        unsigned* bar = b.bar;
        __builtin_amdgcn_s_waitcnt(0);
        unsigned nloc = b.st[0], nx = b.st[1];
        if (nloc == 0u) { xcd_barrier_complete(bar, b.x, nloc, nx); b.st[0] = nloc; b.st[1] = nx; }
        const unsigned old = xb_add(&bar[XB_XSUB(b.x)], 1u);
        const unsigned gen = old / nloc;
        if (old + 1u == (gen + 1u) * nloc) {
            __builtin_amdgcn_fence(__ATOMIC_RELEASE, "agent");
            asm volatile("s_waitcnt vmcnt(0)" ::: "memory");
            const unsigned og = xb_add(&bar[XB_TOP], 1u);
            const unsigned tg = og / nx;
            if (og + 1u == (tg + 1u) * nx) xb_add(&bar[XB_TOPGEN], 1u);
            else XB_SPIN(xb_ld(&bar[XB_TOPGEN]) == tg, bar);
            __builtin_amdgcn_fence(__ATOMIC_ACQUIRE, "agent");
            xb_add(&bar[XB_XGEN(b.x)], 1u);
            asm volatile("s_waitcnt vmcnt(0)" ::: "memory");
        } else {
            XB_SPIN(xb_ld(&bar[XB_XGEN(b.x)]) == gen, bar);
            __builtin_amdgcn_fence(__ATOMIC_ACQUIRE, "agent");
            asm volatile("s_waitcnt vmcnt(0)" ::: "memory");
        }
    }
    __syncthreads();
}

struct Args { const void* in[35]; float* out; unsigned char* ws; int ph_lo, ph_hi; };
struct Frame {
    LAS unsigned char* lds;
    int tid, lane, wave, vcu, G;
    const Args* a;
    unsigned char* ws;
};
#define INF(i) ((const float*)F.a->in[i])
#define WSP(T, off) ((T*)(F.ws + (off)))

__device__ __forceinline__ void tr_item(const float* W, int ldw, int Kvalid, int Nvalid, int k0, int n0, bf16_t* dst, int dpitch, int drow0, int dk0, LAS float* scr, int lane, int NW = 64) {
    f32x4 v[16];
    const int nn = n0 + 4 * (lane & 15);
#pragma unroll
    for (int i = 0; i < 16; ++i) { const int kk = 4 * i + (lane >> 4);
        v[i] = (f32x4){0.f, 0.f, 0.f, 0.f};
        if (W != nullptr && (k0 + kk) < Kvalid && nn < Nvalid) v[i] = *(const GAS f32x4*)(W + (size_t)(k0 + kk) * ldw + nn); }
#pragma unroll
    for (int i = 0; i < 16; ++i) { const int kk = 4 * i + (lane >> 4);
        *(LAS f32x4*)(scr + kk * 64 + ((4 * (lane & 15)) ^ (4 * ((kk >> 3) & 7)))) = v[i]; }
    LDS_WAIT(); asm volatile("" ::: "memory");
    const int kc = lane & 7, nl = lane >> 3;
#pragma unroll
    for (int j = 0; j < 8; ++j) { const int n = 8 * j + nl; const LAS float* sp = scr + (8 * kc) * 64 + (n ^ (4 * kc));
        u32x4 o; o.x = pk2(sp[0 * 64], sp[1 * 64]); o.y = pk2(sp[2 * 64], sp[3 * 64]); o.z = pk2(sp[4 * 64], sp[5 * 64]); o.w = pk2(sp[6 * 64], sp[7 * 64]);
        if (n < NW) *(GAS u32x4*)(dst + (size_t)(drow0 + n) * dpitch + dk0 + k0 + 8 * kc) = o; }
    LDS_WAIT(); asm volatile("" ::: "memory");
}

__device__ __forceinline__ void p0_phase(Frame& F) {
    const int tid = F.tid, lane = F.lane, wave = F.wave;
    {
        LAS float* cs = (LAS float*)(F.lds);
        LAS float* red = (LAS float*)(F.lds + 8192);
        const float* c = INF(1);
        for (int i = tid; i < 2048; i += NTHR) { const float v = c[i]; cs[i] = v / (1.0f + fexp(-v)); }
        __syncthreads();
        for (int cb = blockIdx.x; cb < 256; cb += F.G) {
            const int j = tid % 48, kg = tid / 48;
            const int col = cb * 48 + j, l = col / 6144, n = col % 6144;
            if (kg < 10) {
                const float* w = INF(3) + (size_t)l * 1024 * 6144 + n;
                float a0 = 0.f, a1 = 0.f;
#pragma unroll 26
                for (int k = kg; k < 1024; k += 10) { const float wv = w[(size_t)k * 6144]; a0 += cs[k] * wv; a1 += cs[1024 + k] * wv; }
                red[(kg * 48 + j) * 2] = a0; red[(kg * 48 + j) * 2 + 1] = a1;
            }
            __syncthreads();
            if (tid < 96) { const int jj = tid >> 1, b = tid & 1; float s = 0.f;
                for (int g = 0; g < 10; ++g) s += red[(g * 48 + jj) * 2 + b];
                const int col2 = cb * 48 + jj, l2 = col2 / 6144, n2 = col2 % 6144;
                WSP(float, WS_MOD)[(l2 * 2 + b) * 6144 + n2] = s + INF(4)[l2 * 6144 + n2]; }
            __syncthreads();
        }
    }
    {
        const int gw = F.vcu * NWAVES + wave, NGW = F.G * NWAVES;
        for (int l = 0; l < 2; ++l) {
            const float* w1 = INF(18) + l * 17 * 64; const float* w2 = INF(21) + l * 64 * 64;
            float w1c[17], w2c[64];
#pragma unroll
            for (int i = 0; i < 17; ++i) w1c[i] = w1[i * 64 + lane];
#pragma unroll
            for (int k = 0; k < 64; ++k) w2c[k] = w2[k * 64 + lane];
            const float b1 = INF(19)[l * 64 + lane], fr1 = INF(20)[l * 64 + lane], b2 = INF(22)[l * 64 + lane], fr2 = INF(23)[l * 64 + lane];
            for (int t = gw; t < SEQ; t += NGW) {
                const float tt = (float)t * (1.0f / SEQ);
                float a = b1 + tt * w1c[0];
#pragma unroll
                for (int bnd = 1; bnd <= 8; ++bnd) { float r = (float)((t * bnd) & (SEQ - 1)) * (1.0f / SEQ); a += sin_rev(r) * w1c[bnd] + cos_rev(r) * w1c[8 + bnd]; }
                const float h1 = sin_rad(fr1 * a);
                float a2 = b2;
#pragma unroll
                for (int k = 0; k < 64; ++k) a2 += __shfl(h1, k) * w2c[k];
                WSP(float, WS_HID)[((size_t)l * SEQ + t) * 64 + lane] = sin_rad(fr2 * a2);
            }
        }
    }
    {
        LAS float* scr = (LAS float*)(F.lds + wave * 16384);
        const int gw = F.vcu * NWAVES + wave, NGW = F.G * NWAVES;
        constexpr int I_WIN = 16 * 48, I_WOUT = 16 * 16, I_WMLA = 6 * 16, I_GU = 16 * 2 * 16 * 32, I_DN = 16 * 32 * 16;
        constexpr int I_LAYER = I_WIN + I_WOUT + I_WMLA + I_GU + I_DN;
        for (int it = gw; it < 2 * I_LAYER; it += NGW) {
            const int l = it / I_LAYER; int r = it % I_LAYER;
            if (r < I_WIN) { const int kb = r / 48, nb = r % 48;
                tr_item(INF(9) + (size_t)l * 1024 * DIN, DIN, 1024, DIN, kb * 64, nb * 64, WSP(bf16_t, WS_WIN) + (size_t)l * DINP * 1024, 1024, nb * 64, 0, scr, lane); continue; }
            r -= I_WIN;
            if (r < I_WOUT) { const int kb = r / 16, nb = r % 16;
                tr_item(INF(30) + (size_t)l * 1024 * 1024, 1024, 1024, 1024, kb * 64, nb * 64, WSP(bf16_t, WS_WOUT) + (size_t)l * 1024 * 1024, 1024, nb * 64, 0, scr, lane); continue; }
            r -= I_WOUT;
            if (r < I_WMLA) { const int kb = r / 16, nb = r % 16;
                bf16_t* dst = WSP(bf16_t, WS_WMLA) + (size_t)l * 1024 * 384;
                const float* Wq = INF(13) + (size_t)l * 224 * 384;
                if (nb < 4) { if (kb < 4) tr_item(Wq, 384, 224, nb * 96 + 64, kb * 64, nb * 96, dst, 384, nb * 64, 0, scr, lane); else tr_item(nullptr, 4, 0, 0, 0, 0, dst, 384, nb * 64, kb * 64, scr, lane); }
                else if (nb < 6) { const int h0 = 2 * (nb - 4);
                    if (kb < 4) { tr_item(Wq, 384, 224, h0 * 96 + 96, kb * 64, h0 * 96 + 64, dst, 384, 256 + h0 * 32, 0, scr, lane, 32);
                                  tr_item(Wq, 384, 224, (h0 + 1) * 96 + 96, kb * 64, (h0 + 1) * 96 + 64, dst, 384, 256 + (h0 + 1) * 32, 0, scr, lane, 32); }
                    else tr_item(nullptr, 4, 0, 0, 0, 0, dst, 384, nb * 64, kb * 64, scr, lane); }
                else if (nb < 8) tr_item(nullptr, 4, 0, 0, 0, 0, dst, 384, nb * 64, kb * 64, scr, lane);
                else { const float* W = (nb < 12) ? INF(14) + (size_t)l * 128 * 256 : INF(15) + (size_t)l * 128 * 256; const int nsrc = ((nb - 8) & 3) * 64;
                    if (kb >= 4) tr_item(W, 256, 128, 256, (kb - 4) * 64, nsrc, dst, 384, nb * 64, 256, scr, lane); else tr_item(nullptr, 4, 0, 0, 0, 0, dst, 384, nb * 64, kb * 64, scr, lane); }
                continue; }
            r -= I_WMLA;
            if (r < I_GU) { const int e = r / (2 * 16 * 32); int q = r % (2 * 16 * 32); const int which = q / (16 * 32); q %= (16 * 32); const int kb = q / 32, nb = q % 32;
                const float* W = INF(which ? 33 : 32) + ((size_t)l * NEXP + e) * 1024 * 2048;
                const int n0 = nb * 64, drow = (n0 >> 7) * 256 + (n0 & 127) + (which ? 128 : 0);
                tr_item(W, 2048, 1024, 2048, kb * 64, n0, WSP(bf16_t, WS_WGU) + ((size_t)l * NEXP + e) * 4096 * 1024, 1024, drow, 0, scr, lane); continue; }
            r -= I_GU;
            { const int e = r / (32 * 16); const int q = r % (32 * 16); const int kb = q / 16, nb = q % 16;
                const float* W = INF(34) + ((size_t)l * NEXP + e) * 2048 * 1024;
                tr_item(W, 1024, 2048, 1024, kb * 64, nb * 64, WSP(bf16_t, WS_WDN) + ((size_t)l * NEXP + e) * 1024 * 2048, 2048, nb * 64, 0, scr, lane); }
        }
    }
}

__device__ __forceinline__ void ld_row_f32(const float* p, int lane, f32x4 (&v)[4]) {
    const GAS f32x4* r = (const GAS f32x4*)p + lane;
#pragma unroll
    for (int j = 0; j < 4; ++j) v[j] = r[64 * j];
}
__device__ __forceinline__ void st_row_f32(float* p, int lane, const f32x4 (&v)[4]) {
    GAS f32x4* r = (GAS f32x4*)p + lane;
#pragma unroll
    for (int j = 0; j < 4; ++j) r[64 * j] = v[j];
}
__device__ __forceinline__ void st_row_bf16(bf16_t* p, int lane, const f32x4 (&v)[4]) {
    GAS u32x2* r = (GAS u32x2*)p + lane;
#pragma unroll
    for (int j = 0; j < 4; ++j) { u32x2 w; w.x = pk2(v[j].x, v[j].y); w.y = pk2(v[j].z, v[j].w); r[64 * j] = w; }
}
__device__ __forceinline__ float row_ss(const f32x4 (&v)[4]) {
    float s = 0.f;
#pragma unroll
    for (int j = 0; j < 4; ++j) s += (v[j].x * v[j].x + v[j].y * v[j].y) + (v[j].z * v[j].z + v[j].w * v[j].w);
    return wave_sum(s);
}
__device__ __forceinline__ void modnorm(const f32x4 (&x)[4], const float* g, const float* sc, const float* sh, int lane, f32x4 (&h)[4]) {
    const float rstd = __builtin_amdgcn_rsqf(row_ss(x) * (1.0f / DM) + EPS);
    f32x4 gv[4], scv[4], shv[4];
    ld_row_f32(g, lane, gv); ld_row_f32(sc, lane, scv); ld_row_f32(sh, lane, shv);
#pragma unroll
    for (int j = 0; j < 4; ++j) h[j] = (x[j] * rstd) * gv[j] * (scv[j] + 1.0f) + shv[j];
}

__device__ __forceinline__ void filt_gemm_tile(Frame& F, int wt) {
    const int lane = F.lane, hi = lane >> 5, l31 = lane & 31;
    const int l = wt >> 11, r = wt & 2047, t0 = (r >> 3) * 32, col0 = (r & 7) * 128;
    f32x16 acc[4];
#pragma unroll
    for (int jb = 0; jb < 4; ++jb)
#pragma unroll
        for (int q = 0; q < 16; ++q) acc[jb][q] = 0.f;
    const float* hid = WSP(float, WS_HID) + ((size_t)l * SEQ + t0 + l31) * 64 + hi;
    const float* w3 = INF(24) + (size_t)l * 64 * 1024 + (size_t)hi * 1024 + col0 + l31;
#pragma unroll
    for (int s2 = 0; s2 < 32; ++s2) {
        const float bv = hid[2 * s2];
#pragma unroll
        for (int jb = 0; jb < 4; ++jb) { const float av = w3[(size_t)(2 * s2) * 1024 + 32 * jb]; acc[jb] = __builtin_amdgcn_mfma_f32_32x32x2f32(av, bv, acc[jb], 0, 0, 0); }
    }
    const float tt = (float)(t0 + l31) * (1.0f / SEQ);
    float* FT = WSP(float, WS_FILT) + (size_t)l * 1024 * SEQ + t0 + l31;
#pragma unroll
    for (int jb = 0; jb < 4; ++jb)
#pragma unroll
        for (int q = 0; q < 16; ++q) { const int col = col0 + 32 * jb + crow(q, hi);
            const float v = (acc[jb][q] + INF(25)[l * 1024 + col]) * fexp(-tt * fexp(INF(26)[l * 1024 + col]));
            FT[(size_t)col * SEQ] = v; }
}

__device__ __forceinline__ void p1_phase(Frame& F) {
    const int gw = F.vcu * NWAVES + F.wave, NGW = F.G * NWAVES;
    const float* mod = WSP(float, WS_MOD);
    for (int m = gw; m < MTOK; m += 2 * NGW) {
        const int m2 = (m + NGW < MTOK) ? m + NGW : m; f32x4 xa[4], xb[4], h[4];
        ld_row_f32(INF(0) + (size_t)m * DM, F.lane, xa); ld_row_f32(INF(0) + (size_t)m2 * DM, F.lane, xb);
        { const int b = m >> 13; modnorm(xa, INF(5), mod + (0 * 2 + b) * 6144 + 1024, mod + (0 * 2 + b) * 6144, F.lane, h); st_row_bf16(WSP(bf16_t, WS_XN) + (size_t)m * DM, F.lane, h); }
        { const int b = m2 >> 13; modnorm(xb, INF(5), mod + (0 * 2 + b) * 6144 + 1024, mod + (0 * 2 + b) * 6144, F.lane, h); st_row_bf16(WSP(bf16_t, WS_XN) + (size_t)m2 * DM, F.lane, h); }
    }
    for (int wt = gw; wt < 4096; wt += NGW) filt_gemm_tile(F, wt);
}

__device__ __forceinline__ float wave_scan_add(float v, int lane) {
#pragma unroll
    for (int o = 1; o < 64; o <<= 1) { const float n = __shfl_up(v, o); if (lane >= o) v += n; }
    return v;
}
__device__ __forceinline__ float wave_scan_max(float v, int lane) {
#pragma unroll
    for (int o = 1; o < 64; o <<= 1) { const float n = __shfl_up(v, o); if (lane >= o) v = fmaxf(v, n); }
    return v;
}
__device__ __forceinline__ float wave_max(float v) {
#pragma unroll
    for (int o = 1; o < 64; o <<= 1) v = fmaxf(v, __shfl_xor(v, o));
    return v;
}
__device__ __forceinline__ float logsigmoid(float x) { return fminf(x, 0.f) - flog(1.0f + fexp(-fabsf(x))); }
struct MlItem { int b, h, dir, n, t0; };
__device__ __forceinline__ MlItem ml_decode(int item) { MlItem I; I.b = item >> 9; I.h = (item >> 7) & 3; I.dir = (item >> 6) & 1; I.n = item & 63;
    I.t0 = I.b * SEQ + (I.dir ? SEQ - 128 * (I.n + 1) : 128 * I.n); return I; }

__device__ __forceinline__ void ml_local_item(Frame& F, int item, int l) {
    const int tid = F.tid; const MlItem I = ml_decode(item);
    const bf16_t* U = WSP(bf16_t, WS_U);
    LAS float* EK = (LAS float*)(F.lds);
    LAS float* VV = (LAS float*)(F.lds + 32768);
    LAS float* LF = (LAS float*)(F.lds + 65536);
    LAS float* IG = LF + 128; LAS float* WW = LF + 256; LAS float* EST = LF + 384;
    const float* gb = INF(10) + l * 16;
    if (tid < 128) { const int j = tid, r = I.dir ? 127 - j : j; const size_t t = (size_t)(I.t0 + r);
        const float ipre = bf2f(U[t * DINP + U_MLG + (I.dir ? 2 : 0) * 4 + I.h]) + gb[(I.dir ? 2 : 0) * 4 + I.h];
        const float fpre = bf2f(U[t * DINP + U_MLG + (I.dir ? 3 : 1) * 4 + I.h]) + gb[(I.dir ? 3 : 1) * 4 + I.h];
        LF[j] = logsigmoid(fpre); IG[j] = ipre; }
    __syncthreads();
    float a = 0.f, aend = 0.f;
    if (tid < 128) { for (int i = 0; i < 128; ++i) { const float v = LF[i]; aend += v; if (i <= tid) a += v; }
        WW[tid] = aend - a + IG[tid]; }
    __syncthreads();
    float mloc = -3.0e38f;
    if (tid < 128) { for (int i = 0; i < 128; ++i) mloc = fmaxf(mloc, WW[i]);
        const int r = I.dir ? 127 - tid : tid; EST[r] = fexp(WW[tid] - mloc); }
    __syncthreads();
#pragma unroll
    for (int i = 0; i < 2; ++i) { const int p = tid + 512 * i, row = p >> 3, c8 = p & 7;
        const u32x4 kq = *(const GAS u32x4*)(U + (size_t)(I.t0 + row) * DINP + U_MLK + I.h * 64 + c8 * 8);
        const u32x4 vq = *(const GAS u32x4*)(U + (size_t)(I.t0 + row) * DINP + U_MLV + I.h * 64 + c8 * 8);
        const float es = EST[row] * 0.125f;
        LAS f32x4* ek = (LAS f32x4*)(EK + row * 64 + c8 * 8); LAS f32x4* vv = (LAS f32x4*)(VV + row * 64 + c8 * 8);
        ek[0] = (f32x4){bflo(kq.x) * es, bfhi(kq.x) * es, bflo(kq.y) * es, bfhi(kq.y) * es};
        ek[1] = (f32x4){bflo(kq.z) * es, bfhi(kq.z) * es, bflo(kq.w) * es, bfhi(kq.w) * es};
        vv[0] = (f32x4){bflo(vq.x), bfhi(vq.x), bflo(vq.y), bfhi(vq.y)};
        vv[1] = (f32x4){bflo(vq.z), bfhi(vq.z), bflo(vq.w), bfhi(vq.w)}; }
    __syncthreads();
    {
        const int d = tid >> 3, e0 = (tid & 7) * 8;
        f32x4 c0 = {0.f, 0.f, 0.f, 0.f}, c1 = {0.f, 0.f, 0.f, 0.f};
#pragma unroll 4
        for (int j = 0; j < 128; ++j) { const float ek = EK[j * 64 + d]; const f32x4 v0 = *(const LAS f32x4*)(VV + j * 64 + e0), v1 = *(const LAS f32x4*)(VV + j * 64 + e0 + 4);
            c0 += v0 * ek; c1 += v1 * ek; }
        GAS f32x4* dst = (GAS f32x4*)(WSP(float, WS_MLC) + (size_t)item * 4096 + d * 64 + e0);
        dst[0] = c0; dst[1] = c1;
        if (tid < 64) { float s = 0.f; for (int j = 0; j < 128; ++j) s += EK[j * 64 + tid]; WSP(float, WS_MLN)[item * 64 + tid] = s; }
        if (tid == 0) { WSP(float, WS_MLS)[item * 4] = mloc; WSP(float, WS_MLS)[item * 4 + 1] = aend; }
    }
    __syncthreads();
}

__device__ __forceinline__ void ml_scan(Frame& F) {
    float* MLC = WSP(float, WS_MLC); float* MLN = WSP(float, WS_MLN); float* MLS = WSP(float, WS_MLS);
    for (int blk = blockIdx.x; blk < 256; blk += F.G) { if (F.tid >= 260) continue; const int idx = blk * 260 + F.tid;
        const int seq = idx / 4160, el = idx % 4160;
        float* p0 = el < 4096 ? (MLC + (size_t)seq * 64 * 4096 + el) : (MLN + seq * 64 * 64 + (el - 4096));
        const int pstr = el < 4096 ? 4096 : 64;
        float mst = 0.f, st = 0.f;
#pragma unroll 1
        for (int n0 = 0; n0 < 64; n0 += 16) {
            float cl[16], mlv[16], aev[16];
#pragma unroll
            for (int i = 0; i < 16; ++i) { cl[i] = p0[(size_t)(n0 + i) * pstr]; mlv[i] = MLS[(seq * 64 + n0 + i) * 4]; aev[i] = MLS[(seq * 64 + n0 + i) * 4 + 1]; }
#pragma unroll
            for (int i = 0; i < 16; ++i) { const int item = seq * 64 + n0 + i;
                p0[(size_t)(n0 + i) * pstr] = st;
                if (el == 0) MLS[item * 4 + 2] = mst;
                const float mnew = fmaxf(aev[i] + mst, mlv[i]), sp = fexp(aev[i] + mst - mnew), sl = fexp(mlv[i] - mnew);
                st = sp * st + sl * cl[i]; mst = mnew; }
        }
    }
}

#define MFMA32(a, b, c) __builtin_amdgcn_mfma_f32_32x32x16_bf16((a), (b), (c), 0, 0, 0)
template <int NK>
__device__ __forceinline__ void qkt_tile(f32x16& p0, f32x16& p1, LAS const unsigned char* Kt, const bf16x8 (&qr)[NK], int r32, int hi) {
#pragma unroll
    for (int r = 0; r < 16; ++r) { p0[r] = 0.f; p1[r] = 0.f; }
#pragma unroll
    for (int d0 = 0; d0 < NK; ++d0) {
        const bf16x8 b0 = *(const LAS bf16x8*)(Kt + (2 * d0 + hi) * 1024 + r32 * 16);
        const bf16x8 b1 = *(const LAS bf16x8*)(Kt + (2 * d0 + hi) * 1024 + r32 * 16 + 512);
        p0 = MFMA32(b0, qr[d0], p0); p1 = MFMA32(b1, qr[d0], p1);
    }
}
typedef short v4i16_t __attribute__((ext_vector_type(4)));
__device__ __forceinline__ s16x4 vtr(LAS const unsigned char* p) { return __builtin_bit_cast(s16x4, __builtin_amdgcn_ds_read_tr16_b64_v4i16((LAS v4i16_t*)p)); }
__device__ __forceinline__ void pv_tile(f32x16 (&o)[2], LAS const unsigned char* Vt, const bf16x8 (&pa)[4], int lane) {
    const int hi = lane >> 5;
    LAS const unsigned char* vb = Vt + ((lane >> 4) & 1) * 32 + (lane & 3) * 8 + (4 * hi + ((lane & 15) >> 2)) * 64;
#pragma unroll
    for (int d0 = 0; d0 < 2; ++d0)
#pragma unroll
        for (int ks = 0; ks < 4; ++ks) {
            const s16x4 lo = vtr(vb + d0 * 4096 + ks * 1024), hh = vtr(vb + d0 * 4096 + ks * 1024 + 512);
            const bf16x8 vf = (bf16x8){lo[0], lo[1], lo[2], lo[3], hh[0], hh[1], hh[2], hh[3]};
            o[d0] = MFMA32(pa[ks], vf, o[d0]);
        }
}
__device__ __forceinline__ void pack_p(const f32x16& p0, const f32x16& p1, bf16x8 (&pa)[4]) {
    u32x4 w0, w1, w2, w3;
    w0 = (u32x4){pk2(p0[0], p0[1]), pk2(p0[2], p0[3]), pk2(p0[4], p0[5]), pk2(p0[6], p0[7])};
    w1 = (u32x4){pk2(p0[8], p0[9]), pk2(p0[10], p0[11]), pk2(p0[12], p0[13]), pk2(p0[14], p0[15])};
    w2 = (u32x4){pk2(p1[0], p1[1]), pk2(p1[2], p1[3]), pk2(p1[4], p1[5]), pk2(p1[6], p1[7])};
    w3 = (u32x4){pk2(p1[8], p1[9]), pk2(p1[10], p1[11]), pk2(p1[12], p1[13]), pk2(p1[14], p1[15])};
    pa[0] = __builtin_bit_cast(bf16x8, w0); pa[1] = __builtin_bit_cast(bf16x8, w1); pa[2] = __builtin_bit_cast(bf16x8, w2); pa[3] = __builtin_bit_cast(bf16x8, w3);
}

__device__ __forceinline__ void ml_local_pair(Frame& F, int pair, int l) {
    const int tid = F.tid, lane = F.lane, wid = F.wave, half = wid >> 2, wq = wid & 3, th = tid & 255, hi = lane >> 5;
    const int item = pair * 2 + half; const MlItem I = ml_decode(item);
    const bf16_t* U = WSP(bf16_t, WS_U);
    LAS unsigned char* base = F.lds + half * 49152;
    LAS unsigned char* EKI = base;
    LAS unsigned char* VI = base + 16384;
    LAS float* LF = (LAS float*)(base + 32768); LAS float* IG = LF + 128; LAS float* WW = LF + 256; LAS float* EST = LF + 384;
    const float* gb = INF(10) + l * 16;
    unsigned short graw_i = 0, graw_f = 0;
    if (th < 128) { const int r = I.dir ? 127 - th : th; const size_t t = (size_t)(I.t0 + r);
        graw_i = U[t * DINP + U_MLG + (I.dir ? 2 : 0) * 4 + I.h]; graw_f = U[t * DINP + U_MLG + (I.dir ? 3 : 1) * 4 + I.h]; }
    u32x4 kpc[4], vpc[4];
#pragma unroll
    for (int i = 0; i < 4; ++i) { const int p = th + 256 * i; const int tt = p >> 9, dh = (p >> 8) & 1, row = (p >> 2) & 63, c4 = p & 3, r = 64 * tt + row;
        const bf16_t* src = U + (size_t)(I.t0 + r) * DINP + I.h * 64 + dh * 32 + c4 * 8;
        kpc[i] = *(const GAS u32x4*)(src + U_MLK); vpc[i] = *(const GAS u32x4*)(src + U_MLV); }
    float a = 0.f, aend = 0.f, mloc = -3.0e38f;
    const float lfv = (th < 128) ? logsigmoid(bf2f(graw_f) + gb[(I.dir ? 3 : 1) * 4 + I.h]) : 0.f, igv = (th < 128) ? bf2f(graw_i) + gb[(I.dir ? 2 : 0) * 4 + I.h] : 0.f;
    if (th < 128) { a = wave_scan_add(lfv, lane); if (lane == 63) LF[wq] = a; }
    __syncthreads();
    float wv = 0.f;
    if (th < 128) { aend = LF[0] + LF[1]; if (wq == 1) a += LF[0]; wv = aend - a + igv; const float wm = wave_max(wv); if (lane == 0) IG[wq] = wm; }
    __syncthreads();
    if (th < 128) { mloc = fmaxf(IG[0], IG[1]); const int r = I.dir ? 127 - th : th; EST[r] = fexp(wv - mloc) * 0.125f; }
    __syncthreads();
#pragma unroll
    for (int i = 0; i < 4; ++i) { const int p = th + 256 * i; const int tt = p >> 9, dh = (p >> 8) & 1, row = (p >> 2) & 63, c4 = p & 3, r = 64 * tt + row;
        const u32x4 kq = kpc[i];
        const float es = EST[r];
        u32x4 ek; ek.x = pk2(bflo(kq.x) * es, bfhi(kq.x) * es); ek.y = pk2(bflo(kq.y) * es, bfhi(kq.y) * es); ek.z = pk2(bflo(kq.z) * es, bfhi(kq.z) * es); ek.w = pk2(bflo(kq.w) * es, bfhi(kq.w) * es);
        const int off = tt * 8192 + dh * 4096 + row * 64 + c4 * 16;
        *(LAS u32x4*)(EKI + off) = ek; *(LAS u32x4*)(VI + off) = vpc[i]; }
    __syncthreads();
    {
        const int da = wq >> 1, eb = wq & 1;
        f32x16 acc;
#pragma unroll
        for (int r = 0; r < 16; ++r) acc[r] = 0.f;
        const int lo_off = ((lane >> 4) & 1) * 32 + (lane & 3) * 8 + (4 * hi + ((lane & 15) >> 2)) * 64;
#pragma unroll
        for (int tt = 0; tt < 2; ++tt)
#pragma unroll
            for (int ks = 0; ks < 4; ++ks) {
                LAS const unsigned char* ap = EKI + tt * 8192 + da * 4096 + lo_off + ks * 1024; LAS const unsigned char* bp = VI + tt * 8192 + eb * 4096 + lo_off + ks * 1024;
                const s16x4 a0 = vtr(ap), a1 = vtr(ap + 512), b0 = vtr(bp), b1 = vtr(bp + 512);
                const bf16x8 af = (bf16x8){a0[0], a0[1], a0[2], a0[3], a1[0], a1[1], a1[2], a1[3]}, bf = (bf16x8){b0[0], b0[1], b0[2], b0[3], b1[0], b1[1], b1[2], b1[3]};
                acc = MFMA32(af, bf, acc); }
        float* dst = WSP(float, WS_MLC) + (size_t)item * 4096 + eb * 32 + (lane & 31);
#pragma unroll
        for (int r = 0; r < 16; ++r) dst[(da * 32 + crow(r, hi)) * 64] = acc[r];
        if (th < 64) { const int dh = th >> 5, col = th & 31; float sacc = 0.f;
            for (int tt = 0; tt < 2; ++tt) for (int row = 0; row < 64; ++row) sacc += bf2f(*(const LAS unsigned short*)(EKI + tt * 8192 + dh * 4096 + row * 64 + col * 2));
            WSP(float, WS_MLN)[item * 64 + th] = sacc; }
        if (th == 0) { WSP(float, WS_MLS)[item * 4] = mloc; WSP(float, WS_MLS)[item * 4 + 1] = aend; }
    }
    __syncthreads();
}

__device__ __forceinline__ void ml_out_pair(Frame& F, int pair, int l) {
    const int tid = F.tid, lane = F.lane, wid = F.wave, half = wid >> 2, wq = wid & 3, th = tid & 255, r32 = lane & 31, hi = lane >> 5;
    const int item = pair * 2 + half; const MlItem I = ml_decode(item);
    const bf16_t* U = WSP(bf16_t, WS_U);
    LAS unsigned char* base = F.lds + half * 49152;
    LAS unsigned char* KI = base;
    LAS unsigned char* VI = base + 16384;
    LAS unsigned char* CT = base + 32768;
    LAS float* vec = (LAS float*)(base + 32768 + 9216);
    LAS float* LF = vec; LAS float* IG = vec + 128; LAS float* BL = vec + 256; LAS float* SA = vec + 384; LAS float* SCI = vec + 512; LAS float* EDEN = vec + 640;
    LAS float* NPV = vec + 768; LAS float* wsf = vec + 832 + wq * 64;
    const float* gb = INF(10) + l * 16;
    unsigned short graw_i = 0, graw_f = 0; float mprev = 0.f;
    if (th < 128) { const int r = I.dir ? 127 - th : th; const size_t t = (size_t)(I.t0 + r);
        graw_i = U[t * DINP + U_MLG + (I.dir ? 2 : 0) * 4 + I.h]; graw_f = U[t * DINP + U_MLG + (I.dir ? 3 : 1) * 4 + I.h];
        mprev = WSP(float, WS_MLS)[item * 4 + 2]; }
    u32x4 kpc[4], vpc[4];
#pragma unroll
    for (int i = 0; i < 4; ++i) { const int p = th + 256 * i;
        { const int tt = p >> 9, c = (p >> 6) & 7, kv = p & 63, j = 64 * tt + kv, r = I.dir ? 127 - j : j;
          kpc[i] = *(const GAS u32x4*)(U + (size_t)(I.t0 + r) * DINP + U_MLK + I.h * 64 + c * 8); }
        { const int tt = p >> 9, dh = (p >> 8) & 1, kv = (p >> 2) & 63, c4 = p & 3, j = 64 * tt + kv, r = I.dir ? 127 - j : j;
          vpc[i] = *(const GAS u32x4*)(U + (size_t)(I.t0 + r) * DINP + U_MLV + I.h * 64 + dh * 32 + c4 * 8); } }
    float cpv[16];
    { const float* cp = WSP(float, WS_MLC) + (size_t)item * 4096;
#pragma unroll
      for (int i = 0; i < 16; ++i) cpv[i] = cp[th + 256 * i]; }
    const float npv = (th < 64) ? WSP(float, WS_MLN)[item * 64 + th] : 0.f;
    const int q = 32 * wq + r32;
    const int rq = I.dir ? 127 - q : q;
    bf16x8 qr[4];
    { const bf16_t* qp = U + (size_t)(I.t0 + rq) * DINP + U_MLQ + I.h * 64 + hi * 8;
#pragma unroll
      for (int d0 = 0; d0 < 4; ++d0) qr[d0] = *(const GAS bf16x8*)(qp + d0 * 16); }
    const float lfv = (th < 128) ? logsigmoid(bf2f(graw_f) + gb[(I.dir ? 3 : 1) * 4 + I.h]) : 0.f, igv = (th < 128) ? bf2f(graw_i) + gb[(I.dir ? 2 : 0) * 4 + I.h] : 0.f;
    float a = 0.f;
    if (th < 128) { a = wave_scan_add(lfv, lane); if (lane == 63) LF[wq] = a; }
#pragma unroll
    for (int i = 0; i < 4; ++i) { const int p = th + 256 * i;
        { const int tt = p >> 9, c = (p >> 6) & 7, kv = p & 63; *(LAS u32x4*)(KI + tt * 8192 + c * 1024 + kv * 16) = kpc[i]; }
        { const int tt = p >> 9, dh = (p >> 8) & 1, kv = (p >> 2) & 63, c4 = p & 3; *(LAS u32x4*)(VI + tt * 8192 + dh * 4096 + kv * 64 + c4 * 16) = vpc[i]; } }
#pragma unroll
    for (int i = 0; i < 16; ++i) { const int idx = th + 256 * i, d = idx >> 6, e = idx & 63;
        *(LAS unsigned short*)(CT + e * 144 + d * 2) = (unsigned short)(pk2(cpv[i], 0.f) & 0xffffu); }
    if (th < 64) NPV[th] = npv;
    __syncthreads();
    float bv = 0.f, bm = -3.0e38f;
    if (th < 128) { if (wq == 1) a += LF[0]; bv = igv - a; bm = wave_scan_max(bv, lane); if (lane == 63) IG[wq] = bm; }
    __syncthreads();
    if (th < 128) { if (wq == 1) bm = fmaxf(bm, IG[0]);
        const float mt = a + fmaxf(mprev, bm);
        SA[th] = (a - mt) * LOG2E; SCI[th] = fexp(a + mprev - mt); EDEN[th] = fexp(-mt); BL[th] = bv * LOG2E; }
    __syncthreads();
    {
        f32x16 o[2];
#pragma unroll
        for (int r = 0; r < 16; ++r) { o[0][r] = 0.f; o[1][r] = 0.f; }
        const float saq = SA[q], scq = SCI[q];
        float den = 0.f;
        for (int tt = 0; tt < 2; ++tt) {
            if (64 * tt > 32 * wq + 31) break;
            f32x16 p0, p1;
            qkt_tile<4>(p0, p1, KI + tt * 8192, qr, r32, hi);
#pragma unroll
            for (int g = 0; g < 4; ++g) {
                const f32x4 b0 = *(const LAS f32x4*)(BL + 64 * tt + 8 * g + 4 * hi), b1 = *(const LAS f32x4*)(BL + 64 * tt + 32 + 8 * g + 4 * hi);
#pragma unroll
                for (int i = 0; i < 4; ++i) { const int r = 4 * g + i; const int kv0 = 64 * tt + 8 * g + 4 * hi + i, kv1 = kv0 + 32;
                    const float e0 = (kv0 <= q) ? __builtin_amdgcn_exp2f(saq + b0[i]) * 0.125f : 0.f, e1 = (kv1 <= q) ? __builtin_amdgcn_exp2f(saq + b1[i]) * 0.125f : 0.f;
                    p0[r] *= e0; p1[r] *= e1; den += p0[r] + p1[r]; }
            }
            bf16x8 pa[4]; pack_p(p0, p1, pa);
            pv_tile(o, VI + tt * 8192, pa, lane);
        }
        float dot = 0.f;
#pragma unroll
        for (int ks = 0; ks < 4; ++ks) {
            const u32x4 qw = __builtin_bit_cast(u32x4, qr[ks]);
            const f32x4 n0 = *(const LAS f32x4*)(NPV + 16 * ks + 8 * hi), n1 = *(const LAS f32x4*)(NPV + 16 * ks + 8 * hi + 4);
            const float q0 = bflo(qw.x), q1 = bfhi(qw.x), q2 = bflo(qw.y), q3 = bfhi(qw.y), q4 = bflo(qw.z), q5 = bfhi(qw.z), q6 = bflo(qw.w), q7 = bfhi(qw.w);
            dot += q0 * n0[0] + q1 * n0[1] + q2 * n0[2] + q3 * n0[3] + q4 * n1[0] + q5 * n1[1] + q6 * n1[2] + q7 * n1[3];
            const u32x4 sw = (u32x4){pk2(q0 * scq, q1 * scq), pk2(q2 * scq, q3 * scq), pk2(q4 * scq, q5 * scq), pk2(q6 * scq, q7 * scq)};
            const bf16x8 qs = __builtin_bit_cast(bf16x8, sw);
#pragma unroll
            for (int de = 0; de < 2; ++de) {
                const bf16x8 cf = *(const LAS bf16x8*)(CT + (de * 32 + r32) * 144 + (16 * ks + 8 * hi) * 2);
                o[de] = MFMA32(qs, cf, o[de]);
            }
        }
        den += scq * dot;
        den += __shfl_xor(den, 32);
        const float rinv = 1.0f / fmaxf(fabsf(den), EDEN[q]);
        if (hi == 0) wsf[r32] = rinv;
        LDS_WAIT();
        float* dst = WSP(float, I.dir ? WS_HB : WS_HF);
#pragma unroll
        for (int r = 0; r < 16; ++r) { const int jq = 32 * wq + crow(r, hi), row = I.dir ? 127 - jq : jq; const float rr = wsf[crow(r, hi)];
            float* dp = dst + (size_t)(I.t0 + row) * 256 + I.h * 64 + r32;
            dp[0] = o[0][r] * rr; dp[32] = o[1][r] * rr; }
    }
    __syncthreads();
}

__device__ __forceinline__ double rope_kd_dyn(int i) {
    double r = 0.15915494309189535;
    r = (i == 1) ? 0.08949940160889101 : r; r = (i == 2) ? 0.050329212104487035 : r; r = (i == 3) ? 0.0283021958306234 : r; r = (i == 4) ? 0.015915494309189534 : r;
    r = (i == 5) ? 0.008949940160889102 : r; r = (i == 6) ? 0.005032921210448704 : r; r = (i == 7) ? 0.00283021958306234 : r; r = (i == 8) ? 0.0015915494309189536 : r;
    r = (i == 9) ? 0.0008949940160889102 : r; r = (i == 10) ? 0.0005032921210448703 : r; r = (i == 11) ? 0.00028302195830623395 : r; r = (i == 12) ? 0.00015915494309189535 : r;
    r = (i == 13) ? 8.949940160889102e-05 : r; r = (i == 14) ? 5.0329212104487035e-05 : r; r = (i == 15) ? 2.8302195830623396e-05 : r;
    return r;
}
__device__ __forceinline__ void mla_prep_rows(Frame& F, int l) {
    const int gw = F.vcu * NWAVES + F.wave, NGW = F.G * NWAVES, lane = F.lane;
    const bf16_t* U = WSP(bf16_t, WS_U); bf16_t* A = WSP(bf16_t, WS_AMLA);
    f32x4 gq = {0.f, 0.f, 0.f, 0.f}; if (lane < 56) gq = *(const GAS f32x4*)(INF(11) + l * 224 + 4 * lane);
    const f32x2 gk = *(const GAS f32x2*)(INF(12) + l * 128 + 2 * lane);
    for (int m0 = gw; m0 < MTOK; m0 += 4 * NGW) {
        u32x2 qw[4]; unsigned kw[4];
#pragma unroll
        for (int r = 0; r < 4; ++r) { const int m = m0 + r * NGW; const bf16_t* ur = U + (size_t)(m < MTOK ? m : 0) * DINP;
            qw[r] = (u32x2){0u, 0u}; if (lane < 56) qw[r] = *(const GAS u32x2*)(ur + U_CQ + 4 * lane);
            kw[r] = *(const GAS unsigned*)(ur + U_CKV + 2 * lane); }
#pragma unroll
        for (int r = 0; r < 4; ++r) { const int m = m0 + r * NGW; if (m >= MTOK) break;
            const float q0 = bflo(qw[r].x), q1 = bfhi(qw[r].x), q2 = bflo(qw[r].y), q3 = bfhi(qw[r].y), k0 = bflo(kw[r]), k1 = bfhi(kw[r]);
            const float rq = __builtin_amdgcn_rsqf(wave_sum(q0 * q0 + q1 * q1 + q2 * q2 + q3 * q3) * (1.0f / 224.0f) + EPS);
            const float rk = __builtin_amdgcn_rsqf(wave_sum(k0 * k0 + k1 * k1) * (1.0f / 128.0f) + EPS);
            bf16_t* ar = A + (size_t)m * 384;
            u32x2 qo; qo.x = pk2(q0 * rq * gq.x, q1 * rq * gq.y); qo.y = pk2(q2 * rq * gq.z, q3 * rq * gq.w);
            *(GAS u32x2*)(ar + 4 * lane) = qo;
            *(GAS unsigned*)(ar + 256 + 2 * lane) = pk2(k0 * rk * gk.x, k1 * rk * gk.y); }
    }
    const int* pos = (const int*)F.a->in[2];
    for (int m0 = gw; m0 < MTOK; m0 += 4 * NGW) {
        unsigned short x1r[4], x2r[4]; int pv[4];
#pragma unroll
        for (int r = 0; r < 4; ++r) { const int m = (m0 + r * NGW < MTOK) ? m0 + r * NGW : m0; x1r[r] = 0; x2r[r] = 0; pv[r] = 0;
            if (lane < 16) { x1r[r] = U[(size_t)m * DINP + U_KR + lane]; x2r[r] = U[(size_t)m * DINP + U_KR + 16 + lane]; pv[r] = pos[m]; } }
#pragma unroll
        for (int r = 0; r < 4; ++r) { const int m = m0 + r * NGW; if (m >= MTOK) break;
            if (lane < 16) { const int b = m >> 13, sq = m & 8191;
                double rev = (double)pv[r] * rope_kd_dyn(lane); rev -= __builtin_floor(rev);
                const float rr = (float)rev, c = cos_rev(rr), sn = sin_rev(rr), x1 = bf2f(x1r[r]), x2 = bf2f(x2r[r]);
                const unsigned short o1 = (unsigned short)(pk2(x1 * c - x2 * sn, 0.f) & 0xffffu), o2 = (unsigned short)(pk2(x2 * c + x1 * sn, 0.f) & 0xffffu);
#pragma unroll
                for (int h = 0; h < 4; ++h) { bf16_t* kd = WSP(bf16_t, WS_KIMG) + ((size_t)(b * 4 + h) * 128 + (sq >> 6)) * 6144 + (sq & 63) * 8;
                    kd[(8 + (lane >> 3)) * 512 + (lane & 7)] = o1; kd[(10 + (lane >> 3)) * 512 + (lane & 7)] = o2; } } }
    }
}

__device__ __forceinline__ double rope_k(int i) {
    switch (i) { case 0: return 0.15915494309189535; case 1: return 0.08949940160889101; case 2: return 0.050329212104487035; case 3: return 0.0283021958306234;
        case 4: return 0.015915494309189534; case 5: return 0.008949940160889102; case 6: return 0.005032921210448704; case 7: return 0.00283021958306234;
        case 8: return 0.0015915494309189536; case 9: return 0.0008949940160889102; case 10: return 0.0005032921210448703; case 11: return 0.00028302195830623395;
        case 12: return 0.00015915494309189535; case 13: return 8.949940160889102e-05; case 14: return 5.0329212104487035e-05; default: return 2.8302195830623396e-05; }
}
__device__ __forceinline__ void rope_cs(int pos, int i, float& c, float& s) {
    double rev = (double)pos * rope_k(i);
    rev -= __builtin_floor(rev);
    const float r = (float)rev;
    c = cos_rev(r); s = sin_rev(r);
}
__device__ __forceinline__ void relayout_phase(Frame& F) {
    const bf16_t* O = WSP(bf16_t, WS_OMLA); const bf16_t* U = WSP(bf16_t, WS_U);
    const int* pos = (const int*)F.a->in[2];
    const float qscale = 0.10206207261596577f * LOG2E;
    for (int idx = blockIdx.x * NTHR + F.tid; idx < MTOK * 4; idx += F.G * NTHR) {
        const int t = idx >> 2, h = idx & 3, b = t >> 13, s = t & 8191, bh = b * 4 + h;
        const int p = pos[t];
        float cs[16], sn[16];
#pragma unroll
        for (int i = 0; i < 16; ++i) rope_cs(p, i, cs[i], sn[i]);
        const bf16_t* qsrc = O + (size_t)t * 1024 + h * 96;
        bf16_t* qdst = WSP(bf16_t, WS_Q) + ((size_t)bh * SEQ + s) * 96;
#pragma unroll
        for (int c = 0; c < 8; ++c) { const u32x4 w = *(const GAS u32x4*)(qsrc + c * 8);
            u32x4 o; o.x = pk2(bflo(w.x) * qscale, bfhi(w.x) * qscale); o.y = pk2(bflo(w.y) * qscale, bfhi(w.y) * qscale); o.z = pk2(bflo(w.z) * qscale, bfhi(w.z) * qscale); o.w = pk2(bflo(w.w) * qscale, bfhi(w.w) * qscale);
            *(GAS u32x4*)(qdst + c * 8) = o; }
        {
            float x1[16], x2[16];
#pragma unroll
            for (int c = 0; c < 2; ++c) { const u32x4 w = *(const GAS u32x4*)(qsrc + 64 + c * 8); const u32x4 v = *(const GAS u32x4*)(qsrc + 80 + c * 8);
                x1[c * 8 + 0] = bflo(w.x); x1[c * 8 + 1] = bfhi(w.x); x1[c * 8 + 2] = bflo(w.y); x1[c * 8 + 3] = bfhi(w.y); x1[c * 8 + 4] = bflo(w.z); x1[c * 8 + 5] = bfhi(w.z); x1[c * 8 + 6] = bflo(w.w); x1[c * 8 + 7] = bfhi(w.w);
                x2[c * 8 + 0] = bflo(v.x); x2[c * 8 + 1] = bfhi(v.x); x2[c * 8 + 2] = bflo(v.y); x2[c * 8 + 3] = bfhi(v.y); x2[c * 8 + 4] = bflo(v.z); x2[c * 8 + 5] = bfhi(v.z); x2[c * 8 + 6] = bflo(v.w); x2[c * 8 + 7] = bfhi(v.w); }
#pragma unroll
            for (int c = 0; c < 2; ++c) { u32x4 o1, o2;
#define RQ1(i) ((x1[i] * cs[i] - x2[i] * sn[i]) * qscale)
#define RQ2(i) ((x2[i] * cs[i] + x1[i] * sn[i]) * qscale)
                o1.x = pk2(RQ1(c * 8 + 0), RQ1(c * 8 + 1)); o1.y = pk2(RQ1(c * 8 + 2), RQ1(c * 8 + 3)); o1.z = pk2(RQ1(c * 8 + 4), RQ1(c * 8 + 5)); o1.w = pk2(RQ1(c * 8 + 6), RQ1(c * 8 + 7));
                o2.x = pk2(RQ2(c * 8 + 0), RQ2(c * 8 + 1)); o2.y = pk2(RQ2(c * 8 + 2), RQ2(c * 8 + 3)); o2.z = pk2(RQ2(c * 8 + 4), RQ2(c * 8 + 5)); o2.w = pk2(RQ2(c * 8 + 6), RQ2(c * 8 + 7));
                *(GAS u32x4*)(qdst + 64 + c * 8) = o1; *(GAS u32x4*)(qdst + 80 + c * 8) = o2; }
#undef RQ1
#undef RQ2
        }
        bf16_t* kdst = WSP(bf16_t, WS_KIMG) + ((size_t)bh * 128 + (s >> 6)) * 6144 + (s & 63) * 8;
        const bf16_t* ksrc = O + (size_t)t * 1024 + 384 + h * 64;
#pragma unroll
        for (int c = 0; c < 8; ++c) *(GAS u32x4*)(kdst + c * 512) = *(const GAS u32x4*)(ksrc + c * 8);
        {
            const bf16_t* krs = U + (size_t)t * DINP + U_KR;
            float x1[16], x2[16];
#pragma unroll
            for (int c = 0; c < 2; ++c) { const u32x4 w = *(const GAS u32x4*)(krs + c * 8); const u32x4 v = *(const GAS u32x4*)(krs + 16 + c * 8);
                x1[c * 8 + 0] = bflo(w.x); x1[c * 8 + 1] = bfhi(w.x); x1[c * 8 + 2] = bflo(w.y); x1[c * 8 + 3] = bfhi(w.y); x1[c * 8 + 4] = bflo(w.z); x1[c * 8 + 5] = bfhi(w.z); x1[c * 8 + 6] = bflo(w.w); x1[c * 8 + 7] = bfhi(w.w);
                x2[c * 8 + 0] = bflo(v.x); x2[c * 8 + 1] = bfhi(v.x); x2[c * 8 + 2] = bflo(v.y); x2[c * 8 + 3] = bfhi(v.y); x2[c * 8 + 4] = bflo(v.z); x2[c * 8 + 5] = bfhi(v.z); x2[c * 8 + 6] = bflo(v.w); x2[c * 8 + 7] = bfhi(v.w); }
#pragma unroll
            for (int c = 0; c < 2; ++c) { u32x4 o1, o2;
#define RK1(i) (x1[i] * cs[i] - x2[i] * sn[i])
#define RK2(i) (x2[i] * cs[i] + x1[i] * sn[i])
                o1.x = pk2(RK1(c * 8 + 0), RK1(c * 8 + 1)); o1.y = pk2(RK1(c * 8 + 2), RK1(c * 8 + 3)); o1.z = pk2(RK1(c * 8 + 4), RK1(c * 8 + 5)); o1.w = pk2(RK1(c * 8 + 6), RK1(c * 8 + 7));
                o2.x = pk2(RK2(c * 8 + 0), RK2(c * 8 + 1)); o2.y = pk2(RK2(c * 8 + 2), RK2(c * 8 + 3)); o2.z = pk2(RK2(c * 8 + 4), RK2(c * 8 + 5)); o2.w = pk2(RK2(c * 8 + 6), RK2(c * 8 + 7));
                *(GAS u32x4*)(kdst + (8 + c) * 512) = o1; *(GAS u32x4*)(kdst + (10 + c) * 512) = o2; }
#undef RK1
#undef RK2
        }
        bf16_t* vdst = WSP(bf16_t, WS_VIMG) + ((size_t)bh * 128 + (s >> 6)) * 4096 + (s & 63) * 32;
        const bf16_t* vsrc = O + (size_t)t * 1024 + 640 + h * 64;
#pragma unroll
        for (int c = 0; c < 8; ++c) *(GAS u32x4*)(vdst + (c >> 2) * 2048 + (c & 3) * 8) = *(const GAS u32x4*)(vsrc + c * 8);
    }
}

__device__ __forceinline__ void attn_unit(Frame& F, int bh, int qb) {
    const int tid = F.tid, lane = F.lane, wid = F.wave, r32 = lane & 31, hi = lane >> 5;
    LAS unsigned char* KB = F.lds;
    LAS unsigned char* VB = F.lds + 24576;
    LAS float* wsf = (LAS float*)(F.lds + 40960) + wid * 64;
    const int b = bh >> 2, h = bh & 3;
    const bf16_t* Qp = WSP(bf16_t, WS_Q) + ((size_t)bh * SEQ + qb * 256 + wid * 32 + r32) * 96 + hi * 8;
    bf16x8 qr[6];
#pragma unroll
    for (int d0 = 0; d0 < 6; ++d0) qr[d0] = *(const GAS bf16x8*)(Qp + d0 * 16);
    const GAS u32x4* Kg = (const GAS u32x4*)(WSP(bf16_t, WS_KIMG) + (size_t)bh * 128 * 6144);
    const GAS u32x4* Vg = (const GAS u32x4*)(WSP(bf16_t, WS_VIMG) + (size_t)bh * 128 * 4096);
    const bool kx = tid < 256;
    u32x4 k0 = Kg[tid], k1 = kx ? Kg[512 + tid] : (u32x4){0u, 0u, 0u, 0u}, v0 = Vg[tid];
    u32x4 k2 = Kg[768 + tid], k3 = kx ? Kg[768 + 512 + tid] : (u32x4){0u, 0u, 0u, 0u};
    *(LAS u32x4*)(KB + tid * 16) = k0; if (kx) *(LAS u32x4*)(KB + (512 + tid) * 16) = k1; *(LAS u32x4*)(VB + tid * 16) = v0;
    *(LAS u32x4*)(KB + 12288 + tid * 16) = k2; if (kx) *(LAS u32x4*)(KB + 12288 + (512 + tid) * 16) = k3;
    __syncthreads();
    f32x16 s0, s1;
    qkt_tile<6>(s0, s1, KB, qr, r32, hi);
    __syncthreads();
    f32x16 o[2]; float lsum = 0.f;
#pragma unroll
    for (int r = 0; r < 16; ++r) { o[0][r] = 0.f; o[1][r] = 0.f; }
    float m;
    { float rm = fmaxf(fmaxf(s0[0], s1[0]), fmaxf(s0[1], s1[1]));
#pragma unroll
      for (int r = 2; r < 16; r += 2) rm = fmaxf(fmaxf(rm, s0[r]), fmaxf(s1[r], fmaxf(s0[r + 1], s1[r + 1])));
      m = fmaxf(rm, __shfl_xor(rm, 32));
#pragma unroll
      for (int r = 0; r < 16; ++r) { s0[r] -= m; s1[r] -= m; } }
    LAS const unsigned char* vbl = VB + ((lane >> 4) & 1) * 32 + (lane & 3) * 8 + (4 * hi + ((lane & 15) >> 2)) * 64;
    u32x4 kb0 = Kg[2 * 768 + tid], kb1 = kx ? Kg[2 * 768 + 512 + tid] : (u32x4){0u, 0u, 0u, 0u}, vb0 = Vg[512 + tid];
#define ATT_ITER(T, LK0, LK1, LV, WK0, WK1, WV) do { \
        const int t = (T); const int cur = t & 1; \
        const int tv = (t + 2 < 128) ? t + 2 : 127, tk = (t + 3 < 128) ? t + 3 : 127; \
        LK0 = Kg[tk * 768 + tid]; if (kx) LK1 = Kg[tk * 768 + 512 + tid]; \
        LV = Vg[tv * 512 + tid]; \
        LAS const unsigned char* Kt = KB + (cur ^ 1) * 12288 + hi * 1024 + r32 * 16; \
        bf16x8 kf[12]; \
        _Pragma("unroll") for (int d0 = 0; d0 < 6; ++d0) { kf[2 * d0] = *(const LAS bf16x8*)(Kt + d0 * 2048); kf[2 * d0 + 1] = *(const LAS bf16x8*)(Kt + d0 * 2048 + 512); } \
        _Pragma("unroll") for (int r = 0; r < 16; ++r) { s0[r] = __builtin_amdgcn_exp2f(s0[r]); s1[r] = __builtin_amdgcn_exp2f(s1[r]); } \
        { float ls_ = 0.f; _Pragma("unroll") for (int r = 0; r < 16; ++r) ls_ += s0[r] + s1[r]; lsum += ls_; } \
        bf16x8 pa[4]; pack_p(s0, s1, pa); \
        f32x16 n0, n1; { const float nm_ = -m; _Pragma("unroll") for (int r = 0; r < 16; ++r) { n0[r] = nm_; n1[r] = nm_; } } \
        n0 = MFMA32(kf[0], qr[0], n0); n1 = MFMA32(kf[1], qr[0], n1); \
        _Pragma("unroll") for (int d0 = 1; d0 < 6; ++d0) { n0 = MFMA32(kf[2 * d0], qr[d0], n0); n1 = MFMA32(kf[2 * d0 + 1], qr[d0], n1); } \
        LAS const unsigned char* vb = vbl + cur * 8192; \
        _Pragma("unroll") for (int ks = 0; ks < 4; ++ks) { \
            _Pragma("unroll") for (int d0 = 0; d0 < 2; ++d0) { \
                const s16x4 lo = vtr(vb + d0 * 4096 + ks * 1024), hh = vtr(vb + d0 * 4096 + ks * 1024 + 512); \
                const bf16x8 vf = (bf16x8){lo[0], lo[1], lo[2], lo[3], hh[0], hh[1], hh[2], hh[3]}; \
                o[d0] = MFMA32(pa[ks], vf, o[d0]); } } \
        float rm = fmaxf(fmaxf(n0[0], n1[0]), fmaxf(n0[1], n1[1])); \
        _Pragma("unroll") for (int r = 2; r < 16; r += 2) rm = fmaxf(fmaxf(rm, n0[r]), fmaxf(n1[r], fmaxf(n0[r + 1], n1[r + 1]))); \
        rm = fmaxf(rm, __shfl_xor(rm, 32)); \
        _Pragma("unroll") for (int i = 0; i < 12; ++i) { __builtin_amdgcn_sched_group_barrier(0x008, 1, 0); __builtin_amdgcn_sched_group_barrier(0x002, 7, 0); } \
        if (__any(rm > 8.0f)) { \
            const float dl = fmaxf(rm, 0.f), f = __builtin_amdgcn_exp2f(-dl); \
            m += dl; lsum *= f; \
            _Pragma("unroll") for (int r = 0; r < 16; ++r) { n0[r] -= dl; n1[r] -= dl; } \
            if (hi == 0) wsf[r32] = f; \
            LDS_WAIT(); \
            _Pragma("unroll") for (int r = 0; r < 16; ++r) { const float fr = wsf[crow(r, hi)]; o[0][r] *= fr; o[1][r] *= fr; } \
        } \
        *(LAS u32x4*)(KB + cur * 12288 + tid * 16) = WK0; if (kx) *(LAS u32x4*)(KB + cur * 12288 + (512 + tid) * 16) = WK1; \
        *(LAS u32x4*)(VB + (cur ^ 1) * 8192 + tid * 16) = WV; \
        __syncthreads(); \
        s0 = n0; s1 = n1; } while (0)
#pragma unroll 1
    for (int t2 = 0; t2 < 128; t2 += 2) {
        ATT_ITER(t2, k0, k1, v0, kb0, kb1, vb0);
        ATT_ITER(t2 + 1, kb0, kb1, vb0, k0, k1, v0);
    }
#undef ATT_ITER
    lsum += __shfl_xor(lsum, 32);
    if (hi == 0) wsf[r32] = 1.0f / lsum;
    LDS_WAIT();
    bf16_t* Y = WSP(bf16_t, WS_YATT);
#pragma unroll
    for (int r = 0; r < 16; ++r) { const float rl = wsf[crow(r, hi)]; const int q = qb * 256 + wid * 32 + crow(r, hi);
        bf16_t* yp = Y + ((size_t)b * SEQ + q) * 256 + h * 64 + r32;
        yp[0] = (bf16_t)(pk2(o[0][r] * rl, 0.f) & 0xffffu); yp[32] = (bf16_t)(pk2(o[1][r] * rl, 0.f) & 0xffffu); }
    __syncthreads();
}

#define PX(e) ((e) + ((e) >> 5))
__device__ __forceinline__ f32x2 cmul(f32x2 a, float c, float s) { return (f32x2){a.x * c - a.y * s, a.x * s + a.y * c}; }
__device__ __forceinline__ void bf4_fwd(f32x2& x0, f32x2& x1, f32x2& x2, f32x2& x3, float c1, float s1) {
    const float c2 = c1 * c1 - s1 * s1, s2 = 2.0f * c1 * s1, c3 = c2 * c1 - s2 * s1, s3 = c2 * s1 + s2 * c1;
    const f32x2 a = x0 + x2, b = x0 - x2, c = x1 + x3, d = x1 - x3;
    x0 = a + c;
    x1 = cmul((f32x2){b.x + d.y, b.y - d.x}, c1, s1);
    x2 = cmul(a - c, c2, s2);
    x3 = cmul((f32x2){b.x - d.y, b.y + d.x}, c3, s3);
}
__device__ __forceinline__ void bf4_inv(f32x2& x0, f32x2& x1, f32x2& x2, f32x2& x3, float c1, float s1) {
    const float c2 = c1 * c1 - s1 * s1, s2 = 2.0f * c1 * s1, c3 = c2 * c1 - s2 * s1, s3 = c2 * s1 + s2 * c1;
    const f32x2 t1 = cmul(x1, c1, s1), t2 = cmul(x2, c2, s2), t3 = cmul(x3, c3, s3);
    const f32x2 a = x0 + t2, b = x0 - t2, c = t1 + t3, d = t1 - t3;
    x0 = a + c; x2 = a - c;
    x1 = (f32x2){b.x - d.y, b.y + d.x};
    x3 = (f32x2){b.x + d.y, b.y - d.x};
}
template <bool INV>
__device__ __forceinline__ void fft_r4_last(LAS f32x2* X, int tid) {
#pragma unroll 2
    for (int i = 0; i < 8; ++i) { int base = 4 * (tid + 512 * i); asm volatile("" : "+v"(base));
        f32x2 x0 = X[PX(base)], x1 = X[PX(base + 1)], x2 = X[PX(base + 2)], x3 = X[PX(base + 3)];
        if (!INV) bf4_fwd(x0, x1, x2, x3, 1.0f, 0.0f); else bf4_inv(x0, x1, x2, x3, 1.0f, 0.0f);
        X[PX(base)] = x0; X[PX(base + 1)] = x1; X[PX(base + 2)] = x2; X[PX(base + 3)] = x3; }
    __syncthreads();
}
template <bool INV>
__device__ __forceinline__ void r16_core(f32x2 (&x)[16], int j, int lq, float r16, float r4) {
    const float angB = (float)j * r4;
    if (!INV) {
#pragma unroll
        for (int r = 0; r < 4; ++r) { const float ang = (float)(j + (r << lq)) * r16; bf4_fwd(x[r], x[r + 4], x[r + 8], x[r + 12], cos_rev(ang), -sin_rev(ang)); }
        const float cb = cos_rev(angB), sb = -sin_rev(angB);
#pragma unroll
        for (int k = 0; k < 4; ++k) bf4_fwd(x[4 * k], x[4 * k + 1], x[4 * k + 2], x[4 * k + 3], cb, sb);
    } else {
        const float cb = cos_rev(angB), sb = sin_rev(angB);
#pragma unroll
        for (int k = 0; k < 4; ++k) bf4_inv(x[4 * k], x[4 * k + 1], x[4 * k + 2], x[4 * k + 3], cb, sb);
#pragma unroll
        for (int r = 0; r < 4; ++r) { const float ang = (float)(j + (r << lq)) * r16; bf4_inv(x[r], x[r + 4], x[r + 8], x[r + 12], cos_rev(ang), sin_rev(ang)); }
    }
}
template <bool INV>
__device__ __forceinline__ void fft_r16_pass(LAS f32x2* X, int tid, int lq) {
    const int qp = 1 << lq;
    const float r16 = 1.0f / (float)(16 * qp), r4 = 1.0f / (float)(4 * qp);
    int u0 = tid; asm volatile("" : "+v"(u0)); int u1 = tid + 512; asm volatile("" : "+v"(u1));
    const int j0 = u0 & (qp - 1), b0 = ((u0 >> lq) << (lq + 4)) + j0, j1 = u1 & (qp - 1), b1 = ((u1 >> lq) << (lq + 4)) + j1;
    f32x2 xa[16], xb[16];
#pragma unroll
    for (int r = 0; r < 16; ++r) xa[r] = X[PX(b0 + (r << lq))];
#pragma unroll
    for (int r = 0; r < 16; ++r) xb[r] = X[PX(b1 + (r << lq))];
    r16_core<INV>(xa, j0, lq, r16, r4);
#pragma unroll
    for (int r = 0; r < 16; ++r) X[PX(b0 + (r << lq))] = xa[r];
    r16_core<INV>(xb, j1, lq, r16, r4);
#pragma unroll
    for (int r = 0; r < 16; ++r) X[PX(b1 + (r << lq))] = xb[r];
    __syncthreads();
}
template <bool INV>
__device__ __forceinline__ void fft16k(LAS f32x2* X, int tid) {
    if (!INV) { fft_r16_pass<false>(X, tid, 10); fft_r16_pass<false>(X, tid, 6); fft_r16_pass<false>(X, tid, 2); fft_r4_last<false>(X, tid); }
    else { fft_r4_last<true>(X, tid); fft_r16_pass<true>(X, tid, 2); fft_r16_pass<true>(X, tid, 6); fft_r16_pass<true>(X, tid, 10); }
}
__device__ __forceinline__ int drev4(int x) { unsigned y = __builtin_bitreverse32((unsigned)x) >> 18; return (int)(((y & 0x2AAAu) >> 1) | ((y & 0x1555u) << 1)); }
__device__ __forceinline__ float block_sum(Frame& F, float v, LAS float* red) {
    v = wave_sum(v);
    if (F.lane == 0) red[F.wave] = v;
    __syncthreads();
    float s = 0.f;
#pragma unroll
    for (int w = 0; w < NWAVES; ++w) s += red[w];
    __syncthreads();
    return s;
}
__device__ __forceinline__ void hyena_item(Frame& F, int c_in, int l) {
    int c = c_in; asm volatile("" : "+s"(c));
    const int tid = F.tid;
    LAS f32x2* X = (LAS f32x2*)F.lds;
    LAS float* red = (LAS float*)(F.lds + XTRA_OFF);
    f32x2* KF = WSP(f32x2, WS_KF) + (size_t)c * 2 * 16384;
    {
        const float* F0f = WSP(float, WS_FILT) + ((size_t)l * 1024 + c) * SEQ; const float* F0b = F0f + (size_t)256 * SEQ;
        const float* F1f = F0f + (size_t)512 * SEQ; const float* F1b = F0f + (size_t)768 * SEQ;
        float s0 = 0.f, s1 = 0.f;
#pragma unroll 1
        for (int i0 = 0; i0 < 16; i0 += 8) { float a0[8], b0[8], a1[8], b1[8];
#pragma unroll
            for (int i = 0; i < 8; ++i) { int t = tid + 512 * (i0 + i); asm volatile("" : "+v"(t)); a0[i] = F0f[t]; b0[i] = F0b[t]; a1[i] = F1f[t]; b1[i] = F1b[t]; }
#pragma unroll
            for (int i = 0; i < 8; ++i) { const int t = tid + 512 * (i0 + i); s0 += fabsf(a0[i]) + fabsf(b0[i]); s1 += fabsf(a1[i]) + fabsf(b1[i]);
                X[PX(t)] = (f32x2){a0[i], a1[i]}; X[PX(16383 - t)] = (f32x2){b0[i], b1[i]}; } }
        const float inv0 = 0.5f / block_sum(F, s0, red), inv1 = 0.5f / block_sum(F, s1, red);
        fft16k<false>(X, tid);
#pragma unroll 2
        for (int i = 0; i < 32; ++i) { int p = tid + 512 * i; asm volatile("" : "+v"(p)); const int f = drev4(p), pp = drev4((16384 - f) & 16383);
            const f32x2 w = X[PX(p)], wp = X[PX(pp)];
            KF[p] = (f32x2){(w.x + wp.x) * inv0, (w.y - wp.y) * inv0};
            KF[16384 + p] = (f32x2){(w.y + wp.y) * inv1, (wp.x - w.x) * inv1}; }
        __syncthreads();
    }
    const float* HT0 = WSP(float, WS_HYT);
    const float hb0 = INF(27)[l * 512 + c], hb1 = INF(27)[l * 512 + 256 + c];
    float zz[16][2];
    { const float* z0p = HT0 + (size_t)(0 * 768 + 512 + c) * SEQ; const float* z1p = HT0 + (size_t)(1 * 768 + 512 + c) * SEQ;
#pragma unroll
      for (int i = 0; i < 16; ++i) { zz[i][0] = z0p[tid + 512 * i]; zz[i][1] = z1p[tid + 512 * i]; }
#pragma unroll
      for (int i = 0; i < 16; ++i) { int t = tid + 512 * i; asm volatile("" : "+v"(t)); X[PX(t)] = (f32x2){zz[i][0], zz[i][1]}; X[PX(8192 + t)] = (f32x2){0.f, 0.f}; } }
    __syncthreads();
    const float invn = 1.0f / 16384.0f;
#pragma unroll 1
    for (int o = 0; o < 2; ++o) {
        fft16k<false>(X, tid);
        { const f32x2* kp = KF + o * 16384;
#pragma unroll 1
          for (int i0 = 0; i0 < 32; i0 += 8) { f32x2 kv[8];
#pragma unroll
              for (int i = 0; i < 8; ++i) kv[i] = kp[tid + 512 * (i0 + i)];
#pragma unroll
              for (int i = 0; i < 8; ++i) { int p = tid + 512 * (i0 + i); asm volatile("" : "+v"(p)); const f32x2 v = X[PX(p)]; X[PX(p)] = (f32x2){v.x * kv[i].x - v.y * kv[i].y, v.x * kv[i].y + v.y * kv[i].x}; } } }
        __syncthreads();
        fft16k<true>(X, tid);
        float ga[16], gb[16];
        { const float* g0p = HT0 + (size_t)(0 * 768 + o * 256 + c) * SEQ; const float* g1p = HT0 + (size_t)(1 * 768 + o * 256 + c) * SEQ;
#pragma unroll
          for (int i = 0; i < 16; ++i) { ga[i] = g0p[tid + 512 * i]; gb[i] = g1p[tid + 512 * i]; } }
        const float hbo = o ? hb1 : hb0;
        if (o == 0) {
#pragma unroll
            for (int i = 0; i < 16; ++i) { int t = tid + 512 * i; asm volatile("" : "+v"(t)); const f32x2 y = X[PX(t)];
                zz[i][0] = ga[i] * (y.x * invn + zz[i][0] * hbo); zz[i][1] = gb[i] * (y.y * invn + zz[i][1] * hbo);
                X[PX(t)] = (f32x2){zz[i][0], zz[i][1]}; X[PX(8192 + t)] = (f32x2){0.f, 0.f}; }
            __syncthreads();
        } else {
            bf16_t* Y0 = WSP(bf16_t, WS_YHT) + (size_t)(0 * 256 + c) * SEQ; bf16_t* Y1 = WSP(bf16_t, WS_YHT) + (size_t)(1 * 256 + c) * SEQ;
#pragma unroll
            for (int i = 0; i < 16; ++i) { int t = tid + 512 * i; asm volatile("" : "+v"(t)); const f32x2 y = X[PX(t)];
                const float r0 = ga[i] * (y.x * invn + zz[i][0] * hbo), r1 = gb[i] * (y.y * invn + zz[i][1] * hbo);
                Y0[t] = (bf16_t)(pk2(r0, 0.f) & 0xffffu); Y1[t] = (bf16_t)(pk2(r1, 0.f) & 0xffffu); }
            __syncthreads();
        }
    }
}

__device__ __forceinline__ void hy_prep_tile(Frame& F, int tile, int l) {
    const int tid = F.tid, lane = F.lane, wave = F.wave;
    const int b = tile >> 7, t0 = (tile & 127) * 64;
    constexpr int RS = 1552;
    const bf16_t* U = WSP(bf16_t, WS_U);
    { u32x4 hv[13];
#pragma unroll
      for (int i = 0; i < 13; ++i) { const int idx = tid + 512 * i; const int row = idx / 96, pc = idx % 96; const int tok = t0 - 1 + row;
          hv[i] = (u32x4){0u, 0u, 0u, 0u};
          if (row < 66 && tok >= 0 && tok < SEQ) hv[i] = *(const GAS u32x4*)(U + ((size_t)b * SEQ + tok) * DINP + U_HY + pc * 8); }
#pragma unroll
      for (int i = 0; i < 13; ++i) { const int idx = tid + 512 * i; const int row = idx / 96, pc = idx % 96;
          if (row < 66) *(LAS u32x4*)(F.lds + row * RS + pc * 16) = hv[i]; } }
    __syncthreads();
    const float* cw = INF(16) + (size_t)l * 768 * 3; const float* cb = INF(17) + l * 768;
    float* HT = WSP(float, WS_HYT);
#pragma unroll 2
    for (int cp = wave; cp < 384; cp += 8) { const int ch = 2 * cp;
        const float w00 = cw[ch * 3], w01 = cw[ch * 3 + 1], w02 = cw[ch * 3 + 2], w10 = cw[ch * 3 + 3], w11 = cw[ch * 3 + 4], w12 = cw[ch * 3 + 5], b0 = cb[ch], b1 = cb[ch + 1];
        const unsigned r0 = *(const LAS unsigned*)(F.lds + lane * RS + cp * 4), r1 = *(const LAS unsigned*)(F.lds + (lane + 1) * RS + cp * 4), r2 = *(const LAS unsigned*)(F.lds + (lane + 2) * RS + cp * 4);
        HT[((size_t)(b * 768 + ch)) * SEQ + t0 + lane] = w00 * bflo(r0) + w01 * bflo(r1) + w02 * bflo(r2) + b0;
        HT[((size_t)(b * 768 + ch + 1)) * SEQ + t0 + lane] = w10 * bfhi(r0) + w11 * bfhi(r1) + w12 * bfhi(r2) + b1; }
    __syncthreads();
}

__device__ __forceinline__ void headnorm_phase(Frame& F, int l) {
    const int lane = F.lane, tid = F.tid, wave = F.wave;
    const bf16_t* U = WSP(bf16_t, WS_U); const bf16_t* YA = WSP(bf16_t, WS_YATT); const bf16_t* YH = WSP(bf16_t, WS_YHT);
    constexpr int RS2 = 528;
    const int g = wave >> 1, sub = wave & 1, cg = 4 * lane, ch = g * 256 + cg;
    const f32x4 og = *(const GAS f32x4*)(INF(29) + l * 1024 + ch);
    float scw[12];
#pragma unroll
    for (int j = 0; j < 12; ++j) scw[j] = INF(28)[(size_t)l * 768 + cg * 3 + j];
    for (int tile = F.vcu; tile < 256; tile += F.G) {
      const int tb = tile >> 7, t0 = (tile & 127) * 64;
#pragma unroll
      for (int i = 0; i < 4; ++i) { const int idx = tid + 512 * i, c = idx >> 3, p8 = idx & 7;
          const u32x4 v = *(const GAS u32x4*)(YH + ((size_t)(tb * 256 + c)) * SEQ + t0 + p8 * 8);
          LAS unsigned char* hp = F.lds + (8 * p8) * RS2 + 2 * c;
          *(LAS unsigned short*)(hp + 0 * RS2) = (unsigned short)(v.x & 0xffffu); *(LAS unsigned short*)(hp + 1 * RS2) = (unsigned short)(v.x >> 16);
          *(LAS unsigned short*)(hp + 2 * RS2) = (unsigned short)(v.y & 0xffffu); *(LAS unsigned short*)(hp + 3 * RS2) = (unsigned short)(v.y >> 16);
          *(LAS unsigned short*)(hp + 4 * RS2) = (unsigned short)(v.z & 0xffffu); *(LAS unsigned short*)(hp + 5 * RS2) = (unsigned short)(v.z >> 16);
          *(LAS unsigned short*)(hp + 6 * RS2) = (unsigned short)(v.w & 0xffffu); *(LAS unsigned short*)(hp + 7 * RS2) = (unsigned short)(v.w >> 16); }
      __syncthreads();
#pragma unroll 4
      for (int rr = 0; rr < 32; ++rr) {
        const int trow = sub * 32 + rr; const int m = tb * SEQ + t0 + trow;
        float y0, y1, y2, y3;
        if (g == 0) {
            const u32x2 ow = *(const GAS u32x2*)(U + (size_t)m * DINP + U_MLO + cg);
            const f32x4 hs = *(const GAS f32x4*)(WSP(float, WS_HF) + (size_t)m * 256 + cg) + *(const GAS f32x4*)(WSP(float, WS_HB) + (size_t)m * 256 + cg);
            y0 = hs.x / (1.0f + fexp(-bflo(ow.x))); y1 = hs.y / (1.0f + fexp(-bfhi(ow.x))); y2 = hs.z / (1.0f + fexp(-bflo(ow.y))); y3 = hs.w / (1.0f + fexp(-bfhi(ow.y)));
        } else if (g == 1) {
            const u32x2 w = *(const GAS u32x2*)(YA + (size_t)m * 256 + cg);
            y0 = bflo(w.x); y1 = bfhi(w.x); y2 = bflo(w.y); y3 = bfhi(w.y);
        } else if (g == 2) {
            const u32x2 w = *(const LAS u32x2*)(F.lds + trow * RS2 + cg * 2);
            y0 = bflo(w.x); y1 = bfhi(w.x); y2 = bflo(w.y); y3 = bfhi(w.y);
        } else {
            const int s = t0 + trow;
            const bf16_t* up = U + (size_t)m * DINP + U_SC + cg;
            const u32x2 bw = *(const GAS u32x2*)up;
            u32x2 c0 = {0u, 0u}, x0 = {0u, 0u}, c2 = {0u, 0u}, x2 = {0u, 0u};
            if (s > 0) { c0 = *(const GAS u32x2*)(up - DINP + 256); x0 = *(const GAS u32x2*)(up - DINP + 512); }
            const u32x2 c1 = *(const GAS u32x2*)(up + 256), x1 = *(const GAS u32x2*)(up + 512);
            if (s < SEQ - 1) { c2 = *(const GAS u32x2*)(up + DINP + 256); x2 = *(const GAS u32x2*)(up + DINP + 512); }
            y0 = bflo(bw.x) * (scw[0] * bflo(c0.x) * bflo(x0.x) + scw[1] * bflo(c1.x) * bflo(x1.x) + scw[2] * bflo(c2.x) * bflo(x2.x));
            y1 = bfhi(bw.x) * (scw[3] * bfhi(c0.x) * bfhi(x0.x) + scw[4] * bfhi(c1.x) * bfhi(x1.x) + scw[5] * bfhi(c2.x) * bfhi(x2.x));
            y2 = bflo(bw.y) * (scw[6] * bflo(c0.y) * bflo(x0.y) + scw[7] * bflo(c1.y) * bflo(x1.y) + scw[8] * bflo(c2.y) * bflo(x2.y));
            y3 = bfhi(bw.y) * (scw[9] * bfhi(c0.y) * bfhi(x0.y) + scw[10] * bfhi(c1.y) * bfhi(x1.y) + scw[11] * bfhi(c2.y) * bfhi(x2.y));
        }
        float ss = (y0 * y0 + y1 * y1) + (y2 * y2 + y3 * y3);
        ss += __shfl_xor(ss, 1); ss += __shfl_xor(ss, 2); ss += __shfl_xor(ss, 4); ss += __shfl_xor(ss, 8);
        const float rstd = __builtin_amdgcn_rsqf(ss * (1.0f / 64.0f) + EPS);
        u32x2 w; w.x = pk2(y0 * rstd * og.x, y1 * rstd * og.y); w.y = pk2(y2 * rstd * og.z, y3 * rstd * og.w);
        *(GAS u32x2*)(WSP(bf16_t, WS_YN) + (size_t)m * DM + ch) = w;
      }
      __syncthreads();
    }
}

__device__ __forceinline__ void post_mixer_phase(Frame& F, int l, const float* xin) {
    const int gw = F.vcu * NWAVES + F.wave, NGW = F.G * NWAVES, lane = F.lane, tid = F.tid;
    LAS float* RWT = (LAS float*)F.lds;
    { const GAS f32x4* src = (const GAS f32x4*)(INF(31) + (size_t)l * 1024 * 16);
      f32x4 wv[8];
#pragma unroll
      for (int q = 0; q < 8; ++q) wv[q] = src[tid + NTHR * q];
#pragma unroll
      for (int q = 0; q < 8; ++q) { const int i = tid + NTHR * q; const f32x4 w = wv[q]; const int k = i >> 2, e4 = (i & 3) * 4;
          RWT[(e4 + 0) * 1024 + k] = w.x; RWT[(e4 + 1) * 1024 + k] = w.y; RWT[(e4 + 2) * 1024 + k] = w.z; RWT[(e4 + 3) * 1024 + k] = w.w; } }
    __syncthreads();
    const float* mod = WSP(float, WS_MOD);
    for (int m0 = gw; m0 < MTOK; m0 += 2 * NGW) {
        u32x2 yw[2][4]; f32x4 xr[2][4];
#pragma unroll
        for (int r = 0; r < 2; ++r) { const int mm = (m0 + r * NGW < MTOK) ? m0 + r * NGW : m0;
            const GAS u32x2* yr = (const GAS u32x2*)(WSP(bf16_t, WS_Y2) + (size_t)mm * DM) + lane;
#pragma unroll
            for (int j = 0; j < 4; ++j) yw[r][j] = yr[64 * j];
            ld_row_f32(xin + (size_t)mm * DM, lane, xr[r]); }
#pragma unroll
        for (int r = 0; r < 2; ++r) { const int m = m0 + r * NGW; if (m >= MTOK) break;
        const int b = m >> 13, s = m & 8191; const float* md = mod + (l * 2 + b) * 6144;
        f32x4 y2[4], x[4], pg[4], g1[4];
#pragma unroll
        for (int j = 0; j < 4; ++j) { y2[j] = (f32x4){bflo(yw[r][j].x), bfhi(yw[r][j].x), bflo(yw[r][j].y), bfhi(yw[r][j].y)}; x[j] = xr[r][j]; }
        ld_row_f32(INF(6) + l * 1024, lane, pg); ld_row_f32(md + 2048, lane, g1);
        const float rstd = __builtin_amdgcn_rsqf(row_ss(y2) * (1.0f / DM) + EPS);
#pragma unroll
        for (int j = 0; j < 4; ++j) x[j] = x[j] + g1[j] * (y2[j] * rstd * pg[j]);
        st_row_f32(WSP(float, WS_X1) + (size_t)m * DM, lane, x);
        f32x4 h[4];
        modnorm(x, INF(7) + l * 1024, md + 4096, md + 3072, lane, h);
        st_row_bf16(WSP(bf16_t, WS_XN) + (size_t)m * DM, lane, h);
        float part[16];
#pragma unroll
        for (int e = 0; e < 16; ++e) part[e] = 0.f;
#pragma unroll
        for (int j = 0; j < 4; ++j) {
#pragma unroll
            for (int e = 0; e < 16; ++e) { const f32x4 w = *(const LAS f32x4*)(RWT + e * 1024 + 4 * lane + 256 * j);
                part[e] += (h[j].x * w.x + h[j].y * w.y) + (h[j].z * w.z + h[j].w * w.w); }
            asm volatile("" ::: "memory"); }
        float a8[8], a4[4], a2[2], lg;
        { const bool up = (lane & 32) != 0;
#pragma unroll
          for (int i = 0; i < 8; ++i) { const float keep = up ? part[8 + i] : part[i], send = up ? part[i] : part[8 + i]; a8[i] = keep + __shfl_xor(send, 32); } }
        { const bool up = (lane & 16) != 0;
#pragma unroll
          for (int i = 0; i < 4; ++i) { const float keep = up ? a8[4 + i] : a8[i], send = up ? a8[i] : a8[4 + i]; a4[i] = keep + __shfl_xor(send, 16); } }
        { const bool up = (lane & 8) != 0;
#pragma unroll
          for (int i = 0; i < 2; ++i) { const float keep = up ? a4[2 + i] : a4[i], send = up ? a4[i] : a4[2 + i]; a2[i] = keep + __shfl_xor(send, 8); } }
        { const bool up = (lane & 4) != 0; const float keep = up ? a2[1] : a2[0], send = up ? a2[0] : a2[1]; lg = keep + __shfl_xor(send, 4); }
        lg += __shfl_xor(lg, 2); lg += __shfl_xor(lg, 1);
        float mx = lg;
#pragma unroll
        for (int o = 4; o < 64; o <<= 1) mx = fmaxf(mx, __shfl_xor(mx, o));
        const float ex = fexp(lg - mx); float sm = ex;
#pragma unroll
        for (int o = 4; o < 64; o <<= 1) sm += __shfl_xor(sm, o);
        if ((lane & 3) == 0) WSP(float, WS_AFF)[((size_t)b * 16 + (lane >> 2)) * SEQ + s] = ex / sm;
        if (lane < 16) WSP(int, WS_SLOT)[(size_t)m * 16 + lane] = -1;
            }
    }
    __syncthreads();
}

__device__ __forceinline__ void topk_item(Frame& F, int it) {
    const int tid = F.tid, lane = F.lane, wave = F.wave;
    const int b = it >> 4, e = it & 15;
    LAS unsigned* wcnt = (LAS unsigned*)F.lds;
    LAS unsigned* wtot = wcnt + 16;
    unsigned key[16];
    { const GAS u32x4* src = (const GAS u32x4*)(WSP(float, WS_AFF) + (size_t)it * SEQ) + tid * 4;
#pragma unroll
      for (int q = 0; q < 4; ++q) { const u32x4 v = src[q]; key[4 * q] = v.x; key[4 * q + 1] = v.y; key[4 * q + 2] = v.z; key[4 * q + 3] = v.w; } }
    unsigned T = 0u;
#pragma unroll 1
    for (int bit = 30; bit >= 0; --bit) {
        const unsigned cand = T | (1u << bit);
        unsigned c = 0u;
#pragma unroll
        for (int i = 0; i < 16; ++i) c += (key[i] >= cand) ? 1u : 0u;
#pragma unroll
        for (int o = 1; o < 64; o <<= 1) c += __shfl_xor(c, o);
        LAS unsigned* wc = wcnt + (bit & 1) * 8;
        if (lane == 0) wc[wave] = c;
        __syncthreads();
        unsigned tot = 0u;
#pragma unroll
        for (int w = 0; w < NWAVES; ++w) tot += wc[w];
        if (tot >= (unsigned)CAP) T = cand;
    }
    unsigned cg = 0u, ce = 0u;
#pragma unroll
    for (int i = 0; i < 16; ++i) { cg += (key[i] > T) ? 1u : 0u; ce += (key[i] == T) ? 1u : 0u; }
    unsigned v = cg | (ce << 16), inc = v;
#pragma unroll
    for (int o = 1; o < 64; o <<= 1) { const unsigned n = __shfl_up(inc, o); if (lane >= o) inc += n; }
    __syncthreads();
    if (lane == 63) wtot[wave] = inc;
    __syncthreads();
    unsigned off = 0u, all = 0u;
#pragma unroll
    for (int w = 0; w < NWAVES; ++w) { const unsigned tw = wtot[w]; all += tw; if (w < wave) off += tw; }
    const unsigned need = (unsigned)CAP - (all & 0xffffu);
    const unsigned excl = off + inc - v;
    unsigned ng = excl & 0xffffu, ne = excl >> 16;
    int* IDX = WSP(int, WS_IDX) + (e * 2 + b) * CAP; int* SLOT = WSP(int, WS_SLOT);
#pragma unroll
    for (int i = 0; i < 16; ++i) { const int idx = tid * 16 + i; const unsigned k = key[i];
        const bool gt = k > T, eq = k == T; const bool sel = gt || (eq && ne < need);
        if (sel) { const int slot = (int)(ng + (ne < need ? ne : need)); IDX[slot] = b * SEQ + idx; SLOT[((size_t)b * SEQ + idx) * 16 + e] = slot; }
        ng += gt ? 1u : 0u; ne += eq ? 1u : 0u; }
    __syncthreads();
}

__device__ __forceinline__ void gather_phase(Frame& F) {
    const int gw = F.vcu * NWAVES + F.wave, NGW = F.G * NWAVES, lane = F.lane;
    const int* IDX = WSP(int, WS_IDX);
    for (int r = gw; r < NEXP * 2 * CAP; r += NGW) {
        const int e = r >> 11, b = (r >> 10) & 1, j = r & 1023;
        const int tok = IDX[(b * 16 + e) * CAP + j];
        const GAS u32x4* src = (const GAS u32x4*)(WSP(bf16_t, WS_XN) + ((size_t)b * SEQ + tok) * DM);
        GAS u32x4* dst = (GAS u32x4*)(WSP(bf16_t, WS_XE) + (size_t)r * DM);
        dst[lane] = src[lane]; dst[64 + lane] = src[64 + lane];
    }
}

__device__ __forceinline__ void combine_phase(Frame& F, int l) {
    const int gw = F.vcu * NWAVES + F.wave, NGW = F.G * NWAVES, lane = F.lane;
    const float* mod = WSP(float, WS_MOD);
    const bf16_t* YE = WSP(bf16_t, WS_YE);
    f32x4 pg[4]; ld_row_f32(INF(8) + l * 1024, lane, pg);
    for (int m0 = gw; m0 < MTOK; m0 += 2 * NGW) {
        int sl[2]; float gv[2]; f32x4 x1[2][4];
#pragma unroll
        for (int r = 0; r < 2; ++r) { const int mm = (m0 + r * NGW < MTOK) ? m0 + r * NGW : m0; const int b = mm >> 13, s = mm & 8191;
            sl[r] = -1; gv[r] = 0.f;
            if (lane < 16) { sl[r] = WSP(int, WS_SLOT)[(size_t)mm * 16 + lane]; gv[r] = WSP(float, WS_AFF)[((size_t)b * 16 + lane) * SEQ + s]; }
            ld_row_f32(WSP(float, WS_X1) + (size_t)mm * DM, lane, x1[r]); }
#pragma unroll
        for (int r = 0; r < 2; ++r) { const int m = m0 + r * NGW; if (m >= MTOK) break;
            const int b = m >> 13; const float* md = mod + (l * 2 + b) * 6144;
            f32x4 acc[4];
#pragma unroll
            for (int j = 0; j < 4; ++j) acc[j] = (f32x4){0.f, 0.f, 0.f, 0.f};
            unsigned long long msk = __ballot(sl[r] >= 0) & 0xffffull;
            while (msk) {
                const int e0 = __builtin_ctzll(msk); msk &= msk - 1;
                int e1 = -1; if (msk) { e1 = __builtin_ctzll(msk); msk &= msk - 1; }
                const int s0 = __shfl(sl[r], e0); const float g0 = __shfl(gv[r], e0);
                const int s1 = __shfl(sl[r], e1 < 0 ? e0 : e1); const float g1 = (e1 < 0) ? 0.f : __shfl(gv[r], e1 < 0 ? e0 : e1);
                const GAS u32x2* r0 = (const GAS u32x2*)(YE + ((size_t)e0 * 2048 + b * CAP + s0) * DM) + lane;
                const GAS u32x2* r1 = (const GAS u32x2*)(YE + ((size_t)(e1 < 0 ? e0 : e1) * 2048 + b * CAP + s1) * DM) + lane;
                u32x2 w0[4], w1[4];
#pragma unroll
                for (int j = 0; j < 4; ++j) { w0[j] = r0[64 * j]; w1[j] = r1[64 * j]; }
#pragma unroll
                for (int j = 0; j < 4; ++j) { acc[j] += (f32x4){bflo(w0[j].x), bfhi(w0[j].x), bflo(w0[j].y), bfhi(w0[j].y)} * g0;
                                              acc[j] += (f32x4){bflo(w1[j].x), bfhi(w1[j].x), bflo(w1[j].y), bfhi(w1[j].y)} * g1; }
            }
            f32x4 g2[4]; ld_row_f32(md + 5120, lane, g2);
            const float rstd = __builtin_amdgcn_rsqf(row_ss(acc) * (1.0f / DM) + EPS);
            f32x4 xo[4];
#pragma unroll
            for (int j = 0; j < 4; ++j) xo[j] = x1[r][j] + g2[j] * (acc[j] * rstd * pg[j]);
            st_row_f32(F.a->out + (size_t)m * DM, lane, xo);
            if (l == 0) { f32x4 h[4]; const float* md1 = mod + (1 * 2 + b) * 6144;
                modnorm(xo, INF(5) + 1024, md1 + 1024, md1, lane, h);
                st_row_bf16(WSP(bf16_t, WS_XN) + (size_t)m * DM, lane, h); }
        }
    }
}

constexpr int PH_PER_LAYER = 11, N_PHASES = 2 + 2 * PH_PER_LAYER;
__global__ void __launch_bounds__(NTHR, 2) mega_fwd(Args args) {
    extern __shared__ __attribute__((aligned(16))) unsigned char lds_raw[];
    Frame F;
    F.lds = (LAS unsigned char*)lds_raw;
    F.tid = threadIdx.x; F.lane = F.tid & 63; F.wave = __builtin_amdgcn_readfirstlane(F.tid >> 6);
    F.G = gridDim.x; { const int bx = blockIdx.x; F.vcu = (F.G % 8 == 0) ? (bx % 8) * (F.G / 8) + bx / 8 : bx; }
    F.a = &args; F.ws = args.ws;
    volatile LAS unsigned* MISC = (volatile LAS unsigned*)(F.lds + MISC_OFF);
    for (int u = F.tid; u < (LDS_BYTES - LDSCTL_OFF) / 4; u += NTHR) ((LAS unsigned*)(F.lds + LDSCTL_OFF))[u] = 0u;
    __syncthreads();
    gu32* ctl = (gu32*)(F.ws + WS_CTL);
    XcdBarrier bar; bar.bar = (unsigned*)(ctl + CW_BAR); bar.x = 0; bar.st = nullptr;
#if !MK_SPLIT
    bar = xcd_barrier_post((unsigned*)(ctl + CW_BAR), MISC + 8);
#endif
    const int lo = args.ph_lo, hi = args.ph_hi;
    int ph = 0;
#if MK_SPLIT
#define SEAM() do { } while (0)
#else
#define SEAM() do { if (ph + 1 < hi) xcd_barrier(bar); } while (0)
#endif
#ifndef PHSEL
#define PHSEL -1
#endif
#ifndef PHMASK
#define PHMASK 0x7fff
#endif
#ifndef DBL_MASK
#define DBL_MASK 0
#endif
#define PHASE_BEGIN(id) if ((PHSEL < 0 || PHSEL == (id)) && ((PHMASK >> (id)) & 1) && lo <= ph && ph < hi) for (int rep_ = 0; rep_ < (((DBL_MASK >> (id)) & 1) ? 2 : 1); ++rep_) { if (rep_) xcd_barrier(bar); { int t_ = threadIdx.x; asm volatile("" : "+v"(t_)); F.tid = t_; F.lane = t_ & 63; F.wave = __builtin_amdgcn_readfirstlane(t_ >> 6); }
#define PHASE_END   SEAM(); } ++ph;

    PHASE_BEGIN(0) p0_phase(F); PHASE_END
    PHASE_BEGIN(1) p1_phase(F); PHASE_END
#pragma unroll 1
    for (int l = 0; l < 2; ++l) {
        const float* xin = (l == 0) ? (const float*)args.in[0] : (const float*)args.out;
        PHASE_BEGIN(2) {
            pg8::Gemm g{WSP(bf16_t, WS_XN), WSP(bf16_t, WS_WIN) + (size_t)l * DINP * 1024, MTOK, DINP, 1024}; pg8::StaticOrder S; S.init(MTOK, DINP, F.G, (int)blockIdx.x);
            pg8::EpiBf16 E{WSP(bf16_t, WS_U), DINP, DINP / 256};
            pg8::gemm_phase<pg8::EpiBf16, pg8::StaticOrder, true, true>(F.lds, g, S, E, F.tid);
        } PHASE_END
        PHASE_BEGIN(3) {
#ifndef SUBSEL
#define SUBSEL 0
#endif
#ifndef REP_A
#define REP_A 1
#define REP_B 1
#define REP_C 1
#define REP_D 1
#define REP_E 1
#endif
            for (int q_ = 0; q_ < REP_A; ++q_) for (int tl = F.vcu; tl < 256; tl += F.G) hy_prep_tile(F, tl, l);
            for (int q_ = 0; q_ < REP_B; ++q_) for (int p = F.vcu; p < 512; p += F.G) ml_local_pair(F, p, l);
            for (int q_ = 0; q_ < REP_C; ++q_) mla_prep_rows(F, l);
        } PHASE_END
        PHASE_BEGIN(4) {
            pg8::Gemm g{WSP(bf16_t, WS_AMLA), WSP(bf16_t, WS_WMLA) + (size_t)l * 1024 * 384, MTOK, 1024, 384}; pg8::StaticOrder S; S.init(MTOK, 1024, F.G, (int)blockIdx.x);
            EpiMla E{WSP(bf16_t, WS_Q), WSP(bf16_t, WS_KIMG), WSP(bf16_t, WS_VIMG), (const int*)F.a->in[2], 0.10206207261596577f * LOG2E};
            pg8::gemm_phase<EpiMla, pg8::StaticOrder, true, true>(F.lds, g, S, E, F.tid);
#define REFRESH_TID() do { int t_ = threadIdx.x; asm volatile("" : "+v"(t_)); F.tid = t_; F.lane = t_ & 63; F.wave = __builtin_amdgcn_readfirstlane(t_ >> 6); } while (0)
            REFRESH_TID();
            ml_scan(F);
            REFRESH_TID();
#ifndef HY_REP
#define HY_REP 1
#endif
            for (int rep2_ = 0; rep2_ < HY_REP; ++rep2_) for (int c = F.vcu; c < 256; c += F.G) hyena_item(F, c, l);
        } PHASE_END
        PHASE_BEGIN(5) {
            for (int q_ = 0; q_ < REP_D; ++q_) for (int u = F.vcu; u < 256; u += F.G) attn_unit(F, u >> 5, u & 31);
            for (int q_ = 0; q_ < REP_E; ++q_) for (int p = F.vcu; p < 512; p += F.G) ml_out_pair(F, p, l);
        } PHASE_END
        PHASE_BEGIN(6) headnorm_phase(F, l); PHASE_END
        PHASE_BEGIN(7) {
            pg8::Gemm g{WSP(bf16_t, WS_YN), WSP(bf16_t, WS_WOUT) + (size_t)l * 1024 * 1024, MTOK, 1024, 1024}; pg8::StaticOrder S; S.init(MTOK, 1024, F.G, (int)blockIdx.x);
            pg8::EpiBf16 E{WSP(bf16_t, WS_Y2), 1024, 4};
            pg8::gemm_phase<pg8::EpiBf16, pg8::StaticOrder, true, true>(F.lds, g, S, E, F.tid);
        } PHASE_END
        PHASE_BEGIN(8) post_mixer_phase(F, l, xin); PHASE_END
        PHASE_BEGIN(9) { for (int it = F.vcu; it < 32; it += F.G) topk_item(F, it); } PHASE_END
        PHASE_BEGIN(10) {
            pg8::Gemm g{WSP(bf16_t, WS_XN), WSP(bf16_t, WS_WGU) + (size_t)l * NEXP * 4096 * 1024, NEXP * 2048, NEXP * 4096, 1024, WSP(int, WS_IDX)}; pg8::GroupedOrder S; S.init(16, F.G, (int)blockIdx.x);
            pg8::EpiSwiGLU E{WSP(bf16_t, WS_ACT), EFF};
            pg8::gemm_phase<pg8::EpiSwiGLU, pg8::GroupedOrder, true, true, true>(F.lds, g, S, E, F.tid);
        } PHASE_END
        PHASE_BEGIN(11) {
            pg8::Gemm g{WSP(bf16_t, WS_ACT), WSP(bf16_t, WS_WDN) + (size_t)l * NEXP * 1024 * 2048, NEXP * 2048, NEXP * 1024, 2048}; pg8::GroupedOrder S; S.init(4, F.G, (int)blockIdx.x);
            pg8::EpiBf16 E{WSP(bf16_t, WS_YE), 1024, 4};
            pg8::gemm_phase<pg8::EpiBf16, pg8::GroupedOrder, true, true>(F.lds, g, S, E, F.tid);
        } PHASE_END
        PHASE_BEGIN(12) combine_phase(F, l); PHASE_END
    }
}

extern "C" void kernel_launch(void* const* d_in, const int* in_sizes, int n_in, void* d_out, int out_size, void* d_ws, size_t ws_size, hipStream_t stream) {
    static int grid = 0;
    if (grid == 0) {
        if (n_in != 35 || out_size != MTOK * DM || ws_size < WS_END) { fprintf(stderr, "kernel_launch: unexpected shapes: n_in %d out %d ws %zu (need %zu)\n", n_in, out_size, ws_size, (size_t)WS_END); grid = -1; return; }
        int dev = 0, cus = 0, per_cu = 0;
        if (hipGetDevice(&dev) != hipSuccess || hipDeviceGetAttribute(&cus, hipDeviceAttributeMultiprocessorCount, dev) != hipSuccess) { grid = -1; return; }
        if (hipFuncSetAttribute((const void*)mega_fwd, hipFuncAttributeMaxDynamicSharedMemorySize, LDS_BYTES) != hipSuccess) { fprintf(stderr, "kernel_launch: hipFuncSetAttribute failed\n"); grid = -1; return; }
        (void)hipOccupancyMaxActiveBlocksPerMultiprocessor(&per_cu, (const void*)mega_fwd, NTHR, LDS_BYTES);
        (void)hipGetLastError();
        grid = cus > 0 ? cus : 256;
        if (per_cu < 1) fprintf(stderr, "kernel_launch: occupancy query reports %d\n", per_cu);
    }
    if (grid < 0) return;
    (void)hipMemsetAsync((char*)d_ws + WS_CTL, 0, CTL_ZERO_BYTES, stream);
    Args a{};
    for (int i = 0; i < 35; ++i) a.in[i] = d_in[i];
    a.out = (float*)d_out; a.ws = (unsigned char*)d_ws;
#if MK_SPLIT
    for (int p = 0; p < N_PHASES; ++p) { a.ph_lo = p; a.ph_hi = p + 1; hipLaunchKernelGGL(mega_fwd, dim3(grid), dim3(NTHR), LDS_BYTES, stream, a); }
#else
    a.ph_lo = 0; a.ph_hi = N_PHASES;
    hipLaunchKernelGGL(mega_fwd, dim3(grid), dim3(NTHR), LDS_BYTES, stream, a);
#endif
}
```

```cpp
#include <hip/hip_runtime.h>
#include <cstdio>
#include <cstdint>

#ifndef MK_SPLIT
#define MK_SPLIT 0
#endif

#define GAS __attribute__((address_space(1)))
#define LAS __attribute__((address_space(3)))
typedef GAS unsigned gu32;
#define RLX_AGENT __ATOMIC_RELAXED, __HIP_MEMORY_SCOPE_AGENT
typedef unsigned short bf16_t;
typedef short bf16x8 __attribute__((ext_vector_type(8)));
typedef short s16x4 __attribute__((ext_vector_type(4)));
typedef float f32x4 __attribute__((ext_vector_type(4)));
typedef float f32x2 __attribute__((ext_vector_type(2)));
typedef float f32x16 __attribute__((ext_vector_type(16)));
typedef unsigned u32x4 __attribute__((ext_vector_type(4)));
typedef unsigned u32x2 __attribute__((ext_vector_type(2)));
typedef __bf16 bf16x2_t __attribute__((ext_vector_type(2)));

namespace pg8 {
#define PG8_LAS __attribute__((address_space(3)))
constexpr int BM = 256, BK = 64, HALF = 128, HTB = HALF * BK * 2, STAGE_BYTES = 8 * HTB, NXCD = 8, WGM = 8;
__host__ __device__ __forceinline__ int lds_byte(int r, int c) { const int st = (r >> 4) * 2 + (c >> 5), rr = r & 15, cc = c & 31, ob = rr * 64 + cc * 2; return st * 1024 + (ob ^ (((ob >> 9) & 1) << 5)); }
__host__ __device__ __forceinline__ void stage_rc(int b, int& R, int& C) { const int st = b / 1024, sb = b % 1024, swz = sb ^ (((sb >> 9) & 1) << 5); R = (st >> 1) * 16 + swz / 64; C = (st & 1) * 32 + (swz % 64) / 2; }
__host__ __device__ __forceinline__ int perm32(int rho) { const int n = rho >> 4, i = rho & 15; return 8 * (i >> 2) + 4 * n + (i & 3); }
struct Unit { int pm, pn; };
struct Gemm { const bf16_t* A; const bf16_t* Bt; int M, N, K; const int* rowidx; };
struct StaticOrder {
    int nM, nN, nwg, G, c;
    __host__ __device__ void init(int M, int N, int G_, int c_) { nM = M / BM; nN = N / BM; nwg = nM * nN; G = G_; c = c_; }
    __host__ __device__ bool next(int i, Unit& u) const {
        const long L = (long)i * G + c; if (L >= nwg) return false;
        int wgid = (int)L; { const int q = nwg / NXCD, r = nwg % NXCD, xcd = wgid % NXCD, off = wgid / NXCD; wgid = (xcd < r ? xcd * (q + 1) : r * (q + 1) + (xcd - r) * q) + off; }
        const int nig = WGM * nN, gid = wgid / nig, fm = gid * WGM, gsz = (nM - fm) < WGM ? (nM - fm) : WGM;
        u.pm = fm + ((wgid % nig) % gsz); u.pn = (wgid % nig) / gsz; return true;
    }
    __device__ __forceinline__ void a_ready(const Unit&) const {}
    __device__ __forceinline__ void done(const Unit&) const {}
};
struct GroupedOrder {
    int nNl, total, G, c;
    __host__ __device__ void init(int nNl_, int G_, int c_) { nNl = nNl_; total = 16 * 8 * nNl_; G = G_; c = c_; }
    __host__ __device__ bool next(int i, Unit& u) const {
        const long L = (long)i * G + c; if (L >= total) return false;
        if (G == 256 && (nNl == 16 || nNl == 4)) {
            const int x = c & 7, w = c >> 3;
            if (nNl == 16) { const int e = 2 * i + (w >> 4), q = w & 15; u.pm = e * 8 + 4 * (x & 1) + (q & 3); u.pn = e * 16 + 4 * (x >> 1) + (q >> 2); }
            else { const int e = 8 * i + x; u.pm = e * 8 + (w & 7); u.pn = e * 4 + (w >> 3); }
            return true;
        }
        const int per_e = 8 * nNl, e = (int)L / per_e, r = (int)L % per_e;
        u.pm = e * 8 + (r % 8); u.pn = e * nNl + (r / 8); return true;
    }
    __device__ __forceinline__ void a_ready(const Unit&) const {}
    __device__ __forceinline__ void done(const Unit&) const {}
};
__device__ __forceinline__ unsigned cvt_pk_bf16(float lo, float hi) { f32x2 v = {lo, hi}; bf16x2_t b = __builtin_convertvector(v, bf16x2_t); return __builtin_bit_cast(unsigned, b); }

struct EpiBf16 {
    static constexpr bool PERM = true, AFTER_DRAIN = false;
    bf16_t* O; int ldc; int ntn;
    __device__ __forceinline__ void operator()(const f32x4 (&acc)[2][2][4][2], const Unit& u, int wr, int wc, int fr, int fq) const {
        const int row0 = u.pm * BM + wr * 64 + fr; const int colt = (u.pn % ntn) * BM;
        const int col0 = colt + wc * 32 + 8 * fq;
#pragma unroll
        for (int ai = 0; ai < 2; ++ai)
#pragma unroll
            for (int m = 0; m < 4; ++m) { bf16_t* rowp = O + (size_t)(row0 + ai * HALF + m * 16) * ldc + col0;
#pragma unroll
                for (int bj = 0; bj < 2; ++bj) { const f32x4 v0 = acc[ai][bj][m][0], v1 = acc[ai][bj][m][1];
                    u32x4 w; w.x = cvt_pk_bf16(v0[0], v0[1]); w.y = cvt_pk_bf16(v0[2], v0[3]); w.z = cvt_pk_bf16(v1[0], v1[1]); w.w = cvt_pk_bf16(v1[2], v1[3]);
                    *(u32x4*)(rowp + bj * HALF) = w; } }
    }
};
struct EpiF32 {
    static constexpr bool PERM = false, AFTER_DRAIN = false;
    float* O; int ldc;
    __device__ __forceinline__ void operator()(const f32x4 (&acc)[2][2][4][2], const Unit& u, int wr, int wc, int fr, int fq) const {
        const int col0 = u.pn * BM + wc * 32 + 4 * fq;
#pragma unroll
        for (int ai = 0; ai < 2; ++ai)
#pragma unroll
            for (int m = 0; m < 4; ++m) { float* rowp = O + (size_t)(u.pm * BM + ai * HALF + wr * 64 + m * 16 + fr) * ldc + col0;
#pragma unroll
                for (int bj = 0; bj < 2; ++bj)
#pragma unroll
                    for (int n = 0; n < 2; ++n) *(f32x4*)(rowp + bj * HALF + n * 16) = acc[ai][bj][m][n]; }
    }
};
__device__ __forceinline__ float silu_f(float a) { return a * __builtin_amdgcn_rcpf(1.0f + __builtin_amdgcn_exp2f(-1.4426950408889634f * a)); }
struct EpiSwiGLU {
    static constexpr bool PERM = true, AFTER_DRAIN = false;
    bf16_t* O; int ldc;
    __device__ __forceinline__ void operator()(const f32x4 (&acc)[2][2][4][2], const Unit& u, int wr, int wc, int fr, int fq) const {
        const int row0 = u.pm * BM + wr * 64 + fr; const int col0 = (u.pn % 16) * HALF + wc * 32 + 8 * fq;
#pragma unroll
        for (int ai = 0; ai < 2; ++ai)
#pragma unroll
            for (int m = 0; m < 4; ++m) { bf16_t* rowp = O + (size_t)(row0 + ai * HALF + m * 16) * ldc + col0;
                const f32x4 g0 = acc[ai][0][m][0], g1 = acc[ai][0][m][1], u0 = acc[ai][1][m][0], u1 = acc[ai][1][m][1];
                u32x4 w;
                w.x = cvt_pk_bf16(silu_f(g0[0]) * u0[0], silu_f(g0[1]) * u0[1]); w.y = cvt_pk_bf16(silu_f(g0[2]) * u0[2], silu_f(g0[3]) * u0[3]);
                w.z = cvt_pk_bf16(silu_f(g1[0]) * u1[0], silu_f(g1[1]) * u1[1]); w.w = cvt_pk_bf16(silu_f(g1[2]) * u1[2], silu_f(g1[3]) * u1[3]);
                *(u32x4*)rowp = w; }
    }
};

template <class Epi, class Sched, bool ALIGN_EPI = false, bool SP2 = false, bool GATHER = false>
__device__ __forceinline__ void gemm_phase(PG8_LAS unsigned char* lds, const Gemm g, const Sched& S, const Epi& E, const int tid) {
    const int wid = __builtin_amdgcn_readfirstlane(tid >> 6), lane = tid & 63, wr = wid >> 2, wc = wid & 3, fr = lane & 15, fq = lane >> 4;
    int K_ = g.K; asm volatile("" : "+s"(K_));
    const int K = K_, nt = K / BK;
    unsigned voffA[2], voffB[2];
#pragma unroll
    for (int i = 0; i < 2; ++i) { int R, C; stage_rc(tid * 16 + i * 8192, R, C); const int Rb = Epi::PERM ? ((R & ~31) + perm32(R & 31)) : R;
        voffA[i] = (unsigned)(R * K + C) * 2u; voffB[i] = (unsigned)(Rb * K + C) * 2u; }
    const size_t kstep = (size_t)(BK * 2);
    const size_t hstep = (size_t)HALF * K * 2;
    const size_t tstep = 2 * hstep;
    const unsigned ldsw = (unsigned)wid * 1024u;
    const int aoff = lds_byte(wr * 64 + fr, fq * 8), boff = lds_byte(wc * 32 + fr, fq * 8);
#define PG8_SA(b, h) (((b) * 2 + (h)) * HTB)
#define PG8_SB(b, h) ((4 + (b) * 2 + (h)) * HTB)
#define PG8_STAGE(bufoff, gbase, voff) do { _Pragma("unroll") for (int _i = 0; _i < 2; ++_i) \
        __builtin_amdgcn_global_load_lds((const unsigned*)((const char*)(gbase) + (voff)[_i]), (PG8_LAS unsigned*)(lds + (bufoff) + ldsw + _i * 8192), 16, 0, 0); } while (0)
#define PG8_LDA(dst, b, h) do { _Pragma("unroll") for (int m = 0; m < 4; ++m) _Pragma("unroll") for (int k = 0; k < 2; ++k) dst[m][k] = *(const PG8_LAS bf16x8*)(lds + PG8_SA(b, h) + aoff + m * 2048 + k * 1024); } while (0)
#define PG8_LDB(dst, b, h) do { _Pragma("unroll") for (int n = 0; n < 2; ++n) _Pragma("unroll") for (int k = 0; k < 2; ++k) dst[n][k] = *(const PG8_LAS bf16x8*)(lds + PG8_SB(b, h) + boff + n * 2048 + k * 1024); } while (0)
#define PG8_MMA(ai, bj, At, Bt) do { __builtin_amdgcn_s_setprio(1); _Pragma("unroll") for (int m = 0; m < 4; ++m) _Pragma("unroll") for (int n = 0; n < 2; ++n) _Pragma("unroll") for (int k = 0; k < 2; ++k) \
        acc[ai][bj][m][n] = __builtin_amdgcn_mfma_f32_16x16x32_bf16(Bt[n][k], At[m][k], acc[ai][bj][m][n], 0, 0, 0); __builtin_amdgcn_s_setprio(0); } while (0)
#define PG8_WAIT_V(n) asm volatile("s_waitcnt vmcnt(" #n ")" ::: "memory")
#define PG8_WAIT_L(n) asm volatile("s_waitcnt lgkmcnt(" #n ")" ::: "memory")
#define PG8_BAR __builtin_amdgcn_s_barrier()
#define PG8_SCHED __builtin_amdgcn_sched_barrier(0)
    Unit cur, nxt; int ui = 0;
    if (!S.next(0, cur)) return;
    f32x4 acc[2][2][4][2];
#pragma unroll
    for (int a = 0; a < 2; ++a)
#pragma unroll
        for (int b = 0; b < 2; ++b)
#pragma unroll
            for (int m = 0; m < 4; ++m)
#pragma unroll
                for (int n = 0; n < 2; ++n) acc[a][b][m][n] = (f32x4){0.f, 0.f, 0.f, 0.f};
    bf16x8 At[4][2], B0[2][2], B1[2][2];
    const char* cA = GATHER ? (const char*)g.A : (const char*)g.A + (size_t)cur.pm * tstep; const char* cB = (const char*)g.Bt + (size_t)cur.pn * tstep;
    unsigned gc0[2] = {0u, 0u}, gc1[2] = {0u, 0u}, gn0[2] = {0u, 0u}, gn1[2] = {0u, 0u}; int gR[2] = {0, 0}; unsigned gC[2] = {0u, 0u};
    if constexpr (GATHER) {
#pragma unroll
        for (int i = 0; i < 2; ++i) { int R, C; stage_rc(tid * 16 + i * 8192, R, C); gR[i] = R; gC[i] = (unsigned)C * 2u;
            gc0[i] = (unsigned)g.rowidx[cur.pm * BM + R] * (unsigned)(K * 2) + gC[i]; gc1[i] = (unsigned)g.rowidx[cur.pm * BM + HALF + R] * (unsigned)(K * 2) + gC[i]; }
    }
#define PG8_STAGE_A(bufoff, base, half, o0, o1) do { if constexpr (GATHER) { if ((half) == 0) PG8_STAGE(bufoff, base, o0); else PG8_STAGE(bufoff, base, o1); } \
        else PG8_STAGE(bufoff, (base) + ((half) ? hstep : 0), voffA); } while (0)
    S.a_ready(cur);
    if constexpr (SP2) {
        PG8_STAGE(PG8_SB(0, 0), cB, voffB); PG8_STAGE(PG8_SB(0, 1), cB + hstep, voffB); PG8_STAGE_A(PG8_SA(0, 0), cA, 0, gc0, gc1); PG8_STAGE_A(PG8_SA(0, 1), cA, 1, gc0, gc1);
        if (wr == 1) PG8_BAR;
        PG8_WAIT_V(2); PG8_BAR;
        PG8_STAGE(PG8_SB(1, 0), cB + kstep, voffB); PG8_STAGE_A(PG8_SA(1, 0), cA + kstep, 0, gc0, gc1); PG8_STAGE(PG8_SB(1, 1), cB + hstep + kstep, voffB);
        PG8_WAIT_V(6); PG8_BAR;
    } else {
        PG8_STAGE(PG8_SB(0, 0), cB, voffB); PG8_STAGE(PG8_SA(0, 0), cA, voffA); PG8_STAGE(PG8_SB(0, 1), cB + hstep, voffB); PG8_STAGE(PG8_SA(0, 1), cA + hstep, voffA);
        if (wr == 1) PG8_BAR;
        PG8_WAIT_V(4); PG8_BAR;
        PG8_STAGE(PG8_SB(1, 0), cB + kstep, voffB); PG8_STAGE(PG8_SA(1, 0), cA + kstep, voffA); PG8_STAGE(PG8_SB(1, 1), cB + hstep + kstep, voffB);
        PG8_WAIT_V(6); PG8_BAR;
    }
    for (;;) {
        const bool has_next = S.next(ui + 1, nxt);
        const char* nA = GATHER ? cA : (has_next ? (const char*)g.A + (size_t)nxt.pm * tstep : cA); const char* nB = has_next ? (const char*)g.Bt + (size_t)nxt.pn * tstep : cB;
        if constexpr (GATHER) { const int npm = has_next ? nxt.pm : cur.pm;
#pragma unroll
            for (int i = 0; i < 2; ++i) { gn0[i] = (unsigned)g.rowidx[npm * BM + gR[i]] * (unsigned)(K * 2) + gC[i]; gn1[i] = (unsigned)g.rowidx[npm * BM + HALF + gR[i]] * (unsigned)(K * 2) + gC[i]; } }
        for (int t = 0; t < nt; t += 2) {
            const bool last = (t == nt - 2);
            const char* a1 = cA + (size_t)(t + 1) * kstep;
            const char* a2 = last ? nA : cA + (size_t)(t + 2) * kstep; const char* b2 = last ? nB : cB + (size_t)(t + 2) * kstep;
            const char* a3 = a2 + kstep; const char* b3 = b2 + kstep;
            if (last && has_next) S.a_ready(nxt);
            if constexpr (SP2) {
            unsigned gs0[2], gs1[2];
#pragma unroll
            for (int i = 0; i < 2; ++i) { gs0[i] = last ? gn0[i] : gc0[i]; gs1[i] = last ? gn1[i] : gc1[i]; }
            PG8_LDB(B0, 0, 0); PG8_LDB(B1, 0, 1); PG8_SCHED; PG8_LDA(At, 0, 0); PG8_STAGE_A(PG8_SA(1, 1), a1, 1, gc0, gc1);
            PG8_WAIT_V(8); PG8_WAIT_L(0); PG8_BAR; PG8_MMA(0, 0, At, B0); PG8_MMA(0, 1, At, B1); PG8_BAR; PG8_SCHED;
            PG8_LDA(At, 0, 1); PG8_STAGE(PG8_SB(0, 0), b2, voffB); PG8_STAGE(PG8_SB(0, 1), b2 + hstep, voffB); PG8_STAGE_A(PG8_SA(0, 0), a2, 0, gs0, gs1);
            PG8_WAIT_V(8); PG8_WAIT_L(0); PG8_BAR; PG8_MMA(1, 0, At, B0); PG8_MMA(1, 1, At, B1); PG8_BAR; PG8_SCHED;
            PG8_LDB(B0, 1, 0); PG8_LDB(B1, 1, 1); PG8_SCHED; PG8_LDA(At, 1, 0); PG8_STAGE_A(PG8_SA(0, 1), a2, 1, gs0, gs1);
            PG8_WAIT_V(8); PG8_WAIT_L(0); PG8_BAR; PG8_MMA(0, 0, At, B0); PG8_MMA(0, 1, At, B1); PG8_BAR; PG8_SCHED;
            PG8_LDA(At, 1, 1); PG8_STAGE(PG8_SB(1, 0), b3, voffB); PG8_STAGE(PG8_SB(1, 1), b3 + hstep, voffB); PG8_STAGE_A(PG8_SA(1, 0), a3, 0, gs0, gs1);
            PG8_WAIT_V(8); PG8_WAIT_L(0); PG8_BAR; PG8_MMA(1, 0, At, B0); PG8_MMA(1, 1, At, B1); PG8_BAR; PG8_SCHED;
            } else {
            PG8_LDB(B0, 0, 0); PG8_SCHED; PG8_LDA(At, 0, 0); PG8_STAGE(PG8_SA(1, 1), a1 + hstep, voffA);
            PG8_WAIT_L(8); PG8_BAR; PG8_WAIT_L(0); PG8_MMA(0, 0, At, B0); PG8_BAR; PG8_SCHED;
            PG8_LDB(B1, 0, 1); PG8_STAGE(PG8_SB(0, 0), b2, voffB);
            PG8_BAR; PG8_WAIT_L(0); PG8_MMA(0, 1, At, B1); PG8_BAR;
            PG8_LDA(At, 0, 1); PG8_STAGE(PG8_SA(0, 0), a2, voffA);
            PG8_BAR; PG8_WAIT_L(0); PG8_MMA(1, 0, At, B0); PG8_BAR; PG8_SCHED;
            PG8_STAGE(PG8_SB(0, 1), b2 + hstep, voffB);
            PG8_WAIT_V(6); PG8_BAR; PG8_MMA(1, 1, At, B1); PG8_BAR;
            PG8_LDB(B0, 1, 0); PG8_SCHED; PG8_LDA(At, 1, 0); PG8_STAGE(PG8_SA(0, 1), a2 + hstep, voffA);
            PG8_WAIT_L(8); PG8_BAR; PG8_WAIT_L(0); PG8_MMA(0, 0, At, B0); PG8_BAR; PG8_SCHED;
            PG8_LDB(B1, 1, 1); PG8_STAGE(PG8_SB(1, 0), b3, voffB);
            PG8_BAR; PG8_WAIT_L(0); PG8_MMA(0, 1, At, B1); PG8_BAR;
            PG8_LDA(At, 1, 1); PG8_STAGE(PG8_SA(1, 0), a3, voffA);
            PG8_BAR; PG8_WAIT_L(0); PG8_MMA(1, 0, At, B0); PG8_BAR; PG8_SCHED;
            PG8_STAGE(PG8_SB(1, 1), b3 + hstep, voffB);
            PG8_WAIT_V(6); PG8_BAR; PG8_MMA(1, 1, At, B1); PG8_BAR;
            }
        }
        if constexpr (ALIGN_EPI) { if (wr == 0) PG8_BAR; }
        if constexpr (!Epi::AFTER_DRAIN) { E(acc, cur, wr, wc, fr, fq); S.done(cur); }
        if (!has_next) break;
#pragma unroll
        for (int a = 0; a < 2; ++a)
#pragma unroll
            for (int b = 0; b < 2; ++b)
#pragma unroll
                for (int m = 0; m < 4; ++m)
#pragma unroll
                    for (int n = 0; n < 2; ++n) acc[a][b][m][n] = (f32x4){0.f, 0.f, 0.f, 0.f};
        cur = nxt; cA = nA; cB = nB; ++ui;
        if constexpr (GATHER) { gc0[0] = gn0[0]; gc0[1] = gn0[1]; gc1[0] = gn1[0]; gc1[1] = gn1[1]; }
        if constexpr (ALIGN_EPI) { if (wr == 1) PG8_BAR; }
    }
    PG8_WAIT_V(0);
    if constexpr (!ALIGN_EPI) { if (wr == 0) PG8_BAR; }
    PG8_BAR;
#undef PG8_SA
#undef PG8_SB
#undef PG8_STAGE
#undef PG8_STAGE_A
#undef PG8_LDA
#undef PG8_LDB
#undef PG8_MMA
#undef PG8_WAIT_V
#undef PG8_WAIT_L
#undef PG8_BAR
#undef PG8_SCHED
}
}

__device__ __forceinline__ double rope_kd(int i) {
    switch (i) { case 0: return 0.15915494309189535; case 1: return 0.08949940160889101; case 2: return 0.050329212104487035; case 3: return 0.0283021958306234;
        case 4: return 0.015915494309189534; case 5: return 0.008949940160889102; case 6: return 0.005032921210448704; case 7: return 0.00283021958306234;
        case 8: return 0.0015915494309189536; case 9: return 0.0008949940160889102; case 10: return 0.0005032921210448703; case 11: return 0.00028302195830623395;
        case 12: return 0.00015915494309189535; case 13: return 8.949940160889102e-05; case 14: return 5.0329212104487035e-05; default: return 2.8302195830623396e-05; }
}
__device__ __forceinline__ float rope_frac(int p, int i) {
    const double kd = rope_kd(i); const float kh = (float)kd, kl = (float)(kd - (double)kh), pf = (float)p;
    const float r1 = pf * kh, e1 = __builtin_fmaf(pf, kh, -r1) + pf * kl;
    float fr = (r1 - __builtin_floorf(r1)) + e1;
    return fr - __builtin_floorf(fr);
}
struct EpiMla {
    static constexpr bool PERM = true, AFTER_DRAIN = false;
    bf16_t* Q; bf16_t* KI; bf16_t* VI; const int* pos; float qscale;
    __device__ __forceinline__ void operator()(const f32x4 (&acc)[2][2][4][2], const pg8::Unit& u, int wr, int wc, int fr, int fq) const {
        const int tile = u.pn & 3;
#pragma unroll
        for (int ai = 0; ai < 2; ++ai)
#pragma unroll
            for (int m = 0; m < 4; ++m) {
                int t = u.pm * 256 + ai * 128 + wr * 64 + m * 16 + fr; asm volatile("" : "+v"(t)); const int b = t >> 13, sq = t & 8191;
                if (tile == 1) {
                    const int p = pos[t]; const float sgn = (fq < 2) ? -1.0f : 1.0f;
                    u32x4 w;
#pragma unroll
                    for (int n = 0; n < 2; ++n) { const f32x4 vv = acc[ai][0][m][n]; float o4[4];
#pragma unroll
                        for (int j = 0; j < 4; ++j) { const float own = vv[j], oth = __shfl_xor(own, 32);
                            const float rr = (fq & 1) ? rope_frac(p, 8 + 4 * n + j) : rope_frac(p, 4 * n + j), c = __builtin_amdgcn_cosf(rr), sn = __builtin_amdgcn_sinf(rr);
                            o4[j] = (own * c + sgn * oth * sn) * qscale; }
                        if (n == 0) { w.x = pg8::cvt_pk_bf16(o4[0], o4[1]); w.y = pg8::cvt_pk_bf16(o4[2], o4[3]); } else { w.z = pg8::cvt_pk_bf16(o4[0], o4[1]); w.w = pg8::cvt_pk_bf16(o4[2], o4[3]); }
                        asm volatile("" ::: "memory"); }
                    *(u32x4*)(Q + ((size_t)(b * 4 + wc) * 8192 + sq) * 96 + 64 + 8 * fq) = w;
                    asm volatile("" ::: "memory");
                } else {
#pragma unroll
                    for (int bj = 0; bj < 2; ++bj) { const f32x4 v0 = acc[ai][bj][m][0], v1 = acc[ai][bj][m][1];
                        const int h = 2 * bj + (wc >> 1), bh = b * 4 + h;
                        if (tile == 0) { u32x4 w; w.x = pg8::cvt_pk_bf16(v0[0] * qscale, v0[1] * qscale); w.y = pg8::cvt_pk_bf16(v0[2] * qscale, v0[3] * qscale); w.z = pg8::cvt_pk_bf16(v1[0] * qscale, v1[1] * qscale); w.w = pg8::cvt_pk_bf16(v1[2] * qscale, v1[3] * qscale);
                            *(u32x4*)(Q + ((size_t)bh * 8192 + sq) * 96 + 32 * (wc & 1) + 8 * fq) = w; }
                        else { u32x4 w; w.x = pg8::cvt_pk_bf16(v0[0], v0[1]); w.y = pg8::cvt_pk_bf16(v0[2], v0[3]); w.z = pg8::cvt_pk_bf16(v1[0], v1[1]); w.w = pg8::cvt_pk_bf16(v1[2], v1[3]);
                            if (tile == 2) *(u32x4*)(KI + ((size_t)bh * 128 + (sq >> 6)) * 6144 + (4 * (wc & 1) + fq) * 512 + (sq & 63) * 8) = w;
                            else *(u32x4*)(VI + ((size_t)bh * 128 + (sq >> 6)) * 4096 + (wc & 1) * 2048 + (sq & 63) * 32 + 8 * fq) = w; } }
                }
            }
    }
};

constexpr int NWAVES = 8, NTHR = 512;
constexpr int BATCH = 2, SEQ = 8192, DM = 1024, MTOK = BATCH * SEQ;
constexpr int DIN = 2960, DINP = 3072;
constexpr int NEXP = 16, CAP = 1024, EFF = 2048;
constexpr float EPS = 1e-6f;
constexpr int U_MLQ = 0, U_MLK = 256, U_MLV = 512, U_MLO = 768, U_MLG = 1024, U_CQ = 1040, U_CKV = 1264, U_KR = 1392, U_HY = 1424, U_SC = 2192;
constexpr float LOG2E = 1.4426950408889634f;

constexpr size_t MiB = 1u << 20;
constexpr size_t WS_CTL = 0, CTL_ZERO_BYTES = 1 * MiB;
constexpr size_t WS_MOD = 1 * MiB;
constexpr size_t WS_MLS = 1 * MiB + 128 * 1024;
constexpr size_t WS_MLN = 1 * MiB + 256 * 1024;
constexpr size_t WS_AFF = 2 * MiB;
constexpr size_t WS_SLOT = 3 * MiB;
constexpr size_t WS_IDX = 4 * MiB;
constexpr size_t WS_HID = 5 * MiB;
constexpr size_t WS_WMLA = 9 * MiB;
constexpr size_t WS_WOUT = 11 * MiB;
constexpr size_t WS_WIN = 15 * MiB;
constexpr size_t WS_WGU = 28 * MiB;
constexpr size_t WS_WDN = 284 * MiB;
constexpr size_t WS_XN = 412 * MiB;
constexpr size_t WS_AMLA = 444 * MiB;
constexpr size_t WS_Q = 456 * MiB;
constexpr size_t WS_KIMG = 468 * MiB;
constexpr size_t WS_VIMG = 480 * MiB;
constexpr size_t WS_MLC = 488 * MiB;
constexpr size_t WS_HF = 504 * MiB;
constexpr size_t WS_HB = 520 * MiB;
constexpr size_t WS_YATT = 536 * MiB;
constexpr size_t WS_YHT = 544 * MiB;
constexpr size_t WS_YN = 552 * MiB;
constexpr size_t WS_X1 = 584 * MiB;
constexpr size_t WS_U = 648 * MiB;
constexpr size_t WS_OMLA = 744 * MiB;
constexpr size_t WS_ACT = 648 * MiB;
constexpr size_t WS_KF = 776 * MiB;
constexpr size_t WS_Y2 = 776 * MiB;
constexpr size_t WS_XE = 776 * MiB;
constexpr size_t WS_YE = 840 * MiB;
constexpr size_t WS_HYT = 904 * MiB;
constexpr size_t WS_FILT = 956 * MiB;
constexpr size_t WS_END = 1020 * MiB;
constexpr int CW_BAR = 4096;

constexpr int RING_BYTES = 139264;
constexpr int LDSCTL_OFF = RING_BYTES, MISC_OFF = LDSCTL_OFF + 320;
constexpr int XTRA_OFF = RING_BYTES + 1024;
constexpr int LDS_BYTES = 147456;

__device__ __forceinline__ float bf2f(unsigned short u) { return __uint_as_float((unsigned)u << 16); }
__device__ __forceinline__ unsigned pk2(float lo, float hi) { f32x2 v = {lo, hi}; bf16x2_t b = __builtin_convertvector(v, bf16x2_t); return __builtin_bit_cast(unsigned, b); }
__device__ __forceinline__ float bflo(unsigned w) { return __uint_as_float(w << 16); }
__device__ __forceinline__ float bfhi(unsigned w) { return __uint_as_float(w & 0xffff0000u); }
__device__ __forceinline__ float wave_sum(float v) {
#pragma unroll
    for (int o = 1; o < 64; o <<= 1) v += __shfl_xor(v, o);
    return v;
}
__device__ __forceinline__ float fexp(float x) { return __builtin_amdgcn_exp2f(x * LOG2E); }
__device__ __forceinline__ float flog(float x) { return __builtin_amdgcn_logf(x) * 0.6931471805599453f; }
__device__ __forceinline__ float sin_rev(float r) { return __builtin_amdgcn_sinf(r); }
__device__ __forceinline__ float cos_rev(float r) { return __builtin_amdgcn_cosf(r); }
__device__ __forceinline__ float sin_rad(float x) { float r = x * 0.15915494309189535f; r = r - __builtin_rintf(r); return __builtin_amdgcn_sinf(r); }
__device__ __forceinline__ int crow(int r, int hi) { return (r & 3) + 8 * (r >> 2) + 4 * hi; }
#define LDS_WAIT() asm volatile("s_waitcnt lgkmcnt(0)" ::: "memory")
#define VM_WAIT() asm volatile("s_waitcnt vmcnt(0)" ::: "memory")

#define XB_TMO      128
#define XB_XCNT(j)  (256  + 64 * (j))
#define XB_XSUB(j)  (1280 + 64 * (j))
#define XB_XGEN(j)  (2304 + 64 * (j))
#define XB_TOP      3328
#define XB_TOPGEN   3392
#define XCD_BAR_WORDS 3456
#define XB_SPIN_CAP (1u << 18)
__device__ __forceinline__ unsigned xb_ld(unsigned* p)              { return __hip_atomic_load(p, __ATOMIC_RELAXED, __HIP_MEMORY_SCOPE_AGENT); }
__device__ __forceinline__ unsigned xb_add(unsigned* p, unsigned v) { return __hip_atomic_fetch_add(p, v, __ATOMIC_RELAXED, __HIP_MEMORY_SCOPE_AGENT); }
__device__ __forceinline__ unsigned xb_xcc_id() { return (unsigned)__builtin_amdgcn_s_getreg((3 << 11) | 20) & 0xFu; }
#define XB_SPIN(cond, bar) do { unsigned _sp = 0; while (cond) { __builtin_amdgcn_s_sleep(1); \
    if ((++_sp & 255u) == 0u) { if (xb_ld(&(bar)[XB_TMO])) break; if (_sp > XB_SPIN_CAP) { atomicAdd(&(bar)[XB_TMO], 1u); break; } } } } while (0)
struct XcdBarrier { unsigned* bar; unsigned x; volatile LAS unsigned* st; };
__device__ __forceinline__ XcdBarrier xcd_barrier_post(unsigned* bar, volatile LAS unsigned* st) {
    XcdBarrier b; b.bar = bar; b.x = xb_xcc_id(); b.st = st;
    if (threadIdx.x == 0) (void)xb_add(&bar[XB_XCNT(b.x)], 1u);
    return b;
}
__device__ __forceinline__ void xcd_barrier_complete(unsigned* bar, unsigned x, unsigned& nloc, unsigned& nx) {
    const unsigned G = gridDim.x * gridDim.y * gridDim.z;
    unsigned sum, cnt, mine, sp = 0u;
    for (;;) {
        sum = 0u; cnt = 0u; mine = 0u;
#pragma unroll
        for (unsigned j = 0; j < 16; ++j) { const unsigned c = xb_ld(&bar[XB_XCNT(j)]); sum += c; cnt += (c > 0u) ? 1u : 0u; mine = (j == x) ? c : mine; }
        if (sum == G) break;
        __builtin_amdgcn_s_sleep(1);
        if ((++sp & 255u) == 0u) { if (xb_ld(&bar[XB_TMO])) break; if (sp > XB_SPIN_CAP) { atomicAdd(&bar[XB_TMO], 1u); break; } }
    }
    nloc = mine > 0u ? mine : 1u; nx = cnt > 0u ? cnt : 1u;
}
__device__ __forceinline__ void xcd_barrier(const XcdBarrier& b) {
    asm volatile("s_waitcnt vmcnt(0)" ::: "memory");
    __syncthreads();
    if (threadIdx.x == 0) {
        unsigned* bar = b.bar;
        __builtin_amdgcn_s_waitcnt(0);
        unsigned nloc = b.st[0], nx = b.st[1];
        if (nloc == 0u) { xcd_barrier_complete(bar, b.x, nloc, nx); b.st[0] = nloc; b.st[1] = nx; }
        const unsigned old = xb_add(&bar[XB_XSUB(b.x)], 1u);
        const unsigned gen = old / nloc;
        if (old + 1u == (gen + 1u) * nloc) {
            __builtin_amdgcn_fence(__ATOMIC_RELEASE, "agent");
            asm volatile("s_waitcnt vmcnt(0)" ::: "memory");
            const unsigned og = xb_add(&bar[XB_TOP], 1u);
            const unsigned tg = og / nx;
            if (og + 1u == (tg + 1u) * nx) xb_add(&bar[XB_TOPGEN], 1u);
            else XB_SPIN(xb_ld(&bar[XB_TOPGEN]) == tg, bar);
            __builtin_amdgcn_fence(__ATOMIC_ACQUIRE, "agent");
            xb_add(&bar[XB_XGEN(b.x)], 1u);
            asm volatile("s_waitcnt vmcnt(0)" ::: "memory");
        } else {
            XB_SPIN(xb_ld(&bar[XB_XGEN(b.x)]) == gen, bar);
            __builtin_amdgcn_fence(__ATOMIC_ACQUIRE, "agent");
            asm volatile("s_waitcnt vmcnt(0)" ::: "memory");
        }
    }
    __syncthreads();
}

struct Args { const void* in[35]; float* out; unsigned char* ws; int ph_lo, ph_hi; };
struct Frame {
    LAS unsigned char* lds;
    int tid, lane, wave, vcu, G;
    const Args* a;
    unsigned char* ws;
};
#define INF(i) ((const float*)F.a->in[i])
#define WSP(T, off) ((T*)(F.ws + (off)))

__device__ __forceinline__ void tr_item(const float* W, int ldw, int Kvalid, int Nvalid, int k0, int n0, bf16_t* dst, int dpitch, int drow0, int dk0, LAS float* scr, int lane, int NW = 64) {
    f32x4 v[16];
    const int nn = n0 + 4 * (lane & 15);
#pragma unroll
    for (int i = 0; i < 16; ++i) { const int kk = 4 * i + (lane >> 4);
        v[i] = (f32x4){0.f, 0.f, 0.f, 0.f};
        if (W != nullptr && (k0 + kk) < Kvalid && nn < Nvalid) v[i] = *(const GAS f32x4*)(W + (size_t)(k0 + kk) * ldw + nn); }
#pragma unroll
    for (int i = 0; i < 16; ++i) { const int kk = 4 * i + (lane >> 4);
        *(LAS f32x4*)(scr + kk * 64 + ((4 * (lane & 15)) ^ (4 * ((kk >> 3) & 7)))) = v[i]; }
    LDS_WAIT(); asm volatile("" ::: "memory");
    const int kc = lane & 7, nl = lane >> 3;
#pragma unroll
    for (int j = 0; j < 8; ++j) { const int n = 8 * j + nl; const LAS float* sp = scr + (8 * kc) * 64 + (n ^ (4 * kc));
        u32x4 o; o.x = pk2(sp[0 * 64], sp[1 * 64]); o.y = pk2(sp[2 * 64], sp[3 * 64]); o.z = pk2(sp[4 * 64], sp[5 * 64]); o.w = pk2(sp[6 * 64], sp[7 * 64]);
        if (n < NW) *(GAS u32x4*)(dst + (size_t)(drow0 + n) * dpitch + dk0 + k0 + 8 * kc) = o; }
    LDS_WAIT(); asm volatile("" ::: "memory");
}

__device__ __forceinline__ void p0_phase(Frame& F) {
    const int tid = F.tid, lane = F.lane, wave = F.wave;
    {
        LAS float* cs = (LAS float*)(F.lds);
        LAS float* red = (LAS float*)(F.lds + 8192);
        const float* c = INF(1);
        for (int i = tid; i < 2048; i += NTHR) { const float v = c[i]; cs[i] = v / (1.0f + fexp(-v)); }
        __syncthreads();
        for (int cb = blockIdx.x; cb < 256; cb += F.G) {
            const int j = tid % 48, kg = tid / 48;
            const int col = cb * 48 + j, l = col / 6144, n = col % 6144;
            if (kg < 10) {
                const float* w = INF(3) + (size_t)l * 1024 * 6144 + n;
                float a0 = 0.f, a1 = 0.f;
#pragma unroll 26
                for (int k = kg; k < 1024; k += 10) { const float wv = w[(size_t)k * 6144]; a0 += cs[k] * wv; a1 += cs[1024 + k] * wv; }
                red[(kg * 48 + j) * 2] = a0; red[(kg * 48 + j) * 2 + 1] = a1;
            }
            __syncthreads();
            if (tid < 96) { const int jj = tid >> 1, b = tid & 1; float s = 0.f;
                for (int g = 0; g < 10; ++g) s += red[(g * 48 + jj) * 2 + b];
                const int col2 = cb * 48 + jj, l2 = col2 / 6144, n2 = col2 % 6144;
                WSP(float, WS_MOD)[(l2 * 2 + b) * 6144 + n2] = s + INF(4)[l2 * 6144 + n2]; }
            __syncthreads();
        }
    }
    {
        const int gw = F.vcu * NWAVES + wave, NGW = F.G * NWAVES;
        for (int l = 0; l < 2; ++l) {
            const float* w1 = INF(18) + l * 17 * 64; const float* w2 = INF(21) + l * 64 * 64;
            float w1c[17], w2c[64];
#pragma unroll
            for (int i = 0; i < 17; ++i) w1c[i] = w1[i * 64 + lane];
#pragma unroll
            for (int k = 0; k < 64; ++k) w2c[k] = w2[k * 64 + lane];
            const float b1 = INF(19)[l * 64 + lane], fr1 = INF(20)[l * 64 + lane], b2 = INF(22)[l * 64 + lane], fr2 = INF(23)[l * 64 + lane];
            for (int t = gw; t < SEQ; t += NGW) {
                const float tt = (float)t * (1.0f / SEQ);
                float a = b1 + tt * w1c[0];
#pragma unroll
                for (int bnd = 1; bnd <= 8; ++bnd) { float r = (float)((t * bnd) & (SEQ - 1)) * (1.0f / SEQ); a += sin_rev(r) * w1c[bnd] + cos_rev(r) * w1c[8 + bnd]; }
                const float h1 = sin_rad(fr1 * a);
                float a2 = b2;
#pragma unroll
                for (int k = 0; k < 64; ++k) a2 += __shfl(h1, k) * w2c[k];
                WSP(float, WS_HID)[((size_t)l * SEQ + t) * 64 + lane] = sin_rad(fr2 * a2);
            }
        }
    }
    {
        LAS float* scr = (LAS float*)(F.lds + wave * 16384);
        const int gw = F.vcu * NWAVES + wave, NGW = F.G * NWAVES;
        constexpr int I_WIN = 16 * 48, I_WOUT = 16 * 16, I_WMLA = 6 * 16, I_GU = 16 * 2 * 16 * 32, I_DN = 16 * 32 * 16;
        constexpr int I_LAYER = I_WIN + I_WOUT + I_WMLA + I_GU + I_DN;
        for (int it = gw; it < 2 * I_LAYER; it += NGW) {
            const int l = it / I_LAYER; int r = it % I_LAYER;
            if (r < I_WIN) { const int kb = r / 48, nb = r % 48;
                tr_item(INF(9) + (size_t)l * 1024 * DIN, DIN, 1024, DIN, kb * 64, nb * 64, WSP(bf16_t, WS_WIN) + (size_t)l * DINP * 1024, 1024, nb * 64, 0, scr, lane); continue; }
            r -= I_WIN;
            if (r < I_WOUT) { const int kb = r / 16, nb = r % 16;
                tr_item(INF(30) + (size_t)l * 1024 * 1024, 1024, 1024, 1024, kb * 64, nb * 64, WSP(bf16_t, WS_WOUT) + (size_t)l * 1024 * 1024, 1024, nb * 64, 0, scr, lane); continue; }
            r -= I_WOUT;
            if (r < I_WMLA) { const int kb = r / 16, nb = r % 16;
                bf16_t* dst = WSP(bf16_t, WS_WMLA) + (size_t)l * 1024 * 384;
                const float* Wq = INF(13) + (size_t)l * 224 * 384;
                if (nb < 4) { if (kb < 4) tr_item(Wq, 384, 224, nb * 96 + 64, kb * 64, nb * 96, dst, 384, nb * 64, 0, scr, lane); else tr_item(nullptr, 4, 0, 0, 0, 0, dst, 384, nb * 64, kb * 64, scr, lane); }
                else if (nb < 6) { const int h0 = 2 * (nb - 4);
                    if (kb < 4) { tr_item(Wq, 384, 224, h0 * 96 + 96, kb * 64, h0 * 96 + 64, dst, 384, 256 + h0 * 32, 0, scr, lane, 32);
                                  tr_item(Wq, 384, 224, (h0 + 1) * 96 + 96, kb * 64, (h0 + 1) * 96 + 64, dst, 384, 256 + (h0 + 1) * 32, 0, scr, lane, 32); }
                    else tr_item(nullptr, 4, 0, 0, 0, 0, dst, 384, nb * 64, kb * 64, scr, lane); }
                else if (nb < 8) tr_item(nullptr, 4, 0, 0, 0, 0, dst, 384, nb * 64, kb * 64, scr, lane);
                else { const float* W = (nb < 12) ? INF(14) + (size_t)l * 128 * 256 : INF(15) + (size_t)l * 128 * 256; const int nsrc = ((nb - 8) & 3) * 64;
                    if (kb >= 4) tr_item(W, 256, 128, 256, (kb - 4) * 64, nsrc, dst, 384, nb * 64, 256, scr, lane); else tr_item(nullptr, 4, 0, 0, 0, 0, dst, 384, nb * 64, kb * 64, scr, lane); }
                continue; }
            r -= I_WMLA;
            if (r < I_GU) { const int e = r / (2 * 16 * 32); int q = r % (2 * 16 * 32); const int which = q / (16 * 32); q %= (16 * 32); const int kb = q / 32, nb = q % 32;
                const float* W = INF(which ? 33 : 32) + ((size_t)l * NEXP + e) * 1024 * 2048;
                const int n0 = nb * 64, drow = (n0 >> 7) * 256 + (n0 & 127) + (which ? 128 : 0);
                tr_item(W, 2048, 1024, 2048, kb * 64, n0, WSP(bf16_t, WS_WGU) + ((size_t)l * NEXP + e) * 4096 * 1024, 1024, drow, 0, scr, lane); continue; }
            r -= I_GU;
            { const int e = r / (32 * 16); const int q = r % (32 * 16); const int kb = q / 16, nb = q % 16;
                const float* W = INF(34) + ((size_t)l * NEXP + e) * 2048 * 1024;
                tr_item(W, 1024, 2048, 1024, kb * 64, nb * 64, WSP(bf16_t, WS_WDN) + ((size_t)l * NEXP + e) * 1024 * 2048, 2048, nb * 64, 0, scr, lane); }
        }
    }
}

__device__ __forceinline__ void ld_row_f32(const float* p, int lane, f32x4 (&v)[4]) {
    const GAS f32x4* r = (const GAS f32x4*)p + lane;
#pragma unroll
    for (int j = 0; j < 4; ++j) v[j] = r[64 * j];
}
__device__ __forceinline__ void st_row_f32(float* p, int lane, const f32x4 (&v)[4]) {
    GAS f32x4* r = (GAS f32x4*)p + lane;
#pragma unroll
    for (int j = 0; j < 4; ++j) r[64 * j] = v[j];
}
__device__ __forceinline__ void st_row_bf16(bf16_t* p, int lane, const f32x4 (&v)[4]) {
    GAS u32x2* r = (GAS u32x2*)p + lane;
#pragma unroll
    for (int j = 0; j < 4; ++j) { u32x2 w; w.x = pk2(v[j].x, v[j].y); w.y = pk2(v[j].z, v[j].w); r[64 * j] = w; }
}
__device__ __forceinline__ float row_ss(const f32x4 (&v)[4]) {
    float s = 0.f;
#pragma unroll
    for (int j = 0; j < 4; ++j) s += (v[j].x * v[j].x + v[j].y * v[j].y) + (v[j].z * v[j].z + v[j].w * v[j].w);
    return wave_sum(s);
}
__device__ __forceinline__ void modnorm(const f32x4 (&x)[4], const float* g, const float* sc, const float* sh, int lane, f32x4 (&h)[4]) {
    const float rstd = __builtin_amdgcn_rsqf(row_ss(x) * (1.0f / DM) + EPS);
    f32x4 gv[4], scv[4], shv[4];
    ld_row_f32(g, lane, gv); ld_row_f32(sc, lane, scv); ld_row_f32(sh, lane, shv);
#pragma unroll
    for (int j = 0; j < 4; ++j) h[j] = (x[j] * rstd) * gv[j] * (scv[j] + 1.0f) + shv[j];
}

__device__ __forceinline__ void filt_gemm_tile(Frame& F, int wt) {
    const int lane = F.lane, hi = lane >> 5, l31 = lane & 31;
    const int l = wt >> 11, r = wt & 2047, t0 = (r >> 3) * 32, col0 = (r & 7) * 128;
    f32x16 acc[4];
#pragma unroll
    for (int jb = 0; jb < 4; ++jb)
#pragma unroll
        for (int q = 0; q < 16; ++q) acc[jb][q] = 0.f;
    const float* hid = WSP(float, WS_HID) + ((size_t)l * SEQ + t0 + l31) * 64 + hi;
    const float* w3 = INF(24) + (size_t)l * 64 * 1024 + (size_t)hi * 1024 + col0 + l31;
    float bA[4], aA[4][4], bB[4], aB[4][4];
#define FG_LOAD(bq, aq, b0) do { _Pragma("unroll") for (int q = 0; q < 4; ++q) { bq[q] = hid[2 * ((b0) * 4 + q)]; \
        _Pragma("unroll") for (int jb = 0; jb < 4; ++jb) aq[q][jb] = w3[(size_t)(2 * ((b0) * 4 + q)) * 1024 + 32 * jb]; } } while (0)
#define FG_MMA(bq, aq) do { _Pragma("unroll") for (int q = 0; q < 4; ++q) _Pragma("unroll") for (int jb = 0; jb < 4; ++jb) \
        acc[jb] = __builtin_amdgcn_mfma_f32_32x32x2f32(aq[q][jb], bq[q], acc[jb], 0, 0, 0); } while (0)
    FG_LOAD(bA, aA, 0);
#pragma unroll 1
    for (int b2 = 0; b2 < 8; b2 += 2) {
        FG_LOAD(bB, aB, b2 + 1);
        FG_MMA(bA, aA);
        if (b2 + 2 < 8) FG_LOAD(bA, aA, b2 + 2);
        FG_MMA(bB, aB);
    }
#undef FG_LOAD
#undef FG_MMA
    const float tt = (float)(t0 + l31) * (1.0f / SEQ);
    float* FT = WSP(float, WS_FILT) + (size_t)l * 1024 * SEQ + t0 + l31;
#pragma unroll
    for (int jb = 0; jb < 4; ++jb)
#pragma unroll
        for (int q = 0; q < 16; ++q) { const int col = col0 + 32 * jb + crow(q, hi);
            const float v = (acc[jb][q] + INF(25)[l * 1024 + col]) * fexp(-tt * fexp(INF(26)[l * 1024 + col]));
            FT[(size_t)col * SEQ] = v; }
}

__device__ __forceinline__ void p1_phase(Frame& F) {
    const int gw = F.vcu * NWAVES + F.wave, NGW = F.G * NWAVES;
    const float* mod = WSP(float, WS_MOD);
    for (int m = gw; m < MTOK; m += 2 * NGW) {
        const int m2 = (m + NGW < MTOK) ? m + NGW : m; f32x4 xa[4], xb[4], h[4];
        ld_row_f32(INF(0) + (size_t)m * DM, F.lane, xa); ld_row_f32(INF(0) + (size_t)m2 * DM, F.lane, xb);
        { const int b = m >> 13; modnorm(xa, INF(5), mod + (0 * 2 + b) * 6144 + 1024, mod + (0 * 2 + b) * 6144, F.lane, h); st_row_bf16(WSP(bf16_t, WS_XN) + (size_t)m * DM, F.lane, h); }
        { const int b = m2 >> 13; modnorm(xb, INF(5), mod + (0 * 2 + b) * 6144 + 1024, mod + (0 * 2 + b) * 6144, F.lane, h); st_row_bf16(WSP(bf16_t, WS_XN) + (size_t)m2 * DM, F.lane, h); }
    }
    for (int wt = gw; wt < 4096; wt += NGW) filt_gemm_tile(F, wt);
}

__device__ __forceinline__ float wave_scan_add(float v, int lane) {
#pragma unroll
    for (int o = 1; o < 64; o <<= 1) { const float n = __shfl_up(v, o); if (lane >= o) v += n; }
    return v;
}
__device__ __forceinline__ float wave_scan_max(float v, int lane) {
#pragma unroll
    for (int o = 1; o < 64; o <<= 1) { const float n = __shfl_up(v, o); if (lane >= o) v = fmaxf(v, n); }
    return v;
}
__device__ __forceinline__ float wave_max(float v) {
#pragma unroll
    for (int o = 1; o < 64; o <<= 1) v = fmaxf(v, __shfl_xor(v, o));
    return v;
}
__device__ __forceinline__ float logsigmoid(float x) { return fminf(x, 0.f) - flog(1.0f + fexp(-fabsf(x))); }
struct MlItem { int b, h, dir, n, t0; };
__device__ __forceinline__ MlItem ml_decode(int item) { MlItem I; I.b = item >> 9; I.h = (item >> 7) & 3; I.dir = (item >> 6) & 1; I.n = item & 63;
    I.t0 = I.b * SEQ + (I.dir ? SEQ - 128 * (I.n + 1) : 128 * I.n); return I; }

__device__ __forceinline__ void ml_local_item(Frame& F, int item, int l) {
    const int tid = F.tid; const MlItem I = ml_decode(item);
    const bf16_t* U = WSP(bf16_t, WS_U);
    LAS float* EK = (LAS float*)(F.lds);
    LAS float* VV = (LAS float*)(F.lds + 32768);
    LAS float* LF = (LAS float*)(F.lds + 65536);
    LAS float* IG = LF + 128; LAS float* WW = LF + 256; LAS float* EST = LF + 384;
    const float* gb = INF(10) + l * 16;
    if (tid < 128) { const int j = tid, r = I.dir ? 127 - j : j; const size_t t = (size_t)(I.t0 + r);
        const float ipre = bf2f(U[t * DINP + U_MLG + (I.dir ? 2 : 0) * 4 + I.h]) + gb[(I.dir ? 2 : 0) * 4 + I.h];
        const float fpre = bf2f(U[t * DINP + U_MLG + (I.dir ? 3 : 1) * 4 + I.h]) + gb[(I.dir ? 3 : 1) * 4 + I.h];
        LF[j] = logsigmoid(fpre); IG[j] = ipre; }
    __syncthreads();
    float a = 0.f, aend = 0.f;
    if (tid < 128) { for (int i = 0; i < 128; ++i) { const float v = LF[i]; aend += v; if (i <= tid) a += v; }
        WW[tid] = aend - a + IG[tid]; }
    __syncthreads();
    float mloc = -3.0e38f;
    if (tid < 128) { for (int i = 0; i < 128; ++i) mloc = fmaxf(mloc, WW[i]);
        const int r = I.dir ? 127 - tid : tid; EST[r] = fexp(WW[tid] - mloc); }
    __syncthreads();
#pragma unroll
    for (int i = 0; i < 2; ++i) { const int p = tid + 512 * i, row = p >> 3, c8 = p & 7;
        const u32x4 kq = *(const GAS u32x4*)(U + (size_t)(I.t0 + row) * DINP + U_MLK + I.h * 64 + c8 * 8);
        const u32x4 vq = *(const GAS u32x4*)(U + (size_t)(I.t0 + row) * DINP + U_MLV + I.h * 64 + c8 * 8);
        const float es = EST[row] * 0.125f;
        LAS f32x4* ek = (LAS f32x4*)(EK + row * 64 + c8 * 8); LAS f32x4* vv = (LAS f32x4*)(VV + row * 64 + c8 * 8);
        ek[0] = (f32x4){bflo(kq.x) * es, bfhi(kq.x) * es, bflo(kq.y) * es, bfhi(kq.y) * es};
        ek[1] = (f32x4){bflo(kq.z) * es, bfhi(kq.z) * es, bflo(kq.w) * es, bfhi(kq.w) * es};
        vv[0] = (f32x4){bflo(vq.x), bfhi(vq.x), bflo(vq.y), bfhi(vq.y)};
        vv[1] = (f32x4){bflo(vq.z), bfhi(vq.z), bflo(vq.w), bfhi(vq.w)}; }
    __syncthreads();
    {
        const int d = tid >> 3, e0 = (tid & 7) * 8;
        f32x4 c0 = {0.f, 0.f, 0.f, 0.f}, c1 = {0.f, 0.f, 0.f, 0.f};
#pragma unroll 4
        for (int j = 0; j < 128; ++j) { const float ek = EK[j * 64 + d]; const f32x4 v0 = *(const LAS f32x4*)(VV + j * 64 + e0), v1 = *(const LAS f32x4*)(VV + j * 64 + e0 + 4);
            c0 += v0 * ek; c1 += v1 * ek; }
        GAS f32x4* dst = (GAS f32x4*)(WSP(float, WS_MLC) + (size_t)item * 4096 + d * 64 + e0);
        dst[0] = c0; dst[1] = c1;
        if (tid < 64) { float s = 0.f; for (int j = 0; j < 128; ++j) s += EK[j * 64 + tid]; WSP(float, WS_MLN)[item * 64 + tid] = s; }
        if (tid == 0) { WSP(float, WS_MLS)[item * 4] = mloc; WSP(float, WS_MLS)[item * 4 + 1] = aend; }
    }
    __syncthreads();
}

__device__ __forceinline__ void ml_scan(Frame& F) {
    float* MLC = WSP(float, WS_MLC); float* MLN = WSP(float, WS_MLN); float* MLS = WSP(float, WS_MLS);
    for (int blk = blockIdx.x; blk < 256; blk += F.G) { if (F.tid >= 260) continue; const int idx = blk * 260 + F.tid;
        const int seq = idx / 4160, el = idx % 4160;
        float* p0 = el < 4096 ? (MLC + (size_t)seq * 64 * 4096 + el) : (MLN + seq * 64 * 64 + (el - 4096));
        const int pstr = el < 4096 ? 4096 : 64;
        float mst = 0.f, st = 0.f;
#pragma unroll 1
        for (int n0 = 0; n0 < 64; n0 += 16) {
            float cl[16], mlv[16], aev[16];
#pragma unroll
            for (int i = 0; i < 16; ++i) { cl[i] = p0[(size_t)(n0 + i) * pstr]; mlv[i] = MLS[(seq * 64 + n0 + i) * 4]; aev[i] = MLS[(seq * 64 + n0 + i) * 4 + 1]; }
#pragma unroll
            for (int i = 0; i < 16; ++i) { const int item = seq * 64 + n0 + i;
                p0[(size_t)(n0 + i) * pstr] = st;
                if (el == 0) MLS[item * 4 + 2] = mst;
                const float mnew = fmaxf(aev[i] + mst, mlv[i]), sp = fexp(aev[i] + mst - mnew), sl = fexp(mlv[i] - mnew);
                st = sp * st + sl * cl[i]; mst = mnew; }
        }
    }
}

#define MFMA32(a, b, c) __builtin_amdgcn_mfma_f32_32x32x16_bf16((a), (b), (c), 0, 0, 0)
template <int NK>
__device__ __forceinline__ void qkt_tile(f32x16& p0, f32x16& p1, LAS const unsigned char* Kt, const bf16x8 (&qr)[NK], int r32, int hi) {
#pragma unroll
    for (int r = 0; r < 16; ++r) { p0[r] = 0.f; p1[r] = 0.f; }
#pragma unroll
    for (int d0 = 0; d0 < NK; ++d0) {
        const bf16x8 b0 = *(const LAS bf16x8*)(Kt + (2 * d0 + hi) * 1024 + r32 * 16);
        const bf16x8 b1 = *(const LAS bf16x8*)(Kt + (2 * d0 + hi) * 1024 + r32 * 16 + 512);
        p0 = MFMA32(b0, qr[d0], p0); p1 = MFMA32(b1, qr[d0], p1);
    }
}
typedef short v4i16_t __attribute__((ext_vector_type(4)));
__device__ __forceinline__ s16x4 vtr(LAS const unsigned char* p) { return __builtin_bit_cast(s16x4, __builtin_amdgcn_ds_read_tr16_b64_v4i16((LAS v4i16_t*)p)); }
__device__ __forceinline__ void pv_tile(f32x16 (&o)[2], LAS const unsigned char* Vt, const bf16x8 (&pa)[4], int lane) {
    const int hi = lane >> 5;
    LAS const unsigned char* vb = Vt + ((lane >> 4) & 1) * 32 + (lane & 3) * 8 + (4 * hi + ((lane & 15) >> 2)) * 64;
#pragma unroll
    for (int d0 = 0; d0 < 2; ++d0)
#pragma unroll
        for (int ks = 0; ks < 4; ++ks) {
            const s16x4 lo = vtr(vb + d0 * 4096 + ks * 1024), hh = vtr(vb + d0 * 4096 + ks * 1024 + 512);
            const bf16x8 vf = (bf16x8){lo[0], lo[1], lo[2], lo[3], hh[0], hh[1], hh[2], hh[3]};
            o[d0] = MFMA32(pa[ks], vf, o[d0]);
        }
}
__device__ __forceinline__ void pack_p(const f32x16& p0, const f32x16& p1, bf16x8 (&pa)[4]) {
    u32x4 w0, w1, w2, w3;
    w0 = (u32x4){pk2(p0[0], p0[1]), pk2(p0[2], p0[3]), pk2(p0[4], p0[5]), pk2(p0[6], p0[7])};
    w1 = (u32x4){pk2(p0[8], p0[9]), pk2(p0[10], p0[11]), pk2(p0[12], p0[13]), pk2(p0[14], p0[15])};
    w2 = (u32x4){pk2(p1[0], p1[1]), pk2(p1[2], p1[3]), pk2(p1[4], p1[5]), pk2(p1[6], p1[7])};
    w3 = (u32x4){pk2(p1[8], p1[9]), pk2(p1[10], p1[11]), pk2(p1[12], p1[13]), pk2(p1[14], p1[15])};
    pa[0] = __builtin_bit_cast(bf16x8, w0); pa[1] = __builtin_bit_cast(bf16x8, w1); pa[2] = __builtin_bit_cast(bf16x8, w2); pa[3] = __builtin_bit_cast(bf16x8, w3);
}

__device__ __forceinline__ void ml_local_pair(Frame& F, int pair, int l) {
    const int tid = F.tid, lane = F.lane, wid = F.wave, half = wid >> 2, wq = wid & 3, th = tid & 255, hi = lane >> 5;
    const int item = pair * 2 + half; const MlItem I = ml_decode(item);
    const bf16_t* U = WSP(bf16_t, WS_U);
    LAS unsigned char* base = F.lds + half * 49152;
    LAS unsigned char* EKI = base;
    LAS unsigned char* VI = base + 16384;
    LAS float* LF = (LAS float*)(base + 32768); LAS float* IG = LF + 128; LAS float* WW = LF + 256; LAS float* EST = LF + 384;
    const float* gb = INF(10) + l * 16;
    unsigned short graw_i = 0, graw_f = 0;
    if (th < 128) { const int r = I.dir ? 127 - th : th; const size_t t = (size_t)(I.t0 + r);
        graw_i = U[t * DINP + U_MLG + (I.dir ? 2 : 0) * 4 + I.h]; graw_f = U[t * DINP + U_MLG + (I.dir ? 3 : 1) * 4 + I.h]; }
    u32x4 kpc[4], vpc[4];
#pragma unroll
    for (int i = 0; i < 4; ++i) { const int p = th + 256 * i; const int tt = p >> 9, dh = (p >> 8) & 1, row = (p >> 2) & 63, c4 = p & 3, r = 64 * tt + row;
        const bf16_t* src = U + (size_t)(I.t0 + r) * DINP + I.h * 64 + dh * 32 + c4 * 8;
        kpc[i] = *(const GAS u32x4*)(src + U_MLK); vpc[i] = *(const GAS u32x4*)(src + U_MLV); }
    float a = 0.f, aend = 0.f, mloc = -3.0e38f;
    const float lfv = (th < 128) ? logsigmoid(bf2f(graw_f) + gb[(I.dir ? 3 : 1) * 4 + I.h]) : 0.f, igv = (th < 128) ? bf2f(graw_i) + gb[(I.dir ? 2 : 0) * 4 + I.h] : 0.f;
    if (th < 128) { a = wave_scan_add(lfv, lane); if (lane == 63) LF[wq] = a; }
    __syncthreads();
    float wv = 0.f;
    if (th < 128) { aend = LF[0] + LF[1]; if (wq == 1) a += LF[0]; wv = aend - a + igv; const float wm = wave_max(wv); if (lane == 0) IG[wq] = wm; }
    __syncthreads();
    if (th < 128) { mloc = fmaxf(IG[0], IG[1]); const int r = I.dir ? 127 - th : th; EST[r] = fexp(wv - mloc) * 0.125f; }
    __syncthreads();
#pragma unroll
    for (int i = 0; i < 4; ++i) { const int p = th + 256 * i; const int tt = p >> 9, dh = (p >> 8) & 1, row = (p >> 2) & 63, c4 = p & 3, r = 64 * tt + row;
        const u32x4 kq = kpc[i];
        const float es = EST[r];
        u32x4 ek; ek.x = pk2(bflo(kq.x) * es, bfhi(kq.x) * es); ek.y = pk2(bflo(kq.y) * es, bfhi(kq.y) * es); ek.z = pk2(bflo(kq.z) * es, bfhi(kq.z) * es); ek.w = pk2(bflo(kq.w) * es, bfhi(kq.w) * es);
        const int off = tt * 8192 + dh * 4096 + row * 64 + c4 * 16;
        *(LAS u32x4*)(EKI + off) = ek; *(LAS u32x4*)(VI + off) = vpc[i]; }
    __syncthreads();
    {
        const int da = wq >> 1, eb = wq & 1;
        f32x16 acc;
#pragma unroll
        for (int r = 0; r < 16; ++r) acc[r] = 0.f;
        const int lo_off = ((lane >> 4) & 1) * 32 + (lane & 3) * 8 + (4 * hi + ((lane & 15) >> 2)) * 64;
#pragma unroll
        for (int tt = 0; tt < 2; ++tt)
#pragma unroll
            for (int ks = 0; ks < 4; ++ks) {
                LAS const unsigned char* ap = EKI + tt * 8192 + da * 4096 + lo_off + ks * 1024; LAS const unsigned char* bp = VI + tt * 8192 + eb * 4096 + lo_off + ks * 1024;
                const s16x4 a0 = vtr(ap), a1 = vtr(ap + 512), b0 = vtr(bp), b1 = vtr(bp + 512);
                const bf16x8 af = (bf16x8){a0[0], a0[1], a0[2], a0[3], a1[0], a1[1], a1[2], a1[3]}, bf = (bf16x8){b0[0], b0[1], b0[2], b0[3], b1[0], b1[1], b1[2], b1[3]};
                acc = MFMA32(af, bf, acc); }
        float* dst = WSP(float, WS_MLC) + (size_t)item * 4096 + eb * 32 + (lane & 31);
#pragma unroll
        for (int r = 0; r < 16; ++r) dst[(da * 32 + crow(r, hi)) * 64] = acc[r];
        if (th < 64) { const int dh = th >> 5, col = th & 31; float sacc = 0.f;
            for (int tt = 0; tt < 2; ++tt) for (int row = 0; row < 64; ++row) sacc += bf2f(*(const LAS unsigned short*)(EKI + tt * 8192 + dh * 4096 + row * 64 + col * 2));
            WSP(float, WS_MLN)[item * 64 + th] = sacc; }
        if (th == 0) { WSP(float, WS_MLS)[item * 4] = mloc; WSP(float, WS_MLS)[item * 4 + 1] = aend; }
    }
    __syncthreads();
}

__device__ __forceinline__ void ml_out_pair(Frame& F, int pair, int l) {
    const int tid = F.tid, lane = F.lane, wid = F.wave, half = wid >> 2, wq = wid & 3, th = tid & 255, r32 = lane & 31, hi = lane >> 5;
    const int item = pair * 2 + half; const MlItem I = ml_decode(item);
    const bf16_t* U = WSP(bf16_t, WS_U);
    LAS unsigned char* base = F.lds + half * 49152;
    LAS unsigned char* KI = base;
    LAS unsigned char* VI = base + 16384;
    LAS unsigned char* CT = base + 32768;
    LAS float* vec = (LAS float*)(base + 32768 + 9216);
    LAS float* LF = vec; LAS float* IG = vec + 128; LAS float* BL = vec + 256; LAS float* SA = vec + 384; LAS float* SCI = vec + 512; LAS float* EDEN = vec + 640;
    LAS float* NPV = vec + 768; LAS float* wsf = vec + 832 + wq * 64;
    const float* gb = INF(10) + l * 16;
    unsigned short graw_i = 0, graw_f = 0; float mprev = 0.f;
    if (th < 128) { const int r = I.dir ? 127 - th : th; const size_t t = (size_t)(I.t0 + r);
        graw_i = U[t * DINP + U_MLG + (I.dir ? 2 : 0) * 4 + I.h]; graw_f = U[t * DINP + U_MLG + (I.dir ? 3 : 1) * 4 + I.h];
        mprev = WSP(float, WS_MLS)[item * 4 + 2]; }
    u32x4 kpc[4], vpc[4];
#pragma unroll
    for (int i = 0; i < 4; ++i) { const int p = th + 256 * i;
        { const int tt = p >> 9, c = (p >> 6) & 7, kv = p & 63, j = 64 * tt + kv, r = I.dir ? 127 - j : j;
          kpc[i] = *(const GAS u32x4*)(U + (size_t)(I.t0 + r) * DINP + U_MLK + I.h * 64 + c * 8); }
        { const int tt = p >> 9, dh = (p >> 8) & 1, kv = (p >> 2) & 63, c4 = p & 3, j = 64 * tt + kv, r = I.dir ? 127 - j : j;
          vpc[i] = *(const GAS u32x4*)(U + (size_t)(I.t0 + r) * DINP + U_MLV + I.h * 64 + dh * 32 + c4 * 8); } }
    float cpv[16];
    { const float* cp = WSP(float, WS_MLC) + (size_t)item * 4096;
#pragma unroll
      for (int i = 0; i < 16; ++i) cpv[i] = cp[th + 256 * i]; }
    const float npv = (th < 64) ? WSP(float, WS_MLN)[item * 64 + th] : 0.f;
    const int q = 32 * wq + r32;
    const int rq = I.dir ? 127 - q : q;
    bf16x8 qr[4];
    { const bf16_t* qp = U + (size_t)(I.t0 + rq) * DINP + U_MLQ + I.h * 64 + hi * 8;
#pragma unroll
      for (int d0 = 0; d0 < 4; ++d0) qr[d0] = *(const GAS bf16x8*)(qp + d0 * 16); }
    const float lfv = (th < 128) ? logsigmoid(bf2f(graw_f) + gb[(I.dir ? 3 : 1) * 4 + I.h]) : 0.f, igv = (th < 128) ? bf2f(graw_i) + gb[(I.dir ? 2 : 0) * 4 + I.h] : 0.f;
    float a = 0.f;
    if (th < 128) { a = wave_scan_add(lfv, lane); if (lane == 63) LF[wq] = a; }
#pragma unroll
    for (int i = 0; i < 4; ++i) { const int p = th + 256 * i;
        { const int tt = p >> 9, c = (p >> 6) & 7, kv = p & 63; *(LAS u32x4*)(KI + tt * 8192 + c * 1024 + kv * 16) = kpc[i]; }
        { const int tt = p >> 9, dh = (p >> 8) & 1, kv = (p >> 2) & 63, c4 = p & 3; *(LAS u32x4*)(VI + tt * 8192 + dh * 4096 + kv * 64 + c4 * 16) = vpc[i]; } }
#pragma unroll
    for (int i = 0; i < 16; ++i) { const int idx = th + 256 * i, d = idx >> 6, e = idx & 63;
        *(LAS unsigned short*)(CT + e * 144 + d * 2) = (unsigned short)(pk2(cpv[i], 0.f) & 0xffffu); }
    if (th < 64) NPV[th] = npv;
    __syncthreads();
    float bv = 0.f, bm = -3.0e38f;
    if (th < 128) { if (wq == 1) a += LF[0]; bv = igv - a; bm = wave_scan_max(bv, lane); if (lane == 63) IG[wq] = bm; }
    __syncthreads();
    if (th < 128) { if (wq == 1) bm = fmaxf(bm, IG[0]);
        const float mt = a + fmaxf(mprev, bm);
        SA[th] = (a - mt) * LOG2E; SCI[th] = fexp(a + mprev - mt); EDEN[th] = fexp(-mt); BL[th] = bv * LOG2E; }
    __syncthreads();
    {
        f32x16 o[2];
#pragma unroll
        for (int r = 0; r < 16; ++r) { o[0][r] = 0.f; o[1][r] = 0.f; }
        const float saq = SA[q], scq = SCI[q];
        float den = 0.f;
        for (int tt = 0; tt < 2; ++tt) {
            if (64 * tt > 32 * wq + 31) break;
            f32x16 p0, p1;
            qkt_tile<4>(p0, p1, KI + tt * 8192, qr, r32, hi);
#pragma unroll
            for (int g = 0; g < 4; ++g) {
                const f32x4 b0 = *(const LAS f32x4*)(BL + 64 * tt + 8 * g + 4 * hi), b1 = *(const LAS f32x4*)(BL + 64 * tt + 32 + 8 * g + 4 * hi);
#pragma unroll
                for (int i = 0; i < 4; ++i) { const int r = 4 * g + i; const int kv0 = 64 * tt + 8 * g + 4 * hi + i, kv1 = kv0 + 32;
                    const float e0 = (kv0 <= q) ? __builtin_amdgcn_exp2f(saq + b0[i]) * 0.125f : 0.f, e1 = (kv1 <= q) ? __builtin_amdgcn_exp2f(saq + b1[i]) * 0.125f : 0.f;
                    p0[r] *= e0; p1[r] *= e1; den += p0[r] + p1[r]; }
            }
            bf16x8 pa[4]; pack_p(p0, p1, pa);
            pv_tile(o, VI + tt * 8192, pa, lane);
        }
        float dot = 0.f;
#pragma unroll
        for (int ks = 0; ks < 4; ++ks) {
            const u32x4 qw = __builtin_bit_cast(u32x4, qr[ks]);
            const f32x4 n0 = *(const LAS f32x4*)(NPV + 16 * ks + 8 * hi), n1 = *(const LAS f32x4*)(NPV + 16 * ks + 8 * hi + 4);
            const float q0 = bflo(qw.x), q1 = bfhi(qw.x), q2 = bflo(qw.y), q3 = bfhi(qw.y), q4 = bflo(qw.z), q5 = bfhi(qw.z), q6 = bflo(qw.w), q7 = bfhi(qw.w);
            dot += q0 * n0[0] + q1 * n0[1] + q2 * n0[2] + q3 * n0[3] + q4 * n1[0] + q5 * n1[1] + q6 * n1[2] + q7 * n1[3];
            const u32x4 sw = (u32x4){pk2(q0 * scq, q1 * scq), pk2(q2 * scq, q3 * scq), pk2(q4 * scq, q5 * scq), pk2(q6 * scq, q7 * scq)};
            const bf16x8 qs = __builtin_bit_cast(bf16x8, sw);
#pragma unroll
            for (int de = 0; de < 2; ++de) {
                const bf16x8 cf = *(const LAS bf16x8*)(CT + (de * 32 + r32) * 144 + (16 * ks + 8 * hi) * 2);
                o[de] = MFMA32(qs, cf, o[de]);
            }
        }
        den += scq * dot;
        den += __shfl_xor(den, 32);
        const float rinv = 1.0f / fmaxf(fabsf(den), EDEN[q]);
        if (hi == 0) wsf[r32] = rinv;
        LDS_WAIT();
        bf16_t* dst = WSP(bf16_t, I.dir ? WS_HB : WS_HF);
#pragma unroll
        for (int r = 0; r < 16; ++r) { const int jq = 32 * wq + crow(r, hi), row = I.dir ? 127 - jq : jq; const float rr = wsf[crow(r, hi)];
            bf16_t* dp = dst + (size_t)(I.t0 + row) * 256 + I.h * 64 + r32;
            dp[0] = (bf16_t)(pk2(o[0][r] * rr, 0.f) & 0xffffu); dp[32] = (bf16_t)(pk2(o[1][r] * rr, 0.f) & 0xffffu); }
    }
    __syncthreads();
}

__device__ __forceinline__ double rope_kd_dyn(int i) {
    double r = 0.15915494309189535;
    r = (i == 1) ? 0.08949940160889101 : r; r = (i == 2) ? 0.050329212104487035 : r; r = (i == 3) ? 0.0283021958306234 : r; r = (i == 4) ? 0.015915494309189534 : r;
    r = (i == 5) ? 0.008949940160889102 : r; r = (i == 6) ? 0.005032921210448704 : r; r = (i == 7) ? 0.00283021958306234 : r; r = (i == 8) ? 0.0015915494309189536 : r;
    r = (i == 9) ? 0.0008949940160889102 : r; r = (i == 10) ? 0.0005032921210448703 : r; r = (i == 11) ? 0.00028302195830623395 : r; r = (i == 12) ? 0.00015915494309189535 : r;
    r = (i == 13) ? 8.949940160889102e-05 : r; r = (i == 14) ? 5.0329212104487035e-05 : r; r = (i == 15) ? 2.8302195830623396e-05 : r;
    return r;
}
__device__ __forceinline__ void mla_prep_rows(Frame& F, int l) {
    const int gw = F.vcu * NWAVES + F.wave, NGW = F.G * NWAVES, lane = F.lane;
    const bf16_t* U = WSP(bf16_t, WS_U); bf16_t* A = WSP(bf16_t, WS_AMLA);
    f32x4 gq = {0.f, 0.f, 0.f, 0.f}; if (lane < 56) gq = *(const GAS f32x4*)(INF(11) + l * 224 + 4 * lane);
    const f32x2 gk = *(const GAS f32x2*)(INF(12) + l * 128 + 2 * lane);
    for (int m0 = gw; m0 < MTOK; m0 += 4 * NGW) {
        u32x2 qw[4]; unsigned kw[4];
#pragma unroll
        for (int r = 0; r < 4; ++r) { const int m = m0 + r * NGW; const bf16_t* ur = U + (size_t)(m < MTOK ? m : 0) * DINP;
            qw[r] = (u32x2){0u, 0u}; if (lane < 56) qw[r] = *(const GAS u32x2*)(ur + U_CQ + 4 * lane);
            kw[r] = *(const GAS unsigned*)(ur + U_CKV + 2 * lane); }
#pragma unroll
        for (int r = 0; r < 4; ++r) { const int m = m0 + r * NGW; if (m >= MTOK) break;
            const float q0 = bflo(qw[r].x), q1 = bfhi(qw[r].x), q2 = bflo(qw[r].y), q3 = bfhi(qw[r].y), k0 = bflo(kw[r]), k1 = bfhi(kw[r]);
            const float rq = __builtin_amdgcn_rsqf(wave_sum(q0 * q0 + q1 * q1 + q2 * q2 + q3 * q3) * (1.0f / 224.0f) + EPS);
            const float rk = __builtin_amdgcn_rsqf(wave_sum(k0 * k0 + k1 * k1) * (1.0f / 128.0f) + EPS);
            bf16_t* ar = A + (size_t)m * 384;
            u32x2 qo; qo.x = pk2(q0 * rq * gq.x, q1 * rq * gq.y); qo.y = pk2(q2 * rq * gq.z, q3 * rq * gq.w);
            *(GAS u32x2*)(ar + 4 * lane) = qo;
            *(GAS unsigned*)(ar + 256 + 2 * lane) = pk2(k0 * rk * gk.x, k1 * rk * gk.y); }
    }
    const int* pos = (const int*)F.a->in[2];
    for (int m0 = gw; m0 < MTOK; m0 += 4 * NGW) {
        unsigned short x1r[4], x2r[4]; int pv[4];
#pragma unroll
        for (int r = 0; r < 4; ++r) { const int m = (m0 + r * NGW < MTOK) ? m0 + r * NGW : m0; x1r[r] = 0; x2r[r] = 0; pv[r] = 0;
            if (lane < 16) { x1r[r] = U[(size_t)m * DINP + U_KR + lane]; x2r[r] = U[(size_t)m * DINP + U_KR + 16 + lane]; pv[r] = pos[m]; } }
#pragma unroll
        for (int r = 0; r < 4; ++r) { const int m = m0 + r * NGW; if (m >= MTOK) break;
            if (lane < 16) { const int b = m >> 13, sq = m & 8191;
                double rev = (double)pv[r] * rope_kd_dyn(lane); rev -= __builtin_floor(rev);
                const float rr = (float)rev, c = cos_rev(rr), sn = sin_rev(rr), x1 = bf2f(x1r[r]), x2 = bf2f(x2r[r]);
                const unsigned short o1 = (unsigned short)(pk2(x1 * c - x2 * sn, 0.f) & 0xffffu), o2 = (unsigned short)(pk2(x2 * c + x1 * sn, 0.f) & 0xffffu);
#pragma unroll
                for (int h = 0; h < 4; ++h) { bf16_t* kd = WSP(bf16_t, WS_KIMG) + ((size_t)(b * 4 + h) * 128 + (sq >> 6)) * 6144 + (sq & 63) * 8;
                    kd[(8 + (lane >> 3)) * 512 + (lane & 7)] = o1; kd[(10 + (lane >> 3)) * 512 + (lane & 7)] = o2; } } }
    }
}

__device__ __forceinline__ double rope_k(int i) {
    switch (i) { case 0: return 0.15915494309189535; case 1: return 0.08949940160889101; case 2: return 0.050329212104487035; case 3: return 0.0283021958306234;
        case 4: return 0.015915494309189534; case 5: return 0.008949940160889102; case 6: return 0.005032921210448704; case 7: return 0.00283021958306234;
        case 8: return 0.0015915494309189536; case 9: return 0.0008949940160889102; case 10: return 0.0005032921210448703; case 11: return 0.00028302195830623395;
        case 12: return 0.00015915494309189535; case 13: return 8.949940160889102e-05; case 14: return 5.0329212104487035e-05; default: return 2.8302195830623396e-05; }
}
__device__ __forceinline__ void rope_cs(int pos, int i, float& c, float& s) {
    double rev = (double)pos * rope_k(i);
    rev -= __builtin_floor(rev);
    const float r = (float)rev;
    c = cos_rev(r); s = sin_rev(r);
}
__device__ __forceinline__ void relayout_phase(Frame& F) {
    const bf16_t* O = WSP(bf16_t, WS_OMLA); const bf16_t* U = WSP(bf16_t, WS_U);
    const int* pos = (const int*)F.a->in[2];
    const float qscale = 0.10206207261596577f * LOG2E;
    for (int idx = blockIdx.x * NTHR + F.tid; idx < MTOK * 4; idx += F.G * NTHR) {
        const int t = idx >> 2, h = idx & 3, b = t >> 13, s = t & 8191, bh = b * 4 + h;
        const int p = pos[t];
        float cs[16], sn[16];
#pragma unroll
        for (int i = 0; i < 16; ++i) rope_cs(p, i, cs[i], sn[i]);
        const bf16_t* qsrc = O + (size_t)t * 1024 + h * 96;
        bf16_t* qdst = WSP(bf16_t, WS_Q) + ((size_t)bh * SEQ + s) * 96;
#pragma unroll
        for (int c = 0; c < 8; ++c) { const u32x4 w = *(const GAS u32x4*)(qsrc + c * 8);
            u32x4 o; o.x = pk2(bflo(w.x) * qscale, bfhi(w.x) * qscale); o.y = pk2(bflo(w.y) * qscale, bfhi(w.y) * qscale); o.z = pk2(bflo(w.z) * qscale, bfhi(w.z) * qscale); o.w = pk2(bflo(w.w) * qscale, bfhi(w.w) * qscale);
            *(GAS u32x4*)(qdst + c * 8) = o; }
        {
            float x1[16], x2[16];
#pragma unroll
            for (int c = 0; c < 2; ++c) { const u32x4 w = *(const GAS u32x4*)(qsrc + 64 + c * 8); const u32x4 v = *(const GAS u32x4*)(qsrc + 80 + c * 8);
                x1[c * 8 + 0] = bflo(w.x); x1[c * 8 + 1] = bfhi(w.x); x1[c * 8 + 2] = bflo(w.y); x1[c * 8 + 3] = bfhi(w.y); x1[c * 8 + 4] = bflo(w.z); x1[c * 8 + 5] = bfhi(w.z); x1[c * 8 + 6] = bflo(w.w); x1[c * 8 + 7] = bfhi(w.w);
                x2[c * 8 + 0] = bflo(v.x); x2[c * 8 + 1] = bfhi(v.x); x2[c * 8 + 2] = bflo(v.y); x2[c * 8 + 3] = bfhi(v.y); x2[c * 8 + 4] = bflo(v.z); x2[c * 8 + 5] = bfhi(v.z); x2[c * 8 + 6] = bflo(v.w); x2[c * 8 + 7] = bfhi(v.w); }
#pragma unroll
            for (int c = 0; c < 2; ++c) { u32x4 o1, o2;
#define RQ1(i) ((x1[i] * cs[i] - x2[i] * sn[i]) * qscale)
#define RQ2(i) ((x2[i] * cs[i] + x1[i] * sn[i]) * qscale)
                o1.x = pk2(RQ1(c * 8 + 0), RQ1(c * 8 + 1)); o1.y = pk2(RQ1(c * 8 + 2), RQ1(c * 8 + 3)); o1.z = pk2(RQ1(c * 8 + 4), RQ1(c * 8 + 5)); o1.w = pk2(RQ1(c * 8 + 6), RQ1(c * 8 + 7));
                o2.x = pk2(RQ2(c * 8 + 0), RQ2(c * 8 + 1)); o2.y = pk2(RQ2(c * 8 + 2), RQ2(c * 8 + 3)); o2.z = pk2(RQ2(c * 8 + 4), RQ2(c * 8 + 5)); o2.w = pk2(RQ2(c * 8 + 6), RQ2(c * 8 + 7));
                *(GAS u32x4*)(qdst + 64 + c * 8) = o1; *(GAS u32x4*)(qdst + 80 + c * 8) = o2; }
#undef RQ1
#undef RQ2
        }
        bf16_t* kdst = WSP(bf16_t, WS_KIMG) + ((size_t)bh * 128 + (s >> 6)) * 6144 + (s & 63) * 8;
        const bf16_t* ksrc = O + (size_t)t * 1024 + 384 + h * 64;
#pragma unroll
        for (int c = 0; c < 8; ++c) *(GAS u32x4*)(kdst + c * 512) = *(const GAS u32x4*)(ksrc + c * 8);
        {
            const bf16_t* krs = U + (size_t)t * DINP + U_KR;
            float x1[16], x2[16];
#pragma unroll
            for (int c = 0; c < 2; ++c) { const u32x4 w = *(const GAS u32x4*)(krs + c * 8); const u32x4 v = *(const GAS u32x4*)(krs + 16 + c * 8);
                x1[c * 8 + 0] = bflo(w.x); x1[c * 8 + 1] = bfhi(w.x); x1[c * 8 + 2] = bflo(w.y); x1[c * 8 + 3] = bfhi(w.y); x1[c * 8 + 4] = bflo(w.z); x1[c * 8 + 5] = bfhi(w.z); x1[c * 8 + 6] = bflo(w.w); x1[c * 8 + 7] = bfhi(w.w);
                x2[c * 8 + 0] = bflo(v.x); x2[c * 8 + 1] = bfhi(v.x); x2[c * 8 + 2] = bflo(v.y); x2[c * 8 + 3] = bfhi(v.y); x2[c * 8 + 4] = bflo(v.z); x2[c * 8 + 5] = bfhi(v.z); x2[c * 8 + 6] = bflo(v.w); x2[c * 8 + 7] = bfhi(v.w); }
#pragma unroll
            for (int c = 0; c < 2; ++c) { u32x4 o1, o2;
#define RK1(i) (x1[i] * cs[i] - x2[i] * sn[i])
#define RK2(i) (x2[i] * cs[i] + x1[i] * sn[i])
                o1.x = pk2(RK1(c * 8 + 0), RK1(c * 8 + 1)); o1.y = pk2(RK1(c * 8 + 2), RK1(c * 8 + 3)); o1.z = pk2(RK1(c * 8 + 4), RK1(c * 8 + 5)); o1.w = pk2(RK1(c * 8 + 6), RK1(c * 8 + 7));
                o2.x = pk2(RK2(c * 8 + 0), RK2(c * 8 + 1)); o2.y = pk2(RK2(c * 8 + 2), RK2(c * 8 + 3)); o2.z = pk2(RK2(c * 8 + 4), RK2(c * 8 + 5)); o2.w = pk2(RK2(c * 8 + 6), RK2(c * 8 + 7));
                *(GAS u32x4*)(kdst + (8 + c) * 512) = o1; *(GAS u32x4*)(kdst + (10 + c) * 512) = o2; }
#undef RK1
#undef RK2
        }
        bf16_t* vdst = WSP(bf16_t, WS_VIMG) + ((size_t)bh * 128 + (s >> 6)) * 4096 + (s & 63) * 32;
        const bf16_t* vsrc = O + (size_t)t * 1024 + 640 + h * 64;
#pragma unroll
        for (int c = 0; c < 8; ++c) *(GAS u32x4*)(vdst + (c >> 2) * 2048 + (c & 3) * 8) = *(const GAS u32x4*)(vsrc + c * 8);
    }
}

__device__ __forceinline__ void attn_unit(Frame& F, int bh, int qb) {
    const int tid = F.tid, lane = F.lane, wid = F.wave, r32 = lane & 31, hi = lane >> 5;
    LAS unsigned char* KB = F.lds;
    LAS unsigned char* VB = F.lds + 24576;
    LAS float* wsf = (LAS float*)(F.lds + 40960) + wid * 64;
    const int b = bh >> 2, h = bh & 3;
    const bf16_t* Qp = WSP(bf16_t, WS_Q) + ((size_t)bh * SEQ + qb * 256 + wid * 32 + r32) * 96 + hi * 8;
    bf16x8 qr[6];
#pragma unroll
    for (int d0 = 0; d0 < 6; ++d0) qr[d0] = *(const GAS bf16x8*)(Qp + d0 * 16);
    const GAS u32x4* Kg = (const GAS u32x4*)(WSP(bf16_t, WS_KIMG) + (size_t)bh * 128 * 6144);
    const GAS u32x4* Vg = (const GAS u32x4*)(WSP(bf16_t, WS_VIMG) + (size_t)bh * 128 * 4096);
    const bool kx = tid < 256;
    u32x4 k0 = Kg[tid], k1 = kx ? Kg[512 + tid] : (u32x4){0u, 0u, 0u, 0u}, v0 = Vg[tid];
    u32x4 k2 = Kg[768 + tid], k3 = kx ? Kg[768 + 512 + tid] : (u32x4){0u, 0u, 0u, 0u};
    *(LAS u32x4*)(KB + tid * 16) = k0; if (kx) *(LAS u32x4*)(KB + (512 + tid) * 16) = k1; *(LAS u32x4*)(VB + tid * 16) = v0;
    *(LAS u32x4*)(KB + 12288 + tid * 16) = k2; if (kx) *(LAS u32x4*)(KB + 12288 + (512 + tid) * 16) = k3;
    __syncthreads();
    f32x16 s0, s1;
    qkt_tile<6>(s0, s1, KB, qr, r32, hi);
    __syncthreads();
    f32x16 o[2]; float lsum = 0.f;
#pragma unroll
    for (int r = 0; r < 16; ++r) { o[0][r] = 0.f; o[1][r] = 0.f; }
    float m;
    { float rm = fmaxf(fmaxf(s0[0], s1[0]), fmaxf(s0[1], s1[1]));
#pragma unroll
      for (int r = 2; r < 16; r += 2) rm = fmaxf(fmaxf(rm, s0[r]), fmaxf(s1[r], fmaxf(s0[r + 1], s1[r + 1])));
      m = fmaxf(rm, __shfl_xor(rm, 32));
#pragma unroll
      for (int r = 0; r < 16; ++r) { s0[r] -= m; s1[r] -= m; } }
    LAS const unsigned char* vbl = VB + ((lane >> 4) & 1) * 32 + (lane & 3) * 8 + (4 * hi + ((lane & 15) >> 2)) * 64;
    u32x4 kb0 = Kg[2 * 768 + tid], kb1 = kx ? Kg[2 * 768 + 512 + tid] : (u32x4){0u, 0u, 0u, 0u}, vb0 = Vg[512 + tid];
#define ATT_ITER(T, LK0, LK1, LV, WK0, WK1, WV) do { \
        const int t = (T); const int cur = t & 1; \
        const int tv = (t + 2 < 128) ? t + 2 : 127, tk = (t + 3 < 128) ? t + 3 : 127; \
        LK0 = Kg[tk * 768 + tid]; if (kx) LK1 = Kg[tk * 768 + 512 + tid]; \
        LV = Vg[tv * 512 + tid]; \
        LAS const unsigned char* Kt = KB + (cur ^ 1) * 12288 + hi * 1024 + r32 * 16; \
        bf16x8 kf[12]; \
        _Pragma("unroll") for (int d0 = 0; d0 < 6; ++d0) { kf[2 * d0] = *(const LAS bf16x8*)(Kt + d0 * 2048); kf[2 * d0 + 1] = *(const LAS bf16x8*)(Kt + d0 * 2048 + 512); } \
        _Pragma("unroll") for (int r = 0; r < 16; ++r) { s0[r] = __builtin_amdgcn_exp2f(s0[r]); s1[r] = __builtin_amdgcn_exp2f(s1[r]); } \
        { float ls_ = 0.f; _Pragma("unroll") for (int r = 0; r < 16; ++r) ls_ += s0[r] + s1[r]; lsum += ls_; } \
        bf16x8 pa[4]; pack_p(s0, s1, pa); \
        f32x16 n0, n1; { const float nm_ = -m; _Pragma("unroll") for (int r = 0; r < 16; ++r) { n0[r] = nm_; n1[r] = nm_; } } \
        n0 = MFMA32(kf[0], qr[0], n0); n1 = MFMA32(kf[1], qr[0], n1); \
        _Pragma("unroll") for (int d0 = 1; d0 < 6; ++d0) { n0 = MFMA32(kf[2 * d0], qr[d0], n0); n1 = MFMA32(kf[2 * d0 + 1], qr[d0], n1); } \
        LAS const unsigned char* vb = vbl + cur * 8192; \
        _Pragma("unroll") for (int ks = 0; ks < 4; ++ks) { \
            _Pragma("unroll") for (int d0 = 0; d0 < 2; ++d0) { \
                const s16x4 lo = vtr(vb + d0 * 4096 + ks * 1024), hh = vtr(vb + d0 * 4096 + ks * 1024 + 512); \
                const bf16x8 vf = (bf16x8){lo[0], lo[1], lo[2], lo[3], hh[0], hh[1], hh[2], hh[3]}; \
                o[d0] = MFMA32(pa[ks], vf, o[d0]); } } \
        float rm = fmaxf(fmaxf(n0[0], n1[0]), fmaxf(n0[1], n1[1])); \
        _Pragma("unroll") for (int r = 2; r < 16; r += 2) rm = fmaxf(fmaxf(rm, n0[r]), fmaxf(n1[r], fmaxf(n0[r + 1], n1[r + 1]))); \
        rm = fmaxf(rm, __shfl_xor(rm, 32)); \
        _Pragma("unroll") for (int i = 0; i < 12; ++i) { __builtin_amdgcn_sched_group_barrier(0x008, 1, 0); __builtin_amdgcn_sched_group_barrier(0x002, 7, 0); } \
        if (__any(rm > 8.0f)) { \
            const float dl = fmaxf(rm, 0.f), f = __builtin_amdgcn_exp2f(-dl); \
            m += dl; lsum *= f; \
            _Pragma("unroll") for (int r = 0; r < 16; ++r) { n0[r] -= dl; n1[r] -= dl; } \
            if (hi == 0) wsf[r32] = f; \
            LDS_WAIT(); \
            _Pragma("unroll") for (int r = 0; r < 16; ++r) { const float fr = wsf[crow(r, hi)]; o[0][r] *= fr; o[1][r] *= fr; } \
        } \
        *(LAS u32x4*)(KB + cur * 12288 + tid * 16) = WK0; if (kx) *(LAS u32x4*)(KB + cur * 12288 + (512 + tid) * 16) = WK1; \
        *(LAS u32x4*)(VB + (cur ^ 1) * 8192 + tid * 16) = WV; \
        __syncthreads(); \
        s0 = n0; s1 = n1; } while (0)
#pragma unroll 1
    for (int t2 = 0; t2 < 128; t2 += 2) {
        ATT_ITER(t2, k0, k1, v0, kb0, kb1, vb0);
        ATT_ITER(t2 + 1, kb0, kb1, vb0, k0, k1, v0);
    }
#undef ATT_ITER
    lsum += __shfl_xor(lsum, 32);
    if (hi == 0) wsf[r32] = 1.0f / lsum;
    LDS_WAIT();
    bf16_t* Y = WSP(bf16_t, WS_YATT);
#pragma unroll
    for (int r = 0; r < 16; ++r) { const float rl = wsf[crow(r, hi)]; const int q = qb * 256 + wid * 32 + crow(r, hi);
        bf16_t* yp = Y + ((size_t)b * SEQ + q) * 256 + h * 64 + r32;
        yp[0] = (bf16_t)(pk2(o[0][r] * rl, 0.f) & 0xffffu); yp[32] = (bf16_t)(pk2(o[1][r] * rl, 0.f) & 0xffffu); }
    __syncthreads();
}

#define PX(e) ((e) + ((e) >> 5))
__device__ __forceinline__ f32x2 cmul(f32x2 a, float c, float s) { return (f32x2){a.x * c - a.y * s, a.x * s + a.y * c}; }
__device__ __forceinline__ void bf4_fwd(f32x2& x0, f32x2& x1, f32x2& x2, f32x2& x3, float c1, float s1) {
    const float c2 = c1 * c1 - s1 * s1, s2 = 2.0f * c1 * s1, c3 = c2 * c1 - s2 * s1, s3 = c2 * s1 + s2 * c1;
    const f32x2 a = x0 + x2, b = x0 - x2, c = x1 + x3, d = x1 - x3;
    x0 = a + c;
    x1 = cmul((f32x2){b.x + d.y, b.y - d.x}, c1, s1);
    x2 = cmul(a - c, c2, s2);
    x3 = cmul((f32x2){b.x - d.y, b.y + d.x}, c3, s3);
}
__device__ __forceinline__ void bf4_inv(f32x2& x0, f32x2& x1, f32x2& x2, f32x2& x3, float c1, float s1) {
    const float c2 = c1 * c1 - s1 * s1, s2 = 2.0f * c1 * s1, c3 = c2 * c1 - s2 * s1, s3 = c2 * s1 + s2 * c1;
    const f32x2 t1 = cmul(x1, c1, s1), t2 = cmul(x2, c2, s2), t3 = cmul(x3, c3, s3);
    const f32x2 a = x0 + t2, b = x0 - t2, c = t1 + t3, d = t1 - t3;
    x0 = a + c; x2 = a - c;
    x1 = (f32x2){b.x - d.y, b.y + d.x};
    x3 = (f32x2){b.x + d.y, b.y - d.x};
}
template <bool INV>
__device__ __forceinline__ void fft_r4_last(LAS f32x2* X, int tid) {
#pragma unroll 2
    for (int i = 0; i < 8; ++i) { int base = 4 * (tid + 512 * i); asm volatile("" : "+v"(base));
        f32x2 x0 = X[PX(base)], x1 = X[PX(base + 1)], x2 = X[PX(base + 2)], x3 = X[PX(base + 3)];
        if (!INV) bf4_fwd(x0, x1, x2, x3, 1.0f, 0.0f); else bf4_inv(x0, x1, x2, x3, 1.0f, 0.0f);
        X[PX(base)] = x0; X[PX(base + 1)] = x1; X[PX(base + 2)] = x2; X[PX(base + 3)] = x3; }
    __syncthreads();
}
template <bool INV>
__device__ __forceinline__ void r16_core(f32x2 (&x)[16], int j, int lq, float r16, float r4) {
    const float angB = (float)j * r4;
    if (!INV) {
#pragma unroll
        for (int r = 0; r < 4; ++r) { const float ang = (float)(j + (r << lq)) * r16; bf4_fwd(x[r], x[r + 4], x[r + 8], x[r + 12], cos_rev(ang), -sin_rev(ang)); }
        const float cb = cos_rev(angB), sb = -sin_rev(angB);
#pragma unroll
        for (int k = 0; k < 4; ++k) bf4_fwd(x[4 * k], x[4 * k + 1], x[4 * k + 2], x[4 * k + 3], cb, sb);
    } else {
        const float cb = cos_rev(angB), sb = sin_rev(angB);
#pragma unroll
        for (int k = 0; k < 4; ++k) bf4_inv(x[4 * k], x[4 * k + 1], x[4 * k + 2], x[4 * k + 3], cb, sb);
#pragma unroll
        for (int r = 0; r < 4; ++r) { const float ang = (float)(j + (r << lq)) * r16; bf4_inv(x[r], x[r + 4], x[r + 8], x[r + 12], cos_rev(ang), sin_rev(ang)); }
    }
}
template <bool INV>
__device__ __forceinline__ void fft_r16_pass(LAS f32x2* X, int tid, int lq) {
    const int qp = 1 << lq;
    const float r16 = 1.0f / (float)(16 * qp), r4 = 1.0f / (float)(4 * qp);
    int u0 = tid; asm volatile("" : "+v"(u0)); int u1 = tid + 512; asm volatile("" : "+v"(u1));
    const int j0 = u0 & (qp - 1), b0 = ((u0 >> lq) << (lq + 4)) + j0, j1 = u1 & (qp - 1), b1 = ((u1 >> lq) << (lq + 4)) + j1;
    f32x2 xa[16], xb[16];
#pragma unroll
    for (int r = 0; r < 16; ++r) xa[r] = X[PX(b0 + (r << lq))];
#pragma unroll
    for (int r = 0; r < 16; ++r) xb[r] = X[PX(b1 + (r << lq))];
    r16_core<INV>(xa, j0, lq, r16, r4);
#pragma unroll
    for (int r = 0; r < 16; ++r) X[PX(b0 + (r << lq))] = xa[r];
    r16_core<INV>(xb, j1, lq, r16, r4);
#pragma unroll
    for (int r = 0; r < 16; ++r) X[PX(b1 + (r << lq))] = xb[r];
    __syncthreads();
}
template <bool INV>
__device__ __forceinline__ void fft16k(LAS f32x2* X, int tid) {
    if (!INV) { fft_r16_pass<false>(X, tid, 10); fft_r16_pass<false>(X, tid, 6); fft_r16_pass<false>(X, tid, 2); fft_r4_last<false>(X, tid); }
    else { fft_r4_last<true>(X, tid); fft_r16_pass<true>(X, tid, 2); fft_r16_pass<true>(X, tid, 6); fft_r16_pass<true>(X, tid, 10); }
}
__device__ __forceinline__ int drev4(int x) { unsigned y = __builtin_bitreverse32((unsigned)x) >> 18; return (int)(((y & 0x2AAAu) >> 1) | ((y & 0x1555u) << 1)); }
__device__ __forceinline__ float block_sum(Frame& F, float v, LAS float* red) {
    v = wave_sum(v);
    if (F.lane == 0) red[F.wave] = v;
    __syncthreads();
    float s = 0.f;
#pragma unroll
    for (int w = 0; w < NWAVES; ++w) s += red[w];
    __syncthreads();
    return s;
}
__device__ __forceinline__ void hyena_item(Frame& F, int c_in, int l) {
    int c = c_in; asm volatile("" : "+s"(c));
    const int tid = F.tid;
    LAS f32x2* X = (LAS f32x2*)F.lds;
    LAS float* red = (LAS float*)(F.lds + XTRA_OFF);
    f32x2* KF = WSP(f32x2, WS_KF) + (size_t)c * 2 * 16384;
    {
        const float* F0f = WSP(float, WS_FILT) + ((size_t)l * 1024 + c) * SEQ; const float* F0b = F0f + (size_t)256 * SEQ;
        const float* F1f = F0f + (size_t)512 * SEQ; const float* F1b = F0f + (size_t)768 * SEQ;
        float s0 = 0.f, s1 = 0.f;
#pragma unroll 1
        for (int i0 = 0; i0 < 16; i0 += 8) { float a0[8], b0[8], a1[8], b1[8];
#pragma unroll
            for (int i = 0; i < 8; ++i) { int t = tid + 512 * (i0 + i); asm volatile("" : "+v"(t)); a0[i] = F0f[t]; b0[i] = F0b[t]; a1[i] = F1f[t]; b1[i] = F1b[t]; }
#pragma unroll
            for (int i = 0; i < 8; ++i) { const int t = tid + 512 * (i0 + i); s0 += fabsf(a0[i]) + fabsf(b0[i]); s1 += fabsf(a1[i]) + fabsf(b1[i]);
                X[PX(t)] = (f32x2){a0[i], a1[i]}; X[PX(16383 - t)] = (f32x2){b0[i], b1[i]}; } }
        const float inv0 = 0.5f / block_sum(F, s0, red), inv1 = 0.5f / block_sum(F, s1, red);
        fft16k<false>(X, tid);
#pragma unroll 2
        for (int i = 0; i < 32; ++i) { int p = tid + 512 * i; asm volatile("" : "+v"(p)); const int f = drev4(p), pp = drev4((16384 - f) & 16383);
            const f32x2 w = X[PX(p)], wp = X[PX(pp)];
            KF[p] = (f32x2){(w.x + wp.x) * inv0, (w.y - wp.y) * inv0};
            KF[16384 + p] = (f32x2){(w.y + wp.y) * inv1, (wp.x - w.x) * inv1}; }
        __syncthreads();
    }
    const float* HT0 = WSP(float, WS_HYT);
    const float hb0 = INF(27)[l * 512 + c], hb1 = INF(27)[l * 512 + 256 + c];
    float zz[16][2];
    { const float* z0p = HT0 + (size_t)(0 * 768 + 512 + c) * SEQ; const float* z1p = HT0 + (size_t)(1 * 768 + 512 + c) * SEQ;
#pragma unroll
      for (int i = 0; i < 16; ++i) { zz[i][0] = z0p[tid + 512 * i]; zz[i][1] = z1p[tid + 512 * i]; }
#pragma unroll
      for (int i = 0; i < 16; ++i) { int t = tid + 512 * i; asm volatile("" : "+v"(t)); X[PX(t)] = (f32x2){zz[i][0], zz[i][1]}; X[PX(8192 + t)] = (f32x2){0.f, 0.f}; } }
    __syncthreads();
    const float invn = 1.0f / 16384.0f;
#pragma unroll 1
    for (int o = 0; o < 2; ++o) {
        const f32x2* kp = KF + o * 16384;
        f32x2 kv[16];
#pragma unroll
        for (int i = 0; i < 16; ++i) kv[i] = kp[tid + 512 * i];
        fft16k<false>(X, tid);
#pragma unroll
        for (int i = 0; i < 16; ++i) { int p = tid + 512 * i; asm volatile("" : "+v"(p)); const f32x2 v = X[PX(p)]; X[PX(p)] = (f32x2){v.x * kv[i].x - v.y * kv[i].y, v.x * kv[i].y + v.y * kv[i].x}; }
#pragma unroll
        for (int i = 0; i < 16; ++i) kv[i] = kp[tid + 512 * (16 + i)];
#pragma unroll
        for (int i = 0; i < 16; ++i) { int p = tid + 512 * (16 + i); asm volatile("" : "+v"(p)); const f32x2 v = X[PX(p)]; X[PX(p)] = (f32x2){v.x * kv[i].x - v.y * kv[i].y, v.x * kv[i].y + v.y * kv[i].x}; }
        __syncthreads();
        fft16k<true>(X, tid);
        float ga[16], gb[16];
        { const float* g0p = HT0 + (size_t)(0 * 768 + o * 256 + c) * SEQ; const float* g1p = HT0 + (size_t)(1 * 768 + o * 256 + c) * SEQ;
#pragma unroll
          for (int i = 0; i < 16; ++i) { ga[i] = g0p[tid + 512 * i]; gb[i] = g1p[tid + 512 * i]; } }
        const float hbo = o ? hb1 : hb0;
        if (o == 0) {
#pragma unroll
            for (int i = 0; i < 16; ++i) { int t = tid + 512 * i; asm volatile("" : "+v"(t)); const f32x2 y = X[PX(t)];
                zz[i][0] = ga[i] * (y.x * invn + zz[i][0] * hbo); zz[i][1] = gb[i] * (y.y * invn + zz[i][1] * hbo);
                X[PX(t)] = (f32x2){zz[i][0], zz[i][1]}; X[PX(8192 + t)] = (f32x2){0.f, 0.f}; }
            __syncthreads();
        } else {
            bf16_t* Y0 = WSP(bf16_t, WS_YHT) + (size_t)(0 * 256 + c) * SEQ; bf16_t* Y1 = WSP(bf16_t, WS_YHT) + (size_t)(1 * 256 + c) * SEQ;
#pragma unroll
            for (int i = 0; i < 16; ++i) { int t = tid + 512 * i; asm volatile("" : "+v"(t)); const f32x2 y = X[PX(t)];
                const float r0 = ga[i] * (y.x * invn + zz[i][0] * hbo), r1 = gb[i] * (y.y * invn + zz[i][1] * hbo);
                Y0[t] = (bf16_t)(pk2(r0, 0.f) & 0xffffu); Y1[t] = (bf16_t)(pk2(r1, 0.f) & 0xffffu); }
            __syncthreads();
        }
    }
}

__device__ __forceinline__ void hy_prep_tile(Frame& F, int tile, int l) {
    const int tid = F.tid, lane = F.lane, wave = F.wave;
    const int b = tile >> 7, t0 = (tile & 127) * 64;
    constexpr int RS = 1552;
    const bf16_t* U = WSP(bf16_t, WS_U);
    { u32x4 hv[13];
#pragma unroll
      for (int i = 0; i < 13; ++i) { const int idx = tid + 512 * i; const int row = idx / 96, pc = idx % 96; const int tok = t0 - 1 + row;
          hv[i] = (u32x4){0u, 0u, 0u, 0u};
          if (row < 66 && tok >= 0 && tok < SEQ) hv[i] = *(const GAS u32x4*)(U + ((size_t)b * SEQ + tok) * DINP + U_HY + pc * 8); }
#pragma unroll
      for (int i = 0; i < 13; ++i) { const int idx = tid + 512 * i; const int row = idx / 96, pc = idx % 96;
          if (row < 66) *(LAS u32x4*)(F.lds + row * RS + pc * 16) = hv[i]; } }
    __syncthreads();
    const float* cw = INF(16) + (size_t)l * 768 * 3; const float* cb = INF(17) + l * 768;
    float* HT = WSP(float, WS_HYT);
#pragma unroll 2
    for (int cp = wave; cp < 384; cp += 8) { const int ch = 2 * cp;
        const float w00 = cw[ch * 3], w01 = cw[ch * 3 + 1], w02 = cw[ch * 3 + 2], w10 = cw[ch * 3 + 3], w11 = cw[ch * 3 + 4], w12 = cw[ch * 3 + 5], b0 = cb[ch], b1 = cb[ch + 1];
        const unsigned r0 = *(const LAS unsigned*)(F.lds + lane * RS + cp * 4), r1 = *(const LAS unsigned*)(F.lds + (lane + 1) * RS + cp * 4), r2 = *(const LAS unsigned*)(F.lds + (lane + 2) * RS + cp * 4);
        HT[((size_t)(b * 768 + ch)) * SEQ + t0 + lane] = w00 * bflo(r0) + w01 * bflo(r1) + w02 * bflo(r2) + b0;
        HT[((size_t)(b * 768 + ch + 1)) * SEQ + t0 + lane] = w10 * bfhi(r0) + w11 * bfhi(r1) + w12 * bfhi(r2) + b1; }
    __syncthreads();
}

__device__ __forceinline__ void headnorm_phase(Frame& F, int l) {
    const int lane = F.lane, tid = F.tid, wave = F.wave;
    const bf16_t* U = WSP(bf16_t, WS_U); const bf16_t* YA = WSP(bf16_t, WS_YATT); const bf16_t* YH = WSP(bf16_t, WS_YHT);
    constexpr int RS2 = 528;
    const int g = wave >> 1, sub = wave & 1, cg = 4 * lane, ch = g * 256 + cg;
    const f32x4 og = *(const GAS f32x4*)(INF(29) + l * 1024 + ch);
    float scw[12];
#pragma unroll
    for (int j = 0; j < 12; ++j) scw[j] = INF(28)[(size_t)l * 768 + cg * 3 + j];
    for (int tile = F.vcu; tile < 256; tile += F.G) {
      const int tb = tile >> 7, t0 = (tile & 127) * 64;
#pragma unroll
      for (int i = 0; i < 4; ++i) { const int idx = tid + 512 * i, c = idx >> 3, p8 = idx & 7;
          const u32x4 v = *(const GAS u32x4*)(YH + ((size_t)(tb * 256 + c)) * SEQ + t0 + p8 * 8);
          LAS unsigned char* hp = F.lds + (8 * p8) * RS2 + 2 * c;
          *(LAS unsigned short*)(hp + 0 * RS2) = (unsigned short)(v.x & 0xffffu); *(LAS unsigned short*)(hp + 1 * RS2) = (unsigned short)(v.x >> 16);
          *(LAS unsigned short*)(hp + 2 * RS2) = (unsigned short)(v.y & 0xffffu); *(LAS unsigned short*)(hp + 3 * RS2) = (unsigned short)(v.y >> 16);
          *(LAS unsigned short*)(hp + 4 * RS2) = (unsigned short)(v.z & 0xffffu); *(LAS unsigned short*)(hp + 5 * RS2) = (unsigned short)(v.z >> 16);
          *(LAS unsigned short*)(hp + 6 * RS2) = (unsigned short)(v.w & 0xffffu); *(LAS unsigned short*)(hp + 7 * RS2) = (unsigned short)(v.w >> 16); }
      __syncthreads();
#pragma unroll 4
      for (int rr = 0; rr < 32; ++rr) {
        const int trow = sub * 32 + rr; const int m = tb * SEQ + t0 + trow;
        float y0, y1, y2, y3;
        if (g == 0) {
            const u32x2 ow = *(const GAS u32x2*)(U + (size_t)m * DINP + U_MLO + cg);
            const u32x2 hfw = *(const GAS u32x2*)(WSP(bf16_t, WS_HF) + (size_t)m * 256 + cg), hbw = *(const GAS u32x2*)(WSP(bf16_t, WS_HB) + (size_t)m * 256 + cg);
            const f32x4 hs = (f32x4){bflo(hfw.x) + bflo(hbw.x), bfhi(hfw.x) + bfhi(hbw.x), bflo(hfw.y) + bflo(hbw.y), bfhi(hfw.y) + bfhi(hbw.y)};
            y0 = hs.x / (1.0f + fexp(-bflo(ow.x))); y1 = hs.y / (1.0f + fexp(-bfhi(ow.x))); y2 = hs.z / (1.0f + fexp(-bflo(ow.y))); y3 = hs.w / (1.0f + fexp(-bfhi(ow.y)));
        } else if (g == 1) {
            const u32x2 w = *(const GAS u32x2*)(YA + (size_t)m * 256 + cg);
            y0 = bflo(w.x); y1 = bfhi(w.x); y2 = bflo(w.y); y3 = bfhi(w.y);
        } else if (g == 2) {
            const u32x2 w = *(const LAS u32x2*)(F.lds + trow * RS2 + cg * 2);
            y0 = bflo(w.x); y1 = bfhi(w.x); y2 = bflo(w.y); y3 = bfhi(w.y);
        } else {
            const int s = t0 + trow;
            const bf16_t* up = U + (size_t)m * DINP + U_SC + cg;
            const u32x2 bw = *(const GAS u32x2*)up;
            u32x2 c0 = {0u, 0u}, x0 = {0u, 0u}, c2 = {0u, 0u}, x2 = {0u, 0u};
            if (s > 0) { c0 = *(const GAS u32x2*)(up - DINP + 256); x0 = *(const GAS u32x2*)(up - DINP + 512); }
            const u32x2 c1 = *(const GAS u32x2*)(up + 256), x1 = *(const GAS u32x2*)(up + 512);
            if (s < SEQ - 1) { c2 = *(const GAS u32x2*)(up + DINP + 256); x2 = *(const GAS u32x2*)(up + DINP + 512); }
            y0 = bflo(bw.x) * (scw[0] * bflo(c0.x) * bflo(x0.x) + scw[1] * bflo(c1.x) * bflo(x1.x) + scw[2] * bflo(c2.x) * bflo(x2.x));
            y1 = bfhi(bw.x) * (scw[3] * bfhi(c0.x) * bfhi(x0.x) + scw[4] * bfhi(c1.x) * bfhi(x1.x) + scw[5] * bfhi(c2.x) * bfhi(x2.x));
            y2 = bflo(bw.y) * (scw[6] * bflo(c0.y) * bflo(x0.y) + scw[7] * bflo(c1.y) * bflo(x1.y) + scw[8] * bflo(c2.y) * bflo(x2.y));
            y3 = bfhi(bw.y) * (scw[9] * bfhi(c0.y) * bfhi(x0.y) + scw[10] * bfhi(c1.y) * bfhi(x1.y) + scw[11] * bfhi(c2.y) * bfhi(x2.y));
        }
        float ss = (y0 * y0 + y1 * y1) + (y2 * y2 + y3 * y3);
        ss += __shfl_xor(ss, 1); ss += __shfl_xor(ss, 2); ss += __shfl_xor(ss, 4); ss += __shfl_xor(ss, 8);
        const float rstd = __builtin_amdgcn_rsqf(ss * (1.0f / 64.0f) + EPS);
        u32x2 w; w.x = pk2(y0 * rstd * og.x, y1 * rstd * og.y); w.y = pk2(y2 * rstd * og.z, y3 * rstd * og.w);
        *(GAS u32x2*)(WSP(bf16_t, WS_YN) + (size_t)m * DM + ch) = w;
      }
      __syncthreads();
    }
}

__device__ __forceinline__ void post_mixer_phase(Frame& F, int l, const float* xin) {
    const int gw = F.vcu * NWAVES + F.wave, NGW = F.G * NWAVES, lane = F.lane, tid = F.tid;
    LAS float* RWT = (LAS float*)F.lds;
    { const GAS f32x4* src = (const GAS f32x4*)(INF(31) + (size_t)l * 1024 * 16);
      f32x4 wv[8];
#pragma unroll
      for (int q = 0; q < 8; ++q) wv[q] = src[tid + NTHR * q];
#pragma unroll
      for (int q = 0; q < 8; ++q) { const int i = tid + NTHR * q; const f32x4 w = wv[q]; const int k = i >> 2, e4 = (i & 3) * 4;
          RWT[(e4 + 0) * 1024 + k] = w.x; RWT[(e4 + 1) * 1024 + k] = w.y; RWT[(e4 + 2) * 1024 + k] = w.z; RWT[(e4 + 3) * 1024 + k] = w.w; } }
    __syncthreads();
    const float* mod = WSP(float, WS_MOD);
    for (int m0 = gw; m0 < MTOK; m0 += 2 * NGW) {
        u32x2 yw[2][4]; f32x4 xr[2][4];
#pragma unroll
        for (int r = 0; r < 2; ++r) { const int mm = (m0 + r * NGW < MTOK) ? m0 + r * NGW : m0;
            const GAS u32x2* yr = (const GAS u32x2*)(WSP(bf16_t, WS_Y2) + (size_t)mm * DM) + lane;
#pragma unroll
            for (int j = 0; j < 4; ++j) yw[r][j] = yr[64 * j];
            ld_row_f32(xin + (size_t)mm * DM, lane, xr[r]); }
#pragma unroll
        for (int r = 0; r < 2; ++r) { const int m = m0 + r * NGW; if (m >= MTOK) break;
        const int b = m >> 13, s = m & 8191; const float* md = mod + (l * 2 + b) * 6144;
        f32x4 y2[4], x[4], pg[4], g1[4];
#pragma unroll
        for (int j = 0; j < 4; ++j) { y2[j] = (f32x4){bflo(yw[r][j].x), bfhi(yw[r][j].x), bflo(yw[r][j].y), bfhi(yw[r][j].y)}; x[j] = xr[r][j]; }
        ld_row_f32(INF(6) + l * 1024, lane, pg); ld_row_f32(md + 2048, lane, g1);
        const float rstd = __builtin_amdgcn_rsqf(row_ss(y2) * (1.0f / DM) + EPS);
#pragma unroll
        for (int j = 0; j < 4; ++j) x[j] = x[j] + g1[j] * (y2[j] * rstd * pg[j]);
        st_row_bf16(WSP(bf16_t, WS_X1) + (size_t)m * DM, lane, x);
        f32x4 h[4];
        modnorm(x, INF(7) + l * 1024, md + 4096, md + 3072, lane, h);
        st_row_bf16(WSP(bf16_t, WS_XN) + (size_t)m * DM, lane, h);
        float part[16];
#pragma unroll
        for (int e = 0; e < 16; ++e) part[e] = 0.f;
#pragma unroll
        for (int j = 0; j < 4; ++j) {
#pragma unroll
            for (int e = 0; e < 16; ++e) { const f32x4 w = *(const LAS f32x4*)(RWT + e * 1024 + 4 * lane + 256 * j);
                part[e] += (h[j].x * w.x + h[j].y * w.y) + (h[j].z * w.z + h[j].w * w.w); }
            asm volatile("" ::: "memory"); }
        float a8[8], a4[4], a2[2], lg;
        { const bool up = (lane & 32) != 0;
#pragma unroll
          for (int i = 0; i < 8; ++i) { const float keep = up ? part[8 + i] : part[i], send = up ? part[i] : part[8 + i]; a8[i] = keep + __shfl_xor(send, 32); } }
        { const bool up = (lane & 16) != 0;
#pragma unroll
          for (int i = 0; i < 4; ++i) { const float keep = up ? a8[4 + i] : a8[i], send = up ? a8[i] : a8[4 + i]; a4[i] = keep + __shfl_xor(send, 16); } }
        { const bool up = (lane & 8) != 0;
#pragma unroll
          for (int i = 0; i < 2; ++i) { const float keep = up ? a4[2 + i] : a4[i], send = up ? a4[i] : a4[2 + i]; a2[i] = keep + __shfl_xor(send, 8); } }
        { const bool up = (lane & 4) != 0; const float keep = up ? a2[1] : a2[0], send = up ? a2[0] : a2[1]; lg = keep + __shfl_xor(send, 4); }
        lg += __shfl_xor(lg, 2); lg += __shfl_xor(lg, 1);
        float mx = lg;
#pragma unroll
        for (int o = 4; o < 64; o <<= 1) mx = fmaxf(mx, __shfl_xor(mx, o));
        const float ex = fexp(lg - mx); float sm = ex;
#pragma unroll
        for (int o = 4; o < 64; o <<= 1) sm += __shfl_xor(sm, o);
        if ((lane & 3) == 0) WSP(float, WS_AFF)[((size_t)b * 16 + (lane >> 2)) * SEQ + s] = ex / sm;
        if (lane < 16) WSP(int, WS_SLOT)[(size_t)m * 16 + lane] = -1;
            }
    }
    __syncthreads();
}

__device__ __forceinline__ void topk_item(Frame& F, int it) {
    const int tid = F.tid, lane = F.lane, wave = F.wave;
    const int b = it >> 4, e = it & 15;
    LAS unsigned* wcnt = (LAS unsigned*)F.lds;
    LAS unsigned* wtot = wcnt + 16;
    unsigned key[16];
    { const GAS u32x4* src = (const GAS u32x4*)(WSP(float, WS_AFF) + (size_t)it * SEQ) + tid * 4;
#pragma unroll
      for (int q = 0; q < 4; ++q) { const u32x4 v = src[q]; key[4 * q] = v.x; key[4 * q + 1] = v.y; key[4 * q + 2] = v.z; key[4 * q + 3] = v.w; } }
    unsigned T = 0u;
#pragma unroll 1
    for (int bit = 30; bit >= 0; --bit) {
        const unsigned cand = T | (1u << bit);
        unsigned c = 0u;
#pragma unroll
        for (int i = 0; i < 16; ++i) c += (key[i] >= cand) ? 1u : 0u;
#pragma unroll
        for (int o = 1; o < 64; o <<= 1) c += __shfl_xor(c, o);
        LAS unsigned* wc = wcnt + (bit & 1) * 8;
        if (lane == 0) wc[wave] = c;
        __syncthreads();
        unsigned tot = 0u;
#pragma unroll
        for (int w = 0; w < NWAVES; ++w) tot += wc[w];
        if (tot >= (unsigned)CAP) T = cand;
    }
    unsigned cg = 0u, ce = 0u;
#pragma unroll
    for (int i = 0; i < 16; ++i) { cg += (key[i] > T) ? 1u : 0u; ce += (key[i] == T) ? 1u : 0u; }
    unsigned v = cg | (ce << 16), inc = v;
#pragma unroll
    for (int o = 1; o < 64; o <<= 1) { const unsigned n = __shfl_up(inc, o); if (lane >= o) inc += n; }
    __syncthreads();
    if (lane == 63) wtot[wave] = inc;
    __syncthreads();
    unsigned off = 0u, all = 0u;
#pragma unroll
    for (int w = 0; w < NWAVES; ++w) { const unsigned tw = wtot[w]; all += tw; if (w < wave) off += tw; }
    const unsigned need = (unsigned)CAP - (all & 0xffffu);
    const unsigned excl = off + inc - v;
    unsigned ng = excl & 0xffffu, ne = excl >> 16;
    int* IDX = WSP(int, WS_IDX) + (e * 2 + b) * CAP; int* SLOT = WSP(int, WS_SLOT);
#pragma unroll
    for (int i = 0; i < 16; ++i) { const int idx = tid * 16 + i; const unsigned k = key[i];
        const bool gt = k > T, eq = k == T; const bool sel = gt || (eq && ne < need);
        if (sel) { const int slot = (int)(ng + (ne < need ? ne : need)); IDX[slot] = b * SEQ + idx; SLOT[((size_t)b * SEQ + idx) * 16 + e] = slot; }
        ng += gt ? 1u : 0u; ne += eq ? 1u : 0u; }
    __syncthreads();
}

__device__ __forceinline__ void gather_phase(Frame& F) {
    const int gw = F.vcu * NWAVES + F.wave, NGW = F.G * NWAVES, lane = F.lane;
    const int* IDX = WSP(int, WS_IDX);
    for (int r = gw; r < NEXP * 2 * CAP; r += NGW) {
        const int e = r >> 11, b = (r >> 10) & 1, j = r & 1023;
        const int tok = IDX[(b * 16 + e) * CAP + j];
        const GAS u32x4* src = (const GAS u32x4*)(WSP(bf16_t, WS_XN) + ((size_t)b * SEQ + tok) * DM);
        GAS u32x4* dst = (GAS u32x4*)(WSP(bf16_t, WS_XE) + (size_t)r * DM);
        dst[lane] = src[lane]; dst[64 + lane] = src[64 + lane];
    }
}

__device__ __forceinline__ void combine_phase(Frame& F, int l) {
    const int gw = F.vcu * NWAVES + F.wave, NGW = F.G * NWAVES, lane = F.lane;
    const float* mod = WSP(float, WS_MOD);
    const bf16_t* YE = WSP(bf16_t, WS_YE);
    f32x4 pg[4]; ld_row_f32(INF(8) + l * 1024, lane, pg);
    for (int m0 = gw; m0 < MTOK; m0 += 2 * NGW) {
        int sl[2]; float gv[2]; f32x4 x1[2][4];
#pragma unroll
        for (int r = 0; r < 2; ++r) { const int mm = (m0 + r * NGW < MTOK) ? m0 + r * NGW : m0; const int b = mm >> 13, s = mm & 8191;
            sl[r] = -1; gv[r] = 0.f;
            if (lane < 16) { sl[r] = WSP(int, WS_SLOT)[(size_t)mm * 16 + lane]; gv[r] = WSP(float, WS_AFF)[((size_t)b * 16 + lane) * SEQ + s]; }
            { const GAS u32x2* xr = (const GAS u32x2*)(WSP(bf16_t, WS_X1) + (size_t)mm * DM) + lane;
#pragma unroll
              for (int j = 0; j < 4; ++j) { const u32x2 w = xr[64 * j]; x1[r][j] = (f32x4){bflo(w.x), bfhi(w.x), bflo(w.y), bfhi(w.y)}; } } }
#pragma unroll
        for (int r = 0; r < 2; ++r) { const int m = m0 + r * NGW; if (m >= MTOK) break;
            const int b = m >> 13; const float* md = mod + (l * 2 + b) * 6144;
            f32x4 acc[4];
#pragma unroll
            for (int j = 0; j < 4; ++j) acc[j] = (f32x4){0.f, 0.f, 0.f, 0.f};
            unsigned long long msk = __ballot(sl[r] >= 0) & 0xffffull;
            while (msk) {
                const int e0 = __builtin_ctzll(msk); msk &= msk - 1;
                int e1 = -1; if (msk) { e1 = __builtin_ctzll(msk); msk &= msk - 1; }
                const int s0 = __shfl(sl[r], e0); const float g0 = __shfl(gv[r], e0);
                const int s1 = __shfl(sl[r], e1 < 0 ? e0 : e1); const float g1 = (e1 < 0) ? 0.f : __shfl(gv[r], e1 < 0 ? e0 : e1);
                const GAS u32x2* r0 = (const GAS u32x2*)(YE + ((size_t)e0 * 2048 + b * CAP + s0) * DM) + lane;
                const GAS u32x2* r1 = (const GAS u32x2*)(YE + ((size_t)(e1 < 0 ? e0 : e1) * 2048 + b * CAP + s1) * DM) + lane;
                u32x2 w0[4], w1[4];
#pragma unroll
                for (int j = 0; j < 4; ++j) { w0[j] = r0[64 * j]; w1[j] = r1[64 * j]; }
#pragma unroll
                for (int j = 0; j < 4; ++j) { acc[j] += (f32x4){bflo(w0[j].x), bfhi(w0[j].x), bflo(w0[j].y), bfhi(w0[j].y)} * g0;
                                              acc[j] += (f32x4){bflo(w1[j].x), bfhi(w1[j].x), bflo(w1[j].y), bfhi(w1[j].y)} * g1; }
            }
            f32x4 g2[4]; ld_row_f32(md + 5120, lane, g2);
            const float rstd = __builtin_amdgcn_rsqf(row_ss(acc) * (1.0f / DM) + EPS);
            f32x4 xo[4];
#pragma unroll
            for (int j = 0; j < 4; ++j) xo[j] = x1[r][j] + g2[j] * (acc[j] * rstd * pg[j]);
            st_row_f32(F.a->out + (size_t)m * DM, lane, xo);
            if (l == 0) { f32x4 h[4]; const float* md1 = mod + (1 * 2 + b) * 6144;
                modnorm(xo, INF(5) + 1024, md1 + 1024, md1, lane, h);
                st_row_bf16(WSP(bf16_t, WS_XN) + (size_t)m * DM, lane, h); }
        }
    }
}

constexpr int PH_PER_LAYER = 11, N_PHASES = 2 + 2 * PH_PER_LAYER;
__global__ void __launch_bounds__(NTHR, 2) mega_fwd(Args args) {
    extern __shared__ __attribute__((aligned(16))) unsigned char lds_raw[];
    Frame F;
    F.lds = (LAS unsigned char*)lds_raw;
    F.tid = threadIdx.x; F.lane = F.tid & 63; F.wave = __builtin_amdgcn_readfirstlane(F.tid >> 6);
    F.G = gridDim.x; { const int bx = blockIdx.x; F.vcu = (F.G % 8 == 0) ? (bx % 8) * (F.G / 8) + bx / 8 : bx; }
    F.a = &args; F.ws = args.ws;
    volatile LAS unsigned* MISC = (volatile LAS unsigned*)(F.lds + MISC_OFF);
    for (int u = F.tid; u < (LDS_BYTES - LDSCTL_OFF) / 4; u += NTHR) ((LAS unsigned*)(F.lds + LDSCTL_OFF))[u] = 0u;
    __syncthreads();
    gu32* ctl = (gu32*)(F.ws + WS_CTL);
    XcdBarrier bar; bar.bar = (unsigned*)(ctl + CW_BAR); bar.x = 0; bar.st = nullptr;
#if !MK_SPLIT
    bar = xcd_barrier_post((unsigned*)(ctl + CW_BAR), MISC + 8);
#endif
    const int lo = args.ph_lo, hi = args.ph_hi;
    int ph = 0;
#if MK_SPLIT
#define SEAM() do { } while (0)
#else
#define SEAM() do { if (ph + 1 < hi) xcd_barrier(bar); } while (0)
#endif
#ifndef PHSEL
#define PHSEL -1
#endif
#ifndef PHMASK
#define PHMASK 0x7fff
#endif
#ifndef DBL_MASK
#define DBL_MASK 0
#endif
#define PHASE_BEGIN(id) if ((PHSEL < 0 || PHSEL == (id)) && ((PHMASK >> (id)) & 1) && lo <= ph && ph < hi) for (int rep_ = 0; rep_ < (((DBL_MASK >> (id)) & 1) ? 2 : 1); ++rep_) { if (rep_) xcd_barrier(bar); { int t_ = threadIdx.x; asm volatile("" : "+v"(t_)); F.tid = t_; F.lane = t_ & 63; F.wave = __builtin_amdgcn_readfirstlane(t_ >> 6); }
#define PHASE_END   SEAM(); } ++ph;

    PHASE_BEGIN(0) p0_phase(F); PHASE_END
    PHASE_BEGIN(1) p1_phase(F); PHASE_END
#pragma unroll 1
    for (int l = 0; l < 2; ++l) {
        const float* xin = (l == 0) ? (const float*)args.in[0] : (const float*)args.out;
        PHASE_BEGIN(2) {
            pg8::Gemm g{WSP(bf16_t, WS_XN), WSP(bf16_t, WS_WIN) + (size_t)l * DINP * 1024, MTOK, DINP, 1024}; pg8::StaticOrder S; S.init(MTOK, DINP, F.G, (int)blockIdx.x);
            pg8::EpiBf16 E{WSP(bf16_t, WS_U), DINP, DINP / 256};
            pg8::gemm_phase<pg8::EpiBf16, pg8::StaticOrder, true, true>(F.lds, g, S, E, F.tid);
        } PHASE_END
        PHASE_BEGIN(3) {
#ifndef SUBSEL
#define SUBSEL 0
#endif
#ifndef REP_A
#define REP_A 1
#define REP_B 1
#define REP_C 1
#define REP_D 1
#define REP_E 1
#endif
            for (int q_ = 0; q_ < REP_A; ++q_) for (int tl = F.vcu; tl < 256; tl += F.G) hy_prep_tile(F, tl, l);
            for (int q_ = 0; q_ < REP_B; ++q_) for (int p = F.vcu; p < 512; p += F.G) ml_local_pair(F, p, l);
            for (int q_ = 0; q_ < REP_C; ++q_) mla_prep_rows(F, l);
        } PHASE_END
        PHASE_BEGIN(4) {
            pg8::Gemm g{WSP(bf16_t, WS_AMLA), WSP(bf16_t, WS_WMLA) + (size_t)l * 1024 * 384, MTOK, 1024, 384}; pg8::StaticOrder S; S.init(MTOK, 1024, F.G, (int)blockIdx.x);
            EpiMla E{WSP(bf16_t, WS_Q), WSP(bf16_t, WS_KIMG), WSP(bf16_t, WS_VIMG), (const int*)F.a->in[2], 0.10206207261596577f * LOG2E};
            pg8::gemm_phase<EpiMla, pg8::StaticOrder, true, true>(F.lds, g, S, E, F.tid);
#define REFRESH_TID() do { int t_ = threadIdx.x; asm volatile("" : "+v"(t_)); F.tid = t_; F.lane = t_ & 63; F.wave = __builtin_amdgcn_readfirstlane(t_ >> 6); } while (0)
            REFRESH_TID();
            ml_scan(F);
            REFRESH_TID();
#ifndef HY_REP
#define HY_REP 1
#endif
            for (int rep2_ = 0; rep2_ < HY_REP; ++rep2_) for (int c = F.vcu; c < 256; c += F.G) hyena_item(F, c, l);
        } PHASE_END
        PHASE_BEGIN(5) {
            for (int q_ = 0; q_ < REP_D; ++q_) for (int u = F.vcu; u < 256; u += F.G) attn_unit(F, u >> 5, u & 31);
            for (int q_ = 0; q_ < REP_E; ++q_) for (int p = F.vcu; p < 512; p += F.G) ml_out_pair(F, p, l);
        } PHASE_END
        PHASE_BEGIN(6) headnorm_phase(F, l); PHASE_END
        PHASE_BEGIN(7) {
            pg8::Gemm g{WSP(bf16_t, WS_YN), WSP(bf16_t, WS_WOUT) + (size_t)l * 1024 * 1024, MTOK, 1024, 1024}; pg8::StaticOrder S; S.init(MTOK, 1024, F.G, (int)blockIdx.x);
            pg8::EpiBf16 E{WSP(bf16_t, WS_Y2), 1024, 4};
            pg8::gemm_phase<pg8::EpiBf16, pg8::StaticOrder, true, true>(F.lds, g, S, E, F.tid);
        } PHASE_END
        PHASE_BEGIN(8) post_mixer_phase(F, l, xin); PHASE_END
        PHASE_BEGIN(9) { for (int it = F.vcu; it < 32; it += F.G) topk_item(F, it); } PHASE_END
        PHASE_BEGIN(10) {
            pg8::Gemm g{WSP(bf16_t, WS_XN), WSP(bf16_t, WS_WGU) + (size_t)l * NEXP * 4096 * 1024, NEXP * 2048, NEXP * 4096, 1024, WSP(int, WS_IDX)}; pg8::GroupedOrder S; S.init(16, F.G, (int)blockIdx.x);
            pg8::EpiSwiGLU E{WSP(bf16_t, WS_ACT), EFF};
            pg8::gemm_phase<pg8::EpiSwiGLU, pg8::GroupedOrder, true, true, true>(F.lds, g, S, E, F.tid);
        } PHASE_END
        PHASE_BEGIN(11) {
            pg8::Gemm g{WSP(bf16_t, WS_ACT), WSP(bf16_t, WS_WDN) + (size_t)l * NEXP * 1024 * 2048, NEXP * 2048, NEXP * 1024, 2048}; pg8::GroupedOrder S; S.init(4, F.G, (int)blockIdx.x);
            pg8::EpiBf16 E{WSP(bf16_t, WS_YE), 1024, 4};
            pg8::gemm_phase<pg8::EpiBf16, pg8::GroupedOrder, true, true>(F.lds, g, S, E, F.tid);
        } PHASE_END
        PHASE_BEGIN(12) combine_phase(F, l); PHASE_END
    }
}

extern "C" void kernel_launch(void* const* d_in, const int* in_sizes, int n_in, void* d_out, int out_size, void* d_ws, size_t ws_size, hipStream_t stream) {
    static int grid = 0;
    if (grid == 0) {
        if (n_in != 35 || out_size != MTOK * DM || ws_size < WS_END) { fprintf(stderr, "kernel_launch: unexpected shapes: n_in %d out %d ws %zu (need %zu)\n", n_in, out_size, ws_size, (size_t)WS_END); grid = -1; return; }
        int dev = 0, cus = 0, per_cu = 0;
        if (hipGetDevice(&dev) != hipSuccess || hipDeviceGetAttribute(&cus, hipDeviceAttributeMultiprocessorCount, dev) != hipSuccess) { grid = -1; return; }
        if (hipFuncSetAttribute((const void*)mega_fwd, hipFuncAttributeMaxDynamicSharedMemorySize, LDS_BYTES) != hipSuccess) { fprintf(stderr, "kernel_launch: hipFuncSetAttribute failed\n"); grid = -1; return; }
        (void)hipOccupancyMaxActiveBlocksPerMultiprocessor(&per_cu, (const void*)mega_fwd, NTHR, LDS_BYTES);
        (void)hipGetLastError();
        grid = cus > 0 ? cus : 256;
        if (per_cu < 1) fprintf(stderr, "kernel_launch: occupancy query reports %d\n", per_cu);
    }
    if (grid < 0) return;
    (void)hipMemsetAsync((char*)d_ws + WS_CTL, 0, CTL_ZERO_BYTES, stream);
    Args a{};
    for (int i = 0; i < 35; ++i) a.in[i] = d_in[i];
    a.out = (float*)d_out; a.ws = (unsigned char*)d_ws;
#if MK_SPLIT
    for (int p = 0; p < N_PHASES; ++p) { a.ph_lo = p; a.ph_hi = p + 1; hipLaunchKernelGGL(mega_fwd, dim3(grid), dim3(NTHR), LDS_BYTES, stream, a); }
#else
    a.ph_lo = 0; a.ph_hi = N_PHASES;
    hipLaunchKernelGGL(mega_fwd, dim3(grid), dim3(NTHR), LDS_BYTES, stream, a);
#endif
}
```

```cpp
#include <hip/hip_runtime.h>
#include <cstdio>
#include <cstdint>

#ifndef MK_SPLIT
#define MK_SPLIT 0
#endif

#define GAS __attribute__((address_space(1)))
#define LAS __attribute__((address_space(3)))
typedef GAS unsigned gu32;
#define RLX_AGENT __ATOMIC_RELAXED, __HIP_MEMORY_SCOPE_AGENT
typedef unsigned short bf16_t;
typedef short bf16x8 __attribute__((ext_vector_type(8)));
typedef short s16x4 __attribute__((ext_vector_type(4)));
typedef float f32x4 __attribute__((ext_vector_type(4)));
typedef float f32x2 __attribute__((ext_vector_type(2)));
typedef float f32x16 __attribute__((ext_vector_type(16)));
typedef unsigned u32x4 __attribute__((ext_vector_type(4)));
typedef unsigned u32x2 __attribute__((ext_vector_type(2)));
typedef __bf16 bf16x2_t __attribute__((ext_vector_type(2)));

namespace pg8 {
#define PG8_LAS __attribute__((address_space(3)))
constexpr int BM = 256, BK = 64, HALF = 128, HTB = HALF * BK * 2, STAGE_BYTES = 8 * HTB, NXCD = 8, WGM = 8;
__host__ __device__ __forceinline__ int lds_byte(int r, int c) { const int st = (r >> 4) * 2 + (c >> 5), rr = r & 15, cc = c & 31, ob = rr * 64 + cc * 2; return st * 1024 + (ob ^ (((ob >> 9) & 1) << 5)); }
__host__ __device__ __forceinline__ void stage_rc(int b, int& R, int& C) { const int st = b / 1024, sb = b % 1024, swz = sb ^ (((sb >> 9) & 1) << 5); R = (st >> 1) * 16 + swz / 64; C = (st & 1) * 32 + (swz % 64) / 2; }
__host__ __device__ __forceinline__ int perm32(int rho) { const int n = rho >> 4, i = rho & 15; return 8 * (i >> 2) + 4 * n + (i & 3); }
struct Unit { int pm, pn; };
struct Gemm { const bf16_t* A; const bf16_t* Bt; int M, N, K; const int* rowidx; int lda, ldb; };
struct StaticOrder {
    int nM, nN, nwg, G, c;
    __host__ __device__ void init(int M, int N, int G_, int c_) { nM = M / BM; nN = N / BM; nwg = nM * nN; G = G_; c = c_; }
    __host__ __device__ bool next(int i, Unit& u) const {
        const long L = (long)i * G + c; if (L >= nwg) return false;
        int wgid = (int)L; { const int q = nwg / NXCD, r = nwg % NXCD, xcd = wgid % NXCD, off = wgid / NXCD; wgid = (xcd < r ? xcd * (q + 1) : r * (q + 1) + (xcd - r) * q) + off; }
        const int nig = WGM * nN, gid = wgid / nig, fm = gid * WGM, gsz = (nM - fm) < WGM ? (nM - fm) : WGM;
        u.pm = fm + ((wgid % nig) % gsz); u.pn = (wgid % nig) / gsz; return true;
    }
    __device__ __forceinline__ void a_ready(const Unit&) const {}
    __device__ __forceinline__ void done(const Unit&) const {}
};
struct GroupedOrder {
    int nNl, total, G, c;
    __host__ __device__ void init(int nNl_, int G_, int c_) { nNl = nNl_; total = 16 * 8 * nNl_; G = G_; c = c_; }
    __host__ __device__ bool next(int i, Unit& u) const {
        const long L = (long)i * G + c; if (L >= total) return false;
        if (G == 256 && (nNl == 16 || nNl == 4)) {
            const int x = c & 7, w = c >> 3;
            if (nNl == 16) { const int e = 2 * i + (w >> 4), q = w & 15; u.pm = e * 8 + 4 * (x & 1) + (q & 3); u.pn = e * 16 + 4 * (x >> 1) + (q >> 2); }
            else { const int e = 8 * i + x; u.pm = e * 8 + (w & 7); u.pn = e * 4 + (w >> 3); }
            return true;
        }
        const int per_e = 8 * nNl, e = (int)L / per_e, r = (int)L % per_e;
        u.pm = e * 8 + (r % 8); u.pn = e * nNl + (r / 8); return true;
    }
    __device__ __forceinline__ void a_ready(const Unit&) const {}
    __device__ __forceinline__ void done(const Unit&) const {}
};
__device__ __forceinline__ unsigned cvt_pk_bf16(float lo, float hi) { f32x2 v = {lo, hi}; bf16x2_t b = __builtin_convertvector(v, bf16x2_t); return __builtin_bit_cast(unsigned, b); }

struct EpiBf16 {
    static constexpr bool PERM = true, AFTER_DRAIN = false;
    bf16_t* O; int ldc; int ntn;
    __device__ __forceinline__ void operator()(const f32x4 (&acc)[2][2][4][2], const Unit& u, int wr, int wc, int fr, int fq) const {
        const int row0 = u.pm * BM + wr * 64 + fr; const int colt = (u.pn % ntn) * BM;
        const int col0 = colt + wc * 32 + 8 * fq;
#pragma unroll
        for (int ai = 0; ai < 2; ++ai)
#pragma unroll
            for (int m = 0; m < 4; ++m) { bf16_t* rowp = O + (size_t)(row0 + ai * HALF + m * 16) * ldc + col0;
#pragma unroll
                for (int bj = 0; bj < 2; ++bj) { const f32x4 v0 = acc[ai][bj][m][0], v1 = acc[ai][bj][m][1];
                    u32x4 w; w.x = cvt_pk_bf16(v0[0], v0[1]); w.y = cvt_pk_bf16(v0[2], v0[3]); w.z = cvt_pk_bf16(v1[0], v1[1]); w.w = cvt_pk_bf16(v1[2], v1[3]);
                    *(u32x4*)(rowp + bj * HALF) = w; } }
    }
};
struct EpiF32 {
    static constexpr bool PERM = false, AFTER_DRAIN = false;
    float* O; int ldc;
    __device__ __forceinline__ void operator()(const f32x4 (&acc)[2][2][4][2], const Unit& u, int wr, int wc, int fr, int fq) const {
        const int col0 = u.pn * BM + wc * 32 + 4 * fq;
#pragma unroll
        for (int ai = 0; ai < 2; ++ai)
#pragma unroll
            for (int m = 0; m < 4; ++m) { float* rowp = O + (size_t)(u.pm * BM + ai * HALF + wr * 64 + m * 16 + fr) * ldc + col0;
#pragma unroll
                for (int bj = 0; bj < 2; ++bj)
#pragma unroll
                    for (int n = 0; n < 2; ++n) *(f32x4*)(rowp + bj * HALF + n * 16) = acc[ai][bj][m][n]; }
    }
};
__device__ __forceinline__ float silu_f(float a) { return a * __builtin_amdgcn_rcpf(1.0f + __builtin_amdgcn_exp2f(-1.4426950408889634f * a)); }
struct EpiSwiGLU {
    static constexpr bool PERM = true, AFTER_DRAIN = false;
    bf16_t* O; int ldc;
    __device__ __forceinline__ void operator()(const f32x4 (&acc)[2][2][4][2], const Unit& u, int wr, int wc, int fr, int fq) const {
        const int row0 = u.pm * BM + wr * 64 + fr; const int col0 = (u.pn % 16) * HALF + wc * 32 + 8 * fq;
#pragma unroll
        for (int ai = 0; ai < 2; ++ai)
#pragma unroll
            for (int m = 0; m < 4; ++m) { bf16_t* rowp = O + (size_t)(row0 + ai * HALF + m * 16) * ldc + col0;
                const f32x4 g0 = acc[ai][0][m][0], g1 = acc[ai][0][m][1], u0 = acc[ai][1][m][0], u1 = acc[ai][1][m][1];
                u32x4 w;
                w.x = cvt_pk_bf16(silu_f(g0[0]) * u0[0], silu_f(g0[1]) * u0[1]); w.y = cvt_pk_bf16(silu_f(g0[2]) * u0[2], silu_f(g0[3]) * u0[3]);
                w.z = cvt_pk_bf16(silu_f(g1[0]) * u1[0], silu_f(g1[1]) * u1[1]); w.w = cvt_pk_bf16(silu_f(g1[2]) * u1[2], silu_f(g1[3]) * u1[3]);
                *(u32x4*)rowp = w; }
    }
};

template <class Epi, class Sched, bool ALIGN_EPI = false, bool SP2 = false, bool GATHER = false>
__device__ __forceinline__ void gemm_phase(PG8_LAS unsigned char* lds, const Gemm g, const Sched& S, const Epi& E, const int tid) {
    const int wid = __builtin_amdgcn_readfirstlane(tid >> 6), lane = tid & 63, wr = wid >> 2, wc = wid & 3, fr = lane & 15, fq = lane >> 4;
    int K_ = g.K; asm volatile("" : "+s"(K_));
    const int K = K_, nt = K / BK;
    const int lda = g.lda ? g.lda : K, ldb = g.ldb ? g.ldb : K;
    unsigned voffA[2], voffB[2];
#pragma unroll
    for (int i = 0; i < 2; ++i) { int R, C; stage_rc(tid * 16 + i * 8192, R, C); const int Rb = Epi::PERM ? ((R & ~31) + perm32(R & 31)) : R;
        voffA[i] = (unsigned)(R * lda + C) * 2u; voffB[i] = (unsigned)(Rb * ldb + C) * 2u; }
    const size_t kstep = (size_t)(BK * 2);
    const size_t hstepA = (size_t)HALF * lda * 2, hstepB = (size_t)HALF * ldb * 2;
    const size_t tstepA = 2 * hstepA, tstepB = 2 * hstepB;
    const unsigned ldsw = (unsigned)wid * 1024u;
    const int aoff = lds_byte(wr * 64 + fr, fq * 8), boff = lds_byte(wc * 32 + fr, fq * 8);
#define PG8_SA(b, h) (((b) * 2 + (h)) * HTB)
#define PG8_SB(b, h) ((4 + (b) * 2 + (h)) * HTB)
#define PG8_STAGE(bufoff, gbase, voff) do { _Pragma("unroll") for (int _i = 0; _i < 2; ++_i) \
        __builtin_amdgcn_global_load_lds((const unsigned*)((const char*)(gbase) + (voff)[_i]), (PG8_LAS unsigned*)(lds + (bufoff) + ldsw + _i * 8192), 16, 0, 0); } while (0)
#define PG8_LDA(dst, b, h) do { _Pragma("unroll") for (int m = 0; m < 4; ++m) _Pragma("unroll") for (int k = 0; k < 2; ++k) dst[m][k] = *(const PG8_LAS bf16x8*)(lds + PG8_SA(b, h) + aoff + m * 2048 + k * 1024); } while (0)
#define PG8_LDB(dst, b, h) do { _Pragma("unroll") for (int n = 0; n < 2; ++n) _Pragma("unroll") for (int k = 0; k < 2; ++k) dst[n][k] = *(const PG8_LAS bf16x8*)(lds + PG8_SB(b, h) + boff + n * 2048 + k * 1024); } while (0)
#define PG8_MMA(ai, bj, At, Bt) do { __builtin_amdgcn_s_setprio(1); _Pragma("unroll") for (int m = 0; m < 4; ++m) _Pragma("unroll") for (int n = 0; n < 2; ++n) _Pragma("unroll") for (int k = 0; k < 2; ++k) \
        acc[ai][bj][m][n] = __builtin_amdgcn_mfma_f32_16x16x32_bf16(Bt[n][k], At[m][k], acc[ai][bj][m][n], 0, 0, 0); __builtin_amdgcn_s_setprio(0); } while (0)
#define PG8_WAIT_V(n) asm volatile("s_waitcnt vmcnt(" #n ")" ::: "memory")
#define PG8_WAIT_L(n) asm volatile("s_waitcnt lgkmcnt(" #n ")" ::: "memory")
#define PG8_BAR __builtin_amdgcn_s_barrier()
#define PG8_SCHED __builtin_amdgcn_sched_barrier(0)
    Unit cur, nxt; int ui = 0;
    if (!S.next(0, cur)) return;
    f32x4 acc[2][2][4][2];
#pragma unroll
    for (int a = 0; a < 2; ++a)
#pragma unroll
        for (int b = 0; b < 2; ++b)
#pragma unroll
            for (int m = 0; m < 4; ++m)
#pragma unroll
                for (int n = 0; n < 2; ++n) acc[a][b][m][n] = (f32x4){0.f, 0.f, 0.f, 0.f};
    bf16x8 At[4][2], B0[2][2], B1[2][2];
    const char* cA = GATHER ? (const char*)g.A : (const char*)g.A + (size_t)cur.pm * tstepA; const char* cB = (const char*)g.Bt + (size_t)cur.pn * tstepB;
    unsigned gc0[2] = {0u, 0u}, gc1[2] = {0u, 0u}, gn0[2] = {0u, 0u}, gn1[2] = {0u, 0u}; int gR[2] = {0, 0}; unsigned gC[2] = {0u, 0u};
    if constexpr (GATHER) {
#pragma unroll
        for (int i = 0; i < 2; ++i) { int R, C; stage_rc(tid * 16 + i * 8192, R, C); gR[i] = R; gC[i] = (unsigned)C * 2u;
            gc0[i] = (unsigned)g.rowidx[cur.pm * BM + R] * (unsigned)(lda * 2) + gC[i]; gc1[i] = (unsigned)g.rowidx[cur.pm * BM + HALF + R] * (unsigned)(lda * 2) + gC[i]; }
    }
#define PG8_STAGE_A(bufoff, base, half, o0, o1) do { if constexpr (GATHER) { if ((half) == 0) PG8_STAGE(bufoff, base, o0); else PG8_STAGE(bufoff, base, o1); } \
        else PG8_STAGE(bufoff, (base) + ((half) ? hstepA : 0), voffA); } while (0)
    S.a_ready(cur);
    if constexpr (SP2) {
        PG8_STAGE(PG8_SB(0, 0), cB, voffB); PG8_STAGE(PG8_SB(0, 1), cB + hstepB, voffB); PG8_STAGE_A(PG8_SA(0, 0), cA, 0, gc0, gc1); PG8_STAGE_A(PG8_SA(0, 1), cA, 1, gc0, gc1);
        if (wr == 1) PG8_BAR;
        PG8_WAIT_V(2); PG8_BAR;
        PG8_STAGE(PG8_SB(1, 0), cB + kstep, voffB); PG8_STAGE_A(PG8_SA(1, 0), cA + kstep, 0, gc0, gc1); PG8_STAGE(PG8_SB(1, 1), cB + hstepB + kstep, voffB);
        PG8_WAIT_V(6); PG8_BAR;
    } else {
        PG8_STAGE(PG8_SB(0, 0), cB, voffB); PG8_STAGE(PG8_SA(0, 0), cA, voffA); PG8_STAGE(PG8_SB(0, 1), cB + hstepB, voffB); PG8_STAGE(PG8_SA(0, 1), cA + hstepA, voffA);
        if (wr == 1) PG8_BAR;
        PG8_WAIT_V(4); PG8_BAR;
        PG8_STAGE(PG8_SB(1, 0), cB + kstep, voffB); PG8_STAGE(PG8_SA(1, 0), cA + kstep, voffA); PG8_STAGE(PG8_SB(1, 1), cB + hstepB + kstep, voffB);
        PG8_WAIT_V(6); PG8_BAR;
    }
    for (;;) {
        const bool has_next = S.next(ui + 1, nxt);
        const char* nA = GATHER ? cA : (has_next ? (const char*)g.A + (size_t)nxt.pm * tstepA : cA); const char* nB = has_next ? (const char*)g.Bt + (size_t)nxt.pn * tstepB : cB;
        if constexpr (GATHER) { const int npm = has_next ? nxt.pm : cur.pm;
#pragma unroll
            for (int i = 0; i < 2; ++i) { gn0[i] = (unsigned)g.rowidx[npm * BM + gR[i]] * (unsigned)(lda * 2) + gC[i]; gn1[i] = (unsigned)g.rowidx[npm * BM + HALF + gR[i]] * (unsigned)(lda * 2) + gC[i]; } }
        for (int t = 0; t < nt; t += 2) {
            const bool last = (t == nt - 2);
            const char* a1 = cA + (size_t)(t + 1) * kstep;
            const char* a2 = last ? nA : cA + (size_t)(t + 2) * kstep; const char* b2 = last ? nB : cB + (size_t)(t + 2) * kstep;
            const char* a3 = a2 + kstep; const char* b3 = b2 + kstep;
            if (last && has_next) S.a_ready(nxt);
            if constexpr (SP2) {
            unsigned gs0[2], gs1[2];
#pragma unroll
            for (int i = 0; i < 2; ++i) { gs0[i] = last ? gn0[i] : gc0[i]; gs1[i] = last ? gn1[i] : gc1[i]; }
            PG8_LDB(B0, 0, 0); PG8_LDB(B1, 0, 1); PG8_SCHED; PG8_LDA(At, 0, 0); PG8_STAGE_A(PG8_SA(1, 1), a1, 1, gc0, gc1);
            PG8_WAIT_V(8); PG8_WAIT_L(0); PG8_BAR; PG8_MMA(0, 0, At, B0); PG8_MMA(0, 1, At, B1); PG8_BAR; PG8_SCHED;
            PG8_LDA(At, 0, 1); PG8_STAGE(PG8_SB(0, 0), b2, voffB); PG8_STAGE(PG8_SB(0, 1), b2 + hstepB, voffB); PG8_STAGE_A(PG8_SA(0, 0), a2, 0, gs0, gs1);
            PG8_WAIT_V(8); PG8_WAIT_L(0); PG8_BAR; PG8_MMA(1, 0, At, B0); PG8_MMA(1, 1, At, B1); PG8_BAR; PG8_SCHED;
            PG8_LDB(B0, 1, 0); PG8_LDB(B1, 1, 1); PG8_SCHED; PG8_LDA(At, 1, 0); PG8_STAGE_A(PG8_SA(0, 1), a2, 1, gs0, gs1);
            PG8_WAIT_V(8); PG8_WAIT_L(0); PG8_BAR; PG8_MMA(0, 0, At, B0); PG8_MMA(0, 1, At, B1); PG8_BAR; PG8_SCHED;
            PG8_LDA(At, 1, 1); PG8_STAGE(PG8_SB(1, 0), b3, voffB); PG8_STAGE(PG8_SB(1, 1), b3 + hstepB, voffB); PG8_STAGE_A(PG8_SA(1, 0), a3, 0, gs0, gs1);
            PG8_WAIT_V(8); PG8_WAIT_L(0); PG8_BAR; PG8_MMA(1, 0, At, B0); PG8_MMA(1, 1, At, B1); PG8_BAR; PG8_SCHED;
            } else {
            PG8_LDB(B0, 0, 0); PG8_SCHED; PG8_LDA(At, 0, 0); PG8_STAGE(PG8_SA(1, 1), a1 + hstepA, voffA);
            PG8_WAIT_L(8); PG8_BAR; PG8_WAIT_L(0); PG8_MMA(0, 0, At, B0); PG8_BAR; PG8_SCHED;
            PG8_LDB(B1, 0, 1); PG8_STAGE(PG8_SB(0, 0), b2, voffB);
            PG8_BAR; PG8_WAIT_L(0); PG8_MMA(0, 1, At, B1); PG8_BAR;
            PG8_LDA(At, 0, 1); PG8_STAGE(PG8_SA(0, 0), a2, voffA);
            PG8_BAR; PG8_WAIT_L(0); PG8_MMA(1, 0, At, B0); PG8_BAR; PG8_SCHED;
            PG8_STAGE(PG8_SB(0, 1), b2 + hstepB, voffB);
            PG8_WAIT_V(6); PG8_BAR; PG8_MMA(1, 1, At, B1); PG8_BAR;
            PG8_LDB(B0, 1, 0); PG8_SCHED; PG8_LDA(At, 1, 0); PG8_STAGE(PG8_SA(0, 1), a2 + hstepA, voffA);
            PG8_WAIT_L(8); PG8_BAR; PG8_WAIT_L(0); PG8_MMA(0, 0, At, B0); PG8_BAR; PG8_SCHED;
            PG8_LDB(B1, 1, 1); PG8_STAGE(PG8_SB(1, 0), b3, voffB);
            PG8_BAR; PG8_WAIT_L(0); PG8_MMA(0, 1, At, B1); PG8_BAR;
            PG8_LDA(At, 1, 1); PG8_STAGE(PG8_SA(1, 0), a3, voffA);
            PG8_BAR; PG8_WAIT_L(0); PG8_MMA(1, 0, At, B0); PG8_BAR; PG8_SCHED;
            PG8_STAGE(PG8_SB(1, 1), b3 + hstepB, voffB);
            PG8_WAIT_V(6); PG8_BAR; PG8_MMA(1, 1, At, B1); PG8_BAR;
            }
        }
        if constexpr (ALIGN_EPI) { if (wr == 0) PG8_BAR; }
        if constexpr (!Epi::AFTER_DRAIN) { E(acc, cur, wr, wc, fr, fq); S.done(cur); }
        if (!has_next) break;
#pragma unroll
        for (int a = 0; a < 2; ++a)
#pragma unroll
            for (int b = 0; b < 2; ++b)
#pragma unroll
                for (int m = 0; m < 4; ++m)
#pragma unroll
                    for (int n = 0; n < 2; ++n) acc[a][b][m][n] = (f32x4){0.f, 0.f, 0.f, 0.f};
        cur = nxt; cA = nA; cB = nB; ++ui;
        if constexpr (GATHER) { gc0[0] = gn0[0]; gc0[1] = gn0[1]; gc1[0] = gn1[0]; gc1[1] = gn1[1]; }
        if constexpr (ALIGN_EPI) { if (wr == 1) PG8_BAR; }
    }
    PG8_WAIT_V(0);
    if constexpr (!ALIGN_EPI) { if (wr == 0) PG8_BAR; }
    PG8_BAR;
#undef PG8_SA
#undef PG8_SB
#undef PG8_STAGE
#undef PG8_STAGE_A
#undef PG8_LDA
#undef PG8_LDB
#undef PG8_MMA
#undef PG8_WAIT_V
#undef PG8_WAIT_L
#undef PG8_BAR
#undef PG8_SCHED
}
}

__device__ __forceinline__ double rope_kd(int i) {
    switch (i) { case 0: return 0.15915494309189535; case 1: return 0.08949940160889101; case 2: return 0.050329212104487035; case 3: return 0.0283021958306234;
        case 4: return 0.015915494309189534; case 5: return 0.008949940160889102; case 6: return 0.005032921210448704; case 7: return 0.00283021958306234;
        case 8: return 0.0015915494309189536; case 9: return 0.0008949940160889102; case 10: return 0.0005032921210448703; case 11: return 0.00028302195830623395;
        case 12: return 0.00015915494309189535; case 13: return 8.949940160889102e-05; case 14: return 5.0329212104487035e-05; default: return 2.8302195830623396e-05; }
}
__device__ __forceinline__ float rope_frac(int p, int i) {
    const double kd = rope_kd(i); const float kh = (float)kd, kl = (float)(kd - (double)kh), pf = (float)p;
    const float r1 = pf * kh, e1 = __builtin_fmaf(pf, kh, -r1) + pf * kl;
    float fr = (r1 - __builtin_floorf(r1)) + e1;
    return fr - __builtin_floorf(fr);
}
struct EpiMla {
    static constexpr bool PERM = true, AFTER_DRAIN = false;
    bf16_t* Q; bf16_t* KI; bf16_t* VI; const int* pos; float qscale;
    __device__ __forceinline__ void operator()(const f32x4 (&acc)[2][2][4][2], const pg8::Unit& u, int wr, int wc, int fr, int fq) const {
        const int tile = u.pn & 3;
#pragma unroll
        for (int ai = 0; ai < 2; ++ai)
#pragma unroll
            for (int m = 0; m < 4; ++m) {
                int t = u.pm * 256 + ai * 128 + wr * 64 + m * 16 + fr; asm volatile("" : "+v"(t)); const int b = t >> 13, sq = t & 8191;
                if (tile == 1) {
                    const int p = pos[t]; const float sgn = (fq < 2) ? -1.0f : 1.0f;
                    u32x4 w;
#pragma unroll
                    for (int n = 0; n < 2; ++n) { const f32x4 vv = acc[ai][0][m][n]; float o4[4];
#pragma unroll
                        for (int j = 0; j < 4; ++j) { const float own = vv[j], oth = __shfl_xor(own, 32);
                            const float rr = (fq & 1) ? rope_frac(p, 8 + 4 * n + j) : rope_frac(p, 4 * n + j), c = __builtin_amdgcn_cosf(rr), sn = __builtin_amdgcn_sinf(rr);
                            o4[j] = (own * c + sgn * oth * sn) * qscale; }
                        if (n == 0) { w.x = pg8::cvt_pk_bf16(o4[0], o4[1]); w.y = pg8::cvt_pk_bf16(o4[2], o4[3]); } else { w.z = pg8::cvt_pk_bf16(o4[0], o4[1]); w.w = pg8::cvt_pk_bf16(o4[2], o4[3]); }
                        asm volatile("" ::: "memory"); }
                    *(u32x4*)(Q + ((size_t)(b * 4 + wc) * 8192 + sq) * 96 + 64 + 8 * fq) = w;
                    asm volatile("" ::: "memory");
                } else {
#pragma unroll
                    for (int bj = 0; bj < 2; ++bj) { const f32x4 v0 = acc[ai][bj][m][0], v1 = acc[ai][bj][m][1];
                        const int h = 2 * bj + (wc >> 1), bh = b * 4 + h;
                        if (tile == 0) { u32x4 w; w.x = pg8::cvt_pk_bf16(v0[0] * qscale, v0[1] * qscale); w.y = pg8::cvt_pk_bf16(v0[2] * qscale, v0[3] * qscale); w.z = pg8::cvt_pk_bf16(v1[0] * qscale, v1[1] * qscale); w.w = pg8::cvt_pk_bf16(v1[2] * qscale, v1[3] * qscale);
                            *(u32x4*)(Q + ((size_t)bh * 8192 + sq) * 96 + 32 * (wc & 1) + 8 * fq) = w; }
                        else { u32x4 w; w.x = pg8::cvt_pk_bf16(v0[0], v0[1]); w.y = pg8::cvt_pk_bf16(v0[2], v0[3]); w.z = pg8::cvt_pk_bf16(v1[0], v1[1]); w.w = pg8::cvt_pk_bf16(v1[2], v1[3]);
                            if (tile == 2) *(u32x4*)(KI + ((size_t)bh * 128 + (sq >> 6)) * 6144 + (4 * (wc & 1) + fq) * 512 + (sq & 63) * 8) = w;
                            else *(u32x4*)(VI + ((size_t)bh * 128 + (sq >> 6)) * 4096 + (wc & 1) * 2048 + (sq & 63) * 32 + 8 * fq) = w; } }
                }
            }
    }
};

constexpr int NWAVES = 8, NTHR = 512;
constexpr int BATCH = 2, SEQ = 8192, DM = 1024, MTOK = BATCH * SEQ;
constexpr int DIN = 2960, DINP = 3072;
constexpr int NEXP = 16, CAP = 1024, EFF = 2048;
constexpr int LDFF = EFF + 64;
constexpr float EPS = 1e-6f;
constexpr int U_MLQ = 0, U_MLK = 256, U_MLV = 512, U_MLO = 768, U_MLG = 1024, U_CQ = 1040, U_CKV = 1264, U_KR = 1392, U_HY = 1424, U_SC = 2192;
constexpr float LOG2E = 1.4426950408889634f;

constexpr size_t MiB = 1u << 20;
constexpr size_t WS_CTL = 0, CTL_ZERO_BYTES = 1 * MiB;
constexpr size_t WS_MOD = 1 * MiB;
constexpr size_t WS_MLS = 1 * MiB + 128 * 1024;
constexpr size_t WS_MLN = 1 * MiB + 256 * 1024;
constexpr size_t WS_AFF = 2 * MiB;
constexpr size_t WS_SLOT = 3 * MiB;
constexpr size_t WS_IDX = 4 * MiB;
constexpr size_t WS_HID = 5 * MiB;
constexpr size_t WS_W3T = 7 * MiB;
constexpr size_t WS_WMLA = 9 * MiB;
constexpr size_t WS_WOUT = 11 * MiB;
constexpr size_t WS_WIN = 15 * MiB;
constexpr size_t WS_WGU = 28 * MiB;
constexpr size_t WS_WDN = 284 * MiB;
constexpr size_t WS_XN = 616 * MiB;
constexpr size_t WS_AMLA = 444 * MiB;
constexpr size_t WS_Q = 456 * MiB;
constexpr size_t WS_KIMG = 468 * MiB;
constexpr size_t WS_VIMG = 480 * MiB;
constexpr size_t WS_MLC = 488 * MiB;
constexpr size_t WS_HF = 504 * MiB;
constexpr size_t WS_HB = 520 * MiB;
constexpr size_t WS_YATT = 536 * MiB;
constexpr size_t WS_YHT = 544 * MiB;
constexpr size_t WS_YN = 552 * MiB;
constexpr size_t WS_X1 = 584 * MiB;
constexpr size_t WS_U = 648 * MiB;
constexpr size_t WS_OMLA = 744 * MiB;
constexpr size_t WS_ACT = 648 * MiB;
constexpr size_t WS_KF = 776 * MiB;
constexpr size_t WS_Y2 = 776 * MiB;
constexpr size_t WS_XE = 776 * MiB;
constexpr size_t WS_YE = 840 * MiB;
constexpr size_t WS_HYT = 904 * MiB;
constexpr size_t WS_FILT = 956 * MiB;
constexpr size_t WS_END = 1020 * MiB;
constexpr int CW_BAR = 4096;

constexpr int RING_BYTES = 139264;
constexpr int LDSCTL_OFF = RING_BYTES, MISC_OFF = LDSCTL_OFF + 320;
constexpr int XTRA_OFF = RING_BYTES + 1024;
constexpr int LDS_BYTES = 147456;

__device__ __forceinline__ float bf2f(unsigned short u) { return __uint_as_float((unsigned)u << 16); }
__device__ __forceinline__ unsigned pk2(float lo, float hi) { f32x2 v = {lo, hi}; bf16x2_t b = __builtin_convertvector(v, bf16x2_t); return __builtin_bit_cast(unsigned, b); }
__device__ __forceinline__ float bflo(unsigned w) { return __uint_as_float(w << 16); }
__device__ __forceinline__ float bfhi(unsigned w) { return __uint_as_float(w & 0xffff0000u); }
__device__ __forceinline__ float wave_sum(float v) {
#pragma unroll
    for (int o = 1; o < 64; o <<= 1) v += __shfl_xor(v, o);
    return v;
}
__device__ __forceinline__ float fexp(float x) { return __builtin_amdgcn_exp2f(x * LOG2E); }
__device__ __forceinline__ float flog(float x) { return __builtin_amdgcn_logf(x) * 0.6931471805599453f; }
__device__ __forceinline__ float sin_rev(float r) { return __builtin_amdgcn_sinf(r); }
__device__ __forceinline__ float cos_rev(float r) { return __builtin_amdgcn_cosf(r); }
__device__ __forceinline__ float sin_rad(float x) { float r = x * 0.15915494309189535f; r = r - __builtin_rintf(r); return __builtin_amdgcn_sinf(r); }
__device__ __forceinline__ int crow(int r, int hi) { return (r & 3) + 8 * (r >> 2) + 4 * hi; }
#define MFMA32(a, b, c) __builtin_amdgcn_mfma_f32_32x32x16_bf16((a), (b), (c), 0, 0, 0)
#define LDS_WAIT() asm volatile("s_waitcnt lgkmcnt(0)" ::: "memory")
#define VM_WAIT() asm volatile("s_waitcnt vmcnt(0)" ::: "memory")

#define XB_TMO      128
#define XB_XCNT(j)  (256  + 64 * (j))
#define XB_XSUB(j)  (1280 + 64 * (j))
#define XB_XGEN(j)  (2304 + 64 * (j))
#define XB_TOP      3328
#define XB_TOPGEN   3392
#define XCD_BAR_WORDS 3456
#define XB_SPIN_CAP (1u << 18)
__device__ __forceinline__ unsigned xb_ld(unsigned* p)              { return __hip_atomic_load(p, __ATOMIC_RELAXED, __HIP_MEMORY_SCOPE_AGENT); }
__device__ __forceinline__ unsigned xb_add(unsigned* p, unsigned v) { return __hip_atomic_fetch_add(p, v, __ATOMIC_RELAXED, __HIP_MEMORY_SCOPE_AGENT); }
__device__ __forceinline__ unsigned xb_xcc_id() { return (unsigned)__builtin_amdgcn_s_getreg((3 << 11) | 20) & 0xFu; }
#define XB_SPIN(cond, bar) do { unsigned _sp = 0; while (cond) { __builtin_amdgcn_s_sleep(1); \
    if ((++_sp & 255u) == 0u) { if (xb_ld(&(bar)[XB_TMO])) break; if (_sp > XB_SPIN_CAP) { atomicAdd(&(bar)[XB_TMO], 1u); break; } } } } while (0)
struct XcdBarrier { unsigned* bar; unsigned x; volatile LAS unsigned* st; };
__device__ __forceinline__ XcdBarrier xcd_barrier_post(unsigned* bar, volatile LAS unsigned* st) {
    XcdBarrier b; b.bar = bar; b.x = xb_xcc_id(); b.st = st;
    if (threadIdx.x == 0) (void)xb_add(&bar[XB_XCNT(b.x)], 1u);
    return b;
}
__device__ __forceinline__ void xcd_barrier_complete(unsigned* bar, unsigned x, unsigned& nloc, unsigned& nx) {
    const unsigned G = gridDim.x * gridDim.y * gridDim.z;
    unsigned sum, cnt, mine, sp = 0u;
    for (;;) {
        sum = 0u; cnt = 0u; mine = 0u;
#pragma unroll
        for (unsigned j = 0; j < 16; ++j) { const unsigned c = xb_ld(&bar[XB_XCNT(j)]); sum += c; cnt += (c > 0u) ? 1u : 0u; mine = (j == x) ? c : mine; }
        if (sum == G) break;
        __builtin_amdgcn_s_sleep(1);
        if ((++sp & 255u) == 0u) { if (xb_ld(&bar[XB_TMO])) break; if (sp > XB_SPIN_CAP) { atomicAdd(&bar[XB_TMO], 1u); break; } }
    }
    nloc = mine > 0u ? mine : 1u; nx = cnt > 0u ? cnt : 1u;
}
__device__ __forceinline__ void xcd_barrier(const XcdBarrier& b) {
    asm volatile("s_waitcnt vmcnt(0)" ::: "memory");
    __syncthreads();
    if (threadIdx.x == 0) {
        unsigned* bar = b.bar;
        __builtin_amdgcn_s_waitcnt(0);
        unsigned nloc = b.st[0], nx = b.st[1];
        if (nloc == 0u) { xcd_barrier_complete(bar, b.x, nloc, nx); b.st[0] = nloc; b.st[1] = nx; }
        const unsigned old = xb_add(&bar[XB_XSUB(b.x)], 1u);
        const unsigned gen = old / nloc;
        if (old + 1u == (gen + 1u) * nloc) {
            __builtin_amdgcn_fence(__ATOMIC_RELEASE, "agent");
            asm volatile("s_waitcnt vmcnt(0)" ::: "memory");
            const unsigned og = xb_add(&bar[XB_TOP], 1u);
            const unsigned tg = og / nx;
            if (og + 1u == (tg + 1u) * nx) xb_add(&bar[XB_TOPGEN], 1u);
            else XB_SPIN(xb_ld(&bar[XB_TOPGEN]) == tg, bar);
            __builtin_amdgcn_fence(__ATOMIC_ACQUIRE, "agent");
            xb_add(&bar[XB_XGEN(b.x)], 1u);
            asm volatile("s_waitcnt vmcnt(0)" ::: "memory");
        } else {
            XB_SPIN(xb_ld(&bar[XB_XGEN(b.x)]) == gen, bar);
            __builtin_amdgcn_fence(__ATOMIC_ACQUIRE, "agent");
            asm volatile("s_waitcnt vmcnt(0)" ::: "memory");
        }
    }
    __syncthreads();
}

struct Args { const void* in[35]; float* out; unsigned char* ws; int ph_lo, ph_hi; };
struct Frame {
    LAS unsigned char* lds;
    int tid, lane, wave, vcu, G;
    const Args* a;
    unsigned char* ws;
};
#define INF(i) ((const float*)F.a->in[i])
#define WSP(T, off) ((T*)(F.ws + (off)))

__device__ __forceinline__ void tr_item(const float* W, int ldw, int Kvalid, int Nvalid, int k0, int n0, bf16_t* dst, int dpitch, int drow0, int dk0, LAS float* scr, int lane, int NW = 64) {
    f32x4 v[16];
    const int nn = n0 + 4 * (lane & 15);
#pragma unroll
    for (int i = 0; i < 16; ++i) { const int kk = 4 * i + (lane >> 4);
        v[i] = (f32x4){0.f, 0.f, 0.f, 0.f};
        if (W != nullptr && (k0 + kk) < Kvalid && nn < Nvalid) v[i] = *(const GAS f32x4*)(W + (size_t)(k0 + kk) * ldw + nn); }
#pragma unroll
    for (int i = 0; i < 16; ++i) { const int kk = 4 * i + (lane >> 4);
        *(LAS f32x4*)(scr + kk * 64 + ((4 * (lane & 15)) ^ (4 * ((kk >> 3) & 7)))) = v[i]; }
    LDS_WAIT(); asm volatile("" ::: "memory");
    const int kc = lane & 7, nl = lane >> 3;
#pragma unroll
    for (int j = 0; j < 8; ++j) { const int n = 8 * j + nl; const LAS float* sp = scr + (8 * kc) * 64 + (n ^ (4 * kc));
        u32x4 o; o.x = pk2(sp[0 * 64], sp[1 * 64]); o.y = pk2(sp[2 * 64], sp[3 * 64]); o.z = pk2(sp[4 * 64], sp[5 * 64]); o.w = pk2(sp[6 * 64], sp[7 * 64]);
        if (n < NW) *(GAS u32x4*)(dst + (size_t)(drow0 + n) * dpitch + dk0 + k0 + 8 * kc) = o; }
    LDS_WAIT(); asm volatile("" ::: "memory");
}

__device__ __forceinline__ void p0_phase(Frame& F) {
    const int tid = F.tid, lane = F.lane, wave = F.wave;
    {
        LAS float* cs = (LAS float*)(F.lds);
        LAS float* red = (LAS float*)(F.lds + 8192);
        const float* c = INF(1);
        for (int i = tid; i < 2048; i += NTHR) { const float v = c[i]; cs[i] = v / (1.0f + fexp(-v)); }
        __syncthreads();
        for (int cb = blockIdx.x; cb < 256; cb += F.G) {
            const int j = tid % 48, kg = tid / 48;
            const int col = cb * 48 + j, l = col / 6144, n = col % 6144;
            if (kg < 10) {
                const float* w = INF(3) + (size_t)l * 1024 * 6144 + n;
                float a0 = 0.f, a1 = 0.f;
#pragma unroll 26
                for (int k = kg; k < 1024; k += 10) { const float wv = w[(size_t)k * 6144]; a0 += cs[k] * wv; a1 += cs[1024 + k] * wv; }
                red[(kg * 48 + j) * 2] = a0; red[(kg * 48 + j) * 2 + 1] = a1;
            }
            __syncthreads();
            if (tid < 96) { const int jj = tid >> 1, b = tid & 1; float s = 0.f;
                for (int g = 0; g < 10; ++g) s += red[(g * 48 + jj) * 2 + b];
                const int col2 = cb * 48 + jj, l2 = col2 / 6144, n2 = col2 % 6144;
                WSP(float, WS_MOD)[(l2 * 2 + b) * 6144 + n2] = s + INF(4)[l2 * 6144 + n2]; }
            __syncthreads();
        }
    }
    {
        const int gw = F.vcu * NWAVES + wave, NGW = F.G * NWAVES;
        for (int l = 0; l < 2; ++l) {
            const float* w1 = INF(18) + l * 17 * 64; const float* w2 = INF(21) + l * 64 * 64;
            float w1c[17], w2c[64];
#pragma unroll
            for (int i = 0; i < 17; ++i) w1c[i] = w1[i * 64 + lane];
#pragma unroll
            for (int k = 0; k < 64; ++k) w2c[k] = w2[k * 64 + lane];
            const float b1 = INF(19)[l * 64 + lane], fr1 = INF(20)[l * 64 + lane], b2 = INF(22)[l * 64 + lane], fr2 = INF(23)[l * 64 + lane];
            for (int t = gw; t < SEQ; t += NGW) {
                const float tt = (float)t * (1.0f / SEQ);
                float a = b1 + tt * w1c[0];
#pragma unroll
                for (int bnd = 1; bnd <= 8; ++bnd) { float r = (float)((t * bnd) & (SEQ - 1)) * (1.0f / SEQ); a += sin_rev(r) * w1c[bnd] + cos_rev(r) * w1c[8 + bnd]; }
                const float h1 = sin_rad(fr1 * a);
                float a2 = b2;
#pragma unroll
                for (int k = 0; k < 64; ++k) a2 += __shfl(h1, k) * w2c[k];
                WSP(bf16_t, WS_HID)[((size_t)l * SEQ + t) * 64 + lane] = (bf16_t)(pk2(sin_rad(fr2 * a2), 0.f) & 0xffffu);
            }
        }
    }
    {
        LAS float* scr = (LAS float*)(F.lds + wave * 16384);
        const int gw = F.vcu * NWAVES + wave, NGW = F.G * NWAVES;
        constexpr int I_WIN = 16 * 48, I_WOUT = 16 * 16, I_WMLA = 6 * 16, I_W3 = 16, I_GU = 16 * 2 * 16 * 32, I_DN = 16 * 32 * 16;
        constexpr int I_LAYER = I_WIN + I_WOUT + I_WMLA + I_W3 + I_GU + I_DN;
        for (int it = gw; it < 2 * I_LAYER; it += NGW) {
            const int l = it / I_LAYER; int r = it % I_LAYER;
            if (r < I_WIN) { const int kb = r / 48, nb = r % 48;
                tr_item(INF(9) + (size_t)l * 1024 * DIN, DIN, 1024, DIN, kb * 64, nb * 64, WSP(bf16_t, WS_WIN) + (size_t)l * DINP * 1024, 1024, nb * 64, 0, scr, lane); continue; }
            r -= I_WIN;
            if (r < I_WOUT) { const int kb = r / 16, nb = r % 16;
                tr_item(INF(30) + (size_t)l * 1024 * 1024, 1024, 1024, 1024, kb * 64, nb * 64, WSP(bf16_t, WS_WOUT) + (size_t)l * 1024 * 1024, 1024, nb * 64, 0, scr, lane); continue; }
            r -= I_WOUT;
            if (r < I_WMLA) { const int kb = r / 16, nb = r % 16;
                bf16_t* dst = WSP(bf16_t, WS_WMLA) + (size_t)l * 1024 * 384;
                const float* Wq = INF(13) + (size_t)l * 224 * 384;
                if (nb < 4) { if (kb < 4) tr_item(Wq, 384, 224, nb * 96 + 64, kb * 64, nb * 96, dst, 384, nb * 64, 0, scr, lane); else tr_item(nullptr, 4, 0, 0, 0, 0, dst, 384, nb * 64, kb * 64, scr, lane); }
                else if (nb < 6) { const int h0 = 2 * (nb - 4);
                    if (kb < 4) { tr_item(Wq, 384, 224, h0 * 96 + 96, kb * 64, h0 * 96 + 64, dst, 384, 256 + h0 * 32, 0, scr, lane, 32);
                                  tr_item(Wq, 384, 224, (h0 + 1) * 96 + 96, kb * 64, (h0 + 1) * 96 + 64, dst, 384, 256 + (h0 + 1) * 32, 0, scr, lane, 32); }
                    else tr_item(nullptr, 4, 0, 0, 0, 0, dst, 384, nb * 64, kb * 64, scr, lane); }
                else if (nb < 8) tr_item(nullptr, 4, 0, 0, 0, 0, dst, 384, nb * 64, kb * 64, scr, lane);
                else { const float* W = (nb < 12) ? INF(14) + (size_t)l * 128 * 256 : INF(15) + (size_t)l * 128 * 256; const int nsrc = ((nb - 8) & 3) * 64;
                    if (kb >= 4) tr_item(W, 256, 128, 256, (kb - 4) * 64, nsrc, dst, 384, nb * 64, 256, scr, lane); else tr_item(nullptr, 4, 0, 0, 0, 0, dst, 384, nb * 64, kb * 64, scr, lane); }
                continue; }
            r -= I_WMLA;
            if (r < I_W3) { tr_item(INF(24) + (size_t)l * 64 * 1024, 1024, 64, 1024, 0, r * 64, WSP(bf16_t, WS_W3T) + (size_t)l * 1024 * 64, 64, r * 64, 0, scr, lane); continue; }
            r -= I_W3;
            if (r < I_GU) { const int e = r / (2 * 16 * 32); int q = r % (2 * 16 * 32); const int which = q / (16 * 32); q %= (16 * 32); const int kb = q / 32, nb = q % 32;
                const float* W = INF(which ? 33 : 32) + ((size_t)l * NEXP + e) * 1024 * 2048;
                const int n0 = nb * 64, drow = (n0 >> 7) * 256 + (n0 & 127) + (which ? 128 : 0);
                tr_item(W, 2048, 1024, 2048, kb * 64, n0, WSP(bf16_t, WS_WGU) + ((size_t)l * NEXP + e) * 4096 * 1024, 1024, drow, 0, scr, lane); continue; }
            r -= I_GU;
            { const int e = r / (32 * 16); const int q = r % (32 * 16); const int kb = q / 16, nb = q % 16;
                const float* W = INF(34) + ((size_t)l * NEXP + e) * 2048 * 1024;
                tr_item(W, 1024, 2048, 1024, kb * 64, nb * 64, WSP(bf16_t, WS_WDN) + ((size_t)l * NEXP + e) * 1024 * LDFF, LDFF, nb * 64, 0, scr, lane); }
        }
    }
}

__device__ __forceinline__ void ld_row_f32(const float* p, int lane, f32x4 (&v)[4]) {
    const GAS f32x4* r = (const GAS f32x4*)p + lane;
#pragma unroll
    for (int j = 0; j < 4; ++j) v[j] = r[64 * j];
}
__device__ __forceinline__ void st_row_f32(float* p, int lane, const f32x4 (&v)[4]) {
    GAS f32x4* r = (GAS f32x4*)p + lane;
#pragma unroll
    for (int j = 0; j < 4; ++j) r[64 * j] = v[j];
}
__device__ __forceinline__ void st_row_bf16(bf16_t* p, int lane, const f32x4 (&v)[4]) {
    GAS u32x2* r = (GAS u32x2*)p + lane;
#pragma unroll
    for (int j = 0; j < 4; ++j) { u32x2 w; w.x = pk2(v[j].x, v[j].y); w.y = pk2(v[j].z, v[j].w); r[64 * j] = w; }
}
__device__ __forceinline__ float row_ss(const f32x4 (&v)[4]) {
    float s = 0.f;
#pragma unroll
    for (int j = 0; j < 4; ++j) s += (v[j].x * v[j].x + v[j].y * v[j].y) + (v[j].z * v[j].z + v[j].w * v[j].w);
    return wave_sum(s);
}
__device__ __forceinline__ void modnorm(const f32x4 (&x)[4], const float* g, const float* sc, const float* sh, int lane, f32x4 (&h)[4]) {
    const float rstd = __builtin_amdgcn_rsqf(row_ss(x) * (1.0f / DM) + EPS);
    f32x4 gv[4], scv[4], shv[4];
    ld_row_f32(g, lane, gv); ld_row_f32(sc, lane, scv); ld_row_f32(sh, lane, shv);
#pragma unroll
    for (int j = 0; j < 4; ++j) h[j] = (x[j] * rstd) * gv[j] * (scv[j] + 1.0f) + shv[j];
}

__device__ __forceinline__ void filt_gemm_tile(Frame& F, int wt) {
    const int lane = F.lane, hi = lane >> 5, l31 = lane & 31;
    const int l = wt >> 11, r = wt & 2047, t0 = (r >> 3) * 32, col0 = (r & 7) * 128;
    const bf16_t* hidp = WSP(bf16_t, WS_HID) + ((size_t)l * SEQ + t0 + l31) * 64 + hi * 8;
    const bf16_t* w3p = WSP(bf16_t, WS_W3T) + ((size_t)l * 1024 + col0 + l31) * 64 + hi * 8;
    bf16x8 bfr[4], afr[4][4];
#pragma unroll
    for (int ks = 0; ks < 4; ++ks) { bfr[ks] = *(const GAS bf16x8*)(hidp + 16 * ks);
#pragma unroll
        for (int jb = 0; jb < 4; ++jb) afr[jb][ks] = *(const GAS bf16x8*)(w3p + (size_t)(32 * jb) * 64 + 16 * ks); }
    f32x16 acc[4];
#pragma unroll
    for (int jb = 0; jb < 4; ++jb) {
#pragma unroll
        for (int q = 0; q < 16; ++q) acc[jb][q] = 0.f;
#pragma unroll
        for (int ks = 0; ks < 4; ++ks) acc[jb] = MFMA32(afr[jb][ks], bfr[ks], acc[jb]); }
    const float tt = (float)(t0 + l31) * (1.0f / SEQ);
    float* FT = WSP(float, WS_FILT) + (size_t)l * 1024 * SEQ + t0 + l31;
#pragma unroll
    for (int jb = 0; jb < 4; ++jb)
#pragma unroll
        for (int q = 0; q < 16; ++q) { const int col = col0 + 32 * jb + crow(q, hi);
            const float v = (acc[jb][q] + INF(25)[l * 1024 + col]) * fexp(-tt * fexp(INF(26)[l * 1024 + col]));
            FT[(size_t)col * SEQ] = v; }
}

__device__ __forceinline__ void p1_phase(Frame& F) {
    const int gw = F.vcu * NWAVES + F.wave, NGW = F.G * NWAVES;
    const float* mod = WSP(float, WS_MOD);
    for (int m = gw; m < MTOK; m += 2 * NGW) {
        const int m2 = (m + NGW < MTOK) ? m + NGW : m; f32x4 xa[4], xb[4], h[4];
        ld_row_f32(INF(0) + (size_t)m * DM, F.lane, xa); ld_row_f32(INF(0) + (size_t)m2 * DM, F.lane, xb);
        { const int b = m >> 13; modnorm(xa, INF(5), mod + (0 * 2 + b) * 6144 + 1024, mod + (0 * 2 + b) * 6144, F.lane, h); st_row_bf16(WSP(bf16_t, WS_XN) + (size_t)m * DM, F.lane, h); }
        { const int b = m2 >> 13; modnorm(xb, INF(5), mod + (0 * 2 + b) * 6144 + 1024, mod + (0 * 2 + b) * 6144, F.lane, h); st_row_bf16(WSP(bf16_t, WS_XN) + (size_t)m2 * DM, F.lane, h); }
    }
    for (int wt = gw; wt < 4096; wt += NGW) filt_gemm_tile(F, wt);
}

__device__ __forceinline__ float wave_scan_add(float v, int lane) {
#pragma unroll
    for (int o = 1; o < 64; o <<= 1) { const float n = __shfl_up(v, o); if (lane >= o) v += n; }
    return v;
}
__device__ __forceinline__ float wave_scan_max(float v, int lane) {
#pragma unroll
    for (int o = 1; o < 64; o <<= 1) { const float n = __shfl_up(v, o); if (lane >= o) v = fmaxf(v, n); }
    return v;
}
__device__ __forceinline__ float wave_max(float v) {
#pragma unroll
    for (int o = 1; o < 64; o <<= 1) v = fmaxf(v, __shfl_xor(v, o));
    return v;
}
__device__ __forceinline__ float logsigmoid(float x) { return fminf(x, 0.f) - flog(1.0f + fexp(-fabsf(x))); }
struct MlItem { int b, h, dir, n, t0; };
__device__ __forceinline__ MlItem ml_decode(int item) { MlItem I; I.b = item >> 9; I.h = (item >> 7) & 3; I.dir = (item >> 6) & 1; I.n = item & 63;
    I.t0 = I.b * SEQ + (I.dir ? SEQ - 128 * (I.n + 1) : 128 * I.n); return I; }

__device__ __forceinline__ void ml_local_item(Frame& F, int item, int l) {
    const int tid = F.tid; const MlItem I = ml_decode(item);
    const bf16_t* U = WSP(bf16_t, WS_U);
    LAS float* EK = (LAS float*)(F.lds);
    LAS float* VV = (LAS float*)(F.lds + 32768);
    LAS float* LF = (LAS float*)(F.lds + 65536);
    LAS float* IG = LF + 128; LAS float* WW = LF + 256; LAS float* EST = LF + 384;
    const float* gb = INF(10) + l * 16;
    if (tid < 128) { const int j = tid, r = I.dir ? 127 - j : j; const size_t t = (size_t)(I.t0 + r);
        const float ipre = bf2f(U[t * DINP + U_MLG + (I.dir ? 2 : 0) * 4 + I.h]) + gb[(I.dir ? 2 : 0) * 4 + I.h];
        const float fpre = bf2f(U[t * DINP + U_MLG + (I.dir ? 3 : 1) * 4 + I.h]) + gb[(I.dir ? 3 : 1) * 4 + I.h];
        LF[j] = logsigmoid(fpre); IG[j] = ipre; }
    __syncthreads();
    float a = 0.f, aend = 0.f;
    if (tid < 128) { for (int i = 0; i < 128; ++i) { const float v = LF[i]; aend += v; if (i <= tid) a += v; }
        WW[tid] = aend - a + IG[tid]; }
    __syncthreads();
    float mloc = -3.0e38f;
    if (tid < 128) { for (int i = 0; i < 128; ++i) mloc = fmaxf(mloc, WW[i]);
        const int r = I.dir ? 127 - tid : tid; EST[r] = fexp(WW[tid] - mloc); }
    __syncthreads();
#pragma unroll
    for (int i = 0; i < 2; ++i) { const int p = tid + 512 * i, row = p >> 3, c8 = p & 7;
        const u32x4 kq = *(const GAS u32x4*)(U + (size_t)(I.t0 + row) * DINP + U_MLK + I.h * 64 + c8 * 8);
        const u32x4 vq = *(const GAS u32x4*)(U + (size_t)(I.t0 + row) * DINP + U_MLV + I.h * 64 + c8 * 8);
        const float es = EST[row] * 0.125f;
        LAS f32x4* ek = (LAS f32x4*)(EK + row * 64 + c8 * 8); LAS f32x4* vv = (LAS f32x4*)(VV + row * 64 + c8 * 8);
        ek[0] = (f32x4){bflo(kq.x) * es, bfhi(kq.x) * es, bflo(kq.y) * es, bfhi(kq.y) * es};
        ek[1] = (f32x4){bflo(kq.z) * es, bfhi(kq.z) * es, bflo(kq.w) * es, bfhi(kq.w) * es};
        vv[0] = (f32x4){bflo(vq.x), bfhi(vq.x), bflo(vq.y), bfhi(vq.y)};
        vv[1] = (f32x4){bflo(vq.z), bfhi(vq.z), bflo(vq.w), bfhi(vq.w)}; }
    __syncthreads();
    {
        const int d = tid >> 3, e0 = (tid & 7) * 8;
        f32x4 c0 = {0.f, 0.f, 0.f, 0.f}, c1 = {0.f, 0.f, 0.f, 0.f};
#pragma unroll 4
        for (int j = 0; j < 128; ++j) { const float ek = EK[j * 64 + d]; const f32x4 v0 = *(const LAS f32x4*)(VV + j * 64 + e0), v1 = *(const LAS f32x4*)(VV + j * 64 + e0 + 4);
            c0 += v0 * ek; c1 += v1 * ek; }
        GAS f32x4* dst = (GAS f32x4*)(WSP(float, WS_MLC) + (size_t)item * 4096 + d * 64 + e0);
        dst[0] = c0; dst[1] = c1;
        if (tid < 64) { float s = 0.f; for (int j = 0; j < 128; ++j) s += EK[j * 64 + tid]; WSP(float, WS_MLN)[item * 64 + tid] = s; }
        if (tid == 0) { WSP(float, WS_MLS)[item * 4] = mloc; WSP(float, WS_MLS)[item * 4 + 1] = aend; }
    }
    __syncthreads();
}

__device__ __forceinline__ void ml_scan(Frame& F) {
    float* MLC = WSP(float, WS_MLC); float* MLN = WSP(float, WS_MLN); float* MLS = WSP(float, WS_MLS);
    for (int blk = blockIdx.x; blk < 256; blk += F.G) { if (F.tid >= 260) continue; const int idx = blk * 260 + F.tid;
        const int seq = idx / 4160, el = idx % 4160;
        float* p0 = el < 4096 ? (MLC + (size_t)seq * 64 * 4096 + el) : (MLN + seq * 64 * 64 + (el - 4096));
        const int pstr = el < 4096 ? 4096 : 64;
        float mst = 0.f, st = 0.f;
#pragma unroll 1
        for (int n0 = 0; n0 < 64; n0 += 16) {
            float cl[16], mlv[16], aev[16];
#pragma unroll
            for (int i = 0; i < 16; ++i) { cl[i] = p0[(size_t)(n0 + i) * pstr]; mlv[i] = MLS[(seq * 64 + n0 + i) * 4]; aev[i] = MLS[(seq * 64 + n0 + i) * 4 + 1]; }
#pragma unroll
            for (int i = 0; i < 16; ++i) { const int item = seq * 64 + n0 + i;
                p0[(size_t)(n0 + i) * pstr] = st;
                if (el == 0) MLS[item * 4 + 2] = mst;
                const float mnew = fmaxf(aev[i] + mst, mlv[i]), sp = fexp(aev[i] + mst - mnew), sl = fexp(mlv[i] - mnew);
                st = sp * st + sl * cl[i]; mst = mnew; }
        }
    }
}

template <int NK>
__device__ __forceinline__ void qkt_tile(f32x16& p0, f32x16& p1, LAS const unsigned char* Kt, const bf16x8 (&qr)[NK], int r32, int hi) {
#pragma unroll
    for (int r = 0; r < 16; ++r) { p0[r] = 0.f; p1[r] = 0.f; }
#pragma unroll
    for (int d0 = 0; d0 < NK; ++d0) {
        const bf16x8 b0 = *(const LAS bf16x8*)(Kt + (2 * d0 + hi) * 1024 + r32 * 16);
        const bf16x8 b1 = *(const LAS bf16x8*)(Kt + (2 * d0 + hi) * 1024 + r32 * 16 + 512);
        p0 = MFMA32(b0, qr[d0], p0); p1 = MFMA32(b1, qr[d0], p1);
    }
}
typedef short v4i16_t __attribute__((ext_vector_type(4)));
__device__ __forceinline__ s16x4 vtr(LAS const unsigned char* p) { return __builtin_bit_cast(s16x4, __builtin_amdgcn_ds_read_tr16_b64_v4i16((LAS v4i16_t*)p)); }
__device__ __forceinline__ void pv_tile(f32x16 (&o)[2], LAS const unsigned char* Vt, const bf16x8 (&pa)[4], int lane) {
    const int hi = lane >> 5;
    LAS const unsigned char* vb = Vt + ((lane >> 4) & 1) * 32 + (lane & 3) * 8 + (4 * hi + ((lane & 15) >> 2)) * 64;
#pragma unroll
    for (int d0 = 0; d0 < 2; ++d0)
#pragma unroll
        for (int ks = 0; ks < 4; ++ks) {
            const s16x4 lo = vtr(vb + d0 * 4096 + ks * 1024), hh = vtr(vb + d0 * 4096 + ks * 1024 + 512);
            const bf16x8 vf = (bf16x8){lo[0], lo[1], lo[2], lo[3], hh[0], hh[1], hh[2], hh[3]};
            o[d0] = MFMA32(pa[ks], vf, o[d0]);
        }
}
__device__ __forceinline__ void pack_p(const f32x16& p0, const f32x16& p1, bf16x8 (&pa)[4]) {
    u32x4 w0, w1, w2, w3;
    w0 = (u32x4){pk2(p0[0], p0[1]), pk2(p0[2], p0[3]), pk2(p0[4], p0[5]), pk2(p0[6], p0[7])};
    w1 = (u32x4){pk2(p0[8], p0[9]), pk2(p0[10], p0[11]), pk2(p0[12], p0[13]), pk2(p0[14], p0[15])};
    w2 = (u32x4){pk2(p1[0], p1[1]), pk2(p1[2], p1[3]), pk2(p1[4], p1[5]), pk2(p1[6], p1[7])};
    w3 = (u32x4){pk2(p1[8], p1[9]), pk2(p1[10], p1[11]), pk2(p1[12], p1[13]), pk2(p1[14], p1[15])};
    pa[0] = __builtin_bit_cast(bf16x8, w0); pa[1] = __builtin_bit_cast(bf16x8, w1); pa[2] = __builtin_bit_cast(bf16x8, w2); pa[3] = __builtin_bit_cast(bf16x8, w3);
}

__device__ __forceinline__ void ml_local_pair(Frame& F, int pair, int l) {
    const int tid = F.tid, lane = F.lane, wid = F.wave, half = wid >> 2, wq = wid & 3, th = tid & 255, hi = lane >> 5;
    const int item = pair * 2 + half; const MlItem I = ml_decode(item);
    const bf16_t* U = WSP(bf16_t, WS_U);
    LAS unsigned char* base = F.lds + half * 49152;
    LAS unsigned char* EKI = base;
    LAS unsigned char* VI = base + 16384;
    LAS float* LF = (LAS float*)(base + 32768); LAS float* IG = LF + 128; LAS float* WW = LF + 256; LAS float* EST = LF + 384;
    const float* gb = INF(10) + l * 16;
    unsigned short graw_i = 0, graw_f = 0;
    if (th < 128) { const int r = I.dir ? 127 - th : th; const size_t t = (size_t)(I.t0 + r);
        graw_i = U[t * DINP + U_MLG + (I.dir ? 2 : 0) * 4 + I.h]; graw_f = U[t * DINP + U_MLG + (I.dir ? 3 : 1) * 4 + I.h]; }
    u32x4 kpc[4], vpc[4];
#pragma unroll
    for (int i = 0; i < 4; ++i) { const int p = th + 256 * i; const int tt = p >> 9, dh = (p >> 8) & 1, row = (p >> 2) & 63, c4 = p & 3, r = 64 * tt + row;
        const bf16_t* src = U + (size_t)(I.t0 + r) * DINP + I.h * 64 + dh * 32 + c4 * 8;
        kpc[i] = *(const GAS u32x4*)(src + U_MLK); vpc[i] = *(const GAS u32x4*)(src + U_MLV); }
    float a = 0.f, aend = 0.f, mloc = -3.0e38f;
    const float lfv = (th < 128) ? logsigmoid(bf2f(graw_f) + gb[(I.dir ? 3 : 1) * 4 + I.h]) : 0.f, igv = (th < 128) ? bf2f(graw_i) + gb[(I.dir ? 2 : 0) * 4 + I.h] : 0.f;
    if (th < 128) { a = wave_scan_add(lfv, lane); if (lane == 63) LF[wq] = a; }
    __syncthreads();
    float wv = 0.f;
    if (th < 128) { aend = LF[0] + LF[1]; if (wq == 1) a += LF[0]; wv = aend - a + igv; const float wm = wave_max(wv); if (lane == 0) IG[wq] = wm; }
    __syncthreads();
    if (th < 128) { mloc = fmaxf(IG[0], IG[1]); const int r = I.dir ? 127 - th : th; EST[r] = fexp(wv - mloc) * 0.125f; }
    __syncthreads();
#pragma unroll
    for (int i = 0; i < 4; ++i) { const int p = th + 256 * i; const int tt = p >> 9, dh = (p >> 8) & 1, row = (p >> 2) & 63, c4 = p & 3, r = 64 * tt + row;
        const u32x4 kq = kpc[i];
        const float es = EST[r];
        u32x4 ek; ek.x = pk2(bflo(kq.x) * es, bfhi(kq.x) * es); ek.y = pk2(bflo(kq.y) * es, bfhi(kq.y) * es); ek.z = pk2(bflo(kq.z) * es, bfhi(kq.z) * es); ek.w = pk2(bflo(kq.w) * es, bfhi(kq.w) * es);
        const int off = tt * 8192 + dh * 4096 + row * 64 + c4 * 16;
        *(LAS u32x4*)(EKI + off) = ek; *(LAS u32x4*)(VI + off) = vpc[i]; }
    __syncthreads();
    {
        const int da = wq >> 1, eb = wq & 1;
        f32x16 acc;
#pragma unroll
        for (int r = 0; r < 16; ++r) acc[r] = 0.f;
        const int lo_off = ((lane >> 4) & 1) * 32 + (lane & 3) * 8 + (4 * hi + ((lane & 15) >> 2)) * 64;
#pragma unroll
        for (int tt = 0; tt < 2; ++tt)
#pragma unroll
            for (int ks = 0; ks < 4; ++ks) {
                LAS const unsigned char* ap = EKI + tt * 8192 + da * 4096 + lo_off + ks * 1024; LAS const unsigned char* bp = VI + tt * 8192 + eb * 4096 + lo_off + ks * 1024;
                const s16x4 a0 = vtr(ap), a1 = vtr(ap + 512), b0 = vtr(bp), b1 = vtr(bp + 512);
                const bf16x8 af = (bf16x8){a0[0], a0[1], a0[2], a0[3], a1[0], a1[1], a1[2], a1[3]}, bf = (bf16x8){b0[0], b0[1], b0[2], b0[3], b1[0], b1[1], b1[2], b1[3]};
                acc = MFMA32(af, bf, acc); }
        float* dst = WSP(float, WS_MLC) + (size_t)item * 4096 + eb * 32 + (lane & 31);
#pragma unroll
        for (int r = 0; r < 16; ++r) dst[(da * 32 + crow(r, hi)) * 64] = acc[r];
        if (th < 64) { const int dh = th >> 5, col = th & 31; float sacc = 0.f;
            for (int tt = 0; tt < 2; ++tt) for (int row = 0; row < 64; ++row) sacc += bf2f(*(const LAS unsigned short*)(EKI + tt * 8192 + dh * 4096 + row * 64 + col * 2));
            WSP(float, WS_MLN)[item * 64 + th] = sacc; }
        if (th == 0) { WSP(float, WS_MLS)[item * 4] = mloc; WSP(float, WS_MLS)[item * 4 + 1] = aend; }
    }
    __syncthreads();
}

__device__ __forceinline__ void ml_out_pair(Frame& F, int pair, int l) {
    const int tid = F.tid, lane = F.lane, wid = F.wave, half = wid >> 2, wq = wid & 3, th = tid & 255, r32 = lane & 31, hi = lane >> 5;
    const int item = pair * 2 + half; const MlItem I = ml_decode(item);
    const bf16_t* U = WSP(bf16_t, WS_U);
    LAS unsigned char* base = F.lds + half * 49152;
    LAS unsigned char* KI = base;
    LAS unsigned char* VI = base + 16384;
    LAS unsigned char* CT = base + 32768;
    LAS float* vec = (LAS float*)(base + 32768 + 9216);
    LAS float* LF = vec; LAS float* IG = vec + 128; LAS float* BL = vec + 256; LAS float* SA = vec + 384; LAS float* SCI = vec + 512; LAS float* EDEN = vec + 640;
    LAS float* NPV = vec + 768; LAS float* wsf = vec + 832 + wq * 64;
    const float* gb = INF(10) + l * 16;
    unsigned short graw_i = 0, graw_f = 0; float mprev = 0.f;
    if (th < 128) { const int r = I.dir ? 127 - th : th; const size_t t = (size_t)(I.t0 + r);
        graw_i = U[t * DINP + U_MLG + (I.dir ? 2 : 0) * 4 + I.h]; graw_f = U[t * DINP + U_MLG + (I.dir ? 3 : 1) * 4 + I.h];
        mprev = WSP(float, WS_MLS)[item * 4 + 2]; }
    u32x4 kpc[4], vpc[4];
#pragma unroll
    for (int i = 0; i < 4; ++i) { const int p = th + 256 * i;
        { const int tt = p >> 9, c = (p >> 6) & 7, kv = p & 63, j = 64 * tt + kv, r = I.dir ? 127 - j : j;
          kpc[i] = *(const GAS u32x4*)(U + (size_t)(I.t0 + r) * DINP + U_MLK + I.h * 64 + c * 8); }
        { const int tt = p >> 9, dh = (p >> 8) & 1, kv = (p >> 2) & 63, c4 = p & 3, j = 64 * tt + kv, r = I.dir ? 127 - j : j;
          vpc[i] = *(const GAS u32x4*)(U + (size_t)(I.t0 + r) * DINP + U_MLV + I.h * 64 + dh * 32 + c4 * 8); } }
    float cpv[16];
    { const float* cp = WSP(float, WS_MLC) + (size_t)item * 4096;
#pragma unroll
      for (int i = 0; i < 16; ++i) cpv[i] = cp[th + 256 * i]; }
    const float npv = (th < 64) ? WSP(float, WS_MLN)[item * 64 + th] : 0.f;
    const int q = 32 * wq + r32;
    const int rq = I.dir ? 127 - q : q;
    bf16x8 qr[4];
    { const bf16_t* qp = U + (size_t)(I.t0 + rq) * DINP + U_MLQ + I.h * 64 + hi * 8;
#pragma unroll
      for (int d0 = 0; d0 < 4; ++d0) qr[d0] = *(const GAS bf16x8*)(qp + d0 * 16); }
    const float lfv = (th < 128) ? logsigmoid(bf2f(graw_f) + gb[(I.dir ? 3 : 1) * 4 + I.h]) : 0.f, igv = (th < 128) ? bf2f(graw_i) + gb[(I.dir ? 2 : 0) * 4 + I.h] : 0.f;
    float a = 0.f;
    if (th < 128) { a = wave_scan_add(lfv, lane); if (lane == 63) LF[wq] = a; }
#pragma unroll
    for (int i = 0; i < 4; ++i) { const int p = th + 256 * i;
        { const int tt = p >> 9, c = (p >> 6) & 7, kv = p & 63; *(LAS u32x4*)(KI + tt * 8192 + c * 1024 + kv * 16) = kpc[i]; }
        { const int tt = p >> 9, dh = (p >> 8) & 1, kv = (p >> 2) & 63, c4 = p & 3; *(LAS u32x4*)(VI + tt * 8192 + dh * 4096 + kv * 64 + c4 * 16) = vpc[i]; } }
#pragma unroll
    for (int i = 0; i < 16; ++i) { const int idx = th + 256 * i, d = idx >> 6, e = idx & 63;
        *(LAS unsigned short*)(CT + e * 144 + d * 2) = (unsigned short)(pk2(cpv[i], 0.f) & 0xffffu); }
    if (th < 64) NPV[th] = npv;
    __syncthreads();
    float bv = 0.f, bm = -3.0e38f;
    if (th < 128) { if (wq == 1) a += LF[0]; bv = igv - a; bm = wave_scan_max(bv, lane); if (lane == 63) IG[wq] = bm; }
    __syncthreads();
    if (th < 128) { if (wq == 1) bm = fmaxf(bm, IG[0]);
        const float mt = a + fmaxf(mprev, bm);
        SA[th] = (a - mt) * LOG2E; SCI[th] = fexp(a + mprev - mt); EDEN[th] = fexp(-mt); BL[th] = bv * LOG2E; }
    __syncthreads();
    {
        f32x16 o[2];
#pragma unroll
        for (int r = 0; r < 16; ++r) { o[0][r] = 0.f; o[1][r] = 0.f; }
        const float saq = SA[q], scq = SCI[q];
        float den = 0.f;
        for (int tt = 0; tt < 2; ++tt) {
            if (64 * tt > 32 * wq + 31) break;
            f32x16 p0, p1;
            qkt_tile<4>(p0, p1, KI + tt * 8192, qr, r32, hi);
#pragma unroll
            for (int g = 0; g < 4; ++g) {
                const f32x4 b0 = *(const LAS f32x4*)(BL + 64 * tt + 8 * g + 4 * hi), b1 = *(const LAS f32x4*)(BL + 64 * tt + 32 + 8 * g + 4 * hi);
#pragma unroll
                for (int i = 0; i < 4; ++i) { const int r = 4 * g + i; const int kv0 = 64 * tt + 8 * g + 4 * hi + i, kv1 = kv0 + 32;
                    const float e0 = (kv0 <= q) ? __builtin_amdgcn_exp2f(saq + b0[i]) * 0.125f : 0.f, e1 = (kv1 <= q) ? __builtin_amdgcn_exp2f(saq + b1[i]) * 0.125f : 0.f;
                    p0[r] *= e0; p1[r] *= e1; den += p0[r] + p1[r]; }
            }
            bf16x8 pa[4]; pack_p(p0, p1, pa);
            pv_tile(o, VI + tt * 8192, pa, lane);
        }
        float dot = 0.f;
#pragma unroll
        for (int ks = 0; ks < 4; ++ks) {
            const u32x4 qw = __builtin_bit_cast(u32x4, qr[ks]);
            const f32x4 n0 = *(const LAS f32x4*)(NPV + 16 * ks + 8 * hi), n1 = *(const LAS f32x4*)(NPV + 16 * ks + 8 * hi + 4);
            const float q0 = bflo(qw.x), q1 = bfhi(qw.x), q2 = bflo(qw.y), q3 = bfhi(qw.y), q4 = bflo(qw.z), q5 = bfhi(qw.z), q6 = bflo(qw.w), q7 = bfhi(qw.w);
            dot += q0 * n0[0] + q1 * n0[1] + q2 * n0[2] + q3 * n0[3] + q4 * n1[0] + q5 * n1[1] + q6 * n1[2] + q7 * n1[3];
            const u32x4 sw = (u32x4){pk2(q0 * scq, q1 * scq), pk2(q2 * scq, q3 * scq), pk2(q4 * scq, q5 * scq), pk2(q6 * scq, q7 * scq)};
            const bf16x8 qs = __builtin_bit_cast(bf16x8, sw);
#pragma unroll
            for (int de = 0; de < 2; ++de) {
                const bf16x8 cf = *(const LAS bf16x8*)(CT + (de * 32 + r32) * 144 + (16 * ks + 8 * hi) * 2);
                o[de] = MFMA32(qs, cf, o[de]);
            }
        }
        den += scq * dot;
        den += __shfl_xor(den, 32);
        const float rinv = 1.0f / fmaxf(fabsf(den), EDEN[q]);
        if (hi == 0) wsf[r32] = rinv;
        LDS_WAIT();
        bf16_t* dst = WSP(bf16_t, I.dir ? WS_HB : WS_HF);
#pragma unroll
        for (int r = 0; r < 16; ++r) { const int jq = 32 * wq + crow(r, hi), row = I.dir ? 127 - jq : jq; const float rr = wsf[crow(r, hi)];
            bf16_t* dp = dst + (size_t)(I.t0 + row) * 256 + I.h * 64 + r32;
            dp[0] = (bf16_t)(pk2(o[0][r] * rr, 0.f) & 0xffffu); dp[32] = (bf16_t)(pk2(o[1][r] * rr, 0.f) & 0xffffu); }
    }
    __syncthreads();
}

__device__ __forceinline__ double rope_kd_dyn(int i) {
    double r = 0.15915494309189535;
    r = (i == 1) ? 0.08949940160889101 : r; r = (i == 2) ? 0.050329212104487035 : r; r = (i == 3) ? 0.0283021958306234 : r; r = (i == 4) ? 0.015915494309189534 : r;
    r = (i == 5) ? 0.008949940160889102 : r; r = (i == 6) ? 0.005032921210448704 : r; r = (i == 7) ? 0.00283021958306234 : r; r = (i == 8) ? 0.0015915494309189536 : r;
    r = (i == 9) ? 0.0008949940160889102 : r; r = (i == 10) ? 0.0005032921210448703 : r; r = (i == 11) ? 0.00028302195830623395 : r; r = (i == 12) ? 0.00015915494309189535 : r;
    r = (i == 13) ? 8.949940160889102e-05 : r; r = (i == 14) ? 5.0329212104487035e-05 : r; r = (i == 15) ? 2.8302195830623396e-05 : r;
    return r;
}
__device__ __forceinline__ void mla_prep_rows(Frame& F, int l) {
    const int gw = F.vcu * NWAVES + F.wave, NGW = F.G * NWAVES, lane = F.lane;
    const bf16_t* U = WSP(bf16_t, WS_U); bf16_t* A = WSP(bf16_t, WS_AMLA);
    f32x4 gq = {0.f, 0.f, 0.f, 0.f}; if (lane < 56) gq = *(const GAS f32x4*)(INF(11) + l * 224 + 4 * lane);
    const f32x2 gk = *(const GAS f32x2*)(INF(12) + l * 128 + 2 * lane);
    for (int m0 = gw; m0 < MTOK; m0 += 4 * NGW) {
        u32x2 qw[4]; unsigned kw[4];
#pragma unroll
        for (int r = 0; r < 4; ++r) { const int m = m0 + r * NGW; const bf16_t* ur = U + (size_t)(m < MTOK ? m : 0) * DINP;
            qw[r] = (u32x2){0u, 0u}; if (lane < 56) qw[r] = *(const GAS u32x2*)(ur + U_CQ + 4 * lane);
            kw[r] = *(const GAS unsigned*)(ur + U_CKV + 2 * lane); }
#pragma unroll
        for (int r = 0; r < 4; ++r) { const int m = m0 + r * NGW; if (m >= MTOK) break;
            const float q0 = bflo(qw[r].x), q1 = bfhi(qw[r].x), q2 = bflo(qw[r].y), q3 = bfhi(qw[r].y), k0 = bflo(kw[r]), k1 = bfhi(kw[r]);
            const float rq = __builtin_amdgcn_rsqf(wave_sum(q0 * q0 + q1 * q1 + q2 * q2 + q3 * q3) * (1.0f / 224.0f) + EPS);
            const float rk = __builtin_amdgcn_rsqf(wave_sum(k0 * k0 + k1 * k1) * (1.0f / 128.0f) + EPS);
            bf16_t* ar = A + (size_t)m * 384;
            u32x2 qo; qo.x = pk2(q0 * rq * gq.x, q1 * rq * gq.y); qo.y = pk2(q2 * rq * gq.z, q3 * rq * gq.w);
            *(GAS u32x2*)(ar + 4 * lane) = qo;
            *(GAS unsigned*)(ar + 256 + 2 * lane) = pk2(k0 * rk * gk.x, k1 * rk * gk.y); }
    }
    const int* pos = (const int*)F.a->in[2];
    for (int m0 = gw; m0 < MTOK; m0 += 4 * NGW) {
        unsigned short x1r[4], x2r[4]; int pv[4];
#pragma unroll
        for (int r = 0; r < 4; ++r) { const int m = (m0 + r * NGW < MTOK) ? m0 + r * NGW : m0; x1r[r] = 0; x2r[r] = 0; pv[r] = 0;
            if (lane < 16) { x1r[r] = U[(size_t)m * DINP + U_KR + lane]; x2r[r] = U[(size_t)m * DINP + U_KR + 16 + lane]; pv[r] = pos[m]; } }
#pragma unroll
        for (int r = 0; r < 4; ++r) { const int m = m0 + r * NGW; if (m >= MTOK) break;
            if (lane < 16) { const int b = m >> 13, sq = m & 8191;
                double rev = (double)pv[r] * rope_kd_dyn(lane); rev -= __builtin_floor(rev);
                const float rr = (float)rev, c = cos_rev(rr), sn = sin_rev(rr), x1 = bf2f(x1r[r]), x2 = bf2f(x2r[r]);
                const unsigned short o1 = (unsigned short)(pk2(x1 * c - x2 * sn, 0.f) & 0xffffu), o2 = (unsigned short)(pk2(x2 * c + x1 * sn, 0.f) & 0xffffu);
#pragma unroll
                for (int h = 0; h < 4; ++h) { bf16_t* kd = WSP(bf16_t, WS_KIMG) + ((size_t)(b * 4 + h) * 128 + (sq >> 6)) * 6144 + (sq & 63) * 8;
                    kd[(8 + (lane >> 3)) * 512 + (lane & 7)] = o1; kd[(10 + (lane >> 3)) * 512 + (lane & 7)] = o2; } } }
    }
}

__device__ __forceinline__ double rope_k(int i) {
    switch (i) { case 0: return 0.15915494309189535; case 1: return 0.08949940160889101; case 2: return 0.050329212104487035; case 3: return 0.0283021958306234;
        case 4: return 0.015915494309189534; case 5: return 0.008949940160889102; case 6: return 0.005032921210448704; case 7: return 0.00283021958306234;
        case 8: return 0.0015915494309189536; case 9: return 0.0008949940160889102; case 10: return 0.0005032921210448703; case 11: return 0.00028302195830623395;
        case 12: return 0.00015915494309189535; case 13: return 8.949940160889102e-05; case 14: return 5.0329212104487035e-05; default: return 2.8302195830623396e-05; }
}
__device__ __forceinline__ void rope_cs(int pos, int i, float& c, float& s) {
    double rev = (double)pos * rope_k(i);
    rev -= __builtin_floor(rev);
    const float r = (float)rev;
    c = cos_rev(r); s = sin_rev(r);
}
__device__ __forceinline__ void relayout_phase(Frame& F) {
    const bf16_t* O = WSP(bf16_t, WS_OMLA); const bf16_t* U = WSP(bf16_t, WS_U);
    const int* pos = (const int*)F.a->in[2];
    const float qscale = 0.10206207261596577f * LOG2E;
    for (int idx = blockIdx.x * NTHR + F.tid; idx < MTOK * 4; idx += F.G * NTHR) {
        const int t = idx >> 2, h = idx & 3, b = t >> 13, s = t & 8191, bh = b * 4 + h;
        const int p = pos[t];
        float cs[16], sn[16];
#pragma unroll
        for (int i = 0; i < 16; ++i) rope_cs(p, i, cs[i], sn[i]);
        const bf16_t* qsrc = O + (size_t)t * 1024 + h * 96;
        bf16_t* qdst = WSP(bf16_t, WS_Q) + ((size_t)bh * SEQ + s) * 96;
#pragma unroll
        for (int c = 0; c < 8; ++c) { const u32x4 w = *(const GAS u32x4*)(qsrc + c * 8);
            u32x4 o; o.x = pk2(bflo(w.x) * qscale, bfhi(w.x) * qscale); o.y = pk2(bflo(w.y) * qscale, bfhi(w.y) * qscale); o.z = pk2(bflo(w.z) * qscale, bfhi(w.z) * qscale); o.w = pk2(bflo(w.w) * qscale, bfhi(w.w) * qscale);
            *(GAS u32x4*)(qdst + c * 8) = o; }
        {
            float x1[16], x2[16];
#pragma unroll
            for (int c = 0; c < 2; ++c) { const u32x4 w = *(const GAS u32x4*)(qsrc + 64 + c * 8); const u32x4 v = *(const GAS u32x4*)(qsrc + 80 + c * 8);
                x1[c * 8 + 0] = bflo(w.x); x1[c * 8 + 1] = bfhi(w.x); x1[c * 8 + 2] = bflo(w.y); x1[c * 8 + 3] = bfhi(w.y); x1[c * 8 + 4] = bflo(w.z); x1[c * 8 + 5] = bfhi(w.z); x1[c * 8 + 6] = bflo(w.w); x1[c * 8 + 7] = bfhi(w.w);
                x2[c * 8 + 0] = bflo(v.x); x2[c * 8 + 1] = bfhi(v.x); x2[c * 8 + 2] = bflo(v.y); x2[c * 8 + 3] = bfhi(v.y); x2[c * 8 + 4] = bflo(v.z); x2[c * 8 + 5] = bfhi(v.z); x2[c * 8 + 6] = bflo(v.w); x2[c * 8 + 7] = bfhi(v.w); }
#pragma unroll
            for (int c = 0; c < 2; ++c) { u32x4 o1, o2;
#define RQ1(i) ((x1[i] * cs[i] - x2[i] * sn[i]) * qscale)
#define RQ2(i) ((x2[i] * cs[i] + x1[i] * sn[i]) * qscale)
                o1.x = pk2(RQ1(c * 8 + 0), RQ1(c * 8 + 1)); o1.y = pk2(RQ1(c * 8 + 2), RQ1(c * 8 + 3)); o1.z = pk2(RQ1(c * 8 + 4), RQ1(c * 8 + 5)); o1.w = pk2(RQ1(c * 8 + 6), RQ1(c * 8 + 7));
                o2.x = pk2(RQ2(c * 8 + 0), RQ2(c * 8 + 1)); o2.y = pk2(RQ2(c * 8 + 2), RQ2(c * 8 + 3)); o2.z = pk2(RQ2(c * 8 + 4), RQ2(c * 8 + 5)); o2.w = pk2(RQ2(c * 8 + 6), RQ2(c * 8 + 7));
                *(GAS u32x4*)(qdst + 64 + c * 8) = o1; *(GAS u32x4*)(qdst + 80 + c * 8) = o2; }
#undef RQ1
#undef RQ2
        }
        bf16_t* kdst = WSP(bf16_t, WS_KIMG) + ((size_t)bh * 128 + (s >> 6)) * 6144 + (s & 63) * 8;
        const bf16_t* ksrc = O + (size_t)t * 1024 + 384 + h * 64;
#pragma unroll
        for (int c = 0; c < 8; ++c) *(GAS u32x4*)(kdst + c * 512) = *(const GAS u32x4*)(ksrc + c * 8);
        {
            const bf16_t* krs = U + (size_t)t * DINP + U_KR;
            float x1[16], x2[16];
#pragma unroll
            for (int c = 0; c < 2; ++c) { const u32x4 w = *(const GAS u32x4*)(krs + c * 8); const u32x4 v = *(const GAS u32x4*)(krs + 16 + c * 8);
                x1[c * 8 + 0] = bflo(w.x); x1[c * 8 + 1] = bfhi(w.x); x1[c * 8 + 2] = bflo(w.y); x1[c * 8 + 3] = bfhi(w.y); x1[c * 8 + 4] = bflo(w.z); x1[c * 8 + 5] = bfhi(w.z); x1[c * 8 + 6] = bflo(w.w); x1[c * 8 + 7] = bfhi(w.w);
                x2[c * 8 + 0] = bflo(v.x); x2[c * 8 + 1] = bfhi(v.x); x2[c * 8 + 2] = bflo(v.y); x2[c * 8 + 3] = bfhi(v.y); x2[c * 8 + 4] = bflo(v.z); x2[c * 8 + 5] = bfhi(v.z); x2[c * 8 + 6] = bflo(v.w); x2[c * 8 + 7] = bfhi(v.w); }
#pragma unroll
            for (int c = 0; c < 2; ++c) { u32x4 o1, o2;
#define RK1(i) (x1[i] * cs[i] - x2[i] * sn[i])
#define RK2(i) (x2[i] * cs[i] + x1[i] * sn[i])
                o1.x = pk2(RK1(c * 8 + 0), RK1(c * 8 + 1)); o1.y = pk2(RK1(c * 8 + 2), RK1(c * 8 + 3)); o1.z = pk2(RK1(c * 8 + 4), RK1(c * 8 + 5)); o1.w = pk2(RK1(c * 8 + 6), RK1(c * 8 + 7));
                o2.x = pk2(RK2(c * 8 + 0), RK2(c * 8 + 1)); o2.y = pk2(RK2(c * 8 + 2), RK2(c * 8 + 3)); o2.z = pk2(RK2(c * 8 + 4), RK2(c * 8 + 5)); o2.w = pk2(RK2(c * 8 + 6), RK2(c * 8 + 7));
                *(GAS u32x4*)(kdst + (8 + c) * 512) = o1; *(GAS u32x4*)(kdst + (10 + c) * 512) = o2; }
#undef RK1
#undef RK2
        }
        bf16_t* vdst = WSP(bf16_t, WS_VIMG) + ((size_t)bh * 128 + (s >> 6)) * 4096 + (s & 63) * 32;
        const bf16_t* vsrc = O + (size_t)t * 1024 + 640 + h * 64;
#pragma unroll
        for (int c = 0; c < 8; ++c) *(GAS u32x4*)(vdst + (c >> 2) * 2048 + (c & 3) * 8) = *(const GAS u32x4*)(vsrc + c * 8);
    }
}

__device__ __forceinline__ void attn_unit(Frame& F, int bh, int qb) {
    const int tid = F.tid, lane = F.lane, wid = F.wave, r32 = lane & 31, hi = lane >> 5;
    LAS unsigned char* KB = F.lds;
    LAS unsigned char* VB = F.lds + 24576;
    LAS float* wsf = (LAS float*)(F.lds + 40960) + wid * 64;
    const int b = bh >> 2, h = bh & 3;
    const bf16_t* Qp = WSP(bf16_t, WS_Q) + ((size_t)bh * SEQ + qb * 256 + wid * 32 + r32) * 96 + hi * 8;
    bf16x8 qr[6];
#pragma unroll
    for (int d0 = 0; d0 < 6; ++d0) qr[d0] = *(const GAS bf16x8*)(Qp + d0 * 16);
    const GAS u32x4* Kg = (const GAS u32x4*)(WSP(bf16_t, WS_KIMG) + (size_t)bh * 128 * 6144);
    const GAS u32x4* Vg = (const GAS u32x4*)(WSP(bf16_t, WS_VIMG) + (size_t)bh * 128 * 4096);
    const bool kx = tid < 256;
    u32x4 k0 = Kg[tid], k1 = kx ? Kg[512 + tid] : (u32x4){0u, 0u, 0u, 0u}, v0 = Vg[tid];
    u32x4 k2 = Kg[768 + tid], k3 = kx ? Kg[768 + 512 + tid] : (u32x4){0u, 0u, 0u, 0u};
    *(LAS u32x4*)(KB + tid * 16) = k0; if (kx) *(LAS u32x4*)(KB + (512 + tid) * 16) = k1; *(LAS u32x4*)(VB + tid * 16) = v0;
    *(LAS u32x4*)(KB + 12288 + tid * 16) = k2; if (kx) *(LAS u32x4*)(KB + 12288 + (512 + tid) * 16) = k3;
    __syncthreads();
    f32x16 s0, s1;
    qkt_tile<6>(s0, s1, KB, qr, r32, hi);
    __syncthreads();
    f32x16 o[2]; float lsum = 0.f;
#pragma unroll
    for (int r = 0; r < 16; ++r) { o[0][r] = 0.f; o[1][r] = 0.f; }
    float m;
    { float rm = fmaxf(fmaxf(s0[0], s1[0]), fmaxf(s0[1], s1[1]));
#pragma unroll
      for (int r = 2; r < 16; r += 2) rm = fmaxf(fmaxf(rm, s0[r]), fmaxf(s1[r], fmaxf(s0[r + 1], s1[r + 1])));
      m = fmaxf(rm, __shfl_xor(rm, 32));
#pragma unroll
      for (int r = 0; r < 16; ++r) { s0[r] -= m; s1[r] -= m; } }
    LAS const unsigned char* vbl = VB + ((lane >> 4) & 1) * 32 + (lane & 3) * 8 + (4 * hi + ((lane & 15) >> 2)) * 64;
    u32x4 kb0 = Kg[2 * 768 + tid], kb1 = kx ? Kg[2 * 768 + 512 + tid] : (u32x4){0u, 0u, 0u, 0u}, vb0 = Vg[512 + tid];
#define ATT_ITER(T, LK0, LK1, LV, WK0, WK1, WV) do { \
        const int t = (T); const int cur = t & 1; \
        const int tv = (t + 2 < 128) ? t + 2 : 127, tk = (t + 3 < 128) ? t + 3 : 127; \
        LK0 = Kg[tk * 768 + tid]; if (kx) LK1 = Kg[tk * 768 + 512 + tid]; \
        LV = Vg[tv * 512 + tid]; \
        LAS const unsigned char* Kt = KB + (cur ^ 1) * 12288 + hi * 1024 + r32 * 16; \
        bf16x8 kf[12]; \
        _Pragma("unroll") for (int d0 = 0; d0 < 6; ++d0) { kf[2 * d0] = *(const LAS bf16x8*)(Kt + d0 * 2048); kf[2 * d0 + 1] = *(const LAS bf16x8*)(Kt + d0 * 2048 + 512); } \
        _Pragma("unroll") for (int r = 0; r < 16; ++r) { s0[r] = __builtin_amdgcn_exp2f(s0[r]); s1[r] = __builtin_amdgcn_exp2f(s1[r]); } \
        { float ls_ = 0.f; _Pragma("unroll") for (int r = 0; r < 16; ++r) ls_ += s0[r] + s1[r]; lsum += ls_; } \
        bf16x8 pa[4]; pack_p(s0, s1, pa); \
        f32x16 n0, n1; { const float nm_ = -m; _Pragma("unroll") for (int r = 0; r < 16; ++r) { n0[r] = nm_; n1[r] = nm_; } } \
        n0 = MFMA32(kf[0], qr[0], n0); n1 = MFMA32(kf[1], qr[0], n1); \
        _Pragma("unroll") for (int d0 = 1; d0 < 6; ++d0) { n0 = MFMA32(kf[2 * d0], qr[d0], n0); n1 = MFMA32(kf[2 * d0 + 1], qr[d0], n1); } \
        LAS const unsigned char* vb = vbl + cur * 8192; \
        _Pragma("unroll") for (int ks = 0; ks < 4; ++ks) { \
            _Pragma("unroll") for (int d0 = 0; d0 < 2; ++d0) { \
                const s16x4 lo = vtr(vb + d0 * 4096 + ks * 1024), hh = vtr(vb + d0 * 4096 + ks * 1024 + 512); \
                const bf16x8 vf = (bf16x8){lo[0], lo[1], lo[2], lo[3], hh[0], hh[1], hh[2], hh[3]}; \
                o[d0] = MFMA32(pa[ks], vf, o[d0]); } } \
        float rm = fmaxf(fmaxf(n0[0], n1[0]), fmaxf(n0[1], n1[1])); \
        _Pragma("unroll") for (int r = 2; r < 16; r += 2) rm = fmaxf(fmaxf(rm, n0[r]), fmaxf(n1[r], fmaxf(n0[r + 1], n1[r + 1]))); \
        rm = fmaxf(rm, __shfl_xor(rm, 32)); \
        _Pragma("unroll") for (int i = 0; i < 12; ++i) { __builtin_amdgcn_sched_group_barrier(0x008, 1, 0); __builtin_amdgcn_sched_group_barrier(0x002, 7, 0); } \
        if (__any(rm > 8.0f)) { \
            const float dl = fmaxf(rm, 0.f), f = __builtin_amdgcn_exp2f(-dl); \
            m += dl; lsum *= f; \
            _Pragma("unroll") for (int r = 0; r < 16; ++r) { n0[r] -= dl; n1[r] -= dl; } \
            if (hi == 0) wsf[r32] = f; \
            LDS_WAIT(); \
            _Pragma("unroll") for (int r = 0; r < 16; ++r) { const float fr = wsf[crow(r, hi)]; o[0][r] *= fr; o[1][r] *= fr; } \
        } \
        *(LAS u32x4*)(KB + cur * 12288 + tid * 16) = WK0; if (kx) *(LAS u32x4*)(KB + cur * 12288 + (512 + tid) * 16) = WK1; \
        *(LAS u32x4*)(VB + (cur ^ 1) * 8192 + tid * 16) = WV; \
        __syncthreads(); \
        s0 = n0; s1 = n1; } while (0)
#pragma unroll 1
    for (int t2 = 0; t2 < 128; t2 += 2) {
        ATT_ITER(t2, k0, k1, v0, kb0, kb1, vb0);
        ATT_ITER(t2 + 1, kb0, kb1, vb0, k0, k1, v0);
    }
#undef ATT_ITER
    lsum += __shfl_xor(lsum, 32);
    if (hi == 0) wsf[r32] = 1.0f / lsum;
    LDS_WAIT();
    bf16_t* Y = WSP(bf16_t, WS_YATT);
#pragma unroll
    for (int r = 0; r < 16; ++r) { const float rl = wsf[crow(r, hi)]; const int q = qb * 256 + wid * 32 + crow(r, hi);
        bf16_t* yp = Y + ((size_t)b * SEQ + q) * 256 + h * 64 + r32;
        yp[0] = (bf16_t)(pk2(o[0][r] * rl, 0.f) & 0xffffu); yp[32] = (bf16_t)(pk2(o[1][r] * rl, 0.f) & 0xffffu); }
    __syncthreads();
}

#define PX(e) ((e) + ((e) >> 5))
__device__ __forceinline__ f32x2 cmul(f32x2 a, float c, float s) { return (f32x2){a.x * c - a.y * s, a.x * s + a.y * c}; }
__device__ __forceinline__ void bf4_fwd(f32x2& x0, f32x2& x1, f32x2& x2, f32x2& x3, float c1, float s1) {
    const float c2 = c1 * c1 - s1 * s1, s2 = 2.0f * c1 * s1, c3 = c2 * c1 - s2 * s1, s3 = c2 * s1 + s2 * c1;
    const f32x2 a = x0 + x2, b = x0 - x2, c = x1 + x3, d = x1 - x3;
    x0 = a + c;
    x1 = cmul((f32x2){b.x + d.y, b.y - d.x}, c1, s1);
    x2 = cmul(a - c, c2, s2);
    x3 = cmul((f32x2){b.x - d.y, b.y + d.x}, c3, s3);
}
__device__ __forceinline__ void bf4_inv(f32x2& x0, f32x2& x1, f32x2& x2, f32x2& x3, float c1, float s1) {
    const float c2 = c1 * c1 - s1 * s1, s2 = 2.0f * c1 * s1, c3 = c2 * c1 - s2 * s1, s3 = c2 * s1 + s2 * c1;
    const f32x2 t1 = cmul(x1, c1, s1), t2 = cmul(x2, c2, s2), t3 = cmul(x3, c3, s3);
    const f32x2 a = x0 + t2, b = x0 - t2, c = t1 + t3, d = t1 - t3;
    x0 = a + c; x2 = a - c;
    x1 = (f32x2){b.x - d.y, b.y + d.x};
    x3 = (f32x2){b.x + d.y, b.y - d.x};
}
template <bool INV>
__device__ __forceinline__ void fft_r4_last(LAS f32x2* X, int tid) {
#pragma unroll 2
    for (int i = 0; i < 8; ++i) { int base = 4 * (tid + 512 * i); asm volatile("" : "+v"(base));
        f32x2 x0 = X[PX(base)], x1 = X[PX(base + 1)], x2 = X[PX(base + 2)], x3 = X[PX(base + 3)];
        if (!INV) bf4_fwd(x0, x1, x2, x3, 1.0f, 0.0f); else bf4_inv(x0, x1, x2, x3, 1.0f, 0.0f);
        X[PX(base)] = x0; X[PX(base + 1)] = x1; X[PX(base + 2)] = x2; X[PX(base + 3)] = x3; }
    __syncthreads();
}
template <bool INV>
__device__ __forceinline__ void r16_core(f32x2 (&x)[16], int j, int lq, float r16, float r4) {
    const float angB = (float)j * r4;
    if (!INV) {
#pragma unroll
        for (int r = 0; r < 4; ++r) { const float ang = (float)(j + (r << lq)) * r16; bf4_fwd(x[r], x[r + 4], x[r + 8], x[r + 12], cos_rev(ang), -sin_rev(ang)); }
        const float cb = cos_rev(angB), sb = -sin_rev(angB);
#pragma unroll
        for (int k = 0; k < 4; ++k) bf4_fwd(x[4 * k], x[4 * k + 1], x[4 * k + 2], x[4 * k + 3], cb, sb);
    } else {
        const float cb = cos_rev(angB), sb = sin_rev(angB);
#pragma unroll
        for (int k = 0; k < 4; ++k) bf4_inv(x[4 * k], x[4 * k + 1], x[4 * k + 2], x[4 * k + 3], cb, sb);
#pragma unroll
        for (int r = 0; r < 4; ++r) { const float ang = (float)(j + (r << lq)) * r16; bf4_inv(x[r], x[r + 4], x[r + 8], x[r + 12], cos_rev(ang), sin_rev(ang)); }
    }
}
template <bool INV>
__device__ __forceinline__ void fft_r16_pass(LAS f32x2* X, int tid, int lq) {
    const int qp = 1 << lq;
    const float r16 = 1.0f / (float)(16 * qp), r4 = 1.0f / (float)(4 * qp);
    int u0 = tid; asm volatile("" : "+v"(u0)); int u1 = tid + 512; asm volatile("" : "+v"(u1));
    const int j0 = u0 & (qp - 1), b0 = ((u0 >> lq) << (lq + 4)) + j0, j1 = u1 & (qp - 1), b1 = ((u1 >> lq) << (lq + 4)) + j1;
    f32x2 xa[16], xb[16];
#pragma unroll
    for (int r = 0; r < 16; ++r) xa[r] = X[PX(b0 + (r << lq))];
#pragma unroll
    for (int r = 0; r < 16; ++r) xb[r] = X[PX(b1 + (r << lq))];
    r16_core<INV>(xa, j0, lq, r16, r4);
#pragma unroll
    for (int r = 0; r < 16; ++r) X[PX(b0 + (r << lq))] = xa[r];
    r16_core<INV>(xb, j1, lq, r16, r4);
#pragma unroll
    for (int r = 0; r < 16; ++r) X[PX(b1 + (r << lq))] = xb[r];
    __syncthreads();
}
template <bool INV>
__device__ __forceinline__ void fft16k(LAS f32x2* X, int tid) {
    if (!INV) { fft_r16_pass<false>(X, tid, 10); fft_r16_pass<false>(X, tid, 6); fft_r16_pass<false>(X, tid, 2); fft_r4_last<false>(X, tid); }
    else { fft_r4_last<true>(X, tid); fft_r16_pass<true>(X, tid, 2); fft_r16_pass<true>(X, tid, 6); fft_r16_pass<true>(X, tid, 10); }
}
__device__ __forceinline__ int drev4(int x) { unsigned y = __builtin_bitreverse32((unsigned)x) >> 18; return (int)(((y & 0x2AAAu) >> 1) | ((y & 0x1555u) << 1)); }
__device__ __forceinline__ float block_sum(Frame& F, float v, LAS float* red) {
    v = wave_sum(v);
    if (F.lane == 0) red[F.wave] = v;
    __syncthreads();
    float s = 0.f;
#pragma unroll
    for (int w = 0; w < NWAVES; ++w) s += red[w];
    __syncthreads();
    return s;
}
__device__ __forceinline__ void hyena_item(Frame& F, int c_in, int l) {
    int c = c_in; asm volatile("" : "+s"(c));
    const int tid = F.tid;
    LAS f32x2* X = (LAS f32x2*)F.lds;
    LAS float* red = (LAS float*)(F.lds + XTRA_OFF);
    f32x2* KF = WSP(f32x2, WS_KF) + (size_t)c * 2 * 16384;
    {
        const float* F0f = WSP(float, WS_FILT) + ((size_t)l * 1024 + c) * SEQ; const float* F0b = F0f + (size_t)256 * SEQ;
        const float* F1f = F0f + (size_t)512 * SEQ; const float* F1b = F0f + (size_t)768 * SEQ;
        float s0 = 0.f, s1 = 0.f;
#pragma unroll 1
        for (int i0 = 0; i0 < 16; i0 += 8) { float a0[8], b0[8], a1[8], b1[8];
#pragma unroll
            for (int i = 0; i < 8; ++i) { int t = tid + 512 * (i0 + i); asm volatile("" : "+v"(t)); a0[i] = F0f[t]; b0[i] = F0b[t]; a1[i] = F1f[t]; b1[i] = F1b[t]; }
#pragma unroll
            for (int i = 0; i < 8; ++i) { const int t = tid + 512 * (i0 + i); s0 += fabsf(a0[i]) + fabsf(b0[i]); s1 += fabsf(a1[i]) + fabsf(b1[i]);
                X[PX(t)] = (f32x2){a0[i], a1[i]}; X[PX(16383 - t)] = (f32x2){b0[i], b1[i]}; } }
        const float inv0 = 0.5f / block_sum(F, s0, red), inv1 = 0.5f / block_sum(F, s1, red);
        fft16k<false>(X, tid);
#pragma unroll 2
        for (int i = 0; i < 32; ++i) { int p = tid + 512 * i; asm volatile("" : "+v"(p)); const int f = drev4(p), pp = drev4((16384 - f) & 16383);
            const f32x2 w = X[PX(p)], wp = X[PX(pp)];
            KF[p] = (f32x2){(w.x + wp.x) * inv0, (w.y - wp.y) * inv0};
            KF[16384 + p] = (f32x2){(w.y + wp.y) * inv1, (wp.x - w.x) * inv1}; }
        __syncthreads();
    }
    const float* HT0 = WSP(float, WS_HYT);
    const float hb0 = INF(27)[l * 512 + c], hb1 = INF(27)[l * 512 + 256 + c];
    float zz[16][2];
    { const float* z0p = HT0 + (size_t)(0 * 768 + 512 + c) * SEQ; const float* z1p = HT0 + (size_t)(1 * 768 + 512 + c) * SEQ;
#pragma unroll
      for (int i = 0; i < 16; ++i) { zz[i][0] = z0p[tid + 512 * i]; zz[i][1] = z1p[tid + 512 * i]; }
#pragma unroll
      for (int i = 0; i < 16; ++i) { int t = tid + 512 * i; asm volatile("" : "+v"(t)); X[PX(t)] = (f32x2){zz[i][0], zz[i][1]}; X[PX(8192 + t)] = (f32x2){0.f, 0.f}; } }
    __syncthreads();
    const float invn = 1.0f / 16384.0f;
#pragma unroll 1
    for (int o = 0; o < 2; ++o) {
        const f32x2* kp = KF + o * 16384;
        f32x2 kv[16];
#pragma unroll
        for (int i = 0; i < 16; ++i) kv[i] = kp[tid + 512 * i];
        fft16k<false>(X, tid);
#pragma unroll
        for (int i = 0; i < 16; ++i) { int p = tid + 512 * i; asm volatile("" : "+v"(p)); const f32x2 v = X[PX(p)]; X[PX(p)] = (f32x2){v.x * kv[i].x - v.y * kv[i].y, v.x * kv[i].y + v.y * kv[i].x}; }
#pragma unroll
        for (int i = 0; i < 16; ++i) kv[i] = kp[tid + 512 * (16 + i)];
#pragma unroll
        for (int i = 0; i < 16; ++i) { int p = tid + 512 * (16 + i); asm volatile("" : "+v"(p)); const f32x2 v = X[PX(p)]; X[PX(p)] = (f32x2){v.x * kv[i].x - v.y * kv[i].y, v.x * kv[i].y + v.y * kv[i].x}; }
        __syncthreads();
        fft16k<true>(X, tid);
        float ga[16], gb[16];
        { const float* g0p = HT0 + (size_t)(0 * 768 + o * 256 + c) * SEQ; const float* g1p = HT0 + (size_t)(1 * 768 + o * 256 + c) * SEQ;
#pragma unroll
          for (int i = 0; i < 16; ++i) { ga[i] = g0p[tid + 512 * i]; gb[i] = g1p[tid + 512 * i]; } }
        const float hbo = o ? hb1 : hb0;
        if (o == 0) {
#pragma unroll
            for (int i = 0; i < 16; ++i) { int t = tid + 512 * i; asm volatile("" : "+v"(t)); const f32x2 y = X[PX(t)];
                zz[i][0] = ga[i] * (y.x * invn + zz[i][0] * hbo); zz[i][1] = gb[i] * (y.y * invn + zz[i][1] * hbo);
                X[PX(t)] = (f32x2){zz[i][0], zz[i][1]}; X[PX(8192 + t)] = (f32x2){0.f, 0.f}; }
            __syncthreads();
        } else {
            bf16_t* Y0 = WSP(bf16_t, WS_YHT) + (size_t)(0 * 256 + c) * SEQ; bf16_t* Y1 = WSP(bf16_t, WS_YHT) + (size_t)(1 * 256 + c) * SEQ;
#pragma unroll
            for (int i = 0; i < 16; ++i) { int t = tid + 512 * i; asm volatile("" : "+v"(t)); const f32x2 y = X[PX(t)];
                const float r0 = ga[i] * (y.x * invn + zz[i][0] * hbo), r1 = gb[i] * (y.y * invn + zz[i][1] * hbo);
                Y0[t] = (bf16_t)(pk2(r0, 0.f) & 0xffffu); Y1[t] = (bf16_t)(pk2(r1, 0.f) & 0xffffu); }
            __syncthreads();
        }
    }
}

__device__ __forceinline__ void hy_prep_tile(Frame& F, int tile, int l) {
    const int tid = F.tid, lane = F.lane, wave = F.wave;
    const int b = tile >> 7, t0 = (tile & 127) * 64;
    constexpr int RS = 1552;
    const bf16_t* U = WSP(bf16_t, WS_U);
    { u32x4 hv[13];
#pragma unroll
      for (int i = 0; i < 13; ++i) { const int idx = tid + 512 * i; const int row = idx / 96, pc = idx % 96; const int tok = t0 - 1 + row;
          hv[i] = (u32x4){0u, 0u, 0u, 0u};
          if (row < 66 && tok >= 0 && tok < SEQ) hv[i] = *(const GAS u32x4*)(U + ((size_t)b * SEQ + tok) * DINP + U_HY + pc * 8); }
#pragma unroll
      for (int i = 0; i < 13; ++i) { const int idx = tid + 512 * i; const int row = idx / 96, pc = idx % 96;
          if (row < 66) *(LAS u32x4*)(F.lds + row * RS + pc * 16) = hv[i]; } }
    __syncthreads();
    const float* cw = INF(16) + (size_t)l * 768 * 3; const float* cb = INF(17) + l * 768;
    float* HT = WSP(float, WS_HYT);
#pragma unroll 2
    for (int cp = wave; cp < 384; cp += 8) { const int ch = 2 * cp;
        const float w00 = cw[ch * 3], w01 = cw[ch * 3 + 1], w02 = cw[ch * 3 + 2], w10 = cw[ch * 3 + 3], w11 = cw[ch * 3 + 4], w12 = cw[ch * 3 + 5], b0 = cb[ch], b1 = cb[ch + 1];
        const unsigned r0 = *(const LAS unsigned*)(F.lds + lane * RS + cp * 4), r1 = *(const LAS unsigned*)(F.lds + (lane + 1) * RS + cp * 4), r2 = *(const LAS unsigned*)(F.lds + (lane + 2) * RS + cp * 4);
        HT[((size_t)(b * 768 + ch)) * SEQ + t0 + lane] = w00 * bflo(r0) + w01 * bflo(r1) + w02 * bflo(r2) + b0;
        HT[((size_t)(b * 768 + ch + 1)) * SEQ + t0 + lane] = w10 * bfhi(r0) + w11 * bfhi(r1) + w12 * bfhi(r2) + b1; }
    __syncthreads();
}

__device__ __forceinline__ void headnorm_phase(Frame& F, int l) {
    const int lane = F.lane, tid = F.tid, wave = F.wave;
    const bf16_t* U = WSP(bf16_t, WS_U); const bf16_t* YA = WSP(bf16_t, WS_YATT); const bf16_t* YH = WSP(bf16_t, WS_YHT);
    constexpr int RS2 = 528;
    const int g = wave >> 1, sub = wave & 1, cg = 4 * lane, ch = g * 256 + cg;
    const f32x4 og = *(const GAS f32x4*)(INF(29) + l * 1024 + ch);
    float scw[12];
#pragma unroll
    for (int j = 0; j < 12; ++j) scw[j] = INF(28)[(size_t)l * 768 + cg * 3 + j];
    for (int tile = F.vcu; tile < 256; tile += F.G) {
      const int tb = tile >> 7, t0 = (tile & 127) * 64;
#pragma unroll
      for (int i = 0; i < 4; ++i) { const int idx = tid + 512 * i, c = idx >> 3, p8 = idx & 7;
          const u32x4 v = *(const GAS u32x4*)(YH + ((size_t)(tb * 256 + c)) * SEQ + t0 + p8 * 8);
          LAS unsigned char* hp = F.lds + (8 * p8) * RS2 + 2 * c;
          *(LAS unsigned short*)(hp + 0 * RS2) = (unsigned short)(v.x & 0xffffu); *(LAS unsigned short*)(hp + 1 * RS2) = (unsigned short)(v.x >> 16);
          *(LAS unsigned short*)(hp + 2 * RS2) = (unsigned short)(v.y & 0xffffu); *(LAS unsigned short*)(hp + 3 * RS2) = (unsigned short)(v.y >> 16);
          *(LAS unsigned short*)(hp + 4 * RS2) = (unsigned short)(v.z & 0xffffu); *(LAS unsigned short*)(hp + 5 * RS2) = (unsigned short)(v.z >> 16);
          *(LAS unsigned short*)(hp + 6 * RS2) = (unsigned short)(v.w & 0xffffu); *(LAS unsigned short*)(hp + 7 * RS2) = (unsigned short)(v.w >> 16); }
      __syncthreads();
#pragma unroll 4
      for (int rr = 0; rr < 32; ++rr) {
        const int trow = sub * 32 + rr; const int m = tb * SEQ + t0 + trow;
        float y0, y1, y2, y3;
        if (g == 0) {
            const u32x2 ow = *(const GAS u32x2*)(U + (size_t)m * DINP + U_MLO + cg);
            const u32x2 hfw = *(const GAS u32x2*)(WSP(bf16_t, WS_HF) + (size_t)m * 256 + cg), hbw = *(const GAS u32x2*)(WSP(bf16_t, WS_HB) + (size_t)m * 256 + cg);
            const f32x4 hs = (f32x4){bflo(hfw.x) + bflo(hbw.x), bfhi(hfw.x) + bfhi(hbw.x), bflo(hfw.y) + bflo(hbw.y), bfhi(hfw.y) + bfhi(hbw.y)};
            y0 = hs.x / (1.0f + fexp(-bflo(ow.x))); y1 = hs.y / (1.0f + fexp(-bfhi(ow.x))); y2 = hs.z / (1.0f + fexp(-bflo(ow.y))); y3 = hs.w / (1.0f + fexp(-bfhi(ow.y)));
        } else if (g == 1) {
            const u32x2 w = *(const GAS u32x2*)(YA + (size_t)m * 256 + cg);
            y0 = bflo(w.x); y1 = bfhi(w.x); y2 = bflo(w.y); y3 = bfhi(w.y);
        } else if (g == 2) {
            const u32x2 w = *(const LAS u32x2*)(F.lds + trow * RS2 + cg * 2);
            y0 = bflo(w.x); y1 = bfhi(w.x); y2 = bflo(w.y); y3 = bfhi(w.y);
        } else {
            const int s = t0 + trow;
            const bf16_t* up = U + (size_t)m * DINP + U_SC + cg;
            const u32x2 bw = *(const GAS u32x2*)up;
            u32x2 c0 = {0u, 0u}, x0 = {0u, 0u}, c2 = {0u, 0u}, x2 = {0u, 0u};
            if (s > 0) { c0 = *(const GAS u32x2*)(up - DINP + 256); x0 = *(const GAS u32x2*)(up - DINP + 512); }
            const u32x2 c1 = *(const GAS u32x2*)(up + 256), x1 = *(const GAS u32x2*)(up + 512);
            if (s < SEQ - 1) { c2 = *(const GAS u32x2*)(up + DINP + 256); x2 = *(const GAS u32x2*)(up + DINP + 512); }
            y0 = bflo(bw.x) * (scw[0] * bflo(c0.x) * bflo(x0.x) + scw[1] * bflo(c1.x) * bflo(x1.x) + scw[2] * bflo(c2.x) * bflo(x2.x));
            y1 = bfhi(bw.x) * (scw[3] * bfhi(c0.x) * bfhi(x0.x) + scw[4] * bfhi(c1.x) * bfhi(x1.x) + scw[5] * bfhi(c2.x) * bfhi(x2.x));
            y2 = bflo(bw.y) * (scw[6] * bflo(c0.y) * bflo(x0.y) + scw[7] * bflo(c1.y) * bflo(x1.y) + scw[8] * bflo(c2.y) * bflo(x2.y));
            y3 = bfhi(bw.y) * (scw[9] * bfhi(c0.y) * bfhi(x0.y) + scw[10] * bfhi(c1.y) * bfhi(x1.y) + scw[11] * bfhi(c2.y) * bfhi(x2.y));
        }
        float ss = (y0 * y0 + y1 * y1) + (y2 * y2 + y3 * y3);
        ss += __shfl_xor(ss, 1); ss += __shfl_xor(ss, 2); ss += __shfl_xor(ss, 4); ss += __shfl_xor(ss, 8);
        const float rstd = __builtin_amdgcn_rsqf(ss * (1.0f / 64.0f) + EPS);
        u32x2 w; w.x = pk2(y0 * rstd * og.x, y1 * rstd * og.y); w.y = pk2(y2 * rstd * og.z, y3 * rstd * og.w);
        *(GAS u32x2*)(WSP(bf16_t, WS_YN) + (size_t)m * DM + ch) = w;
      }
      __syncthreads();
    }
}

__device__ __forceinline__ void post_mixer_phase(Frame& F, int l, const float* xin) {
    const int gw = F.vcu * NWAVES + F.wave, NGW = F.G * NWAVES, lane = F.lane, tid = F.tid;
    LAS float* RWT = (LAS float*)F.lds;
    { const GAS f32x4* src = (const GAS f32x4*)(INF(31) + (size_t)l * 1024 * 16);
      f32x4 wv[8];
#pragma unroll
      for (int q = 0; q < 8; ++q) wv[q] = src[tid + NTHR * q];
#pragma unroll
      for (int q = 0; q < 8; ++q) { const int i = tid + NTHR * q; const f32x4 w = wv[q]; const int k = i >> 2, e4 = (i & 3) * 4;
          RWT[(e4 + 0) * 1024 + k] = w.x; RWT[(e4 + 1) * 1024 + k] = w.y; RWT[(e4 + 2) * 1024 + k] = w.z; RWT[(e4 + 3) * 1024 + k] = w.w; } }
    __syncthreads();
    const float* mod = WSP(float, WS_MOD);
    for (int m0 = gw; m0 < MTOK; m0 += 2 * NGW) {
        u32x2 yw[2][4]; f32x4 xr[2][4];
#pragma unroll
        for (int r = 0; r < 2; ++r) { const int mm = (m0 + r * NGW < MTOK) ? m0 + r * NGW : m0;
            const GAS u32x2* yr = (const GAS u32x2*)(WSP(bf16_t, WS_Y2) + (size_t)mm * DM) + lane;
#pragma unroll
            for (int j = 0; j < 4; ++j) yw[r][j] = yr[64 * j];
            ld_row_f32(xin + (size_t)mm * DM, lane, xr[r]); }
#pragma unroll
        for (int r = 0; r < 2; ++r) { const int m = m0 + r * NGW; if (m >= MTOK) break;
        const int b = m >> 13, s = m & 8191; const float* md = mod + (l * 2 + b) * 6144;
        f32x4 y2[4], x[4], pg[4], g1[4];
#pragma unroll
        for (int j = 0; j < 4; ++j) { y2[j] = (f32x4){bflo(yw[r][j].x), bfhi(yw[r][j].x), bflo(yw[r][j].y), bfhi(yw[r][j].y)}; x[j] = xr[r][j]; }
        ld_row_f32(INF(6) + l * 1024, lane, pg); ld_row_f32(md + 2048, lane, g1);
        const float rstd = __builtin_amdgcn_rsqf(row_ss(y2) * (1.0f / DM) + EPS);
#pragma unroll
        for (int j = 0; j < 4; ++j) x[j] = x[j] + g1[j] * (y2[j] * rstd * pg[j]);
        st_row_bf16(WSP(bf16_t, WS_X1) + (size_t)m * DM, lane, x);
        f32x4 h[4];
        modnorm(x, INF(7) + l * 1024, md + 4096, md + 3072, lane, h);
        st_row_bf16(WSP(bf16_t, WS_XN) + (size_t)m * DM, lane, h);
        float part[16];
#pragma unroll
        for (int e = 0; e < 16; ++e) part[e] = 0.f;
#pragma unroll
        for (int j = 0; j < 4; ++j) {
#pragma unroll
            for (int e = 0; e < 16; ++e) { const f32x4 w = *(const LAS f32x4*)(RWT + e * 1024 + 4 * lane + 256 * j);
                part[e] += (h[j].x * w.x + h[j].y * w.y) + (h[j].z * w.z + h[j].w * w.w); }
            asm volatile("" ::: "memory"); }
        float a8[8], a4[4], a2[2], lg;
        { const bool up = (lane & 32) != 0;
#pragma unroll
          for (int i = 0; i < 8; ++i) { const float keep = up ? part[8 + i] : part[i], send = up ? part[i] : part[8 + i]; a8[i] = keep + __shfl_xor(send, 32); } }
        { const bool up = (lane & 16) != 0;
#pragma unroll
          for (int i = 0; i < 4; ++i) { const float keep = up ? a8[4 + i] : a8[i], send = up ? a8[i] : a8[4 + i]; a4[i] = keep + __shfl_xor(send, 16); } }
        { const bool up = (lane & 8) != 0;
#pragma unroll
          for (int i = 0; i < 2; ++i) { const float keep = up ? a4[2 + i] : a4[i], send = up ? a4[i] : a4[2 + i]; a2[i] = keep + __shfl_xor(send, 8); } }
        { const bool up = (lane & 4) != 0; const float keep = up ? a2[1] : a2[0], send = up ? a2[0] : a2[1]; lg = keep + __shfl_xor(send, 4); }
        lg += __shfl_xor(lg, 2); lg += __shfl_xor(lg, 1);
        float mx = lg;
#pragma unroll
        for (int o = 4; o < 64; o <<= 1) mx = fmaxf(mx, __shfl_xor(mx, o));
        const float ex = fexp(lg - mx); float sm = ex;
#pragma unroll
        for (int o = 4; o < 64; o <<= 1) sm += __shfl_xor(sm, o);
        if ((lane & 3) == 0) WSP(float, WS_AFF)[((size_t)b * 16 + (lane >> 2)) * SEQ + s] = ex / sm;
        if (lane < 16) WSP(int, WS_SLOT)[(size_t)m * 16 + lane] = -1;
            }
    }
    __syncthreads();
}

__device__ __forceinline__ void topk_item(Frame& F, int it) {
    const int tid = F.tid, lane = F.lane, wave = F.wave;
    const int b = it >> 4, e = it & 15;
    LAS unsigned* wcnt = (LAS unsigned*)F.lds;
    LAS unsigned* wtot = wcnt + 16;
    unsigned key[16];
    { const GAS u32x4* src = (const GAS u32x4*)(WSP(float, WS_AFF) + (size_t)it * SEQ) + tid * 4;
#pragma unroll
      for (int q = 0; q < 4; ++q) { const u32x4 v = src[q]; key[4 * q] = v.x; key[4 * q + 1] = v.y; key[4 * q + 2] = v.z; key[4 * q + 3] = v.w; } }
    unsigned T = 0u;
#pragma unroll 1
    for (int bit = 30; bit >= 0; --bit) {
        const unsigned cand = T | (1u << bit);
        unsigned c = 0u;
#pragma unroll
        for (int i = 0; i < 16; ++i) c += (key[i] >= cand) ? 1u : 0u;
#pragma unroll
        for (int o = 1; o < 64; o <<= 1) c += __shfl_xor(c, o);
        LAS unsigned* wc = wcnt + (bit & 1) * 8;
        if (lane == 0) wc[wave] = c;
        __syncthreads();
        unsigned tot = 0u;
#pragma unroll
        for (int w = 0; w < NWAVES; ++w) tot += wc[w];
        if (tot >= (unsigned)CAP) T = cand;
    }
    unsigned cg = 0u, ce = 0u;
#pragma unroll
    for (int i = 0; i < 16; ++i) { cg += (key[i] > T) ? 1u : 0u; ce += (key[i] == T) ? 1u : 0u; }
    unsigned v = cg | (ce << 16), inc = v;
#pragma unroll
    for (int o = 1; o < 64; o <<= 1) { const unsigned n = __shfl_up(inc, o); if (lane >= o) inc += n; }
    __syncthreads();
    if (lane == 63) wtot[wave] = inc;
    __syncthreads();
    unsigned off = 0u, all = 0u;
#pragma unroll
    for (int w = 0; w < NWAVES; ++w) { const unsigned tw = wtot[w]; all += tw; if (w < wave) off += tw; }
    const unsigned need = (unsigned)CAP - (all & 0xffffu);
    const unsigned excl = off + inc - v;
    unsigned ng = excl & 0xffffu, ne = excl >> 16;
    int* IDX = WSP(int, WS_IDX) + (e * 2 + b) * CAP; int* SLOT = WSP(int, WS_SLOT);
#pragma unroll
    for (int i = 0; i < 16; ++i) { const int idx = tid * 16 + i; const unsigned k = key[i];
        const bool gt = k > T, eq = k == T; const bool sel = gt || (eq && ne < need);
        if (sel) { const int slot = (int)(ng + (ne < need ? ne : need)); IDX[slot] = b * SEQ + idx; SLOT[((size_t)b * SEQ + idx) * 16 + e] = slot; }
        ng += gt ? 1u : 0u; ne += eq ? 1u : 0u; }
    __syncthreads();
}

__device__ __forceinline__ void gather_phase(Frame& F) {
    const int gw = F.vcu * NWAVES + F.wave, NGW = F.G * NWAVES, lane = F.lane;
    const int* IDX = WSP(int, WS_IDX);
    for (int r = gw; r < NEXP * 2 * CAP; r += NGW) {
        const int e = r >> 11, b = (r >> 10) & 1, j = r & 1023;
        const int tok = IDX[(b * 16 + e) * CAP + j];
        const GAS u32x4* src = (const GAS u32x4*)(WSP(bf16_t, WS_XN) + ((size_t)b * SEQ + tok) * DM);
        GAS u32x4* dst = (GAS u32x4*)(WSP(bf16_t, WS_XE) + (size_t)r * DM);
        dst[lane] = src[lane]; dst[64 + lane] = src[64 + lane];
    }
}

__device__ __forceinline__ void combine_phase(Frame& F, int l) {
    const int gw = F.vcu * NWAVES + F.wave, NGW = F.G * NWAVES, lane = F.lane;
    const float* mod = WSP(float, WS_MOD);
    const bf16_t* YE = WSP(bf16_t, WS_YE);
    f32x4 pg[4]; ld_row_f32(INF(8) + l * 1024, lane, pg);
    for (int m0 = gw; m0 < MTOK; m0 += 2 * NGW) {
        int sl[2]; float gv[2]; f32x4 x1[2][4];
#pragma unroll
        for (int r = 0; r < 2; ++r) { const int mm = (m0 + r * NGW < MTOK) ? m0 + r * NGW : m0; const int b = mm >> 13, s = mm & 8191;
            sl[r] = -1; gv[r] = 0.f;
            if (lane < 16) { sl[r] = WSP(int, WS_SLOT)[(size_t)mm * 16 + lane]; gv[r] = WSP(float, WS_AFF)[((size_t)b * 16 + lane) * SEQ + s]; }
            { const GAS u32x2* xr = (const GAS u32x2*)(WSP(bf16_t, WS_X1) + (size_t)mm * DM) + lane;
#pragma unroll
              for (int j = 0; j < 4; ++j) { const u32x2 w = xr[64 * j]; x1[r][j] = (f32x4){bflo(w.x), bfhi(w.x), bflo(w.y), bfhi(w.y)}; } } }
#pragma unroll
        for (int r = 0; r < 2; ++r) { const int m = m0 + r * NGW; if (m >= MTOK) break;
            const int b = m >> 13; const float* md = mod + (l * 2 + b) * 6144;
            f32x4 acc[4];
#pragma unroll
            for (int j = 0; j < 4; ++j) acc[j] = (f32x4){0.f, 0.f, 0.f, 0.f};
            unsigned long long msk = __ballot(sl[r] >= 0) & 0xffffull;
            while (msk) {
                const int e0 = __builtin_ctzll(msk); msk &= msk - 1;
                int e1 = -1; if (msk) { e1 = __builtin_ctzll(msk); msk &= msk - 1; }
                const int s0 = __shfl(sl[r], e0); const float g0 = __shfl(gv[r], e0);
                const int s1 = __shfl(sl[r], e1 < 0 ? e0 : e1); const float g1 = (e1 < 0) ? 0.f : __shfl(gv[r], e1 < 0 ? e0 : e1);
                const GAS u32x2* r0 = (const GAS u32x2*)(YE + ((size_t)e0 * 2048 + b * CAP + s0) * DM) + lane;
                const GAS u32x2* r1 = (const GAS u32x2*)(YE + ((size_t)(e1 < 0 ? e0 : e1) * 2048 + b * CAP + s1) * DM) + lane;
                u32x2 w0[4], w1[4];
#pragma unroll
                for (int j = 0; j < 4; ++j) { w0[j] = r0[64 * j]; w1[j] = r1[64 * j]; }
#pragma unroll
                for (int j = 0; j < 4; ++j) { acc[j] += (f32x4){bflo(w0[j].x), bfhi(w0[j].x), bflo(w0[j].y), bfhi(w0[j].y)} * g0;
                                              acc[j] += (f32x4){bflo(w1[j].x), bfhi(w1[j].x), bflo(w1[j].y), bfhi(w1[j].y)} * g1; }
            }
            f32x4 g2[4]; ld_row_f32(md + 5120, lane, g2);
            const float rstd = __builtin_amdgcn_rsqf(row_ss(acc) * (1.0f / DM) + EPS);
            f32x4 xo[4];
#pragma unroll
            for (int j = 0; j < 4; ++j) xo[j] = x1[r][j] + g2[j] * (acc[j] * rstd * pg[j]);
            st_row_f32(F.a->out + (size_t)m * DM, lane, xo);
            if (l == 0) { f32x4 h[4]; const float* md1 = mod + (1 * 2 + b) * 6144;
                modnorm(xo, INF(5) + 1024, md1 + 1024, md1, lane, h);
                st_row_bf16(WSP(bf16_t, WS_XN) + (size_t)m * DM, lane, h); }
        }
    }
}

constexpr int PH_PER_LAYER = 11, N_PHASES = 2 + 2 * PH_PER_LAYER;
__global__ void __launch_bounds__(NTHR, 2) mega_fwd(Args args) {
    extern __shared__ __attribute__((aligned(16))) unsigned char lds_raw[];
    Frame F;
    F.lds = (LAS unsigned char*)lds_raw;
    F.tid = threadIdx.x; F.lane = F.tid & 63; F.wave = __builtin_amdgcn_readfirstlane(F.tid >> 6);
    F.G = gridDim.x; { const int bx = blockIdx.x; F.vcu = (F.G % 8 == 0) ? (bx % 8) * (F.G / 8) + bx / 8 : bx; }
    F.a = &args; F.ws = args.ws;
    volatile LAS unsigned* MISC = (volatile LAS unsigned*)(F.lds + MISC_OFF);
    for (int u = F.tid; u < (LDS_BYTES - LDSCTL_OFF) / 4; u += NTHR) ((LAS unsigned*)(F.lds + LDSCTL_OFF))[u] = 0u;
    __syncthreads();
    gu32* ctl = (gu32*)(F.ws + WS_CTL);
    XcdBarrier bar; bar.bar = (unsigned*)(ctl + CW_BAR); bar.x = 0; bar.st = nullptr;
#if !MK_SPLIT
    bar = xcd_barrier_post((unsigned*)(ctl + CW_BAR), MISC + 8);
#endif
    const int lo = args.ph_lo, hi = args.ph_hi;
    int ph = 0;
#if MK_SPLIT
#define SEAM() do { } while (0)
#else
#define SEAM() do { if (ph + 1 < hi) xcd_barrier(bar); } while (0)
#endif
#ifndef PHSEL
#define PHSEL -1
#endif
#ifndef PHMASK
#define PHMASK 0x7fff
#endif
#ifndef DBL_MASK
#define DBL_MASK 0
#endif
#define PHASE_BEGIN(id) if ((PHSEL < 0 || PHSEL == (id)) && ((PHMASK >> (id)) & 1) && lo <= ph && ph < hi) for (int rep_ = 0; rep_ < (((DBL_MASK >> (id)) & 1) ? 2 : 1); ++rep_) { if (rep_) xcd_barrier(bar); { int t_ = threadIdx.x; asm volatile("" : "+v"(t_)); F.tid = t_; F.lane = t_ & 63; F.wave = __builtin_amdgcn_readfirstlane(t_ >> 6); }
#define PHASE_END   SEAM(); } ++ph;

    PHASE_BEGIN(0) p0_phase(F); PHASE_END
    PHASE_BEGIN(1) p1_phase(F); PHASE_END
#pragma unroll 1
    for (int l = 0; l < 2; ++l) {
        const float* xin = (l == 0) ? (const float*)args.in[0] : (const float*)args.out;
        PHASE_BEGIN(2) {
            pg8::Gemm g{WSP(bf16_t, WS_XN), WSP(bf16_t, WS_WIN) + (size_t)l * DINP * 1024, MTOK, DINP, 1024}; pg8::StaticOrder S; S.init(MTOK, DINP, F.G, (int)blockIdx.x);
            pg8::EpiBf16 E{WSP(bf16_t, WS_U), DINP, DINP / 256};
            pg8::gemm_phase<pg8::EpiBf16, pg8::StaticOrder, true, true>(F.lds, g, S, E, F.tid);
        } PHASE_END
        PHASE_BEGIN(3) {
#ifndef SUBSEL
#define SUBSEL 0
#endif
#ifndef REP_A
#define REP_A 1
#define REP_B 1
#define REP_C 1
#define REP_D 1
#define REP_E 1
#endif
            for (int q_ = 0; q_ < REP_A; ++q_) for (int tl = F.vcu; tl < 256; tl += F.G) hy_prep_tile(F, tl, l);
            for (int q_ = 0; q_ < REP_B; ++q_) for (int p = F.vcu; p < 512; p += F.G) ml_local_pair(F, p, l);
            for (int q_ = 0; q_ < REP_C; ++q_) mla_prep_rows(F, l);
        } PHASE_END
        PHASE_BEGIN(4) {
            pg8::Gemm g{WSP(bf16_t, WS_AMLA), WSP(bf16_t, WS_WMLA) + (size_t)l * 1024 * 384, MTOK, 1024, 384}; pg8::StaticOrder S; S.init(MTOK, 1024, F.G, (int)blockIdx.x);
            EpiMla E{WSP(bf16_t, WS_Q), WSP(bf16_t, WS_KIMG), WSP(bf16_t, WS_VIMG), (const int*)F.a->in[2], 0.10206207261596577f * LOG2E};
            pg8::gemm_phase<EpiMla, pg8::StaticOrder, true, true>(F.lds, g, S, E, F.tid);
#define REFRESH_TID() do { int t_ = threadIdx.x; asm volatile("" : "+v"(t_)); F.tid = t_; F.lane = t_ & 63; F.wave = __builtin_amdgcn_readfirstlane(t_ >> 6); } while (0)
            REFRESH_TID();
            ml_scan(F);
            REFRESH_TID();
#ifndef HY_REP
#define HY_REP 1
#endif
            for (int rep2_ = 0; rep2_ < HY_REP; ++rep2_) for (int c = F.vcu; c < 256; c += F.G) hyena_item(F, c, l);
        } PHASE_END
        PHASE_BEGIN(5) {
            for (int q_ = 0; q_ < REP_D; ++q_) for (int u = F.vcu; u < 256; u += F.G) attn_unit(F, u >> 5, u & 31);
            for (int q_ = 0; q_ < REP_E; ++q_) for (int p = F.vcu; p < 512; p += F.G) ml_out_pair(F, p, l);
        } PHASE_END
        PHASE_BEGIN(6) headnorm_phase(F, l); PHASE_END
        PHASE_BEGIN(7) {
            pg8::Gemm g{WSP(bf16_t, WS_YN), WSP(bf16_t, WS_WOUT) + (size_t)l * 1024 * 1024, MTOK, 1024, 1024}; pg8::StaticOrder S; S.init(MTOK, 1024, F.G, (int)blockIdx.x);
            pg8::EpiBf16 E{WSP(bf16_t, WS_Y2), 1024, 4};
            pg8::gemm_phase<pg8::EpiBf16, pg8::StaticOrder, true, true>(F.lds, g, S, E, F.tid);
        } PHASE_END
        PHASE_BEGIN(8) post_mixer_phase(F, l, xin); PHASE_END
        PHASE_BEGIN(9) { for (int it = F.vcu; it < 32; it += F.G) topk_item(F, it); } PHASE_END
        PHASE_BEGIN(10) {
            pg8::Gemm g{WSP(bf16_t, WS_XN), WSP(bf16_t, WS_WGU) + (size_t)l * NEXP * 4096 * 1024, NEXP * 2048, NEXP * 4096, 1024, WSP(int, WS_IDX)}; pg8::GroupedOrder S; S.init(16, F.G, (int)blockIdx.x);
            pg8::EpiSwiGLU E{WSP(bf16_t, WS_ACT), LDFF};
            pg8::gemm_phase<pg8::EpiSwiGLU, pg8::GroupedOrder, true, true, true>(F.lds, g, S, E, F.tid);
        } PHASE_END
        PHASE_BEGIN(11) {
            pg8::Gemm g{WSP(bf16_t, WS_ACT), WSP(bf16_t, WS_WDN) + (size_t)l * NEXP * 1024 * LDFF, NEXP * 2048, NEXP * 1024, 2048, nullptr, LDFF, LDFF}; pg8::GroupedOrder S; S.init(4, F.G, (int)blockIdx.x);
            pg8::EpiBf16 E{WSP(bf16_t, WS_YE), 1024, 4};
            pg8::gemm_phase<pg8::EpiBf16, pg8::GroupedOrder, true, true>(F.lds, g, S, E, F.tid);
        } PHASE_END
        PHASE_BEGIN(12) combine_phase(F, l); PHASE_END
    }
}

extern "C" void kernel_launch(void* const* d_in, const int* in_sizes, int n_in, void* d_out, int out_size, void* d_ws, size_t ws_size, hipStream_t stream) {
    static int grid = 0;
    if (grid == 0) {
        if (n_in != 35 || out_size != MTOK * DM || ws_size < WS_END) { fprintf(stderr, "kernel_launch: unexpected shapes: n_in %d out %d ws %zu (need %zu)\n", n_in, out_size, ws_size, (size_t)WS_END); grid = -1; return; }
        int dev = 0, cus = 0, per_cu = 0;
        if (hipGetDevice(&dev) != hipSuccess || hipDeviceGetAttribute(&cus, hipDeviceAttributeMultiprocessorCount, dev) != hipSuccess) { grid = -1; return; }
        if (hipFuncSetAttribute((const void*)mega_fwd, hipFuncAttributeMaxDynamicSharedMemorySize, LDS_BYTES) != hipSuccess) { fprintf(stderr, "kernel_launch: hipFuncSetAttribute failed\n"); grid = -1; return; }
        (void)hipOccupancyMaxActiveBlocksPerMultiprocessor(&per_cu, (const void*)mega_fwd, NTHR, LDS_BYTES);
        (void)hipGetLastError();
        grid = cus > 0 ? cus : 256;
        if (per_cu < 1) fprintf(stderr, "kernel_launch: occupancy query reports %d\n", per_cu);
    }
    if (grid < 0) return;
    (void)hipMemsetAsync((char*)d_ws + WS_CTL, 0, CTL_ZERO_BYTES, stream);
    Args a{};
    for (int i = 0; i < 35; ++i) a.in[i] = d_in[i];
    a.out = (float*)d_out; a.ws = (unsigned char*)d_ws;
#if MK_SPLIT
    for (int p = 0; p < N_PHASES; ++p) { a.ph_lo = p; a.ph_hi = p + 1; hipLaunchKernelGGL(mega_fwd, dim3(grid), dim3(NTHR), LDS_BYTES, stream, a); }
#else
    a.ph_lo = 0; a.ph_hi = N_PHASES;
    hipLaunchKernelGGL(mega_fwd, dim3(grid), dim3(NTHR), LDS_BYTES, stream, a);
#endif
}
```

```cpp
#include <hip/hip_runtime.h>
#include <cstdio>
#include <cstdint>

#ifndef MK_SPLIT
#define MK_SPLIT 0
#endif

#define GAS __attribute__((address_space(1)))
#define LAS __attribute__((address_space(3)))
typedef GAS unsigned gu32;
#define RLX_AGENT __ATOMIC_RELAXED, __HIP_MEMORY_SCOPE_AGENT
typedef unsigned short bf16_t;
typedef short bf16x8 __attribute__((ext_vector_type(8)));
typedef short s16x4 __attribute__((ext_vector_type(4)));
typedef float f32x4 __attribute__((ext_vector_type(4)));
typedef float f32x2 __attribute__((ext_vector_type(2)));
typedef float f32x16 __attribute__((ext_vector_type(16)));
typedef unsigned u32x4 __attribute__((ext_vector_type(4)));
typedef unsigned u32x2 __attribute__((ext_vector_type(2)));
typedef __bf16 bf16x2_t __attribute__((ext_vector_type(2)));

namespace pg8 {
#define PG8_LAS __attribute__((address_space(3)))
constexpr int BM = 256, BK = 64, HALF = 128, HTB = HALF * BK * 2, STAGE_BYTES = 8 * HTB, NXCD = 8, WGM = 8;
__host__ __device__ __forceinline__ int lds_byte(int r, int c) { const int st = (r >> 4) * 2 + (c >> 5), rr = r & 15, cc = c & 31, ob = rr * 64 + cc * 2; return st * 1024 + (ob ^ (((ob >> 9) & 1) << 5)); }
__host__ __device__ __forceinline__ void stage_rc(int b, int& R, int& C) { const int st = b / 1024, sb = b % 1024, swz = sb ^ (((sb >> 9) & 1) << 5); R = (st >> 1) * 16 + swz / 64; C = (st & 1) * 32 + (swz % 64) / 2; }
__host__ __device__ __forceinline__ int perm32(int rho) { const int n = rho >> 4, i = rho & 15; return 8 * (i >> 2) + 4 * n + (i & 3); }
struct Unit { int pm, pn; };
struct Gemm { const bf16_t* A; const bf16_t* Bt; int M, N, K; const int* rowidx; int lda, ldb; };
struct StaticOrder {
    int nM, nN, nwg, G, c;
    __host__ __device__ void init(int M, int N, int G_, int c_) { nM = M / BM; nN = N / BM; nwg = nM * nN; G = G_; c = c_; }
    __host__ __device__ bool next(int i, Unit& u) const {
        const long L = (long)i * G + c; if (L >= nwg) return false;
        int wgid = (int)L; { const int q = nwg / NXCD, r = nwg % NXCD, xcd = wgid % NXCD, off = wgid / NXCD; wgid = (xcd < r ? xcd * (q + 1) : r * (q + 1) + (xcd - r) * q) + off; }
        const int nig = WGM * nN, gid = wgid / nig, fm = gid * WGM, gsz = (nM - fm) < WGM ? (nM - fm) : WGM;
        u.pm = fm + ((wgid % nig) % gsz); u.pn = (wgid % nig) / gsz; return true;
    }
    __device__ __forceinline__ void a_ready(const Unit&) const {}
    __device__ __forceinline__ void done(const Unit&) const {}
};
struct GroupedOrder {
    int nNl, total, G, c;
    __host__ __device__ void init(int nNl_, int G_, int c_) { nNl = nNl_; total = 16 * 8 * nNl_; G = G_; c = c_; }
    __host__ __device__ bool next(int i, Unit& u) const {
        const long L = (long)i * G + c; if (L >= total) return false;
        if (G == 256 && (nNl == 16 || nNl == 4)) {
            const int x = c & 7, w = c >> 3;
            if (nNl == 16) { const int e = 2 * i + (w >> 4), q = w & 15; u.pm = e * 8 + 4 * (x & 1) + (q & 3); u.pn = e * 16 + 4 * (x >> 1) + (q >> 2); }
            else { const int e = 8 * i + x; u.pm = e * 8 + (w & 7); u.pn = e * 4 + (w >> 3); }
            return true;
        }
        const int per_e = 8 * nNl, e = (int)L / per_e, r = (int)L % per_e;
        u.pm = e * 8 + (r % 8); u.pn = e * nNl + (r / 8); return true;
    }
    __device__ __forceinline__ void a_ready(const Unit&) const {}
    __device__ __forceinline__ void done(const Unit&) const {}
};
__device__ __forceinline__ unsigned cvt_pk_bf16(float lo, float hi) { f32x2 v = {lo, hi}; bf16x2_t b = __builtin_convertvector(v, bf16x2_t); return __builtin_bit_cast(unsigned, b); }

struct EpiBf16 {
    static constexpr bool PERM = true, AFTER_DRAIN = false;
    bf16_t* O; int ldc; int ntn;
    __device__ __forceinline__ void operator()(const f32x4 (&acc)[2][2][4][2], const Unit& u, int wr, int wc, int fr, int fq) const {
        const int row0 = u.pm * BM + wr * 64 + fr; const int colt = (u.pn % ntn) * BM;
        const int col0 = colt + wc * 32 + 8 * fq;
#pragma unroll
        for (int ai = 0; ai < 2; ++ai)
#pragma unroll
            for (int m = 0; m < 4; ++m) { bf16_t* rowp = O + (size_t)(row0 + ai * HALF + m * 16) * ldc + col0;
#pragma unroll
                for (int bj = 0; bj < 2; ++bj) { const f32x4 v0 = acc[ai][bj][m][0], v1 = acc[ai][bj][m][1];
                    u32x4 w; w.x = cvt_pk_bf16(v0[0], v0[1]); w.y = cvt_pk_bf16(v0[2], v0[3]); w.z = cvt_pk_bf16(v1[0], v1[1]); w.w = cvt_pk_bf16(v1[2], v1[3]);
                    *(u32x4*)(rowp + bj * HALF) = w; } }
    }
};
struct EpiF32 {
    static constexpr bool PERM = false, AFTER_DRAIN = false;
    float* O; int ldc;
    __device__ __forceinline__ void operator()(const f32x4 (&acc)[2][2][4][2], const Unit& u, int wr, int wc, int fr, int fq) const {
        const int col0 = u.pn * BM + wc * 32 + 4 * fq;
#pragma unroll
        for (int ai = 0; ai < 2; ++ai)
#pragma unroll
            for (int m = 0; m < 4; ++m) { float* rowp = O + (size_t)(u.pm * BM + ai * HALF + wr * 64 + m * 16 + fr) * ldc + col0;
#pragma unroll
                for (int bj = 0; bj < 2; ++bj)
#pragma unroll
                    for (int n = 0; n < 2; ++n) *(f32x4*)(rowp + bj * HALF + n * 16) = acc[ai][bj][m][n]; }
    }
};
__device__ __forceinline__ float silu_f(float a) { return a * __builtin_amdgcn_rcpf(1.0f + __builtin_amdgcn_exp2f(-1.4426950408889634f * a)); }
struct EpiSwiGLU {
    static constexpr bool PERM = true, AFTER_DRAIN = false;
    bf16_t* O; int ldc;
    __device__ __forceinline__ void operator()(const f32x4 (&acc)[2][2][4][2], const Unit& u, int wr, int wc, int fr, int fq) const {
        const int row0 = u.pm * BM + wr * 64 + fr; const int col0 = (u.pn % 16) * HALF + wc * 32 + 8 * fq;
#pragma unroll
        for (int ai = 0; ai < 2; ++ai)
#pragma unroll
            for (int m = 0; m < 4; ++m) { bf16_t* rowp = O + (size_t)(row0 + ai * HALF + m * 16) * ldc + col0;
                const f32x4 g0 = acc[ai][0][m][0], g1 = acc[ai][0][m][1], u0 = acc[ai][1][m][0], u1 = acc[ai][1][m][1];
                u32x4 w;
                w.x = cvt_pk_bf16(silu_f(g0[0]) * u0[0], silu_f(g0[1]) * u0[1]); w.y = cvt_pk_bf16(silu_f(g0[2]) * u0[2], silu_f(g0[3]) * u0[3]);
                w.z = cvt_pk_bf16(silu_f(g1[0]) * u1[0], silu_f(g1[1]) * u1[1]); w.w = cvt_pk_bf16(silu_f(g1[2]) * u1[2], silu_f(g1[3]) * u1[3]);
                *(u32x4*)rowp = w; }
    }
};

template <class Epi, class Sched, bool ALIGN_EPI = false, bool SP2 = false, bool GATHER = false>
__device__ __forceinline__ void gemm_phase(PG8_LAS unsigned char* lds, const Gemm g, const Sched& S, const Epi& E, const int tid) {
    const int wid = __builtin_amdgcn_readfirstlane(tid >> 6), lane = tid & 63, wr = wid >> 2, wc = wid & 3, fr = lane & 15, fq = lane >> 4;
    int K_ = g.K; asm volatile("" : "+s"(K_));
    const int K = K_, nt = K / BK;
    const int lda = g.lda ? g.lda : K, ldb = g.ldb ? g.ldb : K;
    unsigned voffA[2], voffB[2];
#pragma unroll
    for (int i = 0; i < 2; ++i) { int R, C; stage_rc(tid * 16 + i * 8192, R, C); const int Rb = Epi::PERM ? ((R & ~31) + perm32(R & 31)) : R;
        voffA[i] = (unsigned)(R * lda + C) * 2u; voffB[i] = (unsigned)(Rb * ldb + C) * 2u; }
    const size_t kstep = (size_t)(BK * 2);
    const size_t hstepA = (size_t)HALF * lda * 2, hstepB = (size_t)HALF * ldb * 2;
    const size_t tstepA = 2 * hstepA, tstepB = 2 * hstepB;
    const unsigned ldsw = (unsigned)wid * 1024u;
    const int aoff = lds_byte(wr * 64 + fr, fq * 8), boff = lds_byte(wc * 32 + fr, fq * 8);
#define PG8_SA(b, h) (((b) * 2 + (h)) * HTB)
#define PG8_SB(b, h) ((4 + (b) * 2 + (h)) * HTB)
#define PG8_STAGE(bufoff, gbase, voff) do { _Pragma("unroll") for (int _i = 0; _i < 2; ++_i) \
        __builtin_amdgcn_global_load_lds((const unsigned*)((const char*)(gbase) + (voff)[_i]), (PG8_LAS unsigned*)(lds + (bufoff) + ldsw + _i * 8192), 16, 0, 0); } while (0)
#define PG8_LDA(dst, b, h) do { _Pragma("unroll") for (int m = 0; m < 4; ++m) _Pragma("unroll") for (int k = 0; k < 2; ++k) dst[m][k] = *(const PG8_LAS bf16x8*)(lds + PG8_SA(b, h) + aoff + m * 2048 + k * 1024); } while (0)
#define PG8_LDB(dst, b, h) do { _Pragma("unroll") for (int n = 0; n < 2; ++n) _Pragma("unroll") for (int k = 0; k < 2; ++k) dst[n][k] = *(const PG8_LAS bf16x8*)(lds + PG8_SB(b, h) + boff + n * 2048 + k * 1024); } while (0)
#define PG8_MMA(ai, bj, At, Bt) do { __builtin_amdgcn_s_setprio(1); _Pragma("unroll") for (int m = 0; m < 4; ++m) _Pragma("unroll") for (int n = 0; n < 2; ++n) _Pragma("unroll") for (int k = 0; k < 2; ++k) \
        acc[ai][bj][m][n] = __builtin_amdgcn_mfma_f32_16x16x32_bf16(Bt[n][k], At[m][k], acc[ai][bj][m][n], 0, 0, 0); __builtin_amdgcn_s_setprio(0); } while (0)
#define PG8_WAIT_V(n) asm volatile("s_waitcnt vmcnt(" #n ")" ::: "memory")
#define PG8_WAIT_L(n) asm volatile("s_waitcnt lgkmcnt(" #n ")" ::: "memory")
#define PG8_BAR __builtin_amdgcn_s_barrier()
#define PG8_SCHED __builtin_amdgcn_sched_barrier(0)
    Unit cur, nxt; int ui = 0;
    if (!S.next(0, cur)) return;
    f32x4 acc[2][2][4][2];
#pragma unroll
    for (int a = 0; a < 2; ++a)
#pragma unroll
        for (int b = 0; b < 2; ++b)
#pragma unroll
            for (int m = 0; m < 4; ++m)
#pragma unroll
                for (int n = 0; n < 2; ++n) acc[a][b][m][n] = (f32x4){0.f, 0.f, 0.f, 0.f};
    bf16x8 At[4][2], B0[2][2], B1[2][2];
    const char* cA = GATHER ? (const char*)g.A : (const char*)g.A + (size_t)cur.pm * tstepA; const char* cB = (const char*)g.Bt + (size_t)cur.pn * tstepB;
    unsigned gc0[2] = {0u, 0u}, gc1[2] = {0u, 0u}, gn0[2] = {0u, 0u}, gn1[2] = {0u, 0u}; int gR[2] = {0, 0}; unsigned gC[2] = {0u, 0u};
    if constexpr (GATHER) {
#pragma unroll
        for (int i = 0; i < 2; ++i) { int R, C; stage_rc(tid * 16 + i * 8192, R, C); gR[i] = R; gC[i] = (unsigned)C * 2u;
            gc0[i] = (unsigned)g.rowidx[cur.pm * BM + R] * (unsigned)(lda * 2) + gC[i]; gc1[i] = (unsigned)g.rowidx[cur.pm * BM + HALF + R] * (unsigned)(lda * 2) + gC[i]; }
    }
#define PG8_STAGE_A(bufoff, base, half, o0, o1) do { if constexpr (GATHER) { if ((half) == 0) PG8_STAGE(bufoff, base, o0); else PG8_STAGE(bufoff, base, o1); } \
        else PG8_STAGE(bufoff, (base) + ((half) ? hstepA : 0), voffA); } while (0)
    S.a_ready(cur);
    if constexpr (SP2) {
        PG8_STAGE(PG8_SB(0, 0), cB, voffB); PG8_STAGE(PG8_SB(0, 1), cB + hstepB, voffB); PG8_STAGE_A(PG8_SA(0, 0), cA, 0, gc0, gc1); PG8_STAGE_A(PG8_SA(0, 1), cA, 1, gc0, gc1);
        if (wr == 1) PG8_BAR;
        PG8_WAIT_V(2); PG8_BAR;
        PG8_STAGE(PG8_SB(1, 0), cB + kstep, voffB); PG8_STAGE_A(PG8_SA(1, 0), cA + kstep, 0, gc0, gc1); PG8_STAGE(PG8_SB(1, 1), cB + hstepB + kstep, voffB);
        PG8_WAIT_V(6); PG8_BAR;
    } else {
        PG8_STAGE(PG8_SB(0, 0), cB, voffB); PG8_STAGE(PG8_SA(0, 0), cA, voffA); PG8_STAGE(PG8_SB(0, 1), cB + hstepB, voffB); PG8_STAGE(PG8_SA(0, 1), cA + hstepA, voffA);
        if (wr == 1) PG8_BAR;
        PG8_WAIT_V(4); PG8_BAR;
        PG8_STAGE(PG8_SB(1, 0), cB + kstep, voffB); PG8_STAGE(PG8_SA(1, 0), cA + kstep, voffA); PG8_STAGE(PG8_SB(1, 1), cB + hstepB + kstep, voffB);
        PG8_WAIT_V(6); PG8_BAR;
    }
    for (;;) {
        const bool has_next = S.next(ui + 1, nxt);
        const char* nA = GATHER ? cA : (has_next ? (const char*)g.A + (size_t)nxt.pm * tstepA : cA); const char* nB = has_next ? (const char*)g.Bt + (size_t)nxt.pn * tstepB : cB;
        if constexpr (GATHER) { const int npm = has_next ? nxt.pm : cur.pm;
#pragma unroll
            for (int i = 0; i < 2; ++i) { gn0[i] = (unsigned)g.rowidx[npm * BM + gR[i]] * (unsigned)(lda * 2) + gC[i]; gn1[i] = (unsigned)g.rowidx[npm * BM + HALF + gR[i]] * (unsigned)(lda * 2) + gC[i]; } }
        for (int t = 0; t < nt; t += 2) {
            const bool last = (t == nt - 2);
            const char* a1 = cA + (size_t)(t + 1) * kstep;
            const char* a2 = last ? nA : cA + (size_t)(t + 2) * kstep; const char* b2 = last ? nB : cB + (size_t)(t + 2) * kstep;
            const char* a3 = a2 + kstep; const char* b3 = b2 + kstep;
            if (last && has_next) S.a_ready(nxt);
            if constexpr (SP2) {
            unsigned gs0[2], gs1[2];
#pragma unroll
            for (int i = 0; i < 2; ++i) { gs0[i] = last ? gn0[i] : gc0[i]; gs1[i] = last ? gn1[i] : gc1[i]; }
            PG8_LDB(B0, 0, 0); PG8_LDB(B1, 0, 1); PG8_SCHED; PG8_LDA(At, 0, 0); PG8_STAGE_A(PG8_SA(1, 1), a1, 1, gc0, gc1);
            PG8_WAIT_V(8); PG8_WAIT_L(0); PG8_BAR; PG8_MMA(0, 0, At, B0); PG8_MMA(0, 1, At, B1); PG8_BAR; PG8_SCHED;
            PG8_LDA(At, 0, 1); PG8_STAGE(PG8_SB(0, 0), b2, voffB); PG8_STAGE(PG8_SB(0, 1), b2 + hstepB, voffB); PG8_STAGE_A(PG8_SA(0, 0), a2, 0, gs0, gs1);
            PG8_WAIT_V(8); PG8_WAIT_L(0); PG8_BAR; PG8_MMA(1, 0, At, B0); PG8_MMA(1, 1, At, B1); PG8_BAR; PG8_SCHED;
            PG8_LDB(B0, 1, 0); PG8_LDB(B1, 1, 1); PG8_SCHED; PG8_LDA(At, 1, 0); PG8_STAGE_A(PG8_SA(0, 1), a2, 1, gs0, gs1);
            PG8_WAIT_V(8); PG8_WAIT_L(0); PG8_BAR; PG8_MMA(0, 0, At, B0); PG8_MMA(0, 1, At, B1); PG8_BAR; PG8_SCHED;
            PG8_LDA(At, 1, 1); PG8_STAGE(PG8_SB(1, 0), b3, voffB); PG8_STAGE(PG8_SB(1, 1), b3 + hstepB, voffB); PG8_STAGE_A(PG8_SA(1, 0), a3, 0, gs0, gs1);
            PG8_WAIT_V(8); PG8_WAIT_L(0); PG8_BAR; PG8_MMA(1, 0, At, B0); PG8_MMA(1, 1, At, B1); PG8_BAR; PG8_SCHED;
            } else {
            PG8_LDB(B0, 0, 0); PG8_SCHED; PG8_LDA(At, 0, 0); PG8_STAGE(PG8_SA(1, 1), a1 + hstepA, voffA);
            PG8_WAIT_L(8); PG8_BAR; PG8_WAIT_L(0); PG8_MMA(0, 0, At, B0); PG8_BAR; PG8_SCHED;
            PG8_LDB(B1, 0, 1); PG8_STAGE(PG8_SB(0, 0), b2, voffB);
            PG8_BAR; PG8_WAIT_L(0); PG8_MMA(0, 1, At, B1); PG8_BAR;
            PG8_LDA(At, 0, 1); PG8_STAGE(PG8_SA(0, 0), a2, voffA);
            PG8_BAR; PG8_WAIT_L(0); PG8_MMA(1, 0, At, B0); PG8_BAR; PG8_SCHED;
            PG8_STAGE(PG8_SB(0, 1), b2 + hstepB, voffB);
            PG8_WAIT_V(6); PG8_BAR; PG8_MMA(1, 1, At, B1); PG8_BAR;
            PG8_LDB(B0, 1, 0); PG8_SCHED; PG8_LDA(At, 1, 0); PG8_STAGE(PG8_SA(0, 1), a2 + hstepA, voffA);
            PG8_WAIT_L(8); PG8_BAR; PG8_WAIT_L(0); PG8_MMA(0, 0, At, B0); PG8_BAR; PG8_SCHED;
            PG8_LDB(B1, 1, 1); PG8_STAGE(PG8_SB(1, 0), b3, voffB);
            PG8_BAR; PG8_WAIT_L(0); PG8_MMA(0, 1, At, B1); PG8_BAR;
            PG8_LDA(At, 1, 1); PG8_STAGE(PG8_SA(1, 0), a3, voffA);
            PG8_BAR; PG8_WAIT_L(0); PG8_MMA(1, 0, At, B0); PG8_BAR; PG8_SCHED;
            PG8_STAGE(PG8_SB(1, 1), b3 + hstepB, voffB);
            PG8_WAIT_V(6); PG8_BAR; PG8_MMA(1, 1, At, B1); PG8_BAR;
            }
        }
        if constexpr (ALIGN_EPI) { if (wr == 0) PG8_BAR; }
        if constexpr (!Epi::AFTER_DRAIN) { E(acc, cur, wr, wc, fr, fq); S.done(cur); }
        if (!has_next) break;
#pragma unroll
        for (int a = 0; a < 2; ++a)
#pragma unroll
            for (int b = 0; b < 2; ++b)
#pragma unroll
                for (int m = 0; m < 4; ++m)
#pragma unroll
                    for (int n = 0; n < 2; ++n) acc[a][b][m][n] = (f32x4){0.f, 0.f, 0.f, 0.f};
        cur = nxt; cA = nA; cB = nB; ++ui;
        if constexpr (GATHER) { gc0[0] = gn0[0]; gc0[1] = gn0[1]; gc1[0] = gn1[0]; gc1[1] = gn1[1]; }
        if constexpr (ALIGN_EPI) { if (wr == 1) PG8_BAR; }
    }
    PG8_WAIT_V(0);
    if constexpr (!ALIGN_EPI) { if (wr == 0) PG8_BAR; }
    PG8_BAR;
#undef PG8_SA
#undef PG8_SB
#undef PG8_STAGE
#undef PG8_STAGE_A
#undef PG8_LDA
#undef PG8_LDB
#undef PG8_MMA
#undef PG8_WAIT_V
#undef PG8_WAIT_L
#undef PG8_BAR
#undef PG8_SCHED
}
}

__device__ __forceinline__ double rope_kd(int i) {
    switch (i) { case 0: return 0.15915494309189535; case 1: return 0.08949940160889101; case 2: return 0.050329212104487035; case 3: return 0.0283021958306234;
        case 4: return 0.015915494309189534; case 5: return 0.008949940160889102; case 6: return 0.005032921210448704; case 7: return 0.00283021958306234;
        case 8: return 0.0015915494309189536; case 9: return 0.0008949940160889102; case 10: return 0.0005032921210448703; case 11: return 0.00028302195830623395;
        case 12: return 0.00015915494309189535; case 13: return 8.949940160889102e-05; case 14: return 5.0329212104487035e-05; default: return 2.8302195830623396e-05; }
}
__device__ __forceinline__ float rope_frac(int p, int i) {
    const double kd = rope_kd(i); const float kh = (float)kd, kl = (float)(kd - (double)kh), pf = (float)p;
    const float r1 = pf * kh, e1 = __builtin_fmaf(pf, kh, -r1) + pf * kl;
    float fr = (r1 - __builtin_floorf(r1)) + e1;
    return fr - __builtin_floorf(fr);
}
struct EpiMla {
    static constexpr bool PERM = true, AFTER_DRAIN = false;
    bf16_t* Q; bf16_t* KI; bf16_t* VI; const int* pos; float qscale;
    __device__ __forceinline__ void operator()(const f32x4 (&acc)[2][2][4][2], const pg8::Unit& u, int wr, int wc, int fr, int fq) const {
        const int tile = u.pn & 3;
#pragma unroll
        for (int ai = 0; ai < 2; ++ai)
#pragma unroll
            for (int m = 0; m < 4; ++m) {
                int t = u.pm * 256 + ai * 128 + wr * 64 + m * 16 + fr; asm volatile("" : "+v"(t)); const int b = t >> 13, sq = t & 8191;
                if (tile == 1) {
                    const int p = pos[t]; const float sgn = (fq < 2) ? -1.0f : 1.0f;
                    u32x4 w;
#pragma unroll
                    for (int n = 0; n < 2; ++n) { const f32x4 vv = acc[ai][0][m][n]; float o4[4];
#pragma unroll
                        for (int j = 0; j < 4; ++j) { const float own = vv[j], oth = __shfl_xor(own, 32);
                            const float rr = (fq & 1) ? rope_frac(p, 8 + 4 * n + j) : rope_frac(p, 4 * n + j), c = __builtin_amdgcn_cosf(rr), sn = __builtin_amdgcn_sinf(rr);
                            o4[j] = (own * c + sgn * oth * sn) * qscale; }
                        if (n == 0) { w.x = pg8::cvt_pk_bf16(o4[0], o4[1]); w.y = pg8::cvt_pk_bf16(o4[2], o4[3]); } else { w.z = pg8::cvt_pk_bf16(o4[0], o4[1]); w.w = pg8::cvt_pk_bf16(o4[2], o4[3]); }
                        asm volatile("" ::: "memory"); }
                    *(u32x4*)(Q + ((size_t)(b * 4 + wc) * 8192 + sq) * 96 + 64 + 8 * fq) = w;
                    asm volatile("" ::: "memory");
                } else {
#pragma unroll
                    for (int bj = 0; bj < 2; ++bj) { const f32x4 v0 = acc[ai][bj][m][0], v1 = acc[ai][bj][m][1];
                        const int h = 2 * bj + (wc >> 1), bh = b * 4 + h;
                        if (tile == 0) { u32x4 w; w.x = pg8::cvt_pk_bf16(v0[0] * qscale, v0[1] * qscale); w.y = pg8::cvt_pk_bf16(v0[2] * qscale, v0[3] * qscale); w.z = pg8::cvt_pk_bf16(v1[0] * qscale, v1[1] * qscale); w.w = pg8::cvt_pk_bf16(v1[2] * qscale, v1[3] * qscale);
                            *(u32x4*)(Q + ((size_t)bh * 8192 + sq) * 96 + 32 * (wc & 1) + 8 * fq) = w; }
                        else { u32x4 w; w.x = pg8::cvt_pk_bf16(v0[0], v0[1]); w.y = pg8::cvt_pk_bf16(v0[2], v0[3]); w.z = pg8::cvt_pk_bf16(v1[0], v1[1]); w.w = pg8::cvt_pk_bf16(v1[2], v1[3]);
                            if (tile == 2) *(u32x4*)(KI + ((size_t)bh * 128 + (sq >> 6)) * 6144 + (4 * (wc & 1) + fq) * 512 + (sq & 63) * 8) = w;
                            else *(u32x4*)(VI + ((size_t)bh * 128 + (sq >> 6)) * 4096 + (wc & 1) * 2048 + (sq & 63) * 32 + 8 * fq) = w; } }
                }
            }
    }
};

constexpr int NWAVES = 8, NTHR = 512;
constexpr int BATCH = 2, SEQ = 8192, DM = 1024, MTOK = BATCH * SEQ;
constexpr int DIN = 2960, DINP = 3072;
constexpr int NEXP = 16, CAP = 1024, EFF = 2048;
constexpr int LDFF = EFF + 64;
constexpr float EPS = 1e-6f;
constexpr int U_MLQ = 0, U_MLK = 256, U_MLV = 512, U_MLO = 768, U_MLG = 1024, U_CQ = 1040, U_CKV = 1264, U_KR = 1392, U_HY = 1424, U_SC = 2192;
constexpr float LOG2E = 1.4426950408889634f;

constexpr size_t MiB = 1u << 20;
constexpr size_t WS_CTL = 0, CTL_ZERO_BYTES = 1 * MiB;
constexpr size_t WS_MOD = 1 * MiB;
constexpr size_t WS_MLS = 1 * MiB + 128 * 1024;
constexpr size_t WS_MLN = 1 * MiB + 256 * 1024;
constexpr size_t WS_AFF = 2 * MiB;
constexpr size_t WS_SLOT = 3 * MiB;
constexpr size_t WS_IDX = 4 * MiB;
constexpr size_t WS_HID = 5 * MiB;
constexpr size_t WS_W3T = 7 * MiB;
constexpr size_t WS_WMLA = 9 * MiB;
constexpr size_t WS_WOUT = 11 * MiB;
constexpr size_t WS_WIN = 15 * MiB;
constexpr size_t WS_WGU = 28 * MiB;
constexpr size_t WS_WDN = 284 * MiB;
constexpr size_t WS_XN = 616 * MiB;
constexpr size_t WS_AMLA = 444 * MiB;
constexpr size_t WS_Q = 456 * MiB;
constexpr size_t WS_KIMG = 468 * MiB;
constexpr size_t WS_VIMG = 480 * MiB;
constexpr size_t WS_MLC = 488 * MiB;
constexpr size_t WS_HF = 504 * MiB;
constexpr size_t WS_HB = 520 * MiB;
constexpr size_t WS_YATT = 536 * MiB;
constexpr size_t WS_YHT = 544 * MiB;
constexpr size_t WS_YN = 552 * MiB;
constexpr size_t WS_X1 = 584 * MiB;
constexpr size_t WS_U = 648 * MiB;
constexpr size_t WS_OMLA = 744 * MiB;
constexpr size_t WS_ACT = 648 * MiB;
constexpr size_t WS_KF = 776 * MiB;
constexpr size_t WS_Y2 = 776 * MiB;
constexpr size_t WS_XE = 776 * MiB;
constexpr size_t WS_YE = 840 * MiB;
constexpr size_t WS_HYT = 904 * MiB;
constexpr size_t WS_FILT = 956 * MiB;
constexpr size_t WS_END = 1020 * MiB;
constexpr int CW_BAR = 4096;

constexpr int RING_BYTES = 139264;
constexpr int LDSCTL_OFF = RING_BYTES, MISC_OFF = LDSCTL_OFF + 320;
constexpr int XTRA_OFF = RING_BYTES + 1024;
constexpr int LDS_BYTES = 147456;

__device__ __forceinline__ float bf2f(unsigned short u) { return __uint_as_float((unsigned)u << 16); }
__device__ __forceinline__ unsigned pk2(float lo, float hi) { f32x2 v = {lo, hi}; bf16x2_t b = __builtin_convertvector(v, bf16x2_t); return __builtin_bit_cast(unsigned, b); }
__device__ __forceinline__ float bflo(unsigned w) { return __uint_as_float(w << 16); }
__device__ __forceinline__ float bfhi(unsigned w) { return __uint_as_float(w & 0xffff0000u); }
__device__ __forceinline__ float wave_sum(float v) {
#pragma unroll
    for (int o = 1; o < 64; o <<= 1) v += __shfl_xor(v, o);
    return v;
}
__device__ __forceinline__ float fexp(float x) { return __builtin_amdgcn_exp2f(x * LOG2E); }
__device__ __forceinline__ float flog(float x) { return __builtin_amdgcn_logf(x) * 0.6931471805599453f; }
__device__ __forceinline__ float sin_rev(float r) { return __builtin_amdgcn_sinf(r); }
__device__ __forceinline__ float cos_rev(float r) { return __builtin_amdgcn_cosf(r); }
__device__ __forceinline__ float sin_rad(float x) { float r = x * 0.15915494309189535f; r = r - __builtin_rintf(r); return __builtin_amdgcn_sinf(r); }
__device__ __forceinline__ int crow(int r, int hi) { return (r & 3) + 8 * (r >> 2) + 4 * hi; }
#define MFMA32(a, b, c) __builtin_amdgcn_mfma_f32_32x32x16_bf16((a), (b), (c), 0, 0, 0)
#define LDS_WAIT() asm volatile("s_waitcnt lgkmcnt(0)" ::: "memory")
#define VM_WAIT() asm volatile("s_waitcnt vmcnt(0)" ::: "memory")

#define XB_TMO      128
#define XB_XCNT(j)  (256  + 64 * (j))
#define XB_XSUB(j)  (1280 + 64 * (j))
#define XB_XGEN(j)  (2304 + 64 * (j))
#define XB_TOP      3328
#define XB_TOPGEN   3392
#define XCD_BAR_WORDS 3456
#define XB_SPIN_CAP (1u << 18)
__device__ __forceinline__ unsigned xb_ld(unsigned* p)              { return __hip_atomic_load(p, __ATOMIC_RELAXED, __HIP_MEMORY_SCOPE_AGENT); }
__device__ __forceinline__ unsigned xb_add(unsigned* p, unsigned v) { return __hip_atomic_fetch_add(p, v, __ATOMIC_RELAXED, __HIP_MEMORY_SCOPE_AGENT); }
__device__ __forceinline__ unsigned xb_xcc_id() { return (unsigned)__builtin_amdgcn_s_getreg((3 << 11) | 20) & 0xFu; }
#define XB_SPIN(cond, bar) do { unsigned _sp = 0; while (cond) { __builtin_amdgcn_s_sleep(1); \
    if ((++_sp & 255u) == 0u) { if (xb_ld(&(bar)[XB_TMO])) break; if (_sp > XB_SPIN_CAP) { atomicAdd(&(bar)[XB_TMO], 1u); break; } } } } while (0)
struct XcdBarrier { unsigned* bar; unsigned x; volatile LAS unsigned* st; };
__device__ __forceinline__ XcdBarrier xcd_barrier_post(unsigned* bar, volatile LAS unsigned* st) {
    XcdBarrier b; b.bar = bar; b.x = xb_xcc_id(); b.st = st;
    if (threadIdx.x == 0) (void)xb_add(&bar[XB_XCNT(b.x)], 1u);
    return b;
}
__device__ __forceinline__ void xcd_barrier_complete(unsigned* bar, unsigned x, unsigned& nloc, unsigned& nx) {
    const unsigned G = gridDim.x * gridDim.y * gridDim.z;
    unsigned sum, cnt, mine, sp = 0u;
    for (;;) {
        sum = 0u; cnt = 0u; mine = 0u;
#pragma unroll
        for (unsigned j = 0; j < 16; ++j) { const unsigned c = xb_ld(&bar[XB_XCNT(j)]); sum += c; cnt += (c > 0u) ? 1u : 0u; mine = (j == x) ? c : mine; }
        if (sum == G) break;
        __builtin_amdgcn_s_sleep(1);
        if ((++sp & 255u) == 0u) { if (xb_ld(&bar[XB_TMO])) break; if (sp > XB_SPIN_CAP) { atomicAdd(&bar[XB_TMO], 1u); break; } }
    }
    nloc = mine > 0u ? mine : 1u; nx = cnt > 0u ? cnt : 1u;
}
__device__ __forceinline__ void xcd_barrier(const XcdBarrier& b) {
    asm volatile("s_waitcnt vmcnt(0)" ::: "memory");
    __syncthreads();
    if (threadIdx.x == 0) {
        unsigned* bar = b.bar;
        __builtin_amdgcn_s_waitcnt(0);
        unsigned nloc = b.st[0], nx = b.st[1];
        if (nloc == 0u) { xcd_barrier_complete(bar, b.x, nloc, nx); b.st[0] = nloc; b.st[1] = nx; }
        const unsigned old = xb_add(&bar[XB_XSUB(b.x)], 1u);
        const unsigned gen = old / nloc;
        if (old + 1u == (gen + 1u) * nloc) {
            __builtin_amdgcn_fence(__ATOMIC_RELEASE, "agent");
            asm volatile("s_waitcnt vmcnt(0)" ::: "memory");
            const unsigned og = xb_add(&bar[XB_TOP], 1u);
            const unsigned tg = og / nx;
            if (og + 1u == (tg + 1u) * nx) xb_add(&bar[XB_TOPGEN], 1u);
            else XB_SPIN(xb_ld(&bar[XB_TOPGEN]) == tg, bar);
            __builtin_amdgcn_fence(__ATOMIC_ACQUIRE, "agent");
            xb_add(&bar[XB_XGEN(b.x)], 1u);
            asm volatile("s_waitcnt vmcnt(0)" ::: "memory");
        } else {
            XB_SPIN(xb_ld(&bar[XB_XGEN(b.x)]) == gen, bar);
            __builtin_amdgcn_fence(__ATOMIC_ACQUIRE, "agent");
            asm volatile("s_waitcnt vmcnt(0)" ::: "memory");
        }
    }
    __syncthreads();
}

struct Args { const void* in[35]; float* out; unsigned char* ws; int ph_lo, ph_hi; };
struct Frame {
    LAS unsigned char* lds;
    int tid, lane, wave, vcu, G;
    const Args* a;
    unsigned char* ws;
};
#define INF(i) ((const float*)F.a->in[i])
#define WSP(T, off) ((T*)(F.ws + (off)))

__device__ __forceinline__ void tr_item(const float* W, int ldw, int Kvalid, int Nvalid, int k0, int n0, bf16_t* dst, int dpitch, int drow0, int dk0, LAS float* scr, int lane, int NW = 64) {
    f32x4 v[16];
    const int nn = n0 + 4 * (lane & 15);
#pragma unroll
    for (int i = 0; i < 16; ++i) { const int kk = 4 * i + (lane >> 4);
        v[i] = (f32x4){0.f, 0.f, 0.f, 0.f};
        if (W != nullptr && (k0 + kk) < Kvalid && nn < Nvalid) v[i] = *(const GAS f32x4*)(W + (size_t)(k0 + kk) * ldw + nn); }
#pragma unroll
    for (int i = 0; i < 16; ++i) { const int kk = 4 * i + (lane >> 4);
        *(LAS f32x4*)(scr + kk * 64 + ((4 * (lane & 15)) ^ (4 * ((kk >> 3) & 7)))) = v[i]; }
    LDS_WAIT(); asm volatile("" ::: "memory");
    const int kc = lane & 7, nl = lane >> 3;
#pragma unroll
    for (int j = 0; j < 8; ++j) { const int n = 8 * j + nl; const LAS float* sp = scr + (8 * kc) * 64 + (n ^ (4 * kc));
        u32x4 o; o.x = pk2(sp[0 * 64], sp[1 * 64]); o.y = pk2(sp[2 * 64], sp[3 * 64]); o.z = pk2(sp[4 * 64], sp[5 * 64]); o.w = pk2(sp[6 * 64], sp[7 * 64]);
        if (n < NW) *(GAS u32x4*)(dst + (size_t)(drow0 + n) * dpitch + dk0 + k0 + 8 * kc) = o; }
    LDS_WAIT(); asm volatile("" ::: "memory");
}

__device__ __forceinline__ void p0_phase(Frame& F) {
    const int tid = F.tid, lane = F.lane, wave = F.wave;
    {
        LAS float* cs = (LAS float*)(F.lds);
        LAS float* red = (LAS float*)(F.lds + 8192);
        const float* c = INF(1);
        for (int i = tid; i < 2048; i += NTHR) { const float v = c[i]; cs[i] = v / (1.0f + fexp(-v)); }
        __syncthreads();
        for (int cb = blockIdx.x; cb < 256; cb += F.G) {
            const int j = tid % 48, kg = tid / 48;
            const int col = cb * 48 + j, l = col / 6144, n = col % 6144;
            if (kg < 10) {
                const float* w = INF(3) + (size_t)l * 1024 * 6144 + n;
                float a0 = 0.f, a1 = 0.f;
#pragma unroll 26
                for (int k = kg; k < 1024; k += 10) { const float wv = w[(size_t)k * 6144]; a0 += cs[k] * wv; a1 += cs[1024 + k] * wv; }
                red[(kg * 48 + j) * 2] = a0; red[(kg * 48 + j) * 2 + 1] = a1;
            }
            __syncthreads();
            if (tid < 96) { const int jj = tid >> 1, b = tid & 1; float s = 0.f;
                for (int g = 0; g < 10; ++g) s += red[(g * 48 + jj) * 2 + b];
                const int col2 = cb * 48 + jj, l2 = col2 / 6144, n2 = col2 % 6144;
                WSP(float, WS_MOD)[(l2 * 2 + b) * 6144 + n2] = s + INF(4)[l2 * 6144 + n2]; }
            __syncthreads();
        }
    }
    {
        const int gw = F.vcu * NWAVES + wave, NGW = F.G * NWAVES;
        for (int l = 0; l < 2; ++l) {
            const float* w1 = INF(18) + l * 17 * 64; const float* w2 = INF(21) + l * 64 * 64;
            float w1c[17], w2c[64];
#pragma unroll
            for (int i = 0; i < 17; ++i) w1c[i] = w1[i * 64 + lane];
#pragma unroll
            for (int k = 0; k < 64; ++k) w2c[k] = w2[k * 64 + lane];
            const float b1 = INF(19)[l * 64 + lane], fr1 = INF(20)[l * 64 + lane], b2 = INF(22)[l * 64 + lane], fr2 = INF(23)[l * 64 + lane];
            for (int t = gw; t < SEQ; t += NGW) {
                const float tt = (float)t * (1.0f / SEQ);
                float a = b1 + tt * w1c[0];
#pragma unroll
                for (int bnd = 1; bnd <= 8; ++bnd) { float r = (float)((t * bnd) & (SEQ - 1)) * (1.0f / SEQ); a += sin_rev(r) * w1c[bnd] + cos_rev(r) * w1c[8 + bnd]; }
                const float h1 = sin_rad(fr1 * a);
                float a2 = b2;
#pragma unroll
                for (int k = 0; k < 64; ++k) a2 += __shfl(h1, k) * w2c[k];
                WSP(bf16_t, WS_HID)[((size_t)l * SEQ + t) * 64 + lane] = (bf16_t)(pk2(sin_rad(fr2 * a2), 0.f) & 0xffffu);
            }
        }
    }
    {
        LAS float* scr = (LAS float*)(F.lds + wave * 16384);
        const int gw = F.vcu * NWAVES + wave, NGW = F.G * NWAVES;
        constexpr int I_WIN = 16 * 48, I_WOUT = 16 * 16, I_WMLA = 6 * 16, I_W3 = 16, I_GU = 16 * 2 * 16 * 32, I_DN = 16 * 32 * 16;
        constexpr int I_LAYER = I_WIN + I_WOUT + I_WMLA + I_W3 + I_GU + I_DN;
        for (int it = gw; it < 2 * I_LAYER; it += NGW) {
            const int l = it / I_LAYER; int r = it % I_LAYER;
            if (r < I_WIN) { const int kb = r / 48, nb = r % 48;
                tr_item(INF(9) + (size_t)l * 1024 * DIN, DIN, 1024, DIN, kb * 64, nb * 64, WSP(bf16_t, WS_WIN) + (size_t)l * DINP * 1024, 1024, nb * 64, 0, scr, lane); continue; }
            r -= I_WIN;
            if (r < I_WOUT) { const int kb = r / 16, nb = r % 16;
                tr_item(INF(30) + (size_t)l * 1024 * 1024, 1024, 1024, 1024, kb * 64, nb * 64, WSP(bf16_t, WS_WOUT) + (size_t)l * 1024 * 1024, 1024, nb * 64, 0, scr, lane); continue; }
            r -= I_WOUT;
            if (r < I_WMLA) { const int kb = r / 16, nb = r % 16;
                bf16_t* dst = WSP(bf16_t, WS_WMLA) + (size_t)l * 1024 * 384;
                const float* Wq = INF(13) + (size_t)l * 224 * 384;
                if (nb < 4) { if (kb < 4) tr_item(Wq, 384, 224, nb * 96 + 64, kb * 64, nb * 96, dst, 384, nb * 64, 0, scr, lane); else tr_item(nullptr, 4, 0, 0, 0, 0, dst, 384, nb * 64, kb * 64, scr, lane); }
                else if (nb < 6) { const int h0 = 2 * (nb - 4);
                    if (kb < 4) { tr_item(Wq, 384, 224, h0 * 96 + 96, kb * 64, h0 * 96 + 64, dst, 384, 256 + h0 * 32, 0, scr, lane, 32);
                                  tr_item(Wq, 384, 224, (h0 + 1) * 96 + 96, kb * 64, (h0 + 1) * 96 + 64, dst, 384, 256 + (h0 + 1) * 32, 0, scr, lane, 32); }
                    else tr_item(nullptr, 4, 0, 0, 0, 0, dst, 384, nb * 64, kb * 64, scr, lane); }
                else if (nb < 8) tr_item(nullptr, 4, 0, 0, 0, 0, dst, 384, nb * 64, kb * 64, scr, lane);
                else { const float* W = (nb < 12) ? INF(14) + (size_t)l * 128 * 256 : INF(15) + (size_t)l * 128 * 256; const int nsrc = ((nb - 8) & 3) * 64;
                    if (kb >= 4) tr_item(W, 256, 128, 256, (kb - 4) * 64, nsrc, dst, 384, nb * 64, 256, scr, lane); else tr_item(nullptr, 4, 0, 0, 0, 0, dst, 384, nb * 64, kb * 64, scr, lane); }
                continue; }
            r -= I_WMLA;
            if (r < I_W3) { tr_item(INF(24) + (size_t)l * 64 * 1024, 1024, 64, 1024, 0, r * 64, WSP(bf16_t, WS_W3T) + (size_t)l * 1024 * 64, 64, r * 64, 0, scr, lane); continue; }
            r -= I_W3;
            if (r < I_GU) { const int e = r / (2 * 16 * 32); int q = r % (2 * 16 * 32); const int which = q / (16 * 32); q %= (16 * 32); const int kb = q / 32, nb = q % 32;
                const float* W = INF(which ? 33 : 32) + ((size_t)l * NEXP + e) * 1024 * 2048;
                const int n0 = nb * 64, drow = (n0 >> 7) * 256 + (n0 & 127) + (which ? 128 : 0);
                tr_item(W, 2048, 1024, 2048, kb * 64, n0, WSP(bf16_t, WS_WGU) + ((size_t)l * NEXP + e) * 4096 * 1024, 1024, drow, 0, scr, lane); continue; }
            r -= I_GU;
            { const int e = r / (32 * 16); const int q = r % (32 * 16); const int kb = q / 16, nb = q % 16;
                const float* W = INF(34) + ((size_t)l * NEXP + e) * 2048 * 1024;
                tr_item(W, 1024, 2048, 1024, kb * 64, nb * 64, WSP(bf16_t, WS_WDN) + ((size_t)l * NEXP + e) * 1024 * LDFF, LDFF, nb * 64, 0, scr, lane); }
        }
    }
}

__device__ __forceinline__ void ld_row_f32(const float* p, int lane, f32x4 (&v)[4]) {
    const GAS f32x4* r = (const GAS f32x4*)p + lane;
#pragma unroll
    for (int j = 0; j < 4; ++j) v[j] = r[64 * j];
}
__device__ __forceinline__ void st_row_f32(float* p, int lane, const f32x4 (&v)[4]) {
    GAS f32x4* r = (GAS f32x4*)p + lane;
#pragma unroll
    for (int j = 0; j < 4; ++j) r[64 * j] = v[j];
}
__device__ __forceinline__ void st_row_bf16(bf16_t* p, int lane, const f32x4 (&v)[4]) {
    GAS u32x2* r = (GAS u32x2*)p + lane;
#pragma unroll
    for (int j = 0; j < 4; ++j) { u32x2 w; w.x = pk2(v[j].x, v[j].y); w.y = pk2(v[j].z, v[j].w); r[64 * j] = w; }
}
__device__ __forceinline__ float row_ss(const f32x4 (&v)[4]) {
    float s = 0.f;
#pragma unroll
    for (int j = 0; j < 4; ++j) s += (v[j].x * v[j].x + v[j].y * v[j].y) + (v[j].z * v[j].z + v[j].w * v[j].w);
    return wave_sum(s);
}
__device__ __forceinline__ void modnorm(const f32x4 (&x)[4], const float* g, const float* sc, const float* sh, int lane, f32x4 (&h)[4]) {
    const float rstd = __builtin_amdgcn_rsqf(row_ss(x) * (1.0f / DM) + EPS);
    f32x4 gv[4], scv[4], shv[4];
    ld_row_f32(g, lane, gv); ld_row_f32(sc, lane, scv); ld_row_f32(sh, lane, shv);
#pragma unroll
    for (int j = 0; j < 4; ++j) h[j] = (x[j] * rstd) * gv[j] * (scv[j] + 1.0f) + shv[j];
}

__device__ __forceinline__ void filt_gemm_tile(Frame& F, int wt) {
    const int lane = F.lane, hi = lane >> 5, l31 = lane & 31;
    const int l = wt >> 11, r = wt & 2047, t0 = (r >> 3) * 32, col0 = (r & 7) * 128;
    const bf16_t* hidp = WSP(bf16_t, WS_HID) + ((size_t)l * SEQ + t0 + l31) * 64 + hi * 8;
    const bf16_t* w3p = WSP(bf16_t, WS_W3T) + ((size_t)l * 1024 + col0 + l31) * 64 + hi * 8;
    bf16x8 bfr[4], afr[4][4];
#pragma unroll
    for (int ks = 0; ks < 4; ++ks) { bfr[ks] = *(const GAS bf16x8*)(hidp + 16 * ks);
#pragma unroll
        for (int jb = 0; jb < 4; ++jb) afr[jb][ks] = *(const GAS bf16x8*)(w3p + (size_t)(32 * jb) * 64 + 16 * ks); }
    f32x16 acc[4];
#pragma unroll
    for (int jb = 0; jb < 4; ++jb) {
#pragma unroll
        for (int q = 0; q < 16; ++q) acc[jb][q] = 0.f;
#pragma unroll
        for (int ks = 0; ks < 4; ++ks) acc[jb] = MFMA32(afr[jb][ks], bfr[ks], acc[jb]); }
    const float tt = (float)(t0 + l31) * (1.0f / SEQ);
    float* FT = WSP(float, WS_FILT) + (size_t)l * 1024 * SEQ + t0 + l31;
#pragma unroll
    for (int jb = 0; jb < 4; ++jb)
#pragma unroll
        for (int q = 0; q < 16; ++q) { const int col = col0 + 32 * jb + crow(q, hi);
            const float v = (acc[jb][q] + INF(25)[l * 1024 + col]) * fexp(-tt * fexp(INF(26)[l * 1024 + col]));
            FT[(size_t)col * SEQ] = v; }
}

__device__ __forceinline__ void p1_phase(Frame& F) {
    const int gw = F.vcu * NWAVES + F.wave, NGW = F.G * NWAVES;
    const float* mod = WSP(float, WS_MOD);
    for (int m = gw; m < MTOK; m += 2 * NGW) {
        const int m2 = (m + NGW < MTOK) ? m + NGW : m; f32x4 xa[4], xb[4], h[4];
        ld_row_f32(INF(0) + (size_t)m * DM, F.lane, xa); ld_row_f32(INF(0) + (size_t)m2 * DM, F.lane, xb);
        { const int b = m >> 13; modnorm(xa, INF(5), mod + (0 * 2 + b) * 6144 + 1024, mod + (0 * 2 + b) * 6144, F.lane, h); st_row_bf16(WSP(bf16_t, WS_XN) + (size_t)m * DM, F.lane, h); }
        { const int b = m2 >> 13; modnorm(xb, INF(5), mod + (0 * 2 + b) * 6144 + 1024, mod + (0 * 2 + b) * 6144, F.lane, h); st_row_bf16(WSP(bf16_t, WS_XN) + (size_t)m2 * DM, F.lane, h); }
    }
    for (int wt = gw; wt < 4096; wt += NGW) filt_gemm_tile(F, wt);
}

__device__ __forceinline__ float wave_scan_add(float v, int lane) {
#pragma unroll
    for (int o = 1; o < 64; o <<= 1) { const float n = __shfl_up(v, o); if (lane >= o) v += n; }
    return v;
}
__device__ __forceinline__ float wave_scan_max(float v, int lane) {
#pragma unroll
    for (int o = 1; o < 64; o <<= 1) { const float n = __shfl_up(v, o); if (lane >= o) v = fmaxf(v, n); }
    return v;
}
__device__ __forceinline__ float wave_max(float v) {
#pragma unroll
    for (int o = 1; o < 64; o <<= 1) v = fmaxf(v, __shfl_xor(v, o));
    return v;
}
__device__ __forceinline__ float logsigmoid(float x) { return fminf(x, 0.f) - flog(1.0f + fexp(-fabsf(x))); }
struct MlItem { int b, h, dir, n, t0; };
__device__ __forceinline__ MlItem ml_decode(int item) { MlItem I; I.b = item >> 9; I.h = (item >> 7) & 3; I.dir = (item >> 6) & 1; I.n = item & 63;
    I.t0 = I.b * SEQ + (I.dir ? SEQ - 128 * (I.n + 1) : 128 * I.n); return I; }

__device__ __forceinline__ void ml_local_item(Frame& F, int item, int l) {
    const int tid = F.tid; const MlItem I = ml_decode(item);
    const bf16_t* U = WSP(bf16_t, WS_U);
    LAS float* EK = (LAS float*)(F.lds);
    LAS float* VV = (LAS float*)(F.lds + 32768);
    LAS float* LF = (LAS float*)(F.lds + 65536);
    LAS float* IG = LF + 128; LAS float* WW = LF + 256; LAS float* EST = LF + 384;
    const float* gb = INF(10) + l * 16;
    if (tid < 128) { const int j = tid, r = I.dir ? 127 - j : j; const size_t t = (size_t)(I.t0 + r);
        const float ipre = bf2f(U[t * DINP + U_MLG + (I.dir ? 2 : 0) * 4 + I.h]) + gb[(I.dir ? 2 : 0) * 4 + I.h];
        const float fpre = bf2f(U[t * DINP + U_MLG + (I.dir ? 3 : 1) * 4 + I.h]) + gb[(I.dir ? 3 : 1) * 4 + I.h];
        LF[j] = logsigmoid(fpre); IG[j] = ipre; }
    __syncthreads();
    float a = 0.f, aend = 0.f;
    if (tid < 128) { for (int i = 0; i < 128; ++i) { const float v = LF[i]; aend += v; if (i <= tid) a += v; }
        WW[tid] = aend - a + IG[tid]; }
    __syncthreads();
    float mloc = -3.0e38f;
    if (tid < 128) { for (int i = 0; i < 128; ++i) mloc = fmaxf(mloc, WW[i]);
        const int r = I.dir ? 127 - tid : tid; EST[r] = fexp(WW[tid] - mloc); }
    __syncthreads();
#pragma unroll
    for (int i = 0; i < 2; ++i) { const int p = tid + 512 * i, row = p >> 3, c8 = p & 7;
        const u32x4 kq = *(const GAS u32x4*)(U + (size_t)(I.t0 + row) * DINP + U_MLK + I.h * 64 + c8 * 8);
        const u32x4 vq = *(const GAS u32x4*)(U + (size_t)(I.t0 + row) * DINP + U_MLV + I.h * 64 + c8 * 8);
        const float es = EST[row] * 0.125f;
        LAS f32x4* ek = (LAS f32x4*)(EK + row * 64 + c8 * 8); LAS f32x4* vv = (LAS f32x4*)(VV + row * 64 + c8 * 8);
        ek[0] = (f32x4){bflo(kq.x) * es, bfhi(kq.x) * es, bflo(kq.y) * es, bfhi(kq.y) * es};
        ek[1] = (f32x4){bflo(kq.z) * es, bfhi(kq.z) * es, bflo(kq.w) * es, bfhi(kq.w) * es};
        vv[0] = (f32x4){bflo(vq.x), bfhi(vq.x), bflo(vq.y), bfhi(vq.y)};
        vv[1] = (f32x4){bflo(vq.z), bfhi(vq.z), bflo(vq.w), bfhi(vq.w)}; }
    __syncthreads();
    {
        const int d = tid >> 3, e0 = (tid & 7) * 8;
        f32x4 c0 = {0.f, 0.f, 0.f, 0.f}, c1 = {0.f, 0.f, 0.f, 0.f};
#pragma unroll 4
        for (int j = 0; j < 128; ++j) { const float ek = EK[j * 64 + d]; const f32x4 v0 = *(const LAS f32x4*)(VV + j * 64 + e0), v1 = *(const LAS f32x4*)(VV + j * 64 + e0 + 4);
            c0 += v0 * ek; c1 += v1 * ek; }
        GAS f32x4* dst = (GAS f32x4*)(WSP(float, WS_MLC) + (size_t)item * 4096 + d * 64 + e0);
        dst[0] = c0; dst[1] = c1;
        if (tid < 64) { float s = 0.f; for (int j = 0; j < 128; ++j) s += EK[j * 64 + tid]; WSP(float, WS_MLN)[item * 64 + tid] = s; }
        if (tid == 0) { WSP(float, WS_MLS)[item * 4] = mloc; WSP(float, WS_MLS)[item * 4 + 1] = aend; }
    }
    __syncthreads();
}

__device__ __forceinline__ void ml_scan(Frame& F) {
    float* MLC = WSP(float, WS_MLC); float* MLN = WSP(float, WS_MLN); float* MLS = WSP(float, WS_MLS);
    for (int blk = blockIdx.x; blk < 256; blk += F.G) { if (F.tid >= 260) continue; const int idx = blk * 260 + F.tid;
        const int seq = idx / 4160, el = idx % 4160;
        float* p0 = el < 4096 ? (MLC + (size_t)seq * 64 * 4096 + el) : (MLN + seq * 64 * 64 + (el - 4096));
        const int pstr = el < 4096 ? 4096 : 64;
        float mst = 0.f, st = 0.f;
#pragma unroll 1
        for (int n0 = 0; n0 < 64; n0 += 16) {
            float cl[16], mlv[16], aev[16];
#pragma unroll
            for (int i = 0; i < 16; ++i) { cl[i] = p0[(size_t)(n0 + i) * pstr]; mlv[i] = MLS[(seq * 64 + n0 + i) * 4]; aev[i] = MLS[(seq * 64 + n0 + i) * 4 + 1]; }
#pragma unroll
            for (int i = 0; i < 16; ++i) { const int item = seq * 64 + n0 + i;
                p0[(size_t)(n0 + i) * pstr] = st;
                if (el == 0) MLS[item * 4 + 2] = mst;
                const float mnew = fmaxf(aev[i] + mst, mlv[i]), sp = fexp(aev[i] + mst - mnew), sl = fexp(mlv[i] - mnew);
                st = sp * st + sl * cl[i]; mst = mnew; }
        }
    }
}

template <int NK>
__device__ __forceinline__ void qkt_tile(f32x16& p0, f32x16& p1, LAS const unsigned char* Kt, const bf16x8 (&qr)[NK], int r32, int hi) {
#pragma unroll
    for (int r = 0; r < 16; ++r) { p0[r] = 0.f; p1[r] = 0.f; }
#pragma unroll
    for (int d0 = 0; d0 < NK; ++d0) {
        const bf16x8 b0 = *(const LAS bf16x8*)(Kt + (2 * d0 + hi) * 1024 + r32 * 16);
        const bf16x8 b1 = *(const LAS bf16x8*)(Kt + (2 * d0 + hi) * 1024 + r32 * 16 + 512);
        p0 = MFMA32(b0, qr[d0], p0); p1 = MFMA32(b1, qr[d0], p1);
    }
}
typedef short v4i16_t __attribute__((ext_vector_type(4)));
__device__ __forceinline__ s16x4 vtr(LAS const unsigned char* p) { return __builtin_bit_cast(s16x4, __builtin_amdgcn_ds_read_tr16_b64_v4i16((LAS v4i16_t*)p)); }
__device__ __forceinline__ void pv_tile(f32x16 (&o)[2], LAS const unsigned char* Vt, const bf16x8 (&pa)[4], int lane) {
    const int hi = lane >> 5;
    LAS const unsigned char* vb = Vt + ((lane >> 4) & 1) * 32 + (lane & 3) * 8 + (4 * hi + ((lane & 15) >> 2)) * 64;
#pragma unroll
    for (int d0 = 0; d0 < 2; ++d0)
#pragma unroll
        for (int ks = 0; ks < 4; ++ks) {
            const s16x4 lo = vtr(vb + d0 * 4096 + ks * 1024), hh = vtr(vb + d0 * 4096 + ks * 1024 + 512);
            const bf16x8 vf = (bf16x8){lo[0], lo[1], lo[2], lo[3], hh[0], hh[1], hh[2], hh[3]};
            o[d0] = MFMA32(pa[ks], vf, o[d0]);
        }
}
__device__ __forceinline__ void pack_p(const f32x16& p0, const f32x16& p1, bf16x8 (&pa)[4]) {
    u32x4 w0, w1, w2, w3;
    w0 = (u32x4){pk2(p0[0], p0[1]), pk2(p0[2], p0[3]), pk2(p0[4], p0[5]), pk2(p0[6], p0[7])};
    w1 = (u32x4){pk2(p0[8], p0[9]), pk2(p0[10], p0[11]), pk2(p0[12], p0[13]), pk2(p0[14], p0[15])};
    w2 = (u32x4){pk2(p1[0], p1[1]), pk2(p1[2], p1[3]), pk2(p1[4], p1[5]), pk2(p1[6], p1[7])};
    w3 = (u32x4){pk2(p1[8], p1[9]), pk2(p1[10], p1[11]), pk2(p1[12], p1[13]), pk2(p1[14], p1[15])};
    pa[0] = __builtin_bit_cast(bf16x8, w0); pa[1] = __builtin_bit_cast(bf16x8, w1); pa[2] = __builtin_bit_cast(bf16x8, w2); pa[3] = __builtin_bit_cast(bf16x8, w3);
}

__device__ __forceinline__ void ml_local_pair(Frame& F, int pair, int l) {
    const int tid = F.tid, lane = F.lane, wid = F.wave, half = wid >> 2, wq = wid & 3, th = tid & 255, hi = lane >> 5;
    const int item = pair * 2 + half; const MlItem I = ml_decode(item);
    const bf16_t* U = WSP(bf16_t, WS_U);
    LAS unsigned char* base = F.lds + half * 49152;
    LAS unsigned char* EKI = base;
    LAS unsigned char* VI = base + 16384;
    LAS float* LF = (LAS float*)(base + 32768); LAS float* IG = LF + 128; LAS float* WW = LF + 256; LAS float* EST = LF + 384;
    const float* gb = INF(10) + l * 16;
    unsigned short graw_i = 0, graw_f = 0;
    if (th < 128) { const int r = I.dir ? 127 - th : th; const size_t t = (size_t)(I.t0 + r);
        graw_i = U[t * DINP + U_MLG + (I.dir ? 2 : 0) * 4 + I.h]; graw_f = U[t * DINP + U_MLG + (I.dir ? 3 : 1) * 4 + I.h]; }
    u32x4 kpc[4], vpc[4];
#pragma unroll
    for (int i = 0; i < 4; ++i) { const int p = th + 256 * i; const int tt = p >> 9, dh = (p >> 8) & 1, row = (p >> 2) & 63, c4 = p & 3, r = 64 * tt + row;
        const bf16_t* src = U + (size_t)(I.t0 + r) * DINP + I.h * 64 + dh * 32 + c4 * 8;
        kpc[i] = *(const GAS u32x4*)(src + U_MLK); vpc[i] = *(const GAS u32x4*)(src + U_MLV); }
    float a = 0.f, aend = 0.f, mloc = -3.0e38f;
    const float lfv = (th < 128) ? logsigmoid(bf2f(graw_f) + gb[(I.dir ? 3 : 1) * 4 + I.h]) : 0.f, igv = (th < 128) ? bf2f(graw_i) + gb[(I.dir ? 2 : 0) * 4 + I.h] : 0.f;
    if (th < 128) { a = wave_scan_add(lfv, lane); if (lane == 63) LF[wq] = a; }
    __syncthreads();
    float wv = 0.f;
    if (th < 128) { aend = LF[0] + LF[1]; if (wq == 1) a += LF[0]; wv = aend - a + igv; const float wm = wave_max(wv); if (lane == 0) IG[wq] = wm; }
    __syncthreads();
    if (th < 128) { mloc = fmaxf(IG[0], IG[1]); const int r = I.dir ? 127 - th : th; EST[r] = fexp(wv - mloc) * 0.125f; }
    __syncthreads();
#pragma unroll
    for (int i = 0; i < 4; ++i) { const int p = th + 256 * i; const int tt = p >> 9, dh = (p >> 8) & 1, row = (p >> 2) & 63, c4 = p & 3, r = 64 * tt + row;
        const u32x4 kq = kpc[i];
        const float es = EST[r];
        u32x4 ek; ek.x = pk2(bflo(kq.x) * es, bfhi(kq.x) * es); ek.y = pk2(bflo(kq.y) * es, bfhi(kq.y) * es); ek.z = pk2(bflo(kq.z) * es, bfhi(kq.z) * es); ek.w = pk2(bflo(kq.w) * es, bfhi(kq.w) * es);
        const int off = tt * 8192 + dh * 4096 + row * 64 + c4 * 16;
        *(LAS u32x4*)(EKI + off) = ek; *(LAS u32x4*)(VI + off) = vpc[i]; }
    __syncthreads();
    {
        const int da = wq >> 1, eb = wq & 1;
        f32x16 acc;
#pragma unroll
        for (int r = 0; r < 16; ++r) acc[r] = 0.f;
        const int lo_off = ((lane >> 4) & 1) * 32 + (lane & 3) * 8 + (4 * hi + ((lane & 15) >> 2)) * 64;
#pragma unroll
        for (int tt = 0; tt < 2; ++tt)
#pragma unroll
            for (int ks = 0; ks < 4; ++ks) {
                LAS const unsigned char* ap = EKI + tt * 8192 + da * 4096 + lo_off + ks * 1024; LAS const unsigned char* bp = VI + tt * 8192 + eb * 4096 + lo_off + ks * 1024;
                const s16x4 a0 = vtr(ap), a1 = vtr(ap + 512), b0 = vtr(bp), b1 = vtr(bp + 512);
                const bf16x8 af = (bf16x8){a0[0], a0[1], a0[2], a0[3], a1[0], a1[1], a1[2], a1[3]}, bf = (bf16x8){b0[0], b0[1], b0[2], b0[3], b1[0], b1[1], b1[2], b1[3]};
                acc = MFMA32(af, bf, acc); }
        float* dst = WSP(float, WS_MLC) + (size_t)item * 4096 + eb * 32 + (lane & 31);
#pragma unroll
        for (int r = 0; r < 16; ++r) dst[(da * 32 + crow(r, hi)) * 64] = acc[r];
        if (th < 64) { const int dh = th >> 5, col = th & 31; float sacc = 0.f;
            for (int tt = 0; tt < 2; ++tt) for (int row = 0; row < 64; ++row) sacc += bf2f(*(const LAS unsigned short*)(EKI + tt * 8192 + dh * 4096 + row * 64 + col * 2));
            WSP(float, WS_MLN)[item * 64 + th] = sacc; }
        if (th == 0) { WSP(float, WS_MLS)[item * 4] = mloc; WSP(float, WS_MLS)[item * 4 + 1] = aend; }
    }
    __syncthreads();
}

__device__ __forceinline__ void ml_out_pair(Frame& F, int pair, int l) {
    const int tid = F.tid, lane = F.lane, wid = F.wave, half = wid >> 2, wq = wid & 3, th = tid & 255, r32 = lane & 31, hi = lane >> 5;
    const int item = pair * 2 + half; const MlItem I = ml_decode(item);
    const bf16_t* U = WSP(bf16_t, WS_U);
    LAS unsigned char* base = F.lds + half * 49152;
    LAS unsigned char* KI = base;
    LAS unsigned char* VI = base + 16384;
    LAS unsigned char* CT = base + 32768;
    LAS float* vec = (LAS float*)(base + 32768 + 9216);
    LAS float* LF = vec; LAS float* IG = vec + 128; LAS float* BL = vec + 256; LAS float* SA = vec + 384; LAS float* SCI = vec + 512; LAS float* EDEN = vec + 640;
    LAS float* NPV = vec + 768; LAS float* wsf = vec + 832 + wq * 64;
    const float* gb = INF(10) + l * 16;
    unsigned short graw_i = 0, graw_f = 0; float mprev = 0.f;
    if (th < 128) { const int r = I.dir ? 127 - th : th; const size_t t = (size_t)(I.t0 + r);
        graw_i = U[t * DINP + U_MLG + (I.dir ? 2 : 0) * 4 + I.h]; graw_f = U[t * DINP + U_MLG + (I.dir ? 3 : 1) * 4 + I.h];
        mprev = WSP(float, WS_MLS)[item * 4 + 2]; }
    u32x4 kpc[4], vpc[4];
#pragma unroll
    for (int i = 0; i < 4; ++i) { const int p = th + 256 * i;
        { const int tt = p >> 9, c = (p >> 6) & 7, kv = p & 63, j = 64 * tt + kv, r = I.dir ? 127 - j : j;
          kpc[i] = *(const GAS u32x4*)(U + (size_t)(I.t0 + r) * DINP + U_MLK + I.h * 64 + c * 8); }
        { const int tt = p >> 9, dh = (p >> 8) & 1, kv = (p >> 2) & 63, c4 = p & 3, j = 64 * tt + kv, r = I.dir ? 127 - j : j;
          vpc[i] = *(const GAS u32x4*)(U + (size_t)(I.t0 + r) * DINP + U_MLV + I.h * 64 + dh * 32 + c4 * 8); } }
    float cpv[16];
    { const float* cp = WSP(float, WS_MLC) + (size_t)item * 4096;
#pragma unroll
      for (int i = 0; i < 16; ++i) cpv[i] = cp[th + 256 * i]; }
    const float npv = (th < 64) ? WSP(float, WS_MLN)[item * 64 + th] : 0.f;
    const int q = 32 * wq + r32;
    const int rq = I.dir ? 127 - q : q;
    bf16x8 qr[4];
    { const bf16_t* qp = U + (size_t)(I.t0 + rq) * DINP + U_MLQ + I.h * 64 + hi * 8;
#pragma unroll
      for (int d0 = 0; d0 < 4; ++d0) qr[d0] = *(const GAS bf16x8*)(qp + d0 * 16); }
    const float lfv = (th < 128) ? logsigmoid(bf2f(graw_f) + gb[(I.dir ? 3 : 1) * 4 + I.h]) : 0.f, igv = (th < 128) ? bf2f(graw_i) + gb[(I.dir ? 2 : 0) * 4 + I.h] : 0.f;
    float a = 0.f;
    if (th < 128) { a = wave_scan_add(lfv, lane); if (lane == 63) LF[wq] = a; }
#pragma unroll
    for (int i = 0; i < 4; ++i) { const int p = th + 256 * i;
        { const int tt = p >> 9, c = (p >> 6) & 7, kv = p & 63; *(LAS u32x4*)(KI + tt * 8192 + c * 1024 + kv * 16) = kpc[i]; }
        { const int tt = p >> 9, dh = (p >> 8) & 1, kv = (p >> 2) & 63, c4 = p & 3; *(LAS u32x4*)(VI + tt * 8192 + dh * 4096 + kv * 64 + c4 * 16) = vpc[i]; } }
#pragma unroll
    for (int i = 0; i < 16; ++i) { const int idx = th + 256 * i, d = idx >> 6, e = idx & 63;
        *(LAS unsigned short*)(CT + e * 144 + d * 2) = (unsigned short)(pk2(cpv[i], 0.f) & 0xffffu); }
    if (th < 64) NPV[th] = npv;
    __syncthreads();
    float bv = 0.f, bm = -3.0e38f;
    if (th < 128) { if (wq == 1) a += LF[0]; bv = igv - a; bm = wave_scan_max(bv, lane); if (lane == 63) IG[wq] = bm; }
    __syncthreads();
    if (th < 128) { if (wq == 1) bm = fmaxf(bm, IG[0]);
        const float mt = a + fmaxf(mprev, bm);
        SA[th] = (a - mt) * LOG2E; SCI[th] = fexp(a + mprev - mt); EDEN[th] = fexp(-mt); BL[th] = bv * LOG2E; }
    __syncthreads();
    {
        f32x16 o[2];
#pragma unroll
        for (int r = 0; r < 16; ++r) { o[0][r] = 0.f; o[1][r] = 0.f; }
        const float saq = SA[q], scq = SCI[q];
        float den = 0.f;
        for (int tt = 0; tt < 2; ++tt) {
            if (64 * tt > 32 * wq + 31) break;
            f32x16 p0, p1;
            qkt_tile<4>(p0, p1, KI + tt * 8192, qr, r32, hi);
#pragma unroll
            for (int g = 0; g < 4; ++g) {
                const f32x4 b0 = *(const LAS f32x4*)(BL + 64 * tt + 8 * g + 4 * hi), b1 = *(const LAS f32x4*)(BL + 64 * tt + 32 + 8 * g + 4 * hi);
#pragma unroll
                for (int i = 0; i < 4; ++i) { const int r = 4 * g + i; const int kv0 = 64 * tt + 8 * g + 4 * hi + i, kv1 = kv0 + 32;
                    const float e0 = (kv0 <= q) ? __builtin_amdgcn_exp2f(saq + b0[i]) * 0.125f : 0.f, e1 = (kv1 <= q) ? __builtin_amdgcn_exp2f(saq + b1[i]) * 0.125f : 0.f;
                    p0[r] *= e0; p1[r] *= e1; den += p0[r] + p1[r]; }
            }
            bf16x8 pa[4]; pack_p(p0, p1, pa);
            pv_tile(o, VI + tt * 8192, pa, lane);
        }
        float dot = 0.f;
#pragma unroll
        for (int ks = 0; ks < 4; ++ks) {
            const u32x4 qw = __builtin_bit_cast(u32x4, qr[ks]);
            const f32x4 n0 = *(const LAS f32x4*)(NPV + 16 * ks + 8 * hi), n1 = *(const LAS f32x4*)(NPV + 16 * ks + 8 * hi + 4);
            const float q0 = bflo(qw.x), q1 = bfhi(qw.x), q2 = bflo(qw.y), q3 = bfhi(qw.y), q4 = bflo(qw.z), q5 = bfhi(qw.z), q6 = bflo(qw.w), q7 = bfhi(qw.w);
            dot += q0 * n0[0] + q1 * n0[1] + q2 * n0[2] + q3 * n0[3] + q4 * n1[0] + q5 * n1[1] + q6 * n1[2] + q7 * n1[3];
            const u32x4 sw = (u32x4){pk2(q0 * scq, q1 * scq), pk2(q2 * scq, q3 * scq), pk2(q4 * scq, q5 * scq), pk2(q6 * scq, q7 * scq)};
            const bf16x8 qs = __builtin_bit_cast(bf16x8, sw);
#pragma unroll
            for (int de = 0; de < 2; ++de) {
                const bf16x8 cf = *(const LAS bf16x8*)(CT + (de * 32 + r32) * 144 + (16 * ks + 8 * hi) * 2);
                o[de] = MFMA32(qs, cf, o[de]);
            }
        }
        den += scq * dot;
        den += __shfl_xor(den, 32);
        const float rinv = 1.0f / fmaxf(fabsf(den), EDEN[q]);
        if (hi == 0) wsf[r32] = rinv;
        LDS_WAIT();
        bf16_t* dst = WSP(bf16_t, I.dir ? WS_HB : WS_HF);
#pragma unroll
        for (int r = 0; r < 16; ++r) { const int jq = 32 * wq + crow(r, hi), row = I.dir ? 127 - jq : jq; const float rr = wsf[crow(r, hi)];
            bf16_t* dp = dst + (size_t)(I.t0 + row) * 256 + I.h * 64 + r32;
            dp[0] = (bf16_t)(pk2(o[0][r] * rr, 0.f) & 0xffffu); dp[32] = (bf16_t)(pk2(o[1][r] * rr, 0.f) & 0xffffu); }
    }
    __syncthreads();
}

__device__ __forceinline__ double rope_kd_dyn(int i) {
    double r = 0.15915494309189535;
    r = (i == 1) ? 0.08949940160889101 : r; r = (i == 2) ? 0.050329212104487035 : r; r = (i == 3) ? 0.0283021958306234 : r; r = (i == 4) ? 0.015915494309189534 : r;
    r = (i == 5) ? 0.008949940160889102 : r; r = (i == 6) ? 0.005032921210448704 : r; r = (i == 7) ? 0.00283021958306234 : r; r = (i == 8) ? 0.0015915494309189536 : r;
    r = (i == 9) ? 0.0008949940160889102 : r; r = (i == 10) ? 0.0005032921210448703 : r; r = (i == 11) ? 0.00028302195830623395 : r; r = (i == 12) ? 0.00015915494309189535 : r;
    r = (i == 13) ? 8.949940160889102e-05 : r; r = (i == 14) ? 5.0329212104487035e-05 : r; r = (i == 15) ? 2.8302195830623396e-05 : r;
    return r;
}
__device__ __forceinline__ void mla_prep_rows(Frame& F, int l) {
    const int gw = F.vcu * NWAVES + F.wave, NGW = F.G * NWAVES, lane = F.lane;
    const bf16_t* U = WSP(bf16_t, WS_U); bf16_t* A = WSP(bf16_t, WS_AMLA);
    f32x4 gq = {0.f, 0.f, 0.f, 0.f}; if (lane < 56) gq = *(const GAS f32x4*)(INF(11) + l * 224 + 4 * lane);
    const f32x2 gk = *(const GAS f32x2*)(INF(12) + l * 128 + 2 * lane);
    for (int m0 = gw; m0 < MTOK; m0 += 4 * NGW) {
        u32x2 qw[4]; unsigned kw[4];
#pragma unroll
        for (int r = 0; r < 4; ++r) { const int m = m0 + r * NGW; const bf16_t* ur = U + (size_t)(m < MTOK ? m : 0) * DINP;
            qw[r] = (u32x2){0u, 0u}; if (lane < 56) qw[r] = *(const GAS u32x2*)(ur + U_CQ + 4 * lane);
            kw[r] = *(const GAS unsigned*)(ur + U_CKV + 2 * lane); }
#pragma unroll
        for (int r = 0; r < 4; ++r) { const int m = m0 + r * NGW; if (m >= MTOK) break;
            const float q0 = bflo(qw[r].x), q1 = bfhi(qw[r].x), q2 = bflo(qw[r].y), q3 = bfhi(qw[r].y), k0 = bflo(kw[r]), k1 = bfhi(kw[r]);
            const float rq = __builtin_amdgcn_rsqf(wave_sum(q0 * q0 + q1 * q1 + q2 * q2 + q3 * q3) * (1.0f / 224.0f) + EPS);
            const float rk = __builtin_amdgcn_rsqf(wave_sum(k0 * k0 + k1 * k1) * (1.0f / 128.0f) + EPS);
            bf16_t* ar = A + (size_t)m * 384;
            u32x2 qo; qo.x = pk2(q0 * rq * gq.x, q1 * rq * gq.y); qo.y = pk2(q2 * rq * gq.z, q3 * rq * gq.w);
            *(GAS u32x2*)(ar + 4 * lane) = qo;
            *(GAS unsigned*)(ar + 256 + 2 * lane) = pk2(k0 * rk * gk.x, k1 * rk * gk.y); }
    }
    const int* pos = (const int*)F.a->in[2];
    for (int m0 = gw; m0 < MTOK; m0 += 4 * NGW) {
        unsigned short x1r[4], x2r[4]; int pv[4];
#pragma unroll
        for (int r = 0; r < 4; ++r) { const int m = (m0 + r * NGW < MTOK) ? m0 + r * NGW : m0; x1r[r] = 0; x2r[r] = 0; pv[r] = 0;
            if (lane < 16) { x1r[r] = U[(size_t)m * DINP + U_KR + lane]; x2r[r] = U[(size_t)m * DINP + U_KR + 16 + lane]; pv[r] = pos[m]; } }
#pragma unroll
        for (int r = 0; r < 4; ++r) { const int m = m0 + r * NGW; if (m >= MTOK) break;
            if (lane < 16) { const int b = m >> 13, sq = m & 8191;
                double rev = (double)pv[r] * rope_kd_dyn(lane); rev -= __builtin_floor(rev);
                const float rr = (float)rev, c = cos_rev(rr), sn = sin_rev(rr), x1 = bf2f(x1r[r]), x2 = bf2f(x2r[r]);
                const unsigned short o1 = (unsigned short)(pk2(x1 * c - x2 * sn, 0.f) & 0xffffu), o2 = (unsigned short)(pk2(x2 * c + x1 * sn, 0.f) & 0xffffu);
#pragma unroll
                for (int h = 0; h < 4; ++h) { bf16_t* kd = WSP(bf16_t, WS_KIMG) + ((size_t)(b * 4 + h) * 128 + (sq >> 6)) * 6144 + (sq & 63) * 8;
                    kd[(8 + (lane >> 3)) * 512 + (lane & 7)] = o1; kd[(10 + (lane >> 3)) * 512 + (lane & 7)] = o2; } } }
    }
}

__device__ __forceinline__ double rope_k(int i) {
    switch (i) { case 0: return 0.15915494309189535; case 1: return 0.08949940160889101; case 2: return 0.050329212104487035; case 3: return 0.0283021958306234;
        case 4: return 0.015915494309189534; case 5: return 0.008949940160889102; case 6: return 0.005032921210448704; case 7: return 0.00283021958306234;
        case 8: return 0.0015915494309189536; case 9: return 0.0008949940160889102; case 10: return 0.0005032921210448703; case 11: return 0.00028302195830623395;
        case 12: return 0.00015915494309189535; case 13: return 8.949940160889102e-05; case 14: return 5.0329212104487035e-05; default: return 2.8302195830623396e-05; }
}
__device__ __forceinline__ void rope_cs(int pos, int i, float& c, float& s) {
    double rev = (double)pos * rope_k(i);
    rev -= __builtin_floor(rev);
    const float r = (float)rev;
    c = cos_rev(r); s = sin_rev(r);
}
__device__ __forceinline__ void relayout_phase(Frame& F) {
    const bf16_t* O = WSP(bf16_t, WS_OMLA); const bf16_t* U = WSP(bf16_t, WS_U);
    const int* pos = (const int*)F.a->in[2];
    const float qscale = 0.10206207261596577f * LOG2E;
    for (int idx = blockIdx.x * NTHR + F.tid; idx < MTOK * 4; idx += F.G * NTHR) {
        const int t = idx >> 2, h = idx & 3, b = t >> 13, s = t & 8191, bh = b * 4 + h;
        const int p = pos[t];
        float cs[16], sn[16];
#pragma unroll
        for (int i = 0; i < 16; ++i) rope_cs(p, i, cs[i], sn[i]);
        const bf16_t* qsrc = O + (size_t)t * 1024 + h * 96;
        bf16_t* qdst = WSP(bf16_t, WS_Q) + ((size_t)bh * SEQ + s) * 96;
#pragma unroll
        for (int c = 0; c < 8; ++c) { const u32x4 w = *(const GAS u32x4*)(qsrc + c * 8);
            u32x4 o; o.x = pk2(bflo(w.x) * qscale, bfhi(w.x) * qscale); o.y = pk2(bflo(w.y) * qscale, bfhi(w.y) * qscale); o.z = pk2(bflo(w.z) * qscale, bfhi(w.z) * qscale); o.w = pk2(bflo(w.w) * qscale, bfhi(w.w) * qscale);
            *(GAS u32x4*)(qdst + c * 8) = o; }
        {
            float x1[16], x2[16];
#pragma unroll
            for (int c = 0; c < 2; ++c) { const u32x4 w = *(const GAS u32x4*)(qsrc + 64 + c * 8); const u32x4 v = *(const GAS u32x4*)(qsrc + 80 + c * 8);
                x1[c * 8 + 0] = bflo(w.x); x1[c * 8 + 1] = bfhi(w.x); x1[c * 8 + 2] = bflo(w.y); x1[c * 8 + 3] = bfhi(w.y); x1[c * 8 + 4] = bflo(w.z); x1[c * 8 + 5] = bfhi(w.z); x1[c * 8 + 6] = bflo(w.w); x1[c * 8 + 7] = bfhi(w.w);
                x2[c * 8 + 0] = bflo(v.x); x2[c * 8 + 1] = bfhi(v.x); x2[c * 8 + 2] = bflo(v.y); x2[c * 8 + 3] = bfhi(v.y); x2[c * 8 + 4] = bflo(v.z); x2[c * 8 + 5] = bfhi(v.z); x2[c * 8 + 6] = bflo(v.w); x2[c * 8 + 7] = bfhi(v.w); }
#pragma unroll
            for (int c = 0; c < 2; ++c) { u32x4 o1, o2;
#define RQ1(i) ((x1[i] * cs[i] - x2[i] * sn[i]) * qscale)
#define RQ2(i) ((x2[i] * cs[i] + x1[i] * sn[i]) * qscale)
                o1.x = pk2(RQ1(c * 8 + 0), RQ1(c * 8 + 1)); o1.y = pk2(RQ1(c * 8 + 2), RQ1(c * 8 + 3)); o1.z = pk2(RQ1(c * 8 + 4), RQ1(c * 8 + 5)); o1.w = pk2(RQ1(c * 8 + 6), RQ1(c * 8 + 7));
                o2.x = pk2(RQ2(c * 8 + 0), RQ2(c * 8 + 1)); o2.y = pk2(RQ2(c * 8 + 2), RQ2(c * 8 + 3)); o2.z = pk2(RQ2(c * 8 + 4), RQ2(c * 8 + 5)); o2.w = pk2(RQ2(c * 8 + 6), RQ2(c * 8 + 7));
                *(GAS u32x4*)(qdst + 64 + c * 8) = o1; *(GAS u32x4*)(qdst + 80 + c * 8) = o2; }
#undef RQ1
#undef RQ2
        }
        bf16_t* kdst = WSP(bf16_t, WS_KIMG) + ((size_t)bh * 128 + (s >> 6)) * 6144 + (s & 63) * 8;
        const bf16_t* ksrc = O + (size_t)t * 1024 + 384 + h * 64;
#pragma unroll
        for (int c = 0; c < 8; ++c) *(GAS u32x4*)(kdst + c * 512) = *(const GAS u32x4*)(ksrc + c * 8);
        {
            const bf16_t* krs = U + (size_t)t * DINP + U_KR;
            float x1[16], x2[16];
#pragma unroll
            for (int c = 0; c < 2; ++c) { const u32x4 w = *(const GAS u32x4*)(krs + c * 8); const u32x4 v = *(const GAS u32x4*)(krs + 16 + c * 8);
                x1[c * 8 + 0] = bflo(w.x); x1[c * 8 + 1] = bfhi(w.x); x1[c * 8 + 2] = bflo(w.y); x1[c * 8 + 3] = bfhi(w.y); x1[c * 8 + 4] = bflo(w.z); x1[c * 8 + 5] = bfhi(w.z); x1[c * 8 + 6] = bflo(w.w); x1[c * 8 + 7] = bfhi(w.w);
                x2[c * 8 + 0] = bflo(v.x); x2[c * 8 + 1] = bfhi(v.x); x2[c * 8 + 2] = bflo(v.y); x2[c * 8 + 3] = bfhi(v.y); x2[c * 8 + 4] = bflo(v.z); x2[c * 8 + 5] = bfhi(v.z); x2[c * 8 + 6] = bflo(v.w); x2[c * 8 + 7] = bfhi(v.w); }
#pragma unroll
            for (int c = 0; c < 2; ++c) { u32x4 o1, o2;
#define RK1(i) (x1[i] * cs[i] - x2[i] * sn[i])
#define RK2(i) (x2[i] * cs[i] + x1[i] * sn[i])
                o1.x = pk2(RK1(c * 8 + 0), RK1(c * 8 + 1)); o1.y = pk2(RK1(c * 8 + 2), RK1(c * 8 + 3)); o1.z = pk2(RK1(c * 8 + 4), RK1(c * 8 + 5)); o1.w = pk2(RK1(c * 8 + 6), RK1(c * 8 + 7));
                o2.x = pk2(RK2(c * 8 + 0), RK2(c * 8 + 1)); o2.y = pk2(RK2(c * 8 + 2), RK2(c * 8 + 3)); o2.z = pk2(RK2(c * 8 + 4), RK2(c * 8 + 5)); o2.w = pk2(RK2(c * 8 + 6), RK2(c * 8 + 7));
                *(GAS u32x4*)(kdst + (8 + c) * 512) = o1; *(GAS u32x4*)(kdst + (10 + c) * 512) = o2; }
#undef RK1
#undef RK2
        }
        bf16_t* vdst = WSP(bf16_t, WS_VIMG) + ((size_t)bh * 128 + (s >> 6)) * 4096 + (s & 63) * 32;
        const bf16_t* vsrc = O + (size_t)t * 1024 + 640 + h * 64;
#pragma unroll
        for (int c = 0; c < 8; ++c) *(GAS u32x4*)(vdst + (c >> 2) * 2048 + (c & 3) * 8) = *(const GAS u32x4*)(vsrc + c * 8);
    }
}

__device__ __forceinline__ void attn_unit(Frame& F, int bh, int qb) {
    const int tid = F.tid, lane = F.lane, wid = F.wave, r32 = lane & 31, hi = lane >> 5;
    LAS unsigned char* KB = F.lds;
    LAS unsigned char* VB = F.lds + 24576;
    LAS float* wsf = (LAS float*)(F.lds + 40960) + wid * 64;
    const int b = bh >> 2, h = bh & 3;
    const bf16_t* Qp = WSP(bf16_t, WS_Q) + ((size_t)bh * SEQ + qb * 256 + wid * 32 + r32) * 96 + hi * 8;
    bf16x8 qr[6];
#pragma unroll
    for (int d0 = 0; d0 < 6; ++d0) qr[d0] = *(const GAS bf16x8*)(Qp + d0 * 16);
    const GAS u32x4* Kg = (const GAS u32x4*)(WSP(bf16_t, WS_KIMG) + (size_t)bh * 128 * 6144);
    const GAS u32x4* Vg = (const GAS u32x4*)(WSP(bf16_t, WS_VIMG) + (size_t)bh * 128 * 4096);
    const bool kx = tid < 256;
    u32x4 k0 = Kg[tid], k1 = kx ? Kg[512 + tid] : (u32x4){0u, 0u, 0u, 0u}, v0 = Vg[tid];
    u32x4 k2 = Kg[768 + tid], k3 = kx ? Kg[768 + 512 + tid] : (u32x4){0u, 0u, 0u, 0u};
    *(LAS u32x4*)(KB + tid * 16) = k0; if (kx) *(LAS u32x4*)(KB + (512 + tid) * 16) = k1; *(LAS u32x4*)(VB + tid * 16) = v0;
    *(LAS u32x4*)(KB + 12288 + tid * 16) = k2; if (kx) *(LAS u32x4*)(KB + 12288 + (512 + tid) * 16) = k3;
    __syncthreads();
    f32x16 s0, s1;
    qkt_tile<6>(s0, s1, KB, qr, r32, hi);
    __syncthreads();
    f32x16 o[2]; float lsum = 0.f;
#pragma unroll
    for (int r = 0; r < 16; ++r) { o[0][r] = 0.f; o[1][r] = 0.f; }
    float m;
    { float rm = fmaxf(fmaxf(s0[0], s1[0]), fmaxf(s0[1], s1[1]));
#pragma unroll
      for (int r = 2; r < 16; r += 2) rm = fmaxf(fmaxf(rm, s0[r]), fmaxf(s1[r], fmaxf(s0[r + 1], s1[r + 1])));
      m = fmaxf(rm, __shfl_xor(rm, 32));
#pragma unroll
      for (int r = 0; r < 16; ++r) { s0[r] -= m; s1[r] -= m; } }
    LAS const unsigned char* vbl = VB + ((lane >> 4) & 1) * 32 + (lane & 3) * 8 + (4 * hi + ((lane & 15) >> 2)) * 64;
    u32x4 kb0 = Kg[2 * 768 + tid], kb1 = kx ? Kg[2 * 768 + 512 + tid] : (u32x4){0u, 0u, 0u, 0u}, vb0 = Vg[512 + tid];
#define ATT_ITER(T, LK0, LK1, LV, WK0, WK1, WV) do { \
        const int t = (T); const int cur = t & 1; \
        const int tv = (t + 2 < 128) ? t + 2 : 127, tk = (t + 3 < 128) ? t + 3 : 127; \
        LK0 = Kg[tk * 768 + tid]; if (kx) LK1 = Kg[tk * 768 + 512 + tid]; \
        LV = Vg[tv * 512 + tid]; \
        LAS const unsigned char* Kt = KB + (cur ^ 1) * 12288 + hi * 1024 + r32 * 16; \
        bf16x8 kf[12]; \
        _Pragma("unroll") for (int d0 = 0; d0 < 6; ++d0) { kf[2 * d0] = *(const LAS bf16x8*)(Kt + d0 * 2048); kf[2 * d0 + 1] = *(const LAS bf16x8*)(Kt + d0 * 2048 + 512); } \
        _Pragma("unroll") for (int r = 0; r < 16; ++r) { s0[r] = __builtin_amdgcn_exp2f(s0[r]); s1[r] = __builtin_amdgcn_exp2f(s1[r]); } \
        { float ls_ = 0.f; _Pragma("unroll") for (int r = 0; r < 16; ++r) ls_ += s0[r] + s1[r]; lsum += ls_; } \
        bf16x8 pa[4]; pack_p(s0, s1, pa); \
        f32x16 n0, n1; { const float nm_ = -m; _Pragma("unroll") for (int r = 0; r < 16; ++r) { n0[r] = nm_; n1[r] = nm_; } } \
        n0 = MFMA32(kf[0], qr[0], n0); n1 = MFMA32(kf[1], qr[0], n1); \
        _Pragma("unroll") for (int d0 = 1; d0 < 6; ++d0) { n0 = MFMA32(kf[2 * d0], qr[d0], n0); n1 = MFMA32(kf[2 * d0 + 1], qr[d0], n1); } \
        LAS const unsigned char* vb = vbl + cur * 8192; \
        _Pragma("unroll") for (int ks = 0; ks < 4; ++ks) { \
            _Pragma("unroll") for (int d0 = 0; d0 < 2; ++d0) { \
                const s16x4 lo = vtr(vb + d0 * 4096 + ks * 1024), hh = vtr(vb + d0 * 4096 + ks * 1024 + 512); \
                const bf16x8 vf = (bf16x8){lo[0], lo[1], lo[2], lo[3], hh[0], hh[1], hh[2], hh[3]}; \
                o[d0] = MFMA32(pa[ks], vf, o[d0]); } } \
        float rm = fmaxf(fmaxf(n0[0], n1[0]), fmaxf(n0[1], n1[1])); \
        _Pragma("unroll") for (int r = 2; r < 16; r += 2) rm = fmaxf(fmaxf(rm, n0[r]), fmaxf(n1[r], fmaxf(n0[r + 1], n1[r + 1]))); \
        rm = fmaxf(rm, __shfl_xor(rm, 32)); \
        _Pragma("unroll") for (int i = 0; i < 12; ++i) { __builtin_amdgcn_sched_group_barrier(0x008, 1, 0); __builtin_amdgcn_sched_group_barrier(0x002, 7, 0); } \
        if (__any(rm > 8.0f)) { \
            const float dl = fmaxf(rm, 0.f), f = __builtin_amdgcn_exp2f(-dl); \
            m += dl; lsum *= f; \
            _Pragma("unroll") for (int r = 0; r < 16; ++r) { n0[r] -= dl; n1[r] -= dl; } \
            if (hi == 0) wsf[r32] = f; \
            LDS_WAIT(); \
            _Pragma("unroll") for (int r = 0; r < 16; ++r) { const float fr = wsf[crow(r, hi)]; o[0][r] *= fr; o[1][r] *= fr; } \
        } \
        *(LAS u32x4*)(KB + cur * 12288 + tid * 16) = WK0; if (kx) *(LAS u32x4*)(KB + cur * 12288 + (512 + tid) * 16) = WK1; \
        *(LAS u32x4*)(VB + (cur ^ 1) * 8192 + tid * 16) = WV; \
        __syncthreads(); \
        s0 = n0; s1 = n1; } while (0)
#pragma unroll 1
    for (int t2 = 0; t2 < 128; t2 += 2) {
        ATT_ITER(t2, k0, k1, v0, kb0, kb1, vb0);
        ATT_ITER(t2 + 1, kb0, kb1, vb0, k0, k1, v0);
    }
#undef ATT_ITER
    lsum += __shfl_xor(lsum, 32);
    if (hi == 0) wsf[r32] = 1.0f / lsum;
    LDS_WAIT();
    bf16_t* Y = WSP(bf16_t, WS_YATT);
#pragma unroll
    for (int r = 0; r < 16; ++r) { const float rl = wsf[crow(r, hi)]; const int q = qb * 256 + wid * 32 + crow(r, hi);
        bf16_t* yp = Y + ((size_t)b * SEQ + q) * 256 + h * 64 + r32;
        yp[0] = (bf16_t)(pk2(o[0][r] * rl, 0.f) & 0xffffu); yp[32] = (bf16_t)(pk2(o[1][r] * rl, 0.f) & 0xffffu); }
    __syncthreads();
}

#define PX(e) ((e) + ((e) >> 5))
__device__ __forceinline__ f32x2 cmul(f32x2 a, float c, float s) { return (f32x2){a.x * c - a.y * s, a.x * s + a.y * c}; }
__device__ __forceinline__ void bf4_fwd(f32x2& x0, f32x2& x1, f32x2& x2, f32x2& x3, float c1, float s1) {
    const float c2 = c1 * c1 - s1 * s1, s2 = 2.0f * c1 * s1, c3 = c2 * c1 - s2 * s1, s3 = c2 * s1 + s2 * c1;
    const f32x2 a = x0 + x2, b = x0 - x2, c = x1 + x3, d = x1 - x3;
    x0 = a + c;
    x1 = cmul((f32x2){b.x + d.y, b.y - d.x}, c1, s1);
    x2 = cmul(a - c, c2, s2);
    x3 = cmul((f32x2){b.x - d.y, b.y + d.x}, c3, s3);
}
__device__ __forceinline__ void bf4_inv(f32x2& x0, f32x2& x1, f32x2& x2, f32x2& x3, float c1, float s1) {
    const float c2 = c1 * c1 - s1 * s1, s2 = 2.0f * c1 * s1, c3 = c2 * c1 - s2 * s1, s3 = c2 * s1 + s2 * c1;
    const f32x2 t1 = cmul(x1, c1, s1), t2 = cmul(x2, c2, s2), t3 = cmul(x3, c3, s3);
    const f32x2 a = x0 + t2, b = x0 - t2, c = t1 + t3, d = t1 - t3;
    x0 = a + c; x2 = a - c;
    x1 = (f32x2){b.x - d.y, b.y + d.x};
    x3 = (f32x2){b.x + d.y, b.y - d.x};
}
template <bool INV>
__device__ __forceinline__ void fft_r4_last(LAS f32x2* X, int tid) {
#pragma unroll 2
    for (int i = 0; i < 8; ++i) { int base = 4 * (tid + 512 * i); asm volatile("" : "+v"(base));
        f32x2 x0 = X[PX(base)], x1 = X[PX(base + 1)], x2 = X[PX(base + 2)], x3 = X[PX(base + 3)];
        if (!INV) bf4_fwd(x0, x1, x2, x3, 1.0f, 0.0f); else bf4_inv(x0, x1, x2, x3, 1.0f, 0.0f);
        X[PX(base)] = x0; X[PX(base + 1)] = x1; X[PX(base + 2)] = x2; X[PX(base + 3)] = x3; }
    __syncthreads();
}
template <bool INV>
__device__ __forceinline__ void r16_core(f32x2 (&x)[16], int j, int lq, float r16, float r4) {
    const float angB = (float)j * r4;
    if (!INV) {
#pragma unroll
        for (int r = 0; r < 4; ++r) { const float ang = (float)(j + (r << lq)) * r16; bf4_fwd(x[r], x[r + 4], x[r + 8], x[r + 12], cos_rev(ang), -sin_rev(ang)); }
        const float cb = cos_rev(angB), sb = -sin_rev(angB);
#pragma unroll
        for (int k = 0; k < 4; ++k) bf4_fwd(x[4 * k], x[4 * k + 1], x[4 * k + 2], x[4 * k + 3], cb, sb);
    } else {
        const float cb = cos_rev(angB), sb = sin_rev(angB);
#pragma unroll
        for (int k = 0; k < 4; ++k) bf4_inv(x[4 * k], x[4 * k + 1], x[4 * k + 2], x[4 * k + 3], cb, sb);
#pragma unroll
        for (int r = 0; r < 4; ++r) { const float ang = (float)(j + (r << lq)) * r16; bf4_inv(x[r], x[r + 4], x[r + 8], x[r + 12], cos_rev(ang), sin_rev(ang)); }
    }
}
template <bool INV>
__device__ __forceinline__ void fft_r16_pass(LAS f32x2* X, int tid, int lq) {
    const int qp = 1 << lq;
    const float r16 = 1.0f / (float)(16 * qp), r4 = 1.0f / (float)(4 * qp);
    int u0 = tid; asm volatile("" : "+v"(u0)); int u1 = tid + 512; asm volatile("" : "+v"(u1));
    const int j0 = u0 & (qp - 1), b0 = ((u0 >> lq) << (lq + 4)) + j0, j1 = u1 & (qp - 1), b1 = ((u1 >> lq) << (lq + 4)) + j1;
    f32x2 xa[16], xb[16];
#pragma unroll
    for (int r = 0; r < 16; ++r) xa[r] = X[PX(b0 + (r << lq))];
#pragma unroll
    for (int r = 0; r < 16; ++r) xb[r] = X[PX(b1 + (r << lq))];
    r16_core<INV>(xa, j0, lq, r16, r4);
#pragma unroll
    for (int r = 0; r < 16; ++r) X[PX(b0 + (r << lq))] = xa[r];
    r16_core<INV>(xb, j1, lq, r16, r4);
#pragma unroll
    for (int r = 0; r < 16; ++r) X[PX(b1 + (r << lq))] = xb[r];
    __syncthreads();
}
template <bool INV>
__device__ __forceinline__ void fft16k(LAS f32x2* X, int tid) {
    if (!INV) { fft_r16_pass<false>(X, tid, 10); fft_r16_pass<false>(X, tid, 6); fft_r16_pass<false>(X, tid, 2); fft_r4_last<false>(X, tid); }
    else { fft_r4_last<true>(X, tid); fft_r16_pass<true>(X, tid, 2); fft_r16_pass<true>(X, tid, 6); fft_r16_pass<true>(X, tid, 10); }
}
__device__ __forceinline__ int drev4(int x) { unsigned y = __builtin_bitreverse32((unsigned)x) >> 18; return (int)(((y & 0x2AAAu) >> 1) | ((y & 0x1555u) << 1)); }
__device__ __forceinline__ float block_sum(Frame& F, float v, LAS float* red) {
    v = wave_sum(v);
    if (F.lane == 0) red[F.wave] = v;
    __syncthreads();
    float s = 0.f;
#pragma unroll
    for (int w = 0; w < NWAVES; ++w) s += red[w];
    __syncthreads();
    return s;
}
__device__ __forceinline__ void hyena_item(Frame& F, int c_in, int l) {
    int c = c_in; asm volatile("" : "+s"(c));
    const int tid = F.tid;
    LAS f32x2* X = (LAS f32x2*)F.lds;
    LAS float* red = (LAS float*)(F.lds + XTRA_OFF);
    f32x2* KF = WSP(f32x2, WS_KF) + (size_t)c * 2 * 16384;
    {
        const float* F0f = WSP(float, WS_FILT) + ((size_t)l * 1024 + c) * SEQ; const float* F0b = F0f + (size_t)256 * SEQ;
        const float* F1f = F0f + (size_t)512 * SEQ; const float* F1b = F0f + (size_t)768 * SEQ;
        float s0 = 0.f, s1 = 0.f;
#pragma unroll 1
        for (int i0 = 0; i0 < 16; i0 += 8) { float a0[8], b0[8], a1[8], b1[8];
#pragma unroll
            for (int i = 0; i < 8; ++i) { int t = tid + 512 * (i0 + i); asm volatile("" : "+v"(t)); a0[i] = F0f[t]; b0[i] = F0b[t]; a1[i] = F1f[t]; b1[i] = F1b[t]; }
#pragma unroll
            for (int i = 0; i < 8; ++i) { const int t = tid + 512 * (i0 + i); s0 += fabsf(a0[i]) + fabsf(b0[i]); s1 += fabsf(a1[i]) + fabsf(b1[i]);
                X[PX(t)] = (f32x2){a0[i], a1[i]}; X[PX(16383 - t)] = (f32x2){b0[i], b1[i]}; } }
        const float inv0 = 0.5f / block_sum(F, s0, red), inv1 = 0.5f / block_sum(F, s1, red);
        fft16k<false>(X, tid);
#pragma unroll 2
        for (int i = 0; i < 32; ++i) { int p = tid + 512 * i; asm volatile("" : "+v"(p)); const int f = drev4(p), pp = drev4((16384 - f) & 16383);
            const f32x2 w = X[PX(p)], wp = X[PX(pp)];
            KF[p] = (f32x2){(w.x + wp.x) * inv0, (w.y - wp.y) * inv0};
            KF[16384 + p] = (f32x2){(w.y + wp.y) * inv1, (wp.x - w.x) * inv1}; }
        __syncthreads();
    }
    const float* HT0 = WSP(float, WS_HYT);
    const float hb0 = INF(27)[l * 512 + c], hb1 = INF(27)[l * 512 + 256 + c];
    float zz[16][2];
    { const float* z0p = HT0 + (size_t)(0 * 768 + 512 + c) * SEQ; const float* z1p = HT0 + (size_t)(1 * 768 + 512 + c) * SEQ;
#pragma unroll
      for (int i = 0; i < 16; ++i) { zz[i][0] = z0p[tid + 512 * i]; zz[i][1] = z1p[tid + 512 * i]; }
#pragma unroll
      for (int i = 0; i < 16; ++i) { int t = tid + 512 * i; asm volatile("" : "+v"(t)); X[PX(t)] = (f32x2){zz[i][0], zz[i][1]}; X[PX(8192 + t)] = (f32x2){0.f, 0.f}; } }
    __syncthreads();
    const float invn = 1.0f / 16384.0f;
#pragma unroll 1
    for (int o = 0; o < 2; ++o) {
        const f32x2* kp = KF + o * 16384;
        f32x2 kv[16];
#pragma unroll
        for (int i = 0; i < 16; ++i) kv[i] = kp[tid + 512 * i];
        fft16k<false>(X, tid);
#pragma unroll
        for (int i = 0; i < 16; ++i) { int p = tid + 512 * i; asm volatile("" : "+v"(p)); const f32x2 v = X[PX(p)]; X[PX(p)] = (f32x2){v.x * kv[i].x - v.y * kv[i].y, v.x * kv[i].y + v.y * kv[i].x}; }
#pragma unroll
        for (int i = 0; i < 16; ++i) kv[i] = kp[tid + 512 * (16 + i)];
#pragma unroll
        for (int i = 0; i < 16; ++i) { int p = tid + 512 * (16 + i); asm volatile("" : "+v"(p)); const f32x2 v = X[PX(p)]; X[PX(p)] = (f32x2){v.x * kv[i].x - v.y * kv[i].y, v.x * kv[i].y + v.y * kv[i].x}; }
        __syncthreads();
        fft16k<true>(X, tid);
        float ga[16], gb[16];
        { const float* g0p = HT0 + (size_t)(0 * 768 + o * 256 + c) * SEQ; const float* g1p = HT0 + (size_t)(1 * 768 + o * 256 + c) * SEQ;
#pragma unroll
          for (int i = 0; i < 16; ++i) { ga[i] = g0p[tid + 512 * i]; gb[i] = g1p[tid + 512 * i]; } }
        const float hbo = o ? hb1 : hb0;
        if (o == 0) {
#pragma unroll
            for (int i = 0; i < 16; ++i) { int t = tid + 512 * i; asm volatile("" : "+v"(t)); const f32x2 y = X[PX(t)];
                zz[i][0] = ga[i] * (y.x * invn + zz[i][0] * hbo); zz[i][1] = gb[i] * (y.y * invn + zz[i][1] * hbo);
                X[PX(t)] = (f32x2){zz[i][0], zz[i][1]}; X[PX(8192 + t)] = (f32x2){0.f, 0.f}; }
            __syncthreads();
        } else {
            bf16_t* Y0 = WSP(bf16_t, WS_YHT) + (size_t)(0 * 256 + c) * SEQ; bf16_t* Y1 = WSP(bf16_t, WS_YHT) + (size_t)(1 * 256 + c) * SEQ;
#pragma unroll
            for (int i = 0; i < 16; ++i) { int t = tid + 512 * i; asm volatile("" : "+v"(t)); const f32x2 y = X[PX(t)];
                const float r0 = ga[i] * (y.x * invn + zz[i][0] * hbo), r1 = gb[i] * (y.y * invn + zz[i][1] * hbo);
                Y0[t] = (bf16_t)(pk2(r0, 0.f) & 0xffffu); Y1[t] = (bf16_t)(pk2(r1, 0.f) & 0xffffu); }
            __syncthreads();
        }
    }
}

__device__ __forceinline__ void hy_prep_tile(Frame& F, int tile, int l) {
    const int tid = F.tid, lane = F.lane, wave = F.wave;
    const int b = tile >> 7, t0 = (tile & 127) * 64;
    constexpr int RS = 1552;
    const bf16_t* U = WSP(bf16_t, WS_U);
    { u32x4 hv[13];
#pragma unroll
      for (int i = 0; i < 13; ++i) { const int idx = tid + 512 * i; const int row = idx / 96, pc = idx % 96; const int tok = t0 - 1 + row;
          hv[i] = (u32x4){0u, 0u, 0u, 0u};
          if (row < 66 && tok >= 0 && tok < SEQ) hv[i] = *(const GAS u32x4*)(U + ((size_t)b * SEQ + tok) * DINP + U_HY + pc * 8); }
#pragma unroll
      for (int i = 0; i < 13; ++i) { const int idx = tid + 512 * i; const int row = idx / 96, pc = idx % 96;
          if (row < 66) *(LAS u32x4*)(F.lds + row * RS + pc * 16) = hv[i]; } }
    __syncthreads();
    const float* cw = INF(16) + (size_t)l * 768 * 3; const float* cb = INF(17) + l * 768;
    float* HT = WSP(float, WS_HYT);
#pragma unroll 2
    for (int cp = wave; cp < 384; cp += 8) { const int ch = 2 * cp;
        const float w00 = cw[ch * 3], w01 = cw[ch * 3 + 1], w02 = cw[ch * 3 + 2], w10 = cw[ch * 3 + 3], w11 = cw[ch * 3 + 4], w12 = cw[ch * 3 + 5], b0 = cb[ch], b1 = cb[ch + 1];
        const unsigned r0 = *(const LAS unsigned*)(F.lds + lane * RS + cp * 4), r1 = *(const LAS unsigned*)(F.lds + (lane + 1) * RS + cp * 4), r2 = *(const LAS unsigned*)(F.lds + (lane + 2) * RS + cp * 4);
        HT[((size_t)(b * 768 + ch)) * SEQ + t0 + lane] = w00 * bflo(r0) + w01 * bflo(r1) + w02 * bflo(r2) + b0;
        HT[((size_t)(b * 768 + ch + 1)) * SEQ + t0 + lane] = w10 * bfhi(r0) + w11 * bfhi(r1) + w12 * bfhi(r2) + b1; }
    __syncthreads();
}

__device__ __forceinline__ void headnorm_phase(Frame& F, int l) {
    const int lane = F.lane, tid = F.tid, wave = F.wave;
    const bf16_t* U = WSP(bf16_t, WS_U); const bf16_t* YA = WSP(bf16_t, WS_YATT); const bf16_t* YH = WSP(bf16_t, WS_YHT);
    constexpr int RS2 = 528;
    const int g = wave >> 1, sub = wave & 1, cg = 4 * lane, ch = g * 256 + cg;
    const f32x4 og = *(const GAS f32x4*)(INF(29) + l * 1024 + ch);
    float scw[12];
#pragma unroll
    for (int j = 0; j < 12; ++j) scw[j] = INF(28)[(size_t)l * 768 + cg * 3 + j];
    for (int tile = F.vcu; tile < 256; tile += F.G) {
      const int tb = tile >> 7, t0 = (tile & 127) * 64;
#pragma unroll
      for (int i = 0; i < 4; ++i) { const int idx = tid + 512 * i, c = idx >> 3, p8 = idx & 7;
          const u32x4 v = *(const GAS u32x4*)(YH + ((size_t)(tb * 256 + c)) * SEQ + t0 + p8 * 8);
          LAS unsigned char* hp = F.lds + (8 * p8) * RS2 + 2 * c;
          *(LAS unsigned short*)(hp + 0 * RS2) = (unsigned short)(v.x & 0xffffu); *(LAS unsigned short*)(hp + 1 * RS2) = (unsigned short)(v.x >> 16);
          *(LAS unsigned short*)(hp + 2 * RS2) = (unsigned short)(v.y & 0xffffu); *(LAS unsigned short*)(hp + 3 * RS2) = (unsigned short)(v.y >> 16);
          *(LAS unsigned short*)(hp + 4 * RS2) = (unsigned short)(v.z & 0xffffu); *(LAS unsigned short*)(hp + 5 * RS2) = (unsigned short)(v.z >> 16);
          *(LAS unsigned short*)(hp + 6 * RS2) = (unsigned short)(v.w & 0xffffu); *(LAS unsigned short*)(hp + 7 * RS2) = (unsigned short)(v.w >> 16); }
      __syncthreads();
#pragma unroll 4
      for (int rr = 0; rr < 32; ++rr) {
        const int trow = sub * 32 + rr; const int m = tb * SEQ + t0 + trow;
        float y0, y1, y2, y3;
        if (g == 0) {
            const u32x2 ow = *(const GAS u32x2*)(U + (size_t)m * DINP + U_MLO + cg);
            const u32x2 hfw = *(const GAS u32x2*)(WSP(bf16_t, WS_HF) + (size_t)m * 256 + cg), hbw = *(const GAS u32x2*)(WSP(bf16_t, WS_HB) + (size_t)m * 256 + cg);
            const f32x4 hs = (f32x4){bflo(hfw.x) + bflo(hbw.x), bfhi(hfw.x) + bfhi(hbw.x), bflo(hfw.y) + bflo(hbw.y), bfhi(hfw.y) + bfhi(hbw.y)};
            y0 = hs.x / (1.0f + fexp(-bflo(ow.x))); y1 = hs.y / (1.0f + fexp(-bfhi(ow.x))); y2 = hs.z / (1.0f + fexp(-bflo(ow.y))); y3 = hs.w / (1.0f + fexp(-bfhi(ow.y)));
        } else if (g == 1) {
            const u32x2 w = *(const GAS u32x2*)(YA + (size_t)m * 256 + cg);
            y0 = bflo(w.x); y1 = bfhi(w.x); y2 = bflo(w.y); y3 = bfhi(w.y);
        } else if (g == 2) {
            const u32x2 w = *(const LAS u32x2*)(F.lds + trow * RS2 + cg * 2);
            y0 = bflo(w.x); y1 = bfhi(w.x); y2 = bflo(w.y); y3 = bfhi(w.y);
        } else {
            const int s = t0 + trow;
            const bf16_t* up = U + (size_t)m * DINP + U_SC + cg;
            const u32x2 bw = *(const GAS u32x2*)up;
            u32x2 c0 = {0u, 0u}, x0 = {0u, 0u}, c2 = {0u, 0u}, x2 = {0u, 0u};
            if (s > 0) { c0 = *(const GAS u32x2*)(up - DINP + 256); x0 = *(const GAS u32x2*)(up - DINP + 512); }
            const u32x2 c1 = *(const GAS u32x2*)(up + 256), x1 = *(const GAS u32x2*)(up + 512);
            if (s < SEQ - 1) { c2 = *(const GAS u32x2*)(up + DINP + 256); x2 = *(const GAS u32x2*)(up + DINP + 512); }
            y0 = bflo(bw.x) * (scw[0] * bflo(c0.x) * bflo(x0.x) + scw[1] * bflo(c1.x) * bflo(x1.x) + scw[2] * bflo(c2.x) * bflo(x2.x));
            y1 = bfhi(bw.x) * (scw[3] * bfhi(c0.x) * bfhi(x0.x) + scw[4] * bfhi(c1.x) * bfhi(x1.x) + scw[5] * bfhi(c2.x) * bfhi(x2.x));
            y2 = bflo(bw.y) * (scw[6] * bflo(c0.y) * bflo(x0.y) + scw[7] * bflo(c1.y) * bflo(x1.y) + scw[8] * bflo(c2.y) * bflo(x2.y));
            y3 = bfhi(bw.y) * (scw[9] * bfhi(c0.y) * bfhi(x0.y) + scw[10] * bfhi(c1.y) * bfhi(x1.y) + scw[11] * bfhi(c2.y) * bfhi(x2.y));
        }
        float ss = (y0 * y0 + y1 * y1) + (y2 * y2 + y3 * y3);
        ss += __shfl_xor(ss, 1); ss += __shfl_xor(ss, 2); ss += __shfl_xor(ss, 4); ss += __shfl_xor(ss, 8);
        const float rstd = __builtin_amdgcn_rsqf(ss * (1.0f / 64.0f) + EPS);
        u32x2 w; w.x = pk2(y0 * rstd * og.x, y1 * rstd * og.y); w.y = pk2(y2 * rstd * og.z, y3 * rstd * og.w);
        *(GAS u32x2*)(WSP(bf16_t, WS_YN) + (size_t)m * DM + ch) = w;
      }
      __syncthreads();
    }
}

__device__ __forceinline__ void post_mixer_phase(Frame& F, int l, const float* xin) {
    const int gw = F.vcu * NWAVES + F.wave, NGW = F.G * NWAVES, lane = F.lane, tid = F.tid;
    LAS float* RWT = (LAS float*)F.lds;
    { const GAS f32x4* src = (const GAS f32x4*)(INF(31) + (size_t)l * 1024 * 16);
      f32x4 wv[8];
#pragma unroll
      for (int q = 0; q < 8; ++q) wv[q] = src[tid + NTHR * q];
#pragma unroll
      for (int q = 0; q < 8; ++q) { const int i = tid + NTHR * q; const f32x4 w = wv[q]; const int k = i >> 2, e4 = (i & 3) * 4;
          RWT[(e4 + 0) * 1024 + k] = w.x; RWT[(e4 + 1) * 1024 + k] = w.y; RWT[(e4 + 2) * 1024 + k] = w.z; RWT[(e4 + 3) * 1024 + k] = w.w; } }
    __syncthreads();
    const float* mod = WSP(float, WS_MOD);
    for (int m0 = gw; m0 < MTOK; m0 += 2 * NGW) {
        u32x2 yw[2][4]; f32x4 xr[2][4];
#pragma unroll
        for (int r = 0; r < 2; ++r) { const int mm = (m0 + r * NGW < MTOK) ? m0 + r * NGW : m0;
            const GAS u32x2* yr = (const GAS u32x2*)(WSP(bf16_t, WS_Y2) + (size_t)mm * DM) + lane;
#pragma unroll
            for (int j = 0; j < 4; ++j) yw[r][j] = yr[64 * j];
            if (l == 0) ld_row_f32(xin + (size_t)mm * DM, lane, xr[r]);
            else { const GAS u32x2* xb = (const GAS u32x2*)((const bf16_t*)xin + (size_t)mm * DM) + lane;
#pragma unroll
                for (int j = 0; j < 4; ++j) { const u32x2 w = xb[64 * j]; xr[r][j] = (f32x4){bflo(w.x), bfhi(w.x), bflo(w.y), bfhi(w.y)}; } } }
#pragma unroll
        for (int r = 0; r < 2; ++r) { const int m = m0 + r * NGW; if (m >= MTOK) break;
        const int b = m >> 13, s = m & 8191; const float* md = mod + (l * 2 + b) * 6144;
        f32x4 y2[4], x[4], pg[4], g1[4];
#pragma unroll
        for (int j = 0; j < 4; ++j) { y2[j] = (f32x4){bflo(yw[r][j].x), bfhi(yw[r][j].x), bflo(yw[r][j].y), bfhi(yw[r][j].y)}; x[j] = xr[r][j]; }
        ld_row_f32(INF(6) + l * 1024, lane, pg); ld_row_f32(md + 2048, lane, g1);
        const float rstd = __builtin_amdgcn_rsqf(row_ss(y2) * (1.0f / DM) + EPS);
#pragma unroll
        for (int j = 0; j < 4; ++j) x[j] = x[j] + g1[j] * (y2[j] * rstd * pg[j]);
        st_row_bf16(WSP(bf16_t, WS_X1) + (size_t)m * DM, lane, x);
        f32x4 h[4];
        modnorm(x, INF(7) + l * 1024, md + 4096, md + 3072, lane, h);
        st_row_bf16(WSP(bf16_t, WS_XN) + (size_t)m * DM, lane, h);
        float part[16];
#pragma unroll
        for (int e = 0; e < 16; ++e) part[e] = 0.f;
#pragma unroll
        for (int j = 0; j < 4; ++j) {
#pragma unroll
            for (int e = 0; e < 16; ++e) { const f32x4 w = *(const LAS f32x4*)(RWT + e * 1024 + 4 * lane + 256 * j);
                part[e] += (h[j].x * w.x + h[j].y * w.y) + (h[j].z * w.z + h[j].w * w.w); }
            asm volatile("" ::: "memory"); }
        float a8[8], a4[4], a2[2], lg;
        { const bool up = (lane & 32) != 0;
#pragma unroll
          for (int i = 0; i < 8; ++i) { const float keep = up ? part[8 + i] : part[i], send = up ? part[i] : part[8 + i]; a8[i] = keep + __shfl_xor(send, 32); } }
        { const bool up = (lane & 16) != 0;
#pragma unroll
          for (int i = 0; i < 4; ++i) { const float keep = up ? a8[4 + i] : a8[i], send = up ? a8[i] : a8[4 + i]; a4[i] = keep + __shfl_xor(send, 16); } }
        { const bool up = (lane & 8) != 0;
#pragma unroll
          for (int i = 0; i < 2; ++i) { const float keep = up ? a4[2 + i] : a4[i], send = up ? a4[i] : a4[2 + i]; a2[i] = keep + __shfl_xor(send, 8); } }
        { const bool up = (lane & 4) != 0; const float keep = up ? a2[1] : a2[0], send = up ? a2[0] : a2[1]; lg = keep + __shfl_xor(send, 4); }
        lg += __shfl_xor(lg, 2); lg += __shfl_xor(lg, 1);
        float mx = lg;
#pragma unroll
        for (int o = 4; o < 64; o <<= 1) mx = fmaxf(mx, __shfl_xor(mx, o));
        const float ex = fexp(lg - mx); float sm = ex;
#pragma unroll
        for (int o = 4; o < 64; o <<= 1) sm += __shfl_xor(sm, o);
        if ((lane & 3) == 0) WSP(float, WS_AFF)[((size_t)b * 16 + (lane >> 2)) * SEQ + s] = ex / sm;
        if (lane < 16) WSP(int, WS_SLOT)[(size_t)m * 16 + lane] = -1;
            }
    }
    __syncthreads();
}

__device__ __forceinline__ void topk_item(Frame& F, int it) {
    const int tid = F.tid, lane = F.lane, wave = F.wave;
    const int b = it >> 4, e = it & 15;
    LAS unsigned* wcnt = (LAS unsigned*)F.lds;
    LAS unsigned* wtot = wcnt + 16;
    unsigned key[16];
    { const GAS u32x4* src = (const GAS u32x4*)(WSP(float, WS_AFF) + (size_t)it * SEQ) + tid * 4;
#pragma unroll
      for (int q = 0; q < 4; ++q) { const u32x4 v = src[q]; key[4 * q] = v.x; key[4 * q + 1] = v.y; key[4 * q + 2] = v.z; key[4 * q + 3] = v.w; } }
    unsigned T = 0u;
#pragma unroll 1
    for (int bit = 30; bit >= 0; --bit) {
        const unsigned cand = T | (1u << bit);
        unsigned c = 0u;
#pragma unroll
        for (int i = 0; i < 16; ++i) c += (key[i] >= cand) ? 1u : 0u;
#pragma unroll
        for (int o = 1; o < 64; o <<= 1) c += __shfl_xor(c, o);
        LAS unsigned* wc = wcnt + (bit & 1) * 8;
        if (lane == 0) wc[wave] = c;
        __syncthreads();
        unsigned tot = 0u;
#pragma unroll
        for (int w = 0; w < NWAVES; ++w) tot += wc[w];
        if (tot >= (unsigned)CAP) T = cand;
    }
    unsigned cg = 0u, ce = 0u;
#pragma unroll
    for (int i = 0; i < 16; ++i) { cg += (key[i] > T) ? 1u : 0u; ce += (key[i] == T) ? 1u : 0u; }
    unsigned v = cg | (ce << 16), inc = v;
#pragma unroll
    for (int o = 1; o < 64; o <<= 1) { const unsigned n = __shfl_up(inc, o); if (lane >= o) inc += n; }
    __syncthreads();
    if (lane == 63) wtot[wave] = inc;
    __syncthreads();
    unsigned off = 0u, all = 0u;
#pragma unroll
    for (int w = 0; w < NWAVES; ++w) { const unsigned tw = wtot[w]; all += tw; if (w < wave) off += tw; }
    const unsigned need = (unsigned)CAP - (all & 0xffffu);
    const unsigned excl = off + inc - v;
    unsigned ng = excl & 0xffffu, ne = excl >> 16;
    int* IDX = WSP(int, WS_IDX) + (e * 2 + b) * CAP; int* SLOT = WSP(int, WS_SLOT);
#pragma unroll
    for (int i = 0; i < 16; ++i) { const int idx = tid * 16 + i; const unsigned k = key[i];
        const bool gt = k > T, eq = k == T; const bool sel = gt || (eq && ne < need);
        if (sel) { const int slot = (int)(ng + (ne < need ? ne : need)); IDX[slot] = b * SEQ + idx; SLOT[((size_t)b * SEQ + idx) * 16 + e] = slot; }
        ng += gt ? 1u : 0u; ne += eq ? 1u : 0u; }
    __syncthreads();
}

__device__ __forceinline__ void gather_phase(Frame& F) {
    const int gw = F.vcu * NWAVES + F.wave, NGW = F.G * NWAVES, lane = F.lane;
    const int* IDX = WSP(int, WS_IDX);
    for (int r = gw; r < NEXP * 2 * CAP; r += NGW) {
        const int e = r >> 11, b = (r >> 10) & 1, j = r & 1023;
        const int tok = IDX[(b * 16 + e) * CAP + j];
        const GAS u32x4* src = (const GAS u32x4*)(WSP(bf16_t, WS_XN) + ((size_t)b * SEQ + tok) * DM);
        GAS u32x4* dst = (GAS u32x4*)(WSP(bf16_t, WS_XE) + (size_t)r * DM);
        dst[lane] = src[lane]; dst[64 + lane] = src[64 + lane];
    }
}

__device__ __forceinline__ void combine_phase(Frame& F, int l) {
    const int gw = F.vcu * NWAVES + F.wave, NGW = F.G * NWAVES, lane = F.lane;
    const float* mod = WSP(float, WS_MOD);
    const bf16_t* YE = WSP(bf16_t, WS_YE);
    f32x4 pg[4]; ld_row_f32(INF(8) + l * 1024, lane, pg);
    for (int m0 = gw; m0 < MTOK; m0 += 2 * NGW) {
        int sl[2]; float gv[2]; f32x4 x1[2][4];
#pragma unroll
        for (int r = 0; r < 2; ++r) { const int mm = (m0 + r * NGW < MTOK) ? m0 + r * NGW : m0; const int b = mm >> 13, s = mm & 8191;
            sl[r] = -1; gv[r] = 0.f;
            if (lane < 16) { sl[r] = WSP(int, WS_SLOT)[(size_t)mm * 16 + lane]; gv[r] = WSP(float, WS_AFF)[((size_t)b * 16 + lane) * SEQ + s]; }
            { const GAS u32x2* xr = (const GAS u32x2*)(WSP(bf16_t, WS_X1) + (size_t)mm * DM) + lane;
#pragma unroll
              for (int j = 0; j < 4; ++j) { const u32x2 w = xr[64 * j]; x1[r][j] = (f32x4){bflo(w.x), bfhi(w.x), bflo(w.y), bfhi(w.y)}; } } }
#pragma unroll
        for (int r = 0; r < 2; ++r) { const int m = m0 + r * NGW; if (m >= MTOK) break;
            const int b = m >> 13; const float* md = mod + (l * 2 + b) * 6144;
            f32x4 acc[4];
#pragma unroll
            for (int j = 0; j < 4; ++j) acc[j] = (f32x4){0.f, 0.f, 0.f, 0.f};
            unsigned long long msk = __ballot(sl[r] >= 0) & 0xffffull;
            while (msk) {
                const int e0 = __builtin_ctzll(msk); msk &= msk - 1;
                int e1 = -1; if (msk) { e1 = __builtin_ctzll(msk); msk &= msk - 1; }
                const int s0 = __shfl(sl[r], e0); const float g0 = __shfl(gv[r], e0);
                const int s1 = __shfl(sl[r], e1 < 0 ? e0 : e1); const float g1 = (e1 < 0) ? 0.f : __shfl(gv[r], e1 < 0 ? e0 : e1);
                const GAS u32x2* r0 = (const GAS u32x2*)(YE + ((size_t)e0 * 2048 + b * CAP + s0) * DM) + lane;
                const GAS u32x2* r1 = (const GAS u32x2*)(YE + ((size_t)(e1 < 0 ? e0 : e1) * 2048 + b * CAP + s1) * DM) + lane;
                u32x2 w0[4], w1[4];
#pragma unroll
                for (int j = 0; j < 4; ++j) { w0[j] = r0[64 * j]; w1[j] = r1[64 * j]; }
#pragma unroll
                for (int j = 0; j < 4; ++j) { acc[j] += (f32x4){bflo(w0[j].x), bfhi(w0[j].x), bflo(w0[j].y), bfhi(w0[j].y)} * g0;
                                              acc[j] += (f32x4){bflo(w1[j].x), bfhi(w1[j].x), bflo(w1[j].y), bfhi(w1[j].y)} * g1; }
            }
            f32x4 g2[4]; ld_row_f32(md + 5120, lane, g2);
            const float rstd = __builtin_amdgcn_rsqf(row_ss(acc) * (1.0f / DM) + EPS);
            f32x4 xo[4];
#pragma unroll
            for (int j = 0; j < 4; ++j) xo[j] = x1[r][j] + g2[j] * (acc[j] * rstd * pg[j]);
            if (l == 0) st_row_bf16((bf16_t*)F.a->out + (size_t)m * DM, lane, xo); else st_row_f32(F.a->out + (size_t)m * DM, lane, xo);
            if (l == 0) { f32x4 h[4]; const float* md1 = mod + (1 * 2 + b) * 6144;
                modnorm(xo, INF(5) + 1024, md1 + 1024, md1, lane, h);
                st_row_bf16(WSP(bf16_t, WS_XN) + (size_t)m * DM, lane, h); }
        }
    }
}

constexpr int PH_PER_LAYER = 11, N_PHASES = 2 + 2 * PH_PER_LAYER;
__global__ void __launch_bounds__(NTHR, 2) mega_fwd(Args args) {
    extern __shared__ __attribute__((aligned(16))) unsigned char lds_raw[];
    Frame F;
    F.lds = (LAS unsigned char*)lds_raw;
    F.tid = threadIdx.x; F.lane = F.tid & 63; F.wave = __builtin_amdgcn_readfirstlane(F.tid >> 6);
    F.G = gridDim.x; { const int bx = blockIdx.x; F.vcu = (F.G % 8 == 0) ? (bx % 8) * (F.G / 8) + bx / 8 : bx; }
    F.a = &args; F.ws = args.ws;
    volatile LAS unsigned* MISC = (volatile LAS unsigned*)(F.lds + MISC_OFF);
    for (int u = F.tid; u < (LDS_BYTES - LDSCTL_OFF) / 4; u += NTHR) ((LAS unsigned*)(F.lds + LDSCTL_OFF))[u] = 0u;
    __syncthreads();
    gu32* ctl = (gu32*)(F.ws + WS_CTL);
    XcdBarrier bar; bar.bar = (unsigned*)(ctl + CW_BAR); bar.x = 0; bar.st = nullptr;
#if !MK_SPLIT
    bar = xcd_barrier_post((unsigned*)(ctl + CW_BAR), MISC + 8);
#endif
    const int lo = args.ph_lo, hi = args.ph_hi;
    int ph = 0;
#if MK_SPLIT
#define SEAM() do { } while (0)
#else
#define SEAM() do { if (ph + 1 < hi) xcd_barrier(bar); } while (0)
#endif
#ifndef PHSEL
#define PHSEL -1
#endif
#ifndef PHMASK
#define PHMASK 0x7fff
#endif
#ifndef DBL_MASK
#define DBL_MASK 0
#endif
#define PHASE_BEGIN(id) if ((PHSEL < 0 || PHSEL == (id)) && ((PHMASK >> (id)) & 1) && lo <= ph && ph < hi) for (int rep_ = 0; rep_ < (((DBL_MASK >> (id)) & 1) ? 2 : 1); ++rep_) { if (rep_) xcd_barrier(bar); { int t_ = threadIdx.x; asm volatile("" : "+v"(t_)); F.tid = t_; F.lane = t_ & 63; F.wave = __builtin_amdgcn_readfirstlane(t_ >> 6); }
#define PHASE_END   SEAM(); } ++ph;

    PHASE_BEGIN(0) p0_phase(F); PHASE_END
    PHASE_BEGIN(1) p1_phase(F); PHASE_END
#pragma unroll 1
    for (int l = 0; l < 2; ++l) {
        const float* xin = (l == 0) ? (const float*)args.in[0] : (const float*)args.out;
        PHASE_BEGIN(2) {
            pg8::Gemm g{WSP(bf16_t, WS_XN), WSP(bf16_t, WS_WIN) + (size_t)l * DINP * 1024, MTOK, DINP, 1024}; pg8::StaticOrder S; S.init(MTOK, DINP, F.G, (int)blockIdx.x);
            pg8::EpiBf16 E{WSP(bf16_t, WS_U), DINP, DINP / 256};
            pg8::gemm_phase<pg8::EpiBf16, pg8::StaticOrder, true, true>(F.lds, g, S, E, F.tid);
        } PHASE_END
        PHASE_BEGIN(3) {
#ifndef SUBSEL
#define SUBSEL 0
#endif
#ifndef REP_A
#define REP_A 1
#define REP_B 1
#define REP_C 1
#define REP_D 1
#define REP_E 1
#endif
            for (int q_ = 0; q_ < REP_A; ++q_) for (int tl = F.vcu; tl < 256; tl += F.G) hy_prep_tile(F, tl, l);
            for (int q_ = 0; q_ < REP_B; ++q_) for (int p = F.vcu; p < 512; p += F.G) ml_local_pair(F, p, l);
            for (int q_ = 0; q_ < REP_C; ++q_) mla_prep_rows(F, l);
        } PHASE_END
        PHASE_BEGIN(4) {
            pg8::Gemm g{WSP(bf16_t, WS_AMLA), WSP(bf16_t, WS_WMLA) + (size_t)l * 1024 * 384, MTOK, 1024, 384}; pg8::StaticOrder S; S.init(MTOK, 1024, F.G, (int)blockIdx.x);
            EpiMla E{WSP(bf16_t, WS_Q), WSP(bf16_t, WS_KIMG), WSP(bf16_t, WS_VIMG), (const int*)F.a->in[2], 0.10206207261596577f * LOG2E};
            pg8::gemm_phase<EpiMla, pg8::StaticOrder, true, true>(F.lds, g, S, E, F.tid);
#define REFRESH_TID() do { int t_ = threadIdx.x; asm volatile("" : "+v"(t_)); F.tid = t_; F.lane = t_ & 63; F.wave = __builtin_amdgcn_readfirstlane(t_ >> 6); } while (0)
            REFRESH_TID();
            ml_scan(F);
            REFRESH_TID();
#ifndef HY_REP
#define HY_REP 1
#endif
            for (int rep2_ = 0; rep2_ < HY_REP; ++rep2_) for (int c = F.vcu; c < 256; c += F.G) hyena_item(F, c, l);
        } PHASE_END
        PHASE_BEGIN(5) {
            for (int q_ = 0; q_ < REP_D; ++q_) for (int u = F.vcu; u < 256; u += F.G) attn_unit(F, u >> 5, u & 31);
            for (int q_ = 0; q_ < REP_E; ++q_) for (int p = F.vcu; p < 512; p += F.G) ml_out_pair(F, p, l);
        } PHASE_END
        PHASE_BEGIN(6) headnorm_phase(F, l); PHASE_END
        PHASE_BEGIN(7) {
            pg8::Gemm g{WSP(bf16_t, WS_YN), WSP(bf16_t, WS_WOUT) + (size_t)l * 1024 * 1024, MTOK, 1024, 1024}; pg8::StaticOrder S; S.init(MTOK, 1024, F.G, (int)blockIdx.x);
            pg8::EpiBf16 E{WSP(bf16_t, WS_Y2), 1024, 4};
            pg8::gemm_phase<pg8::EpiBf16, pg8::StaticOrder, true, true>(F.lds, g, S, E, F.tid);
        } PHASE_END
        PHASE_BEGIN(8) post_mixer_phase(F, l, xin); PHASE_END
        PHASE_BEGIN(9) { for (int it = F.vcu; it < 32; it += F.G) topk_item(F, it); } PHASE_END
        PHASE_BEGIN(10) {
            pg8::Gemm g{WSP(bf16_t, WS_XN), WSP(bf16_t, WS_WGU) + (size_t)l * NEXP * 4096 * 1024, NEXP * 2048, NEXP * 4096, 1024, WSP(int, WS_IDX)}; pg8::GroupedOrder S; S.init(16, F.G, (int)blockIdx.x);
            pg8::EpiSwiGLU E{WSP(bf16_t, WS_ACT), LDFF};
            pg8::gemm_phase<pg8::EpiSwiGLU, pg8::GroupedOrder, true, true, true>(F.lds, g, S, E, F.tid);
        } PHASE_END
        PHASE_BEGIN(11) {
            pg8::Gemm g{WSP(bf16_t, WS_ACT), WSP(bf16_t, WS_WDN) + (size_t)l * NEXP * 1024 * LDFF, NEXP * 2048, NEXP * 1024, 2048, nullptr, LDFF, LDFF}; pg8::GroupedOrder S; S.init(4, F.G, (int)blockIdx.x);
            pg8::EpiBf16 E{WSP(bf16_t, WS_YE), 1024, 4};
            pg8::gemm_phase<pg8::EpiBf16, pg8::GroupedOrder, true, true>(F.lds, g, S, E, F.tid);
        } PHASE_END
        PHASE_BEGIN(12) combine_phase(F, l); PHASE_END
    }
}

extern "C" void kernel_launch(void* const* d_in, const int* in_sizes, int n_in, void* d_out, int out_size, void* d_ws, size_t ws_size, hipStream_t stream) {
    static int grid = 0;
    if (grid == 0) {
        if (n_in != 35 || out_size != MTOK * DM || ws_size < WS_END) { fprintf(stderr, "kernel_launch: unexpected shapes: n_in %d out %d ws %zu (need %zu)\n", n_in, out_size, ws_size, (size_t)WS_END); grid = -1; return; }
        int dev = 0, cus = 0, per_cu = 0;
        if (hipGetDevice(&dev) != hipSuccess || hipDeviceGetAttribute(&cus, hipDeviceAttributeMultiprocessorCount, dev) != hipSuccess) { grid = -1; return; }
        if (hipFuncSetAttribute((const void*)mega_fwd, hipFuncAttributeMaxDynamicSharedMemorySize, LDS_BYTES) != hipSuccess) { fprintf(stderr, "kernel_launch: hipFuncSetAttribute failed\n"); grid = -1; return; }
        (void)hipOccupancyMaxActiveBlocksPerMultiprocessor(&per_cu, (const void*)mega_fwd, NTHR, LDS_BYTES);
        (void)hipGetLastError();
        grid = cus > 0 ? cus : 256;
        if (per_cu < 1) fprintf(stderr, "kernel_launch: occupancy query reports %d\n", per_cu);
    }
    if (grid < 0) return;
    (void)hipMemsetAsync((char*)d_ws + WS_CTL, 0, CTL_ZERO_BYTES, stream);
    Args a{};
    for (int i = 0; i < 35; ++i) a.in[i] = d_in[i];
    a.out = (float*)d_out; a.ws = (unsigned char*)d_ws;
#if MK_SPLIT
    for (int p = 0; p < N_PHASES; ++p) { a.ph_lo = p; a.ph_hi = p + 1; hipLaunchKernelGGL(mega_fwd, dim3(grid), dim3(NTHR), LDS_BYTES, stream, a); }
#else
    a.ph_lo = 0; a.ph_hi = N_PHASES;
    hipLaunchKernelGGL(mega_fwd, dim3(grid), dim3(NTHR), LDS_BYTES, stream, a);
#endif
}
```

```cpp
#include <hip/hip_runtime.h>
#include <cstdio>
#include <cstdint>

#ifndef MK_SPLIT
#define MK_SPLIT 0
#endif

#define GAS __attribute__((address_space(1)))
#define LAS __attribute__((address_space(3)))
typedef GAS unsigned gu32;
#define RLX_AGENT __ATOMIC_RELAXED, __HIP_MEMORY_SCOPE_AGENT
typedef unsigned short bf16_t;
typedef short bf16x8 __attribute__((ext_vector_type(8)));
typedef short s16x4 __attribute__((ext_vector_type(4)));
typedef float f32x4 __attribute__((ext_vector_type(4)));
typedef float f32x2 __attribute__((ext_vector_type(2)));
typedef float f32x16 __attribute__((ext_vector_type(16)));
typedef unsigned u32x4 __attribute__((ext_vector_type(4)));
typedef unsigned u32x2 __attribute__((ext_vector_type(2)));
typedef __bf16 bf16x2_t __attribute__((ext_vector_type(2)));

namespace pg8 {
#define PG8_LAS __attribute__((address_space(3)))
constexpr int BM = 256, BK = 64, HALF = 128, HTB = HALF * BK * 2, STAGE_BYTES = 8 * HTB, NXCD = 8, WGM = 8;
__host__ __device__ __forceinline__ int lds_byte(int r, int c) { const int st = (r >> 4) * 2 + (c >> 5), rr = r & 15, cc = c & 31, ob = rr * 64 + cc * 2; return st * 1024 + (ob ^ (((ob >> 9) & 1) << 5)); }
__host__ __device__ __forceinline__ void stage_rc(int b, int& R, int& C) { const int st = b / 1024, sb = b % 1024, swz = sb ^ (((sb >> 9) & 1) << 5); R = (st >> 1) * 16 + swz / 64; C = (st & 1) * 32 + (swz % 64) / 2; }
__host__ __device__ __forceinline__ int perm32(int rho) { const int n = rho >> 4, i = rho & 15; return 8 * (i >> 2) + 4 * n + (i & 3); }
struct Unit { int pm, pn; };
struct Gemm { const bf16_t* A; const bf16_t* Bt; int M, N, K; const int* rowidx; int lda, ldb; };
struct StaticOrder {
    int nM, nN, nwg, G, c;
    __host__ __device__ void init(int M, int N, int G_, int c_) { nM = M / BM; nN = N / BM; nwg = nM * nN; G = G_; c = c_; }
    __host__ __device__ bool next(int i, Unit& u) const {
        const long L = (long)i * G + c; if (L >= nwg) return false;
        int wgid = (int)L; { const int q = nwg / NXCD, r = nwg % NXCD, xcd = wgid % NXCD, off = wgid / NXCD; wgid = (xcd < r ? xcd * (q + 1) : r * (q + 1) + (xcd - r) * q) + off; }
        const int nig = WGM * nN, gid = wgid / nig, fm = gid * WGM, gsz = (nM - fm) < WGM ? (nM - fm) : WGM;
        u.pm = fm + ((wgid % nig) % gsz); u.pn = (wgid % nig) / gsz; return true;
    }
    __device__ __forceinline__ void a_ready(const Unit&) const {}
    __device__ __forceinline__ void done(const Unit&) const {}
};
struct GroupedOrder {
    int nNl, total, G, c;
    __host__ __device__ void init(int nNl_, int G_, int c_) { nNl = nNl_; total = 16 * 8 * nNl_; G = G_; c = c_; }
    __host__ __device__ bool next(int i, Unit& u) const {
        const long L = (long)i * G + c; if (L >= total) return false;
        if (G == 256 && (nNl == 16 || nNl == 4)) {
            const int x = c & 7, w = c >> 3;
            if (nNl == 16) { const int e = 2 * i + (w >> 4), q = w & 15; u.pm = e * 8 + 4 * (x & 1) + (q & 3); u.pn = e * 16 + 4 * (x >> 1) + (q >> 2); }
            else { const int e = 8 * i + x; u.pm = e * 8 + (w & 7); u.pn = e * 4 + (w >> 3); }
            return true;
        }
        const int per_e = 8 * nNl, e = (int)L / per_e, r = (int)L % per_e;
        u.pm = e * 8 + (r % 8); u.pn = e * nNl + (r / 8); return true;
    }
    __device__ __forceinline__ void a_ready(const Unit&) const {}
    __device__ __forceinline__ void done(const Unit&) const {}
};
__device__ __forceinline__ unsigned cvt_pk_bf16(float lo, float hi) { f32x2 v = {lo, hi}; bf16x2_t b = __builtin_convertvector(v, bf16x2_t); return __builtin_bit_cast(unsigned, b); }

struct EpiBf16 {
    static constexpr bool PERM = true, AFTER_DRAIN = false;
    bf16_t* O; int ldc; int ntn;
    __device__ __forceinline__ void operator()(const f32x4 (&acc)[2][2][4][2], const Unit& u, int wr, int wc, int fr, int fq) const {
        const int row0 = u.pm * BM + wr * 64 + fr; const int colt = (u.pn % ntn) * BM;
        const int col0 = colt + wc * 32 + 8 * fq;
#pragma unroll
        for (int ai = 0; ai < 2; ++ai)
#pragma unroll
            for (int m = 0; m < 4; ++m) { bf16_t* rowp = O + (size_t)(row0 + ai * HALF + m * 16) * ldc + col0;
#pragma unroll
                for (int bj = 0; bj < 2; ++bj) { const f32x4 v0 = acc[ai][bj][m][0], v1 = acc[ai][bj][m][1];
                    u32x4 w; w.x = cvt_pk_bf16(v0[0], v0[1]); w.y = cvt_pk_bf16(v0[2], v0[3]); w.z = cvt_pk_bf16(v1[0], v1[1]); w.w = cvt_pk_bf16(v1[2], v1[3]);
                    *(u32x4*)(rowp + bj * HALF) = w; } }
    }
};
struct EpiF32 {
    static constexpr bool PERM = false, AFTER_DRAIN = false;
    float* O; int ldc;
    __device__ __forceinline__ void operator()(const f32x4 (&acc)[2][2][4][2], const Unit& u, int wr, int wc, int fr, int fq) const {
        const int col0 = u.pn * BM + wc * 32 + 4 * fq;
#pragma unroll
        for (int ai = 0; ai < 2; ++ai)
#pragma unroll
            for (int m = 0; m < 4; ++m) { float* rowp = O + (size_t)(u.pm * BM + ai * HALF + wr * 64 + m * 16 + fr) * ldc + col0;
#pragma unroll
                for (int bj = 0; bj < 2; ++bj)
#pragma unroll
                    for (int n = 0; n < 2; ++n) *(f32x4*)(rowp + bj * HALF + n * 16) = acc[ai][bj][m][n]; }
    }
};
__device__ __forceinline__ float silu_f(float a) { return a * __builtin_amdgcn_rcpf(1.0f + __builtin_amdgcn_exp2f(-1.4426950408889634f * a)); }
struct EpiSwiGLU {
    static constexpr bool PERM = true, AFTER_DRAIN = false;
    bf16_t* O; int ldc;
    __device__ __forceinline__ void operator()(const f32x4 (&acc)[2][2][4][2], const Unit& u, int wr, int wc, int fr, int fq) const {
        const int row0 = u.pm * BM + wr * 64 + fr; const int col0 = (u.pn % 16) * HALF + wc * 32 + 8 * fq;
#pragma unroll
        for (int ai = 0; ai < 2; ++ai)
#pragma unroll
            for (int m = 0; m < 4; ++m) { bf16_t* rowp = O + (size_t)(row0 + ai * HALF + m * 16) * ldc + col0;
                const f32x4 g0 = acc[ai][0][m][0], g1 = acc[ai][0][m][1], u0 = acc[ai][1][m][0], u1 = acc[ai][1][m][1];
                u32x4 w;
                w.x = cvt_pk_bf16(silu_f(g0[0]) * u0[0], silu_f(g0[1]) * u0[1]); w.y = cvt_pk_bf16(silu_f(g0[2]) * u0[2], silu_f(g0[3]) * u0[3]);
                w.z = cvt_pk_bf16(silu_f(g1[0]) * u1[0], silu_f(g1[1]) * u1[1]); w.w = cvt_pk_bf16(silu_f(g1[2]) * u1[2], silu_f(g1[3]) * u1[3]);
                *(u32x4*)rowp = w; }
    }
};

template <class Epi, class Sched, bool ALIGN_EPI = false, bool SP2 = false, bool GATHER = false>
__device__ __forceinline__ void gemm_phase(PG8_LAS unsigned char* lds, const Gemm g, const Sched& S, const Epi& E, const int tid) {
    const int wid = __builtin_amdgcn_readfirstlane(tid >> 6), lane = tid & 63, wr = wid >> 2, wc = wid & 3, fr = lane & 15, fq = lane >> 4;
    int K_ = g.K; asm volatile("" : "+s"(K_));
    const int K = K_, nt = K / BK;
    const int lda = g.lda ? g.lda : K, ldb = g.ldb ? g.ldb : K;
    unsigned voffA[2], voffB[2];
#pragma unroll
    for (int i = 0; i < 2; ++i) { int R, C; stage_rc(tid * 16 + i * 8192, R, C); const int Rb = Epi::PERM ? ((R & ~31) + perm32(R & 31)) : R;
        voffA[i] = (unsigned)(R * lda + C) * 2u; voffB[i] = (unsigned)(Rb * ldb + C) * 2u; }
    const size_t kstep = (size_t)(BK * 2);
    const size_t hstepA = (size_t)HALF * lda * 2, hstepB = (size_t)HALF * ldb * 2;
    const size_t tstepA = 2 * hstepA, tstepB = 2 * hstepB;
    const unsigned ldsw = (unsigned)wid * 1024u;
    const int aoff = lds_byte(wr * 64 + fr, fq * 8), boff = lds_byte(wc * 32 + fr, fq * 8);
#define PG8_SA(b, h) (((b) * 2 + (h)) * HTB)
#define PG8_SB(b, h) ((4 + (b) * 2 + (h)) * HTB)
#define PG8_STAGE(bufoff, gbase, voff) do { _Pragma("unroll") for (int _i = 0; _i < 2; ++_i) \
        __builtin_amdgcn_global_load_lds((const unsigned*)((const char*)(gbase) + (voff)[_i]), (PG8_LAS unsigned*)(lds + (bufoff) + ldsw + _i * 8192), 16, 0, 0); } while (0)
#define PG8_LDA(dst, b, h) do { _Pragma("unroll") for (int m = 0; m < 4; ++m) _Pragma("unroll") for (int k = 0; k < 2; ++k) dst[m][k] = *(const PG8_LAS bf16x8*)(lds + PG8_SA(b, h) + aoff + m * 2048 + k * 1024); } while (0)
#define PG8_LDB(dst, b, h) do { _Pragma("unroll") for (int n = 0; n < 2; ++n) _Pragma("unroll") for (int k = 0; k < 2; ++k) dst[n][k] = *(const PG8_LAS bf16x8*)(lds + PG8_SB(b, h) + boff + n * 2048 + k * 1024); } while (0)
#define PG8_MMA(ai, bj, At, Bt) do { __builtin_amdgcn_s_setprio(1); _Pragma("unroll") for (int m = 0; m < 4; ++m) _Pragma("unroll") for (int n = 0; n < 2; ++n) _Pragma("unroll") for (int k = 0; k < 2; ++k) \
        acc[ai][bj][m][n] = __builtin_amdgcn_mfma_f32_16x16x32_bf16(Bt[n][k], At[m][k], acc[ai][bj][m][n], 0, 0, 0); __builtin_amdgcn_s_setprio(0); } while (0)
#define PG8_WAIT_V(n) asm volatile("s_waitcnt vmcnt(" #n ")" ::: "memory")
#define PG8_WAIT_L(n) asm volatile("s_waitcnt lgkmcnt(" #n ")" ::: "memory")
#define PG8_BAR __builtin_amdgcn_s_barrier()
#define PG8_SCHED __builtin_amdgcn_sched_barrier(0)
    Unit cur, nxt; int ui = 0;
    if (!S.next(0, cur)) return;
    f32x4 acc[2][2][4][2];
#pragma unroll
    for (int a = 0; a < 2; ++a)
#pragma unroll
        for (int b = 0; b < 2; ++b)
#pragma unroll
            for (int m = 0; m < 4; ++m)
#pragma unroll
                for (int n = 0; n < 2; ++n) acc[a][b][m][n] = (f32x4){0.f, 0.f, 0.f, 0.f};
    bf16x8 At[4][2], B0[2][2], B1[2][2];
    const char* cA = GATHER ? (const char*)g.A : (const char*)g.A + (size_t)cur.pm * tstepA; const char* cB = (const char*)g.Bt + (size_t)cur.pn * tstepB;
    unsigned gc0[2] = {0u, 0u}, gc1[2] = {0u, 0u}, gn0[2] = {0u, 0u}, gn1[2] = {0u, 0u}; int gR[2] = {0, 0}; unsigned gC[2] = {0u, 0u};
    if constexpr (GATHER) {
#pragma unroll
        for (int i = 0; i < 2; ++i) { int R, C; stage_rc(tid * 16 + i * 8192, R, C); gR[i] = R; gC[i] = (unsigned)C * 2u;
            gc0[i] = (unsigned)g.rowidx[cur.pm * BM + R] * (unsigned)(lda * 2) + gC[i]; gc1[i] = (unsigned)g.rowidx[cur.pm * BM + HALF + R] * (unsigned)(lda * 2) + gC[i]; }
    }
#define PG8_STAGE_A(bufoff, base, half, o0, o1) do { if constexpr (GATHER) { if ((half) == 0) PG8_STAGE(bufoff, base, o0); else PG8_STAGE(bufoff, base, o1); } \
        else PG8_STAGE(bufoff, (base) + ((half) ? hstepA : 0), voffA); } while (0)
    S.a_ready(cur);
    if constexpr (SP2) {
        PG8_STAGE(PG8_SB(0, 0), cB, voffB); PG8_STAGE(PG8_SB(0, 1), cB + hstepB, voffB); PG8_STAGE_A(PG8_SA(0, 0), cA, 0, gc0, gc1); PG8_STAGE_A(PG8_SA(0, 1), cA, 1, gc0, gc1);
        if (wr == 1) PG8_BAR;
        PG8_WAIT_V(2); PG8_BAR;
        PG8_STAGE(PG8_SB(1, 0), cB + kstep, voffB); PG8_STAGE_A(PG8_SA(1, 0), cA + kstep, 0, gc0, gc1); PG8_STAGE(PG8_SB(1, 1), cB + hstepB + kstep, voffB);
        PG8_WAIT_V(6); PG8_BAR;
    } else {
        PG8_STAGE(PG8_SB(0, 0), cB, voffB); PG8_STAGE(PG8_SA(0, 0), cA, voffA); PG8_STAGE(PG8_SB(0, 1), cB + hstepB, voffB); PG8_STAGE(PG8_SA(0, 1), cA + hstepA, voffA);
        if (wr == 1) PG8_BAR;
        PG8_WAIT_V(4); PG8_BAR;
        PG8_STAGE(PG8_SB(1, 0), cB + kstep, voffB); PG8_STAGE(PG8_SA(1, 0), cA + kstep, voffA); PG8_STAGE(PG8_SB(1, 1), cB + hstepB + kstep, voffB);
        PG8_WAIT_V(6); PG8_BAR;
    }
    for (;;) {
        const bool has_next = S.next(ui + 1, nxt);
        const char* nA = GATHER ? cA : (has_next ? (const char*)g.A + (size_t)nxt.pm * tstepA : cA); const char* nB = has_next ? (const char*)g.Bt + (size_t)nxt.pn * tstepB : cB;
        if constexpr (GATHER) { const int npm = has_next ? nxt.pm : cur.pm;
#pragma unroll
            for (int i = 0; i < 2; ++i) { gn0[i] = (unsigned)g.rowidx[npm * BM + gR[i]] * (unsigned)(lda * 2) + gC[i]; gn1[i] = (unsigned)g.rowidx[npm * BM + HALF + gR[i]] * (unsigned)(lda * 2) + gC[i]; } }
        for (int t = 0; t < nt; t += 2) {
            const bool last = (t == nt - 2);
            const char* a1 = cA + (size_t)(t + 1) * kstep;
            const char* a2 = last ? nA : cA + (size_t)(t + 2) * kstep; const char* b2 = last ? nB : cB + (size_t)(t + 2) * kstep;
            const char* a3 = a2 + kstep; const char* b3 = b2 + kstep;
            if (last && has_next) S.a_ready(nxt);
            if constexpr (SP2) {
            unsigned gs0[2], gs1[2];
#pragma unroll
            for (int i = 0; i < 2; ++i) { gs0[i] = last ? gn0[i] : gc0[i]; gs1[i] = last ? gn1[i] : gc1[i]; }
            PG8_LDB(B0, 0, 0); PG8_LDB(B1, 0, 1); PG8_SCHED; PG8_LDA(At, 0, 0); PG8_STAGE_A(PG8_SA(1, 1), a1, 1, gc0, gc1);
            PG8_WAIT_V(8); PG8_WAIT_L(0); PG8_BAR; PG8_MMA(0, 0, At, B0); PG8_MMA(0, 1, At, B1); PG8_BAR; PG8_SCHED;
            PG8_LDA(At, 0, 1); PG8_STAGE(PG8_SB(0, 0), b2, voffB); PG8_STAGE(PG8_SB(0, 1), b2 + hstepB, voffB); PG8_STAGE_A(PG8_SA(0, 0), a2, 0, gs0, gs1);
            PG8_WAIT_V(8); PG8_WAIT_L(0); PG8_BAR; PG8_MMA(1, 0, At, B0); PG8_MMA(1, 1, At, B1); PG8_BAR; PG8_SCHED;
            PG8_LDB(B0, 1, 0); PG8_LDB(B1, 1, 1); PG8_SCHED; PG8_LDA(At, 1, 0); PG8_STAGE_A(PG8_SA(0, 1), a2, 1, gs0, gs1);
            PG8_WAIT_V(8); PG8_WAIT_L(0); PG8_BAR; PG8_MMA(0, 0, At, B0); PG8_MMA(0, 1, At, B1); PG8_BAR; PG8_SCHED;
            PG8_LDA(At, 1, 1); PG8_STAGE(PG8_SB(1, 0), b3, voffB); PG8_STAGE(PG8_SB(1, 1), b3 + hstepB, voffB); PG8_STAGE_A(PG8_SA(1, 0), a3, 0, gs0, gs1);
            PG8_WAIT_V(8); PG8_WAIT_L(0); PG8_BAR; PG8_MMA(1, 0, At, B0); PG8_MMA(1, 1, At, B1); PG8_BAR; PG8_SCHED;
            } else {
            PG8_LDB(B0, 0, 0); PG8_SCHED; PG8_LDA(At, 0, 0); PG8_STAGE(PG8_SA(1, 1), a1 + hstepA, voffA);
            PG8_WAIT_L(8); PG8_BAR; PG8_WAIT_L(0); PG8_MMA(0, 0, At, B0); PG8_BAR; PG8_SCHED;
            PG8_LDB(B1, 0, 1); PG8_STAGE(PG8_SB(0, 0), b2, voffB);
            PG8_BAR; PG8_WAIT_L(0); PG8_MMA(0, 1, At, B1); PG8_BAR;
            PG8_LDA(At, 0, 1); PG8_STAGE(PG8_SA(0, 0), a2, voffA);
            PG8_BAR; PG8_WAIT_L(0); PG8_MMA(1, 0, At, B0); PG8_BAR; PG8_SCHED;
            PG8_STAGE(PG8_SB(0, 1), b2 + hstepB, voffB);
            PG8_WAIT_V(6); PG8_BAR; PG8_MMA(1, 1, At, B1); PG8_BAR;
            PG8_LDB(B0, 1, 0); PG8_SCHED; PG8_LDA(At, 1, 0); PG8_STAGE(PG8_SA(0, 1), a2 + hstepA, voffA);
            PG8_WAIT_L(8); PG8_BAR; PG8_WAIT_L(0); PG8_MMA(0, 0, At, B0); PG8_BAR; PG8_SCHED;
            PG8_LDB(B1, 1, 1); PG8_STAGE(PG8_SB(1, 0), b3, voffB);
            PG8_BAR; PG8_WAIT_L(0); PG8_MMA(0, 1, At, B1); PG8_BAR;
            PG8_LDA(At, 1, 1); PG8_STAGE(PG8_SA(1, 0), a3, voffA);
            PG8_BAR; PG8_WAIT_L(0); PG8_MMA(1, 0, At, B0); PG8_BAR; PG8_SCHED;
            PG8_STAGE(PG8_SB(1, 1), b3 + hstepB, voffB);
            PG8_WAIT_V(6); PG8_BAR; PG8_MMA(1, 1, At, B1); PG8_BAR;
            }
        }
        if constexpr (ALIGN_EPI) { if (wr == 0) PG8_BAR; }
        if constexpr (!Epi::AFTER_DRAIN) { E(acc, cur, wr, wc, fr, fq); S.done(cur); }
        if (!has_next) break;
#pragma unroll
        for (int a = 0; a < 2; ++a)
#pragma unroll
            for (int b = 0; b < 2; ++b)
#pragma unroll
                for (int m = 0; m < 4; ++m)
#pragma unroll
                    for (int n = 0; n < 2; ++n) acc[a][b][m][n] = (f32x4){0.f, 0.f, 0.f, 0.f};
        cur = nxt; cA = nA; cB = nB; ++ui;
        if constexpr (GATHER) { gc0[0] = gn0[0]; gc0[1] = gn0[1]; gc1[0] = gn1[0]; gc1[1] = gn1[1]; }
        if constexpr (ALIGN_EPI) { if (wr == 1) PG8_BAR; }
    }
    PG8_WAIT_V(0);
    if constexpr (!ALIGN_EPI) { if (wr == 0) PG8_BAR; }
    PG8_BAR;
#undef PG8_SA
#undef PG8_SB
#undef PG8_STAGE
#undef PG8_STAGE_A
#undef PG8_LDA
#undef PG8_LDB
#undef PG8_MMA
#undef PG8_WAIT_V
#undef PG8_WAIT_L
#undef PG8_BAR
#undef PG8_SCHED
}
}

__device__ __forceinline__ double rope_kd(int i) {
    switch (i) { case 0: return 0.15915494309189535; case 1: return 0.08949940160889101; case 2: return 0.050329212104487035; case 3: return 0.0283021958306234;
        case 4: return 0.015915494309189534; case 5: return 0.008949940160889102; case 6: return 0.005032921210448704; case 7: return 0.00283021958306234;
        case 8: return 0.0015915494309189536; case 9: return 0.0008949940160889102; case 10: return 0.0005032921210448703; case 11: return 0.00028302195830623395;
        case 12: return 0.00015915494309189535; case 13: return 8.949940160889102e-05; case 14: return 5.0329212104487035e-05; default: return 2.8302195830623396e-05; }
}
__device__ __forceinline__ float rope_frac(int p, int i) {
    const double kd = rope_kd(i); const float kh = (float)kd, kl = (float)(kd - (double)kh), pf = (float)p;
    const float r1 = pf * kh, e1 = __builtin_fmaf(pf, kh, -r1) + pf * kl;
    float fr = (r1 - __builtin_floorf(r1)) + e1;
    return fr - __builtin_floorf(fr);
}
struct EpiMla {
    static constexpr bool PERM = true, AFTER_DRAIN = false;
    bf16_t* Q; bf16_t* KI; bf16_t* VI; const int* pos; float qscale;
    __device__ __forceinline__ void operator()(const f32x4 (&acc)[2][2][4][2], const pg8::Unit& u, int wr, int wc, int fr, int fq) const {
        const int tile = u.pn & 3;
#pragma unroll
        for (int ai = 0; ai < 2; ++ai)
#pragma unroll
            for (int m = 0; m < 4; ++m) {
                int t = u.pm * 256 + ai * 128 + wr * 64 + m * 16 + fr; asm volatile("" : "+v"(t)); const int b = t >> 13, sq = t & 8191;
                if (tile == 1) {
                    const f32x4 v0 = acc[ai][0][m][0], v1 = acc[ai][0][m][1];
                    u32x4 w; w.x = pg8::cvt_pk_bf16(v0[0] * qscale, v0[1] * qscale); w.y = pg8::cvt_pk_bf16(v0[2] * qscale, v0[3] * qscale); w.z = pg8::cvt_pk_bf16(v1[0] * qscale, v1[1] * qscale); w.w = pg8::cvt_pk_bf16(v1[2] * qscale, v1[3] * qscale);
                    *(u32x4*)(Q + ((size_t)(b * 4 + wc) * 8192 + sq) * 96 + 64 + 8 * fq) = w;
                } else {
#pragma unroll
                    for (int bj = 0; bj < 2; ++bj) { const f32x4 v0 = acc[ai][bj][m][0], v1 = acc[ai][bj][m][1];
                        const int h = 2 * bj + (wc >> 1), bh = b * 4 + h;
                        if (tile == 0) { u32x4 w; w.x = pg8::cvt_pk_bf16(v0[0] * qscale, v0[1] * qscale); w.y = pg8::cvt_pk_bf16(v0[2] * qscale, v0[3] * qscale); w.z = pg8::cvt_pk_bf16(v1[0] * qscale, v1[1] * qscale); w.w = pg8::cvt_pk_bf16(v1[2] * qscale, v1[3] * qscale);
                            *(u32x4*)(Q + ((size_t)bh * 8192 + sq) * 96 + 32 * (wc & 1) + 8 * fq) = w; }
                        else { u32x4 w; w.x = pg8::cvt_pk_bf16(v0[0], v0[1]); w.y = pg8::cvt_pk_bf16(v0[2], v0[3]); w.z = pg8::cvt_pk_bf16(v1[0], v1[1]); w.w = pg8::cvt_pk_bf16(v1[2], v1[3]);
                            if (tile == 2) *(u32x4*)(KI + ((size_t)bh * 128 + (sq >> 6)) * 6144 + (4 * (wc & 1) + fq) * 512 + (sq & 63) * 8) = w;
                            else *(u32x4*)(VI + ((size_t)bh * 128 + (sq >> 6)) * 4096 + (wc & 1) * 2048 + (sq & 63) * 32 + 8 * fq) = w; } }
                }
                asm volatile("" ::: "memory");
            }
    }
};

constexpr int NWAVES = 8, NTHR = 512;
constexpr int BATCH = 2, SEQ = 8192, DM = 1024, MTOK = BATCH * SEQ;
constexpr int DIN = 2960, DINP = 3072;
constexpr int NEXP = 16, CAP = 1024, EFF = 2048;
constexpr int LDFF = EFF + 64;
constexpr float EPS = 1e-6f;
constexpr int U_MLQ = 0, U_MLK = 256, U_MLV = 512, U_MLO = 768, U_MLG = 1024, U_CQ = 1040, U_CKV = 1264, U_KR = 1392, U_HY = 1424, U_SC = 2192;
constexpr float LOG2E = 1.4426950408889634f;

constexpr size_t MiB = 1u << 20;
constexpr size_t WS_CTL = 0, CTL_ZERO_BYTES = 1 * MiB;
constexpr size_t WS_MOD = 1 * MiB;
constexpr size_t WS_MLS = 1 * MiB + 128 * 1024;
constexpr size_t WS_MLN = 1 * MiB + 256 * 1024;
constexpr size_t WS_AFF = 2 * MiB;
constexpr size_t WS_SLOT = 3 * MiB;
constexpr size_t WS_IDX = 4 * MiB;
constexpr size_t WS_HID = 5 * MiB;
constexpr size_t WS_W3T = 7 * MiB;
constexpr size_t WS_WMLA = 9 * MiB;
constexpr size_t WS_WOUT = 11 * MiB;
constexpr size_t WS_WIN = 15 * MiB;
constexpr size_t WS_WGU = 28 * MiB;
constexpr size_t WS_WDN = 284 * MiB;
constexpr size_t WS_XN = 616 * MiB;
constexpr size_t WS_AMLA = 444 * MiB;
constexpr size_t WS_Q = 456 * MiB;
constexpr size_t WS_KIMG = 468 * MiB;
constexpr size_t WS_VIMG = 480 * MiB;
constexpr size_t WS_MLC = 488 * MiB;
constexpr size_t WS_HF = 504 * MiB;
constexpr size_t WS_HB = 520 * MiB;
constexpr size_t WS_YATT = 536 * MiB;
constexpr size_t WS_YHT = 544 * MiB;
constexpr size_t WS_YN = 552 * MiB;
constexpr size_t WS_X1 = 584 * MiB;
constexpr size_t WS_U = 648 * MiB;
constexpr size_t WS_OMLA = 744 * MiB;
constexpr size_t WS_ACT = 648 * MiB;
constexpr size_t WS_KF = 776 * MiB;
constexpr size_t WS_Y2 = 776 * MiB;
constexpr size_t WS_XE = 776 * MiB;
constexpr size_t WS_YE = 840 * MiB;
constexpr size_t WS_HYT = 904 * MiB;
constexpr size_t WS_FILT = 956 * MiB;
constexpr size_t WS_END = 1020 * MiB;
constexpr int CW_BAR = 4096;

constexpr int RING_BYTES = 139264;
constexpr int LDSCTL_OFF = RING_BYTES, MISC_OFF = LDSCTL_OFF + 320;
constexpr int XTRA_OFF = RING_BYTES + 1024;
constexpr int LDS_BYTES = 147456;

__device__ __forceinline__ float bf2f(unsigned short u) { return __uint_as_float((unsigned)u << 16); }
__device__ __forceinline__ unsigned pk2(float lo, float hi) { f32x2 v = {lo, hi}; bf16x2_t b = __builtin_convertvector(v, bf16x2_t); return __builtin_bit_cast(unsigned, b); }
__device__ __forceinline__ float bflo(unsigned w) { return __uint_as_float(w << 16); }
__device__ __forceinline__ float bfhi(unsigned w) { return __uint_as_float(w & 0xffff0000u); }
__device__ __forceinline__ float wave_sum(float v) {
#pragma unroll
    for (int o = 1; o < 64; o <<= 1) v += __shfl_xor(v, o);
    return v;
}
__device__ __forceinline__ float fexp(float x) { return __builtin_amdgcn_exp2f(x * LOG2E); }
__device__ __forceinline__ float flog(float x) { return __builtin_amdgcn_logf(x) * 0.6931471805599453f; }
__device__ __forceinline__ float sin_rev(float r) { return __builtin_amdgcn_sinf(r); }
__device__ __forceinline__ float cos_rev(float r) { return __builtin_amdgcn_cosf(r); }
__device__ __forceinline__ float sin_rad(float x) { float r = x * 0.15915494309189535f; r = r - __builtin_rintf(r); return __builtin_amdgcn_sinf(r); }
__device__ __forceinline__ int crow(int r, int hi) { return (r & 3) + 8 * (r >> 2) + 4 * hi; }
#define MFMA32(a, b, c) __builtin_amdgcn_mfma_f32_32x32x16_bf16((a), (b), (c), 0, 0, 0)
#define LDS_WAIT() asm volatile("s_waitcnt lgkmcnt(0)" ::: "memory")
#define VM_WAIT() asm volatile("s_waitcnt vmcnt(0)" ::: "memory")

#define XB_TMO      128
#define XB_XCNT(j)  (256  + 64 * (j))
#define XB_XSUB(j)  (1280 + 64 * (j))
#define XB_XGEN(j)  (2304 + 64 * (j))
#define XB_TOP      3328
#define XB_TOPGEN   3392
#define XCD_BAR_WORDS 3456
#define XB_SPIN_CAP (1u << 18)
__device__ __forceinline__ unsigned xb_ld(unsigned* p)              { return __hip_atomic_load(p, __ATOMIC_RELAXED, __HIP_MEMORY_SCOPE_AGENT); }
__device__ __forceinline__ unsigned xb_add(unsigned* p, unsigned v) { return __hip_atomic_fetch_add(p, v, __ATOMIC_RELAXED, __HIP_MEMORY_SCOPE_AGENT); }
__device__ __forceinline__ unsigned xb_xcc_id() { return (unsigned)__builtin_amdgcn_s_getreg((3 << 11) | 20) & 0xFu; }
#define XB_SPIN(cond, bar) do { unsigned _sp = 0; while (cond) { __builtin_amdgcn_s_sleep(1); \
    if ((++_sp & 255u) == 0u) { if (xb_ld(&(bar)[XB_TMO])) break; if (_sp > XB_SPIN_CAP) { atomicAdd(&(bar)[XB_TMO], 1u); break; } } } } while (0)
struct XcdBarrier { unsigned* bar; unsigned x; volatile LAS unsigned* st; };
__device__ __forceinline__ XcdBarrier xcd_barrier_post(unsigned* bar, volatile LAS unsigned* st) {
    XcdBarrier b; b.bar = bar; b.x = xb_xcc_id(); b.st = st;
    if (threadIdx.x == 0) (void)xb_add(&bar[XB_XCNT(b.x)], 1u);
    return b;
}
__device__ __forceinline__ void xcd_barrier_complete(unsigned* bar, unsigned x, unsigned& nloc, unsigned& nx) {
    const unsigned G = gridDim.x * gridDim.y * gridDim.z;
    unsigned sum, cnt, mine, sp = 0u;
    for (;;) {
        sum = 0u; cnt = 0u; mine = 0u;
#pragma unroll
        for (unsigned j = 0; j < 16; ++j) { const unsigned c = xb_ld(&bar[XB_XCNT(j)]); sum += c; cnt += (c > 0u) ? 1u : 0u; mine = (j == x) ? c : mine; }
        if (sum == G) break;
        __builtin_amdgcn_s_sleep(1);
        if ((++sp & 255u) == 0u) { if (xb_ld(&bar[XB_TMO])) break; if (sp > XB_SPIN_CAP) { atomicAdd(&bar[XB_TMO], 1u); break; } }
    }
    nloc = mine > 0u ? mine : 1u; nx = cnt > 0u ? cnt : 1u;
}
__device__ __forceinline__ void xcd_barrier(const XcdBarrier& b) {
    asm volatile("s_waitcnt vmcnt(0)" ::: "memory");
    __syncthreads();
    if (threadIdx.x == 0) {
        unsigned* bar = b.bar;
        __builtin_amdgcn_s_waitcnt(0);
        unsigned nloc = b.st[0], nx = b.st[1];
        if (nloc == 0u) { xcd_barrier_complete(bar, b.x, nloc, nx); b.st[0] = nloc; b.st[1] = nx; }
        const unsigned old = xb_add(&bar[XB_XSUB(b.x)], 1u);
        const unsigned gen = old / nloc;
        if (old + 1u == (gen + 1u) * nloc) {
            __builtin_amdgcn_fence(__ATOMIC_RELEASE, "agent");
            asm volatile("s_waitcnt vmcnt(0)" ::: "memory");
            const unsigned og = xb_add(&bar[XB_TOP], 1u);
            const unsigned tg = og / nx;
            if (og + 1u == (tg + 1u) * nx) xb_add(&bar[XB_TOPGEN], 1u);
            else XB_SPIN(xb_ld(&bar[XB_TOPGEN]) == tg, bar);
            __builtin_amdgcn_fence(__ATOMIC_ACQUIRE, "agent");
            xb_add(&bar[XB_XGEN(b.x)], 1u);
            asm volatile("s_waitcnt vmcnt(0)" ::: "memory");
        } else {
            XB_SPIN(xb_ld(&bar[XB_XGEN(b.x)]) == gen, bar);
            __builtin_amdgcn_fence(__ATOMIC_ACQUIRE, "agent");
            asm volatile("s_waitcnt vmcnt(0)" ::: "memory");
        }
    }
    __syncthreads();
}

struct Args { const void* in[35]; float* out; unsigned char* ws; int ph_lo, ph_hi; };
struct Frame {
    LAS unsigned char* lds;
    int tid, lane, wave, vcu, G;
    const Args* a;
    unsigned char* ws;
};
#define INF(i) ((const float*)F.a->in[i])
#define WSP(T, off) ((T*)(F.ws + (off)))

__device__ __forceinline__ void tr_item(const float* W, int ldw, int Kvalid, int Nvalid, int k0, int n0, bf16_t* dst, int dpitch, int drow0, int dk0, LAS float* scr, int lane, int NW = 64) {
    f32x4 v[16];
    const int nn = n0 + 4 * (lane & 15);
#pragma unroll
    for (int i = 0; i < 16; ++i) { const int kk = 4 * i + (lane >> 4);
        v[i] = (f32x4){0.f, 0.f, 0.f, 0.f};
        if (W != nullptr && (k0 + kk) < Kvalid && nn < Nvalid) v[i] = *(const GAS f32x4*)(W + (size_t)(k0 + kk) * ldw + nn); }
#pragma unroll
    for (int i = 0; i < 16; ++i) { const int kk = 4 * i + (lane >> 4);
        *(LAS f32x4*)(scr + kk * 64 + ((4 * (lane & 15)) ^ (4 * ((kk >> 3) & 7)))) = v[i]; }
    LDS_WAIT(); asm volatile("" ::: "memory");
    const int kc = lane & 7, nl = lane >> 3;
#pragma unroll
    for (int j = 0; j < 8; ++j) { const int n = 8 * j + nl; const LAS float* sp = scr + (8 * kc) * 64 + (n ^ (4 * kc));
        u32x4 o; o.x = pk2(sp[0 * 64], sp[1 * 64]); o.y = pk2(sp[2 * 64], sp[3 * 64]); o.z = pk2(sp[4 * 64], sp[5 * 64]); o.w = pk2(sp[6 * 64], sp[7 * 64]);
        if (n < NW) *(GAS u32x4*)(dst + (size_t)(drow0 + n) * dpitch + dk0 + k0 + 8 * kc) = o; }
    LDS_WAIT(); asm volatile("" ::: "memory");
}

__device__ __forceinline__ void p0_phase(Frame& F) {
    const int tid = F.tid, lane = F.lane, wave = F.wave;
    {
        LAS float* cs = (LAS float*)(F.lds);
        LAS float* red = (LAS float*)(F.lds + 8192);
        const float* c = INF(1);
        for (int i = tid; i < 2048; i += NTHR) { const float v = c[i]; cs[i] = v / (1.0f + fexp(-v)); }
        __syncthreads();
        for (int cb = blockIdx.x; cb < 256; cb += F.G) {
            const int j = tid % 48, kg = tid / 48;
            const int col = cb * 48 + j, l = col / 6144, n = col % 6144;
            if (kg < 10) {
                const float* w = INF(3) + (size_t)l * 1024 * 6144 + n;
                float a0 = 0.f, a1 = 0.f;
#pragma unroll 1
                for (int k0 = kg; k0 < 1024; k0 += 260) {
                    float wv[26];
#pragma unroll
                    for (int u = 0; u < 26; ++u) { const int k = k0 + 10 * u; wv[u] = (k < 1024) ? w[(size_t)k * 6144] : 0.f; }
                    __builtin_amdgcn_sched_barrier(0);
#pragma unroll
                    for (int u = 0; u < 26; ++u) { const int k = (k0 + 10 * u < 1024) ? k0 + 10 * u : kg; a0 += cs[k] * wv[u]; a1 += cs[1024 + k] * wv[u]; }
                }
                red[(kg * 48 + j) * 2] = a0; red[(kg * 48 + j) * 2 + 1] = a1;
            }
            __syncthreads();
            if (tid < 96) { const int jj = tid >> 1, b = tid & 1; float s = 0.f;
                for (int g = 0; g < 10; ++g) s += red[(g * 48 + jj) * 2 + b];
                const int col2 = cb * 48 + jj, l2 = col2 / 6144, n2 = col2 % 6144;
                WSP(float, WS_MOD)[(l2 * 2 + b) * 6144 + n2] = s + INF(4)[l2 * 6144 + n2]; }
            __syncthreads();
        }
    }
    {
        const int gw = F.vcu * NWAVES + wave, NGW = F.G * NWAVES;
        for (int l = 0; l < 2; ++l) {
            const float* w1 = INF(18) + l * 17 * 64; const float* w2 = INF(21) + l * 64 * 64;
            float w1c[17], w2c[64];
#pragma unroll
            for (int i = 0; i < 17; ++i) w1c[i] = w1[i * 64 + lane];
#pragma unroll
            for (int k = 0; k < 64; ++k) w2c[k] = w2[k * 64 + lane];
            const float b1 = INF(19)[l * 64 + lane], fr1 = INF(20)[l * 64 + lane], b2 = INF(22)[l * 64 + lane], fr2 = INF(23)[l * 64 + lane];
            for (int t = gw; t < SEQ; t += NGW) {
                const float tt = (float)t * (1.0f / SEQ);
                float a = b1 + tt * w1c[0];
#pragma unroll
                for (int bnd = 1; bnd <= 8; ++bnd) { float r = (float)((t * bnd) & (SEQ - 1)) * (1.0f / SEQ); a += sin_rev(r) * w1c[bnd] + cos_rev(r) * w1c[8 + bnd]; }
                const float h1 = sin_rad(fr1 * a);
                float a2 = b2;
#pragma unroll
                for (int k = 0; k < 64; ++k) a2 += __shfl(h1, k) * w2c[k];
                WSP(bf16_t, WS_HID)[((size_t)l * SEQ + t) * 64 + lane] = (bf16_t)(pk2(sin_rad(fr2 * a2), 0.f) & 0xffffu);
            }
        }
    }
    {
        LAS float* scr = (LAS float*)(F.lds + wave * 16384);
        const int gw = F.vcu * NWAVES + wave, NGW = F.G * NWAVES;
        constexpr int I_WIN = 16 * 48, I_WOUT = 16 * 16, I_WMLA = 6 * 16, I_W3 = 16, I_GU = 16 * 2 * 16 * 32, I_DN = 16 * 32 * 16;
        constexpr int I_LAYER = I_WIN + I_WOUT + I_WMLA + I_W3 + I_GU + I_DN;
        constexpr int I_SMALL = I_WIN + I_WOUT + I_WMLA + I_W3;
        const bool hosted = (F.G == 256) && !MK_SPLIT;
        const int per_layer = hosted ? I_SMALL : I_LAYER;
        for (int it = gw; it < 2 * per_layer; it += NGW) {
            const int l = it / per_layer; int r = it % per_layer;
            if (r < I_WIN) { const int kb = r / 48, nb = r % 48;
                tr_item(INF(9) + (size_t)l * 1024 * DIN, DIN, 1024, DIN, kb * 64, nb * 64, WSP(bf16_t, WS_WIN) + (size_t)l * DINP * 1024, 1024, nb * 64, 0, scr, lane); continue; }
            r -= I_WIN;
            if (r < I_WOUT) { const int kb = r / 16, nb = r % 16;
                tr_item(INF(30) + (size_t)l * 1024 * 1024, 1024, 1024, 1024, kb * 64, nb * 64, WSP(bf16_t, WS_WOUT) + (size_t)l * 1024 * 1024, 1024, nb * 64, 0, scr, lane); continue; }
            r -= I_WOUT;
            if (r < I_WMLA) { const int kb = r / 16, nb = r % 16;
                bf16_t* dst = WSP(bf16_t, WS_WMLA) + (size_t)l * 1024 * 384;
                const float* Wq = INF(13) + (size_t)l * 224 * 384;
                if (nb < 4) { if (kb < 4) tr_item(Wq, 384, 224, nb * 96 + 64, kb * 64, nb * 96, dst, 384, nb * 64, 0, scr, lane); else tr_item(nullptr, 4, 0, 0, 0, 0, dst, 384, nb * 64, kb * 64, scr, lane); }
                else if (nb < 6) { const int h0 = 2 * (nb - 4);
                    if (kb < 4) { tr_item(Wq, 384, 224, h0 * 96 + 96, kb * 64, h0 * 96 + 64, dst, 384, 256 + h0 * 32, 0, scr, lane, 32);
                                  tr_item(Wq, 384, 224, (h0 + 1) * 96 + 96, kb * 64, (h0 + 1) * 96 + 64, dst, 384, 256 + (h0 + 1) * 32, 0, scr, lane, 32); }
                    else tr_item(nullptr, 4, 0, 0, 0, 0, dst, 384, nb * 64, kb * 64, scr, lane); }
                else if (nb < 8) tr_item(nullptr, 4, 0, 0, 0, 0, dst, 384, nb * 64, kb * 64, scr, lane);
                else { const float* W = (nb < 12) ? INF(14) + (size_t)l * 128 * 256 : INF(15) + (size_t)l * 128 * 256; const int nsrc = ((nb - 8) & 3) * 64;
                    if (kb >= 4) tr_item(W, 256, 128, 256, (kb - 4) * 64, nsrc, dst, 384, nb * 64, 256, scr, lane); else tr_item(nullptr, 4, 0, 0, 0, 0, dst, 384, nb * 64, kb * 64, scr, lane); }
                continue; }
            r -= I_WMLA;
            if (r < I_W3) { tr_item(INF(24) + (size_t)l * 64 * 1024, 1024, 64, 1024, 0, r * 64, WSP(bf16_t, WS_W3T) + (size_t)l * 1024 * 64, 64, r * 64, 0, scr, lane); continue; }
            r -= I_W3;
            if (r < I_GU) { const int e = r / (2 * 16 * 32); int q = r % (2 * 16 * 32); const int which = q / (16 * 32); q %= (16 * 32); const int kb = q / 32, nb = q % 32;
                const float* W = INF(which ? 33 : 32) + ((size_t)l * NEXP + e) * 1024 * 2048;
                const int n0 = nb * 64, drow = (n0 >> 7) * 256 + (n0 & 127) + (which ? 128 : 0);
                tr_item(W, 2048, 1024, 2048, kb * 64, n0, WSP(bf16_t, WS_WGU) + ((size_t)l * NEXP + e) * 4096 * 1024, 1024, drow, 0, scr, lane); continue; }
            r -= I_GU;
            { const int e = r / (32 * 16); const int q = r % (32 * 16); const int kb = q / 16, nb = q % 16;
                const float* W = INF(34) + ((size_t)l * NEXP + e) * 2048 * 1024;
                tr_item(W, 1024, 2048, 1024, kb * 64, nb * 64, WSP(bf16_t, WS_WDN) + ((size_t)l * NEXP + e) * 1024 * LDFF, LDFF, nb * 64, 0, scr, lane); }
        }
    }
}

__device__ __forceinline__ void ld_row_f32(const float* p, int lane, f32x4 (&v)[4]) {
    const GAS f32x4* r = (const GAS f32x4*)p + lane;
#pragma unroll
    for (int j = 0; j < 4; ++j) v[j] = r[64 * j];
}
__device__ __forceinline__ void st_row_f32(float* p, int lane, const f32x4 (&v)[4]) {
    GAS f32x4* r = (GAS f32x4*)p + lane;
#pragma unroll
    for (int j = 0; j < 4; ++j) r[64 * j] = v[j];
}
__device__ __forceinline__ void st_row_bf16(bf16_t* p, int lane, const f32x4 (&v)[4]) {
    GAS u32x2* r = (GAS u32x2*)p + lane;
#pragma unroll
    for (int j = 0; j < 4; ++j) { u32x2 w; w.x = pk2(v[j].x, v[j].y); w.y = pk2(v[j].z, v[j].w); r[64 * j] = w; }
}
__device__ __forceinline__ float row_ss(const f32x4 (&v)[4]) {
    float s = 0.f;
#pragma unroll
    for (int j = 0; j < 4; ++j) s += (v[j].x * v[j].x + v[j].y * v[j].y) + (v[j].z * v[j].z + v[j].w * v[j].w);
    return wave_sum(s);
}
__device__ __forceinline__ void modnorm(const f32x4 (&x)[4], const float* g, const float* sc, const float* sh, int lane, f32x4 (&h)[4]) {
    const float rstd = __builtin_amdgcn_rsqf(row_ss(x) * (1.0f / DM) + EPS);
    f32x4 gv[4], scv[4], shv[4];
    ld_row_f32(g, lane, gv); ld_row_f32(sc, lane, scv); ld_row_f32(sh, lane, shv);
#pragma unroll
    for (int j = 0; j < 4; ++j) h[j] = (x[j] * rstd) * gv[j] * (scv[j] + 1.0f) + shv[j];
}

__device__ __forceinline__ void filt_gemm_tile(Frame& F, int wt) {
    const int lane = F.lane, hi = lane >> 5, l31 = lane & 31;
    const int l = wt >> 11, r = wt & 2047, t0 = (r >> 3) * 32, col0 = (r & 7) * 128;
    const bf16_t* hidp = WSP(bf16_t, WS_HID) + ((size_t)l * SEQ + t0 + l31) * 64 + hi * 8;
    const bf16_t* w3p = WSP(bf16_t, WS_W3T) + ((size_t)l * 1024 + col0 + l31) * 64 + hi * 8;
    bf16x8 bfr[4], afr[4][4];
#pragma unroll
    for (int ks = 0; ks < 4; ++ks) { bfr[ks] = *(const GAS bf16x8*)(hidp + 16 * ks);
#pragma unroll
        for (int jb = 0; jb < 4; ++jb) afr[jb][ks] = *(const GAS bf16x8*)(w3p + (size_t)(32 * jb) * 64 + 16 * ks); }
    const float tt = (float)(t0 + l31) * (1.0f / SEQ);
    bf16_t* FTu = WSP(bf16_t, WS_FILT) + ((size_t)l * 1024 + col0) * SEQ + t0;
    const float* b3u = INF(25) + l * 1024 + col0; const float* ldu = INF(26) + l * 1024 + col0;
    const unsigned vo = (unsigned)(4 * hi * SEQ + l31), vc = (unsigned)(4 * hi);
#pragma unroll
    for (int jb = 0; jb < 4; ++jb) {
        f32x16 acc;
#pragma unroll
        for (int q = 0; q < 16; ++q) acc[q] = 0.f;
#pragma unroll
        for (int ks = 0; ks < 4; ++ks) acc = MFMA32(afr[jb][ks], bfr[ks], acc);
#pragma unroll
        for (int q = 0; q < 16; ++q) { const int cq = 32 * jb + (q & 3) + 8 * (q >> 2);
            const float v = (acc[q] + (b3u + cq)[vc]) * fexp(-tt * fexp((ldu + cq)[vc]));
            (FTu + (size_t)cq * SEQ)[vo] = (bf16_t)(pk2(v, 0.f) & 0xffffu); }
        asm volatile("" ::: "memory");
    }
}

__device__ __forceinline__ void p1_phase(Frame& F) {
    const int gw = F.vcu * NWAVES + F.wave, NGW = F.G * NWAVES;
    const float* mod = WSP(float, WS_MOD);
    for (int m = gw; m < MTOK; m += 2 * NGW) {
        const int m2 = (m + NGW < MTOK) ? m + NGW : m; f32x4 xa[4], xb[4], h[4];
        ld_row_f32(INF(0) + (size_t)m * DM, F.lane, xa); ld_row_f32(INF(0) + (size_t)m2 * DM, F.lane, xb);
        { const int b = m >> 13; modnorm(xa, INF(5), mod + (0 * 2 + b) * 6144 + 1024, mod + (0 * 2 + b) * 6144, F.lane, h); st_row_bf16(WSP(bf16_t, WS_XN) + (size_t)m * DM, F.lane, h); }
        { const int b = m2 >> 13; modnorm(xb, INF(5), mod + (0 * 2 + b) * 6144 + 1024, mod + (0 * 2 + b) * 6144, F.lane, h); st_row_bf16(WSP(bf16_t, WS_XN) + (size_t)m2 * DM, F.lane, h); }
    }
    for (int wt = gw; wt < 4096; wt += NGW) filt_gemm_tile(F, wt);
}

__device__ __forceinline__ float wave_scan_add(float v, int lane) {
#pragma unroll
    for (int o = 1; o < 64; o <<= 1) { const float n = __shfl_up(v, o); if (lane >= o) v += n; }
    return v;
}
__device__ __forceinline__ float wave_scan_max(float v, int lane) {
#pragma unroll
    for (int o = 1; o < 64; o <<= 1) { const float n = __shfl_up(v, o); if (lane >= o) v = fmaxf(v, n); }
    return v;
}
__device__ __forceinline__ float wave_max(float v) {
#pragma unroll
    for (int o = 1; o < 64; o <<= 1) v = fmaxf(v, __shfl_xor(v, o));
    return v;
}
__device__ __forceinline__ float logsigmoid(float x) { return fminf(x, 0.f) - flog(1.0f + fexp(-fabsf(x))); }
struct MlItem { int b, h, dir, n, t0; };
__device__ __forceinline__ MlItem ml_decode(int item) { MlItem I; I.b = item >> 9; I.h = (item >> 7) & 3; I.dir = (item >> 6) & 1; I.n = item & 63;
    I.t0 = I.b * SEQ + (I.dir ? SEQ - 128 * (I.n + 1) : 128 * I.n); return I; }

__device__ __forceinline__ void ml_scan(Frame& F) {
    float* MLC = WSP(float, WS_MLC); float* MLN = WSP(float, WS_MLN); float* MLS = WSP(float, WS_MLS);
    for (int blk = blockIdx.x; blk < 256; blk += F.G) { if (F.tid >= 260) continue; const int idx = blk * 260 + F.tid;
        const int seq = idx / 4160, el = idx % 4160;
        float* p0 = el < 4096 ? (MLC + (size_t)seq * 64 * 4096 + el) : (MLN + seq * 64 * 64 + (el - 4096));
        const int pstr = el < 4096 ? 4096 : 64;
        float mst = 0.f, st = 0.f;
#pragma unroll 1
        for (int n0 = 0; n0 < 64; n0 += 16) {
            float cl[16], mlv[16], aev[16];
#pragma unroll
            for (int i = 0; i < 16; ++i) { cl[i] = p0[(size_t)(n0 + i) * pstr]; mlv[i] = MLS[(seq * 64 + n0 + i) * 4]; aev[i] = MLS[(seq * 64 + n0 + i) * 4 + 1]; }
#pragma unroll
            for (int i = 0; i < 16; ++i) { const int item = seq * 64 + n0 + i;
                p0[(size_t)(n0 + i) * pstr] = st;
                if (el == 0) MLS[item * 4 + 2] = mst;
                const float mnew = fmaxf(aev[i] + mst, mlv[i]), sp = fexp(aev[i] + mst - mnew), sl = fexp(mlv[i] - mnew);
                st = sp * st + sl * cl[i]; mst = mnew; }
        }
    }
}

template <int NK>
__device__ __forceinline__ void qkt_tile(f32x16& p0, f32x16& p1, LAS const unsigned char* Kt, const bf16x8 (&qr)[NK], int r32, int hi) {
#pragma unroll
    for (int r = 0; r < 16; ++r) { p0[r] = 0.f; p1[r] = 0.f; }
#pragma unroll
    for (int d0 = 0; d0 < NK; ++d0) {
        const bf16x8 b0 = *(const LAS bf16x8*)(Kt + (2 * d0 + hi) * 1024 + r32 * 16);
        const bf16x8 b1 = *(const LAS bf16x8*)(Kt + (2 * d0 + hi) * 1024 + r32 * 16 + 512);
        p0 = MFMA32(b0, qr[d0], p0); p1 = MFMA32(b1, qr[d0], p1);
    }
}
typedef short v4i16_t __attribute__((ext_vector_type(4)));
__device__ __forceinline__ s16x4 vtr(LAS const unsigned char* p) { return __builtin_bit_cast(s16x4, __builtin_amdgcn_ds_read_tr16_b64_v4i16((LAS v4i16_t*)p)); }
__device__ __forceinline__ void pv_tile(f32x16 (&o)[2], LAS const unsigned char* Vt, const bf16x8 (&pa)[4], int lane) {
    const int hi = lane >> 5;
    LAS const unsigned char* vb = Vt + ((lane >> 4) & 1) * 32 + (lane & 3) * 8 + (4 * hi + ((lane & 15) >> 2)) * 64;
#pragma unroll
    for (int d0 = 0; d0 < 2; ++d0)
#pragma unroll
        for (int ks = 0; ks < 4; ++ks) {
            const s16x4 lo = vtr(vb + d0 * 4096 + ks * 1024), hh = vtr(vb + d0 * 4096 + ks * 1024 + 512);
            const bf16x8 vf = (bf16x8){lo[0], lo[1], lo[2], lo[3], hh[0], hh[1], hh[2], hh[3]};
            o[d0] = MFMA32(pa[ks], vf, o[d0]);
        }
}
__device__ __forceinline__ void pack_p(const f32x16& p0, const f32x16& p1, bf16x8 (&pa)[4]) {
    u32x4 w0, w1, w2, w3;
    w0 = (u32x4){pk2(p0[0], p0[1]), pk2(p0[2], p0[3]), pk2(p0[4], p0[5]), pk2(p0[6], p0[7])};
    w1 = (u32x4){pk2(p0[8], p0[9]), pk2(p0[10], p0[11]), pk2(p0[12], p0[13]), pk2(p0[14], p0[15])};
    w2 = (u32x4){pk2(p1[0], p1[1]), pk2(p1[2], p1[3]), pk2(p1[4], p1[5]), pk2(p1[6], p1[7])};
    w3 = (u32x4){pk2(p1[8], p1[9]), pk2(p1[10], p1[11]), pk2(p1[12], p1[13]), pk2(p1[14], p1[15])};
    pa[0] = __builtin_bit_cast(bf16x8, w0); pa[1] = __builtin_bit_cast(bf16x8, w1); pa[2] = __builtin_bit_cast(bf16x8, w2); pa[3] = __builtin_bit_cast(bf16x8, w3);
}

__device__ __forceinline__ void ml_local_pair(Frame& F, int pair, int l) {
    const int tid = F.tid, lane = F.lane, wid = F.wave, half = wid >> 2, wq = wid & 3, th = tid & 255, hi = lane >> 5;
    const int item = pair * 2 + half; const MlItem I = ml_decode(item);
    const bf16_t* U = WSP(bf16_t, WS_U);
    LAS unsigned char* base = F.lds + half * 49152;
    LAS unsigned char* EKI = base;
    LAS unsigned char* VI = base + 16384;
    LAS float* LF = (LAS float*)(base + 32768); LAS float* IG = LF + 128; LAS float* WW = LF + 256; LAS float* EST = LF + 384;
    const float* gb = INF(10) + l * 16;
    unsigned short graw_i = 0, graw_f = 0;
    if (th < 128) { const int r = I.dir ? 127 - th : th; const size_t t = (size_t)(I.t0 + r);
        graw_i = U[t * DINP + U_MLG + (I.dir ? 2 : 0) * 4 + I.h]; graw_f = U[t * DINP + U_MLG + (I.dir ? 3 : 1) * 4 + I.h]; }
    u32x4 kpc[4], vpc[4];
#pragma unroll
    for (int i = 0; i < 4; ++i) { const int p = th + 256 * i; const int tt = p >> 9, dh = (p >> 8) & 1, row = (p >> 2) & 63, c4 = p & 3, r = 64 * tt + row;
        const bf16_t* src = U + (size_t)(I.t0 + r) * DINP + I.h * 64 + dh * 32 + c4 * 8;
        kpc[i] = *(const GAS u32x4*)(src + U_MLK); vpc[i] = *(const GAS u32x4*)(src + U_MLV); }
    float a = 0.f, aend = 0.f, mloc = -3.0e38f;
    const float lfv = (th < 128) ? logsigmoid(bf2f(graw_f) + gb[(I.dir ? 3 : 1) * 4 + I.h]) : 0.f, igv = (th < 128) ? bf2f(graw_i) + gb[(I.dir ? 2 : 0) * 4 + I.h] : 0.f;
    if (th < 128) { a = wave_scan_add(lfv, lane); if (lane == 63) LF[wq] = a; }
    __syncthreads();
    float wv = 0.f;
    if (th < 128) { aend = LF[0] + LF[1]; if (wq == 1) a += LF[0]; wv = aend - a + igv; const float wm = wave_max(wv); if (lane == 0) IG[wq] = wm; }
    __syncthreads();
    if (th < 128) { mloc = fmaxf(IG[0], IG[1]); const int r = I.dir ? 127 - th : th; EST[r] = fexp(wv - mloc) * 0.125f; }
    __syncthreads();
#pragma unroll
    for (int i = 0; i < 4; ++i) { const int p = th + 256 * i; const int tt = p >> 9, dh = (p >> 8) & 1, row = (p >> 2) & 63, c4 = p & 3, r = 64 * tt + row;
        const u32x4 kq = kpc[i];
        const float es = EST[r];
        u32x4 ek; ek.x = pk2(bflo(kq.x) * es, bfhi(kq.x) * es); ek.y = pk2(bflo(kq.y) * es, bfhi(kq.y) * es); ek.z = pk2(bflo(kq.z) * es, bfhi(kq.z) * es); ek.w = pk2(bflo(kq.w) * es, bfhi(kq.w) * es);
        const int off = tt * 8192 + dh * 4096 + row * 64 + c4 * 16;
        *(LAS u32x4*)(EKI + off) = ek; *(LAS u32x4*)(VI + off) = vpc[i]; }
    __syncthreads();
    {
        const int da = wq >> 1, eb = wq & 1;
        f32x16 acc, nrm;
#pragma unroll
        for (int r = 0; r < 16; ++r) { acc[r] = 0.f; nrm[r] = 0.f; }
        const bf16x8 ones = (bf16x8){(short)0x3F80, (short)0x3F80, (short)0x3F80, (short)0x3F80, (short)0x3F80, (short)0x3F80, (short)0x3F80, (short)0x3F80};
        const int lo_off = ((lane >> 4) & 1) * 32 + (lane & 3) * 8 + (4 * hi + ((lane & 15) >> 2)) * 64;
#pragma unroll
        for (int tt = 0; tt < 2; ++tt)
#pragma unroll
            for (int ks = 0; ks < 4; ++ks) {
                LAS const unsigned char* ap = EKI + tt * 8192 + da * 4096 + lo_off + ks * 1024; LAS const unsigned char* bp = VI + tt * 8192 + eb * 4096 + lo_off + ks * 1024;
                const s16x4 a0 = vtr(ap), a1 = vtr(ap + 512), b0 = vtr(bp), b1 = vtr(bp + 512);
                const bf16x8 af = (bf16x8){a0[0], a0[1], a0[2], a0[3], a1[0], a1[1], a1[2], a1[3]}, bf = (bf16x8){b0[0], b0[1], b0[2], b0[3], b1[0], b1[1], b1[2], b1[3]};
                acc = MFMA32(af, bf, acc);
                if (eb == 0) nrm = MFMA32(af, ones, nrm); }
        float* dst = WSP(float, WS_MLC) + (size_t)item * 4096 + eb * 32 + (lane & 31);
#pragma unroll
        for (int r = 0; r < 16; ++r) dst[(da * 32 + crow(r, hi)) * 64] = acc[r];
        if (eb == 0 && (lane & 31) == 0) {
#pragma unroll
            for (int r = 0; r < 16; ++r) WSP(float, WS_MLN)[item * 64 + da * 32 + crow(r, hi)] = nrm[r]; }
        if (th == 0) { WSP(float, WS_MLS)[item * 4] = mloc; WSP(float, WS_MLS)[item * 4 + 1] = aend; }
    }
    __syncthreads();
}

__device__ __forceinline__ void ml_out_pair(Frame& F, int pair, int l) {
    const int tid = F.tid, lane = F.lane, wid = F.wave, half = wid >> 2, wq = wid & 3, th = tid & 255, r32 = lane & 31, hi = lane >> 5;
    const int item = pair * 2 + half; const MlItem I = ml_decode(item);
    const bf16_t* U = WSP(bf16_t, WS_U);
    LAS unsigned char* base = F.lds + half * 49152;
    LAS unsigned char* KI = base;
    LAS unsigned char* VI = base + 16384;
    LAS unsigned char* CT = base + 32768;
    LAS float* vec = (LAS float*)(base + 32768 + 9216);
    LAS float* LF = vec; LAS float* IG = vec + 128; LAS float* BL = vec + 256; LAS float* SA = vec + 384; LAS float* SCI = vec + 512; LAS float* EDEN = vec + 640;
    LAS float* NPV = vec + 768; LAS float* wsf = vec + 832 + wq * 64;
    const float* gb = INF(10) + l * 16;
    unsigned short graw_i = 0, graw_f = 0; float mprev = 0.f;
    if (th < 128) { const int r = I.dir ? 127 - th : th; const size_t t = (size_t)(I.t0 + r);
        graw_i = U[t * DINP + U_MLG + (I.dir ? 2 : 0) * 4 + I.h]; graw_f = U[t * DINP + U_MLG + (I.dir ? 3 : 1) * 4 + I.h];
        mprev = WSP(float, WS_MLS)[item * 4 + 2]; }
    u32x4 kpc[4], vpc[4];
#pragma unroll
    for (int i = 0; i < 4; ++i) { const int p = th + 256 * i;
        { const int tt = p >> 9, c = (p >> 6) & 7, kv = p & 63, j = 64 * tt + kv, r = I.dir ? 127 - j : j;
          kpc[i] = *(const GAS u32x4*)(U + (size_t)(I.t0 + r) * DINP + U_MLK + I.h * 64 + c * 8); }
        { const int tt = p >> 9, dh = (p >> 8) & 1, kv = (p >> 2) & 63, c4 = p & 3, j = 64 * tt + kv, r = I.dir ? 127 - j : j;
          vpc[i] = *(const GAS u32x4*)(U + (size_t)(I.t0 + r) * DINP + U_MLV + I.h * 64 + dh * 32 + c4 * 8); } }
    float cpv[16];
    { const float* cp = WSP(float, WS_MLC) + (size_t)item * 4096;
#pragma unroll
      for (int i = 0; i < 16; ++i) cpv[i] = cp[th + 256 * i]; }
    const float npv = (th < 64) ? WSP(float, WS_MLN)[item * 64 + th] : 0.f;
    const int q = 32 * wq + r32;
    const int rq = I.dir ? 127 - q : q;
    bf16x8 qr[4];
    { const bf16_t* qp = U + (size_t)(I.t0 + rq) * DINP + U_MLQ + I.h * 64 + hi * 8;
#pragma unroll
      for (int d0 = 0; d0 < 4; ++d0) qr[d0] = *(const GAS bf16x8*)(qp + d0 * 16); }
    const float lfv = (th < 128) ? logsigmoid(bf2f(graw_f) + gb[(I.dir ? 3 : 1) * 4 + I.h]) : 0.f, igv = (th < 128) ? bf2f(graw_i) + gb[(I.dir ? 2 : 0) * 4 + I.h] : 0.f;
    float a = 0.f;
    if (th < 128) { a = wave_scan_add(lfv, lane); if (lane == 63) LF[wq] = a; }
#pragma unroll
    for (int i = 0; i < 4; ++i) { const int p = th + 256 * i;
        { const int tt = p >> 9, c = (p >> 6) & 7, kv = p & 63; *(LAS u32x4*)(KI + tt * 8192 + c * 1024 + kv * 16) = kpc[i]; }
        { const int tt = p >> 9, dh = (p >> 8) & 1, kv = (p >> 2) & 63, c4 = p & 3; *(LAS u32x4*)(VI + tt * 8192 + dh * 4096 + kv * 64 + c4 * 16) = vpc[i]; } }
#pragma unroll
    for (int i = 0; i < 16; ++i) { const int idx = th + 256 * i, d = idx >> 6, e = idx & 63;
        *(LAS unsigned short*)(CT + e * 144 + d * 2) = (unsigned short)(pk2(cpv[i], 0.f) & 0xffffu); }
    if (th < 64) NPV[th] = npv;
    __syncthreads();
    float bv = 0.f, bm = -3.0e38f;
    if (th < 128) { if (wq == 1) a += LF[0]; bv = igv - a; bm = wave_scan_max(bv, lane); if (lane == 63) IG[wq] = bm; }
    __syncthreads();
    if (th < 128) { if (wq == 1) bm = fmaxf(bm, IG[0]);
        const float mt = a + fmaxf(mprev, bm);
        SA[th] = (a - mt) * LOG2E; SCI[th] = fexp(a + mprev - mt); EDEN[th] = fexp(-mt); BL[th] = bv * LOG2E; }
    __syncthreads();
    {
        f32x16 o[2];
#pragma unroll
        for (int r = 0; r < 16; ++r) { o[0][r] = 0.f; o[1][r] = 0.f; }
        const float saq = SA[q], scq = SCI[q];
        float den = 0.f;
        for (int tt = 0; tt < 2; ++tt) {
            if (64 * tt > 32 * wq + 31) break;
            f32x16 p0, p1;
            qkt_tile<4>(p0, p1, KI + tt * 8192, qr, r32, hi);
#pragma unroll
            for (int g = 0; g < 4; ++g) {
                const f32x4 b0 = *(const LAS f32x4*)(BL + 64 * tt + 8 * g + 4 * hi), b1 = *(const LAS f32x4*)(BL + 64 * tt + 32 + 8 * g + 4 * hi);
#pragma unroll
                for (int i = 0; i < 4; ++i) { const int r = 4 * g + i; const int kv0 = 64 * tt + 8 * g + 4 * hi + i, kv1 = kv0 + 32;
                    const float e0 = (kv0 <= q) ? __builtin_amdgcn_exp2f(saq + b0[i]) * 0.125f : 0.f, e1 = (kv1 <= q) ? __builtin_amdgcn_exp2f(saq + b1[i]) * 0.125f : 0.f;
                    p0[r] *= e0; p1[r] *= e1; den += p0[r] + p1[r]; }
            }
            bf16x8 pa[4]; pack_p(p0, p1, pa);
            pv_tile(o, VI + tt * 8192, pa, lane);
        }
        float dot = 0.f;
#pragma unroll
        for (int ks = 0; ks < 4; ++ks) {
            const u32x4 qw = __builtin_bit_cast(u32x4, qr[ks]);
            const f32x4 n0 = *(const LAS f32x4*)(NPV + 16 * ks + 8 * hi), n1 = *(const LAS f32x4*)(NPV + 16 * ks + 8 * hi + 4);
            const float q0 = bflo(qw.x), q1 = bfhi(qw.x), q2 = bflo(qw.y), q3 = bfhi(qw.y), q4 = bflo(qw.z), q5 = bfhi(qw.z), q6 = bflo(qw.w), q7 = bfhi(qw.w);
            dot += q0 * n0[0] + q1 * n0[1] + q2 * n0[2] + q3 * n0[3] + q4 * n1[0] + q5 * n1[1] + q6 * n1[2] + q7 * n1[3];
            const u32x4 sw = (u32x4){pk2(q0 * scq, q1 * scq), pk2(q2 * scq, q3 * scq), pk2(q4 * scq, q5 * scq), pk2(q6 * scq, q7 * scq)};
            const bf16x8 qs = __builtin_bit_cast(bf16x8, sw);
#pragma unroll
            for (int de = 0; de < 2; ++de) {
                const bf16x8 cf = *(const LAS bf16x8*)(CT + (de * 32 + r32) * 144 + (16 * ks + 8 * hi) * 2);
                o[de] = MFMA32(qs, cf, o[de]);
            }
        }
        den += scq * dot;
        den += __shfl_xor(den, 32);
        const float rinv = 1.0f / fmaxf(fabsf(den), EDEN[q]);
        if (hi == 0) wsf[r32] = rinv;
        LDS_WAIT();
        bf16_t* dst = WSP(bf16_t, I.dir ? WS_HB : WS_HF);
#pragma unroll
        for (int r = 0; r < 16; ++r) { const int jq = 32 * wq + crow(r, hi), row = I.dir ? 127 - jq : jq; const float rr = wsf[crow(r, hi)];
            bf16_t* dp = dst + (size_t)(I.t0 + row) * 256 + I.h * 64 + r32;
            dp[0] = (bf16_t)(pk2(o[0][r] * rr, 0.f) & 0xffffu); dp[32] = (bf16_t)(pk2(o[1][r] * rr, 0.f) & 0xffffu); }
    }
    __syncthreads();
}

__device__ __forceinline__ double rope_kd_dyn(int i) {
    double r = 0.15915494309189535;
    r = (i == 1) ? 0.08949940160889101 : r; r = (i == 2) ? 0.050329212104487035 : r; r = (i == 3) ? 0.0283021958306234 : r; r = (i == 4) ? 0.015915494309189534 : r;
    r = (i == 5) ? 0.008949940160889102 : r; r = (i == 6) ? 0.005032921210448704 : r; r = (i == 7) ? 0.00283021958306234 : r; r = (i == 8) ? 0.0015915494309189536 : r;
    r = (i == 9) ? 0.0008949940160889102 : r; r = (i == 10) ? 0.0005032921210448703 : r; r = (i == 11) ? 0.00028302195830623395 : r; r = (i == 12) ? 0.00015915494309189535 : r;
    r = (i == 13) ? 8.949940160889102e-05 : r; r = (i == 14) ? 5.0329212104487035e-05 : r; r = (i == 15) ? 2.8302195830623396e-05 : r;
    return r;
}
__device__ __forceinline__ void mla_prep_rows(Frame& F, int l) {
    const int gw = F.vcu * NWAVES + F.wave, NGW = F.G * NWAVES, lane = F.lane;
    const bf16_t* U = WSP(bf16_t, WS_U); bf16_t* A = WSP(bf16_t, WS_AMLA);
    f32x4 gq = {0.f, 0.f, 0.f, 0.f}; if (lane < 56) gq = *(const GAS f32x4*)(INF(11) + l * 224 + 4 * lane);
    const f32x2 gk = *(const GAS f32x2*)(INF(12) + l * 128 + 2 * lane);
    for (int m0 = gw; m0 < MTOK; m0 += 4 * NGW) {
        u32x2 qw[4]; unsigned kw[4];
#pragma unroll
        for (int r = 0; r < 4; ++r) { const int m = m0 + r * NGW; const bf16_t* ur = U + (size_t)(m < MTOK ? m : 0) * DINP;
            qw[r] = (u32x2){0u, 0u}; if (lane < 56) qw[r] = *(const GAS u32x2*)(ur + U_CQ + 4 * lane);
            kw[r] = *(const GAS unsigned*)(ur + U_CKV + 2 * lane); }
#pragma unroll
        for (int r = 0; r < 4; ++r) { const int m = m0 + r * NGW; if (m >= MTOK) break;
            const float q0 = bflo(qw[r].x), q1 = bfhi(qw[r].x), q2 = bflo(qw[r].y), q3 = bfhi(qw[r].y), k0 = bflo(kw[r]), k1 = bfhi(kw[r]);
            const float rq = __builtin_amdgcn_rsqf(wave_sum(q0 * q0 + q1 * q1 + q2 * q2 + q3 * q3) * (1.0f / 224.0f) + EPS);
            const float rk = __builtin_amdgcn_rsqf(wave_sum(k0 * k0 + k1 * k1) * (1.0f / 128.0f) + EPS);
            bf16_t* ar = A + (size_t)m * 384;
            u32x2 qo; qo.x = pk2(q0 * rq * gq.x, q1 * rq * gq.y); qo.y = pk2(q2 * rq * gq.z, q3 * rq * gq.w);
            *(GAS u32x2*)(ar + 4 * lane) = qo;
            *(GAS unsigned*)(ar + 256 + 2 * lane) = pk2(k0 * rk * gk.x, k1 * rk * gk.y); }
    }
    const int* pos = (const int*)F.a->in[2];
    for (int m0 = gw; m0 < MTOK; m0 += 4 * NGW) {
        unsigned short x1r[4], x2r[4]; int pv[4];
#pragma unroll
        for (int r = 0; r < 4; ++r) { const int m = (m0 + r * NGW < MTOK) ? m0 + r * NGW : m0; x1r[r] = 0; x2r[r] = 0; pv[r] = 0;
            if (lane < 16) { x1r[r] = U[(size_t)m * DINP + U_KR + lane]; x2r[r] = U[(size_t)m * DINP + U_KR + 16 + lane]; pv[r] = pos[m]; } }
#pragma unroll
        for (int r = 0; r < 4; ++r) { const int m = m0 + r * NGW; if (m >= MTOK) break;
            if (lane < 16) { const int b = m >> 13, sq = m & 8191;
                double rev = (double)pv[r] * rope_kd_dyn(lane); rev -= __builtin_floor(rev);
                const float rr = (float)rev, c = cos_rev(rr), sn = sin_rev(rr), x1 = bf2f(x1r[r]), x2 = bf2f(x2r[r]);
                const unsigned short o1 = (unsigned short)(pk2(x1 * c - x2 * sn, 0.f) & 0xffffu), o2 = (unsigned short)(pk2(x2 * c + x1 * sn, 0.f) & 0xffffu);
#pragma unroll
                for (int h = 0; h < 4; ++h) { bf16_t* kd = WSP(bf16_t, WS_KIMG) + ((size_t)(b * 4 + h) * 128 + (sq >> 6)) * 6144 + (sq & 63) * 8;
                    kd[(8 + (lane >> 3)) * 512 + (lane & 7)] = o1; kd[(10 + (lane >> 3)) * 512 + (lane & 7)] = o2; } } }
    }
}

__device__ __forceinline__ void att_iter(int tk, int tv, const LAS unsigned char* __restrict__ kread, LAS unsigned char* __restrict__ kdma,
                                         const LAS unsigned char* __restrict__ vread, LAS unsigned char* __restrict__ vdma, LAS float* __restrict__ wsf,
                                         const GAS u32x4* Kg, const GAS u32x4* Vg, int tid, int wid, bool kx, int hi, int r32, int vboff,
                                         const bf16x8 (&qr)[6], f32x16& s0, f32x16& s1, f32x16 (&o)[2], f32x16& nm, float& m, float& lsum) {
    __builtin_amdgcn_global_load_lds((const unsigned*)(Kg + tk * 768 + tid), (LAS unsigned*)(kdma + wid * 1024), 16, 0, 0);
    if (kx) __builtin_amdgcn_global_load_lds((const unsigned*)(Kg + tk * 768 + 512 + tid), (LAS unsigned*)(kdma + 8192 + wid * 1024), 16, 0, 0);
    __builtin_amdgcn_global_load_lds((const unsigned*)(Vg + tv * 512 + tid), (LAS unsigned*)(vdma + wid * 1024), 16, 0, 0);
    const LAS unsigned char* Kt = kread + hi * 1024 + r32 * 16;
    bf16x8 kf[12];
#pragma unroll
    for (int d0 = 0; d0 < 6; ++d0) { kf[2 * d0] = *(const LAS bf16x8*)(Kt + d0 * 2048); kf[2 * d0 + 1] = *(const LAS bf16x8*)(Kt + d0 * 2048 + 512); }
#pragma unroll
    for (int r = 0; r < 16; ++r) { s0[r] = __builtin_amdgcn_exp2f(s0[r]); s1[r] = __builtin_amdgcn_exp2f(s1[r]); }
    { float ls_ = 0.f;
#pragma unroll
      for (int r = 0; r < 16; ++r) ls_ += s0[r] + s1[r];
      lsum += ls_; }
    bf16x8 pa[4]; pack_p(s0, s1, pa);
    f32x16 n0, n1;
    n0 = MFMA32(kf[0], qr[0], nm); n1 = MFMA32(kf[1], qr[0], nm);
#pragma unroll
    for (int d0 = 1; d0 < 6; ++d0) { n0 = MFMA32(kf[2 * d0], qr[d0], n0); n1 = MFMA32(kf[2 * d0 + 1], qr[d0], n1); }
    const LAS unsigned char* vb = vread + vboff;
#pragma unroll
    for (int ks = 0; ks < 4; ++ks) {
#pragma unroll
        for (int d0 = 0; d0 < 2; ++d0) {
            const s16x4 lo = vtr((LAS const unsigned char*)(vb + d0 * 4096 + ks * 1024)), hh = vtr((LAS const unsigned char*)(vb + d0 * 4096 + ks * 1024 + 512));
            const bf16x8 vf = (bf16x8){lo[0], lo[1], lo[2], lo[3], hh[0], hh[1], hh[2], hh[3]};
            o[d0] = MFMA32(pa[ks], vf, o[d0]); } }
    float rm = fmaxf(fmaxf(n0[0], n1[0]), fmaxf(n0[1], n1[1]));
#pragma unroll
    for (int r = 2; r < 16; r += 2) rm = fmaxf(fmaxf(rm, n0[r]), fmaxf(n1[r], fmaxf(n0[r + 1], n1[r + 1])));
    rm = fmaxf(rm, __shfl_xor(rm, 32));
#pragma unroll
    for (int i = 0; i < 12; ++i) { __builtin_amdgcn_sched_group_barrier(0x008, 1, 0); __builtin_amdgcn_sched_group_barrier(0x002, 7, 0); }
    if (__any(rm > 8.0f)) {
        const float dl = fmaxf(rm, 0.f), f = __builtin_amdgcn_exp2f(-dl);
        m += dl; lsum *= f;
#pragma unroll
        for (int r = 0; r < 16; ++r) { n0[r] -= dl; n1[r] -= dl; nm[r] = -m; }
        if (hi == 0) wsf[r32] = f;
        LDS_WAIT();
#pragma unroll
        for (int r = 0; r < 16; ++r) { const float fr = wsf[crow(r, hi)]; o[0][r] *= fr; o[1][r] *= fr; }
    }
    if (kx) asm volatile("s_waitcnt vmcnt(3)" ::: "memory"); else asm volatile("s_waitcnt vmcnt(2)" ::: "memory");
    __syncthreads();
    s0 = n0; s1 = n1;
}
__device__ __forceinline__ void attn_unit(Frame& F, int bh, int qb) {
    const int tid = F.tid, lane = F.lane, wid = F.wave, r32 = lane & 31, hi = lane >> 5;
    LAS unsigned char* KB = F.lds;
    LAS unsigned char* VB = F.lds + 36864;
    LAS float* wsf = (LAS float*)(F.lds + 61440) + wid * 64;
    const int b = bh >> 2, h = bh & 3;
    const bf16_t* Qp = WSP(bf16_t, WS_Q) + ((size_t)bh * SEQ + qb * 256 + wid * 32 + r32) * 96 + hi * 8;
    bf16x8 qr[6];
#pragma unroll
    for (int d0 = 0; d0 < 6; ++d0) qr[d0] = *(const GAS bf16x8*)(Qp + d0 * 16);
    {
        const int p = ((const int*)F.a->in[2])[(size_t)(bh >> 2) * SEQ + qb * 256 + wid * 32 + r32];
        const u32x4 a = __builtin_bit_cast(u32x4, qr[4]), c = __builtin_bit_cast(u32x4, qr[5]);
        const unsigned aw[4] = {a.x, a.y, a.z, a.w}, cw[4] = {c.x, c.y, c.z, c.w}; unsigned ao[4], co[4];
#pragma unroll
        for (int j2 = 0; j2 < 4; ++j2) { float x1a = bflo(aw[j2]), x1b = bfhi(aw[j2]), x2a = bflo(cw[j2]), x2b = bfhi(cw[j2]);
            const float ra = hi ? rope_frac(p, 8 + 2 * j2) : rope_frac(p, 2 * j2), rb = hi ? rope_frac(p, 9 + 2 * j2) : rope_frac(p, 1 + 2 * j2);
            const float ca = cos_rev(ra), sa = sin_rev(ra), cb = cos_rev(rb), sb = sin_rev(rb);
            ao[j2] = pk2(x1a * ca - x2a * sa, x1b * cb - x2b * sb); co[j2] = pk2(x2a * ca + x1a * sa, x2b * cb + x1b * sb); }
        qr[4] = __builtin_bit_cast(bf16x8, (u32x4){ao[0], ao[1], ao[2], ao[3]}); qr[5] = __builtin_bit_cast(bf16x8, (u32x4){co[0], co[1], co[2], co[3]});
    }
    const GAS u32x4* Kg = (const GAS u32x4*)(WSP(bf16_t, WS_KIMG) + (size_t)bh * 128 * 6144);
    const GAS u32x4* Vg = (const GAS u32x4*)(WSP(bf16_t, WS_VIMG) + (size_t)bh * 128 * 4096);
    const bool kx = wid < 4;
#define ATT_DMA_K(TILE, BUF) do { __builtin_amdgcn_global_load_lds((const unsigned*)(Kg + (TILE) * 768 + tid), (LAS unsigned*)(KB + (BUF) * 12288 + wid * 1024), 16, 0, 0); \
        if (kx) __builtin_amdgcn_global_load_lds((const unsigned*)(Kg + (TILE) * 768 + 512 + tid), (LAS unsigned*)(KB + (BUF) * 12288 + 8192 + wid * 1024), 16, 0, 0); } while (0)
#define ATT_DMA_V(TILE, BUF) __builtin_amdgcn_global_load_lds((const unsigned*)(Vg + (TILE) * 512 + tid), (LAS unsigned*)(VB + (BUF) * 8192 + wid * 1024), 16, 0, 0)
    ATT_DMA_K(0, 0); ATT_DMA_K(1, 1); ATT_DMA_K(2, 2); ATT_DMA_V(0, 0); ATT_DMA_V(1, 1);
    asm volatile("s_waitcnt vmcnt(0)" ::: "memory");
    __syncthreads();
    f32x16 s0, s1;
    qkt_tile<6>(s0, s1, KB, qr, r32, hi);
    __syncthreads();
    f32x16 o[2]; float lsum = 0.f;
#pragma unroll
    for (int r = 0; r < 16; ++r) { o[0][r] = 0.f; o[1][r] = 0.f; }
    float m;
    { float rm = fmaxf(fmaxf(s0[0], s1[0]), fmaxf(s0[1], s1[1]));
#pragma unroll
      for (int r = 2; r < 16; r += 2) rm = fmaxf(fmaxf(rm, s0[r]), fmaxf(s1[r], fmaxf(s0[r + 1], s1[r + 1])));
      m = fmaxf(rm, __shfl_xor(rm, 32));
#pragma unroll
      for (int r = 0; r < 16; ++r) { s0[r] -= m; s1[r] -= m; } }
    f32x16 nm;
#pragma unroll
    for (int r = 0; r < 16; ++r) nm[r] = -m;
    LAS const unsigned char* vbl = VB + ((lane >> 4) & 1) * 32 + (lane & 3) * 8 + (4 * hi + ((lane & 15) >> 2)) * 64;
    const int vboff = ((lane >> 4) & 1) * 32 + (lane & 3) * 8 + (4 * hi + ((lane & 15) >> 2)) * 64;
#define ATT_ITER(T, KR, KD, VR, VD) do { const int t_ = (T); \
        att_iter((t_ + 3 < 128) ? t_ + 3 : 127, (t_ + 2 < 128) ? t_ + 2 : 127, KB + (KR) * 12288, KB + (KD) * 12288, VB + (VR) * 8192, VB + (VD) * 8192, wsf, \
                 Kg, Vg, tid, wid, kx, hi, r32, vboff, qr, s0, s1, o, nm, m, lsum); } while (0)
#pragma unroll 1
    for (int t3 = 0; t3 < 126; t3 += 3) {
        ATT_ITER(t3, 1, 0, 0, 2);
        ATT_ITER(t3 + 1, 2, 1, 1, 0);
        ATT_ITER(t3 + 2, 0, 2, 2, 1);
    }
    ATT_ITER(126, 1, 0, 0, 2);
    ATT_ITER(127, 2, 1, 1, 0);
    asm volatile("s_waitcnt vmcnt(0)" ::: "memory");
#undef ATT_ITER
#undef ATT_DMA_K
#undef ATT_DMA_V
    lsum += __shfl_xor(lsum, 32);
    if (hi == 0) wsf[r32] = 1.0f / lsum;
    LDS_WAIT();
    bf16_t* Y = WSP(bf16_t, WS_YATT);
#pragma unroll
    for (int r = 0; r < 16; ++r) { const float rl = wsf[crow(r, hi)]; const int q = qb * 256 + wid * 32 + crow(r, hi);
        bf16_t* yp = Y + ((size_t)b * SEQ + q) * 256 + h * 64 + r32;
        yp[0] = (bf16_t)(pk2(o[0][r] * rl, 0.f) & 0xffffu); yp[32] = (bf16_t)(pk2(o[1][r] * rl, 0.f) & 0xffffu); }
    __syncthreads();
}

#define PX(e) ((e) + ((e) >> 5))
__device__ __forceinline__ f32x2 pk_cmul(f32x2 a, f32x2 w) {
    f32x2 t, r;
    asm("v_pk_mul_f32 %0, %1, %2 op_sel_hi:[1,0]" : "=v"(t) : "v"(a), "v"(w));
    asm("v_pk_fma_f32 %0, %1, %2, %3 op_sel:[1,1,0] op_sel_hi:[0,1,1] neg_lo:[1,0,0]" : "=v"(r) : "v"(a), "v"(w), "v"(t));
    return r;
}
__device__ __forceinline__ f32x2 pk_cmulc(f32x2 a, f32x2 w) {
    f32x2 t, r;
    asm("v_pk_mul_f32 %0, %1, %2 op_sel_hi:[1,0]" : "=v"(t) : "v"(a), "v"(w));
    asm("v_pk_fma_f32 %0, %1, %2, %3 op_sel:[1,1,0] op_sel_hi:[0,1,1] neg_hi:[1,0,0]" : "=v"(r) : "v"(a), "v"(w), "v"(t));
    return r;
}
__device__ __forceinline__ f32x2 pk_sub_i(f32x2 b, f32x2 d) {
    f32x2 r; asm("v_pk_add_f32 %0, %1, %2 op_sel:[0,1] op_sel_hi:[1,0] neg_hi:[0,1]" : "=v"(r) : "v"(b), "v"(d)); return r;
}
__device__ __forceinline__ f32x2 pk_add_i(f32x2 b, f32x2 d) {
    f32x2 r; asm("v_pk_add_f32 %0, %1, %2 op_sel:[0,1] op_sel_hi:[1,0] neg_lo:[0,1]" : "=v"(r) : "v"(b), "v"(d)); return r;
}
__device__ __forceinline__ void bf4_fwd(f32x2& x0, f32x2& x1, f32x2& x2, f32x2& x3, f32x2 w1, f32x2 w2, f32x2 w3) {
    const f32x2 a = x0 + x2, b = x0 - x2, c = x1 + x3, d = x1 - x3;
    x0 = a + c;
    x1 = pk_cmul(pk_sub_i(b, d), w1);
    x2 = pk_cmul(a - c, w2);
    x3 = pk_cmul(pk_add_i(b, d), w3);
}
__device__ __forceinline__ void bf4_inv(f32x2& x0, f32x2& x1, f32x2& x2, f32x2& x3, f32x2 w1, f32x2 w2, f32x2 w3) {
    const f32x2 t1 = pk_cmul(x1, w1), t2 = pk_cmul(x2, w2), t3 = pk_cmul(x3, w3);
    const f32x2 a = x0 + t2, b = x0 - t2, c = t1 + t3, d = t1 - t3;
    x0 = a + c; x2 = a - c;
    x1 = pk_add_i(b, d);
    x3 = pk_sub_i(b, d);
}
template <bool INV>
__device__ __forceinline__ void fft_r4_last(LAS f32x2* X, int tid) {
#pragma unroll 2
    for (int i = 0; i < 8; ++i) { int base = 4 * (tid + 512 * i); asm volatile("" : "+v"(base));
        LAS f32x2* xp = X + PX(base);
        const f32x2 x0 = xp[0], x1 = xp[1], x2 = xp[2], x3 = xp[3];
        const f32x2 a = x0 + x2, b = x0 - x2, c = x1 + x3, d = x1 - x3;
        xp[0] = a + c; xp[2] = a - c;
        if (!INV) { xp[1] = pk_sub_i(b, d); xp[3] = pk_add_i(b, d); } else { xp[1] = pk_add_i(b, d); xp[3] = pk_sub_i(b, d); } }
    __syncthreads();
}
template <bool INV>
__device__ __forceinline__ void r16_core(f32x2 (&x)[16], int j, float r16) {
    const float ang = (float)j * r16, sg = INV ? 1.0f : -1.0f;
    f32x2 w0; w0.x = cos_rev(ang); w0.y = INV ? sin_rev(ang) : -sin_rev(ang);
    asm("s_nop 0" : "+v"(w0));
    const f32x2 w0_2 = pk_cmul(w0, w0), wb = pk_cmul(w0_2, w0_2), wb2 = pk_cmul(wb, wb), wb3 = pk_cmul(wb2, wb);
    if (INV) {
#pragma unroll
        for (int k = 0; k < 4; ++k) bf4_inv(x[4 * k], x[4 * k + 1], x[4 * k + 2], x[4 * k + 3], wb, wb2, wb3);
    }
#pragma unroll
    for (int r = 0; r < 4; ++r) {
        f32x2 w1, w2;
        if (r == 0) { w1 = w0; w2 = w0_2; }
        else { const f32x2 cr = r == 1 ? (f32x2){0.92387953251f, sg * 0.38268343237f} : r == 2 ? (f32x2){0.70710678119f, sg * 0.70710678119f} : (f32x2){0.38268343237f, sg * 0.92387953251f};
            w1 = pk_cmul(w0, cr); w2 = pk_cmul(w1, w1); }
        const f32x2 w3 = pk_cmul(w2, w1);
        if (!INV) bf4_fwd(x[r], x[r + 4], x[r + 8], x[r + 12], w1, w2, w3); else bf4_inv(x[r], x[r + 4], x[r + 8], x[r + 12], w1, w2, w3);
    }
    if (!INV) {
#pragma unroll
        for (int k = 0; k < 4; ++k) bf4_fwd(x[4 * k], x[4 * k + 1], x[4 * k + 2], x[4 * k + 3], wb, wb2, wb3);
    }
}
template <bool INV, int LQ>
__device__ __forceinline__ void fft_r16_pass(LAS f32x2* X, int tid) {
    constexpr int qp = 1 << LQ;
    const float r16 = 1.0f / (float)(16 * qp);
    int nrep = 2; asm volatile("" : "+s"(nrep));
#pragma unroll 1
    for (int i = 0; i < nrep; ++i) {
        int u = tid + 512 * i; asm volatile("" : "+v"(u)); const int j = u & (qp - 1), base = ((u >> LQ) << (LQ + 4)) + j;
        LAS f32x2* xp = X + PX(base);
        constexpr int ST = LQ >= 5 ? qp + (qp >> 5) : 4;
        LAS f32x2* xh = xp + 8 * ST + (LQ >= 5 ? 0 : 1); asm volatile("" : "+v"(xh));
        f32x2 x[16];
#pragma unroll
        for (int r = 0; r < 16; ++r) x[r] = (r < 8 ? xp : xh)[(r & 7) * ST];
        r16_core<INV>(x, j, r16);
#pragma unroll
        for (int r = 0; r < 16; ++r) (r < 8 ? xp : xh)[(r & 7) * ST] = x[r];
    }
    __syncthreads();
}
__device__ __forceinline__ int drev4(int x) { unsigned y = __builtin_bitreverse32((unsigned)x) >> 18; return (int)(((y & 0x2AAAu) >> 1) | ((y & 0x1555u) << 1)); }
__device__ __forceinline__ float block_sum(Frame& F, float v, LAS float* red) {
    v = wave_sum(v);
    if (F.lane == 0) red[F.wave] = v;
    __syncthreads();
    float s = 0.f;
#pragma unroll
    for (int w = 0; w < NWAVES; ++w) s += red[w];
    __syncthreads();
    return s;
}
__device__ __forceinline__ void conv_mi_addr(Frame& F, int l, int mi, int lane, const float*& src, int& ldw, bf16_t*& dst, int& dp) {
    const int kg = lane >> 3, jn = lane & 7;
    if (mi < 32768) { const int which = mi >> 14, i = mi & 16383, e = i >> 10, r = i & 1023, kb = r >> 6, nb = r & 63, n0 = nb * 32;
        ldw = 2048; dp = 1024;
        src = INF(which ? 33 : 32) + ((size_t)l * NEXP + e) * 1024 * 2048 + (size_t)(kb * 64 + 8 * kg) * 2048 + n0 + 4 * jn;
        const int drow = (n0 >> 7) * 256 + (n0 & 127) + (which ? 128 : 0) + 4 * jn;
        dst = WSP(bf16_t, WS_WGU) + ((size_t)l * NEXP + e) * 4096 * 1024 + (size_t)drow * 1024 + kb * 64 + 8 * kg;
    } else { const int i = mi - 32768, e = i >> 10, r = i & 1023, kb = r >> 5, nb = r & 31, n0 = nb * 32;
        ldw = 1024; dp = LDFF;
        src = INF(34) + ((size_t)l * NEXP + e) * 2048 * 1024 + (size_t)(kb * 64 + 8 * kg) * 1024 + n0 + 4 * jn;
        dst = WSP(bf16_t, WS_WDN) + ((size_t)l * NEXP + e) * 1024 * LDFF + (size_t)(n0 + 4 * jn) * LDFF + kb * 64 + 8 * kg;
    }
}
__device__ __forceinline__ void conv_mi_issue(f32x4 (&v)[8], const float* src, int ldw) {
#pragma unroll
    for (int r = 0; r < 8; ++r) v[r] = *(const GAS f32x4*)(src + (size_t)r * ldw);
}
__device__ __forceinline__ void conv_mi_finish(const f32x4 (&v)[8], bf16_t* dst, int dp) {
#pragma unroll
    for (int c = 0; c < 4; ++c) { u32x4 o; o.x = pk2(v[0][c], v[1][c]); o.y = pk2(v[2][c], v[3][c]); o.z = pk2(v[4][c], v[5][c]); o.w = pk2(v[6][c], v[7][c]);
        *(GAS u32x4*)(dst + (size_t)c * dp) = o; }
}
constexpr int CONV_PER_BAR = 1792, CONV_NB0 = 9, CONV_NB1 = 10;
__device__ __forceinline__ int conv_r0(int l) { return 40960 - (l == 0 ? CONV_NB0 : CONV_NB1) * CONV_PER_BAR; }
__device__ __forceinline__ void xcd_barrier_conv(const XcdBarrier& b, Frame& F, int l, int mi_base) {
    asm volatile("s_waitcnt vmcnt(0)" ::: "memory");
    __syncthreads();
    const int wv = __builtin_amdgcn_readfirstlane(threadIdx.x >> 6);
    if (wv != 0) {
        int t_ = threadIdx.x; asm volatile("" : "+v"(t_)); const int lane = t_ & 63;
        f32x4 cv[8]; const float* cs; bf16_t* cd; int cl, cp;
        conv_mi_addr(F, l, mi_base + F.vcu * 7 + (wv - 1), lane, cs, cl, cd, cp); conv_mi_issue(cv, cs, cl); conv_mi_finish(cv, cd, cp);
    } else if (threadIdx.x == 0) {
        unsigned* bar = b.bar;
        __builtin_amdgcn_s_waitcnt(0);
        unsigned nloc = b.st[0], nx = b.st[1];
        if (nloc == 0u) { xcd_barrier_complete(bar, b.x, nloc, nx); b.st[0] = nloc; b.st[1] = nx; }
        const unsigned old = xb_add(&bar[XB_XSUB(b.x)], 1u);
        const unsigned gen = old / nloc;
        if (old + 1u == (gen + 1u) * nloc) {
            __builtin_amdgcn_fence(__ATOMIC_RELEASE, "agent");
            asm volatile("s_waitcnt vmcnt(0)" ::: "memory");
            const unsigned og = xb_add(&bar[XB_TOP], 1u);
            const unsigned tg = og / nx;
            if (og + 1u == (tg + 1u) * nx) xb_add(&bar[XB_TOPGEN], 1u);
            else XB_SPIN(xb_ld(&bar[XB_TOPGEN]) == tg, bar);
            __builtin_amdgcn_fence(__ATOMIC_ACQUIRE, "agent");
            xb_add(&bar[XB_XGEN(b.x)], 1u);
            asm volatile("s_waitcnt vmcnt(0)" ::: "memory");
        } else {
            XB_SPIN(xb_ld(&bar[XB_XGEN(b.x)]) == gen, bar);
            __builtin_amdgcn_fence(__ATOMIC_ACQUIRE, "agent");
            asm volatile("s_waitcnt vmcnt(0)" ::: "memory");
        }
    }
    __syncthreads();
}
__device__ __forceinline__ void hyena_item(Frame& F, int c_in, int l) {
    int c = c_in; asm volatile("" : "+s"(c));
    const int tid = F.tid;
    LAS f32x2* X = (LAS f32x2*)F.lds;
    LAS float* red = (LAS float*)(F.lds + XTRA_OFF);
    const bool hosted = (F.G == 256) && !MK_SPLIT;
    constexpr int HY_ACT = 5;
    const int mi0 = F.vcu * HY_ACT; int cm = 0;
#define HY_PASS(CALL) do { f32x4 cv_[8]; const float* cs_ = nullptr; bf16_t* cd_ = nullptr; int cl_ = 0, cp_ = 0; \
        _Pragma("unroll") for (int r_ = 0; r_ < 8; ++r_) cv_[r_] = (f32x4){0.f, 0.f, 0.f, 0.f}; \
        const int k_ = (F.wave - cm) & 7; int mi_ = cm * (HY_ACT * 256) + mi0 + k_; asm volatile("" : "+s"(mi_));     \
        const bool act_ = hosted && k_ < HY_ACT && mi_ < conv_r0(l); \
        if (act_) { conv_mi_addr(F, l, mi_, F.lane, cs_, cl_, cd_, cp_); conv_mi_issue(cv_, cs_, cl_); } \
        CALL; \
        if (act_) { conv_mi_addr(F, l, mi_, F.lane, cs_, cl_, cd_, cp_); conv_mi_finish(cv_, cd_, cp_); } \
        ++cm; } while (0)
#define HY_FFT_FWD() do { HY_PASS((fft_r16_pass<false, 10>(X, tid))); HY_PASS((fft_r16_pass<false, 6>(X, tid))); HY_PASS((fft_r16_pass<false, 2>(X, tid))); HY_PASS(fft_r4_last<false>(X, tid)); } while (0)
#define HY_FFT_INV() do { HY_PASS(fft_r4_last<true>(X, tid)); HY_PASS((fft_r16_pass<true, 2>(X, tid))); HY_PASS((fft_r16_pass<true, 6>(X, tid))); HY_PASS((fft_r16_pass<true, 10>(X, tid))); } while (0)
    f32x2 kq0[16], kq1[16], kx0, kx1;
    const bf16_t* HT0 = WSP(bf16_t, WS_HYT);
    const float hb0 = INF(27)[l * 512 + c], hb1 = INF(27)[l * 512 + 256 + c];
    const unsigned* z0p = (const unsigned*)(HT0 + (size_t)(0 * 768 + 512 + c) * SEQ); const unsigned* z1p = (const unsigned*)(HT0 + (size_t)(1 * 768 + 512 + c) * SEQ);
    unsigned zq0[8], zq1[8];
#pragma unroll
    for (int i = 0; i < 8; ++i) { zq0[i] = z0p[tid + 512 * i]; zq1[i] = z1p[tid + 512 * i]; }
    {
        const unsigned* F0f = (const unsigned*)(WSP(bf16_t, WS_FILT) + ((size_t)l * 1024 + c) * SEQ); const unsigned* F0b = F0f + (size_t)256 * (SEQ / 2);
        const unsigned* F1f = F0f + (size_t)512 * (SEQ / 2); const unsigned* F1b = F0f + (size_t)768 * (SEQ / 2);
        float s0 = 0.f, s1 = 0.f;
        { unsigned a0[8], b0[8], a1[8], b1[8];
#pragma unroll
            for (int i = 0; i < 8; ++i) { int u = tid + 512 * i; asm volatile("" : "+v"(u)); a0[i] = F0f[u]; b0[i] = F0b[u]; a1[i] = F1f[u]; b1[i] = F1b[u]; }
#pragma unroll
            for (int i = 0; i < 8; ++i) { int t = 2 * tid + 1024 * i; asm volatile("" : "+v"(t));
                const f32x2 fa = (f32x2){bflo(a0[i]), bflo(a1[i])}, fb = (f32x2){bfhi(a0[i]), bfhi(a1[i])}, ba = (f32x2){bflo(b0[i]), bflo(b1[i])}, bb = (f32x2){bfhi(b0[i]), bfhi(b1[i])};
                s0 += fabsf(fa.x) + fabsf(fb.x) + fabsf(ba.x) + fabsf(bb.x); s1 += fabsf(fa.y) + fabsf(fb.y) + fabsf(ba.y) + fabsf(bb.y);
                LAS f32x2* xf = X + PX(t); xf[0] = fa; xf[1] = fb;
                LAS f32x2* xr = X + PX(16382 - t); xr[0] = bb; xr[1] = ba; } }
        const float inv0 = 0.5f / block_sum(F, s0, red), inv1 = 0.5f / block_sum(F, s1, red);
        HY_FFT_FWD();
#pragma unroll
        for (int i = 0; i < 16; ++i) { int q = tid + 512 * i; asm volatile("" : "+v"(q)); const int p = ((q >> 1) << 2) | (q & 1), f = drev4(p), pp = drev4((16384 - f) & 16383);
            const f32x2 w = X[PX(p)], wp = X[PX(pp)];
            kq0[i] = (f32x2){(w.x + wp.x) * inv0, (w.y - wp.y) * inv0};
            kq1[i] = (f32x2){(w.y + wp.y) * inv1, (wp.x - w.x) * inv1};
            if ((i & 3) == 3) asm volatile("" ::: "memory"); }
        { const f32x2 w = X[PX(2)]; kx0 = (f32x2){2.0f * w.x * inv0, 0.f}; kx1 = (f32x2){2.0f * w.y * inv1, 0.f}; }
        __syncthreads();
    }
#pragma unroll
    for (int i = 0; i < 8; ++i) { int t = 2 * tid + 1024 * i; asm volatile("" : "+v"(t)); LAS f32x2* xp = X + PX(t); xp[0] = (f32x2){bflo(zq0[i]), bflo(zq1[i])}; xp[1] = (f32x2){bfhi(zq0[i]), bfhi(zq1[i])};
        LAS f32x2* xz = X + PX(8192 + t); xz[0] = (f32x2){0.f, 0.f}; xz[1] = (f32x2){0.f, 0.f}; }
    __syncthreads();
    const float invn = 1.0f / 16384.0f;
#pragma unroll 1
    for (int o = 0; o < 2; ++o) {
        HY_FFT_FWD();
#pragma unroll
        for (int i = 0; i < 16; ++i) { int q = tid + 512 * i; asm volatile("" : "+v"(q)); const int p = ((q >> 1) << 2) | (q & 1), f = drev4(p), pp = drev4((16384 - f) & 16383);
            const f32x2 k = o ? kq1[i] : kq0[i];
            const f32x2 xa = X[PX(p)], xb = X[PX(pp)];
            X[PX(p)] = pk_cmul(xa, k);
            if (i != 0 || pp != p) X[PX(pp)] = pk_cmulc(xb, k);
            if ((i & 3) == 3) asm volatile("" ::: "memory"); }
        if (tid == 0) X[PX(2)] = pk_cmul(X[PX(2)], o ? kx1 : kx0);
        __syncthreads();
        HY_FFT_INV();
        const unsigned* g0p = (const unsigned*)(HT0 + (size_t)(0 * 768 + o * 256 + c) * SEQ); const unsigned* g1p = (const unsigned*)(HT0 + (size_t)(1 * 768 + o * 256 + c) * SEQ);
        const float hbo = o ? hb1 : hb0;
        unsigned* yh0 = (unsigned*)(WSP(bf16_t, WS_YHT) + (size_t)(0 * 256 + c) * SEQ); unsigned* yh1 = (unsigned*)(WSP(bf16_t, WS_YHT) + (size_t)(1 * 256 + c) * SEQ);
        unsigned ga[8], gb[8];
#pragma unroll
        for (int i = 0; i < 8; ++i) { ga[i] = g0p[tid + 512 * i]; gb[i] = g1p[tid + 512 * i]; }
#pragma unroll
        for (int i = 0; i < 8; ++i) { int t = 2 * tid + 1024 * i; asm volatile("" : "+v"(t)); LAS f32x2* xp = X + PX(t); const f32x2 ya = xp[0], yb = xp[1];
            const float r0a = bflo(ga[i]) * (ya.x * invn + bflo(zq0[i]) * hbo), r1a = bflo(gb[i]) * (ya.y * invn + bflo(zq1[i]) * hbo);
            const float r0b = bfhi(ga[i]) * (yb.x * invn + bfhi(zq0[i]) * hbo), r1b = bfhi(gb[i]) * (yb.y * invn + bfhi(zq1[i]) * hbo);
            if (o == 0) { xp[0] = (f32x2){r0a, r1a}; xp[1] = (f32x2){r0b, r1b}; LAS f32x2* xz = X + PX(8192 + t); xz[0] = (f32x2){0.f, 0.f}; xz[1] = (f32x2){0.f, 0.f};
                zq0[i] = pk2(r0a, r0b); zq1[i] = pk2(r1a, r1b); }
            else { yh0[tid + 512 * i] = pk2(r0a, r0b); yh1[tid + 512 * i] = pk2(r1a, r1b); }
            if (i & 1) asm volatile("" ::: "memory"); }
        __syncthreads();
    }
#undef HY_PASS
#undef HY_FFT_FWD
#undef HY_FFT_INV
}

__device__ __forceinline__ void hy_prep_tile(Frame& F, int tile, int l) {
    const int tid = F.tid, lane = F.lane, wave = F.wave;
    const int b = tile >> 7, t0 = (tile & 127) * 64;
    constexpr int RS = 1552;
    const bf16_t* U = WSP(bf16_t, WS_U);
    const float* cw = INF(16) + (size_t)l * 768 * 3; const float* cb = INF(17) + l * 768;
    float wl[8];
#pragma unroll
    for (int k = 0; k < 8; ++k) wl[k] = 0.f;
    if (lane < 48) { const int chl = 2 * (wave + 8 * lane);
#pragma unroll
        for (int k = 0; k < 6; ++k) wl[k] = cw[chl * 3 + k];
        wl[6] = cb[chl]; wl[7] = cb[chl + 1]; }
    { u32x4 hv[13];
#pragma unroll
      for (int i = 0; i < 13; ++i) { const int idx = tid + 512 * i; const int row = idx / 96, pc = idx % 96; const int tok = t0 - 1 + row;
          hv[i] = (u32x4){0u, 0u, 0u, 0u};
          if (row < 66 && tok >= 0 && tok < SEQ) hv[i] = *(const GAS u32x4*)(U + ((size_t)b * SEQ + tok) * DINP + U_HY + pc * 8); }
#pragma unroll
      for (int i = 0; i < 13; ++i) { const int idx = tid + 512 * i; const int row = idx / 96, pc = idx % 96;
          if (row < 66) *(LAS u32x4*)(F.lds + row * RS + pc * 16) = hv[i]; } }
    __syncthreads();
    bf16_t* HT = WSP(bf16_t, WS_HYT);
#define RL_(k) __builtin_bit_cast(float, __builtin_amdgcn_readlane(__builtin_bit_cast(int, wl[k]), i))
#pragma unroll 4
    for (int i = 0; i < 48; ++i) { const int cp = wave + 8 * i, ch = 2 * cp;
        const float w00 = RL_(0), w01 = RL_(1), w02 = RL_(2), w10 = RL_(3), w11 = RL_(4), w12 = RL_(5), b0 = RL_(6), b1 = RL_(7);
        const unsigned r0 = *(const LAS unsigned*)(F.lds + lane * RS + cp * 4), r1 = *(const LAS unsigned*)(F.lds + (lane + 1) * RS + cp * 4), r2 = *(const LAS unsigned*)(F.lds + (lane + 2) * RS + cp * 4);
        HT[((size_t)(b * 768 + ch)) * SEQ + t0 + lane] = (bf16_t)(pk2(w00 * bflo(r0) + w01 * bflo(r1) + w02 * bflo(r2) + b0, 0.f) & 0xffffu);
        HT[((size_t)(b * 768 + ch + 1)) * SEQ + t0 + lane] = (bf16_t)(pk2(w10 * bfhi(r0) + w11 * bfhi(r1) + w12 * bfhi(r2) + b1, 0.f) & 0xffffu); }
#undef RL_
    __syncthreads();
}

__device__ __forceinline__ void headnorm_phase(Frame& F, int l) {
    const int lane = F.lane, tid = F.tid, wave = F.wave;
    const bf16_t* U = WSP(bf16_t, WS_U); const bf16_t* YA = WSP(bf16_t, WS_YATT); const bf16_t* YH = WSP(bf16_t, WS_YHT);
    constexpr int RS2 = 528;
    const int g = wave >> 1, sub = wave & 1, cg = 4 * lane, ch = g * 256 + cg;
    const f32x4 og = *(const GAS f32x4*)(INF(29) + l * 1024 + ch);
    float scw[12];
#pragma unroll
    for (int j = 0; j < 12; ++j) scw[j] = INF(28)[(size_t)l * 768 + cg * 3 + j];
    for (int tile = F.vcu; tile < 256; tile += F.G) {
      const int tb = tile >> 7, t0 = (tile & 127) * 64;
#pragma unroll
      for (int i = 0; i < 4; ++i) { const int idx = tid + 512 * i, c = idx >> 3, p8 = idx & 7;
          const u32x4 v = *(const GAS u32x4*)(YH + ((size_t)(tb * 256 + c)) * SEQ + t0 + p8 * 8);
          LAS unsigned char* hp = F.lds + (8 * p8) * RS2 + 2 * c;
          *(LAS unsigned short*)(hp + 0 * RS2) = (unsigned short)(v.x & 0xffffu); *(LAS unsigned short*)(hp + 1 * RS2) = (unsigned short)(v.x >> 16);
          *(LAS unsigned short*)(hp + 2 * RS2) = (unsigned short)(v.y & 0xffffu); *(LAS unsigned short*)(hp + 3 * RS2) = (unsigned short)(v.y >> 16);
          *(LAS unsigned short*)(hp + 4 * RS2) = (unsigned short)(v.z & 0xffffu); *(LAS unsigned short*)(hp + 5 * RS2) = (unsigned short)(v.z >> 16);
          *(LAS unsigned short*)(hp + 6 * RS2) = (unsigned short)(v.w & 0xffffu); *(LAS unsigned short*)(hp + 7 * RS2) = (unsigned short)(v.w >> 16); }
      __syncthreads();
      constexpr int RB = 8;
      const int mrow0 = tb * SEQ + t0 + sub * 32;
#define PG_FIN(M, Y0, Y1, Y2, Y3) do { const float y0_ = (Y0), y1_ = (Y1), y2_ = (Y2), y3_ = (Y3); \
        float ss = (y0_ * y0_ + y1_ * y1_) + (y2_ * y2_ + y3_ * y3_); \
        ss += __shfl_xor(ss, 1); ss += __shfl_xor(ss, 2); ss += __shfl_xor(ss, 4); ss += __shfl_xor(ss, 8); \
        const float rstd = __builtin_amdgcn_rsqf(ss * (1.0f / 64.0f) + EPS); \
        u32x2 w_; w_.x = pk2(y0_ * rstd * og.x, y1_ * rstd * og.y); w_.y = pk2(y2_ * rstd * og.z, y3_ * rstd * og.w); \
        *(GAS u32x2*)(WSP(bf16_t, WS_YN) + (size_t)(M) * DM + ch) = w_; } while (0)
      if (g == 0) {
#pragma unroll 1
        for (int r0 = 0; r0 < 32; r0 += RB) { u32x2 ow[RB], hfw[RB], hbw[RB];
#pragma unroll
            for (int i = 0; i < RB; ++i) { const int m = mrow0 + r0 + i;
                ow[i] = *(const GAS u32x2*)(U + (size_t)m * DINP + U_MLO + cg);
                hfw[i] = *(const GAS u32x2*)(WSP(bf16_t, WS_HF) + (size_t)m * 256 + cg); hbw[i] = *(const GAS u32x2*)(WSP(bf16_t, WS_HB) + (size_t)m * 256 + cg); }
#pragma unroll
            for (int i = 0; i < RB; ++i) { const int m = mrow0 + r0 + i;
                const f32x4 hs = (f32x4){bflo(hfw[i].x) + bflo(hbw[i].x), bfhi(hfw[i].x) + bfhi(hbw[i].x), bflo(hfw[i].y) + bflo(hbw[i].y), bfhi(hfw[i].y) + bfhi(hbw[i].y)};
                PG_FIN(m, hs.x / (1.0f + fexp(-bflo(ow[i].x))), hs.y / (1.0f + fexp(-bfhi(ow[i].x))), hs.z / (1.0f + fexp(-bflo(ow[i].y))), hs.w / (1.0f + fexp(-bfhi(ow[i].y)))); } }
      } else if (g == 1) {
#pragma unroll 1
        for (int r0 = 0; r0 < 32; r0 += 2 * RB) { u32x2 w[2 * RB];
#pragma unroll
            for (int i = 0; i < 2 * RB; ++i) w[i] = *(const GAS u32x2*)(YA + (size_t)(mrow0 + r0 + i) * 256 + cg);
#pragma unroll
            for (int i = 0; i < 2 * RB; ++i) PG_FIN(mrow0 + r0 + i, bflo(w[i].x), bfhi(w[i].x), bflo(w[i].y), bfhi(w[i].y)); }
      } else if (g == 2) {
#pragma unroll 1
        for (int r0 = 0; r0 < 32; r0 += 2 * RB) { u32x2 w[2 * RB];
#pragma unroll
            for (int i = 0; i < 2 * RB; ++i) w[i] = *(const LAS u32x2*)(F.lds + (sub * 32 + r0 + i) * RS2 + cg * 2);
#pragma unroll
            for (int i = 0; i < 2 * RB; ++i) PG_FIN(mrow0 + r0 + i, bflo(w[i].x), bfhi(w[i].x), bflo(w[i].y), bfhi(w[i].y)); }
      } else {
#pragma unroll 1
        for (int r0 = 0; r0 < 32; r0 += RB) { u32x2 bw[RB], cc[RB + 2], xx[RB + 2];
#pragma unroll
            for (int i = 0; i < RB + 2; ++i) { const int s = t0 + sub * 32 + r0 + i - 1; const bf16_t* up = U + (size_t)(tb * SEQ + s) * DINP + U_SC + cg;
                cc[i] = (u32x2){0u, 0u}; xx[i] = (u32x2){0u, 0u};
                if (s >= 0 && s < SEQ) { cc[i] = *(const GAS u32x2*)(up + 256); xx[i] = *(const GAS u32x2*)(up + 512); }
                if (i >= 1 && i <= RB) bw[i - 1] = *(const GAS u32x2*)up; }
#pragma unroll
            for (int i = 0; i < RB; ++i) { const u32x2 c0 = cc[i], x0 = xx[i], c1 = cc[i + 1], x1 = xx[i + 1], c2 = cc[i + 2], x2 = xx[i + 2], b_ = bw[i];
                PG_FIN(mrow0 + r0 + i,
                    bflo(b_.x) * (scw[0] * bflo(c0.x) * bflo(x0.x) + scw[1] * bflo(c1.x) * bflo(x1.x) + scw[2] * bflo(c2.x) * bflo(x2.x)),
                    bfhi(b_.x) * (scw[3] * bfhi(c0.x) * bfhi(x0.x) + scw[4] * bfhi(c1.x) * bfhi(x1.x) + scw[5] * bfhi(c2.x) * bfhi(x2.x)),
                    bflo(b_.y) * (scw[6] * bflo(c0.y) * bflo(x0.y) + scw[7] * bflo(c1.y) * bflo(x1.y) + scw[8] * bflo(c2.y) * bflo(x2.y)),
                    bfhi(b_.y) * (scw[9] * bfhi(c0.y) * bfhi(x0.y) + scw[10] * bfhi(c1.y) * bfhi(x1.y) + scw[11] * bfhi(c2.y) * bfhi(x2.y))); } }
      }
#undef PG_FIN
      __syncthreads();
    }
}

__device__ __forceinline__ void post_mixer_phase(Frame& F, int l, const float* xin) {
    const int gw = F.vcu * NWAVES + F.wave, NGW = F.G * NWAVES, lane = F.lane, tid = F.tid;
    LAS float* RWT = (LAS float*)F.lds;
    { const GAS f32x4* src = (const GAS f32x4*)(INF(31) + (size_t)l * 1024 * 16);
      f32x4 wv[8];
#pragma unroll
      for (int q = 0; q < 8; ++q) wv[q] = src[tid + NTHR * q];
#pragma unroll
      for (int q = 0; q < 8; ++q) { const int i = tid + NTHR * q; const f32x4 w = wv[q]; const int k = i >> 2, e4 = (i & 3) * 4;
          RWT[(e4 + 0) * 1024 + k] = w.x; RWT[(e4 + 1) * 1024 + k] = w.y; RWT[(e4 + 2) * 1024 + k] = w.z; RWT[(e4 + 3) * 1024 + k] = w.w; } }
    __syncthreads();
    const float* mod = WSP(float, WS_MOD);
    f32x4 pA[4], pS[4], pB[4]; int bcur = -1;
#pragma unroll
    for (int j = 0; j < 4; ++j) { pA[j] = (f32x4){0.f, 0.f, 0.f, 0.f}; pS[j] = pA[j]; pB[j] = pA[j]; }
    for (int m0 = gw; m0 < MTOK; m0 += 2 * NGW) {
        u32x2 yw[2][4]; f32x4 xr[2][4];
#pragma unroll
        for (int r = 0; r < 2; ++r) { const int mm = (m0 + r * NGW < MTOK) ? m0 + r * NGW : m0;
            const GAS u32x2* yr = (const GAS u32x2*)(WSP(bf16_t, WS_Y2) + (size_t)mm * DM) + lane;
#pragma unroll
            for (int j = 0; j < 4; ++j) yw[r][j] = yr[64 * j];
            if (l == 0) ld_row_f32(xin + (size_t)mm * DM, lane, xr[r]);
            else { const GAS u32x2* xb = (const GAS u32x2*)((const bf16_t*)xin + (size_t)mm * DM) + lane;
#pragma unroll
                for (int j = 0; j < 4; ++j) { const u32x2 w = xb[64 * j]; xr[r][j] = (f32x4){bflo(w.x), bfhi(w.x), bflo(w.y), bfhi(w.y)}; } } }
        f32x4 h[2][4];
#pragma unroll
        for (int r = 0; r < 2; ++r) { const int m = (m0 + r * NGW < MTOK) ? m0 + r * NGW : m0;
            const int b = m >> 13;
            if (b != bcur) { bcur = b; const float* md = mod + (l * 2 + b) * 6144; f32x4 t0[4], t1[4];
                ld_row_f32(INF(6) + l * 1024, lane, t0); ld_row_f32(md + 2048, lane, t1);
#pragma unroll
                for (int j = 0; j < 4; ++j) pB[j] = t1[j] * t0[j];
                ld_row_f32(INF(7) + l * 1024, lane, t0); ld_row_f32(md + 4096, lane, t1); ld_row_f32(md + 3072, lane, pS);
#pragma unroll
                for (int j = 0; j < 4; ++j) pA[j] = t0[j] * (t1[j] + 1.0f); }
            f32x4 y2[4], x[4];
#pragma unroll
            for (int j = 0; j < 4; ++j) { y2[j] = (f32x4){bflo(yw[r][j].x), bfhi(yw[r][j].x), bflo(yw[r][j].y), bfhi(yw[r][j].y)}; x[j] = xr[r][j]; }
            const float rstd = __builtin_amdgcn_rsqf(row_ss(y2) * (1.0f / DM) + EPS);
#pragma unroll
            for (int j = 0; j < 4; ++j) x[j] = x[j] + (y2[j] * rstd) * pB[j];
            st_row_bf16(WSP(bf16_t, WS_X1) + (size_t)m * DM, lane, x);
            const float rs2 = __builtin_amdgcn_rsqf(row_ss(x) * (1.0f / DM) + EPS);
#pragma unroll
            for (int j = 0; j < 4; ++j) h[r][j] = (x[j] * rs2) * pA[j] + pS[j];
            st_row_bf16(WSP(bf16_t, WS_XN) + (size_t)m * DM, lane, h[r]); }
        f32x2 acc[16];
#pragma unroll
        for (int e = 0; e < 16; ++e) acc[e] = (f32x2){0.f, 0.f};
#pragma unroll
        for (int j = 0; j < 4; ++j) {
            const f32x2 hx = (f32x2){h[0][j].x, h[1][j].x}, hy = (f32x2){h[0][j].y, h[1][j].y}, hz = (f32x2){h[0][j].z, h[1][j].z}, hw = (f32x2){h[0][j].w, h[1][j].w};
            f32x4 w[16];
#pragma unroll
            for (int e = 0; e < 16; ++e) w[e] = *(const LAS f32x4*)(RWT + e * 1024 + 4 * lane + 256 * j);
            __builtin_amdgcn_sched_barrier(0);
#pragma unroll
            for (int e = 0; e < 16; ++e) { const f32x2 wa = (f32x2){w[e].x, w[e].y}, wb = (f32x2){w[e].z, w[e].w};
                asm("v_pk_fma_f32 %0, %1, %2, %0 op_sel_hi:[1,0,1]" : "+v"(acc[e]) : "v"(hx), "v"(wa));
                asm("v_pk_fma_f32 %0, %1, %2, %0 op_sel:[0,1,0] op_sel_hi:[1,1,1]" : "+v"(acc[e]) : "v"(hy), "v"(wa));
                asm("v_pk_fma_f32 %0, %1, %2, %0 op_sel_hi:[1,0,1]" : "+v"(acc[e]) : "v"(hz), "v"(wb));
                asm("v_pk_fma_f32 %0, %1, %2, %0 op_sel:[0,1,0] op_sel_hi:[1,1,1]" : "+v"(acc[e]) : "v"(hw), "v"(wb)); }
            __builtin_amdgcn_sched_barrier(0); }
#pragma unroll
        for (int r = 0; r < 2; ++r) { const int m = (m0 + r * NGW < MTOK) ? m0 + r * NGW : m0; const int b = m >> 13, s = m & 8191;
        float part[16];
#pragma unroll
        for (int e = 0; e < 16; ++e) part[e] = r ? acc[e].y : acc[e].x;
        float a8[8], a4[4], a2[2], lg;
        { const bool up = (lane & 32) != 0;
#pragma unroll
          for (int i = 0; i < 8; ++i) { const float keep = up ? part[8 + i] : part[i], send = up ? part[i] : part[8 + i]; a8[i] = keep + __shfl_xor(send, 32); } }
        { const bool up = (lane & 16) != 0;
#pragma unroll
          for (int i = 0; i < 4; ++i) { const float keep = up ? a8[4 + i] : a8[i], send = up ? a8[i] : a8[4 + i]; a4[i] = keep + __shfl_xor(send, 16); } }
        { const bool up = (lane & 8) != 0;
#pragma unroll
          for (int i = 0; i < 2; ++i) { const float keep = up ? a4[2 + i] : a4[i], send = up ? a4[i] : a4[2 + i]; a2[i] = keep + __shfl_xor(send, 8); } }
        { const bool up = (lane & 4) != 0; const float keep = up ? a2[1] : a2[0], send = up ? a2[0] : a2[1]; lg = keep + __shfl_xor(send, 4); }
        lg += __shfl_xor(lg, 2); lg += __shfl_xor(lg, 1);
        float mx = lg;
#pragma unroll
        for (int o = 4; o < 64; o <<= 1) mx = fmaxf(mx, __shfl_xor(mx, o));
        const float ex = fexp(lg - mx); float sm = ex;
#pragma unroll
        for (int o = 4; o < 64; o <<= 1) sm += __shfl_xor(sm, o);
        if ((lane & 3) == 0) WSP(float, WS_AFF)[((size_t)b * 16 + (lane >> 2)) * SEQ + s] = ex / sm;
        if (lane < 16) WSP(int, WS_SLOT)[(size_t)m * 16 + lane] = -1;
            }
    }
    __syncthreads();
}

__device__ __forceinline__ void topk_item(Frame& F, int it) {
    const int tid = F.tid, lane = F.lane, wave = F.wave;
    const int b = it >> 4, e = it & 15;
    LAS unsigned* wcnt = (LAS unsigned*)F.lds;
    LAS unsigned* wtot = wcnt + 64;
    unsigned key[16];
    { const GAS u32x4* src = (const GAS u32x4*)(WSP(float, WS_AFF) + (size_t)it * SEQ) + tid * 4;
#pragma unroll
      for (int q = 0; q < 4; ++q) { const u32x4 v = src[q]; key[4 * q] = v.x; key[4 * q + 1] = v.y; key[4 * q + 2] = v.z; key[4 * q + 3] = v.w; } }
    unsigned T = 0u;
#pragma unroll 1
    for (int bit = 30; bit >= 0; bit -= 2) {
        const int lo = bit > 0 ? bit - 1 : 0;
        const unsigned c1 = T | (1u << lo), c2 = bit > 0 ? (T | (2u << lo)) : 0xffffffffu, c3 = bit > 0 ? (T | (3u << lo)) : 0xffffffffu;
        unsigned n1 = 0u, n2 = 0u, n3 = 0u;
#pragma unroll
        for (int i = 0; i < 16; ++i) { n1 += (unsigned)__popcll(__ballot(key[i] >= c1)); n2 += (unsigned)__popcll(__ballot(key[i] >= c2)); n3 += (unsigned)__popcll(__ballot(key[i] >= c3)); }
        LAS unsigned* wc = wcnt + ((bit >> 1) & 1) * 32;
        if (lane == 0) { wc[wave * 4] = n1; wc[wave * 4 + 1] = n2; wc[wave * 4 + 2] = n3; }
        __syncthreads();
        unsigned t1 = 0u, t2 = 0u, t3 = 0u;
#pragma unroll
        for (int w = 0; w < NWAVES; ++w) { t1 += wc[w * 4]; t2 += wc[w * 4 + 1]; t3 += wc[w * 4 + 2]; }
        if (bit > 0 && t3 >= (unsigned)CAP) T = c3; else if (bit > 0 && t2 >= (unsigned)CAP) T = c2; else if (t1 >= (unsigned)CAP) T = c1;
    }
    unsigned cg = 0u, ce = 0u;
#pragma unroll
    for (int i = 0; i < 16; ++i) { cg += (key[i] > T) ? 1u : 0u; ce += (key[i] == T) ? 1u : 0u; }
    unsigned v = cg | (ce << 16), inc = v;
#pragma unroll
    for (int o = 1; o < 64; o <<= 1) { const unsigned n = __shfl_up(inc, o); if (lane >= o) inc += n; }
    __syncthreads();
    if (lane == 63) wtot[wave] = inc;
    __syncthreads();
    unsigned off = 0u, all = 0u;
#pragma unroll
    for (int w = 0; w < NWAVES; ++w) { const unsigned tw = wtot[w]; all += tw; if (w < wave) off += tw; }
    const unsigned need = (unsigned)CAP - (all & 0xffffu);
    const unsigned excl = off + inc - v;
    unsigned ng = excl & 0xffffu, ne = excl >> 16;
    int* IDX = WSP(int, WS_IDX) + (e * 2 + b) * CAP; int* SLOT = WSP(int, WS_SLOT);
#pragma unroll
    for (int i = 0; i < 16; ++i) { const int idx = tid * 16 + i; const unsigned k = key[i];
        const bool gt = k > T, eq = k == T; const bool sel = gt || (eq && ne < need);
        if (sel) { const int slot = (int)(ng + (ne < need ? ne : need)); IDX[slot] = b * SEQ + idx; SLOT[((size_t)b * SEQ + idx) * 16 + e] = slot; }
        ng += gt ? 1u : 0u; ne += eq ? 1u : 0u; }
    __syncthreads();
}

__device__ __forceinline__ void combine_phase(Frame& F, int l) {
    const int gw = F.vcu * NWAVES + F.wave, NGW = F.G * NWAVES, lane = F.lane;
    const float* mod = WSP(float, WS_MOD);
    const bf16_t* YE = WSP(bf16_t, WS_YE);
    f32x4 pg[4]; ld_row_f32(INF(8) + l * 1024, lane, pg);
    f32x4 pG[4], nA[4], nS[4]; int bcur = -1;
#pragma unroll
    for (int j = 0; j < 4; ++j) { pG[j] = (f32x4){0.f, 0.f, 0.f, 0.f}; nA[j] = pG[j]; nS[j] = pG[j]; }
    for (int m0 = gw; m0 < MTOK; m0 += 2 * NGW) {
        int sl[2]; float gv[2]; f32x4 x1[2][4];
#pragma unroll
        for (int r = 0; r < 2; ++r) { const int mm = (m0 + r * NGW < MTOK) ? m0 + r * NGW : m0; const int b = mm >> 13, s = mm & 8191;
            sl[r] = -1; gv[r] = 0.f;
            if (lane < 16) { sl[r] = WSP(int, WS_SLOT)[(size_t)mm * 16 + lane]; gv[r] = WSP(float, WS_AFF)[((size_t)b * 16 + lane) * SEQ + s]; }
            { const GAS u32x2* xr = (const GAS u32x2*)(WSP(bf16_t, WS_X1) + (size_t)mm * DM) + lane;
#pragma unroll
              for (int j = 0; j < 4; ++j) { const u32x2 w = xr[64 * j]; x1[r][j] = (f32x4){bflo(w.x), bfhi(w.x), bflo(w.y), bfhi(w.y)}; } } }
        unsigned long long msk[2]; float g0[2], g1[2]; u32x2 w0[2][4], w1[2][4];
#pragma unroll
        for (int r = 0; r < 2; ++r) { const int mm = (m0 + r * NGW < MTOK) ? m0 + r * NGW : m0; const int b = mm >> 13;
            msk[r] = __ballot(sl[r] >= 0) & 0xffffull;
            int e0 = 0, e1 = -1; unsigned long long mk = msk[r];
            if (mk) { e0 = __builtin_ctzll(mk); mk &= mk - 1; } else e0 = -1;
            if (mk) { e1 = __builtin_ctzll(mk); mk &= mk - 1; }
            msk[r] = mk;
            const int ea = e0 < 0 ? 0 : e0, eb = e1 < 0 ? ea : e1;
            const int s0 = __shfl(sl[r], ea), s1 = __shfl(sl[r], eb);
            g0[r] = (e0 < 0) ? 0.f : __shfl(gv[r], ea); g1[r] = (e1 < 0) ? 0.f : __shfl(gv[r], eb);
            const GAS u32x2* r0 = (const GAS u32x2*)(YE + ((size_t)ea * 2048 + b * CAP + (e0 < 0 ? 0 : s0)) * DM) + lane;
            const GAS u32x2* r1 = (const GAS u32x2*)(YE + ((size_t)eb * 2048 + b * CAP + (e0 < 0 ? 0 : s1)) * DM) + lane;
#pragma unroll
            for (int j = 0; j < 4; ++j) { w0[r][j] = r0[64 * j]; w1[r][j] = r1[64 * j]; } }
#pragma unroll
        for (int r = 0; r < 2; ++r) { const int m = m0 + r * NGW; if (m >= MTOK) break;
            const int b = m >> 13;
            f32x4 acc[4];
#pragma unroll
            for (int j = 0; j < 4; ++j) { acc[j] = (f32x4){bflo(w0[r][j].x), bfhi(w0[r][j].x), bflo(w0[r][j].y), bfhi(w0[r][j].y)} * g0[r];
                                          acc[j] += (f32x4){bflo(w1[r][j].x), bfhi(w1[r][j].x), bflo(w1[r][j].y), bfhi(w1[r][j].y)} * g1[r]; }
            unsigned long long mk = msk[r];
            while (mk) {
                const int e0 = __builtin_ctzll(mk); mk &= mk - 1;
                int e1 = -1; if (mk) { e1 = __builtin_ctzll(mk); mk &= mk - 1; }
                const int s0 = __shfl(sl[r], e0); const float h0 = __shfl(gv[r], e0);
                const int s1 = __shfl(sl[r], e1 < 0 ? e0 : e1); const float h1 = (e1 < 0) ? 0.f : __shfl(gv[r], e1 < 0 ? e0 : e1);
                const GAS u32x2* r0 = (const GAS u32x2*)(YE + ((size_t)e0 * 2048 + b * CAP + s0) * DM) + lane;
                const GAS u32x2* r1 = (const GAS u32x2*)(YE + ((size_t)(e1 < 0 ? e0 : e1) * 2048 + b * CAP + s1) * DM) + lane;
                u32x2 v0[4], v1[4];
#pragma unroll
                for (int j = 0; j < 4; ++j) { v0[j] = r0[64 * j]; v1[j] = r1[64 * j]; }
#pragma unroll
                for (int j = 0; j < 4; ++j) { acc[j] += (f32x4){bflo(v0[j].x), bfhi(v0[j].x), bflo(v0[j].y), bfhi(v0[j].y)} * h0;
                                              acc[j] += (f32x4){bflo(v1[j].x), bfhi(v1[j].x), bflo(v1[j].y), bfhi(v1[j].y)} * h1; }
            }
            if (b != bcur) { bcur = b; const float* md = mod + (l * 2 + b) * 6144; f32x4 t0[4];
                ld_row_f32(md + 5120, lane, t0);
#pragma unroll
                for (int j = 0; j < 4; ++j) pG[j] = t0[j] * pg[j];
                if (l == 0) { const float* md1 = mod + (1 * 2 + b) * 6144; f32x4 t1[4];
                    ld_row_f32(INF(5) + 1024, lane, t0); ld_row_f32(md1 + 1024, lane, t1); ld_row_f32(md1, lane, nS);
#pragma unroll
                    for (int j = 0; j < 4; ++j) nA[j] = t0[j] * (t1[j] + 1.0f); } }
            const float rstd = __builtin_amdgcn_rsqf(row_ss(acc) * (1.0f / DM) + EPS);
            f32x4 xo[4];
#pragma unroll
            for (int j = 0; j < 4; ++j) xo[j] = x1[r][j] + (acc[j] * rstd) * pG[j];
            if (l == 0) st_row_bf16((bf16_t*)F.a->out + (size_t)m * DM, lane, xo); else st_row_f32(F.a->out + (size_t)m * DM, lane, xo);
            if (l == 0) { f32x4 h[4]; const float rs1 = __builtin_amdgcn_rsqf(row_ss(xo) * (1.0f / DM) + EPS);
#pragma unroll
                for (int j = 0; j < 4; ++j) h[j] = (xo[j] * rs1) * nA[j] + nS[j];
                st_row_bf16(WSP(bf16_t, WS_XN) + (size_t)m * DM, lane, h); }
        }
    }
}

constexpr int PH_PER_LAYER = 11, N_PHASES = 2 + 2 * PH_PER_LAYER;
__global__ void __launch_bounds__(NTHR, 2) mega_fwd(Args args) {
    extern __shared__ __attribute__((aligned(16))) unsigned char lds_raw[];
    Frame F;
    F.lds = (LAS unsigned char*)lds_raw;
    F.tid = threadIdx.x; F.lane = F.tid & 63; F.wave = __builtin_amdgcn_readfirstlane(F.tid >> 6);
    F.G = gridDim.x; { const int bx = blockIdx.x; F.vcu = (F.G % 8 == 0) ? (bx % 8) * (F.G / 8) + bx / 8 : bx; }
    F.a = &args; F.ws = args.ws;
    volatile LAS unsigned* MISC = (volatile LAS unsigned*)(F.lds + MISC_OFF);
    for (int u = F.tid; u < (LDS_BYTES - LDSCTL_OFF) / 4; u += NTHR) ((LAS unsigned*)(F.lds + LDSCTL_OFF))[u] = 0u;
    __syncthreads();
    gu32* ctl = (gu32*)(F.ws + WS_CTL);
    XcdBarrier bar; bar.bar = (unsigned*)(ctl + CW_BAR); bar.x = 0; bar.st = nullptr;
#if !MK_SPLIT
    bar = xcd_barrier_post((unsigned*)(ctl + CW_BAR), MISC + 8);
#endif
    const int lo = args.ph_lo, hi = args.ph_hi;
    int ph = 0;
#if MK_SPLIT
#define SEAM() do { } while (0)
#else
#define SEAM() do { if (ph + 1 < hi) { if (F.G == 256 && ph < CONV_NB0 + CONV_NB1) { const int cl_ = ph < CONV_NB0 ? 0 : 1; xcd_barrier_conv(bar, F, cl_, conv_r0(cl_) + (cl_ ? ph - CONV_NB0 : ph) * CONV_PER_BAR); } else xcd_barrier(bar); } } while (0)
#endif
#ifndef PHSEL
#define PHSEL -1
#endif
#ifndef PHMASK
#define PHMASK 0x7fff
#endif
#ifndef DBL_MASK
#define DBL_MASK 0
#endif
#define PHASE_BEGIN(id) if ((PHSEL < 0 || PHSEL == (id)) && ((PHMASK >> (id)) & 1) && lo <= ph && ph < hi) for (int rep_ = 0; rep_ < (((DBL_MASK >> (id)) & 1) ? 2 : 1); ++rep_) { if (rep_) xcd_barrier(bar); { int t_ = threadIdx.x; asm volatile("" : "+v"(t_)); F.tid = t_; F.lane = t_ & 63; F.wave = __builtin_amdgcn_readfirstlane(t_ >> 6); }
#define PHASE_END   SEAM(); } ++ph;

    PHASE_BEGIN(0) p0_phase(F); PHASE_END
    PHASE_BEGIN(1) p1_phase(F); PHASE_END
#pragma unroll 1
    for (int l = 0; l < 2; ++l) {
        const float* xin = (l == 0) ? (const float*)args.in[0] : (const float*)args.out;
        PHASE_BEGIN(2) {
            pg8::Gemm g{WSP(bf16_t, WS_XN), WSP(bf16_t, WS_WIN) + (size_t)l * DINP * 1024, MTOK, DINP, 1024}; pg8::StaticOrder S; S.init(MTOK, DINP, F.G, (int)blockIdx.x);
            pg8::EpiBf16 E{WSP(bf16_t, WS_U), DINP, DINP / 256};
            pg8::gemm_phase<pg8::EpiBf16, pg8::StaticOrder, true, true>(F.lds, g, S, E, F.tid);
        } PHASE_END
        PHASE_BEGIN(3) {
#ifndef SUBSEL
#define SUBSEL 0
#endif
#ifndef REP_A
#define REP_A 1
#define REP_B 1
#define REP_C 1
#define REP_D 1
#define REP_E 1
#endif
            for (int q_ = 0; q_ < REP_A; ++q_) for (int tl = F.vcu; tl < 256; tl += F.G) hy_prep_tile(F, tl, l);
            for (int q_ = 0; q_ < REP_B; ++q_) for (int p = F.vcu; p < 512; p += F.G) ml_local_pair(F, p, l);
            for (int q_ = 0; q_ < REP_C; ++q_) mla_prep_rows(F, l);
        } PHASE_END
        PHASE_BEGIN(4) {
            pg8::Gemm g{WSP(bf16_t, WS_AMLA), WSP(bf16_t, WS_WMLA) + (size_t)l * 1024 * 384, MTOK, 1024, 384}; pg8::StaticOrder S; S.init(MTOK, 1024, F.G, (int)blockIdx.x);
            EpiMla E{WSP(bf16_t, WS_Q), WSP(bf16_t, WS_KIMG), WSP(bf16_t, WS_VIMG), (const int*)F.a->in[2], 0.10206207261596577f * LOG2E};
            pg8::gemm_phase<EpiMla, pg8::StaticOrder, true, true>(F.lds, g, S, E, F.tid);
#define REFRESH_TID() do { int t_ = threadIdx.x; asm volatile("" : "+v"(t_)); F.tid = t_; F.lane = t_ & 63; F.wave = __builtin_amdgcn_readfirstlane(t_ >> 6); } while (0)
            REFRESH_TID();
            ml_scan(F);
            REFRESH_TID();
#ifndef HY_REP
#define HY_REP 1
#endif
            for (int rep2_ = 0; rep2_ < HY_REP; ++rep2_) for (int c = F.vcu; c < 256; c += F.G) hyena_item(F, c, l);
        } PHASE_END
        PHASE_BEGIN(5) {
            for (int q_ = 0; q_ < REP_D; ++q_) for (int u = F.vcu; u < 256; u += F.G) attn_unit(F, u >> 5, u & 31);
            for (int q_ = 0; q_ < REP_E; ++q_) for (int p = F.vcu; p < 512; p += F.G) ml_out_pair(F, p, l);
        } PHASE_END
        PHASE_BEGIN(6) headnorm_phase(F, l); PHASE_END
        PHASE_BEGIN(7) {
            pg8::Gemm g{WSP(bf16_t, WS_YN), WSP(bf16_t, WS_WOUT) + (size_t)l * 1024 * 1024, MTOK, 1024, 1024}; pg8::StaticOrder S; S.init(MTOK, 1024, F.G, (int)blockIdx.x);
            pg8::EpiBf16 E{WSP(bf16_t, WS_Y2), 1024, 4};
            pg8::gemm_phase<pg8::EpiBf16, pg8::StaticOrder, true, true>(F.lds, g, S, E, F.tid);
        } PHASE_END
        PHASE_BEGIN(8) post_mixer_phase(F, l, xin); PHASE_END
        PHASE_BEGIN(9) {
            for (int it = F.vcu; it < 32; it += F.G) topk_item(F, it);
            if (F.G == 256 && !MK_SPLIT && F.vcu >= 32) {
                const int w = (F.vcu - 32) * NWAVES + F.wave;
                int lq_ = l; asm volatile("" : "+s"(lq_));
#pragma unroll 1
                for (int mi = 40960 + w; mi < 49152; mi += 1792) {
                    f32x4 ca[8]; const float* sa; bf16_t* da; int la, pa_;
                    conv_mi_addr(F, lq_, mi, F.lane, sa, la, da, pa_); conv_mi_issue(ca, sa, la);
                    conv_mi_finish(ca, da, pa_);
                }
            }
        } PHASE_END
        PHASE_BEGIN(10) {
            pg8::Gemm g{WSP(bf16_t, WS_XN), WSP(bf16_t, WS_WGU) + (size_t)l * NEXP * 4096 * 1024, NEXP * 2048, NEXP * 4096, 1024, WSP(int, WS_IDX)}; pg8::GroupedOrder S; S.init(16, F.G, (int)blockIdx.x);
            pg8::EpiSwiGLU E{WSP(bf16_t, WS_ACT), LDFF};
            pg8::gemm_phase<pg8::EpiSwiGLU, pg8::GroupedOrder, true, true, true>(F.lds, g, S, E, F.tid);
        } PHASE_END
        PHASE_BEGIN(11) {
            pg8::Gemm g{WSP(bf16_t, WS_ACT), WSP(bf16_t, WS_WDN) + (size_t)l * NEXP * 1024 * LDFF, NEXP * 2048, NEXP * 1024, 2048, nullptr, LDFF, LDFF}; pg8::GroupedOrder S; S.init(4, F.G, (int)blockIdx.x);
            pg8::EpiBf16 E{WSP(bf16_t, WS_YE), 1024, 4};
            pg8::gemm_phase<pg8::EpiBf16, pg8::GroupedOrder, true, true>(F.lds, g, S, E, F.tid);
        } PHASE_END
        PHASE_BEGIN(12) combine_phase(F, l); PHASE_END
    }
}

extern "C" void kernel_launch(void* const* d_in, const int* in_sizes, int n_in, void* d_out, int out_size, void* d_ws, size_t ws_size, hipStream_t stream) {
    static int grid = 0;
    if (grid == 0) {
        if (n_in != 35 || out_size != MTOK * DM || ws_size < WS_END) { fprintf(stderr, "kernel_launch: unexpected shapes: n_in %d out %d ws %zu (need %zu)\n", n_in, out_size, ws_size, (size_t)WS_END); grid = -1; return; }
        int dev = 0, cus = 0, per_cu = 0;
        if (hipGetDevice(&dev) != hipSuccess || hipDeviceGetAttribute(&cus, hipDeviceAttributeMultiprocessorCount, dev) != hipSuccess) { grid = -1; return; }
        if (hipFuncSetAttribute((const void*)mega_fwd, hipFuncAttributeMaxDynamicSharedMemorySize, LDS_BYTES) != hipSuccess) { fprintf(stderr, "kernel_launch: hipFuncSetAttribute failed\n"); grid = -1; return; }
        (void)hipOccupancyMaxActiveBlocksPerMultiprocessor(&per_cu, (const void*)mega_fwd, NTHR, LDS_BYTES);
        (void)hipGetLastError();
        grid = cus > 0 ? cus : 256;
        if (per_cu < 1) fprintf(stderr, "kernel_launch: occupancy query reports %d\n", per_cu);
    }
    if (grid < 0) return;
    (void)hipMemsetAsync((char*)d_ws + WS_CTL, 0, CTL_ZERO_BYTES, stream);
    Args a{};
    for (int i = 0; i < 35; ++i) a.in[i] = d_in[i];
    a.out = (float*)d_out; a.ws = (unsigned char*)d_ws;
#if MK_SPLIT
    for (int p = 0; p < N_PHASES; ++p) { a.ph_lo = p; a.ph_hi = p + 1; hipLaunchKernelGGL(mega_fwd, dim3(grid), dim3(NTHR), LDS_BYTES, stream, a); }
#else
    a.ph_lo = 0; a.ph_hi = N_PHASES;
    hipLaunchKernelGGL(mega_fwd, dim3(grid), dim3(NTHR), LDS_BYTES, stream, a);
#endif
}
```

```cpp
#include <hip/hip_runtime.h>
#include <cstdio>
#include <cstdint>

#ifndef MK_SPLIT
#define MK_SPLIT 0
#endif

#define GAS __attribute__((address_space(1)))
#define LAS __attribute__((address_space(3)))
typedef GAS unsigned gu32;
#define RLX_AGENT __ATOMIC_RELAXED, __HIP_MEMORY_SCOPE_AGENT
typedef unsigned short bf16_t;
typedef short bf16x8 __attribute__((ext_vector_type(8)));
typedef short s16x4 __attribute__((ext_vector_type(4)));
typedef float f32x4 __attribute__((ext_vector_type(4)));
typedef float f32x2 __attribute__((ext_vector_type(2)));
typedef float f32x16 __attribute__((ext_vector_type(16)));
typedef unsigned u32x4 __attribute__((ext_vector_type(4)));
typedef unsigned u32x2 __attribute__((ext_vector_type(2)));
typedef __bf16 bf16x2_t __attribute__((ext_vector_type(2)));

namespace pg8 {
#define PG8_LAS __attribute__((address_space(3)))
constexpr int BM = 256, BK = 64, HALF = 128, HTB = HALF * BK * 2, STAGE_BYTES = 8 * HTB, NXCD = 8, WGM = 8;
__host__ __device__ __forceinline__ int lds_byte(int r, int c) { const int st = (r >> 4) * 2 + (c >> 5), rr = r & 15, cc = c & 31, ob = rr * 64 + cc * 2; return st * 1024 + (ob ^ (((ob >> 9) & 1) << 5)); }
__host__ __device__ __forceinline__ void stage_rc(int b, int& R, int& C) { const int st = b / 1024, sb = b % 1024, swz = sb ^ (((sb >> 9) & 1) << 5); R = (st >> 1) * 16 + swz / 64; C = (st & 1) * 32 + (swz % 64) / 2; }
__host__ __device__ __forceinline__ int perm32(int rho) { const int n = rho >> 4, i = rho & 15; return 8 * (i >> 2) + 4 * n + (i & 3); }
struct Unit { int pm, pn; };
struct Gemm { const bf16_t* A; const bf16_t* Bt; int M, N, K; const int* rowidx; int lda, ldb; };
struct StaticOrder {
    int nM, nN, nwg, G, c;
    __host__ __device__ void init(int M, int N, int G_, int c_) { nM = M / BM; nN = N / BM; nwg = nM * nN; G = G_; c = c_; }
    __host__ __device__ bool next(int i, Unit& u) const {
        const long L = (long)i * G + c; if (L >= nwg) return false;
        int wgid = (int)L; { const int q = nwg / NXCD, r = nwg % NXCD, xcd = wgid % NXCD, off = wgid / NXCD; wgid = (xcd < r ? xcd * (q + 1) : r * (q + 1) + (xcd - r) * q) + off; }
        const int nig = WGM * nN, gid = wgid / nig, fm = gid * WGM, gsz = (nM - fm) < WGM ? (nM - fm) : WGM;
        u.pm = fm + ((wgid % nig) % gsz); u.pn = (wgid % nig) / gsz; return true;
    }
    __device__ __forceinline__ void a_ready(const Unit&) const {}
    __device__ __forceinline__ void done(const Unit&) const {}
};
struct GroupedOrder {
    int nNl, total, G, c;
    __host__ __device__ void init(int nNl_, int G_, int c_) { nNl = nNl_; total = 16 * 8 * nNl_; G = G_; c = c_; }
    __host__ __device__ bool next(int i, Unit& u) const {
        const long L = (long)i * G + c; if (L >= total) return false;
        if (G == 256 && (nNl == 16 || nNl == 4)) {
            const int x = c & 7, w = c >> 3;
            if (nNl == 16) { const int e = 2 * i + (w >> 4), q = w & 15; u.pm = e * 8 + 4 * (x & 1) + (q & 3); u.pn = e * 16 + 4 * (x >> 1) + (q >> 2); }
            else { const int e = 8 * i + x; u.pm = e * 8 + (w & 7); u.pn = e * 4 + (w >> 3); }
            return true;
        }
        const int per_e = 8 * nNl, e = (int)L / per_e, r = (int)L % per_e;
        u.pm = e * 8 + (r % 8); u.pn = e * nNl + (r / 8); return true;
    }
    __device__ __forceinline__ void a_ready(const Unit&) const {}
    __device__ __forceinline__ void done(const Unit&) const {}
};
__device__ __forceinline__ unsigned cvt_pk_bf16(float lo, float hi) { f32x2 v = {lo, hi}; bf16x2_t b = __builtin_convertvector(v, bf16x2_t); return __builtin_bit_cast(unsigned, b); }

struct EpiBf16 {
    static constexpr bool PERM = true, AFTER_DRAIN = false;
    bf16_t* O; int ldc; int ntn;
    __device__ __forceinline__ void operator()(const f32x4 (&acc)[2][2][4][2], const Unit& u, int wr, int wc, int fr, int fq) const {
        const int row0 = u.pm * BM + wr * 64 + fr; const int colt = (u.pn % ntn) * BM;
        const int col0 = colt + wc * 32 + 8 * fq;
#pragma unroll
        for (int ai = 0; ai < 2; ++ai)
#pragma unroll
            for (int m = 0; m < 4; ++m) { bf16_t* rowp = O + (size_t)(row0 + ai * HALF + m * 16) * ldc + col0;
#pragma unroll
                for (int bj = 0; bj < 2; ++bj) { const f32x4 v0 = acc[ai][bj][m][0], v1 = acc[ai][bj][m][1];
                    u32x4 w; w.x = cvt_pk_bf16(v0[0], v0[1]); w.y = cvt_pk_bf16(v0[2], v0[3]); w.z = cvt_pk_bf16(v1[0], v1[1]); w.w = cvt_pk_bf16(v1[2], v1[3]);
                    *(u32x4*)(rowp + bj * HALF) = w; } }
    }
};
struct EpiF32 {
    static constexpr bool PERM = false, AFTER_DRAIN = false;
    float* O; int ldc;
    __device__ __forceinline__ void operator()(const f32x4 (&acc)[2][2][4][2], const Unit& u, int wr, int wc, int fr, int fq) const {
        const int col0 = u.pn * BM + wc * 32 + 4 * fq;
#pragma unroll
        for (int ai = 0; ai < 2; ++ai)
#pragma unroll
            for (int m = 0; m < 4; ++m) { float* rowp = O + (size_t)(u.pm * BM + ai * HALF + wr * 64 + m * 16 + fr) * ldc + col0;
#pragma unroll
                for (int bj = 0; bj < 2; ++bj)
#pragma unroll
                    for (int n = 0; n < 2; ++n) *(f32x4*)(rowp + bj * HALF + n * 16) = acc[ai][bj][m][n]; }
    }
};
__device__ __forceinline__ float silu_f(float a) { return a * __builtin_amdgcn_rcpf(1.0f + __builtin_amdgcn_exp2f(-1.4426950408889634f * a)); }
struct EpiSwiGLU {
    static constexpr bool PERM = true, AFTER_DRAIN = false;
    bf16_t* O; int ldc;
    __device__ __forceinline__ void operator()(const f32x4 (&acc)[2][2][4][2], const Unit& u, int wr, int wc, int fr, int fq) const {
        const int row0 = u.pm * BM + wr * 64 + fr; const int col0 = (u.pn % 16) * HALF + wc * 32 + 8 * fq;
#pragma unroll
        for (int ai = 0; ai < 2; ++ai)
#pragma unroll
            for (int m = 0; m < 4; ++m) { bf16_t* rowp = O + (size_t)(row0 + ai * HALF + m * 16) * ldc + col0;
                const f32x4 g0 = acc[ai][0][m][0], g1 = acc[ai][0][m][1], u0 = acc[ai][1][m][0], u1 = acc[ai][1][m][1];
                u32x4 w;
                w.x = cvt_pk_bf16(silu_f(g0[0]) * u0[0], silu_f(g0[1]) * u0[1]); w.y = cvt_pk_bf16(silu_f(g0[2]) * u0[2], silu_f(g0[3]) * u0[3]);
                w.z = cvt_pk_bf16(silu_f(g1[0]) * u1[0], silu_f(g1[1]) * u1[1]); w.w = cvt_pk_bf16(silu_f(g1[2]) * u1[2], silu_f(g1[3]) * u1[3]);
                *(u32x4*)rowp = w; }
    }
};

template <class Epi, class Sched, bool ALIGN_EPI = false, bool SP2 = false, bool GATHER = false>
__device__ __forceinline__ void gemm_phase(PG8_LAS unsigned char* lds, const Gemm g, const Sched& S, const Epi& E, const int tid) {
    const int wid = __builtin_amdgcn_readfirstlane(tid >> 6), lane = tid & 63, wr = wid >> 2, wc = wid & 3, fr = lane & 15, fq = lane >> 4;
    int K_ = g.K; asm volatile("" : "+s"(K_));
    const int K = K_, nt = K / BK;
    const int lda = g.lda ? g.lda : K, ldb = g.ldb ? g.ldb : K;
    unsigned voffA[2], voffB[2];
#pragma unroll
    for (int i = 0; i < 2; ++i) { int R, C; stage_rc(tid * 16 + i * 8192, R, C); const int Rb = Epi::PERM ? ((R & ~31) + perm32(R & 31)) : R;
        voffA[i] = (unsigned)(R * lda + C) * 2u; voffB[i] = (unsigned)(Rb * ldb + C) * 2u; }
    const size_t kstep = (size_t)(BK * 2);
    const size_t hstepA = (size_t)HALF * lda * 2, hstepB = (size_t)HALF * ldb * 2;
    const size_t tstepA = 2 * hstepA, tstepB = 2 * hstepB;
    const unsigned ldsw = (unsigned)wid * 1024u;
    const int aoff = lds_byte(wr * 64 + fr, fq * 8), boff = lds_byte(wc * 32 + fr, fq * 8);
#define PG8_SA(b, h) (((b) * 2 + (h)) * HTB)
#define PG8_SB(b, h) ((4 + (b) * 2 + (h)) * HTB)
#define PG8_STAGE(bufoff, gbase, voff) do { _Pragma("unroll") for (int _i = 0; _i < 2; ++_i) \
        __builtin_amdgcn_global_load_lds((const unsigned*)((const char*)(gbase) + (voff)[_i]), (PG8_LAS unsigned*)(lds + (bufoff) + ldsw + _i * 8192), 16, 0, 0); } while (0)
#define PG8_LDA(dst, b, h) do { _Pragma("unroll") for (int m = 0; m < 4; ++m) _Pragma("unroll") for (int k = 0; k < 2; ++k) dst[m][k] = *(const PG8_LAS bf16x8*)(lds + PG8_SA(b, h) + aoff + m * 2048 + k * 1024); } while (0)
#define PG8_LDB(dst, b, h) do { _Pragma("unroll") for (int n = 0; n < 2; ++n) _Pragma("unroll") for (int k = 0; k < 2; ++k) dst[n][k] = *(const PG8_LAS bf16x8*)(lds + PG8_SB(b, h) + boff + n * 2048 + k * 1024); } while (0)
#define PG8_MMA(ai, bj, At, Bt) do { __builtin_amdgcn_s_setprio(1); _Pragma("unroll") for (int m = 0; m < 4; ++m) _Pragma("unroll") for (int n = 0; n < 2; ++n) _Pragma("unroll") for (int k = 0; k < 2; ++k) \
        acc[ai][bj][m][n] = __builtin_amdgcn_mfma_f32_16x16x32_bf16(Bt[n][k], At[m][k], acc[ai][bj][m][n], 0, 0, 0); __builtin_amdgcn_s_setprio(0); } while (0)
#define PG8_WAIT_V(n) asm volatile("s_waitcnt vmcnt(" #n ")" ::: "memory")
#define PG8_WAIT_L(n) asm volatile("s_waitcnt lgkmcnt(" #n ")" ::: "memory")
#define PG8_BAR __builtin_amdgcn_s_barrier()
#define PG8_SCHED __builtin_amdgcn_sched_barrier(0)
    Unit cur, nxt; int ui = 0;
    if (!S.next(0, cur)) return;
    f32x4 acc[2][2][4][2];
#pragma unroll
    for (int a = 0; a < 2; ++a)
#pragma unroll
        for (int b = 0; b < 2; ++b)
#pragma unroll
            for (int m = 0; m < 4; ++m)
#pragma unroll
                for (int n = 0; n < 2; ++n) acc[a][b][m][n] = (f32x4){0.f, 0.f, 0.f, 0.f};
    bf16x8 At[4][2], B0[2][2], B1[2][2];
    const char* cA = GATHER ? (const char*)g.A : (const char*)g.A + (size_t)cur.pm * tstepA; const char* cB = (const char*)g.Bt + (size_t)cur.pn * tstepB;
    unsigned gc0[2] = {0u, 0u}, gc1[2] = {0u, 0u}, gn0[2] = {0u, 0u}, gn1[2] = {0u, 0u}; int gR[2] = {0, 0}; unsigned gC[2] = {0u, 0u};
    if constexpr (GATHER) {
#pragma unroll
        for (int i = 0; i < 2; ++i) { int R, C; stage_rc(tid * 16 + i * 8192, R, C); gR[i] = R; gC[i] = (unsigned)C * 2u;
            gc0[i] = (unsigned)g.rowidx[cur.pm * BM + R] * (unsigned)(lda * 2) + gC[i]; gc1[i] = (unsigned)g.rowidx[cur.pm * BM + HALF + R] * (unsigned)(lda * 2) + gC[i]; }
    }
#define PG8_STAGE_A(bufoff, base, half, o0, o1) do { if constexpr (GATHER) { if ((half) == 0) PG8_STAGE(bufoff, base, o0); else PG8_STAGE(bufoff, base, o1); } \
        else PG8_STAGE(bufoff, (base) + ((half) ? hstepA : 0), voffA); } while (0)
    S.a_ready(cur);
    if constexpr (SP2) {
        PG8_STAGE(PG8_SB(0, 0), cB, voffB); PG8_STAGE(PG8_SB(0, 1), cB + hstepB, voffB); PG8_STAGE_A(PG8_SA(0, 0), cA, 0, gc0, gc1); PG8_STAGE_A(PG8_SA(0, 1), cA, 1, gc0, gc1);
        if (wr == 1) PG8_BAR;
        PG8_WAIT_V(2); PG8_BAR;
        PG8_STAGE(PG8_SB(1, 0), cB + kstep, voffB); PG8_STAGE_A(PG8_SA(1, 0), cA + kstep, 0, gc0, gc1); PG8_STAGE(PG8_SB(1, 1), cB + hstepB + kstep, voffB);
        PG8_WAIT_V(6); PG8_BAR;
    } else {
        PG8_STAGE(PG8_SB(0, 0), cB, voffB); PG8_STAGE(PG8_SA(0, 0), cA, voffA); PG8_STAGE(PG8_SB(0, 1), cB + hstepB, voffB); PG8_STAGE(PG8_SA(0, 1), cA + hstepA, voffA);
        if (wr == 1) PG8_BAR;
        PG8_WAIT_V(4); PG8_BAR;
        PG8_STAGE(PG8_SB(1, 0), cB + kstep, voffB); PG8_STAGE(PG8_SA(1, 0), cA + kstep, voffA); PG8_STAGE(PG8_SB(1, 1), cB + hstepB + kstep, voffB);
        PG8_WAIT_V(6); PG8_BAR;
    }
    for (;;) {
        const bool has_next = S.next(ui + 1, nxt);
        const char* nA = GATHER ? cA : (has_next ? (const char*)g.A + (size_t)nxt.pm * tstepA : cA); const char* nB = has_next ? (const char*)g.Bt + (size_t)nxt.pn * tstepB : cB;
        if constexpr (GATHER) { const int npm = has_next ? nxt.pm : cur.pm;
#pragma unroll
            for (int i = 0; i < 2; ++i) { gn0[i] = (unsigned)g.rowidx[npm * BM + gR[i]] * (unsigned)(lda * 2) + gC[i]; gn1[i] = (unsigned)g.rowidx[npm * BM + HALF + gR[i]] * (unsigned)(lda * 2) + gC[i]; } }
        for (int t = 0; t < nt; t += 2) {
            const bool last = (t == nt - 2);
            const char* a1 = cA + (size_t)(t + 1) * kstep;
            const char* a2 = last ? nA : cA + (size_t)(t + 2) * kstep; const char* b2 = last ? nB : cB + (size_t)(t + 2) * kstep;
            const char* a3 = a2 + kstep; const char* b3 = b2 + kstep;
            if (last && has_next) S.a_ready(nxt);
            if constexpr (SP2) {
            unsigned gs0[2], gs1[2];
#pragma unroll
            for (int i = 0; i < 2; ++i) { gs0[i] = last ? gn0[i] : gc0[i]; gs1[i] = last ? gn1[i] : gc1[i]; }
            PG8_LDB(B0, 0, 0); PG8_LDB(B1, 0, 1); PG8_SCHED; PG8_LDA(At, 0, 0); PG8_STAGE_A(PG8_SA(1, 1), a1, 1, gc0, gc1);
            PG8_WAIT_V(8); PG8_WAIT_L(0); PG8_BAR; PG8_MMA(0, 0, At, B0); PG8_MMA(0, 1, At, B1); PG8_BAR; PG8_SCHED;
            PG8_LDA(At, 0, 1); PG8_STAGE(PG8_SB(0, 0), b2, voffB); PG8_STAGE(PG8_SB(0, 1), b2 + hstepB, voffB); PG8_STAGE_A(PG8_SA(0, 0), a2, 0, gs0, gs1);
            PG8_WAIT_V(8); PG8_WAIT_L(0); PG8_BAR; PG8_MMA(1, 0, At, B0); PG8_MMA(1, 1, At, B1); PG8_BAR; PG8_SCHED;
            PG8_LDB(B0, 1, 0); PG8_LDB(B1, 1, 1); PG8_SCHED; PG8_LDA(At, 1, 0); PG8_STAGE_A(PG8_SA(0, 1), a2, 1, gs0, gs1);
            PG8_WAIT_V(8); PG8_WAIT_L(0); PG8_BAR; PG8_MMA(0, 0, At, B0); PG8_MMA(0, 1, At, B1); PG8_BAR; PG8_SCHED;
            PG8_LDA(At, 1, 1); PG8_STAGE(PG8_SB(1, 0), b3, voffB); PG8_STAGE(PG8_SB(1, 1), b3 + hstepB, voffB); PG8_STAGE_A(PG8_SA(1, 0), a3, 0, gs0, gs1);
            PG8_WAIT_V(8); PG8_WAIT_L(0); PG8_BAR; PG8_MMA(1, 0, At, B0); PG8_MMA(1, 1, At, B1); PG8_BAR; PG8_SCHED;
            } else {
            PG8_LDB(B0, 0, 0); PG8_SCHED; PG8_LDA(At, 0, 0); PG8_STAGE(PG8_SA(1, 1), a1 + hstepA, voffA);
            PG8_WAIT_L(8); PG8_BAR; PG8_WAIT_L(0); PG8_MMA(0, 0, At, B0); PG8_BAR; PG8_SCHED;
            PG8_LDB(B1, 0, 1); PG8_STAGE(PG8_SB(0, 0), b2, voffB);
            PG8_BAR; PG8_WAIT_L(0); PG8_MMA(0, 1, At, B1); PG8_BAR;
            PG8_LDA(At, 0, 1); PG8_STAGE(PG8_SA(0, 0), a2, voffA);
            PG8_BAR; PG8_WAIT_L(0); PG8_MMA(1, 0, At, B0); PG8_BAR; PG8_SCHED;
            PG8_STAGE(PG8_SB(0, 1), b2 + hstepB, voffB);
            PG8_WAIT_V(6); PG8_BAR; PG8_MMA(1, 1, At, B1); PG8_BAR;
            PG8_LDB(B0, 1, 0); PG8_SCHED; PG8_LDA(At, 1, 0); PG8_STAGE(PG8_SA(0, 1), a2 + hstepA, voffA);
            PG8_WAIT_L(8); PG8_BAR; PG8_WAIT_L(0); PG8_MMA(0, 0, At, B0); PG8_BAR; PG8_SCHED;
            PG8_LDB(B1, 1, 1); PG8_STAGE(PG8_SB(1, 0), b3, voffB);
            PG8_BAR; PG8_WAIT_L(0); PG8_MMA(0, 1, At, B1); PG8_BAR;
            PG8_LDA(At, 1, 1); PG8_STAGE(PG8_SA(1, 0), a3, voffA);
            PG8_BAR; PG8_WAIT_L(0); PG8_MMA(1, 0, At, B0); PG8_BAR; PG8_SCHED;
            PG8_STAGE(PG8_SB(1, 1), b3 + hstepB, voffB);
            PG8_WAIT_V(6); PG8_BAR; PG8_MMA(1, 1, At, B1); PG8_BAR;
            }
        }
        if constexpr (ALIGN_EPI) { if (wr == 0) PG8_BAR; }
        if constexpr (!Epi::AFTER_DRAIN) { E(acc, cur, wr, wc, fr, fq); S.done(cur); }
        if (!has_next) break;
#pragma unroll
        for (int a = 0; a < 2; ++a)
#pragma unroll
            for (int b = 0; b < 2; ++b)
#pragma unroll
                for (int m = 0; m < 4; ++m)
#pragma unroll
                    for (int n = 0; n < 2; ++n) acc[a][b][m][n] = (f32x4){0.f, 0.f, 0.f, 0.f};
        cur = nxt; cA = nA; cB = nB; ++ui;
        if constexpr (GATHER) { gc0[0] = gn0[0]; gc0[1] = gn0[1]; gc1[0] = gn1[0]; gc1[1] = gn1[1]; }
        if constexpr (ALIGN_EPI) { if (wr == 1) PG8_BAR; }
    }
    PG8_WAIT_V(0);
    if constexpr (!ALIGN_EPI) { if (wr == 0) PG8_BAR; }
    PG8_BAR;
#undef PG8_SA
#undef PG8_SB
#undef PG8_STAGE
#undef PG8_STAGE_A
#undef PG8_LDA
#undef PG8_LDB
#undef PG8_MMA
#undef PG8_WAIT_V
#undef PG8_WAIT_L
#undef PG8_BAR
#undef PG8_SCHED
}
}

__device__ __forceinline__ double rope_kd(int i) {
    switch (i) { case 0: return 0.15915494309189535; case 1: return 0.08949940160889101; case 2: return 0.050329212104487035; case 3: return 0.0283021958306234;
        case 4: return 0.015915494309189534; case 5: return 0.008949940160889102; case 6: return 0.005032921210448704; case 7: return 0.00283021958306234;
        case 8: return 0.0015915494309189536; case 9: return 0.0008949940160889102; case 10: return 0.0005032921210448703; case 11: return 0.00028302195830623395;
        case 12: return 0.00015915494309189535; case 13: return 8.949940160889102e-05; case 14: return 5.0329212104487035e-05; default: return 2.8302195830623396e-05; }
}
__device__ __forceinline__ float rope_frac(int p, int i) {
    const double kd = rope_kd(i); const float kh = (float)kd, kl = (float)(kd - (double)kh), pf = (float)p;
    const float r1 = pf * kh, e1 = __builtin_fmaf(pf, kh, -r1) + pf * kl;
    float fr = (r1 - __builtin_floorf(r1)) + e1;
    return fr - __builtin_floorf(fr);
}
struct EpiMla {
    static constexpr bool PERM = true, AFTER_DRAIN = false;
    bf16_t* Q; bf16_t* KI; bf16_t* VI; const int* pos; float qscale;
    __device__ __forceinline__ void operator()(const f32x4 (&acc)[2][2][4][2], const pg8::Unit& u, int wr, int wc, int fr, int fq) const {
        const int tile = u.pn & 3;
#pragma unroll
        for (int ai = 0; ai < 2; ++ai)
#pragma unroll
            for (int m = 0; m < 4; ++m) {
                int t = u.pm * 256 + ai * 128 + wr * 64 + m * 16 + fr; asm volatile("" : "+v"(t)); const int b = t >> 13, sq = t & 8191;
                if (tile == 1) {
                    const f32x4 v0 = acc[ai][0][m][0], v1 = acc[ai][0][m][1];
                    u32x4 w; w.x = pg8::cvt_pk_bf16(v0[0] * qscale, v0[1] * qscale); w.y = pg8::cvt_pk_bf16(v0[2] * qscale, v0[3] * qscale); w.z = pg8::cvt_pk_bf16(v1[0] * qscale, v1[1] * qscale); w.w = pg8::cvt_pk_bf16(v1[2] * qscale, v1[3] * qscale);
                    *(u32x4*)(Q + ((size_t)(b * 4 + wc) * 8192 + sq) * 96 + 64 + 8 * fq) = w;
                } else {
#pragma unroll
                    for (int bj = 0; bj < 2; ++bj) { const f32x4 v0 = acc[ai][bj][m][0], v1 = acc[ai][bj][m][1];
                        const int h = 2 * bj + (wc >> 1), bh = b * 4 + h;
                        if (tile == 0) { u32x4 w; w.x = pg8::cvt_pk_bf16(v0[0] * qscale, v0[1] * qscale); w.y = pg8::cvt_pk_bf16(v0[2] * qscale, v0[3] * qscale); w.z = pg8::cvt_pk_bf16(v1[0] * qscale, v1[1] * qscale); w.w = pg8::cvt_pk_bf16(v1[2] * qscale, v1[3] * qscale);
                            *(u32x4*)(Q + ((size_t)bh * 8192 + sq) * 96 + 32 * (wc & 1) + 8 * fq) = w; }
                        else { u32x4 w; w.x = pg8::cvt_pk_bf16(v0[0], v0[1]); w.y = pg8::cvt_pk_bf16(v0[2], v0[3]); w.z = pg8::cvt_pk_bf16(v1[0], v1[1]); w.w = pg8::cvt_pk_bf16(v1[2], v1[3]);
                            if (tile == 2) *(u32x4*)(KI + ((size_t)bh * 128 + (sq >> 6)) * 6144 + (4 * (wc & 1) + fq) * 512 + (sq & 63) * 8) = w;
                            else *(u32x4*)(VI + ((size_t)bh * 128 + (sq >> 6)) * 4096 + (wc & 1) * 2048 + (sq & 63) * 32 + 8 * fq) = w; } }
                }
                asm volatile("" ::: "memory");
            }
    }
};

constexpr int NWAVES = 8, NTHR = 512;
constexpr int BATCH = 2, SEQ = 8192, DM = 1024, MTOK = BATCH * SEQ;
constexpr int DIN = 2960, DINP = 3072;
constexpr int NEXP = 16, CAP = 1024, EFF = 2048;
constexpr int LDFF = EFF + 64;
constexpr float EPS = 1e-6f;
constexpr int U_MLQ = 0, U_MLK = 256, U_MLV = 512, U_MLO = 768, U_MLG = 1024, U_CQ = 1040, U_CKV = 1264, U_KR = 1392, U_HY = 1424, U_SC = 2192;
constexpr float LOG2E = 1.4426950408889634f;

constexpr size_t MiB = 1u << 20;
constexpr size_t WS_CTL = 0, CTL_ZERO_BYTES = 1 * MiB;
constexpr size_t WS_MOD = 1 * MiB;
constexpr size_t WS_MLS = 1 * MiB + 128 * 1024;
constexpr size_t WS_MLN = 1 * MiB + 256 * 1024;
constexpr size_t WS_AFF = 2 * MiB;
constexpr size_t WS_SLOT = 3 * MiB;
constexpr size_t WS_IDX = 4 * MiB;
constexpr size_t WS_HID = 5 * MiB;
constexpr size_t WS_W3T = 7 * MiB;
constexpr size_t WS_WMLA = 9 * MiB;
constexpr size_t WS_WOUT = 11 * MiB;
constexpr size_t WS_WIN = 15 * MiB;
constexpr size_t WS_WGU = 28 * MiB;
constexpr size_t WS_WDN = 284 * MiB;
constexpr size_t WS_XN = 616 * MiB;
constexpr size_t WS_AMLA = 444 * MiB;
constexpr size_t WS_Q = 456 * MiB;
constexpr size_t WS_KIMG = 468 * MiB;
constexpr size_t WS_VIMG = 480 * MiB;
constexpr size_t WS_MLC = 488 * MiB;
constexpr size_t WS_HF = 504 * MiB;
constexpr size_t WS_HB = 520 * MiB;
constexpr size_t WS_YATT = 536 * MiB;
constexpr size_t WS_YHT = 544 * MiB;
constexpr size_t WS_YN = 552 * MiB;
constexpr size_t WS_X1 = 584 * MiB;
constexpr size_t WS_U = 648 * MiB;
constexpr size_t WS_OMLA = 744 * MiB;
constexpr size_t WS_ACT = 648 * MiB;
constexpr size_t WS_KF = 776 * MiB;
constexpr size_t WS_Y2 = 776 * MiB;
constexpr size_t WS_XE = 776 * MiB;
constexpr size_t WS_YE = 840 * MiB;
constexpr size_t WS_HYT = 904 * MiB;
constexpr size_t WS_FILT = 956 * MiB;
constexpr size_t WS_END = 1020 * MiB;
constexpr int CW_BAR = 4096;

constexpr int RING_BYTES = 139264;
constexpr int LDSCTL_OFF = RING_BYTES, MISC_OFF = LDSCTL_OFF + 320;
constexpr int XTRA_OFF = RING_BYTES + 1024;
constexpr int LDS_BYTES = 147456;

__device__ __forceinline__ float bf2f(unsigned short u) { return __uint_as_float((unsigned)u << 16); }
__device__ __forceinline__ unsigned pk2(float lo, float hi) { f32x2 v = {lo, hi}; bf16x2_t b = __builtin_convertvector(v, bf16x2_t); return __builtin_bit_cast(unsigned, b); }
__device__ __forceinline__ float bflo(unsigned w) { return __uint_as_float(w << 16); }
__device__ __forceinline__ float bfhi(unsigned w) { return __uint_as_float(w & 0xffff0000u); }
template <int CTRL, int RM = 0xf>
__device__ __forceinline__ float dpp_mov(float old, float v) {
    return __builtin_bit_cast(float, __builtin_amdgcn_update_dpp(__builtin_bit_cast(int, old), __builtin_bit_cast(int, v), CTRL, RM, 0xf, false));
}
__device__ __forceinline__ float row16_sum(float v) {
    v += dpp_mov<0xB1>(v, v); v += dpp_mov<0x4E>(v, v); v += dpp_mov<0x141>(v, v); v += dpp_mov<0x140>(v, v);
    return v;
}
__device__ __forceinline__ float wave_sum(float v) {
    v = row16_sum(v);
    v += dpp_mov<0x142, 0xa>(0.f, v);
    v += dpp_mov<0x143, 0xc>(0.f, v);
    return __builtin_bit_cast(float, __builtin_amdgcn_readlane(__builtin_bit_cast(int, v), 63));
}
__device__ __forceinline__ float fexp(float x) { return __builtin_amdgcn_exp2f(x * LOG2E); }
__device__ __forceinline__ float flog(float x) { return __builtin_amdgcn_logf(x) * 0.6931471805599453f; }
__device__ __forceinline__ float sin_rev(float r) { return __builtin_amdgcn_sinf(r); }
__device__ __forceinline__ float cos_rev(float r) { return __builtin_amdgcn_cosf(r); }
__device__ __forceinline__ float sin_rad(float x) { float r = x * 0.15915494309189535f; r = r - __builtin_rintf(r); return __builtin_amdgcn_sinf(r); }
__device__ __forceinline__ int crow(int r, int hi) { return (r & 3) + 8 * (r >> 2) + 4 * hi; }
#define MFMA32(a, b, c) __builtin_amdgcn_mfma_f32_32x32x16_bf16((a), (b), (c), 0, 0, 0)
#define LDS_WAIT() asm volatile("s_waitcnt lgkmcnt(0)" ::: "memory")
#define VM_WAIT() asm volatile("s_waitcnt vmcnt(0)" ::: "memory")

#define XB_TMO      128
#define XB_XCNT(j)  (256  + 64 * (j))
#define XB_XSUB(j)  (1280 + 64 * (j))
#define XB_XGEN(j)  (2304 + 64 * (j))
#define XB_TOP      3328
#define XB_TOPGEN   3392
#define XCD_BAR_WORDS 3456
#define XB_SPIN_CAP (1u << 18)
__device__ __forceinline__ unsigned xb_ld(unsigned* p)              { return __hip_atomic_load(p, __ATOMIC_RELAXED, __HIP_MEMORY_SCOPE_AGENT); }
__device__ __forceinline__ unsigned xb_add(unsigned* p, unsigned v) { return __hip_atomic_fetch_add(p, v, __ATOMIC_RELAXED, __HIP_MEMORY_SCOPE_AGENT); }
__device__ __forceinline__ unsigned xb_xcc_id() { return (unsigned)__builtin_amdgcn_s_getreg((3 << 11) | 20) & 0xFu; }
#define XB_SPIN(cond, bar) do { unsigned _sp = 0; while (cond) { __builtin_amdgcn_s_sleep(1); \
    if ((++_sp & 255u) == 0u) { if (xb_ld(&(bar)[XB_TMO])) break; if (_sp > XB_SPIN_CAP) { atomicAdd(&(bar)[XB_TMO], 1u); break; } } } } while (0)
struct XcdBarrier { unsigned* bar; unsigned x; volatile LAS unsigned* st; };
__device__ __forceinline__ XcdBarrier xcd_barrier_post(unsigned* bar, volatile LAS unsigned* st) {
    XcdBarrier b; b.bar = bar; b.x = xb_xcc_id(); b.st = st;
    if (threadIdx.x == 0) (void)xb_add(&bar[XB_XCNT(b.x)], 1u);
    return b;
}
__device__ __forceinline__ void xcd_barrier_complete(unsigned* bar, unsigned x, unsigned& nloc, unsigned& nx) {
    const unsigned G = gridDim.x * gridDim.y * gridDim.z;
    unsigned sum, cnt, mine, sp = 0u;
    for (;;) {
        sum = 0u; cnt = 0u; mine = 0u;
#pragma unroll
        for (unsigned j = 0; j < 16; ++j) { const unsigned c = xb_ld(&bar[XB_XCNT(j)]); sum += c; cnt += (c > 0u) ? 1u : 0u; mine = (j == x) ? c : mine; }
        if (sum == G) break;
        __builtin_amdgcn_s_sleep(1);
        if ((++sp & 255u) == 0u) { if (xb_ld(&bar[XB_TMO])) break; if (sp > XB_SPIN_CAP) { atomicAdd(&bar[XB_TMO], 1u); break; } }
    }
    nloc = mine > 0u ? mine : 1u; nx = cnt > 0u ? cnt : 1u;
}
__device__ __forceinline__ void xcd_barrier(const XcdBarrier& b) {
    asm volatile("s_waitcnt vmcnt(0)" ::: "memory");
    __syncthreads();
    if (threadIdx.x == 0) {
        unsigned* bar = b.bar;
        __builtin_amdgcn_s_waitcnt(0);
        unsigned nloc = b.st[0], nx = b.st[1];
        if (nloc == 0u) { xcd_barrier_complete(bar, b.x, nloc, nx); b.st[0] = nloc; b.st[1] = nx; }
        const unsigned old = xb_add(&bar[XB_XSUB(b.x)], 1u);
        const unsigned gen = old / nloc;
        if (old + 1u == (gen + 1u) * nloc) {
            __builtin_amdgcn_fence(__ATOMIC_RELEASE, "agent");
            asm volatile("s_waitcnt vmcnt(0)" ::: "memory");
            const unsigned og = xb_add(&bar[XB_TOP], 1u);
            const unsigned tg = og / nx;
            if (og + 1u != (tg + 1u) * nx) XB_SPIN(xb_ld(&bar[XB_TOP]) < (tg + 1u) * nx, bar);
            xb_add(&bar[XB_XGEN(b.x)], 1u);
            __builtin_amdgcn_fence(__ATOMIC_ACQUIRE, "agent");
            asm volatile("s_waitcnt vmcnt(0)" ::: "memory");
        } else {
            XB_SPIN(xb_ld(&bar[XB_XGEN(b.x)]) == gen, bar);
            __builtin_amdgcn_fence(__ATOMIC_ACQUIRE, "agent");
            asm volatile("s_waitcnt vmcnt(0)" ::: "memory");
        }
    }
    __syncthreads();
}

struct Args { const void* in[35]; float* out; unsigned char* ws; int ph_lo, ph_hi; };
struct Frame {
    LAS unsigned char* lds;
    int tid, lane, wave, vcu, G;
    const Args* a;
    unsigned char* ws;
};
#define INF(i) ((const float*)F.a->in[i])
#define WSP(T, off) ((T*)(F.ws + (off)))

__device__ __forceinline__ void tr_item(const float* W, int ldw, int Kvalid, int Nvalid, int k0, int n0, bf16_t* dst, int dpitch, int drow0, int dk0, LAS float* scr, int lane, int NW = 64) {
    f32x4 v[16];
    const int nn = n0 + 4 * (lane & 15);
#pragma unroll
    for (int i = 0; i < 16; ++i) { const int kk = 4 * i + (lane >> 4);
        v[i] = (f32x4){0.f, 0.f, 0.f, 0.f};
        if (W != nullptr && (k0 + kk) < Kvalid && nn < Nvalid) v[i] = *(const GAS f32x4*)(W + (size_t)(k0 + kk) * ldw + nn); }
#pragma unroll
    for (int i = 0; i < 16; ++i) { const int kk = 4 * i + (lane >> 4);
        *(LAS f32x4*)(scr + kk * 64 + ((4 * (lane & 15)) ^ (4 * ((kk >> 3) & 7)))) = v[i]; }
    LDS_WAIT(); asm volatile("" ::: "memory");
    const int kc = lane & 7, nl = lane >> 3;
#pragma unroll
    for (int j = 0; j < 8; ++j) { const int n = 8 * j + nl; const LAS float* sp = scr + (8 * kc) * 64 + (n ^ (4 * kc));
        u32x4 o; o.x = pk2(sp[0 * 64], sp[1 * 64]); o.y = pk2(sp[2 * 64], sp[3 * 64]); o.z = pk2(sp[4 * 64], sp[5 * 64]); o.w = pk2(sp[6 * 64], sp[7 * 64]);
        if (n < NW) *(GAS u32x4*)(dst + (size_t)(drow0 + n) * dpitch + dk0 + k0 + 8 * kc) = o; }
    LDS_WAIT(); asm volatile("" ::: "memory");
}

__device__ __forceinline__ void p0_phase(Frame& F) {
    const int tid = F.tid, lane = F.lane, wave = F.wave;
    {
        LAS float* cs = (LAS float*)(F.lds);
        LAS float* red = (LAS float*)(F.lds + 8192);
        const float* c = INF(1);
        for (int i = tid; i < 2048; i += NTHR) { const float v = c[i]; cs[i] = v / (1.0f + fexp(-v)); }
        __syncthreads();
        for (int cb = blockIdx.x; cb < 256; cb += F.G) {
            const int j = tid % 48, kg = tid / 48;
            const int col = cb * 48 + j, l = col / 6144, n = col % 6144;
            if (kg < 10) {
                const float* w = INF(3) + (size_t)l * 1024 * 6144 + n;
                float a0 = 0.f, a1 = 0.f;
#pragma unroll 26
                for (int k = kg; k < 1024; k += 10) { const float wv = w[(size_t)k * 6144]; a0 += cs[k] * wv; a1 += cs[1024 + k] * wv; }
                red[(kg * 48 + j) * 2] = a0; red[(kg * 48 + j) * 2 + 1] = a1;
            }
            __syncthreads();
            if (tid < 96) { const int jj = tid >> 1, b = tid & 1; float s = 0.f;
                for (int g = 0; g < 10; ++g) s += red[(g * 48 + jj) * 2 + b];
                const int col2 = cb * 48 + jj, l2 = col2 / 6144, n2 = col2 % 6144;
                WSP(float, WS_MOD)[(l2 * 2 + b) * 6144 + n2] = s + INF(4)[l2 * 6144 + n2]; }
            __syncthreads();
        }
    }
    {
        const int gw = F.vcu * NWAVES + wave, NGW = F.G * NWAVES;
        for (int l = 0; l < 2; ++l) {
            const float* w1 = INF(18) + l * 17 * 64; const float* w2 = INF(21) + l * 64 * 64;
            float w1c[17], w2c[64];
#pragma unroll
            for (int i = 0; i < 17; ++i) w1c[i] = w1[i * 64 + lane];
#pragma unroll
            for (int k = 0; k < 64; ++k) w2c[k] = w2[k * 64 + lane];
            const float b1 = INF(19)[l * 64 + lane], fr1 = INF(20)[l * 64 + lane], b2 = INF(22)[l * 64 + lane], fr2 = INF(23)[l * 64 + lane];
            for (int t = gw; t < SEQ; t += NGW) {
                const float tt = (float)t * (1.0f / SEQ);
                float a = b1 + tt * w1c[0];
#pragma unroll
                for (int bnd = 1; bnd <= 8; ++bnd) { float r = (float)((t * bnd) & (SEQ - 1)) * (1.0f / SEQ); a += sin_rev(r) * w1c[bnd] + cos_rev(r) * w1c[8 + bnd]; }
                const float h1 = sin_rad(fr1 * a);
                float a2 = b2;
#pragma unroll
                for (int k = 0; k < 64; ++k) a2 += __builtin_bit_cast(float, __builtin_amdgcn_readlane(__builtin_bit_cast(int, h1), k)) * w2c[k];
                WSP(bf16_t, WS_HID)[((size_t)l * SEQ + t) * 64 + lane] = (bf16_t)(pk2(sin_rad(fr2 * a2), 0.f) & 0xffffu);
            }
        }
    }
    {
        LAS float* scr = (LAS float*)(F.lds + wave * 16384);
        const int gw = F.vcu * NWAVES + wave, NGW = F.G * NWAVES;
        constexpr int I_WIN = 16 * 48, I_WOUT = 16 * 16, I_WMLA = 6 * 16, I_W3 = 16, I_GU = 16 * 2 * 16 * 32, I_DN = 16 * 32 * 16;
        constexpr int I_LAYER = I_WIN + I_WOUT + I_WMLA + I_W3 + I_GU + I_DN;
        constexpr int I_SMALL = I_WIN + I_WOUT + I_WMLA + I_W3;
        const bool hosted = (F.G == 256) && !MK_SPLIT;
        const int per_layer = hosted ? I_SMALL : I_LAYER;
        for (int it = gw; it < 2 * per_layer; it += NGW) {
            const int l = it / per_layer; int r = it % per_layer;
            if (r < I_WIN) { const int kb = r / 48, nb = r % 48;
                tr_item(INF(9) + (size_t)l * 1024 * DIN, DIN, 1024, DIN, kb * 64, nb * 64, WSP(bf16_t, WS_WIN) + (size_t)l * DINP * 1024, 1024, nb * 64, 0, scr, lane); continue; }
            r -= I_WIN;
            if (r < I_WOUT) { const int kb = r / 16, nb = r % 16;
                tr_item(INF(30) + (size_t)l * 1024 * 1024, 1024, 1024, 1024, kb * 64, nb * 64, WSP(bf16_t, WS_WOUT) + (size_t)l * 1024 * 1024, 1024, nb * 64, 0, scr, lane); continue; }
            r -= I_WOUT;
            if (r < I_WMLA) { const int kb = r / 16, nb = r % 16;
                bf16_t* dst = WSP(bf16_t, WS_WMLA) + (size_t)l * 1024 * 384;
                const float* Wq = INF(13) + (size_t)l * 224 * 384;
                if (nb < 4) { if (kb < 4) tr_item(Wq, 384, 224, nb * 96 + 64, kb * 64, nb * 96, dst, 384, nb * 64, 0, scr, lane); else tr_item(nullptr, 4, 0, 0, 0, 0, dst, 384, nb * 64, kb * 64, scr, lane); }
                else if (nb < 6) { const int h0 = 2 * (nb - 4);
                    if (kb < 4) { tr_item(Wq, 384, 224, h0 * 96 + 96, kb * 64, h0 * 96 + 64, dst, 384, 256 + h0 * 32, 0, scr, lane, 32);
                                  tr_item(Wq, 384, 224, (h0 + 1) * 96 + 96, kb * 64, (h0 + 1) * 96 + 64, dst, 384, 256 + (h0 + 1) * 32, 0, scr, lane, 32); }
                    else tr_item(nullptr, 4, 0, 0, 0, 0, dst, 384, nb * 64, kb * 64, scr, lane); }
                else if (nb < 8) tr_item(nullptr, 4, 0, 0, 0, 0, dst, 384, nb * 64, kb * 64, scr, lane);
                else { const float* W = (nb < 12) ? INF(14) + (size_t)l * 128 * 256 : INF(15) + (size_t)l * 128 * 256; const int nsrc = ((nb - 8) & 3) * 64;
                    if (kb >= 4) tr_item(W, 256, 128, 256, (kb - 4) * 64, nsrc, dst, 384, nb * 64, 256, scr, lane); else tr_item(nullptr, 4, 0, 0, 0, 0, dst, 384, nb * 64, kb * 64, scr, lane); }
                continue; }
            r -= I_WMLA;
            if (r < I_W3) { tr_item(INF(24) + (size_t)l * 64 * 1024, 1024, 64, 1024, 0, r * 64, WSP(bf16_t, WS_W3T) + (size_t)l * 1024 * 64, 64, r * 64, 0, scr, lane); continue; }
            r -= I_W3;
            if (r < I_GU) { const int e = r / (2 * 16 * 32); int q = r % (2 * 16 * 32); const int which = q / (16 * 32); q %= (16 * 32); const int kb = q / 32, nb = q % 32;
                const float* W = INF(which ? 33 : 32) + ((size_t)l * NEXP + e) * 1024 * 2048;
                const int n0 = nb * 64, drow = (n0 >> 7) * 256 + (n0 & 127) + (which ? 128 : 0);
                tr_item(W, 2048, 1024, 2048, kb * 64, n0, WSP(bf16_t, WS_WGU) + ((size_t)l * NEXP + e) * 4096 * 1024, 1024, drow, 0, scr, lane); continue; }
            r -= I_GU;
            { const int e = r / (32 * 16); const int q = r % (32 * 16); const int kb = q / 16, nb = q % 16;
                const float* W = INF(34) + ((size_t)l * NEXP + e) * 2048 * 1024;
                tr_item(W, 1024, 2048, 1024, kb * 64, nb * 64, WSP(bf16_t, WS_WDN) + ((size_t)l * NEXP + e) * 1024 * LDFF, LDFF, nb * 64, 0, scr, lane); }
        }
    }
}

__device__ __forceinline__ void ld_row_f32(const float* p, int lane, f32x4 (&v)[4]) {
    const GAS f32x4* r = (const GAS f32x4*)p + lane;
#pragma unroll
    for (int j = 0; j < 4; ++j) v[j] = r[64 * j];
}
__device__ __forceinline__ void st_row_f32(float* p, int lane, const f32x4 (&v)[4]) {
    GAS f32x4* r = (GAS f32x4*)p + lane;
#pragma unroll
    for (int j = 0; j < 4; ++j) r[64 * j] = v[j];
}
__device__ __forceinline__ void st_row_bf16(bf16_t* p, int lane, const f32x4 (&v)[4]) {
    GAS u32x2* r = (GAS u32x2*)p + lane;
#pragma unroll
    for (int j = 0; j < 4; ++j) { u32x2 w; w.x = pk2(v[j].x, v[j].y); w.y = pk2(v[j].z, v[j].w); r[64 * j] = w; }
}
__device__ __forceinline__ float row_ss(const f32x4 (&v)[4]) {
    float s = 0.f;
#pragma unroll
    for (int j = 0; j < 4; ++j) s += (v[j].x * v[j].x + v[j].y * v[j].y) + (v[j].z * v[j].z + v[j].w * v[j].w);
    return wave_sum(s);
}
__device__ __forceinline__ void modnorm(const f32x4 (&x)[4], const float* g, const float* sc, const float* sh, int lane, f32x4 (&h)[4]) {
    const float rstd = __builtin_amdgcn_rsqf(row_ss(x) * (1.0f / DM) + EPS);
    f32x4 gv[4], scv[4], shv[4];
    ld_row_f32(g, lane, gv); ld_row_f32(sc, lane, scv); ld_row_f32(sh, lane, shv);
#pragma unroll
    for (int j = 0; j < 4; ++j) h[j] = (x[j] * rstd) * gv[j] * (scv[j] + 1.0f) + shv[j];
}

__device__ __forceinline__ void filt_gemm_tile(Frame& F, int wt) {
    const int lane = F.lane, hi = lane >> 5, l31 = lane & 31;
    const int l = wt >> 11, r = wt & 2047, t0 = (r >> 3) * 32, col0 = (r & 7) * 128;
    const bf16_t* hidp = WSP(bf16_t, WS_HID) + ((size_t)l * SEQ + t0 + l31) * 64 + hi * 8;
    const bf16_t* w3p = WSP(bf16_t, WS_W3T) + ((size_t)l * 1024 + col0 + l31) * 64 + hi * 8;
    bf16x8 bfr[4], afr[4][4];
#pragma unroll
    for (int ks = 0; ks < 4; ++ks) { bfr[ks] = *(const GAS bf16x8*)(hidp + 16 * ks);
#pragma unroll
        for (int jb = 0; jb < 4; ++jb) afr[jb][ks] = *(const GAS bf16x8*)(w3p + (size_t)(32 * jb) * 64 + 16 * ks); }
    const float tt = (float)(t0 + l31) * (1.0f / SEQ);
    bf16_t* FTu = WSP(bf16_t, WS_FILT) + ((size_t)l * 1024 + col0) * SEQ + t0;
    const float* b3u = INF(25) + l * 1024 + col0; const float* ldu = INF(26) + l * 1024 + col0;
    const unsigned vo = (unsigned)(4 * hi * SEQ + l31), vc = (unsigned)(4 * hi);
#pragma unroll
    for (int jb = 0; jb < 4; ++jb) {
        f32x16 acc;
#pragma unroll
        for (int q = 0; q < 16; ++q) acc[q] = 0.f;
#pragma unroll
        for (int ks = 0; ks < 4; ++ks) acc = MFMA32(afr[jb][ks], bfr[ks], acc);
#pragma unroll
        for (int q = 0; q < 16; ++q) { const int cq = 32 * jb + (q & 3) + 8 * (q >> 2);
            const float v = (acc[q] + (b3u + cq)[vc]) * fexp(-tt * fexp((ldu + cq)[vc]));
            (FTu + (size_t)cq * SEQ)[vo] = (bf16_t)(pk2(v, 0.f) & 0xffffu); }
        asm volatile("" ::: "memory");
    }
}

__device__ __forceinline__ void p1_phase(Frame& F) {
    const int gw = F.vcu * NWAVES + F.wave, NGW = F.G * NWAVES;
    const float* mod = WSP(float, WS_MOD);
    for (int m = gw; m < MTOK; m += 2 * NGW) {
        const int m2 = (m + NGW < MTOK) ? m + NGW : m; f32x4 xa[4], xb[4], h[4];
        ld_row_f32(INF(0) + (size_t)m * DM, F.lane, xa); ld_row_f32(INF(0) + (size_t)m2 * DM, F.lane, xb);
        { const int b = m >> 13; modnorm(xa, INF(5), mod + (0 * 2 + b) * 6144 + 1024, mod + (0 * 2 + b) * 6144, F.lane, h); st_row_bf16(WSP(bf16_t, WS_XN) + (size_t)m * DM, F.lane, h); }
        { const int b = m2 >> 13; modnorm(xb, INF(5), mod + (0 * 2 + b) * 6144 + 1024, mod + (0 * 2 + b) * 6144, F.lane, h); st_row_bf16(WSP(bf16_t, WS_XN) + (size_t)m2 * DM, F.lane, h); }
    }
    for (int wt = gw; wt < 4096; wt += NGW) filt_gemm_tile(F, wt);
}

__device__ __forceinline__ float wave_scan_add(float v, int lane) {
#pragma unroll
    for (int o = 1; o < 64; o <<= 1) { const float n = __shfl_up(v, o); if (lane >= o) v += n; }
    return v;
}
__device__ __forceinline__ float wave_scan_max(float v, int lane) {
#pragma unroll
    for (int o = 1; o < 64; o <<= 1) { const float n = __shfl_up(v, o); if (lane >= o) v = fmaxf(v, n); }
    return v;
}
__device__ __forceinline__ float wave_max(float v) {
#pragma unroll
    for (int o = 1; o < 64; o <<= 1) v = fmaxf(v, __shfl_xor(v, o));
    return v;
}
__device__ __forceinline__ float logsigmoid(float x) { return fminf(x, 0.f) - flog(1.0f + fexp(-fabsf(x))); }
struct MlItem { int b, h, dir, n, t0; };
__device__ __forceinline__ MlItem ml_decode(int item) { MlItem I; I.b = item >> 9; I.h = (item >> 7) & 3; I.dir = (item >> 6) & 1; I.n = item & 63;
    I.t0 = I.b * SEQ + (I.dir ? SEQ - 128 * (I.n + 1) : 128 * I.n); return I; }

__device__ __forceinline__ void ml_scan(Frame& F) {
    float* MLC = WSP(float, WS_MLC); float* MLN = WSP(float, WS_MLN); float* MLS = WSP(float, WS_MLS);
    for (int blk = blockIdx.x; blk < 256; blk += F.G) { if (F.tid >= 260) continue; const int idx = blk * 260 + F.tid;
        const int seq = idx / 4160, el = idx % 4160;
        float* p0 = el < 4096 ? (MLC + (size_t)seq * 64 * 4096 + el) : (MLN + seq * 64 * 64 + (el - 4096));
        const int pstr = el < 4096 ? 4096 : 64;
        float mst = 0.f, st = 0.f;
#pragma unroll 1
        for (int n0 = 0; n0 < 64; n0 += 32) {
            float cl[32], mlv[32], aev[32];
#pragma unroll
            for (int i = 0; i < 32; ++i) { cl[i] = p0[(size_t)(n0 + i) * pstr]; mlv[i] = MLS[(seq * 64 + n0 + i) * 4]; aev[i] = MLS[(seq * 64 + n0 + i) * 4 + 1]; }
#pragma unroll
            for (int i = 0; i < 32; ++i) { const int item = seq * 64 + n0 + i;
                p0[(size_t)(n0 + i) * pstr] = st;
                if (el == 0) MLS[item * 4 + 2] = mst;
                const float mnew = fmaxf(aev[i] + mst, mlv[i]), sp = fexp(aev[i] + mst - mnew), sl = fexp(mlv[i] - mnew);
                st = sp * st + sl * cl[i]; mst = mnew; }
        }
    }
}

template <int NK>
__device__ __forceinline__ void qkt_tile(f32x16& p0, f32x16& p1, LAS const unsigned char* Kt, const bf16x8 (&qr)[NK], int r32, int hi) {
#pragma unroll
    for (int r = 0; r < 16; ++r) { p0[r] = 0.f; p1[r] = 0.f; }
#pragma unroll
    for (int d0 = 0; d0 < NK; ++d0) {
        const bf16x8 b0 = *(const LAS bf16x8*)(Kt + (2 * d0 + hi) * 1024 + r32 * 16);
        const bf16x8 b1 = *(const LAS bf16x8*)(Kt + (2 * d0 + hi) * 1024 + r32 * 16 + 512);
        p0 = MFMA32(b0, qr[d0], p0); p1 = MFMA32(b1, qr[d0], p1);
    }
}
typedef short v4i16_t __attribute__((ext_vector_type(4)));
__device__ __forceinline__ s16x4 vtr(LAS const unsigned char* p) { return __builtin_bit_cast(s16x4, __builtin_amdgcn_ds_read_tr16_b64_v4i16((LAS v4i16_t*)p)); }
__device__ __forceinline__ void pv_tile(f32x16 (&o)[2], LAS const unsigned char* Vt, const bf16x8 (&pa)[4], int lane) {
    const int hi = lane >> 5;
    LAS const unsigned char* vb = Vt + ((lane >> 4) & 1) * 32 + (lane & 3) * 8 + (4 * hi + ((lane & 15) >> 2)) * 64;
#pragma unroll
    for (int d0 = 0; d0 < 2; ++d0)
#pragma unroll
        for (int ks = 0; ks < 4; ++ks) {
            const s16x4 lo = vtr(vb + d0 * 4096 + ks * 1024), hh = vtr(vb + d0 * 4096 + ks * 1024 + 512);
            const bf16x8 vf = (bf16x8){lo[0], lo[1], lo[2], lo[3], hh[0], hh[1], hh[2], hh[3]};
            o[d0] = MFMA32(pa[ks], vf, o[d0]);
        }
}
__device__ __forceinline__ void pack_p(const f32x16& p0, const f32x16& p1, bf16x8 (&pa)[4]) {
    u32x4 w0, w1, w2, w3;
    w0 = (u32x4){pk2(p0[0], p0[1]), pk2(p0[2], p0[3]), pk2(p0[4], p0[5]), pk2(p0[6], p0[7])};
    w1 = (u32x4){pk2(p0[8], p0[9]), pk2(p0[10], p0[11]), pk2(p0[12], p0[13]), pk2(p0[14], p0[15])};
    w2 = (u32x4){pk2(p1[0], p1[1]), pk2(p1[2], p1[3]), pk2(p1[4], p1[5]), pk2(p1[6], p1[7])};
    w3 = (u32x4){pk2(p1[8], p1[9]), pk2(p1[10], p1[11]), pk2(p1[12], p1[13]), pk2(p1[14], p1[15])};
    pa[0] = __builtin_bit_cast(bf16x8, w0); pa[1] = __builtin_bit_cast(bf16x8, w1); pa[2] = __builtin_bit_cast(bf16x8, w2); pa[3] = __builtin_bit_cast(bf16x8, w3);
}

__device__ __forceinline__ void ml_local_pair(Frame& F, int pair, int l) {
    const int tid = F.tid, lane = F.lane, wid = F.wave, half = wid >> 2, wq = wid & 3, th = tid & 255, hi = lane >> 5;
    const int item = pair * 2 + half; const MlItem I = ml_decode(item);
    const bf16_t* U = WSP(bf16_t, WS_U);
    LAS unsigned char* base = F.lds + half * 49152;
    LAS unsigned char* EKI = base;
    LAS unsigned char* VI = base + 16384;
    LAS float* LF = (LAS float*)(base + 32768); LAS float* IG = LF + 128; LAS float* WW = LF + 256; LAS float* EST = LF + 384;
    const float* gb = INF(10) + l * 16;
    unsigned short graw_i = 0, graw_f = 0;
    if (th < 128) { const int r = I.dir ? 127 - th : th; const size_t t = (size_t)(I.t0 + r);
        graw_i = U[t * DINP + U_MLG + (I.dir ? 2 : 0) * 4 + I.h]; graw_f = U[t * DINP + U_MLG + (I.dir ? 3 : 1) * 4 + I.h]; }
    u32x4 kpc[4], vpc[4];
#pragma unroll
    for (int i = 0; i < 4; ++i) { const int p = th + 256 * i; const int tt = p >> 9, dh = (p >> 8) & 1, row = (p >> 2) & 63, c4 = p & 3, r = 64 * tt + row;
        const bf16_t* src = U + (size_t)(I.t0 + r) * DINP + I.h * 64 + dh * 32 + c4 * 8;
        kpc[i] = *(const GAS u32x4*)(src + U_MLK); vpc[i] = *(const GAS u32x4*)(src + U_MLV); }
    float a = 0.f, aend = 0.f, mloc = -3.0e38f;
    const float lfv = (th < 128) ? logsigmoid(bf2f(graw_f) + gb[(I.dir ? 3 : 1) * 4 + I.h]) : 0.f, igv = (th < 128) ? bf2f(graw_i) + gb[(I.dir ? 2 : 0) * 4 + I.h] : 0.f;
    if (th < 128) { a = wave_scan_add(lfv, lane); if (lane == 63) LF[wq] = a; }
    __syncthreads();
    float wv = 0.f;
    if (th < 128) { aend = LF[0] + LF[1]; if (wq == 1) a += LF[0]; wv = aend - a + igv; const float wm = wave_max(wv); if (lane == 0) IG[wq] = wm; }
    __syncthreads();
    if (th < 128) { mloc = fmaxf(IG[0], IG[1]); const int r = I.dir ? 127 - th : th; EST[r] = fexp(wv - mloc) * 0.125f; }
    __syncthreads();
#pragma unroll
    for (int i = 0; i < 4; ++i) { const int p = th + 256 * i; const int tt = p >> 9, dh = (p >> 8) & 1, row = (p >> 2) & 63, c4 = p & 3, r = 64 * tt + row;
        const u32x4 kq = kpc[i];
        const float es = EST[r];
        u32x4 ek; ek.x = pk2(bflo(kq.x) * es, bfhi(kq.x) * es); ek.y = pk2(bflo(kq.y) * es, bfhi(kq.y) * es); ek.z = pk2(bflo(kq.z) * es, bfhi(kq.z) * es); ek.w = pk2(bflo(kq.w) * es, bfhi(kq.w) * es);
        const int off = tt * 8192 + dh * 4096 + row * 64 + c4 * 16;
        *(LAS u32x4*)(EKI + off) = ek; *(LAS u32x4*)(VI + off) = vpc[i]; }
    __syncthreads();
    {
        const int da = wq >> 1, eb = wq & 1;
        f32x16 acc, nrm;
#pragma unroll
        for (int r = 0; r < 16; ++r) { acc[r] = 0.f; nrm[r] = 0.f; }
        const bf16x8 ones = (bf16x8){(short)0x3F80, (short)0x3F80, (short)0x3F80, (short)0x3F80, (short)0x3F80, (short)0x3F80, (short)0x3F80, (short)0x3F80};
        const int lo_off = ((lane >> 4) & 1) * 32 + (lane & 3) * 8 + (4 * hi + ((lane & 15) >> 2)) * 64;
#pragma unroll
        for (int tt = 0; tt < 2; ++tt)
#pragma unroll
            for (int ks = 0; ks < 4; ++ks) {
                LAS const unsigned char* ap = EKI + tt * 8192 + da * 4096 + lo_off + ks * 1024; LAS const unsigned char* bp = VI + tt * 8192 + eb * 4096 + lo_off + ks * 1024;
                const s16x4 a0 = vtr(ap), a1 = vtr(ap + 512), b0 = vtr(bp), b1 = vtr(bp + 512);
                const bf16x8 af = (bf16x8){a0[0], a0[1], a0[2], a0[3], a1[0], a1[1], a1[2], a1[3]}, bf = (bf16x8){b0[0], b0[1], b0[2], b0[3], b1[0], b1[1], b1[2], b1[3]};
                acc = MFMA32(af, bf, acc);
                if (eb == 0) nrm = MFMA32(af, ones, nrm); }
        float* dst = WSP(float, WS_MLC) + (size_t)item * 4096 + eb * 32 + (lane & 31);
#pragma unroll
        for (int r = 0; r < 16; ++r) dst[(da * 32 + crow(r, hi)) * 64] = acc[r];
        if (eb == 0 && (lane & 31) == 0) {
#pragma unroll
            for (int r = 0; r < 16; ++r) WSP(float, WS_MLN)[item * 64 + da * 32 + crow(r, hi)] = nrm[r]; }
        if (th == 0) { WSP(float, WS_MLS)[item * 4] = mloc; WSP(float, WS_MLS)[item * 4 + 1] = aend; }
    }
    __syncthreads();
}

__device__ __forceinline__ void ml_out_pair(Frame& F, int pair, int l) {
    const int tid = F.tid, lane = F.lane, wid = F.wave, half = wid >> 2, wq = wid & 3, th = tid & 255, r32 = lane & 31, hi = lane >> 5;
    const int item = pair * 2 + half; const MlItem I = ml_decode(item);
    const bf16_t* U = WSP(bf16_t, WS_U);
    LAS unsigned char* base = F.lds + half * 49152;
    LAS unsigned char* KI = base;
    LAS unsigned char* VI = base + 16384;
    LAS unsigned char* CT = base + 32768;
    LAS float* vec = (LAS float*)(base + 32768 + 9216);
    LAS float* LF = vec; LAS float* IG = vec + 128; LAS float* BL = vec + 256; LAS float* SA = vec + 384; LAS float* SCI = vec + 512; LAS float* EDEN = vec + 640;
    LAS float* NPV = vec + 768; LAS float* wsf = vec + 832 + wq * 64;
    const float* gb = INF(10) + l * 16;
    unsigned short graw_i = 0, graw_f = 0; float mprev = 0.f;
    if (th < 128) { const int r = I.dir ? 127 - th : th; const size_t t = (size_t)(I.t0 + r);
        graw_i = U[t * DINP + U_MLG + (I.dir ? 2 : 0) * 4 + I.h]; graw_f = U[t * DINP + U_MLG + (I.dir ? 3 : 1) * 4 + I.h];
        mprev = WSP(float, WS_MLS)[item * 4 + 2]; }
    u32x4 kpc[4], vpc[4];
#pragma unroll
    for (int i = 0; i < 4; ++i) { const int p = th + 256 * i;
        { const int tt = p >> 9, c = (p >> 6) & 7, kv = p & 63, j = 64 * tt + kv, r = I.dir ? 127 - j : j;
          kpc[i] = *(const GAS u32x4*)(U + (size_t)(I.t0 + r) * DINP + U_MLK + I.h * 64 + c * 8); }
        { const int tt = p >> 9, dh = (p >> 8) & 1, kv = (p >> 2) & 63, c4 = p & 3, j = 64 * tt + kv, r = I.dir ? 127 - j : j;
          vpc[i] = *(const GAS u32x4*)(U + (size_t)(I.t0 + r) * DINP + U_MLV + I.h * 64 + dh * 32 + c4 * 8); } }
    float cpv[16];
    { const float* cp = WSP(float, WS_MLC) + (size_t)item * 4096;
#pragma unroll
      for (int i = 0; i < 16; ++i) cpv[i] = cp[th + 256 * i]; }
    const float npv = (th < 64) ? WSP(float, WS_MLN)[item * 64 + th] : 0.f;
    const int q = 32 * wq + r32;
    const int rq = I.dir ? 127 - q : q;
    bf16x8 qr[4];
    { const bf16_t* qp = U + (size_t)(I.t0 + rq) * DINP + U_MLQ + I.h * 64 + hi * 8;
#pragma unroll
      for (int d0 = 0; d0 < 4; ++d0) qr[d0] = *(const GAS bf16x8*)(qp + d0 * 16); }
    const float lfv = (th < 128) ? logsigmoid(bf2f(graw_f) + gb[(I.dir ? 3 : 1) * 4 + I.h]) : 0.f, igv = (th < 128) ? bf2f(graw_i) + gb[(I.dir ? 2 : 0) * 4 + I.h] : 0.f;
    float a = 0.f;
    if (th < 128) { a = wave_scan_add(lfv, lane); if (lane == 63) LF[wq] = a; }
#pragma unroll
    for (int i = 0; i < 4; ++i) { const int p = th + 256 * i;
        { const int tt = p >> 9, c = (p >> 6) & 7, kv = p & 63; *(LAS u32x4*)(KI + tt * 8192 + c * 1024 + kv * 16) = kpc[i]; }
        { const int tt = p >> 9, dh = (p >> 8) & 1, kv = (p >> 2) & 63, c4 = p & 3; *(LAS u32x4*)(VI + tt * 8192 + dh * 4096 + kv * 64 + c4 * 16) = vpc[i]; } }
#pragma unroll
    for (int i = 0; i < 16; ++i) { const int idx = th + 256 * i, d = idx >> 6, e = idx & 63;
        *(LAS unsigned short*)(CT + e * 144 + d * 2) = (unsigned short)(pk2(cpv[i], 0.f) & 0xffffu); }
    if (th < 64) NPV[th] = npv;
    __syncthreads();
    float bv = 0.f, bm = -3.0e38f;
    if (th < 128) { if (wq == 1) a += LF[0]; bv = igv - a; bm = wave_scan_max(bv, lane); if (lane == 63) IG[wq] = bm; }
    __syncthreads();
    if (th < 128) { if (wq == 1) bm = fmaxf(bm, IG[0]);
        const float mt = a + fmaxf(mprev, bm);
        SA[th] = (a - mt) * LOG2E; SCI[th] = fexp(a + mprev - mt); EDEN[th] = fexp(-mt); BL[th] = bv * LOG2E; }
    __syncthreads();
    {
        f32x16 o[2];
#pragma unroll
        for (int r = 0; r < 16; ++r) { o[0][r] = 0.f; o[1][r] = 0.f; }
        const float saq = SA[q], scq = SCI[q];
        float den = 0.f;
        for (int tt = 0; tt < 2; ++tt) {
            if (64 * tt > 32 * wq + 31) break;
            f32x16 p0, p1;
            qkt_tile<4>(p0, p1, KI + tt * 8192, qr, r32, hi);
#pragma unroll
            for (int g = 0; g < 4; ++g) {
                const f32x4 b0 = *(const LAS f32x4*)(BL + 64 * tt + 8 * g + 4 * hi), b1 = *(const LAS f32x4*)(BL + 64 * tt + 32 + 8 * g + 4 * hi);
#pragma unroll
                for (int i = 0; i < 4; ++i) { const int r = 4 * g + i; const int kv0 = 64 * tt + 8 * g + 4 * hi + i, kv1 = kv0 + 32;
                    const float e0 = (kv0 <= q) ? __builtin_amdgcn_exp2f(saq + b0[i]) * 0.125f : 0.f, e1 = (kv1 <= q) ? __builtin_amdgcn_exp2f(saq + b1[i]) * 0.125f : 0.f;
                    p0[r] *= e0; p1[r] *= e1; den += p0[r] + p1[r]; }
            }
            bf16x8 pa[4]; pack_p(p0, p1, pa);
            pv_tile(o, VI + tt * 8192, pa, lane);
        }
        float dot = 0.f;
#pragma unroll
        for (int ks = 0; ks < 4; ++ks) {
            const u32x4 qw = __builtin_bit_cast(u32x4, qr[ks]);
            const f32x4 n0 = *(const LAS f32x4*)(NPV + 16 * ks + 8 * hi), n1 = *(const LAS f32x4*)(NPV + 16 * ks + 8 * hi + 4);
            const float q0 = bflo(qw.x), q1 = bfhi(qw.x), q2 = bflo(qw.y), q3 = bfhi(qw.y), q4 = bflo(qw.z), q5 = bfhi(qw.z), q6 = bflo(qw.w), q7 = bfhi(qw.w);
            dot += q0 * n0[0] + q1 * n0[1] + q2 * n0[2] + q3 * n0[3] + q4 * n1[0] + q5 * n1[1] + q6 * n1[2] + q7 * n1[3];
            const u32x4 sw = (u32x4){pk2(q0 * scq, q1 * scq), pk2(q2 * scq, q3 * scq), pk2(q4 * scq, q5 * scq), pk2(q6 * scq, q7 * scq)};
            const bf16x8 qs = __builtin_bit_cast(bf16x8, sw);
#pragma unroll
            for (int de = 0; de < 2; ++de) {
                const bf16x8 cf = *(const LAS bf16x8*)(CT + (de * 32 + r32) * 144 + (16 * ks + 8 * hi) * 2);
                o[de] = MFMA32(qs, cf, o[de]);
            }
        }
        den += scq * dot;
        den += __shfl_xor(den, 32);
        const float rinv = 1.0f / fmaxf(fabsf(den), EDEN[q]);
        if (hi == 0) wsf[r32] = rinv;
        LDS_WAIT();
        bf16_t* dst = WSP(bf16_t, I.dir ? WS_HB : WS_HF);
#pragma unroll
        for (int r = 0; r < 16; ++r) { const int jq = 32 * wq + crow(r, hi), row = I.dir ? 127 - jq : jq; const float rr = wsf[crow(r, hi)];
            const float a = o[0][r] * rr, c = o[1][r] * rr, an = __shfl_xor(a, 1), cn = __shfl_xor(c, 1);
            const bool odd = (r32 & 1) != 0;
            *(GAS unsigned*)(dst + (size_t)(I.t0 + row) * 256 + I.h * 64 + (odd ? 31 + r32 : r32)) = odd ? pk2(cn, c) : pk2(a, an); }
    }
    __syncthreads();
}

__device__ __forceinline__ double rope_kd_dyn(int i) {
    double r = 0.15915494309189535;
    r = (i == 1) ? 0.08949940160889101 : r; r = (i == 2) ? 0.050329212104487035 : r; r = (i == 3) ? 0.0283021958306234 : r; r = (i == 4) ? 0.015915494309189534 : r;
    r = (i == 5) ? 0.008949940160889102 : r; r = (i == 6) ? 0.005032921210448704 : r; r = (i == 7) ? 0.00283021958306234 : r; r = (i == 8) ? 0.0015915494309189536 : r;
    r = (i == 9) ? 0.0008949940160889102 : r; r = (i == 10) ? 0.0005032921210448703 : r; r = (i == 11) ? 0.00028302195830623395 : r; r = (i == 12) ? 0.00015915494309189535 : r;
    r = (i == 13) ? 8.949940160889102e-05 : r; r = (i == 14) ? 5.0329212104487035e-05 : r; r = (i == 15) ? 2.8302195830623396e-05 : r;
    return r;
}
__device__ __forceinline__ void mla_prep_rows(Frame& F, int l) {
    const int gw = F.vcu * NWAVES + F.wave, NGW = F.G * NWAVES, lane = F.lane;
    const bf16_t* U = WSP(bf16_t, WS_U); bf16_t* A = WSP(bf16_t, WS_AMLA);
    f32x4 gq = {0.f, 0.f, 0.f, 0.f}; if (lane < 56) gq = *(const GAS f32x4*)(INF(11) + l * 224 + 4 * lane);
    const f32x2 gk = *(const GAS f32x2*)(INF(12) + l * 128 + 2 * lane);
    for (int m0 = gw; m0 < MTOK; m0 += 4 * NGW) {
        u32x2 qw[4]; unsigned kw[4];
#pragma unroll
        for (int r = 0; r < 4; ++r) { const int m = m0 + r * NGW; const bf16_t* ur = U + (size_t)(m < MTOK ? m : 0) * DINP;
            qw[r] = (u32x2){0u, 0u}; if (lane < 56) qw[r] = *(const GAS u32x2*)(ur + U_CQ + 4 * lane);
            kw[r] = *(const GAS unsigned*)(ur + U_CKV + 2 * lane); }
#pragma unroll
        for (int r = 0; r < 4; ++r) { const int m = m0 + r * NGW; if (m >= MTOK) break;
            const float q0 = bflo(qw[r].x), q1 = bfhi(qw[r].x), q2 = bflo(qw[r].y), q3 = bfhi(qw[r].y), k0 = bflo(kw[r]), k1 = bfhi(kw[r]);
            const float rq = __builtin_amdgcn_rsqf(wave_sum(q0 * q0 + q1 * q1 + q2 * q2 + q3 * q3) * (1.0f / 224.0f) + EPS);
            const float rk = __builtin_amdgcn_rsqf(wave_sum(k0 * k0 + k1 * k1) * (1.0f / 128.0f) + EPS);
            bf16_t* ar = A + (size_t)m * 384;
            u32x2 qo; qo.x = pk2(q0 * rq * gq.x, q1 * rq * gq.y); qo.y = pk2(q2 * rq * gq.z, q3 * rq * gq.w);
            *(GAS u32x2*)(ar + 4 * lane) = qo;
            *(GAS unsigned*)(ar + 256 + 2 * lane) = pk2(k0 * rk * gk.x, k1 * rk * gk.y); }
    }
    const int* pos = (const int*)F.a->in[2];
    for (int m0 = gw; m0 < MTOK; m0 += 4 * NGW) {
        unsigned short x1r[4], x2r[4]; int pv[4];
#pragma unroll
        for (int r = 0; r < 4; ++r) { const int m = (m0 + r * NGW < MTOK) ? m0 + r * NGW : m0; x1r[r] = 0; x2r[r] = 0; pv[r] = 0;
            if (lane < 16) { x1r[r] = U[(size_t)m * DINP + U_KR + lane]; x2r[r] = U[(size_t)m * DINP + U_KR + 16 + lane]; pv[r] = pos[m]; } }
#pragma unroll
        for (int r = 0; r < 4; ++r) { const int m = m0 + r * NGW; if (m >= MTOK) break;
            if (lane < 16) { const int b = m >> 13, sq = m & 8191;
                double rev = (double)pv[r] * rope_kd_dyn(lane); rev -= __builtin_floor(rev);
                const float rr = (float)rev, c = cos_rev(rr), sn = sin_rev(rr), x1 = bf2f(x1r[r]), x2 = bf2f(x2r[r]);
                const unsigned short o1 = (unsigned short)(pk2(x1 * c - x2 * sn, 0.f) & 0xffffu), o2 = (unsigned short)(pk2(x2 * c + x1 * sn, 0.f) & 0xffffu);
#pragma unroll
                for (int h = 0; h < 4; ++h) { bf16_t* kd = WSP(bf16_t, WS_KIMG) + ((size_t)(b * 4 + h) * 128 + (sq >> 6)) * 6144 + (sq & 63) * 8;
                    kd[(8 + (lane >> 3)) * 512 + (lane & 7)] = o1; kd[(10 + (lane >> 3)) * 512 + (lane & 7)] = o2; } } }
    }
}

__device__ __forceinline__ void att_iter(int tk, int tv, const LAS unsigned char* __restrict__ kread, LAS unsigned char* __restrict__ kdma,
                                         const LAS unsigned char* __restrict__ vread, LAS unsigned char* __restrict__ vdma, LAS float* __restrict__ wsf,
                                         const GAS u32x4* Kg, const GAS u32x4* Vg, int tid, int wid, bool kx, int hi, int r32, int vboff,
                                         const bf16x8 (&qr)[6], f32x16& s0, f32x16& s1, f32x16 (&o)[2], f32x16& nm, float& m, float& lsum) {
    __builtin_amdgcn_global_load_lds((const unsigned*)(Kg + tk * 768 + tid), (LAS unsigned*)(kdma + wid * 1024), 16, 0, 0);
    if (kx) __builtin_amdgcn_global_load_lds((const unsigned*)(Kg + tk * 768 + 512 + tid), (LAS unsigned*)(kdma + 8192 + wid * 1024), 16, 0, 0);
    __builtin_amdgcn_global_load_lds((const unsigned*)(Vg + tv * 512 + tid), (LAS unsigned*)(vdma + wid * 1024), 16, 0, 0);
    const LAS unsigned char* Kt = kread + hi * 1024 + r32 * 16;
    bf16x8 kf[12];
#pragma unroll
    for (int d0 = 0; d0 < 6; ++d0) { kf[2 * d0] = *(const LAS bf16x8*)(Kt + d0 * 2048); kf[2 * d0 + 1] = *(const LAS bf16x8*)(Kt + d0 * 2048 + 512); }
#pragma unroll
    for (int r = 0; r < 16; ++r) { s0[r] = __builtin_amdgcn_exp2f(s0[r]); s1[r] = __builtin_amdgcn_exp2f(s1[r]); }
    { float ls_ = 0.f;
#pragma unroll
      for (int r = 0; r < 16; ++r) ls_ += s0[r] + s1[r];
      lsum += ls_; }
    bf16x8 pa[4]; pack_p(s0, s1, pa);
    f32x16 n0, n1;
    n0 = MFMA32(kf[0], qr[0], nm); n1 = MFMA32(kf[1], qr[0], nm);
#pragma unroll
    for (int d0 = 1; d0 < 6; ++d0) { n0 = MFMA32(kf[2 * d0], qr[d0], n0); n1 = MFMA32(kf[2 * d0 + 1], qr[d0], n1); }
    const LAS unsigned char* vb = vread + vboff;
#pragma unroll
    for (int ks = 0; ks < 4; ++ks) {
#pragma unroll
        for (int d0 = 0; d0 < 2; ++d0) {
            const s16x4 lo = vtr((LAS const unsigned char*)(vb + d0 * 4096 + ks * 1024)), hh = vtr((LAS const unsigned char*)(vb + d0 * 4096 + ks * 1024 + 512));
            const bf16x8 vf = (bf16x8){lo[0], lo[1], lo[2], lo[3], hh[0], hh[1], hh[2], hh[3]};
            o[d0] = MFMA32(pa[ks], vf, o[d0]); } }
    float rm = fmaxf(fmaxf(n0[0], n1[0]), fmaxf(n0[1], n1[1]));
#pragma unroll
    for (int r = 2; r < 16; r += 2) rm = fmaxf(fmaxf(rm, n0[r]), fmaxf(n1[r], fmaxf(n0[r + 1], n1[r + 1])));
    rm = fmaxf(rm, __shfl_xor(rm, 32));
#pragma unroll
    for (int i = 0; i < 6; ++i) { __builtin_amdgcn_sched_group_barrier(0x008, 2, 0); __builtin_amdgcn_sched_group_barrier(0x002, 6, 0); }
    if (__any(rm > 8.0f)) {
        const float dl = fmaxf(rm, 0.f), f = __builtin_amdgcn_exp2f(-dl);
        m += dl; lsum *= f;
#pragma unroll
        for (int r = 0; r < 16; ++r) { n0[r] -= dl; n1[r] -= dl; nm[r] = -m; }
        if (hi == 0) wsf[r32] = f;
        LDS_WAIT();
#pragma unroll
        for (int r = 0; r < 16; ++r) { const float fr = wsf[crow(r, hi)]; o[0][r] *= fr; o[1][r] *= fr; }
    }
    if (kx) asm volatile("s_waitcnt vmcnt(3)" ::: "memory"); else asm volatile("s_waitcnt vmcnt(2)" ::: "memory");
    __syncthreads();
    s0 = n0; s1 = n1;
}
__device__ __forceinline__ void attn_unit(Frame& F, int bh, int qb) {
    const int tid = F.tid, lane = F.lane, wid = F.wave, r32 = lane & 31, hi = lane >> 5;
    LAS unsigned char* KB = F.lds;
    LAS unsigned char* VB = F.lds + 36864;
    LAS float* wsf = (LAS float*)(F.lds + 61440) + wid * 64;
    const int b = bh >> 2, h = bh & 3;
    const bf16_t* Qp = WSP(bf16_t, WS_Q) + ((size_t)bh * SEQ + qb * 256 + wid * 32 + r32) * 96 + hi * 8;
    bf16x8 qr[6];
#pragma unroll
    for (int d0 = 0; d0 < 6; ++d0) qr[d0] = *(const GAS bf16x8*)(Qp + d0 * 16);
    {
        const int p = ((const int*)F.a->in[2])[(size_t)(bh >> 2) * SEQ + qb * 256 + wid * 32 + r32];
        const u32x4 a = __builtin_bit_cast(u32x4, qr[4]), c = __builtin_bit_cast(u32x4, qr[5]);
        const unsigned aw[4] = {a.x, a.y, a.z, a.w}, cw[4] = {c.x, c.y, c.z, c.w}; unsigned ao[4], co[4];
#pragma unroll
        for (int j2 = 0; j2 < 4; ++j2) { float x1a = bflo(aw[j2]), x1b = bfhi(aw[j2]), x2a = bflo(cw[j2]), x2b = bfhi(cw[j2]);
            const float ra = hi ? rope_frac(p, 8 + 2 * j2) : rope_frac(p, 2 * j2), rb = hi ? rope_frac(p, 9 + 2 * j2) : rope_frac(p, 1 + 2 * j2);
            const float ca = cos_rev(ra), sa = sin_rev(ra), cb = cos_rev(rb), sb = sin_rev(rb);
            ao[j2] = pk2(x1a * ca - x2a * sa, x1b * cb - x2b * sb); co[j2] = pk2(x2a * ca + x1a * sa, x2b * cb + x1b * sb); }
        qr[4] = __builtin_bit_cast(bf16x8, (u32x4){ao[0], ao[1], ao[2], ao[3]}); qr[5] = __builtin_bit_cast(bf16x8, (u32x4){co[0], co[1], co[2], co[3]});
    }
    const GAS u32x4* Kg = (const GAS u32x4*)(WSP(bf16_t, WS_KIMG) + (size_t)bh * 128 * 6144);
    const GAS u32x4* Vg = (const GAS u32x4*)(WSP(bf16_t, WS_VIMG) + (size_t)bh * 128 * 4096);
    const bool kx = wid < 4;
#define ATT_DMA_K(TILE, BUF) do { __builtin_amdgcn_global_load_lds((const unsigned*)(Kg + (TILE) * 768 + tid), (LAS unsigned*)(KB + (BUF) * 12288 + wid * 1024), 16, 0, 0); \
        if (kx) __builtin_amdgcn_global_load_lds((const unsigned*)(Kg + (TILE) * 768 + 512 + tid), (LAS unsigned*)(KB + (BUF) * 12288 + 8192 + wid * 1024), 16, 0, 0); } while (0)
#define ATT_DMA_V(TILE, BUF) __builtin_amdgcn_global_load_lds((const unsigned*)(Vg + (TILE) * 512 + tid), (LAS unsigned*)(VB + (BUF) * 8192 + wid * 1024), 16, 0, 0)
    ATT_DMA_K(0, 0); ATT_DMA_K(1, 1); ATT_DMA_K(2, 2); ATT_DMA_V(0, 0); ATT_DMA_V(1, 1);
    asm volatile("s_waitcnt vmcnt(0)" ::: "memory");
    __syncthreads();
    f32x16 s0, s1;
    qkt_tile<6>(s0, s1, KB, qr, r32, hi);
    __syncthreads();
    f32x16 o[2]; float lsum = 0.f;
#pragma unroll
    for (int r = 0; r < 16; ++r) { o[0][r] = 0.f; o[1][r] = 0.f; }
    float m;
    { float rm = fmaxf(fmaxf(s0[0], s1[0]), fmaxf(s0[1], s1[1]));
#pragma unroll
      for (int r = 2; r < 16; r += 2) rm = fmaxf(fmaxf(rm, s0[r]), fmaxf(s1[r], fmaxf(s0[r + 1], s1[r + 1])));
      m = fmaxf(rm, __shfl_xor(rm, 32));
#pragma unroll
      for (int r = 0; r < 16; ++r) { s0[r] -= m; s1[r] -= m; } }
    f32x16 nm;
#pragma unroll
    for (int r = 0; r < 16; ++r) nm[r] = -m;
    LAS const unsigned char* vbl = VB + ((lane >> 4) & 1) * 32 + (lane & 3) * 8 + (4 * hi + ((lane & 15) >> 2)) * 64;
    const int vboff = ((lane >> 4) & 1) * 32 + (lane & 3) * 8 + (4 * hi + ((lane & 15) >> 2)) * 64;
#define ATT_ITER(T, KR, KD, VR, VD) do { const int t_ = (T); \
        att_iter((t_ + 3 < 128) ? t_ + 3 : 127, (t_ + 2 < 128) ? t_ + 2 : 127, KB + (KR) * 12288, KB + (KD) * 12288, VB + (VR) * 8192, VB + (VD) * 8192, wsf, \
                 Kg, Vg, tid, wid, kx, hi, r32, vboff, qr, s0, s1, o, nm, m, lsum); } while (0)
#pragma unroll 1
    for (int t3 = 0; t3 < 126; t3 += 3) {
        ATT_ITER(t3, 1, 0, 0, 2);
        ATT_ITER(t3 + 1, 2, 1, 1, 0);
        ATT_ITER(t3 + 2, 0, 2, 2, 1);
    }
    ATT_ITER(126, 1, 0, 0, 2);
    ATT_ITER(127, 2, 1, 1, 0);
    asm volatile("s_waitcnt vmcnt(0)" ::: "memory");
#undef ATT_ITER
#undef ATT_DMA_K
#undef ATT_DMA_V
    lsum += __shfl_xor(lsum, 32);
    if (hi == 0) wsf[r32] = 1.0f / lsum;
    LDS_WAIT();
    bf16_t* Y = WSP(bf16_t, WS_YATT);
#pragma unroll
    for (int r = 0; r < 16; ++r) { const float rl = wsf[crow(r, hi)]; const int q = qb * 256 + wid * 32 + crow(r, hi);
        const float a = o[0][r] * rl, c = o[1][r] * rl, an = __shfl_xor(a, 1), cn = __shfl_xor(c, 1);
        const bool odd = (r32 & 1) != 0;
        const unsigned w = odd ? pk2(cn, c) : pk2(a, an);
        *(GAS unsigned*)(Y + ((size_t)b * SEQ + q) * 256 + h * 64 + (odd ? 31 + r32 : r32)) = w; }
    __syncthreads();
}

#define PX(e) ((e) + ((e) >> 5))
__device__ __forceinline__ f32x2 pk_cmul(f32x2 a, f32x2 w) {
    f32x2 t, r;
    asm("v_pk_mul_f32 %0, %1, %2 op_sel_hi:[1,0]" : "=v"(t) : "v"(a), "v"(w));
    asm("v_pk_fma_f32 %0, %1, %2, %3 op_sel:[1,1,0] op_sel_hi:[0,1,1] neg_lo:[1,0,0]" : "=v"(r) : "v"(a), "v"(w), "v"(t));
    return r;
}
__device__ __forceinline__ f32x2 pk_cmulc(f32x2 a, f32x2 w) {
    f32x2 t, r;
    asm("v_pk_mul_f32 %0, %1, %2 op_sel_hi:[1,0]" : "=v"(t) : "v"(a), "v"(w));
    asm("v_pk_fma_f32 %0, %1, %2, %3 op_sel:[1,1,0] op_sel_hi:[0,1,1] neg_hi:[1,0,0]" : "=v"(r) : "v"(a), "v"(w), "v"(t));
    return r;
}
__device__ __forceinline__ f32x2 pk_sub_i(f32x2 b, f32x2 d) {
    f32x2 r; asm("v_pk_add_f32 %0, %1, %2 op_sel:[0,1] op_sel_hi:[1,0] neg_hi:[0,1]" : "=v"(r) : "v"(b), "v"(d)); return r;
}
__device__ __forceinline__ f32x2 pk_add_i(f32x2 b, f32x2 d) {
    f32x2 r; asm("v_pk_add_f32 %0, %1, %2 op_sel:[0,1] op_sel_hi:[1,0] neg_lo:[0,1]" : "=v"(r) : "v"(b), "v"(d)); return r;
}
__device__ __forceinline__ void bf4_fwd(f32x2& x0, f32x2& x1, f32x2& x2, f32x2& x3, f32x2 w1, f32x2 w2, f32x2 w3) {
    const f32x2 a = x0 + x2, b = x0 - x2, c = x1 + x3, d = x1 - x3;
    x0 = a + c;
    x1 = pk_cmul(pk_sub_i(b, d), w1);
    x2 = pk_cmul(a - c, w2);
    x3 = pk_cmul(pk_add_i(b, d), w3);
}
__device__ __forceinline__ void bf4_inv(f32x2& x0, f32x2& x1, f32x2& x2, f32x2& x3, f32x2 w1, f32x2 w2, f32x2 w3) {
    const f32x2 t1 = pk_cmul(x1, w1), t2 = pk_cmul(x2, w2), t3 = pk_cmul(x3, w3);
    const f32x2 a = x0 + t2, b = x0 - t2, c = t1 + t3, d = t1 - t3;
    x0 = a + c; x2 = a - c;
    x1 = pk_add_i(b, d);
    x3 = pk_sub_i(b, d);
}
template <bool INV>
__device__ __forceinline__ void fft_r4_last(LAS f32x2* X, int tid) {
#pragma unroll 2
    for (int i = 0; i < 8; ++i) { int base = 4 * (tid + 512 * i); asm volatile("" : "+v"(base));
        LAS f32x2* xp = X + PX(base);
        const f32x2 x0 = xp[0], x1 = xp[1], x2 = xp[2], x3 = xp[3];
        const f32x2 a = x0 + x2, b = x0 - x2, c = x1 + x3, d = x1 - x3;
        xp[0] = a + c; xp[2] = a - c;
        if (!INV) { xp[1] = pk_sub_i(b, d); xp[3] = pk_add_i(b, d); } else { xp[1] = pk_add_i(b, d); xp[3] = pk_sub_i(b, d); } }
    __syncthreads();
}
template <bool INV>
__device__ __forceinline__ void r16_core(f32x2 (&x)[16], int j, float r16) {
    const float ang = (float)j * r16, sg = INV ? 1.0f : -1.0f;
    f32x2 w0; w0.x = cos_rev(ang); w0.y = INV ? sin_rev(ang) : -sin_rev(ang);
    asm("s_nop 0" : "+v"(w0));
    const f32x2 w0_2 = pk_cmul(w0, w0), wb = pk_cmul(w0_2, w0_2), wb2 = pk_cmul(wb, wb), wb3 = pk_cmul(wb2, wb);
    if (INV) {
#pragma unroll
        for (int k = 0; k < 4; ++k) bf4_inv(x[4 * k], x[4 * k + 1], x[4 * k + 2], x[4 * k + 3], wb, wb2, wb3);
    }
#pragma unroll
    for (int r = 0; r < 4; ++r) {
        f32x2 w1, w2;
        if (r == 0) { w1 = w0; w2 = w0_2; }
        else { const f32x2 cr = r == 1 ? (f32x2){0.92387953251f, sg * 0.38268343237f} : r == 2 ? (f32x2){0.70710678119f, sg * 0.70710678119f} : (f32x2){0.38268343237f, sg * 0.92387953251f};
            w1 = pk_cmul(w0, cr); w2 = pk_cmul(w1, w1); }
        const f32x2 w3 = pk_cmul(w2, w1);
        if (!INV) bf4_fwd(x[r], x[r + 4], x[r + 8], x[r + 12], w1, w2, w3); else bf4_inv(x[r], x[r + 4], x[r + 8], x[r + 12], w1, w2, w3);
    }
    if (!INV) {
#pragma unroll
        for (int k = 0; k < 4; ++k) bf4_fwd(x[4 * k], x[4 * k + 1], x[4 * k + 2], x[4 * k + 3], wb, wb2, wb3);
    }
}
template <bool INV, int LQ>
__device__ __forceinline__ void fft_r16_pass(LAS f32x2* X, int tid) {
    constexpr int qp = 1 << LQ;
    const float r16 = 1.0f / (float)(16 * qp);
    int nrep = 2; asm volatile("" : "+s"(nrep));
#pragma unroll 1
    for (int i = 0; i < nrep; ++i) {
        int u = tid + 512 * i; asm volatile("" : "+v"(u)); const int j = u & (qp - 1), base = ((u >> LQ) << (LQ + 4)) + j;
        LAS f32x2* xp = X + PX(base);
        constexpr int ST = LQ >= 5 ? qp + (qp >> 5) : 4;
        LAS f32x2* xh = xp + 8 * ST + (LQ >= 5 ? 0 : 1); asm volatile("" : "+v"(xh));
        f32x2 x[16];
#pragma unroll
        for (int r = 0; r < 16; ++r) x[r] = (r < 8 ? xp : xh)[(r & 7) * ST];
        r16_core<INV>(x, j, r16);
#pragma unroll
        for (int r = 0; r < 16; ++r) (r < 8 ? xp : xh)[(r & 7) * ST] = x[r];
    }
    __syncthreads();
}
__device__ __forceinline__ int drev4(int x) { unsigned y = __builtin_bitreverse32((unsigned)x) >> 18; return (int)(((y & 0x2AAAu) >> 1) | ((y & 0x1555u) << 1)); }
__device__ __forceinline__ float block_sum(Frame& F, float v, LAS float* red) {
    v = wave_sum(v);
    if (F.lane == 0) red[F.wave] = v;
    __syncthreads();
    float s = 0.f;
#pragma unroll
    for (int w = 0; w < NWAVES; ++w) s += red[w];
    __syncthreads();
    return s;
}
__device__ __forceinline__ void conv_mi_addr(Frame& F, int l, int mi, int lane, const float*& src, int& ldw, bf16_t*& dst, int& dp) {
    const int kg = lane >> 3, jn = lane & 7;
    if (mi < 32768) { const int which = mi >> 14, i = mi & 16383, e = i >> 10, r = i & 1023, kb = r >> 6, nb = r & 63, n0 = nb * 32;
        ldw = 2048; dp = 1024;
        src = INF(which ? 33 : 32) + ((size_t)l * NEXP + e) * 1024 * 2048 + (size_t)(kb * 64 + 8 * kg) * 2048 + n0 + 4 * jn;
        const int drow = (n0 >> 7) * 256 + (n0 & 127) + (which ? 128 : 0) + 4 * jn;
        dst = WSP(bf16_t, WS_WGU) + ((size_t)l * NEXP + e) * 4096 * 1024 + (size_t)drow * 1024 + kb * 64 + 8 * kg;
    } else { const int i = mi - 32768, e = i >> 10, r = i & 1023, kb = r >> 5, nb = r & 31, n0 = nb * 32;
        ldw = 1024; dp = LDFF;
        src = INF(34) + ((size_t)l * NEXP + e) * 2048 * 1024 + (size_t)(kb * 64 + 8 * kg) * 1024 + n0 + 4 * jn;
        dst = WSP(bf16_t, WS_WDN) + ((size_t)l * NEXP + e) * 1024 * LDFF + (size_t)(n0 + 4 * jn) * LDFF + kb * 64 + 8 * kg;
    }
}
__device__ __forceinline__ void conv_mi_issue(f32x4 (&v)[8], const float* src, int ldw) {
#pragma unroll
    for (int r = 0; r < 8; ++r) v[r] = *(const GAS f32x4*)(src + (size_t)r * ldw);
}
__device__ __forceinline__ void conv_mi_finish(const f32x4 (&v)[8], bf16_t* dst, int dp) {
#pragma unroll
    for (int c = 0; c < 4; ++c) { u32x4 o; o.x = pk2(v[0][c], v[1][c]); o.y = pk2(v[2][c], v[3][c]); o.z = pk2(v[4][c], v[5][c]); o.w = pk2(v[6][c], v[7][c]);
        *(GAS u32x4*)(dst + (size_t)c * dp) = o; }
}
constexpr int CONV_PER_BAR = 1792, CONV_NB0 = 9, CONV_NB1 = 10;
__device__ __forceinline__ int conv_r0(int l) { return 40960 - (l == 0 ? CONV_NB0 : CONV_NB1) * CONV_PER_BAR; }
__device__ __forceinline__ void xcd_barrier_conv(const XcdBarrier& b, Frame& F, int l, int mi_base) {
    asm volatile("s_waitcnt vmcnt(0)" ::: "memory");
    __syncthreads();
    const int wv = __builtin_amdgcn_readfirstlane(threadIdx.x >> 6);
    if (wv != 0) {
        int t_ = threadIdx.x; asm volatile("" : "+v"(t_)); const int lane = t_ & 63;
        f32x4 cv[8]; const float* cs; bf16_t* cd; int cl, cp;
        conv_mi_addr(F, l, mi_base + F.vcu * 7 + (wv - 1), lane, cs, cl, cd, cp); conv_mi_issue(cv, cs, cl); conv_mi_finish(cv, cd, cp);
    } else if (threadIdx.x == 0) {
        unsigned* bar = b.bar;
        __builtin_amdgcn_s_waitcnt(0);
        unsigned nloc = b.st[0], nx = b.st[1];
        if (nloc == 0u) { xcd_barrier_complete(bar, b.x, nloc, nx); b.st[0] = nloc; b.st[1] = nx; }
        const unsigned old = xb_add(&bar[XB_XSUB(b.x)], 1u);
        const unsigned gen = old / nloc;
        if (old + 1u == (gen + 1u) * nloc) {
            __builtin_amdgcn_fence(__ATOMIC_RELEASE, "agent");
            asm volatile("s_waitcnt vmcnt(0)" ::: "memory");
            const unsigned og = xb_add(&bar[XB_TOP], 1u);
            const unsigned tg = og / nx;
            if (og + 1u != (tg + 1u) * nx) XB_SPIN(xb_ld(&bar[XB_TOP]) < (tg + 1u) * nx, bar);
            xb_add(&bar[XB_XGEN(b.x)], 1u);
            __builtin_amdgcn_fence(__ATOMIC_ACQUIRE, "agent");
            asm volatile("s_waitcnt vmcnt(0)" ::: "memory");
        } else {
            XB_SPIN(xb_ld(&bar[XB_XGEN(b.x)]) == gen, bar);
            __builtin_amdgcn_fence(__ATOMIC_ACQUIRE, "agent");
            asm volatile("s_waitcnt vmcnt(0)" ::: "memory");
        }
    }
    __syncthreads();
}
__device__ __forceinline__ void hyena_item(Frame& F, int c_in, int l) {
    int c = c_in; asm volatile("" : "+s"(c));
    const int tid = F.tid;
    LAS f32x2* X = (LAS f32x2*)F.lds;
    LAS float* red = (LAS float*)(F.lds + XTRA_OFF);
    const bool hosted = (F.G == 256) && !MK_SPLIT;
    constexpr int HY_ACT = 5;
    const int mi0 = F.vcu * HY_ACT; int cm = 0;
#define HY_PASS(CALL) do { f32x4 cv_[8]; const float* cs_ = nullptr; bf16_t* cd_ = nullptr; int cl_ = 0, cp_ = 0; \
        _Pragma("unroll") for (int r_ = 0; r_ < 8; ++r_) cv_[r_] = (f32x4){0.f, 0.f, 0.f, 0.f}; \
        const int k_ = (F.wave - cm) & 7; int mi_ = cm * (HY_ACT * 256) + mi0 + k_; asm volatile("" : "+s"(mi_));     \
        const bool act_ = hosted && k_ < HY_ACT && mi_ < conv_r0(l); \
        if (act_) { conv_mi_addr(F, l, mi_, F.lane, cs_, cl_, cd_, cp_); conv_mi_issue(cv_, cs_, cl_); } \
        CALL; \
        if (act_) { conv_mi_addr(F, l, mi_, F.lane, cs_, cl_, cd_, cp_); conv_mi_finish(cv_, cd_, cp_); } \
        ++cm; } while (0)
#define HY_FFT_FWD() do { HY_PASS((fft_r16_pass<false, 10>(X, tid))); HY_PASS((fft_r16_pass<false, 6>(X, tid))); HY_PASS((fft_r16_pass<false, 2>(X, tid))); HY_PASS(fft_r4_last<false>(X, tid)); } while (0)
#define HY_FFT_INV() do { HY_PASS(fft_r4_last<true>(X, tid)); HY_PASS((fft_r16_pass<true, 2>(X, tid))); HY_PASS((fft_r16_pass<true, 6>(X, tid))); HY_PASS((fft_r16_pass<true, 10>(X, tid))); } while (0)
    f32x2 kq0[16], kq1[16], kx0, kx1;
    const bf16_t* HT0 = WSP(bf16_t, WS_HYT);
    const float hb0 = INF(27)[l * 512 + c], hb1 = INF(27)[l * 512 + 256 + c];
    const unsigned* z0p = (const unsigned*)(HT0 + (size_t)(0 * 768 + 512 + c) * SEQ); const unsigned* z1p = (const unsigned*)(HT0 + (size_t)(1 * 768 + 512 + c) * SEQ);
    unsigned zq0[8], zq1[8];
#pragma unroll
    for (int i = 0; i < 8; ++i) { zq0[i] = z0p[tid + 512 * i]; zq1[i] = z1p[tid + 512 * i]; }
    {
        const unsigned* F0f = (const unsigned*)(WSP(bf16_t, WS_FILT) + ((size_t)l * 1024 + c) * SEQ); const unsigned* F0b = F0f + (size_t)256 * (SEQ / 2);
        const unsigned* F1f = F0f + (size_t)512 * (SEQ / 2); const unsigned* F1b = F0f + (size_t)768 * (SEQ / 2);
        float s0 = 0.f, s1 = 0.f;
        { unsigned a0[8], b0[8], a1[8], b1[8];
#pragma unroll
            for (int i = 0; i < 8; ++i) { int u = tid + 512 * i; asm volatile("" : "+v"(u)); a0[i] = F0f[u]; b0[i] = F0b[u]; a1[i] = F1f[u]; b1[i] = F1b[u]; }
#pragma unroll
            for (int i = 0; i < 8; ++i) { int t = 2 * tid + 1024 * i; asm volatile("" : "+v"(t));
                const f32x2 fa = (f32x2){bflo(a0[i]), bflo(a1[i])}, fb = (f32x2){bfhi(a0[i]), bfhi(a1[i])}, ba = (f32x2){bflo(b0[i]), bflo(b1[i])}, bb = (f32x2){bfhi(b0[i]), bfhi(b1[i])};
                s0 += fabsf(fa.x) + fabsf(fb.x) + fabsf(ba.x) + fabsf(bb.x); s1 += fabsf(fa.y) + fabsf(fb.y) + fabsf(ba.y) + fabsf(bb.y);
                LAS f32x2* xf = X + PX(t); xf[0] = fa; xf[1] = fb;
                LAS f32x2* xr = X + PX(16382 - t); xr[0] = bb; xr[1] = ba; } }
        const float inv0 = 0.5f / block_sum(F, s0, red), inv1 = 0.5f / block_sum(F, s1, red);
        HY_FFT_FWD();
#pragma unroll
        for (int i = 0; i < 16; ++i) { int q = tid + 512 * i; asm volatile("" : "+v"(q)); const int p = ((q >> 1) << 2) | (q & 1), f = drev4(p), pp = drev4((16384 - f) & 16383);
            const f32x2 w = X[PX(p)], wp = X[PX(pp)];
            kq0[i] = (f32x2){(w.x + wp.x) * inv0, (w.y - wp.y) * inv0};
            kq1[i] = (f32x2){(w.y + wp.y) * inv1, (wp.x - w.x) * inv1};
            if ((i & 3) == 3) asm volatile("" ::: "memory"); }
        { const f32x2 w = X[PX(2)]; kx0 = (f32x2){2.0f * w.x * inv0, 0.f}; kx1 = (f32x2){2.0f * w.y * inv1, 0.f}; }
        __syncthreads();
    }
#pragma unroll
    for (int i = 0; i < 8; ++i) { int t = 2 * tid + 1024 * i; asm volatile("" : "+v"(t)); LAS f32x2* xp = X + PX(t); xp[0] = (f32x2){bflo(zq0[i]), bflo(zq1[i])}; xp[1] = (f32x2){bfhi(zq0[i]), bfhi(zq1[i])};
        LAS f32x2* xz = X + PX(8192 + t); xz[0] = (f32x2){0.f, 0.f}; xz[1] = (f32x2){0.f, 0.f}; }
    __syncthreads();
    const float invn = 1.0f / 16384.0f;
#pragma unroll 1
    for (int o = 0; o < 2; ++o) {
        HY_FFT_FWD();
#pragma unroll
        for (int i = 0; i < 16; ++i) { int q = tid + 512 * i; asm volatile("" : "+v"(q)); const int p = ((q >> 1) << 2) | (q & 1), f = drev4(p), pp = drev4((16384 - f) & 16383);
            const f32x2 k = o ? kq1[i] : kq0[i];
            const f32x2 xa = X[PX(p)], xb = X[PX(pp)];
            X[PX(p)] = pk_cmul(xa, k);
            if (i != 0 || pp != p) X[PX(pp)] = pk_cmulc(xb, k);
            if ((i & 3) == 3) asm volatile("" ::: "memory"); }
        if (tid == 0) X[PX(2)] = pk_cmul(X[PX(2)], o ? kx1 : kx0);
        __syncthreads();
        HY_FFT_INV();
        const unsigned* g0p = (const unsigned*)(HT0 + (size_t)(0 * 768 + o * 256 + c) * SEQ); const unsigned* g1p = (const unsigned*)(HT0 + (size_t)(1 * 768 + o * 256 + c) * SEQ);
        const float hbo = o ? hb1 : hb0;
        unsigned* yh0 = (unsigned*)(WSP(bf16_t, WS_YHT) + (size_t)(0 * 256 + c) * SEQ); unsigned* yh1 = (unsigned*)(WSP(bf16_t, WS_YHT) + (size_t)(1 * 256 + c) * SEQ);
        unsigned ga[8], gb[8];
#pragma unroll
        for (int i = 0; i < 8; ++i) { ga[i] = g0p[tid + 512 * i]; gb[i] = g1p[tid + 512 * i]; }
#pragma unroll
        for (int i = 0; i < 8; ++i) { int t = 2 * tid + 1024 * i; asm volatile("" : "+v"(t)); LAS f32x2* xp = X + PX(t); const f32x2 ya = xp[0], yb = xp[1];
            const float r0a = bflo(ga[i]) * (ya.x * invn + bflo(zq0[i]) * hbo), r1a = bflo(gb[i]) * (ya.y * invn + bflo(zq1[i]) * hbo);
            const float r0b = bfhi(ga[i]) * (yb.x * invn + bfhi(zq0[i]) * hbo), r1b = bfhi(gb[i]) * (yb.y * invn + bfhi(zq1[i]) * hbo);
            if (o == 0) { xp[0] = (f32x2){r0a, r1a}; xp[1] = (f32x2){r0b, r1b}; LAS f32x2* xz = X + PX(8192 + t); xz[0] = (f32x2){0.f, 0.f}; xz[1] = (f32x2){0.f, 0.f};
                zq0[i] = pk2(r0a, r0b); zq1[i] = pk2(r1a, r1b); }
            else { yh0[tid + 512 * i] = pk2(r0a, r0b); yh1[tid + 512 * i] = pk2(r1a, r1b); }
            if (i & 1) asm volatile("" ::: "memory"); }
        __syncthreads();
    }
#undef HY_PASS
#undef HY_FFT_FWD
#undef HY_FFT_INV
}

__device__ __forceinline__ void hy_prep_tile(Frame& F, int tile, int l) {
    const int tid = F.tid, lane = F.lane, wave = F.wave;
    const int b = tile >> 7, t0 = (tile & 127) * 64;
    constexpr int RS = 1552;
    const bf16_t* U = WSP(bf16_t, WS_U);
    const float* cw = INF(16) + (size_t)l * 768 * 3; const float* cb = INF(17) + l * 768;
    float wl[8];
#pragma unroll
    for (int k = 0; k < 8; ++k) wl[k] = 0.f;
    if (lane < 48) { const int chl = 2 * (wave + 8 * lane);
#pragma unroll
        for (int k = 0; k < 6; ++k) wl[k] = cw[chl * 3 + k];
        wl[6] = cb[chl]; wl[7] = cb[chl + 1]; }
    { u32x4 hv[13];
#pragma unroll
      for (int i = 0; i < 13; ++i) { const int idx = tid + 512 * i; const int row = idx / 96, pc = idx % 96; const int tok = t0 - 1 + row;
          hv[i] = (u32x4){0u, 0u, 0u, 0u};
          if (row < 66 && tok >= 0 && tok < SEQ) hv[i] = *(const GAS u32x4*)(U + ((size_t)b * SEQ + tok) * DINP + U_HY + pc * 8); }
#pragma unroll
      for (int i = 0; i < 13; ++i) { const int idx = tid + 512 * i; const int row = idx / 96, pc = idx % 96;
          if (row < 66) *(LAS u32x4*)(F.lds + row * RS + pc * 16) = hv[i]; } }
    __syncthreads();
    bf16_t* HT = WSP(bf16_t, WS_HYT);
#define RL_(k) __builtin_bit_cast(float, __builtin_amdgcn_readlane(__builtin_bit_cast(int, wl[k]), i))
#pragma unroll 4
    for (int i = 0; i < 48; ++i) { const int cp = wave + 8 * i, ch = 2 * cp;
        const float w00 = RL_(0), w01 = RL_(1), w02 = RL_(2), w10 = RL_(3), w11 = RL_(4), w12 = RL_(5), b0 = RL_(6), b1 = RL_(7);
        const unsigned r0 = *(const LAS unsigned*)(F.lds + lane * RS + cp * 4), r1 = *(const LAS unsigned*)(F.lds + (lane + 1) * RS + cp * 4), r2 = *(const LAS unsigned*)(F.lds + (lane + 2) * RS + cp * 4);
        HT[((size_t)(b * 768 + ch)) * SEQ + t0 + lane] = (bf16_t)(pk2(w00 * bflo(r0) + w01 * bflo(r1) + w02 * bflo(r2) + b0, 0.f) & 0xffffu);
        HT[((size_t)(b * 768 + ch + 1)) * SEQ + t0 + lane] = (bf16_t)(pk2(w10 * bfhi(r0) + w11 * bfhi(r1) + w12 * bfhi(r2) + b1, 0.f) & 0xffffu); }
#undef RL_
    __syncthreads();
}

__device__ __forceinline__ void headnorm_phase(Frame& F, int l) {
    const int lane = F.lane, tid = F.tid, wave = F.wave;
    const bf16_t* U = WSP(bf16_t, WS_U); const bf16_t* YA = WSP(bf16_t, WS_YATT); const bf16_t* YH = WSP(bf16_t, WS_YHT);
    constexpr int RS2 = 528;
    const int g = wave >> 1, sub = wave & 1, cg = 4 * lane, ch = g * 256 + cg;
    const f32x4 og = *(const GAS f32x4*)(INF(29) + l * 1024 + ch);
    float scw[12];
#pragma unroll
    for (int j = 0; j < 12; ++j) scw[j] = INF(28)[(size_t)l * 768 + cg * 3 + j];
    for (int tile = F.vcu; tile < 256; tile += F.G) {
      const int tb = tile >> 7, t0 = (tile & 127) * 64;
#pragma unroll
      for (int i = 0; i < 4; ++i) { const int idx = tid + 512 * i, c = idx >> 3, p8 = idx & 7;
          const u32x4 v = *(const GAS u32x4*)(YH + ((size_t)(tb * 256 + c)) * SEQ + t0 + p8 * 8);
          LAS unsigned char* hp = F.lds + (8 * p8) * RS2 + 2 * c;
          *(LAS unsigned short*)(hp + 0 * RS2) = (unsigned short)(v.x & 0xffffu); *(LAS unsigned short*)(hp + 1 * RS2) = (unsigned short)(v.x >> 16);
          *(LAS unsigned short*)(hp + 2 * RS2) = (unsigned short)(v.y & 0xffffu); *(LAS unsigned short*)(hp + 3 * RS2) = (unsigned short)(v.y >> 16);
          *(LAS unsigned short*)(hp + 4 * RS2) = (unsigned short)(v.z & 0xffffu); *(LAS unsigned short*)(hp + 5 * RS2) = (unsigned short)(v.z >> 16);
          *(LAS unsigned short*)(hp + 6 * RS2) = (unsigned short)(v.w & 0xffffu); *(LAS unsigned short*)(hp + 7 * RS2) = (unsigned short)(v.w >> 16); }
      __syncthreads();
      constexpr int RB = 8;
      const int mrow0 = tb * SEQ + t0 + sub * 32;
#define PG_FIN(M, Y0, Y1, Y2, Y3) do { const float y0_ = (Y0), y1_ = (Y1), y2_ = (Y2), y3_ = (Y3); \
        float ss = (y0_ * y0_ + y1_ * y1_) + (y2_ * y2_ + y3_ * y3_); \
        ss = row16_sum(ss); \
        const float rstd = __builtin_amdgcn_rsqf(ss * (1.0f / 64.0f) + EPS); \
        u32x2 w_; w_.x = pk2(y0_ * rstd * og.x, y1_ * rstd * og.y); w_.y = pk2(y2_ * rstd * og.z, y3_ * rstd * og.w); \
        *(GAS u32x2*)(WSP(bf16_t, WS_YN) + (size_t)(M) * DM + ch) = w_; } while (0)
      if (g == 0) {
#pragma unroll 1
        for (int r0 = 0; r0 < 32; r0 += RB) { u32x2 ow[RB], hfw[RB], hbw[RB];
#pragma unroll
            for (int i = 0; i < RB; ++i) { const int m = mrow0 + r0 + i;
                ow[i] = *(const GAS u32x2*)(U + (size_t)m * DINP + U_MLO + cg);
                hfw[i] = *(const GAS u32x2*)(WSP(bf16_t, WS_HF) + (size_t)m * 256 + cg); hbw[i] = *(const GAS u32x2*)(WSP(bf16_t, WS_HB) + (size_t)m * 256 + cg); }
#pragma unroll
            for (int i = 0; i < RB; ++i) { const int m = mrow0 + r0 + i;
                const f32x4 hs = (f32x4){bflo(hfw[i].x) + bflo(hbw[i].x), bfhi(hfw[i].x) + bfhi(hbw[i].x), bflo(hfw[i].y) + bflo(hbw[i].y), bfhi(hfw[i].y) + bfhi(hbw[i].y)};
                PG_FIN(m, hs.x / (1.0f + fexp(-bflo(ow[i].x))), hs.y / (1.0f + fexp(-bfhi(ow[i].x))), hs.z / (1.0f + fexp(-bflo(ow[i].y))), hs.w / (1.0f + fexp(-bfhi(ow[i].y)))); } }
      } else if (g == 1) {
#pragma unroll 1
        for (int r0 = 0; r0 < 32; r0 += 2 * RB) { u32x2 w[2 * RB];
#pragma unroll
            for (int i = 0; i < 2 * RB; ++i) w[i] = *(const GAS u32x2*)(YA + (size_t)(mrow0 + r0 + i) * 256 + cg);
#pragma unroll
            for (int i = 0; i < 2 * RB; ++i) PG_FIN(mrow0 + r0 + i, bflo(w[i].x), bfhi(w[i].x), bflo(w[i].y), bfhi(w[i].y)); }
      } else if (g == 2) {
#pragma unroll 1
        for (int r0 = 0; r0 < 32; r0 += 2 * RB) { u32x2 w[2 * RB];
#pragma unroll
            for (int i = 0; i < 2 * RB; ++i) w[i] = *(const LAS u32x2*)(F.lds + (sub * 32 + r0 + i) * RS2 + cg * 2);
#pragma unroll
            for (int i = 0; i < 2 * RB; ++i) PG_FIN(mrow0 + r0 + i, bflo(w[i].x), bfhi(w[i].x), bflo(w[i].y), bfhi(w[i].y)); }
      } else {
#pragma unroll 1
        for (int r0 = 0; r0 < 32; r0 += RB) { u32x2 bw[RB], cc[RB + 2], xx[RB + 2];
#pragma unroll
            for (int i = 0; i < RB + 2; ++i) { const int s = t0 + sub * 32 + r0 + i - 1; const bf16_t* up = U + (size_t)(tb * SEQ + s) * DINP + U_SC + cg;
                cc[i] = (u32x2){0u, 0u}; xx[i] = (u32x2){0u, 0u};
                if (s >= 0 && s < SEQ) { cc[i] = *(const GAS u32x2*)(up + 256); xx[i] = *(const GAS u32x2*)(up + 512); }
                if (i >= 1 && i <= RB) bw[i - 1] = *(const GAS u32x2*)up; }
#pragma unroll
            for (int i = 0; i < RB; ++i) { const u32x2 c0 = cc[i], x0 = xx[i], c1 = cc[i + 1], x1 = xx[i + 1], c2 = cc[i + 2], x2 = xx[i + 2], b_ = bw[i];
                PG_FIN(mrow0 + r0 + i,
                    bflo(b_.x) * (scw[0] * bflo(c0.x) * bflo(x0.x) + scw[1] * bflo(c1.x) * bflo(x1.x) + scw[2] * bflo(c2.x) * bflo(x2.x)),
                    bfhi(b_.x) * (scw[3] * bfhi(c0.x) * bfhi(x0.x) + scw[4] * bfhi(c1.x) * bfhi(x1.x) + scw[5] * bfhi(c2.x) * bfhi(x2.x)),
                    bflo(b_.y) * (scw[6] * bflo(c0.y) * bflo(x0.y) + scw[7] * bflo(c1.y) * bflo(x1.y) + scw[8] * bflo(c2.y) * bflo(x2.y)),
                    bfhi(b_.y) * (scw[9] * bfhi(c0.y) * bfhi(x0.y) + scw[10] * bfhi(c1.y) * bfhi(x1.y) + scw[11] * bfhi(c2.y) * bfhi(x2.y))); } }
      }
#undef PG_FIN
      __syncthreads();
    }
}

__device__ __forceinline__ void post_mixer_phase(Frame& F, int l, const float* xin) {
    const int gw = F.vcu * NWAVES + F.wave, NGW = F.G * NWAVES, lane = F.lane, tid = F.tid;
    LAS float* RWT = (LAS float*)F.lds;
    { const GAS f32x4* src = (const GAS f32x4*)(INF(31) + (size_t)l * 1024 * 16);
      f32x4 wv[8];
#pragma unroll
      for (int q = 0; q < 8; ++q) wv[q] = src[tid + NTHR * q];
#pragma unroll
      for (int q = 0; q < 8; ++q) { const int i = tid + NTHR * q; const f32x4 w = wv[q]; const int k = i >> 2, e4 = (i & 3) * 4;
          RWT[(e4 + 0) * 1024 + k] = w.x; RWT[(e4 + 1) * 1024 + k] = w.y; RWT[(e4 + 2) * 1024 + k] = w.z; RWT[(e4 + 3) * 1024 + k] = w.w; } }
    __syncthreads();
    const float* mod = WSP(float, WS_MOD);
    f32x4 pA[4], pS[4], pB[4]; int bcur = -1;
#pragma unroll
    for (int j = 0; j < 4; ++j) { pA[j] = (f32x4){0.f, 0.f, 0.f, 0.f}; pS[j] = pA[j]; pB[j] = pA[j]; }
    for (int m0 = gw; m0 < MTOK; m0 += 2 * NGW) {
        u32x2 yw[2][4]; f32x4 xr[2][4];
#pragma unroll
        for (int r = 0; r < 2; ++r) { const int mm = (m0 + r * NGW < MTOK) ? m0 + r * NGW : m0;
            const GAS u32x2* yr = (const GAS u32x2*)(WSP(bf16_t, WS_Y2) + (size_t)mm * DM) + lane;
#pragma unroll
            for (int j = 0; j < 4; ++j) yw[r][j] = yr[64 * j];
            if (l == 0) ld_row_f32(xin + (size_t)mm * DM, lane, xr[r]);
            else { const GAS u32x2* xb = (const GAS u32x2*)((const bf16_t*)xin + (size_t)mm * DM) + lane;
#pragma unroll
                for (int j = 0; j < 4; ++j) { const u32x2 w = xb[64 * j]; xr[r][j] = (f32x4){bflo(w.x), bfhi(w.x), bflo(w.y), bfhi(w.y)}; } } }
        f32x4 h[2][4];
#pragma unroll
        for (int r = 0; r < 2; ++r) { const int m = (m0 + r * NGW < MTOK) ? m0 + r * NGW : m0;
            const int b = m >> 13;
            if (b != bcur) { bcur = b; const float* md = mod + (l * 2 + b) * 6144; f32x4 t0[4], t1[4];
                ld_row_f32(INF(6) + l * 1024, lane, t0); ld_row_f32(md + 2048, lane, t1);
#pragma unroll
                for (int j = 0; j < 4; ++j) pB[j] = t1[j] * t0[j];
                ld_row_f32(INF(7) + l * 1024, lane, t0); ld_row_f32(md + 4096, lane, t1); ld_row_f32(md + 3072, lane, pS);
#pragma unroll
                for (int j = 0; j < 4; ++j) pA[j] = t0[j] * (t1[j] + 1.0f); }
            f32x4 y2[4], x[4];
#pragma unroll
            for (int j = 0; j < 4; ++j) { y2[j] = (f32x4){bflo(yw[r][j].x), bfhi(yw[r][j].x), bflo(yw[r][j].y), bfhi(yw[r][j].y)}; x[j] = xr[r][j]; }
            const float rstd = __builtin_amdgcn_rsqf(row_ss(y2) * (1.0f / DM) + EPS);
#pragma unroll
            for (int j = 0; j < 4; ++j) x[j] = x[j] + (y2[j] * rstd) * pB[j];
            st_row_bf16(WSP(bf16_t, WS_X1) + (size_t)m * DM, lane, x);
            const float rs2 = __builtin_amdgcn_rsqf(row_ss(x) * (1.0f / DM) + EPS);
#pragma unroll
            for (int j = 0; j < 4; ++j) h[r][j] = (x[j] * rs2) * pA[j] + pS[j];
            st_row_bf16(WSP(bf16_t, WS_XN) + (size_t)m * DM, lane, h[r]); }
        f32x2 acc[16];
#pragma unroll
        for (int e = 0; e < 16; ++e) acc[e] = (f32x2){0.f, 0.f};
#pragma unroll
        for (int j = 0; j < 4; ++j) {
            const f32x2 hx = (f32x2){h[0][j].x, h[1][j].x}, hy = (f32x2){h[0][j].y, h[1][j].y}, hz = (f32x2){h[0][j].z, h[1][j].z}, hw = (f32x2){h[0][j].w, h[1][j].w};
            f32x4 w[16];
#pragma unroll
            for (int e = 0; e < 16; ++e) w[e] = *(const LAS f32x4*)(RWT + e * 1024 + 4 * lane + 256 * j);
            __builtin_amdgcn_sched_barrier(0);
#pragma unroll
            for (int e = 0; e < 16; ++e) { const f32x2 wa = (f32x2){w[e].x, w[e].y}, wb = (f32x2){w[e].z, w[e].w};
                asm("v_pk_fma_f32 %0, %1, %2, %0 op_sel_hi:[1,0,1]" : "+v"(acc[e]) : "v"(hx), "v"(wa));
                asm("v_pk_fma_f32 %0, %1, %2, %0 op_sel:[0,1,0] op_sel_hi:[1,1,1]" : "+v"(acc[e]) : "v"(hy), "v"(wa));
                asm("v_pk_fma_f32 %0, %1, %2, %0 op_sel_hi:[1,0,1]" : "+v"(acc[e]) : "v"(hz), "v"(wb));
                asm("v_pk_fma_f32 %0, %1, %2, %0 op_sel:[0,1,0] op_sel_hi:[1,1,1]" : "+v"(acc[e]) : "v"(hw), "v"(wb)); }
            __builtin_amdgcn_sched_barrier(0); }
#pragma unroll
        for (int r = 0; r < 2; ++r) { const int m = (m0 + r * NGW < MTOK) ? m0 + r * NGW : m0; const int b = m >> 13, s = m & 8191;
        float part[16];
#pragma unroll
        for (int e = 0; e < 16; ++e) part[e] = r ? acc[e].y : acc[e].x;
        float a8[8], a4[4], a2[2], lg;
        { const bool up = (lane & 32) != 0;
#pragma unroll
          for (int i = 0; i < 8; ++i) { const float keep = up ? part[8 + i] : part[i], send = up ? part[i] : part[8 + i]; a8[i] = keep + __shfl_xor(send, 32); } }
        { const bool up = (lane & 16) != 0;
#pragma unroll
          for (int i = 0; i < 4; ++i) { const float keep = up ? a8[4 + i] : a8[i], send = up ? a8[i] : a8[4 + i]; a4[i] = keep + __shfl_xor(send, 16); } }
        { const bool up = (lane & 8) != 0;
#pragma unroll
          for (int i = 0; i < 2; ++i) { const float keep = up ? a4[2 + i] : a4[i], send = up ? a4[i] : a4[2 + i]; a2[i] = keep + __shfl_xor(send, 8); } }
        { const bool up = (lane & 4) != 0; const float keep = up ? a2[1] : a2[0], send = up ? a2[0] : a2[1]; lg = keep + __shfl_xor(send, 4); }
        lg += __shfl_xor(lg, 2); lg += __shfl_xor(lg, 1);
        float mx = lg;
#pragma unroll
        for (int o = 4; o < 64; o <<= 1) mx = fmaxf(mx, __shfl_xor(mx, o));
        const float ex = fexp(lg - mx); float sm = ex;
#pragma unroll
        for (int o = 4; o < 64; o <<= 1) sm += __shfl_xor(sm, o);
        if ((lane & 3) == 0) WSP(float, WS_AFF)[((size_t)b * 16 + (lane >> 2)) * SEQ + s] = ex / sm;
        if (lane < 16) WSP(int, WS_SLOT)[(size_t)m * 16 + lane] = -1;
            }
    }
    __syncthreads();
}

__device__ __forceinline__ void topk_item(Frame& F, int it) {
    const int tid = F.tid, lane = F.lane, wave = F.wave;
    const int b = it >> 4, e = it & 15;
    LAS unsigned* wcnt = (LAS unsigned*)F.lds;
    LAS unsigned* wtot = wcnt + 16;
    unsigned key[16];
    { const GAS u32x4* src = (const GAS u32x4*)(WSP(float, WS_AFF) + (size_t)it * SEQ) + tid * 4;
#pragma unroll
      for (int q = 0; q < 4; ++q) { const u32x4 v = src[q]; key[4 * q] = v.x; key[4 * q + 1] = v.y; key[4 * q + 2] = v.z; key[4 * q + 3] = v.w; } }
    unsigned T = 0u;
#pragma unroll 1
    for (int bit = 30; bit >= 0; --bit) {
        const unsigned cand = T | (1u << bit);
        unsigned c = 0u;
#pragma unroll
        for (int i = 0; i < 16; ++i) c += (key[i] >= cand) ? 1u : 0u;
#pragma unroll
        for (int o = 1; o < 64; o <<= 1) c += __shfl_xor(c, o);
        LAS unsigned* wc = wcnt + (bit & 1) * 8;
        if (lane == 0) wc[wave] = c;
        __syncthreads();
        unsigned tot = 0u;
#pragma unroll
        for (int w = 0; w < NWAVES; ++w) tot += wc[w];
        if (tot >= (unsigned)CAP) T = cand;
    }
    unsigned cg = 0u, ce = 0u;
#pragma unroll
    for (int i = 0; i < 16; ++i) { cg += (key[i] > T) ? 1u : 0u; ce += (key[i] == T) ? 1u : 0u; }
    unsigned v = cg | (ce << 16), inc = v;
#pragma unroll
    for (int o = 1; o < 64; o <<= 1) { const unsigned n = __shfl_up(inc, o); if (lane >= o) inc += n; }
    __syncthreads();
    if (lane == 63) wtot[wave] = inc;
    __syncthreads();
    unsigned off = 0u, all = 0u;
#pragma unroll
    for (int w = 0; w < NWAVES; ++w) { const unsigned tw = wtot[w]; all += tw; if (w < wave) off += tw; }
    const unsigned need = (unsigned)CAP - (all & 0xffffu);
    const unsigned excl = off + inc - v;
    unsigned ng = excl & 0xffffu, ne = excl >> 16;
    int* IDX = WSP(int, WS_IDX) + (e * 2 + b) * CAP; int* SLOT = WSP(int, WS_SLOT);
#pragma unroll
    for (int i = 0; i < 16; ++i) { const int idx = tid * 16 + i; const unsigned k = key[i];
        const bool gt = k > T, eq = k == T; const bool sel = gt || (eq && ne < need);
        if (sel) { const int slot = (int)(ng + (ne < need ? ne : need)); IDX[slot] = b * SEQ + idx; SLOT[((size_t)b * SEQ + idx) * 16 + e] = slot; }
        ng += gt ? 1u : 0u; ne += eq ? 1u : 0u; }
    __syncthreads();
}

__device__ __forceinline__ void combine_phase(Frame& F, int l) {
    const int gw = F.vcu * NWAVES + F.wave, NGW = F.G * NWAVES, lane = F.lane;
    const float* mod = WSP(float, WS_MOD);
    const bf16_t* YE = WSP(bf16_t, WS_YE);
    f32x4 pg[4]; ld_row_f32(INF(8) + l * 1024, lane, pg);
    f32x4 pG[4], nA[4], nS[4]; int bcur = -1;
#pragma unroll
    for (int j = 0; j < 4; ++j) { pG[j] = (f32x4){0.f, 0.f, 0.f, 0.f}; nA[j] = pG[j]; nS[j] = pG[j]; }
    for (int m0 = gw; m0 < MTOK; m0 += 2 * NGW) {
        int sl[2]; float gv[2]; f32x4 x1[2][4];
#pragma unroll
        for (int r = 0; r < 2; ++r) { const int mm = (m0 + r * NGW < MTOK) ? m0 + r * NGW : m0; const int b = mm >> 13, s = mm & 8191;
            sl[r] = -1; gv[r] = 0.f;
            if (lane < 16) { sl[r] = WSP(int, WS_SLOT)[(size_t)mm * 16 + lane]; gv[r] = WSP(float, WS_AFF)[((size_t)b * 16 + lane) * SEQ + s]; }
            { const GAS u32x2* xr = (const GAS u32x2*)(WSP(bf16_t, WS_X1) + (size_t)mm * DM) + lane;
#pragma unroll
              for (int j = 0; j < 4; ++j) { const u32x2 w = xr[64 * j]; x1[r][j] = (f32x4){bflo(w.x), bfhi(w.x), bflo(w.y), bfhi(w.y)}; } } }
        unsigned long long msk[2]; float g0[2], g1[2]; u32x2 w0[2][4], w1[2][4];
#pragma unroll
        for (int r = 0; r < 2; ++r) { const int mm = (m0 + r * NGW < MTOK) ? m0 + r * NGW : m0; const int b = mm >> 13;
            msk[r] = __ballot(sl[r] >= 0) & 0xffffull;
            int e0 = 0, e1 = -1; unsigned long long mk = msk[r];
            if (mk) { e0 = __builtin_ctzll(mk); mk &= mk - 1; } else e0 = -1;
            if (mk) { e1 = __builtin_ctzll(mk); mk &= mk - 1; }
            msk[r] = mk;
            const int ea = e0 < 0 ? 0 : e0, eb = e1 < 0 ? ea : e1;
            const int s0 = __shfl(sl[r], ea), s1 = __shfl(sl[r], eb);
            g0[r] = (e0 < 0) ? 0.f : __shfl(gv[r], ea); g1[r] = (e1 < 0) ? 0.f : __shfl(gv[r], eb);
            const GAS u32x2* r0 = (const GAS u32x2*)(YE + ((size_t)ea * 2048 + b * CAP + (e0 < 0 ? 0 : s0)) * DM) + lane;
            const GAS u32x2* r1 = (const GAS u32x2*)(YE + ((size_t)eb * 2048 + b * CAP + (e0 < 0 ? 0 : s1)) * DM) + lane;
#pragma unroll
            for (int j = 0; j < 4; ++j) { w0[r][j] = r0[64 * j]; w1[r][j] = r1[64 * j]; } }
#pragma unroll
        for (int r = 0; r < 2; ++r) { const int m = m0 + r * NGW; if (m >= MTOK) break;
            const int b = m >> 13;
            f32x4 acc[4];
#pragma unroll
            for (int j = 0; j < 4; ++j) { acc[j] = (f32x4){bflo(w0[r][j].x), bfhi(w0[r][j].x), bflo(w0[r][j].y), bfhi(w0[r][j].y)} * g0[r];
                                          acc[j] += (f32x4){bflo(w1[r][j].x), bfhi(w1[r][j].x), bflo(w1[r][j].y), bfhi(w1[r][j].y)} * g1[r]; }
            unsigned long long mk = msk[r];
            while (mk) {
                const int e0 = __builtin_ctzll(mk); mk &= mk - 1;
                int e1 = -1; if (mk) { e1 = __builtin_ctzll(mk); mk &= mk - 1; }
                const int s0 = __shfl(sl[r], e0); const float h0 = __shfl(gv[r], e0);
                const int s1 = __shfl(sl[r], e1 < 0 ? e0 : e1); const float h1 = (e1 < 0) ? 0.f : __shfl(gv[r], e1 < 0 ? e0 : e1);
                const GAS u32x2* r0 = (const GAS u32x2*)(YE + ((size_t)e0 * 2048 + b * CAP + s0) * DM) + lane;
                const GAS u32x2* r1 = (const GAS u32x2*)(YE + ((size_t)(e1 < 0 ? e0 : e1) * 2048 + b * CAP + s1) * DM) + lane;
                u32x2 v0[4], v1[4];
#pragma unroll
                for (int j = 0; j < 4; ++j) { v0[j] = r0[64 * j]; v1[j] = r1[64 * j]; }
#pragma unroll
                for (int j = 0; j < 4; ++j) { acc[j] += (f32x4){bflo(v0[j].x), bfhi(v0[j].x), bflo(v0[j].y), bfhi(v0[j].y)} * h0;
                                              acc[j] += (f32x4){bflo(v1[j].x), bfhi(v1[j].x), bflo(v1[j].y), bfhi(v1[j].y)} * h1; }
            }
            if (b != bcur) { bcur = b; const float* md = mod + (l * 2 + b) * 6144; f32x4 t0[4];
                ld_row_f32(md + 5120, lane, t0);
#pragma unroll
                for (int j = 0; j < 4; ++j) pG[j] = t0[j] * pg[j];
                if (l == 0) { const float* md1 = mod + (1 * 2 + b) * 6144; f32x4 t1[4];
                    ld_row_f32(INF(5) + 1024, lane, t0); ld_row_f32(md1 + 1024, lane, t1); ld_row_f32(md1, lane, nS);
#pragma unroll
                    for (int j = 0; j < 4; ++j) nA[j] = t0[j] * (t1[j] + 1.0f); } }
            const float rstd = __builtin_amdgcn_rsqf(row_ss(acc) * (1.0f / DM) + EPS);
            f32x4 xo[4];
#pragma unroll
            for (int j = 0; j < 4; ++j) xo[j] = x1[r][j] + (acc[j] * rstd) * pG[j];
            if (l == 0) st_row_bf16((bf16_t*)F.a->out + (size_t)m * DM, lane, xo); else st_row_f32(F.a->out + (size_t)m * DM, lane, xo);
            if (l == 0) { f32x4 h[4]; const float rs1 = __builtin_amdgcn_rsqf(row_ss(xo) * (1.0f / DM) + EPS);
#pragma unroll
                for (int j = 0; j < 4; ++j) h[j] = (xo[j] * rs1) * nA[j] + nS[j];
                st_row_bf16(WSP(bf16_t, WS_XN) + (size_t)m * DM, lane, h); }
        }
    }
}

constexpr int PH_PER_LAYER = 11, N_PHASES = 2 + 2 * PH_PER_LAYER;
__global__ void __launch_bounds__(NTHR, 2) mega_fwd(Args args) {
    extern __shared__ __attribute__((aligned(16))) unsigned char lds_raw[];
    Frame F;
    F.lds = (LAS unsigned char*)lds_raw;
    F.tid = threadIdx.x; F.lane = F.tid & 63; F.wave = __builtin_amdgcn_readfirstlane(F.tid >> 6);
    F.G = gridDim.x; { const int bx = blockIdx.x; F.vcu = (F.G % 8 == 0) ? (bx % 8) * (F.G / 8) + bx / 8 : bx; }
    F.a = &args; F.ws = args.ws;
    volatile LAS unsigned* MISC = (volatile LAS unsigned*)(F.lds + MISC_OFF);
    for (int u = F.tid; u < (LDS_BYTES - LDSCTL_OFF) / 4; u += NTHR) ((LAS unsigned*)(F.lds + LDSCTL_OFF))[u] = 0u;
    __syncthreads();
    gu32* ctl = (gu32*)(F.ws + WS_CTL);
    XcdBarrier bar; bar.bar = (unsigned*)(ctl + CW_BAR); bar.x = 0; bar.st = nullptr;
#if !MK_SPLIT
    bar = xcd_barrier_post((unsigned*)(ctl + CW_BAR), MISC + 8);
#endif
    const int lo = args.ph_lo, hi = args.ph_hi;
    int ph = 0;
#if MK_SPLIT
#define SEAM() do { } while (0)
#else
#define SEAM() do { if (ph + 1 < hi) { if (F.G == 256 && ph < CONV_NB0 + CONV_NB1) { const int cl_ = ph < CONV_NB0 ? 0 : 1; xcd_barrier_conv(bar, F, cl_, conv_r0(cl_) + (cl_ ? ph - CONV_NB0 : ph) * CONV_PER_BAR); } else xcd_barrier(bar); } } while (0)
#endif
#ifndef PHSEL
#define PHSEL -1
#endif
#ifndef PHMASK
#define PHMASK 0x7fff
#endif
#ifndef DBL_MASK
#define DBL_MASK 0
#endif
#define PHASE_BEGIN(id) if ((PHSEL < 0 || PHSEL == (id)) && ((PHMASK >> (id)) & 1) && lo <= ph && ph < hi) for (int rep_ = 0; rep_ < (((DBL_MASK >> (id)) & 1) ? 2 : 1); ++rep_) { if (rep_) xcd_barrier(bar); { int t_ = threadIdx.x; asm volatile("" : "+v"(t_)); F.tid = t_; F.lane = t_ & 63; F.wave = __builtin_amdgcn_readfirstlane(t_ >> 6); }
#define PHASE_END   SEAM(); } ++ph;

    PHASE_BEGIN(0) p0_phase(F); PHASE_END
    PHASE_BEGIN(1) p1_phase(F); PHASE_END
#pragma unroll 1
    for (int l = 0; l < 2; ++l) {
        const float* xin = (l == 0) ? (const float*)args.in[0] : (const float*)args.out;
        PHASE_BEGIN(2) {
            pg8::Gemm g{WSP(bf16_t, WS_XN), WSP(bf16_t, WS_WIN) + (size_t)l * DINP * 1024, MTOK, DINP, 1024}; pg8::StaticOrder S; S.init(MTOK, DINP, F.G, (int)blockIdx.x);
            pg8::EpiBf16 E{WSP(bf16_t, WS_U), DINP, DINP / 256};
            pg8::gemm_phase<pg8::EpiBf16, pg8::StaticOrder, true, true>(F.lds, g, S, E, F.tid);
        } PHASE_END
        PHASE_BEGIN(3) {
#ifndef SUBSEL
#define SUBSEL 0
#endif
#ifndef REP_A
#define REP_A 1
#define REP_B 1
#define REP_C 1
#define REP_D 1
#define REP_E 1
#endif
            for (int q_ = 0; q_ < REP_A; ++q_) for (int tl = F.vcu; tl < 256; tl += F.G) hy_prep_tile(F, tl, l);
            for (int q_ = 0; q_ < REP_B; ++q_) for (int p = F.vcu; p < 512; p += F.G) ml_local_pair(F, p, l);
            for (int q_ = 0; q_ < REP_C; ++q_) mla_prep_rows(F, l);
        } PHASE_END
        PHASE_BEGIN(4) {
            pg8::Gemm g{WSP(bf16_t, WS_AMLA), WSP(bf16_t, WS_WMLA) + (size_t)l * 1024 * 384, MTOK, 1024, 384}; pg8::StaticOrder S; S.init(MTOK, 1024, F.G, (int)blockIdx.x);
            EpiMla E{WSP(bf16_t, WS_Q), WSP(bf16_t, WS_KIMG), WSP(bf16_t, WS_VIMG), (const int*)F.a->in[2], 0.10206207261596577f * LOG2E};
            pg8::gemm_phase<EpiMla, pg8::StaticOrder, true, true>(F.lds, g, S, E, F.tid);
#define REFRESH_TID() do { int t_ = threadIdx.x; asm volatile("" : "+v"(t_)); F.tid = t_; F.lane = t_ & 63; F.wave = __builtin_amdgcn_readfirstlane(t_ >> 6); } while (0)
            REFRESH_TID();
            ml_scan(F);
            REFRESH_TID();
#ifndef HY_REP
#define HY_REP 1
#endif
            for (int rep2_ = 0; rep2_ < HY_REP; ++rep2_) for (int c = F.vcu; c < 256; c += F.G) hyena_item(F, c, l);
        } PHASE_END
        PHASE_BEGIN(5) {
            for (int q_ = 0; q_ < REP_D; ++q_) for (int u = F.vcu; u < 256; u += F.G) attn_unit(F, u >> 5, u & 31);
            for (int q_ = 0; q_ < REP_E; ++q_) for (int p = F.vcu; p < 512; p += F.G) ml_out_pair(F, p, l);
        } PHASE_END
        PHASE_BEGIN(6) headnorm_phase(F, l); PHASE_END
        PHASE_BEGIN(7) {
            pg8::Gemm g{WSP(bf16_t, WS_YN), WSP(bf16_t, WS_WOUT) + (size_t)l * 1024 * 1024, MTOK, 1024, 1024}; pg8::StaticOrder S; S.init(MTOK, 1024, F.G, (int)blockIdx.x);
            pg8::EpiBf16 E{WSP(bf16_t, WS_Y2), 1024, 4};
            pg8::gemm_phase<pg8::EpiBf16, pg8::StaticOrder, true, true>(F.lds, g, S, E, F.tid);
        } PHASE_END
        PHASE_BEGIN(8) post_mixer_phase(F, l, xin); PHASE_END
        PHASE_BEGIN(9) {
            for (int it = F.vcu; it < 32; it += F.G) topk_item(F, it);
            if (F.G == 256 && !MK_SPLIT && F.vcu >= 32) {
                const int w = (F.vcu - 32) * NWAVES + F.wave;
                int lq_ = l; asm volatile("" : "+s"(lq_));
#pragma unroll 1
                for (int mi = 40960 + w; mi < 49152; mi += 1792) {
                    f32x4 ca[8]; const float* sa; bf16_t* da; int la, pa_;
                    conv_mi_addr(F, lq_, mi, F.lane, sa, la, da, pa_); conv_mi_issue(ca, sa, la);
                    conv_mi_finish(ca, da, pa_);
                }
            }
        } PHASE_END
        PHASE_BEGIN(10) {
            pg8::Gemm g{WSP(bf16_t, WS_XN), WSP(bf16_t, WS_WGU) + (size_t)l * NEXP * 4096 * 1024, NEXP * 2048, NEXP * 4096, 1024, WSP(int, WS_IDX)}; pg8::GroupedOrder S; S.init(16, F.G, (int)blockIdx.x);
            pg8::EpiSwiGLU E{WSP(bf16_t, WS_ACT), LDFF};
            pg8::gemm_phase<pg8::EpiSwiGLU, pg8::GroupedOrder, true, true, true>(F.lds, g, S, E, F.tid);
        } PHASE_END
        PHASE_BEGIN(11) {
            pg8::Gemm g{WSP(bf16_t, WS_ACT), WSP(bf16_t, WS_WDN) + (size_t)l * NEXP * 1024 * LDFF, NEXP * 2048, NEXP * 1024, 2048, nullptr, LDFF, LDFF}; pg8::GroupedOrder S; S.init(4, F.G, (int)blockIdx.x);
            pg8::EpiBf16 E{WSP(bf16_t, WS_YE), 1024, 4};
            pg8::gemm_phase<pg8::EpiBf16, pg8::GroupedOrder, true, true>(F.lds, g, S, E, F.tid);
        } PHASE_END
        PHASE_BEGIN(12) combine_phase(F, l); PHASE_END
    }
}

extern "C" void kernel_launch(void* const* d_in, const int* in_sizes, int n_in, void* d_out, int out_size, void* d_ws, size_t ws_size, hipStream_t stream) {
    static int grid = 0;
    if (grid == 0) {
        if (n_in != 35 || out_size != MTOK * DM || ws_size < WS_END) { fprintf(stderr, "kernel_launch: unexpected shapes: n_in %d out %d ws %zu (need %zu)\n", n_in, out_size, ws_size, (size_t)WS_END); grid = -1; return; }
        int dev = 0, cus = 0, per_cu = 0;
        if (hipGetDevice(&dev) != hipSuccess || hipDeviceGetAttribute(&cus, hipDeviceAttributeMultiprocessorCount, dev) != hipSuccess) { grid = -1; return; }
        if (hipFuncSetAttribute((const void*)mega_fwd, hipFuncAttributeMaxDynamicSharedMemorySize, LDS_BYTES) != hipSuccess) { fprintf(stderr, "kernel_launch: hipFuncSetAttribute failed\n"); grid = -1; return; }
        (void)hipOccupancyMaxActiveBlocksPerMultiprocessor(&per_cu, (const void*)mega_fwd, NTHR, LDS_BYTES);
        (void)hipGetLastError();
        grid = cus > 0 ? cus : 256;
        if (per_cu < 1) fprintf(stderr, "kernel_launch: occupancy query reports %d\n", per_cu);
    }
    if (grid < 0) return;
    (void)hipMemsetAsync((char*)d_ws + WS_CTL, 0, CTL_ZERO_BYTES, stream);
    Args a{};
    for (int i = 0; i < 35; ++i) a.in[i] = d_in[i];
    a.out = (float*)d_out; a.ws = (unsigned char*)d_ws;
#if MK_SPLIT
    for (int p = 0; p < N_PHASES; ++p) { a.ph_lo = p; a.ph_hi = p + 1; hipLaunchKernelGGL(mega_fwd, dim3(grid), dim3(NTHR), LDS_BYTES, stream, a); }
#else
    a.ph_lo = 0; a.ph_hi = N_PHASES;
    hipLaunchKernelGGL(mega_fwd, dim3(grid), dim3(NTHR), LDS_BYTES, stream, a);
#endif
}
```
